# Optimizing an MI355X kernel written in HIP

```python
import jax
import jax.numpy as jnp
from jax import lax
import numpy as np

D_MODEL = 1024
BATCH = 8
SEQ = 4096
DEPTH = 4

CTX_LEN = 256
GRID_W = 64
HEAD_DIM = 64
ROPE_HALF = HEAD_DIM // 2
ROPE_THETA = 10000.0
ATTN_HEADS = 8
ATTN_KV_HEADS = 2
ATTN_GROUP = ATTN_HEADS // ATTN_KV_HEADS
ATTN_WIDTH = ATTN_HEADS * HEAD_DIM
KV_WIDTH = ATTN_KV_HEADS * HEAD_DIM
ATTN_IN = ATTN_WIDTH + 2 * KV_WIDTH
ATTN_SCALE = HEAD_DIM ** -0.5
Q_BLOCK = 128
RWKV_HEADS = 8
RWKV_WIDTH = RWKV_HEADS * HEAD_DIM
DECAY_LORA = 64
ICLR_LORA = 64
GATE_LORA = 128
SHIFT_WIDTH = 3 * RWKV_WIDTH + 2 * DECAY_LORA + 2 * ICLR_LORA + GATE_LORA
IN_WIDTH = ATTN_IN + SHIFT_WIDTH
MIX_WIDTH = ATTN_WIDTH + RWKV_WIDTH
D_FF_DENSE = 2816
D_FF_EXPERT = 3584
N_EXPERTS = 8
TOP_K = 2
MOE_BLOCK = 128
N_DENSE = (DEPTH + 1) // 2
N_MOE = DEPTH // 2
N_MOD = 6
EPS = 1e-6
GN_EPS = 64e-5
F32 = jnp.float32

kernel_name = 'hymba_gqa_rwkv7_moe_prefix_dit'


def rmsnorm(x, g):
    xf = x.astype(F32)
    y = xf * lax.rsqrt(jnp.mean(xf * xf, axis=-1, keepdims=True) + EPS)
    return (y * g.astype(F32)).astype(x.dtype)


def axial_rope(rows):
    row = jnp.repeat(jnp.arange(rows, dtype=F32), GRID_W)
    col = jnp.tile(jnp.arange(GRID_W, dtype=F32), rows)
    inv = ROPE_THETA ** (-jnp.arange(0, ROPE_HALF, 2, dtype=F32) / ROPE_HALF)
    ang = jnp.concatenate([row[:, None] * inv, col[:, None] * inv], axis=-1)
    return jnp.cos(ang), jnp.sin(ang)


def apply_rope(x, cos, sin):
    shape = (1, x.shape[1]) + (1,) * (x.ndim - 3) + (ROPE_HALF,)
    c, s = cos.reshape(shape), sin.reshape(shape)
    xf = x.astype(F32)
    x1, x2 = xf[..., :ROPE_HALF], xf[..., ROPE_HALF:]
    return jnp.concatenate([x1 * c - x2 * s, x1 * s + x2 * c], axis=-1).astype(x.dtype)


def attn_heads(p):
    B, L = p.shape[:2]
    q = p[..., :ATTN_WIDTH].reshape(B, L, ATTN_KV_HEADS, ATTN_GROUP, HEAD_DIM)
    k = p[..., ATTN_WIDTH:ATTN_WIDTH + KV_WIDTH].reshape(B, L, ATTN_KV_HEADS, HEAD_DIM)
    v = p[..., ATTN_WIDTH + KV_WIDTH:ATTN_IN].reshape(B, L, ATTN_KV_HEADS, HEAD_DIM)
    return q, k, v


def attend(q, k, v):
    s = jnp.einsum('bqkgd,bskd->bkgqs', q, k, preferred_element_type=F32) * ATTN_SCALE
    p = jax.nn.softmax(s, axis=-1).astype(v.dtype)
    return jnp.einsum('bkgqs,bskd->bqkgd', p, v)


def blocked_attention(q, k, v):
    B, L = q.shape[:2]
    qb = q.reshape((B, L // Q_BLOCK, Q_BLOCK) + q.shape[2:]).swapaxes(0, 1)
    ob = lax.map(lambda qq: attend(qq, k, v), qb)
    return ob.swapaxes(0, 1).reshape(q.shape)


def token_shift(p, mu):
    zero = jnp.zeros_like(p[:, :1])
    prev = jnp.concatenate([zero, p[:, :-1]], axis=1)
    nxt = jnp.concatenate([p[:, 1:], zero], axis=1)
    return p + mu * (0.5 * (prev + nxt) - p)


def rwkv_streams(p, lp):
    p = p.astype(F32)
    B, L = p.shape[:2]
    W = RWKV_WIDTH
    heads = lambda t: t.reshape(B, L, RWKV_HEADS, HEAD_DIM)
    r, k, v = p[..., :W], p[..., W:2 * W], p[..., 2 * W:3 * W]
    o = 3 * W
    wd = [p[..., o + d * DECAY_LORA:o + (d + 1) * DECAY_LORA] for d in range(2)]
    o += 2 * DECAY_LORA
    ad = [p[..., o + d * ICLR_LORA:o + (d + 1) * ICLR_LORA] for d in range(2)]
    gd = p[..., o + 2 * ICLR_LORA:]
    kk = heads(k * lp['kk'])
    kk = kk * lax.rsqrt(jnp.sum(kk * kk, axis=-1, keepdims=True) + 1e-12)
    dirs = []
    for d in range(2):
        w_log = -jax.nn.softplus(-(lp['w0'][d] + jnp.tanh(wd[d]) @ lp['w2'][d])) - 0.5
        a = jax.nn.sigmoid(lp['a0'][d] + ad[d] @ lp['a2'][d])
        k_d = k * (1.0 + (a - 1.0) * lp['ka'])
        dirs.append((heads(jnp.exp(-jnp.exp(w_log))), heads(k_d), heads(a)))
    return heads(r), heads(v), kk, gd, dirs


def rwkv_scan(S0, dirn, v, kk, r, reverse):
    decay, k, a = dirn
    xs = (decay, k, v, kk, kk * a) + (() if r is None else (r,))
    xs = tuple(t.swapaxes(0, 1) for t in xs)

    def step(S, inp):
        w_t, k_t, v_t, kk_t, b_t = inp[:5]
        sa = jnp.einsum('bhvk,bhk->bhv', S, kk_t)
        S = S * w_t[:, :, None, :] - sa[..., None] * b_t[:, :, None, :] + v_t[..., None] * k_t[:, :, None, :]
        out = None if r is None else jnp.einsum('bhvk,bhk->bhv', S, inp[5])
        return S, out

    S, o = lax.scan(step, S0, xs, reverse=reverse)
    return S, (None if r is None else o.swapaxes(0, 1))


def rwkv_readout(o_dirs, r, v, dirs, gd, lp):
    o = o_dirs[0] + o_dirs[1]
    B, L = o.shape[:2]
    mu = jnp.mean(o, axis=-1, keepdims=True)
    var = jnp.mean(jnp.square(o - mu), axis=-1, keepdims=True)
    y = (o - mu) * lax.rsqrt(var + GN_EPS)
    k_sum = dirs[0][1] + dirs[1][1]
    bonus = jnp.sum(r * k_sum * lp['rk'].reshape(RWKV_HEADS, HEAD_DIM), axis=-1, keepdims=True) * v
    y = y.reshape(B, L, RWKV_WIDTH) * lp['gn_w'] + lp['gn_b'] + bonus.reshape(B, L, RWKV_WIDTH)
    g = jax.nn.sigmoid(gd) @ lp['g2']
    return y * g


def mixer(h, hc, cos, sin, lp, ctx_out):
    B, L, _ = h.shape
    Lc = hc.shape[1]
    p = h @ lp['w_in']
    pc = hc @ lp['w_in']
    q, k, v = attn_heads(p)
    q = apply_rope(rmsnorm(q, lp['q_gain']), cos, sin)
    k = apply_rope(rmsnorm(k, lp['k_gain']), cos, sin)
    qc, kc, vc = attn_heads(pc)
    kc = rmsnorm(kc, lp['k_gain'])
    k_all = jnp.concatenate([k, kc], axis=1)
    v_all = jnp.concatenate([v, vc], axis=1)
    att = blocked_attention(q, k_all, v_all).reshape(B, L, ATTN_WIDTH)
    r_l, v_l, kk_l, gd_l, dirs_l = rwkv_streams(token_shift(p[..., ATTN_IN:], lp['mu']), lp)
    r_c, v_c, kk_c, gd_c, dirs_c = rwkv_streams(token_shift(pc[..., ATTN_IN:], lp['mu']), lp)
    S0 = jnp.zeros((B, RWKV_HEADS, HEAD_DIM, HEAD_DIM), F32)
    o_l, o_c = [], []
    for d, rev in enumerate((False, True)):
        S_c, oc = rwkv_scan(S0, dirs_c[d], v_c, kk_c, r_c if ctx_out else None, rev)
        _, ol = rwkv_scan(S_c, dirs_l[d], v_l, kk_l, r_l, rev)
        o_l.append(ol)
        o_c.append(oc)
    rw = rwkv_readout(o_l, r_l, v_l, dirs_l, gd_l, lp).astype(h.dtype)
    out = jnp.concatenate([att, rw], axis=-1) @ lp['w_out']
    if not ctx_out:
        return out, None
    att_c = attend(rmsnorm(qc, lp['q_gain']), kc, vc).reshape(B, Lc, ATTN_WIDTH)
    rw_c = rwkv_readout(o_c, r_c, v_c, dirs_c, gd_c, lp).astype(hc.dtype)
    out_c = jnp.concatenate([att_c, rw_c], axis=-1) @ lp['w_out']
    return out, out_c


def swiglu(h, wg, wu, wd):
    return (jax.nn.silu(h @ wg) * (h @ wu)) @ wd


def moe_ffn(h, w_router, wg, wu, wd):
    T, D = h.shape
    logits = (h @ w_router).astype(F32)
    top_val, top_idx = lax.top_k(logits, TOP_K)
    gates = jax.nn.softmax(top_val, axis=-1)
    n_assign = T * TOP_K
    expert = top_idx.reshape(-1)
    token = jnp.repeat(jnp.arange(T, dtype=jnp.int32), TOP_K)
    gate = gates.reshape(-1)
    order = jnp.argsort(expert)
    e_sorted = expert[order]
    counts = jnp.bincount(expert, length=N_EXPERTS)
    padded = (counts + MOE_BLOCK - 1) // MOE_BLOCK * MOE_BLOCK
    pad_end = jnp.cumsum(padded)
    pad_start = pad_end - padded
    grp_start = jnp.cumsum(counts) - counts
    slot = pad_start[e_sorted] + jnp.arange(n_assign) - grp_start[e_sorted]
    nb = (n_assign + N_EXPERTS * (MOE_BLOCK - 1) + MOE_BLOCK - 1) // MOE_BLOCK
    n_slots = nb * MOE_BLOCK
    slot_token = jnp.full((n_slots,), T, jnp.int32).at[slot].set(token[order])
    slot_gate = jnp.zeros((n_slots,), h.dtype).at[slot].set(gate[order].astype(h.dtype))
    block_expert = jnp.minimum(jnp.searchsorted(pad_end, jnp.arange(nb) * MOE_BLOCK, side='right'), N_EXPERTS - 1)
    h_pad = jnp.concatenate([h, jnp.zeros((1, D), h.dtype)], axis=0)
    xb = h_pad[slot_token].reshape(nb, MOE_BLOCK, D)

    def expert_block(args):
        xblk, e = args
        return swiglu(xblk, wg[e], wu[e], wd[e])

    yb = lax.map(expert_block, (xb, block_expert)).reshape(n_slots, D)
    out = jnp.zeros((T + 1, D), h.dtype).at[slot_token].add(yb * slot_gate[:, None])
    return out[:T]


def setup_inputs(seed: int = 0) -> dict:
    key = jax.random.key(seed)
    keys = jax.random.split(key, 40)
    counter = [0]

    def nxt():
        counter[0] += 1
        return keys[counter[0] - 1]

    def nrm(shape, scale):
        return jax.random.normal(nxt(), shape, F32) * scale

    def gain(shape):
        return 1.0 + nrm(shape, 0.02)

    def unif(shape, lo, hi):
        return jax.random.uniform(nxt(), shape, F32, lo, hi)

    D = D_MODEL
    return {
        'x': nrm((BATCH, SEQ, D), 1.0),
        'c': nrm((BATCH, D), 1.0),
        'ctx': nrm((BATCH, CTX_LEN, D), 1.0),
        'c_ctx': nrm((D,), 1.0),
        'ada_w': nrm((DEPTH, D, N_MOD * D), 0.5 * D ** -0.5),
        'ada_b': nrm((DEPTH, N_MOD * D), 0.02),
        'norm1_g': gain((DEPTH, D)),
        'norm2_g': gain((DEPTH, D)),
        'w_in': nrm((DEPTH, D, IN_WIDTH), D ** -0.5),
        'w_out': nrm((DEPTH, MIX_WIDTH, D), MIX_WIDTH ** -0.5),
        'q_gain': gain((DEPTH, HEAD_DIM)),
        'k_gain': gain((DEPTH, HEAD_DIM)),
        'shift_mu': unif((DEPTH, SHIFT_WIDTH), 0.0, 1.0),
        'rw_w0': unif((DEPTH, 2, RWKV_WIDTH), -4.0, 1.0),
        'rw_w2': nrm((DEPTH, 2, DECAY_LORA, RWKV_WIDTH), 0.1),
        'rw_a0': nrm((DEPTH, 2, RWKV_WIDTH), 0.5),
        'rw_a2': nrm((DEPTH, 2, ICLR_LORA, RWKV_WIDTH), ICLR_LORA ** -0.5),
        'rw_g2': nrm((DEPTH, GATE_LORA, RWKV_WIDTH), GATE_LORA ** -0.5),
        'rw_kk': 0.85 + nrm((DEPTH, RWKV_WIDTH), 0.02),
        'rw_ka': gain((DEPTH, RWKV_WIDTH)),
        'rw_rk': nrm((DEPTH, RWKV_WIDTH), 0.1),
        'rw_gn_w': gain((DEPTH, RWKV_WIDTH)),
        'rw_gn_b': nrm((DEPTH, RWKV_WIDTH), 0.02),
        'ffn_wg': nrm((N_DENSE, D, D_FF_DENSE), D ** -0.5),
        'ffn_wu': nrm((N_DENSE, D, D_FF_DENSE), D ** -0.5),
        'ffn_wd': nrm((N_DENSE, D_FF_DENSE, D), D_FF_DENSE ** -0.5),
        'moe_router': nrm((N_MOE, D, N_EXPERTS), D ** -0.5),
        'moe_wg': nrm((N_MOE, N_EXPERTS, D, D_FF_EXPERT), D ** -0.5),
        'moe_wu': nrm((N_MOE, N_EXPERTS, D, D_FF_EXPERT), D ** -0.5),
        'moe_wd': nrm((N_MOE, N_EXPERTS, D_FF_EXPERT, D), D_FF_EXPERT ** -0.5),
    }


def reference(x, c, ctx, c_ctx, ada_w, ada_b, norm1_g, norm2_g, w_in, w_out, q_gain, k_gain, shift_mu,
              rw_w0, rw_w2, rw_a0, rw_a2, rw_g2, rw_kk, rw_ka, rw_rk, rw_gn_w, rw_gn_b,
              ffn_wg, ffn_wu, ffn_wd, moe_router, moe_wg, moe_wu, moe_wd):
    B, L, D = x.shape
    rows = L // GRID_W
    cos, sin = axial_rope(rows)
    silu_c = jax.nn.silu(c)
    silu_cc = jax.nn.silu(c_ctx)
    xc = ctx
    for i in range(DEPTH):
        last = i == DEPTH - 1
        lp = dict(w_in=w_in[i], w_out=w_out[i], q_gain=q_gain[i], k_gain=k_gain[i], mu=shift_mu[i],
                  w0=rw_w0[i], w2=rw_w2[i], a0=rw_a0[i], a2=rw_a2[i], g2=rw_g2[i], kk=rw_kk[i],
                  ka=rw_ka[i], rk=rw_rk[i], gn_w=rw_gn_w[i], gn_b=rw_gn_b[i])
        m = (silu_c @ ada_w[i] + ada_b[i]).reshape(B, N_MOD, 1, D)
        mc = (silu_cc @ ada_w[i] + ada_b[i]).reshape(N_MOD, D)
        h = rmsnorm(x, norm1_g[i]) * (1.0 + m[:, 1]) + m[:, 0]
        hc = rmsnorm(xc, norm1_g[i]) * (1.0 + mc[1]) + mc[0]
        mix, mix_c = mixer(h, hc, cos, sin, lp, not last)
        x = x + m[:, 2] * mix
        h = rmsnorm(x, norm2_g[i]) * (1.0 + m[:, 4]) + m[:, 3]
        tokens = h.reshape(B * L, D)
        if not last:
            xc = xc + mc[2] * mix_c
            hc = rmsnorm(xc, norm2_g[i]) * (1.0 + mc[4]) + mc[3]
            tokens = jnp.concatenate([tokens, hc.reshape(-1, D)], axis=0)
        j = i // 2
        if i % 2 == 0:
            f = swiglu(tokens, ffn_wg[j], ffn_wu[j], ffn_wd[j])
        else:
            f = moe_ffn(tokens, moe_router[j], moe_wg[j], moe_wu[j], moe_wd[j])
        x = x + m[:, 5] * f[:B * L].reshape(B, L, D)
        if not last:
            xc = xc + mc[5] * f[B * L:].reshape(xc.shape)
    return x
```

```cpp
#include <hip/hip_runtime.h>
#include <hip/hip_bf16.h>
#include <cstdio>
#include <cstdint>
#include <cmath>
namespace pg8 {
#define PG8_LAS __attribute__((address_space(3)))
typedef unsigned short bf16_t;
typedef short bf16x8 __attribute__((ext_vector_type(8)));
typedef float f32x4 __attribute__((ext_vector_type(4)));
typedef unsigned u32x4 __attribute__((ext_vector_type(4)));
constexpr int BM = 256, BK = 64, HALF = 128, HTB = HALF * BK * 2  , STAGE_BYTES = 8 * HTB, NXCD = 8, WGM = 8;

__host__ __device__ __forceinline__ int lds_byte(int r, int c) { const int st = (r >> 4) * 2 + (c >> 5), rr = r & 15, cc = c & 31, ob = rr * 64 + cc * 2; return st * 1024 + (ob ^ (((ob >> 9) & 1) << 5)); }
__host__ __device__ __forceinline__ void stage_rc(int b, int& R, int& C) { const int st = b / 1024, sb = b % 1024, swz = sb ^ (((sb >> 9) & 1) << 5); R = (st >> 1) * 16 + swz / 64; C = (st & 1) * 32 + (swz % 64) / 2; }
__host__ __device__ __forceinline__ int perm32(int rho) { const int n = rho >> 4, i = rho & 15; return 8 * (i >> 2) + 4 * n + (i & 3); }
__device__ __forceinline__ unsigned cvt_pk_bf16(float lo, float hi) { unsigned r; asm volatile("v_cvt_pk_bf16_f32 %0, %1, %2" : "=v"(r) : "v"(lo), "v"(hi)); return r; }
typedef float f32x2 __attribute__((ext_vector_type(2)));

struct Unit { int pm, pn, pnb; };
struct Gemm { const bf16_t* A; const bf16_t* Bt; int M, N, K; };

struct Sched {
    int nM, nN, nwg, G, c; const PG8_LAS int* pexp;
    __device__ __forceinline__ void init(int nM_, int nN_, int G_, int c_, const PG8_LAS int* pe) { nM = nM_; nN = nN_; nwg = nM * nN; G = G_; c = c_; pexp = pe; }
    __device__ __forceinline__ bool next(int i, Unit& u) const {
        const long L = (long)i * G + c; if (L >= nwg) return false;
        int wgid = (int)L; { const int q = nwg / NXCD, r = nwg % NXCD, xcd = wgid % NXCD, off = wgid / NXCD; wgid = (xcd < r ? xcd * (q + 1) : r * (q + 1) + (xcd - r) * q) + off; }
        const int nig = WGM * nN, gid = wgid / nig, fm = gid * WGM, gsz = (nM - fm) < WGM ? (nM - fm) : WGM;
        u.pm = fm + ((wgid % nig) % gsz); u.pn = (wgid % nig) / gsz; u.pnb = pexp ? pexp[u.pm] * nN + u.pn : u.pn; return true;
    }
    __device__ __forceinline__ void a_ready(const Unit&) const {}
    __device__ __forceinline__ void done(const Unit&) const {}
};

__device__ __forceinline__ float sigmoid_f(float x) { return __builtin_amdgcn_rcpf(1.0f + __builtin_amdgcn_exp2f(-1.4426950408889634f * x)); }
__device__ __forceinline__ float bf_lo(unsigned w) { return __builtin_bit_cast(float, w << 16); }
__device__ __forceinline__ float bf_hi(unsigned w) { return __builtin_bit_cast(float, w & 0xffff0000u); }

struct EpiBf16 {
    static constexpr bool PERM = true, AFTER_DRAIN = false;
    bf16_t* O; int ldc;
    __device__ __forceinline__ void operator()(const f32x4 (&acc)[2][2][4][2], const Unit& u, int wr, int wc, int fr, int fq) const {
        const int row0 = u.pm * BM + wr * 64 + fr; const int col0 = u.pn * BM + wc * 32 + 8 * fq;
#pragma unroll
        for (int ai = 0; ai < 2; ++ai)
#pragma unroll
            for (int m = 0; m < 4; ++m) { bf16_t* rowp = O + (size_t)(row0 + ai * HALF + m * 16) * ldc + col0;
#pragma unroll
                for (int bj = 0; bj < 2; ++bj) { const f32x4 v0 = acc[ai][bj][m][0], v1 = acc[ai][bj][m][1];
                    u32x4 w; w.x = cvt_pk_bf16(v0[0], v0[1]); w.y = cvt_pk_bf16(v0[2], v0[3]); w.z = cvt_pk_bf16(v1[0], v1[1]); w.w = cvt_pk_bf16(v1[2], v1[3]);
                    *(u32x4*)(rowp + bj * HALF) = w; } }
    }
};
struct EpiSwiGLU {
    static constexpr bool PERM = true, AFTER_DRAIN = false;
    bf16_t* O; int ldc;
    __device__ __forceinline__ void operator()(const f32x4 (&acc)[2][2][4][2], const Unit& u, int wr, int wc, int fr, int fq) const {
        const int row0 = u.pm * BM + wr * 64 + fr; const int col0 = u.pn * HALF + wc * 32 + 8 * fq;
#pragma unroll
        for (int ai = 0; ai < 2; ++ai)
#pragma unroll
            for (int m = 0; m < 4; ++m) { bf16_t* rowp = O + (size_t)(row0 + ai * HALF + m * 16) * ldc + col0;
                float h[8];
#pragma unroll
                for (int n = 0; n < 2; ++n)
#pragma unroll
                    for (int j = 0; j < 4; ++j) { const float g = acc[ai][0][m][n][j], up = acc[ai][1][m][n][j]; h[n * 4 + j] = g * sigmoid_f(g) * up; }
                u32x4 w; w.x = cvt_pk_bf16(h[0], h[1]); w.y = cvt_pk_bf16(h[2], h[3]); w.z = cvt_pk_bf16(h[4], h[5]); w.w = cvt_pk_bf16(h[6], h[7]);
                *(u32x4*)rowp = w; }
    }
};
struct EpiResid {
    static constexpr bool PERM = false, AFTER_DRAIN = false;
    const float* baseL; const float* baseC; float* outL; float* outC; const float* gate;
    __device__ __forceinline__ void operator()(const f32x4 (&acc)[2][2][4][2], const Unit& u, int wr, int wc, int fr, int fq) const {
        const float* base; float* out; int bsel;
        if (u.pm < 128) { base = baseL + (size_t)u.pm * BM * 1024; out = outL + (size_t)u.pm * BM * 1024; bsel = u.pm >> 4; }
        else { base = baseC + (size_t)(u.pm - 128) * BM * 1024; out = outC + (size_t)(u.pm - 128) * BM * 1024; bsel = 8; }
        const float* gv = gate + (size_t)bsel * 6144;
        const int col0 = u.pn * BM + wc * 32 + 4 * fq;
        f32x4 g4[2][2];
#pragma unroll
        for (int bj = 0; bj < 2; ++bj)
#pragma unroll
            for (int n = 0; n < 2; ++n) g4[bj][n] = *(const f32x4*)(gv + col0 + bj * HALF + n * 16);
#pragma unroll
        for (int ai = 0; ai < 2; ++ai)
#pragma unroll
            for (int m = 0; m < 4; ++m) { const size_t off = (size_t)(ai * HALF + wr * 64 + m * 16 + fr) * 1024 + col0;
#pragma unroll
                for (int bj = 0; bj < 2; ++bj)
#pragma unroll
                    for (int n = 0; n < 2; ++n) { const f32x4 xs = *(const f32x4*)(base + off + bj * HALF + n * 16); *(f32x4*)(out + off + bj * HALF + n * 16) = xs + g4[bj][n] * acc[ai][bj][m][n]; } }
    }
};
template <class Epi, class Sched, bool ALIGN_EPI = false, bool SP2 = false>
__device__ __forceinline__ void gemm_phase(PG8_LAS unsigned char* lds, const Gemm g, const Sched& S, const Epi& E) {
    int tid_ = threadIdx.x; asm volatile("" : "+v"(tid_)); const int tid = tid_, wid = __builtin_amdgcn_readfirstlane(tid >> 6), lane = tid & 63, wr = wid >> 2, wc = wid & 3, fr = lane & 15, fq = lane >> 4;
    const int K = g.K, nt = K / BK;
    unsigned voffA[2], voffB[2];
#pragma unroll
    for (int i = 0; i < 2; ++i) { int R, C; stage_rc(tid * 16 + i * 8192, R, C); const int Rb = Epi::PERM ? ((R & ~31) + perm32(R & 31)) : R;
        voffA[i] = (unsigned)(R * K + C) * 2u; voffB[i] = (unsigned)(Rb * K + C) * 2u; }
    const size_t kstep = (size_t)(BK * 2);
    const size_t hstep = (size_t)HALF * K * 2;
    const size_t tstep = 2 * hstep;
    const unsigned ldsw = (unsigned)wid * 1024u;
    const int aoff = lds_byte(wr * 64 + fr, fq * 8), boff = lds_byte(wc * 32 + fr, fq * 8);
#define PG8_SA(b, h) (((b) * 2 + (h)) * HTB)
#define PG8_SB(b, h) ((4 + (b) * 2 + (h)) * HTB)
#define PG8_STAGE(bufoff, gbase, voff) do { _Pragma("unroll") for (int _i = 0; _i < 2; ++_i) \
        __builtin_amdgcn_global_load_lds((const unsigned*)((const char*)(gbase) + (voff)[_i]), (PG8_LAS unsigned*)(lds + (bufoff) + ldsw + _i * 8192), 16, 0, 0); } while (0)
#define PG8_LDA(dst, b, h) do { _Pragma("unroll") for (int m = 0; m < 4; ++m) _Pragma("unroll") for (int k = 0; k < 2; ++k) dst[m][k] = *(const PG8_LAS bf16x8*)(lds + PG8_SA(b, h) + aoff + m * 2048 + k * 1024); } while (0)
#define PG8_LDB(dst, b, h) do { _Pragma("unroll") for (int n = 0; n < 2; ++n) _Pragma("unroll") for (int k = 0; k < 2; ++k) dst[n][k] = *(const PG8_LAS bf16x8*)(lds + PG8_SB(b, h) + boff + n * 2048 + k * 1024); } while (0)
#define PG8_MMA(ai, bj, At, Bt) do { __builtin_amdgcn_s_setprio(1); _Pragma("unroll") for (int m = 0; m < 4; ++m) _Pragma("unroll") for (int n = 0; n < 2; ++n) _Pragma("unroll") for (int k = 0; k < 2; ++k) \
        acc[ai][bj][m][n] = __builtin_amdgcn_mfma_f32_16x16x32_bf16(Bt[n][k], At[m][k], acc[ai][bj][m][n], 0, 0, 0); __builtin_amdgcn_s_setprio(0); } while (0)
#define PG8_WAIT_V(n) asm volatile("s_waitcnt vmcnt(" #n ")" ::: "memory")
#define PG8_WAIT_L(n) asm volatile("s_waitcnt lgkmcnt(" #n ")" ::: "memory")
#define PG8_BAR __builtin_amdgcn_s_barrier()
#define PG8_SCHED __builtin_amdgcn_sched_barrier(0)
    Unit cur, nxt; int ui = 0;
    if (!S.next(0, cur)) return;
    f32x4 acc[2][2][4][2];
#pragma unroll
    for (int a = 0; a < 2; ++a)
#pragma unroll
        for (int b = 0; b < 2; ++b)
#pragma unroll
            for (int m = 0; m < 4; ++m)
#pragma unroll
                for (int n = 0; n < 2; ++n) acc[a][b][m][n] = (f32x4){0.f, 0.f, 0.f, 0.f};
    bf16x8 At[4][2], B0[2][2], B1[2][2];
    const char* cA = (const char*)g.A + (size_t)cur.pm * tstep; const char* cB = (const char*)g.Bt + (size_t)cur.pnb * tstep;
    S.a_ready(cur);
    if constexpr (SP2) {
        PG8_STAGE(PG8_SB(0, 0), cB, voffB); PG8_STAGE(PG8_SB(0, 1), cB + hstep, voffB); PG8_STAGE(PG8_SA(0, 0), cA, voffA); PG8_STAGE(PG8_SA(0, 1), cA + hstep, voffA);
        if (wr == 1) PG8_BAR;
        PG8_WAIT_V(2); PG8_BAR;
        PG8_STAGE(PG8_SB(1, 0), cB + kstep, voffB); PG8_STAGE(PG8_SA(1, 0), cA + kstep, voffA); PG8_STAGE(PG8_SB(1, 1), cB + hstep + kstep, voffB);
        PG8_WAIT_V(6); PG8_BAR;
    } else {
        PG8_STAGE(PG8_SB(0, 0), cB, voffB); PG8_STAGE(PG8_SA(0, 0), cA, voffA); PG8_STAGE(PG8_SB(0, 1), cB + hstep, voffB); PG8_STAGE(PG8_SA(0, 1), cA + hstep, voffA);
        if (wr == 1) PG8_BAR;
        PG8_WAIT_V(4); PG8_BAR;
        PG8_STAGE(PG8_SB(1, 0), cB + kstep, voffB); PG8_STAGE(PG8_SA(1, 0), cA + kstep, voffA); PG8_STAGE(PG8_SB(1, 1), cB + hstep + kstep, voffB);
        PG8_WAIT_V(6); PG8_BAR;
    }
    for (;;) {
        const bool has_next = S.next(ui + 1, nxt);
        const char* nA = has_next ? (const char*)g.A + (size_t)nxt.pm * tstep : cA; const char* nB = has_next ? (const char*)g.Bt + (size_t)nxt.pnb * tstep : cB;
        for (int t = 0; t < nt; t += 2) {
            const bool last = (t == nt - 2);
            const char* a1 = cA + (size_t)(t + 1) * kstep;
            const char* a2 = last ? nA : cA + (size_t)(t + 2) * kstep; const char* b2 = last ? nB : cB + (size_t)(t + 2) * kstep;
            const char* a3 = a2 + kstep; const char* b3 = b2 + kstep;
            if (last && has_next) S.a_ready(nxt);
            if constexpr (SP2) {
            PG8_LDB(B0, 0, 0); PG8_LDB(B1, 0, 1); PG8_SCHED; PG8_LDA(At, 0, 0); PG8_STAGE(PG8_SA(1, 1), a1 + hstep, voffA);
            PG8_WAIT_V(8); PG8_WAIT_L(0); PG8_BAR; PG8_MMA(0, 0, At, B0); PG8_MMA(0, 1, At, B1); PG8_BAR; PG8_SCHED;
            PG8_LDA(At, 0, 1); PG8_STAGE(PG8_SB(0, 0), b2, voffB); PG8_STAGE(PG8_SB(0, 1), b2 + hstep, voffB); PG8_STAGE(PG8_SA(0, 0), a2, voffA);
            PG8_WAIT_V(8); PG8_WAIT_L(0); PG8_BAR; PG8_MMA(1, 0, At, B0); PG8_MMA(1, 1, At, B1); PG8_BAR; PG8_SCHED;
            PG8_LDB(B0, 1, 0); PG8_LDB(B1, 1, 1); PG8_SCHED; PG8_LDA(At, 1, 0); PG8_STAGE(PG8_SA(0, 1), a2 + hstep, voffA);
            PG8_WAIT_V(8); PG8_WAIT_L(0); PG8_BAR; PG8_MMA(0, 0, At, B0); PG8_MMA(0, 1, At, B1); PG8_BAR; PG8_SCHED;
            PG8_LDA(At, 1, 1); PG8_STAGE(PG8_SB(1, 0), b3, voffB); PG8_STAGE(PG8_SB(1, 1), b3 + hstep, voffB); PG8_STAGE(PG8_SA(1, 0), a3, voffA);
            PG8_WAIT_V(8); PG8_WAIT_L(0); PG8_BAR; PG8_MMA(1, 0, At, B0); PG8_MMA(1, 1, At, B1); PG8_BAR; PG8_SCHED;
            } else {
            PG8_LDB(B0, 0, 0); PG8_SCHED; PG8_LDA(At, 0, 0); PG8_STAGE(PG8_SA(1, 1), a1 + hstep, voffA);
            PG8_WAIT_L(8); PG8_BAR; PG8_WAIT_L(0); PG8_MMA(0, 0, At, B0); PG8_BAR; PG8_SCHED;
            PG8_LDB(B1, 0, 1); PG8_STAGE(PG8_SB(0, 0), b2, voffB);
            PG8_BAR; PG8_WAIT_L(0); PG8_MMA(0, 1, At, B1); PG8_BAR;
            PG8_LDA(At, 0, 1); PG8_STAGE(PG8_SA(0, 0), a2, voffA);
            PG8_BAR; PG8_WAIT_L(0); PG8_MMA(1, 0, At, B0); PG8_BAR; PG8_SCHED;
            PG8_STAGE(PG8_SB(0, 1), b2 + hstep, voffB);
            PG8_WAIT_V(6); PG8_BAR; PG8_MMA(1, 1, At, B1); PG8_BAR;
            PG8_LDB(B0, 1, 0); PG8_SCHED; PG8_LDA(At, 1, 0); PG8_STAGE(PG8_SA(0, 1), a2 + hstep, voffA);
            PG8_WAIT_L(8); PG8_BAR; PG8_WAIT_L(0); PG8_MMA(0, 0, At, B0); PG8_BAR; PG8_SCHED;
            PG8_LDB(B1, 1, 1); PG8_STAGE(PG8_SB(1, 0), b3, voffB);
            PG8_BAR; PG8_WAIT_L(0); PG8_MMA(0, 1, At, B1); PG8_BAR;
            PG8_LDA(At, 1, 1); PG8_STAGE(PG8_SA(1, 0), a3, voffA);
            PG8_BAR; PG8_WAIT_L(0); PG8_MMA(1, 0, At, B0); PG8_BAR; PG8_SCHED;
            PG8_STAGE(PG8_SB(1, 1), b3 + hstep, voffB);
            PG8_WAIT_V(6); PG8_BAR; PG8_MMA(1, 1, At, B1); PG8_BAR;
            }
        }
        if constexpr (ALIGN_EPI) { if (wr == 0) PG8_BAR; }
        if constexpr (!Epi::AFTER_DRAIN) { E(acc, cur, wr, wc, fr, fq); S.done(cur); }
        if (!has_next) break;
#pragma unroll
        for (int a = 0; a < 2; ++a)
#pragma unroll
            for (int b = 0; b < 2; ++b)
#pragma unroll
                for (int m = 0; m < 4; ++m)
#pragma unroll
                    for (int n = 0; n < 2; ++n) acc[a][b][m][n] = (f32x4){0.f, 0.f, 0.f, 0.f};
        cur = nxt; cA = nA; cB = nB; ++ui;
        if constexpr (ALIGN_EPI) { if (wr == 1) PG8_BAR; }
    }
    PG8_WAIT_V(0);
    if constexpr (!ALIGN_EPI) { if (wr == 0) PG8_BAR; }
    PG8_BAR;
    if constexpr (Epi::AFTER_DRAIN) { E.fused(acc, cur, wr, wc, fr, fq, lds, wid, lane); S.done(cur); }
#undef PG8_SA
#undef PG8_SB
#undef PG8_STAGE
#undef PG8_LDA
#undef PG8_LDB
#undef PG8_MMA
#undef PG8_WAIT_V
#undef PG8_WAIT_L
#undef PG8_BAR
#undef PG8_SCHED
}
}
#include <hip/hip_bf16.h>
#include <cmath>
namespace attn_body {
using bf16=__hip_bfloat16;
using bf16x8=__attribute__((ext_vector_type(8)))short;
using s16x4=__attribute__((ext_vector_type(4)))short;
using f32x16=__attribute__((ext_vector_type(16)))float;
using u32x4=__attribute__((ext_vector_type(4)))unsigned;
constexpr int D=64,DM=1024,KP=128;
constexpr int NW=8,QBLK=32,QB=QBLK*NW,KVBLK=64;
constexpr int ATTN_PITCH=DM, ATTN_UNIT_ROWS=QB;
__device__ __forceinline__ int crow(int r,int hi){return (r&3)+8*(r>>2)+4*hi;}
#define SBAR() __builtin_amdgcn_sched_barrier(0)
__device__ __forceinline__ void cmask(f32x16&p0,f32x16&p1,int jb,int qrel,int hi){
  const float NEG=-INFINITY; int kb=64*jb+4*hi;
  #pragma unroll
  for(int r=0;r<16;++r){int kv=kb+(r&3)+8*(r>>2); if(kv>qrel)p0[r]=NEG; if(kv+32>qrel)p1[r]=NEG;}
}

constexpr int NSLOT=3, SLOTB=8192;
constexpr int LDS_K=0, LDS_V=NSLOT*SLOTB, LDS_WS=2*NSLOT*SLOTB, LDS_OST=LDS_WS+NW*64*4, LDS_BYTES=LDS_OST+NW*4096;
constexpr float C2=0.125f*1.4426950408889634f;
__device__ __forceinline__ void glds16(const void*gsrc,unsigned lds_dst){unsigned keep;
  asm volatile("s_mov_b32 %0, m0\n\ts_mov_b32 m0, %2\n\ts_nop 0\n\tglobal_load_lds_dwordx4 %1, off\n\ts_mov_b32 m0, %0":"=&s"(keep):"v"(gsrc),"s"(lds_dst):"memory");}
__device__ __forceinline__ float max3f(float a,float b,float c){float r;asm("v_max3_f32 %0, %1, %2, %3":"=v"(r):"v"(a),"v"(b),"v"(c));return r;}
__device__ __forceinline__ float max2f(float a,float b){float r;asm("v_max_f32_e32 %0, %1, %2":"=v"(r):"v"(a),"v"(b));return r;}
__device__ __forceinline__ float fadd_s(float a,float b){float r;asm("v_add_f32_e32 %0, %1, %2":"=v"(r):"v"(a),"v"(b));return r;}
__device__ __forceinline__ float fsub_s(float a,float b){float r;asm("v_sub_f32_e32 %0, %1, %2":"=v"(r):"v"(a),"v"(b));return r;}
typedef float f32x2_t __attribute__((ext_vector_type(2))); typedef __bf16 bf16x2_t __attribute__((ext_vector_type(2)));
__device__ __forceinline__ unsigned cvtpk_s(float lo,float hi){f32x2_t v={lo,hi};bf16x2_t b=__builtin_convertvector(v,bf16x2_t);return __builtin_bit_cast(unsigned,b);}
#define WAIT_BAR(N) asm volatile("s_waitcnt vmcnt(" #N ") lgkmcnt(0)\n\ts_barrier":::"memory")

__device__ __forceinline__ void qkt(f32x16&p0,f32x16&p1,const char*Kslot,const bf16x8*qr,const f32x16&negm,int r32,int hi){
  const char*kb=Kslot+hi*1024+r32*16;
  #pragma unroll
  for(int d0=0;d0<4;++d0){
    const bf16x8 b0=*reinterpret_cast<const bf16x8*>(kb+d0*2048);
    const bf16x8 b1=*reinterpret_cast<const bf16x8*>(kb+d0*2048+512);
    if(d0==0){p0=__builtin_amdgcn_mfma_f32_32x32x16_bf16(b0,qr[0],negm,0,0,0);p1=__builtin_amdgcn_mfma_f32_32x32x16_bf16(b1,qr[0],negm,0,0,0);}
    else{p0=__builtin_amdgcn_mfma_f32_32x32x16_bf16(b0,qr[d0],p0,0,0,0);p1=__builtin_amdgcn_mfma_f32_32x32x16_bf16(b1,qr[d0],p1,0,0,0);}}
}
typedef __attribute__((address_space(3))) const char* lds_cptr;
typedef short v4i16_t __attribute__((ext_vector_type(4)));
__device__ __forceinline__ void kload8(bf16x8*kf,lds_cptr kp){
  kf[0]=*(const __attribute__((address_space(3))) bf16x8*)(kp);      kf[1]=*(const __attribute__((address_space(3))) bf16x8*)(kp+512);
  kf[2]=*(const __attribute__((address_space(3))) bf16x8*)(kp+2048); kf[3]=*(const __attribute__((address_space(3))) bf16x8*)(kp+2560);
  kf[4]=*(const __attribute__((address_space(3))) bf16x8*)(kp+4096); kf[5]=*(const __attribute__((address_space(3))) bf16x8*)(kp+4608);
  kf[6]=*(const __attribute__((address_space(3))) bf16x8*)(kp+6144); kf[7]=*(const __attribute__((address_space(3))) bf16x8*)(kp+6656);
}
__device__ __forceinline__ void kload2(bf16x8*kf,lds_cptr kp,int j){ kf[2*j]=*(const __attribute__((address_space(3))) bf16x8*)(kp+j*2048); kf[2*j+1]=*(const __attribute__((address_space(3))) bf16x8*)(kp+j*2048+512); }
__device__ __forceinline__ s16x4 vtr(lds_cptr p){ return __builtin_bit_cast(s16x4,__builtin_amdgcn_ds_read_tr16_b64_v4i16((__attribute__((address_space(3))) v4i16_t*)p)); }
__device__ __forceinline__ float rowmax(const f32x16&p0,const f32x16&p1){
  float a=max3f(p0[0],p0[1],p1[0]),b=max3f(p0[2],p0[3],p1[1]);a=max3f(a,p1[2],p1[3]);
  #pragma unroll
  for(int r=4;r<16;r+=4){a=max3f(a,p0[r],p0[r+1]);b=max3f(b,p0[r+2],p0[r+3]);a=max3f(a,p1[r],p1[r+1]);b=max3f(b,p1[r+2],p1[r+3]);}
  const float m=max2f(a,b);
  auto rr=__builtin_amdgcn_permlane32_swap(__float_as_uint(m),__float_as_uint(m),false,false);
  return max2f(__uint_as_float(rr[0]),__uint_as_float(rr[1]));
}
__device__ __forceinline__ void pv(f32x16*o,int vb,bf16x8 pa0,bf16x8 pa1,bf16x8 pa2,bf16x8 pa3){
  #pragma unroll
  for(int d0=0;d0<2;++d0){s16x4 lo[4],hi[4];
    #pragma unroll
    for(int ks=0;ks<4;++ks){
      asm volatile("ds_read_b64_tr_b16 %0,%1 offset:%c2":"=&v"(lo[ks]):"v"(vb),"i"(d0*4096+ks*1024):"memory");
      asm volatile("ds_read_b64_tr_b16 %0,%1 offset:%c2":"=&v"(hi[ks]):"v"(vb),"i"(d0*4096+ks*1024+512):"memory");}
    asm volatile("s_waitcnt lgkmcnt(0)":::"memory");SBAR();
    #define PK(k) (bf16x8){lo[k][0],lo[k][1],lo[k][2],lo[k][3],hi[k][0],hi[k][1],hi[k][2],hi[k][3]}
    o[d0]=__builtin_amdgcn_mfma_f32_32x32x16_bf16(pa0,PK(0),o[d0],0,0,0);
    o[d0]=__builtin_amdgcn_mfma_f32_32x32x16_bf16(pa1,PK(1),o[d0],0,0,0);
    o[d0]=__builtin_amdgcn_mfma_f32_32x32x16_bf16(pa2,PK(2),o[d0],0,0,0);
    o[d0]=__builtin_amdgcn_mfma_f32_32x32x16_bf16(pa3,PK(3),o[d0],0,0,0);
    #undef PK
  }
}

#ifndef ATTN_STORE16
#define ATTN_STORE16(p,v) (*(u32x4*)(p)=(v))
#endif
template<int THRL> __device__ __forceinline__ void attn_unit(long qrow0,int hcol,long kvrow0,int kvcol,int NT,const bf16*Q,const bf16*__restrict__ K,const bf16*__restrict__ V,bf16*O,char*shm){
  int tid_=threadIdx.x; asm volatile("":"+v"(tid_)); const int tid=tid_,lane=tid&63,r32=lane&31,hi=lane>>5; const int wid=__builtin_amdgcn_readfirstlane(tid>>6);
  const bf16*Qw=Q+(qrow0+wid*QBLK)*DM+hcol;
  const bf16*Kh=K+kvrow0*KP+kvcol,*Vh=V+kvrow0*KP+kvcol;
  const unsigned lds0=(unsigned)(uintptr_t)shm;
  float*wsf=(float*)(shm+LDS_WS)+wid*64;
  const bf16*ksrc=Kh+(long)lane*KP+wid*8;
  const bf16*vsrc=Vh+(long)(16*(wid&3)+(lane>>2))*KP+(wid>>2)*32+(lane&3)*8;
  const unsigned kdst=lds0+LDS_K+wid*1024, vdst=lds0+LDS_V+wid*1024;
  #define DMA_K(t,slot) glds16(ksrc+(long)(t)*KVBLK*KP,(unsigned)__builtin_amdgcn_readfirstlane(kdst+(slot)))
  #define DMA_V(t,slot) glds16(vsrc+(long)(t)*KVBLK*KP,(unsigned)__builtin_amdgcn_readfirstlane(vdst+(slot)))
  const int vb0=(int)(lds0+LDS_V)+((lane>>4)&1)*32+(lane&3)*8+(4*hi+((lane&15)>>2))*64;
  const char*Kbase=shm+LDS_K; bf16x8 kf[8];
  const lds_cptr shm3=(lds_cptr)shm; const lds_cptr kp0=shm3+LDS_K+hi*1024+r32*16; const lds_cptr vp0=shm3+LDS_V+((lane>>4)&1)*32+(lane&3)*8+(4*hi+((lane&15)>>2))*64;
  DMA_K(0,0);DMA_V(0,0);DMA_K(1,SLOTB);
  bf16x8 qr[4];
  #pragma unroll
  for(int d0=0;d0<4;++d0)qr[d0]=*reinterpret_cast<const bf16x8*>(&Qw[(long)r32*DM+d0*16+hi*8]);
  float mhat=0.f,l_reg=0.f;f32x16 o[2];o[0]=f32x16{};o[1]=f32x16{};f32x16 negm=f32x16{};asm volatile("":"+v"(negm));
  #define CMASK(P0,P1,t) do{}while(0)
  bool resc=false;
  #define START(P0,P1) do{ const float rm=rowmax(P0,P1); resc=false; \
    { const float dl=rm; mhat=fadd_s(mhat,dl); \
      _Pragma("unroll") for(int r=0;r<16;++r){P0[r]=fsub_s(P0[r],dl);P1[r]=fsub_s(P1[r],dl);} \
      _Pragma("unroll") for(int r=0;r<16;++r)negm[r]=-mhat; asm volatile("":"+v"(negm)); } \
    _Pragma("unroll") for(int r=0;r<16;++r)P0[r]=__builtin_amdgcn_exp2f(P0[r]); }while(0)
  #define RESC() do{ if(resc){ asm volatile("s_waitcnt lgkmcnt(0)":::"memory"); \
      _Pragma("unroll") for(int d_=0;d_<2;++d_) _Pragma("unroll") for(int r=0;r<16;++r)o[d_][r]*=wsf[crow(r,hi)]; } }while(0)
  f32x16 pA0,pA1,pB0,pB1;
  int sl_prev=0,sl_cur=0,sl_next=SLOTB;
  #define ROT() do{sl_prev=sl_cur;sl_cur=sl_next;sl_next=(sl_next==(NSLOT-1)*SLOTB)?0:sl_next+SLOTB;}while(0)
  DMA_K(2,2*SLOTB);
  WAIT_BAR(3);
  qkt(pA0,pA1,Kbase,qr,negm,r32,hi);asm volatile("s_nop 15\n\ts_nop 7":"+v"(pA0),"+v"(pA1));CMASK(pA0,pA1,0);
  START(pA0,pA1);
  _Pragma("unroll") for(int r=0;r<16;++r)pA1[r]=__builtin_amdgcn_exp2f(pA1[r]);
  WAIT_BAR(0);
  DMA_K(3,0);DMA_V(1,SLOTB);
  ROT();
  kload8(kf,kp0+sl_cur);
  WAIT_BAR(2);
  s16x4 vlo[8],vhi[8]; u32x4 pw0,pw1,pw2,pw3;
  #define PKW(P,B) cvtpk_s(P[B],P[B+1])
  #define PAF(k) __builtin_bit_cast(bf16x8,pw##k)
  #define VFR(i) (bf16x8){vlo[i][0],vlo[i][1],vlo[i][2],vlo[i][3],vhi[i][0],vhi[i][1],vhi[i][2],vhi[i][3]}
  #define PIN(x) asm volatile("":"+v"(x))
  #define MX3(a,b,c) __builtin_fmaxf(__builtin_fmaxf((a),(b)),(c))
  #define GAPA(MF,A0,A1,A2,A3,W0,W1,PW) do{ MF; sacc+=A0; sacc+=A1; sacc+=A2; sacc+=A3; PIN(sacc); W0; W1; PIN(PW); SBAR(); }while(0)
  #define EX(v) __builtin_amdgcn_exp2f(v)
  #define GAPB(MF,X,B) do{ MF; X[B]=EX(X[B]); X[B+1]=EX(X[B+1]); X[B+2]=EX(X[B+2]); X[B+3]=EX(X[B+3]); PIN(X); SBAR(); }while(0)
  #define VRD(i) do{ vlo[i]=vtr(vp_+(((i)>>2)*4096+((i)&3)*1024)); vhi[i]=vtr(vp_+(((i)>>2)*4096+((i)&3)*1024+512)); }while(0)
  #define KRD(G,j) do{ if(G){ kload2(kf,kp0+sl_next,j); SBAR(); } }while(0)
  #define STEP(C0,C1,P0,P1,t,GK,GV,GL) do{ SBAR(); \
    const lds_cptr vp_=vp0+sl_prev; \
    VRD(0); SBAR(); float sacc=(P0[0]+P0[1]); \
    GAPA(C0=__builtin_amdgcn_mfma_f32_32x32x16_bf16(kf[0],qr[0],negm,0,0,0), P0[2],P0[3],P0[4],P0[5],     pw0[0]=PKW(P0,0), pw0[1]=PKW(P0,2), pw0); \
    VRD(4); SBAR(); GAPA(C1=__builtin_amdgcn_mfma_f32_32x32x16_bf16(kf[1],qr[0],negm,0,0,0), P0[6],P0[7],P0[8],P0[9],     pw0[2]=PKW(P0,4), pw0[3]=PKW(P0,6), pw0); \
    VRD(1); SBAR(); GAPA(C0=__builtin_amdgcn_mfma_f32_32x32x16_bf16(kf[2],qr[1],C0,0,0,0),   P0[10],P0[11],P0[12],P0[13], pw1[0]=PKW(P0,8), pw1[1]=PKW(P0,10), pw1); \
    VRD(5); SBAR(); GAPA(C1=__builtin_amdgcn_mfma_f32_32x32x16_bf16(kf[3],qr[1],C1,0,0,0),   P0[14],P0[15],P1[0],P1[1],   pw1[2]=PKW(P0,12),pw1[3]=PKW(P0,14), pw1); \
    VRD(2); SBAR(); GAPA(C0=__builtin_amdgcn_mfma_f32_32x32x16_bf16(kf[4],qr[2],C0,0,0,0),   P1[2],P1[3],P1[4],P1[5],     pw2[0]=PKW(P1,0), pw2[1]=PKW(P1,2), pw2); \
    VRD(6); SBAR(); GAPA(C1=__builtin_amdgcn_mfma_f32_32x32x16_bf16(kf[5],qr[2],C1,0,0,0),   P1[6],P1[7],P1[8],P1[9],     pw2[2]=PKW(P1,4), pw2[3]=PKW(P1,6), pw2); \
    VRD(3); SBAR(); GAPA(C0=__builtin_amdgcn_mfma_f32_32x32x16_bf16(kf[6],qr[3],C0,0,0,0),   P1[10],P1[11],P1[12],P1[13], pw3[0]=PKW(P1,8), pw3[1]=PKW(P1,10), pw3); \
    VRD(7); SBAR(); GAPA(C1=__builtin_amdgcn_mfma_f32_32x32x16_bf16(kf[7],qr[3],C1,0,0,0),   P1[14],P1[15],0.f,0.f,       pw3[2]=PKW(P1,12),pw3[3]=PKW(P1,14), pw3); \
    l_reg+=sacc; \
    if(GK){DMA_K((t)+3,sl_cur);} if(GV){DMA_V((t)+1,sl_next);} \
    CMASK(C0,C1,t); \
    { float a=MX3(C0[0],C0[1],C1[0]),b=MX3(C0[2],C0[3],C1[1]); a=MX3(a,C1[2],C1[3]); \
      _Pragma("unroll") for(int r=4;r<16;r+=4){a=MX3(a,C0[r],C0[r+1]);b=MX3(b,C0[r+2],C0[r+3]);a=MX3(a,C1[r],C1[r+1]);b=MX3(b,C1[r+2],C1[r+3]);} \
      float rm=__builtin_fmaxf(a,b); { auto rr=__builtin_amdgcn_permlane32_swap(__float_as_uint(rm),__float_as_uint(rm),false,false); rm=__builtin_fmaxf(__uint_as_float(rr[0]),__uint_as_float(rr[1])); } \
      resc=false; \
      if(__builtin_expect(__any(rm>(float)THRL),0)){ const float dl=__builtin_fmaxf(rm,0.f); mhat+=dl; \
        _Pragma("unroll") for(int r=0;r<16;++r){C0[r]-=dl;C1[r]-=dl;} \
        _Pragma("unroll") for(int r=0;r<16;++r)negm[r]=-mhat; asm volatile("":"+v"(negm)); \
        const float f=__builtin_amdgcn_exp2f(-dl); l_reg*=f; if(hi==0)wsf[r32]=f; resc=true; } } \
    SBAR(); \
    GAPB(o[0]=__builtin_amdgcn_mfma_f32_32x32x16_bf16(PAF(0),VFR(0),o[0],0,0,0), C0,0); \
    GAPB(o[1]=__builtin_amdgcn_mfma_f32_32x32x16_bf16(PAF(0),VFR(4),o[1],0,0,0), C0,4); \
    KRD(GL,0); GAPB(o[0]=__builtin_amdgcn_mfma_f32_32x32x16_bf16(PAF(1),VFR(1),o[0],0,0,0), C0,8); \
    KRD(GL,1); GAPB(o[1]=__builtin_amdgcn_mfma_f32_32x32x16_bf16(PAF(1),VFR(5),o[1],0,0,0), C0,12); \
    KRD(GL,2); GAPB(o[0]=__builtin_amdgcn_mfma_f32_32x32x16_bf16(PAF(2),VFR(2),o[0],0,0,0), C1,0); \
    KRD(GL,3); GAPB(o[1]=__builtin_amdgcn_mfma_f32_32x32x16_bf16(PAF(2),VFR(6),o[1],0,0,0), C1,4); \
    GAPB(o[0]=__builtin_amdgcn_mfma_f32_32x32x16_bf16(PAF(3),VFR(3),o[0],0,0,0), C1,8); \
    GAPB(o[1]=__builtin_amdgcn_mfma_f32_32x32x16_bf16(PAF(3),VFR(7),o[1],0,0,0), C1,12); \
    }while(0)
  int t=1;
  #undef CMASK
  #define CMASK(P0,P1,t) do{}while(0)
  for(;t+5<NT;t+=2){
    STEP(pB0,pB1,pA0,pA1,t,true,true,true);     WAIT_BAR(2); RESC(); ROT();
    STEP(pA0,pA1,pB0,pB1,t+1,true,true,true);   WAIT_BAR(2); RESC(); ROT();
  }
  #undef CMASK
  #define CMASK(P0,P1,t) do{}while(0)
  #define ENDW(tt) do{ if((tt)+3<NT){WAIT_BAR(2);} else if((tt)+2<NT){WAIT_BAR(1);} else {WAIT_BAR(0);} }while(0)
  for(;t+1<NT;t+=2){
    STEP(pB0,pB1,pA0,pA1,t,(t+3<NT),(t+1<NT),(t+1<NT));       ENDW(t);   RESC(); ROT();
    STEP(pA0,pA1,pB0,pB1,t+1,(t+4<NT),(t+2<NT),(t+2<NT));     ENDW(t+1); RESC(); ROT();
  }
  STEP(pB0,pB1,pA0,pA1,NT-1,false,false,false); RESC();
  { float sacc=pB0[0]+pB0[1]; _Pragma("unroll") for(int r=2;r<16;++r)sacc+=pB0[r]; _Pragma("unroll") for(int r=0;r<16;++r)sacc+=pB1[r]; l_reg+=sacc;
    pw0=(u32x4){PKW(pB0,0),PKW(pB0,2),PKW(pB0,4),PKW(pB0,6)};pw1=(u32x4){PKW(pB0,8),PKW(pB0,10),PKW(pB0,12),PKW(pB0,14)};pw2=(u32x4){PKW(pB1,0),PKW(pB1,2),PKW(pB1,4),PKW(pB1,6)};pw3=(u32x4){PKW(pB1,8),PKW(pB1,10),PKW(pB1,12),PKW(pB1,14)};
    SBAR(); pv(o,vb0+sl_cur,PAF(0),PAF(1),PAF(2),PAF(3)); }
  #undef PKW
  #undef PAF
  #undef VFR
  #undef PIN
  #undef MX3
  #undef GAPA
  #undef GAPB
  #undef EX
  #undef VRD
  #undef KRD
  #undef STEP
  #undef ENDW
  {auto rr=__builtin_amdgcn_permlane32_swap(__float_as_uint(l_reg),__float_as_uint(l_reg),false,false);l_reg=__uint_as_float(rr[0])+__uint_as_float(rr[1]);}
  if(hi==0)wsf[32+r32]=l_reg;asm volatile("s_waitcnt lgkmcnt(0)":::"memory");
  float rli[16];
  #pragma unroll
  for(int r=0;r<16;++r)rli[r]=__builtin_amdgcn_rcpf(wsf[32+crow(r,hi)]);
  bf16*Ow=O+(qrow0+wid*QBLK)*DM+hcol;
  { bf16*stg=(bf16*)(shm+LDS_OST)+wid*2048;
    #pragma unroll
    for(int r=0;r<16;++r){const int orow=crow(r,hi);
      #pragma unroll
      for(int d0=0;d0<2;++d0)stg[orow*64+d0*32+r32]=__float2bfloat16(o[d0][r]*rli[r]);}
    asm volatile("s_waitcnt lgkmcnt(0)":::"memory");
    #pragma unroll
    for(int i=0;i<4;++i){const int row=i*8+(lane>>3),ch=lane&7; const u32x4 v=*(const u32x4*)(stg+row*64+ch*8); ATTN_STORE16(Ow+(long)row*DM+ch*8,v);} }
  asm volatile("s_waitcnt lgkmcnt(0)\n\ts_barrier":::"memory");
  #undef DMA_K
  #undef DMA_V
  #undef CMASK
  #undef START
  #undef RESC
  #undef ROT
}
constexpr int ATTN_LDS_BYTES=LDS_BYTES;
#undef SBAR
#undef WAIT_BAR
}
#define GAS __attribute__((address_space(1)))
#define LAS __attribute__((address_space(3)))
typedef unsigned short bf16;
typedef unsigned v4u __attribute__((ext_vector_type(4)));
typedef float f32x4 __attribute__((ext_vector_type(4)));
typedef short bf16x8 __attribute__((ext_vector_type(8)));
typedef GAS unsigned gu32;
typedef GAS unsigned long long gu64;
#define RLX_AGENT __ATOMIC_RELAXED, __HIP_MEMORY_SCOPE_AGENT
#define LDS_WAIT() asm volatile("s_waitcnt lgkmcnt(0)" ::: "memory")
#define VM_WAIT() asm volatile("s_waitcnt vmcnt(0)" ::: "memory")
__device__ __forceinline__ unsigned long long rt() { return __builtin_amdgcn_s_memrealtime(); }
__device__ __forceinline__ unsigned f2bf(float f) { unsigned u = __builtin_bit_cast(unsigned, f); return (u + 0x7fffu + ((u >> 16) & 1u)) >> 16; }
__device__ __forceinline__ unsigned pk2(float lo, float hi) { return f2bf(lo) | (f2bf(hi) << 16); }

#define XB_TMO      128
#define XB_XCNT(j)  (256  + 64 * (j))
#define XB_XSUB(j)  (1280 + 64 * (j))
#define XB_XGEN(j)  (2304 + 64 * (j))
#define XB_TOP      3328
#define XB_TOPGEN   3392
#define XCD_BAR_WORDS 3456
#define XB_SPIN_CAP (1u << 18)

__device__ __forceinline__ unsigned xb_ld(unsigned* p)              { return __hip_atomic_load(p, __ATOMIC_RELAXED, __HIP_MEMORY_SCOPE_AGENT); }
__device__ __forceinline__ unsigned xb_add(unsigned* p, unsigned v) { return __hip_atomic_fetch_add(p, v, __ATOMIC_RELAXED, __HIP_MEMORY_SCOPE_AGENT); }
__device__ __forceinline__ unsigned xb_xcc_id() { return (unsigned)__builtin_amdgcn_s_getreg((3 << 11) | 20) & 0xFu; }
#define XB_SPIN(cond, bar) do { unsigned _sp = 0; while (cond) { __builtin_amdgcn_s_sleep(1); \
    if ((++_sp & 255u) == 0u) { if (xb_ld(&(bar)[XB_TMO])) break; if (_sp > XB_SPIN_CAP) { atomicAdd(&(bar)[XB_TMO], 1u); break; } } } } while (0)

struct XcdBarrier {
    unsigned* bar; unsigned x;
    volatile LAS unsigned* st;
};

__device__ __forceinline__ XcdBarrier xcd_barrier_post(unsigned* bar, volatile LAS unsigned* st) {
    XcdBarrier b; b.bar = bar; b.x = xb_xcc_id(); b.st = st;
    if (threadIdx.x == 0) (void)xb_add(&bar[XB_XCNT(b.x)], 1u);
    return b;
}
__device__ __forceinline__ void xcd_barrier_complete(unsigned* bar, unsigned x, unsigned& nloc, unsigned& nx) {
    const unsigned G = gridDim.x * gridDim.y * gridDim.z;
    unsigned sum, cnt, mine, sp = 0u;
    for (;;) {
        sum = 0u; cnt = 0u; mine = 0u;
#pragma unroll
        for (unsigned j = 0; j < 16; ++j) { const unsigned c = xb_ld(&bar[XB_XCNT(j)]); sum += c; cnt += (c > 0u) ? 1u : 0u; mine = (j == x) ? c : mine; }
        if (sum == G) break;
        __builtin_amdgcn_s_sleep(1);
        if ((++sp & 255u) == 0u) { if (xb_ld(&bar[XB_TMO])) break; if (sp > XB_SPIN_CAP) { atomicAdd(&bar[XB_TMO], 1u); break; } }
    }
    nloc = mine > 0u ? mine : 1u; nx = cnt > 0u ? cnt : 1u;
}

__device__ __forceinline__ void xcd_barrier(const XcdBarrier& b) {
    asm volatile("s_waitcnt vmcnt(0)" ::: "memory");
    __syncthreads();
    if (threadIdx.x == 0) {
        unsigned* bar = b.bar;
        __builtin_amdgcn_s_waitcnt(0);
        unsigned nloc = b.st[0], nx = b.st[1];
        if (nloc == 0u) { xcd_barrier_complete(bar, b.x, nloc, nx); b.st[0] = nloc; b.st[1] = nx; }
        const unsigned old = xb_add(&bar[XB_XSUB(b.x)], 1u);
        const unsigned gen = old / nloc;
        if (old + 1u == (gen + 1u) * nloc) {
            __builtin_amdgcn_fence(__ATOMIC_RELEASE, "agent");
            asm volatile("s_waitcnt vmcnt(0)" ::: "memory");
            const unsigned og = xb_add(&bar[XB_TOP], 1u);
            const unsigned tg = og / nx;
            if (og + 1u == (tg + 1u) * nx) xb_add(&bar[XB_TOPGEN], 1u);
            else XB_SPIN(xb_ld(&bar[XB_TOPGEN]) == tg, bar);
            __builtin_amdgcn_fence(__ATOMIC_ACQUIRE, "agent");
            xb_add(&bar[XB_XGEN(b.x)], 1u);
            asm volatile("s_waitcnt vmcnt(0)" ::: "memory");
        } else {
            XB_SPIN(xb_ld(&bar[XB_XGEN(b.x)]) == gen, bar);
            __builtin_amdgcn_fence(__ATOMIC_ACQUIRE, "agent");
            asm volatile("s_waitcnt vmcnt(0)" ::: "memory");
        }
    }
    __syncthreads();
}

constexpr int NWAVES = 8;
constexpr int DMODEL = 1024, NBATCH = 8, SEQL = 4096, CTXL = 256, DEPTH = 4;
constexpr int TL = NBATCH * SEQL, TC = NBATCH * CTXL, TT = TL + TC;
constexpr int KVLEN = SEQL + CTXL;
constexpr int INW = 2688, INWP = 2816, ATTIN = 768, SHIFTW = 1920;
constexpr int FFD = 2816, FFE = 3584, NEXP = 8;
constexpr int LORA_K = 384, LORA_N = 2560;
constexpr int MAXPANEL = 280, MAXSLOT = MAXPANEL * 256;
constexpr float RMS_EPS = 1e-6f, GN_EPS = 64e-5f;

constexpr size_t MiB = 1u << 20;
constexpr size_t WS_CTL = 0, CTL_ZERO_BYTES = 64 * 1024;
constexpr size_t WS_MOD = 1 * MiB;
constexpr size_t WS_ROPE = 2 * MiB;
constexpr size_t WS_ROUTE = 3 * MiB;
constexpr size_t RT_E = 0, RT_G = 160 * 1024, RT_S = 448 * 1024, RT_BLK = 768 * 1024, RT_WCNT = 800 * 1024;
constexpr size_t WS_XC = 4 * MiB;
constexpr size_t WS_H = 12 * MiB;
constexpr size_t WS_WIN = 80 * MiB, WS_WOUT = 86 * MiB, WS_WLORA = 88 * MiB;
constexpr size_t WS_WFF = 100 * MiB;
constexpr size_t WS_WFF_D_DENSE = WS_WFF + 12 * MiB, WS_WFF_D_MOE = WS_WFF + 112 * MiB;
constexpr size_t WS_ACT = 270 * MiB;
constexpr size_t WS_QO = WS_ACT, WS_KB = WS_ACT + 68 * MiB, WS_VB = WS_ACT + 77 * MiB, WS_P = WS_ACT + 86 * MiB, WS_OSC = WS_P;
constexpr size_t WS_R = WS_ACT + 273 * MiB, WS_K = WS_ACT + 307 * MiB, WS_V = WS_ACT + 341 * MiB, WS_KK = WS_ACT + 375 * MiB, WS_LIN = WS_ACT + 409 * MiB;
constexpr size_t WS_LOUT = WS_ACT + 435 * MiB;
constexpr size_t WS_HID = WS_ACT;
constexpr size_t WS_AG = WS_ACT, WS_HIDM = WS_ACT + 140 * MiB;
constexpr size_t WS_END = 1000 * MiB;
static_assert(WS_LOUT + (size_t)TT * LORA_N * 2 <= WS_END && WS_HIDM + (size_t)MAXSLOT * FFE * 2 <= WS_END && WS_P + (size_t)TT * INWP * 2 <= WS_R && WS_OSC + (size_t)2 * TT * 512 * 4 <= WS_R, "ws map");
static_assert(WS_WFF_D_MOE + (size_t)NEXP * 1024 * FFE * 2 <= WS_ACT && WS_H + (size_t)TT * 1024 * 2 <= WS_WIN && WS_WIN + (size_t)INWP * 1024 * 2 <= WS_WOUT && WS_WLORA + (size_t)LORA_N * LORA_K * 2 <= WS_WFF, "ws map 2");
constexpr int CW_BAR = 4096;

constexpr int RING_OFF = 0, RING_BYTES = 131072;
constexpr int LDSCTL_OFF = RING_BYTES;
constexpr int MISC_OFF = LDSCTL_OFF;
constexpr int LT_PEXP = LDSCTL_OFF + 256;
constexpr int LT_NPAN = LT_PEXP + 320 * 4;
constexpr int LT_INP = LT_NPAN + 64;
constexpr int LT_TMP = LT_INP + 256;
constexpr int LDS_BYTES = 147456;
static_assert(LT_TMP + 8192 + 1024 <= LDS_BYTES, "LDS map");

struct Frame {
    LAS unsigned char* lds;
    volatile LAS unsigned* MISC;
    gu32* ctl;
    int tid, lane, wave, vcu, G;
    unsigned char* ws;
    float* out;
};
struct Args { const float* in[30]; float* out; unsigned char* ws; };
__device__ __forceinline__ const void* inp_ld(const Frame& F, int k) {
    const LAS unsigned* t = (const LAS unsigned*)(F.lds + LT_INP) + 2 * k; unsigned lo = t[0], hi = t[1];
    lo = __builtin_amdgcn_readfirstlane(lo); hi = __builtin_amdgcn_readfirstlane(hi);
    return (const void*)(((unsigned long long)hi << 32) | lo);
}
#define IN_X 0
#define IN_C 1
#define IN_CTX 2
#define IN_CCTX 3
#define IN_ADAW 4
#define IN_ADAB 5
#define IN_N1G 6
#define IN_N2G 7
#define IN_WIN 8
#define IN_WOUT 9
#define IN_QG 10
#define IN_KG 11
#define IN_MU 12
#define IN_W0 13
#define IN_W2 14
#define IN_A0 15
#define IN_A2 16
#define IN_G2 17
#define IN_KKW 18
#define IN_KA 19
#define IN_RK 20
#define IN_GNW 21
#define IN_GNB 22
#define IN_FWG 23
#define IN_FWU 24
#define IN_FWD 25
#define IN_ROUTER 26
#define IN_MWG 27
#define IN_MWU 28
#define IN_MWD 29

__device__ __forceinline__ int vlaunder(int v) { asm volatile("" : "+v"(v)); return v; }
__device__ __forceinline__ unsigned char* launder(unsigned char* p) { asm volatile("" : "+s"(p)); return p; }
#define INP(k) ((const float*)inp_ld(F, (k)))
__device__ __forceinline__ const void* inp_ld(const struct Frame& F, int k);
__device__ __forceinline__ float wave_sum(float v) {
#pragma unroll
    for (int o = 1; o < 64; o <<= 1) v += __shfl_xor(v, o);
    return v;
}
__device__ __forceinline__ float half_sum(float v) {
#pragma unroll
    for (int o = 1; o < 32; o <<= 1) v += __shfl_xor(v, o);
    return v;
}
__device__ __forceinline__ float bflo(unsigned w) { return __builtin_bit_cast(float, w << 16); }
__device__ __forceinline__ float bfhi(unsigned w) { return __builtin_bit_cast(float, w & 0xffff0000u); }
__device__ __forceinline__ unsigned pkbf(float lo, float hi) { return pg8::cvt_pk_bf16(lo, hi); }
__device__ __forceinline__ float sigm(float x) { return __builtin_amdgcn_rcpf(1.0f + __builtin_amdgcn_exp2f(-1.4426950408889634f * x)); }

__device__ __forceinline__ void p_prologue(Frame& F, const Args& A) {
    unsigned char* const ws = launder(F.ws);
    const int tid = vlaunder(F.tid), lane = tid & 63; (void)lane;
    LAS float* sc = (LAS float*)(F.lds + RING_OFF);
    for (int i = tid; i < 9 * 1024; i += NWAVES * 64) { const int b = i >> 10, k = i & 1023; const float v = (b < 8) ? INP(IN_C)[b * 1024 + k] : INP(IN_CCTX)[k]; sc[i] = v * sigm(v); }
    __syncthreads();
    const int gw = F.vcu * NWAVES + F.wave, NGW = F.G * NWAVES;
    float* mod = (float*)(ws + WS_MOD);
    for (int it = gw; it < DEPTH * 96; it += NGW) {
        const int l = it / 96, j = (it % 96) * 64 + lane;
        const float* W = INP(IN_ADAW) + (size_t)l * 1024 * 6144 + j;
        float acc[9];
#pragma unroll
        for (int b = 0; b < 9; ++b) acc[b] = 0.f;
        for (int k = 0; k < 1024; k += 4) {
            const float w0 = W[(size_t)(k + 0) * 6144], w1 = W[(size_t)(k + 1) * 6144], w2 = W[(size_t)(k + 2) * 6144], w3 = W[(size_t)(k + 3) * 6144];
#pragma unroll
            for (int b = 0; b < 9; ++b) { const f32x4 s = *(const LAS f32x4*)(sc + b * 1024 + k); acc[b] += s[0] * w0 + s[1] * w1 + s[2] * w2 + s[3] * w3; }
        }
        const float bias = INP(IN_ADAB)[l * 6144 + j];
#pragma unroll
        for (int b = 0; b < 9; ++b) mod[((size_t)l * 9 + b) * 6144 + j] = acc[b] + bias;
    }
    float* cs = (float*)(ws + WS_ROPE);
    for (int i = blockIdx.x * (NWAVES * 64) + tid; i < 4096 * 32; i += F.G * NWAVES * 64) {
        const int t = i >> 5, k = i & 31; const int pos = (k < 16) ? (t >> 6) : (t & 63);
        const float inv = powf(10000.0f, -(float)(2 * (k & 15)) / 32.0f); const float ang = (float)pos * inv;
        float s, c; sincosf(ang, &s, &c); cs[2 * i] = c; cs[2 * i + 1] = s;
    }
    __syncthreads();
}

__device__ __forceinline__ void tr_item(const float* W, int K, int N, int k0, int n0, bf16* WT, int drow0, LAS float* scr, int lane) {
#pragma unroll 8
    for (int i = 0; i < 32; ++i) { const int kk = 2 * i + (lane >> 5); scr[kk * 33 + (lane & 31)] = W[(size_t)(k0 + kk) * N + n0 + (lane & 31)]; }
    LDS_WAIT(); asm volatile("" ::: "memory");
    const int c = lane & 7;
#pragma unroll
    for (int j = 0; j < 4; ++j) { const int n = (lane >> 3) + 8 * j; const LAS float* s = scr + (8 * c) * 33 + n;
        v4u o; o.x = pkbf(s[0 * 33], s[1 * 33]); o.y = pkbf(s[2 * 33], s[3 * 33]); o.z = pkbf(s[4 * 33], s[5 * 33]); o.w = pkbf(s[6 * 33], s[7 * 33]);
        *(v4u*)(WT + (size_t)(drow0 + n) * K + k0 + 8 * c) = o; }
    LDS_WAIT(); asm volatile("" ::: "memory");
}
__device__ __forceinline__ int gu_row(int n) { return 256 * (n >> 7) + (n & 127); }

__device__ __forceinline__ void p_wprep(Frame& F, const Args& A, int l) {
    unsigned char* const ws = launder(F.ws);
    const int tid = vlaunder(F.tid), lane = tid & 63; (void)lane;
    LAS float* scr = (LAS float*)(F.lds + RING_OFF + F.wave * 16384);
    const int gw = F.vcu * NWAVES + F.wave, NGW = F.G * NWAVES;
    bf16* WIN = (bf16*)(ws + WS_WIN); bf16* WOUT = (bf16*)(ws + WS_WOUT); bf16* WLORA = (bf16*)(ws + WS_WLORA);
    constexpr int I_IN = 16 * (INW / 32), I_OUT = 16 * 32;
    const bool moe = (l & 1) != 0; const int j = l >> 1;
    constexpr int I_DG = 16 * (FFD / 32), I_DD = (FFD / 64) * 32, I_MG = 16 * (FFE / 32), I_MD = (FFE / 64) * 32;
    const int nff = moe ? NEXP * (2 * I_MG + I_MD) : (2 * I_DG + I_DD);
    const int NIT = I_IN + I_OUT + nff;
    for (int it = gw; it < NIT; it += NGW) {
        int r = it;
        if (r < I_IN) { const int nb = r % (INW / 32), kb = r / (INW / 32); tr_item(INP(IN_WIN) + (size_t)l * 1024 * INW, 1024, INW, kb * 64, nb * 32, WIN, nb * 32, scr, lane); continue; } r -= I_IN;
        if (r < I_OUT) { const int nb = r % 32, kb = r / 32; tr_item(INP(IN_WOUT) + (size_t)l * 1024 * 1024, 1024, 1024, kb * 64, nb * 32, WOUT, nb * 32, scr, lane); continue; } r -= I_OUT;
        if (!moe) {
            bf16* WGU = (bf16*)(ws + WS_WFF); bf16* WD = (bf16*)(ws + WS_WFF_D_DENSE);
            if (r < I_DG) { const int nb = r % (FFD / 32), kb = r / (FFD / 32); tr_item(INP(IN_FWG) + (size_t)j * 1024 * FFD, 1024, FFD, kb * 64, nb * 32, WGU, gu_row(nb * 32), scr, lane); continue; } r -= I_DG;
            if (r < I_DG) { const int nb = r % (FFD / 32), kb = r / (FFD / 32); tr_item(INP(IN_FWU) + (size_t)j * 1024 * FFD, 1024, FFD, kb * 64, nb * 32, WGU, gu_row(nb * 32) + 128, scr, lane); continue; } r -= I_DG;
            { const int nb = r % 32, kb = r / 32; tr_item(INP(IN_FWD) + (size_t)j * FFD * 1024, FFD, 1024, kb * 64, nb * 32, WD, nb * 32, scr, lane); }
        } else {
            constexpr int PER = 2 * I_MG + I_MD; const int e = r / PER; r -= e * PER;
            bf16* WGU = (bf16*)(ws + WS_WFF) + (size_t)e * (2 * FFE) * 1024; bf16* WD = (bf16*)(ws + WS_WFF_D_MOE) + (size_t)e * 1024 * FFE;
            const size_t eo = ((size_t)j * NEXP + e) * 1024 * FFE;
            if (r < I_MG) { const int nb = r % (FFE / 32), kb = r / (FFE / 32); tr_item(INP(IN_MWG) + eo, 1024, FFE, kb * 64, nb * 32, WGU, gu_row(nb * 32), scr, lane); continue; } r -= I_MG;
            if (r < I_MG) { const int nb = r % (FFE / 32), kb = r / (FFE / 32); tr_item(INP(IN_MWU) + eo, 1024, FFE, kb * 64, nb * 32, WGU, gu_row(nb * 32) + 128, scr, lane); continue; } r -= I_MG;
            { const int nb = r % 32, kb = r / 32; tr_item(INP(IN_MWD) + eo, FFE, 1024, kb * 64, nb * 32, WD, nb * 32, scr, lane); }
        }
    }
    for (int i = blockIdx.x * (NWAVES * 64) + tid; i < 16384; i += F.G * NWAVES * 64) ((v4u*)(WIN + (size_t)INW * 1024))[i] = (v4u){0u, 0u, 0u, 0u};
    const float* w2 = INP(IN_W2) + (size_t)l * 2 * 64 * 512; const float* a2 = INP(IN_A2) + (size_t)l * 2 * 64 * 512; const float* g2 = INP(IN_G2) + (size_t)l * 128 * 512;
    for (int i = blockIdx.x * (NWAVES * 64) + tid; i < LORA_N * (LORA_K / 2); i += F.G * NWAVES * 64) {
        const int n = i / (LORA_K / 2), k = (i % (LORA_K / 2)) * 2; const int sec = n >> 9, cn = n & 511;
        float v0 = 0.f, v1 = 0.f;
        if (sec < 2) { const int kk = k - 64 * sec; if (kk >= 0 && kk < 64) { v0 = w2[((size_t)sec * 64 + kk) * 512 + cn]; v1 = w2[((size_t)sec * 64 + kk + 1) * 512 + cn]; } }
        else if (sec < 4) { const int d = sec - 2, kk = k - 128 - 64 * d; if (kk >= 0 && kk < 64) { v0 = a2[((size_t)d * 64 + kk) * 512 + cn]; v1 = a2[((size_t)d * 64 + kk + 1) * 512 + cn]; } }
        else { const int kk = k - 256; if (kk >= 0) { v0 = g2[(size_t)kk * 512 + cn]; v1 = g2[(size_t)(kk + 1) * 512 + cn]; } }
        ((unsigned*)WLORA)[i] = pkbf(v0, v1);
    }
}

template <bool ROUTER, bool COMBINE>
__device__ __forceinline__ void p_norm(Frame& F, const Args& A, int l, int which, const float* srcL, const float* srcC, float* dstL, float* dstC, int lprev) {
    unsigned char* const ws = launder(F.ws);
    const int tid = vlaunder(F.tid), lane = tid & 63; (void)lane;
    const int gw = F.vcu * NWAVES + F.wave, NGW = F.G * NWAVES;
    const float* mod = (const float*)(ws + WS_MOD) + (size_t)l * 9 * 6144;
    const float* gain = A.in[which ? IN_N2G : IN_N1G] + l * 1024;
    bf16* H = (bf16*)(ws + WS_H);
    const int* route_e = (const int*)(ws + WS_ROUTE + RT_E); const float* route_g = (const float*)(ws + WS_ROUTE + RT_G); const int* route_s = (const int*)(ws + WS_ROUTE + RT_S);
    int cnt0 = 0, cnt1 = 0, cnt2 = 0, cnt3 = 0, cnt4 = 0, cnt5 = 0, cnt6 = 0, cnt7 = 0;
    for (int row = gw; row < TT; row += NGW) {
        const bool lat = row < TL; const int bsel = lat ? (row >> 12) : 8;
        const float* xr = lat ? srcL + (size_t)row * 1024 : srcC + (size_t)(row - TL) * 1024;
        f32x4 v[4];
#pragma unroll
        for (int jj = 0; jj < 4; ++jj) v[jj] = *(const f32x4*)(xr + 4 * lane + 256 * jj);
        if (COMBINE) {
            const float* m5 = (const float*)(ws + WS_MOD) + ((size_t)lprev * 9 + bsel) * 6144 + 5 * 1024;
            const float g0 = route_g[2 * row], g1 = route_g[2 * row + 1]; const int s0 = route_s[2 * row], s1 = route_s[2 * row + 1];
            const bf16* Y = (const bf16*)(ws + WS_AG);
            float* xw = lat ? dstL + (size_t)row * 1024 : dstC + (size_t)(row - TL) * 1024;
#pragma unroll
            for (int jj = 0; jj < 4; ++jj) { const int col = 4 * lane + 256 * jj;
                const uint2 y0 = *(const uint2*)(Y + (size_t)s0 * 1024 + col), y1 = *(const uint2*)(Y + (size_t)s1 * 1024 + col); const f32x4 mm = *(const f32x4*)(m5 + col);
                v[jj][0] += mm[0] * (g0 * bflo(y0.x) + g1 * bflo(y1.x)); v[jj][1] += mm[1] * (g0 * bfhi(y0.x) + g1 * bfhi(y1.x));
                v[jj][2] += mm[2] * (g0 * bflo(y0.y) + g1 * bflo(y1.y)); v[jj][3] += mm[3] * (g0 * bfhi(y0.y) + g1 * bfhi(y1.y));
                *(f32x4*)(xw + col) = v[jj]; }
        }
        float ss = 0.f;
#pragma unroll
        for (int jj = 0; jj < 4; ++jj) ss += (v[jj][0] * v[jj][0] + v[jj][1] * v[jj][1]) + (v[jj][2] * v[jj][2] + v[jj][3] * v[jj][3]);
        const float rstd = 1.0f / sqrtf(wave_sum(ss) * (1.0f / 1024.0f) + RMS_EPS);
        const float* shp = mod + (size_t)bsel * 6144 + (which ? 3 : 0) * 1024; const float* scp = shp + 1024;
        float lg[8];
#pragma unroll
        for (int e = 0; e < 8; ++e) lg[e] = 0.f;
#pragma unroll
        for (int jj = 0; jj < 4; ++jj) { const int col = 4 * lane + 256 * jj;
            const f32x4 gg = *(const f32x4*)(gain + col), sh = *(const f32x4*)(shp + col), sc = *(const f32x4*)(scp + col);
            f32x4 h = (v[jj] * rstd) * gg * (sc + 1.0f) + sh;
            uint2 o; o.x = pkbf(h[0], h[1]); o.y = pkbf(h[2], h[3]);
            *(uint2*)(H + (size_t)row * 1024 + col) = o;
            if (ROUTER) { const float* rw = INP(IN_ROUTER) + (size_t)(l >> 1) * 1024 * 8 + (size_t)col * 8;
#pragma unroll
                for (int q = 0; q < 4; ++q) { const f32x4 ra = *(const f32x4*)(rw + q * 8), rb = *(const f32x4*)(rw + q * 8 + 4);
                    lg[0] += h[q] * ra[0]; lg[1] += h[q] * ra[1]; lg[2] += h[q] * ra[2]; lg[3] += h[q] * ra[3]; lg[4] += h[q] * rb[0]; lg[5] += h[q] * rb[1]; lg[6] += h[q] * rb[2]; lg[7] += h[q] * rb[3]; } }
        }
        if (ROUTER) {
#pragma unroll
            for (int e = 0; e < 8; ++e) lg[e] = wave_sum(lg[e]);
            int e0 = 0; float v0 = lg[0];
#pragma unroll
            for (int e = 1; e < 8; ++e) if (lg[e] > v0) { v0 = lg[e]; e0 = e; }
            int e1 = -1; float v1 = -INFINITY;
#pragma unroll
            for (int e = 0; e < 8; ++e) if (e != e0 && lg[e] > v1) { v1 = lg[e]; e1 = e; }
            const float g0 = 1.0f / (1.0f + __expf(v1 - v0)), g1 = 1.0f - g0;
            if (lane == 0) { ((int*)(ws + WS_ROUTE + RT_E))[row] = e0 | (e1 << 8); ((float*)(ws + WS_ROUTE + RT_G))[2 * row] = g0; ((float*)(ws + WS_ROUTE + RT_G))[2 * row + 1] = g1; }
            cnt0 += (e0 == 0) + (e1 == 0); cnt1 += (e0 == 1) + (e1 == 1); cnt2 += (e0 == 2) + (e1 == 2); cnt3 += (e0 == 3) + (e1 == 3);
            cnt4 += (e0 == 4) + (e1 == 4); cnt5 += (e0 == 5) + (e1 == 5); cnt6 += (e0 == 6) + (e1 == 6); cnt7 += (e0 == 7) + (e1 == 7);
        }
    }
    if (ROUTER) {
        int* wcnt = (int*)(ws + WS_ROUTE + RT_WCNT);
        if (lane == 0) { int* w = wcnt + (size_t)gw * 8; w[0] = cnt0; w[1] = cnt1; w[2] = cnt2; w[3] = cnt3; w[4] = cnt4; w[5] = cnt5; w[6] = cnt6; w[7] = cnt7; }
    }
}
__device__ __forceinline__ void p_final_combine(Frame& F, int lprev) {
    unsigned char* const ws = launder(F.ws);
    const int tid = vlaunder(F.tid), lane = tid & 63; (void)lane;
    const int gw = F.vcu * NWAVES + F.wave, NGW = F.G * NWAVES;
    const float* route_g = (const float*)(ws + WS_ROUTE + RT_G); const int* route_s = (const int*)(ws + WS_ROUTE + RT_S);
    const bf16* Y = (const bf16*)(ws + WS_AG);
    for (int row = gw; row < TL; row += NGW) {
        const int bsel = row >> 12;
        const float* m5 = (const float*)(ws + WS_MOD) + ((size_t)lprev * 9 + bsel) * 6144 + 5 * 1024;
        const float g0 = route_g[2 * row], g1 = route_g[2 * row + 1]; const int s0 = route_s[2 * row], s1 = route_s[2 * row + 1];
        float* xw = F.out + (size_t)row * 1024;
#pragma unroll
        for (int jj = 0; jj < 4; ++jj) { const int col = 4 * lane + 256 * jj;
            f32x4 v = *(const f32x4*)(xw + col);
            const uint2 y0 = *(const uint2*)(Y + (size_t)s0 * 1024 + col), y1 = *(const uint2*)(Y + (size_t)s1 * 1024 + col); const f32x4 mm = *(const f32x4*)(m5 + col);
            v[0] += mm[0] * (g0 * bflo(y0.x) + g1 * bflo(y1.x)); v[1] += mm[1] * (g0 * bfhi(y0.x) + g1 * bfhi(y1.x));
            v[2] += mm[2] * (g0 * bflo(y0.y) + g1 * bflo(y1.y)); v[3] += mm[3] * (g0 * bfhi(y0.y) + g1 * bfhi(y1.y));
            *(f32x4*)(xw + col) = v; }
    }
}

__device__ __forceinline__ void p_prep(Frame& F, const Args& A, int l) {
    unsigned char* const ws = launder(F.ws);
    const int tid = vlaunder(F.tid), lane = tid & 63; (void)lane;
    const int gw = F.vcu * NWAVES + F.wave, NGW = F.G * NWAVES;
    const unsigned* P = (const unsigned*)(ws + WS_P);
    const float* cs = (const float*)(ws + WS_ROPE);
    bf16* QO = (bf16*)(ws + WS_QO); bf16* KB = (bf16*)(ws + WS_KB); bf16* VB = (bf16*)(ws + WS_VB);
    unsigned* Rst = (unsigned*)(ws + WS_R); unsigned* Kst = (unsigned*)(ws + WS_K); unsigned* Vst = (unsigned*)(ws + WS_V); unsigned* KKst = (unsigned*)(ws + WS_KK); unsigned* LIN = (unsigned*)(ws + WS_LIN);
    const int d0 = 2 * (lane & 31);
    const float qg0 = INP(IN_QG)[l * 64 + d0], qg1 = INP(IN_QG)[l * 64 + d0 + 1], kg0 = INP(IN_KG)[l * 64 + d0], kg1 = INP(IN_KG)[l * 64 + d0 + 1];
    float mu0[15], mu1[15];
#pragma unroll
    for (int i = 0; i < 15; ++i) { mu0[i] = INP(IN_MU)[l * SHIFTW + 128 * i + 2 * lane]; mu1[i] = INP(IN_MU)[l * SHIFTW + 128 * i + 2 * lane + 1]; }
    float kw0[4], kw1[4];
#pragma unroll
    for (int i = 0; i < 4; ++i) { kw0[i] = INP(IN_KKW)[l * 512 + 128 * i + 2 * lane]; kw1[i] = INP(IN_KKW)[l * 512 + 128 * i + 2 * lane + 1]; }
    const float C2 = 0.125f * 1.4426950408889634f;
    const float sgn = (lane & 16) ? 1.0f : -1.0f;
    for (int w0 = gw; w0 * 17 < TT; w0 += NGW) {
        const int rbeg = w0 * 17;
        unsigned cur[21], nxt[21], prv[15];
#pragma unroll
        for (int i = 0; i < 15; ++i) prv[i] = 0u;
        {   const int r = rbeg; const bool lat = r < TL; const int pos = lat ? (r & 4095) : ((r - TL) & 255);
            if (pos != 0) {
#pragma unroll
                for (int i = 0; i < 15; ++i) prv[i] = P[(size_t)(r - 1) * (INWP / 2) + 64 * (i + 6) + lane]; }
#pragma unroll
            for (int i = 0; i < 21; ++i) cur[i] = P[(size_t)r * (INWP / 2) + 64 * i + lane];
        }
        for (int k = 0; k < 17; ++k) {
            const int r = rbeg + k; const bool lat = r < TL; const int pos = lat ? (r & 4095) : ((r - TL) & 255); const int slen = lat ? 4096 : 256;
            const bool has_next = (pos != slen - 1);
            const bool load_next = (k < 16) || has_next;
            if (load_next && r + 1 < TT) {
#pragma unroll
                for (int i = 0; i < 21; ++i) nxt[i] = P[(size_t)(r + 1) * (INWP / 2) + 64 * i + lane];
            } else {
#pragma unroll
                for (int i = 0; i < 21; ++i) nxt[i] = 0u;
            }
            const int b = lat ? (r >> 12) : ((r - TL) >> 8);
            const size_t kvrow = (size_t)b * KVLEN + (lat ? pos : 4096 + pos);
            f32x4 csv = (f32x4){1.f, 0.f, 1.f, 0.f};
            if (lat) csv = *(const f32x4*)(cs + ((size_t)pos * 32 + 2 * (lane & 15)) * 2);
#pragma unroll
            for (int i = 0; i < 5; ++i) {
                float x0 = bflo(cur[i]), x1 = bfhi(cur[i]);
                const float ss = half_sum(x0 * x0 + x1 * x1);
                const float rstd = 1.0f / sqrtf(ss * (1.0f / 64.0f) + RMS_EPS);
                x0 = x0 * rstd * (i < 4 ? qg0 : kg0); x1 = x1 * rstd * (i < 4 ? qg1 : kg1);
                const float p0 = __shfl_xor(x0, 16), p1 = __shfl_xor(x1, 16);
                const float y0 = x0 * csv[0] + sgn * p0 * csv[1], y1 = x1 * csv[2] + sgn * p1 * csv[3];
                if (i < 4) *(unsigned*)(QO + (size_t)r * 1024 + 128 * i + 2 * lane) = pkbf(y0 * C2, y1 * C2);
                else *(unsigned*)(KB + kvrow * 128 + 2 * lane) = pkbf(y0, y1);
            }
            *(unsigned*)(VB + kvrow * 128 + 2 * lane) = cur[5];
            const float hn = has_next ? 1.0f : 0.0f;
#pragma unroll
            for (int i = 0; i < 15; ++i) {
                const float c0 = bflo(cur[i + 6]), c1 = bfhi(cur[i + 6]);
                const float a0 = bflo(prv[i]) + hn * bflo(nxt[i + 6]), a1 = bfhi(prv[i]) + hn * bfhi(nxt[i + 6]);
                const float s0 = c0 + mu0[i] * (0.5f * a0 - c0), s1 = c1 + mu1[i] * (0.5f * a1 - c1);
                if (i < 4) Rst[(size_t)r * 256 + 64 * i + lane] = pkbf(s0, s1);
                else if (i < 8) { Kst[(size_t)r * 256 + 64 * (i - 4) + lane] = pkbf(s0, s1);
                    const float t0 = s0 * kw0[i - 4], t1 = s1 * kw1[i - 4]; const float q = half_sum(t0 * t0 + t1 * t1); const float rn = 1.0f / sqrtf(q + 1e-12f);
                    KKst[(size_t)r * 256 + 64 * (i - 4) + lane] = pkbf(t0 * rn, t1 * rn); }
                else if (i < 12) Vst[(size_t)r * 256 + 64 * (i - 8) + lane] = pkbf(s0, s1);
                else if (i == 12) { const float e0 = __builtin_amdgcn_exp2f(2.0f * 1.4426950408889634f * s0), e1 = __builtin_amdgcn_exp2f(2.0f * 1.4426950408889634f * s1);
                    LIN[(size_t)r * (LORA_K / 2) + lane] = pkbf(1.0f - 2.0f * __builtin_amdgcn_rcpf(1.0f + e0), 1.0f - 2.0f * __builtin_amdgcn_rcpf(1.0f + e1)); }
                else if (i == 13) LIN[(size_t)r * (LORA_K / 2) + 64 + lane] = pkbf(s0, s1);
                else LIN[(size_t)r * (LORA_K / 2) + 128 + lane] = pkbf(sigm(s0), sigm(s1));
            }
#pragma unroll
            for (int i = 0; i < 15; ++i) prv[i] = has_next ? cur[i + 6] : 0u;
#pragma unroll
            for (int i = 0; i < 21; ++i) cur[i] = nxt[i];
        }
    }
}

template <int CTRL> __device__ __forceinline__ float dppf(float v) { return __builtin_bit_cast(float, __builtin_amdgcn_update_dpp(0, __builtin_bit_cast(int, v), CTRL, 0xf, 0xf, true)); }
__device__ __forceinline__ float red16(float v) { v += dppf<0xB1>(v); v += dppf<0x4E>(v); v += dppf<0x141>(v); v += dppf<0x128>(v); return v; }
constexpr int SC_TS = 32, SC_W = 352;
__device__ __forceinline__ void p_scan(Frame& F, const Args& A, int l) {
    unsigned char* const ws = launder(F.ws);
    const int tid = vlaunder(F.tid), lane = tid & 63; (void)lane;
    LAS float* buf = (LAS float*)(F.lds + RING_OFF);
    float* OSC = (float*)(ws + WS_OSC);
    constexpr int NCH = KVLEN / SC_TS;
    for (int item = blockIdx.x; item < 256; item += F.G) {
        const int chain = item >> 1, rh = item & 1, dir = chain & 1, bh = chain >> 1, b = bh >> 3, h = bh & 7;
        const int row = tid >> 4, c = tid & 15;
        float S0 = 0.f, S1 = 0.f, S2 = 0.f, S3 = 0.f;
        const bool stg = tid < 352; const int sub = (tid >= 176) ? 1 : 0, pp = tid - 176 * sub, a = pp >> 5, w = pp & 31;
        const unsigned* p1; int pitch1 = 256;
        if (a == 0 || a == 2) p1 = (const unsigned*)(ws + WS_KK) + h * 32 + w;
        else if (a == 1) { p1 = (const unsigned*)(ws + WS_LOUT) + dir * 256 + h * 32 + w; pitch1 = LORA_N / 2; }
        else if (a == 3) p1 = (const unsigned*)(ws + WS_K) + h * 32 + w;
        else if (a == 4) p1 = (const unsigned*)(ws + WS_R) + h * 32 + w;
        else p1 = (const unsigned*)(ws + WS_V) + h * 32 + rh * 16 + (pp - 160);
        const unsigned* p2 = (const unsigned*)(ws + WS_LOUT) + 512 + dir * 256 + h * 32 + w;
        const bool two = (a == 2 || a == 3);
        const int cw = (a == 5) ? 0 : 2 * w;
        const float cw0 = INP(IN_W0)[l * 1024 + dir * 512 + h * 64 + cw], cw1 = INP(IN_W0)[l * 1024 + dir * 512 + h * 64 + cw + 1];
        const float ca0 = INP(IN_A0)[l * 1024 + dir * 512 + h * 64 + cw], ca1 = INP(IN_A0)[l * 1024 + dir * 512 + h * 64 + cw + 1];
        const float ck0 = INP(IN_KA)[l * 512 + h * 64 + cw], ck1 = INP(IN_KA)[l * 512 + h * 64 + cw + 1];
        unsigned st[16], st2[16];
#define SC_TOK(s) ((s) < CTXL ? (TL + b * CTXL + (dir ? (CTXL - 1 - (s)) : (s))) : (b * SEQL + (dir ? (SEQL - 1 - ((s) - CTXL)) : ((s) - CTXL))))
#define SC_LOAD(ci) do { if (stg) { _Pragma("unroll") for (int i = 0; i < 16; ++i) { const int s = (ci) * SC_TS + 2 * i + sub; const size_t tok = (size_t)SC_TOK(s); \
            st[i] = p1[tok * pitch1]; st2[i] = two ? p2[tok * (LORA_N / 2)] : 0u; } } } while (0)
#define SC_STORE(bi) do { if (stg) { _Pragma("unroll") for (int i = 0; i < 16; ++i) { \
            float x0 = bflo(st[i]), x1 = bfhi(st[i]); \
            if (a == 1) { x0 = __builtin_amdgcn_exp2f(-1.4426950408889634f * 0.6065306597126334f * sigm(x0 + cw0)); x1 = __builtin_amdgcn_exp2f(-1.4426950408889634f * 0.6065306597126334f * sigm(x1 + cw1)); } \
            else if (a == 2) { x0 *= sigm(bflo(st2[i]) + ca0); x1 *= sigm(bfhi(st2[i]) + ca1); } \
            else if (a == 3) { x0 *= 1.0f + (sigm(bflo(st2[i]) + ca0) - 1.0f) * ck0; x1 *= 1.0f + (sigm(bfhi(st2[i]) + ca1) - 1.0f) * ck1; } \
            LAS float* dp = buf + ((bi) * SC_TS + 2 * i + sub) * SC_W + 2 * pp; dp[0] = x0; dp[1] = x1; } } } while (0)
        __syncthreads();
        SC_LOAD(0); SC_STORE(0); __syncthreads();
        for (int ci = 0; ci < NCH; ++ci) {
            if (ci + 1 < NCH) SC_LOAD(ci + 1);
            const LAS float* bp = buf + (ci & 1) * SC_TS * SC_W;
#pragma unroll 2
            for (int stp = 0; stp < SC_TS; ++stp) {
                const LAS float* sp = bp + stp * SC_W;
                const f32x4 kk = *(const LAS f32x4*)(sp + 4 * c), w4 = *(const LAS f32x4*)(sp + 64 + 4 * c), bb = *(const LAS f32x4*)(sp + 128 + 4 * c), kd = *(const LAS f32x4*)(sp + 192 + 4 * c), rr = *(const LAS f32x4*)(sp + 256 + 4 * c);
                const float vv = sp[320 + row];
                float sa = (S0 * kk[0] + S1 * kk[1]) + (S2 * kk[2] + S3 * kk[3]); sa = red16(sa);
                S0 = S0 * w4[0] + (vv * kd[0] - sa * bb[0]); S1 = S1 * w4[1] + (vv * kd[1] - sa * bb[1]); S2 = S2 * w4[2] + (vv * kd[2] - sa * bb[2]); S3 = S3 * w4[3] + (vv * kd[3] - sa * bb[3]);
                float o = (S0 * rr[0] + S1 * rr[1]) + (S2 * rr[2] + S3 * rr[3]); o = red16(o);
                if (c == 0) { const int s = ci * SC_TS + stp; OSC[((size_t)dir * TT + (size_t)SC_TOK(s)) * 512 + h * 64 + rh * 32 + row] = o; }
            }
            if (ci + 1 < NCH) SC_STORE((ci + 1) & 1);
            __syncthreads();
        }
#undef SC_TOK
#undef SC_LOAD
#undef SC_STORE
    }
}

__device__ __forceinline__ void p_readout(Frame& F, const Args& A, int l) {
    unsigned char* const ws = launder(F.ws);
    const int tid = vlaunder(F.tid), lane = tid & 63; (void)lane;
    const int gw = F.vcu * NWAVES + F.wave, NGW = F.G * NWAVES;
    const float* OSC = (const float*)(ws + WS_OSC);
    const unsigned* Rst = (const unsigned*)(ws + WS_R); const unsigned* Vst = (const unsigned*)(ws + WS_V); const unsigned* Kst = (const unsigned*)(ws + WS_K); const unsigned* LOUT = (const unsigned*)(ws + WS_LOUT);
    bf16* QO = (bf16*)(ws + WS_QO);
    float rk0[4], rk1[4], gw0[4], gw1[4], gb0[4], gb1[4], ka0[4], ka1[4], aa0[4], aa1[4], ab0[4], ab1[4];
#pragma unroll
    for (int i = 0; i < 4; ++i) { const int cc = 128 * i + 2 * lane, cidx = l * 512 + cc; rk0[i] = INP(IN_RK)[cidx]; rk1[i] = INP(IN_RK)[cidx + 1]; gw0[i] = INP(IN_GNW)[cidx]; gw1[i] = INP(IN_GNW)[cidx + 1]; gb0[i] = INP(IN_GNB)[cidx]; gb1[i] = INP(IN_GNB)[cidx + 1];
        ka0[i] = INP(IN_KA)[cidx]; ka1[i] = INP(IN_KA)[cidx + 1]; aa0[i] = INP(IN_A0)[l * 1024 + cc]; aa1[i] = INP(IN_A0)[l * 1024 + cc + 1]; ab0[i] = INP(IN_A0)[l * 1024 + 512 + cc]; ab1[i] = INP(IN_A0)[l * 1024 + 512 + cc + 1]; }
    for (int row = gw; row < TT; row += NGW) {
#pragma unroll
        for (int i = 0; i < 4; ++i) {
            const size_t off = (size_t)row * 256 + 64 * i + lane; const size_t lo = (size_t)row * (LORA_N / 2) + 64 * i + lane;
            const float2 oa = *(const float2*)(OSC + (size_t)row * 512 + 128 * i + 2 * lane), ob = *(const float2*)(OSC + ((size_t)TT + row) * 512 + 128 * i + 2 * lane);
            const float o0 = oa.x + ob.x, o1 = oa.y + ob.y;
            const float mean = half_sum(o0 + o1) * (1.0f / 64.0f);
            const float d0 = o0 - mean, d1 = o1 - mean;
            const float var = half_sum(d0 * d0 + d1 * d1) * (1.0f / 64.0f);
            const float rs = 1.0f / sqrtf(var + GN_EPS);
            const unsigned rw = Rst[off], vw = Vst[off], kw = Kst[off], pa = LOUT[lo + 512], pb = LOUT[lo + 768], gwd = LOUT[lo + 1024];
            const float ks0 = bflo(kw) * (2.0f + (sigm(bflo(pa) + aa0[i]) + sigm(bflo(pb) + ab0[i]) - 2.0f) * ka0[i]), ks1 = bfhi(kw) * (2.0f + (sigm(bfhi(pa) + aa1[i]) + sigm(bfhi(pb) + ab1[i]) - 2.0f) * ka1[i]);
            const float bsum = half_sum(bflo(rw) * ks0 * rk0[i] + bfhi(rw) * ks1 * rk1[i]);
            const float y0 = d0 * rs * gw0[i] + gb0[i] + bsum * bflo(vw), y1 = d1 * rs * gw1[i] + gb1[i] + bsum * bfhi(vw);
            *(unsigned*)(QO + (size_t)row * 1024 + 512 + 128 * i + 2 * lane) = pkbf(y0 * bflo(gwd), y1 * bfhi(gwd));
        }
    }
}

__device__ __forceinline__ void p_route(Frame& F) {
    unsigned char* const ws = launder(F.ws);
    const int tid = vlaunder(F.tid), lane = tid & 63; (void)lane;
    const int gw = F.vcu * NWAVES + F.wave, NGW = F.G * NWAVES;
    const int* wcnt = (const int*)(ws + WS_ROUTE + RT_WCNT);
    LAS int* pexp = (LAS int*)(F.lds + LT_PEXP); LAS int* npan = (LAS int*)(F.lds + LT_NPAN); LAS int* tmp = (LAS int*)(F.lds + LT_TMP);
    {   const int e = lane & 7, part = lane >> 3;
        const int p = F.wave * 8 + part;
        const int wb = p * (NGW / 64), we = wb + NGW / 64; const int myw0 = F.vcu * NWAVES;
        int tot = 0, before = 0;
        for (int w = wb; w < we; ++w) { const int cv = wcnt[(size_t)w * 8 + e]; tot += cv; if (w < myw0) before += cv; }
        tmp[p * 16 + e] = tot; tmp[p * 16 + 8 + e] = before;
    }
    __syncthreads();
    if (tid < 8) { int tot = 0, before = 0; for (int p = 0; p < 64; ++p) { tot += tmp[p * 16 + tid]; before += tmp[p * 16 + 8 + tid]; } tmp[1024 + tid] = tot; tmp[1032 + tid] = before; }
    __syncthreads();
    if (tid == 0) { int acc = 0; for (int e = 0; e < 8; ++e) { const int padded = (tmp[1024 + e] + 255) & ~255; tmp[1040 + e] = acc; acc += padded; tmp[1048 + e] = acc; } npan[0] = acc >> 8; }
    __syncthreads();
    for (int p = tid; p < 320; p += NWAVES * 64) { int e = 7; for (int q = 7; q >= 0; --q) if (p * 256 < tmp[1048 + q]) e = q; pexp[p] = e; }
    int base0, base1, base2, base3, base4, base5, base6, base7;
    {   int bsv[8];
#pragma unroll
        for (int e = 0; e < 8; ++e) { int v = tmp[1040 + e] + tmp[1032 + e]; for (int w = 0; w < F.wave; ++w) v += wcnt[(size_t)(F.vcu * NWAVES + w) * 8 + e]; bsv[e] = v; }
        base0 = bsv[0]; base1 = bsv[1]; base2 = bsv[2]; base3 = bsv[3]; base4 = bsv[4]; base5 = bsv[5]; base6 = bsv[6]; base7 = bsv[7];
    }
    const int* route_e = (const int*)(ws + WS_ROUTE + RT_E); int* route_s = (int*)(ws + WS_ROUTE + RT_S);
    const bf16* H = (const bf16*)(ws + WS_H); bf16* AG = (bf16*)(ws + WS_AG);
    for (int row = gw; row < TT; row += NGW) {
        const int ee = route_e[row]; const int e0 = ee & 255, e1 = ee >> 8;
        int s0 = 0, s1 = 0;
#define RT_TAKE(E, B) do { if (e0 == E) { s0 = B; B += 1; } if (e1 == E) { s1 = B; B += 1; } } while (0)
        RT_TAKE(0, base0); RT_TAKE(1, base1); RT_TAKE(2, base2); RT_TAKE(3, base3); RT_TAKE(4, base4); RT_TAKE(5, base5); RT_TAKE(6, base6); RT_TAKE(7, base7);
#undef RT_TAKE
        if (lane == 0) { route_s[2 * row] = s0; route_s[2 * row + 1] = s1; }
        const v4u* src = (const v4u*)(H + (size_t)row * 1024); const v4u a = src[lane], bq = src[64 + lane];
        v4u* d0 = (v4u*)(AG + (size_t)s0 * 1024); v4u* d1 = (v4u*)(AG + (size_t)s1 * 1024);
        d0[lane] = a; d0[64 + lane] = bq; d1[lane] = a; d1[64 + lane] = bq;
    }
    __syncthreads();
}

__device__ __forceinline__ void p_attn(Frame& F, char* ldsg, bool ctx_on) {
    unsigned char* const ws = launder(F.ws);
    const int tid = vlaunder(F.tid), lane = tid & 63; (void)lane;
    typedef attn_body::bf16 abf;
    const abf* Q = (const abf*)(ws + WS_QO); const abf* K = (const abf*)(ws + WS_KB); const abf* V = (const abf*)(ws + WS_VB); abf* O = (abf*)(ws + WS_QO);
    const int per = (1024 + F.G - 1) / F.G;
    for (int i = 0; i < per; ++i) { const int un = F.vcu * per + i; if (un >= 1024) break;
        const int bh = un >> 4, qb = un & 15, b = bh >> 3, h = bh & 7;
        attn_body::attn_unit<8>((long)b * SEQL + qb * 256, h * 64, (long)b * KVLEN, (h >> 2) * 64, KVLEN / 64, Q, K, V, O, ldsg); }
    if (ctx_on) for (int un = F.vcu; un < 64; un += F.G) { const int b = un >> 3, h = un & 7;
        attn_body::attn_unit<8>((long)TL + b * CTXL, h * 64, (long)b * KVLEN + SEQL, (h >> 2) * 64, CTXL / 64, Q, K, V, O, ldsg); }
}

template <int l> __device__ __forceinline__ void layer_body(Frame& F, const Args& args, const XcdBarrier& bar, unsigned char* lds) {
#define GRID_BAR() xcd_barrier(bar)

        constexpr bool last = (l == DEPTH - 1), moe = (l & 1) != 0;

#ifndef SKIP_WPREP
        p_wprep(F, args, l);
#endif


#ifndef SKIP_NORM1
        {   float* XC = (float*)(launder(F.ws) + WS_XC);
            if (l == 0) p_norm<false, false>(F, args, l, 0, INP(IN_X), INP(IN_CTX), nullptr, nullptr, 0);
            else if (l & 1) p_norm<false, false>(F, args, l, 0, F.out, XC, nullptr, nullptr, 0);
            else p_norm<false, true>(F, args, l, 0, F.out, XC, F.out, XC, l - 1); }
#endif

        GRID_BAR();
        {   unsigned char* const ws = launder(F.ws); float* const XC = (float*)(ws + WS_XC); const float* const MOD = (const float*)(ws + WS_MOD); bf16* const H = (bf16*)(ws + WS_H); (void)XC; (void)MOD; (void)H;
            pg8::Gemm g{H, (const bf16*)(ws + WS_WIN), TT, INWP, 1024}; pg8::Sched S; S.init(TT / 256, INWP / 256, F.G, (int)blockIdx.x, nullptr);
            pg8::EpiBf16 E{(bf16*)(ws + WS_P), INWP};
#ifndef SKIP_G_IN
            pg8::gemm_phase<pg8::EpiBf16, pg8::Sched, true, true>(F.lds + RING_OFF, g, S, E);
#endif
            }
        GRID_BAR();

#ifndef SKIP_PREP
        p_prep(F, args, l);
#endif

        GRID_BAR();
        {   unsigned char* const ws = launder(F.ws); float* const XC = (float*)(ws + WS_XC); const float* const MOD = (const float*)(ws + WS_MOD); bf16* const H = (bf16*)(ws + WS_H); (void)XC; (void)MOD; (void)H;
            pg8::Gemm g{(const bf16*)(ws + WS_LIN), (const bf16*)(ws + WS_WLORA), TT, LORA_N, LORA_K}; pg8::Sched S; S.init(TT / 256, LORA_N / 256, F.G, (int)blockIdx.x, nullptr);
            pg8::EpiBf16 E{(bf16*)(ws + WS_LOUT), LORA_N};
#ifndef SKIP_G_LORA
            pg8::gemm_phase<pg8::EpiBf16, pg8::Sched, true, true>(F.lds + RING_OFF, g, S, E);
#endif
            }

#ifndef SKIP_ATTN
        p_attn(F, (char*)lds + RING_OFF, !last);
#endif

        GRID_BAR();

#ifndef SKIP_SCAN
        p_scan(F, args, l);
#endif

        GRID_BAR();

#ifndef SKIP_READOUT
        p_readout(F, args, l);
#endif

        GRID_BAR();
        {   unsigned char* const ws = launder(F.ws); float* const XC = (float*)(ws + WS_XC); const float* const MOD = (const float*)(ws + WS_MOD); bf16* const H = (bf16*)(ws + WS_H); (void)XC; (void)MOD; (void)H;
            pg8::Gemm g{(const bf16*)(ws + WS_QO), (const bf16*)(ws + WS_WOUT), TT, 1024, 1024}; pg8::Sched S; S.init(TT / 256, 4, F.G, (int)blockIdx.x, nullptr);
            pg8::EpiResid E{l == 0 ? INP(IN_X) : F.out, l == 0 ? INP(IN_CTX) : XC, F.out, XC, MOD + (size_t)l * 9 * 6144 + 2 * 1024};
#ifndef SKIP_G_OUT
            pg8::gemm_phase<pg8::EpiResid, pg8::Sched, true, true>(F.lds + RING_OFF, g, S, E);
#endif
            }
        GRID_BAR();
        if (!moe) {
            p_norm<false, false>(F, args, l, 1, F.out, (float*)(launder(F.ws) + WS_XC), nullptr, nullptr, 0);
            GRID_BAR();
            {   unsigned char* const ws = launder(F.ws); float* const XC = (float*)(ws + WS_XC); const float* const MOD = (const float*)(ws + WS_MOD); bf16* const H = (bf16*)(ws + WS_H); (void)XC; (void)MOD; (void)H;
            pg8::Gemm g{H, (const bf16*)(ws + WS_WFF), TT, 2 * FFD, 1024}; pg8::Sched S; S.init(TT / 256, 2 * FFD / 256, F.G, (int)blockIdx.x, nullptr);
                pg8::EpiSwiGLU E{(bf16*)(ws + WS_HID), FFD};
#ifndef SKIP_G_UP
                pg8::gemm_phase<pg8::EpiSwiGLU, pg8::Sched, true, true>(F.lds + RING_OFF, g, S, E);
#endif
            }
            GRID_BAR();
            {   unsigned char* const ws = launder(F.ws); float* const XC = (float*)(ws + WS_XC); const float* const MOD = (const float*)(ws + WS_MOD); bf16* const H = (bf16*)(ws + WS_H); (void)XC; (void)MOD; (void)H;
            pg8::Gemm g{(const bf16*)(ws + WS_HID), (const bf16*)(ws + WS_WFF_D_DENSE), TT, 1024, FFD}; pg8::Sched S; S.init(TT / 256, 4, F.G, (int)blockIdx.x, nullptr);
                pg8::EpiResid E{F.out, XC, F.out, XC, MOD + (size_t)l * 9 * 6144 + 5 * 1024};
#ifndef SKIP_G_DOWN
                pg8::gemm_phase<pg8::EpiResid, pg8::Sched, true, true>(F.lds + RING_OFF, g, S, E);
#endif
            }
            GRID_BAR();
        } else {
            p_norm<true, false>(F, args, l, 1, F.out, (float*)(launder(F.ws) + WS_XC), nullptr, nullptr, 0);
            GRID_BAR();

#ifndef SKIP_ROUTE
            p_route(F);
#endif

            GRID_BAR();
            const int npanels = *(LAS int*)(F.lds + LT_NPAN);
            {   unsigned char* const ws = launder(F.ws); float* const XC = (float*)(ws + WS_XC); const float* const MOD = (const float*)(ws + WS_MOD); bf16* const H = (bf16*)(ws + WS_H); (void)XC; (void)MOD; (void)H;
            pg8::Gemm g{(const bf16*)(ws + WS_AG), (const bf16*)(ws + WS_WFF), npanels * 256, 2 * FFE, 1024}; pg8::Sched S; S.init(npanels, 2 * FFE / 256, F.G, (int)blockIdx.x, (const LAS int*)(F.lds + LT_PEXP));
                pg8::EpiSwiGLU E{(bf16*)(ws + WS_HIDM), FFE};
#ifndef SKIP_G_MUP
                pg8::gemm_phase<pg8::EpiSwiGLU, pg8::Sched, true, true>(F.lds + RING_OFF, g, S, E);
#endif
            }
            GRID_BAR();
            {   unsigned char* const ws = launder(F.ws); float* const XC = (float*)(ws + WS_XC); const float* const MOD = (const float*)(ws + WS_MOD); bf16* const H = (bf16*)(ws + WS_H); (void)XC; (void)MOD; (void)H;
            pg8::Gemm g{(const bf16*)(ws + WS_HIDM), (const bf16*)(ws + WS_WFF_D_MOE), npanels * 256, 1024, FFE}; pg8::Sched S; S.init(npanels, 4, F.G, (int)blockIdx.x, (const LAS int*)(F.lds + LT_PEXP));
                pg8::EpiBf16 E{(bf16*)(ws + WS_AG), 1024};
#ifndef SKIP_G_MDOWN
                pg8::gemm_phase<pg8::EpiBf16, pg8::Sched, true, true>(F.lds + RING_OFF, g, S, E);
#endif
            }
            GRID_BAR();
        }

#undef GRID_BAR
}
__global__ void __launch_bounds__(NWAVES * 64, 2) mk_fwd(Args args) {
    extern __shared__ __attribute__((aligned(16))) unsigned char lds[];
    Frame F;
    F.lds = (LAS unsigned char*)lds;
    F.MISC = (volatile LAS unsigned*)(F.lds + MISC_OFF);
    F.tid = threadIdx.x; F.lane = F.tid & 63; F.wave = __builtin_amdgcn_readfirstlane(F.tid >> 6);
    F.G = gridDim.x; { const int bx = blockIdx.x; F.vcu = (F.G % 8 == 0) ? (bx % 8) * (F.G / 8) + bx / 8 : bx; }
    F.ws = args.ws; F.ctl = (gu32*)(args.ws + WS_CTL); F.out = args.out;
    for (int u = F.tid; u < 64; u += NWAVES * 64) ((LAS unsigned*)(F.lds + LDSCTL_OFF))[u] = 0u;
    if (F.tid < 30) ((LAS unsigned long long*)(F.lds + LT_INP))[F.tid] = (unsigned long long)args.in[F.tid];
    __syncthreads();
    XcdBarrier bar = xcd_barrier_post((unsigned*)(F.ctl + CW_BAR), F.MISC + 8);
#define GRID_BAR() xcd_barrier(bar)


#ifndef SKIP_PRO
    p_prologue(F, args);
#endif

    GRID_BAR();
    layer_body<0>(F, args, bar, lds);
    layer_body<1>(F, args, bar, lds);
    layer_body<2>(F, args, bar, lds);
    layer_body<3>(F, args, bar, lds);

#ifndef SKIP_FINAL
    p_final_combine(F, DEPTH - 1);
#endif

    if (xb_ld((unsigned*)(F.ctl + CW_BAR) + XB_TMO) != 0u && blockIdx.x == 0 && F.tid == 0) F.out[0] = __builtin_nanf("");
}

extern "C" void kernel_launch(void* const* d_in, const int* in_sizes, int n_in, void* d_out, int out_size, void* d_ws, size_t ws_size, hipStream_t stream) {
    static int grid = 0;
    if (grid == 0) {
        if (n_in != 30 || in_sizes[0] != TL * 1024 || out_size != TL * 1024 || ws_size < WS_END) { fprintf(stderr, "kernel_launch: unexpected shapes / workspace (n_in %d, ws %zu); nothing launched\n", n_in, ws_size); grid = -1; return; }
        int dev = 0, cus = 0, per_cu = 0;
        if (hipGetDevice(&dev) != hipSuccess || hipDeviceGetAttribute(&cus, hipDeviceAttributeMultiprocessorCount, dev) != hipSuccess) { grid = -1; return; }
        if (hipFuncSetAttribute((const void*)mk_fwd, hipFuncAttributeMaxDynamicSharedMemorySize, LDS_BYTES) != hipSuccess) { fprintf(stderr, "kernel_launch: hipFuncSetAttribute failed\n"); grid = -1; return; }
        if (hipOccupancyMaxActiveBlocksPerMultiprocessor(&per_cu, (const void*)mk_fwd, NWAVES * 64, LDS_BYTES) != hipSuccess || per_cu < 1) { fprintf(stderr, "kernel_launch: occupancy query reports %d blocks per CU\n", per_cu); }
        (void)hipGetLastError();
        grid = cus;
    }
    if (grid < 0) return;
    if (hipMemsetAsync((char*)d_ws + WS_CTL, 0, CTL_ZERO_BYTES, stream) != hipSuccess) return;
    Args a{};
    for (int i = 0; i < 30; ++i) a.in[i] = (const float*)d_in[i];
    a.out = (float*)d_out; a.ws = (unsigned char*)d_ws;
    hipLaunchKernelGGL(mk_fwd, dim3(grid), dim3(NWAVES * 64), LDS_BYTES, stream, a);
}
```

```cpp
#include <hip/hip_runtime.h>
#include <hip/hip_bf16.h>
#include <cstdio>
#include <cstdint>
#include <cmath>
__device__ __forceinline__ int hw_lane() { int l_; asm volatile("v_mbcnt_lo_u32_b32 %0, -1, 0\n\tv_mbcnt_hi_u32_b32 %0, -1, %0" : "=v"(l_)); return l_; }
namespace pg8 {
#define PG8_LAS __attribute__((address_space(3)))
typedef unsigned short bf16_t;
typedef short bf16x8 __attribute__((ext_vector_type(8)));
typedef float f32x4 __attribute__((ext_vector_type(4)));
typedef unsigned u32x4 __attribute__((ext_vector_type(4)));
constexpr int BM = 256, BK = 64, HALF = 128, HTB = HALF * BK * 2  , STAGE_BYTES = 8 * HTB, NXCD = 8, WGM = 8;

__host__ __device__ __forceinline__ int lds_byte(int r, int c) { const int st = (r >> 4) * 2 + (c >> 5), rr = r & 15, cc = c & 31, ob = rr * 64 + cc * 2; return st * 1024 + (ob ^ (((ob >> 9) & 1) << 5)); }
__host__ __device__ __forceinline__ void stage_rc(int b, int& R, int& C) { const int st = b / 1024, sb = b % 1024, swz = sb ^ (((sb >> 9) & 1) << 5); R = (st >> 1) * 16 + swz / 64; C = (st & 1) * 32 + (swz % 64) / 2; }
__host__ __device__ __forceinline__ int perm32(int rho) { const int n = rho >> 4, i = rho & 15; return 8 * (i >> 2) + 4 * n + (i & 3); }
__device__ __forceinline__ unsigned cvt_pk_bf16(float lo, float hi) { unsigned r; asm volatile("v_cvt_pk_bf16_f32 %0, %1, %2" : "=v"(r) : "v"(lo), "v"(hi)); return r; }
typedef float f32x2 __attribute__((ext_vector_type(2)));

struct Unit { int pm, pn, pnb, ka, nt, slice; };
struct Gemm { const bf16_t* A; const bf16_t* Bt; int M, N, K, lda, ldb; };

struct Sched {
    static constexpr bool SPLITK = false;
    int nM, nN, nwg, G, c, lora; const PG8_LAS int* pexp;
    __device__ __forceinline__ void init(int nM_, int nN_, int G_, int c_, const PG8_LAS int* pe) { nM = nM_; nN = nN_; nwg = nM * nN; G = G_; c = c_; pexp = pe; lora = 0; }
    __device__ __forceinline__ bool next(int i, Unit& u) const {
        const long L = (long)i * G + c; if (L >= nwg) return false;
        int wgid = (int)L; { const int q = nwg / NXCD, r = nwg % NXCD, xcd = wgid % NXCD, off = wgid / NXCD; wgid = (xcd < r ? xcd * (q + 1) : r * (q + 1) + (xcd - r) * q) + off; }
        const int nig = WGM * nN, gid = wgid / nig, fm = gid * WGM, gsz = (nM - fm) < WGM ? (nM - fm) : WGM;
        u.pm = fm + ((wgid % nig) % gsz); u.pn = (wgid % nig) / gsz; u.pnb = pexp ? pexp[u.pm] * nN + u.pn : u.pn;
        u.ka = lora ? ((u.pn >= 8) ? 512 : ((u.pn >= 4) ? 256 : 0)) : 0; return true;
    }
    __device__ __forceinline__ void a_ready(const Unit&) const {}
    __device__ __forceinline__ void done(const Unit&) const {}
};
struct SchedSK {
    static constexpr bool SPLITK = true;
    int nM, nwg, G, c, nsub, ntt, base, extra;
    __device__ __forceinline__ void init(int nMf_, bool ctx, int ntiles, int G_, int c_) { nM = nMf_; nwg = nMf_ * 4; G = G_; c = c_; nsub = ctx ? 128 : 0; ntt = ntiles; base = (ntiles / 4) & ~1; extra = (ntiles - 4 * base) / 2; }
    __device__ __forceinline__ bool next(int i, Unit& u) const {
        const long L = (long)i * G + c; if (L >= nwg + nsub) return false;
        const bool sub = L >= nwg;
        int wgid = sub ? 0 : (int)L; { const int q = nwg / NXCD, r = nwg % NXCD, xcd = wgid % NXCD, off = wgid / NXCD; wgid = (xcd < r ? xcd * (q + 1) : r * (q + 1) + (xcd - r) * q) + off; }
        const int nig = WGM * 4, gid = wgid / nig, fm = gid * WGM, gsz = (nM - fm) < WGM ? (nM - fm) : WGM;
        const int pmf = fm + ((wgid % nig) % gsz), pnf = (wgid % nig) / gsz;
        const int Ls = sub ? (int)(L - nwg) : 0, sl = Ls >> 5, rem = Ls & 31;
        const int kt0 = sl * base + 2 * (sl < extra ? sl : extra);
        u.pm = sub ? nM + (rem & 7) : pmf; u.pn = sub ? (rem >> 3) : pnf; u.pnb = u.pn; u.slice = sl;
        u.nt = sub ? base + ((sl < extra) ? 2 : 0) : ntt; u.ka = kt0 * (BK * 2); return true;
    }
    __device__ __forceinline__ void a_ready(const Unit&) const {}
    __device__ __forceinline__ void done(const Unit&) const {}
};

__device__ __forceinline__ float sigmoid_f(float x) { return __builtin_amdgcn_rcpf(1.0f + __builtin_amdgcn_exp2f(-1.4426950408889634f * x)); }
__device__ __forceinline__ float bf_lo(unsigned w) { return __builtin_bit_cast(float, w << 16); }
__device__ __forceinline__ float bf_hi(unsigned w) { return __builtin_bit_cast(float, w & 0xffff0000u); }

struct EpiBf16 {
    static constexpr bool PERM = true, AFTER_DRAIN = false;
    bf16_t* O; int ldc;
    __device__ __forceinline__ void operator()(const f32x4 (&acc)[2][2][4][2], const Unit& u, int wr, int wc, int fr, int fq) const {
        const int row0 = u.pm * BM + wr * 64 + fr; const int col0 = u.pn * BM + wc * 32 + 8 * fq;
#pragma unroll
        for (int ai = 0; ai < 2; ++ai)
#pragma unroll
            for (int m = 0; m < 4; ++m) { bf16_t* rowp = O + (size_t)(row0 + ai * HALF + m * 16) * ldc + col0;
#pragma unroll
                for (int bj = 0; bj < 2; ++bj) { const f32x4 v0 = acc[ai][bj][m][0], v1 = acc[ai][bj][m][1];
                    u32x4 w; w.x = cvt_pk_bf16(v0[0], v0[1]); w.y = cvt_pk_bf16(v0[2], v0[3]); w.z = cvt_pk_bf16(v1[0], v1[1]); w.w = cvt_pk_bf16(v1[2], v1[3]);
                    *(u32x4*)(rowp + bj * HALF) = w; } }
    }
};
struct EpiSwiGLU {
    static constexpr bool PERM = true, AFTER_DRAIN = false;
    bf16_t* O; int ldc; float inscale;
    __device__ __forceinline__ void operator()(const f32x4 (&acc)[2][2][4][2], const Unit& u, int wr, int wc, int fr, int fq) const {
        const int row0 = u.pm * BM + wr * 64 + fr; const int col0 = u.pn * HALF + wc * 32 + 8 * fq;
#pragma unroll
        for (int ai = 0; ai < 2; ++ai)
#pragma unroll
            for (int m = 0; m < 4; ++m) { bf16_t* rowp = O + (size_t)(row0 + ai * HALF + m * 16) * ldc + col0;
                float h[8];
#pragma unroll
                for (int n = 0; n < 2; ++n)
#pragma unroll
                    for (int j = 0; j < 4; ++j) { const float g = acc[ai][0][m][n][j] * inscale, up = acc[ai][1][m][n][j] * inscale; h[n * 4 + j] = g * sigmoid_f(g) * up; }
                u32x4 w; w.x = cvt_pk_bf16(h[0], h[1]); w.y = cvt_pk_bf16(h[2], h[3]); w.z = cvt_pk_bf16(h[4], h[5]); w.w = cvt_pk_bf16(h[6], h[7]);
                *(u32x4*)rowp = w; }
    }
};
struct EpiResid {
    static constexpr bool PERM = false, AFTER_DRAIN = false;
    const float* baseL; const float* baseC; float* outL; float* outC; const float* gate; float scale;
    __device__ __forceinline__ void operator()(const f32x4 (&acc)[2][2][4][2], const Unit& u, int wr, int wc, int fr, int fq) const {
        const float* base; float* out; int bsel;
        if (u.pm < 128) { base = baseL + (size_t)u.pm * BM * 1024; out = outL + (size_t)u.pm * BM * 1024; bsel = u.pm >> 4; }
        else { base = baseC + (size_t)(u.pm - 128) * BM * 1024; out = outC + (size_t)(u.pm - 128) * BM * 1024; bsel = 8; }
        const float* gv = gate + (size_t)bsel * 6144;
        const int col0 = u.pn * BM + wc * 32 + 4 * fq;
        f32x4 g4[2][2];
#pragma unroll
        for (int bj = 0; bj < 2; ++bj)
#pragma unroll
            for (int n = 0; n < 2; ++n) g4[bj][n] = *(const f32x4*)(gv + col0 + bj * HALF + n * 16) * scale;
#pragma unroll
        for (int ai = 0; ai < 2; ++ai)
#pragma unroll
            for (int m = 0; m < 4; ++m) { const size_t off = (size_t)(ai * HALF + wr * 64 + m * 16 + fr) * 1024 + col0;
#pragma unroll
                for (int bj = 0; bj < 2; ++bj)
#pragma unroll
                    for (int n = 0; n < 2; ++n) { const f32x4 xs = *(const f32x4*)(base + off + bj * HALF + n * 16); *(f32x4*)(out + off + bj * HALF + n * 16) = xs + g4[bj][n] * acc[ai][bj][m][n]; } }
    }
};

__device__ __forceinline__ float clamp8(float x) { return __builtin_fminf(__builtin_fmaxf(x, -440.0f), 440.0f); }
__device__ __forceinline__ unsigned pk_fp8x4(float a, float b, float c, float d) { int w = 0; w = __builtin_amdgcn_cvt_pk_fp8_f32(clamp8(a), clamp8(b), w, false); w = __builtin_amdgcn_cvt_pk_fp8_f32(clamp8(c), clamp8(d), w, true); return (unsigned)w; }
struct EpiSwiGLU8 {
    static constexpr bool PERM = true, AFTER_DRAIN = false;
    unsigned char* O; int ldc; float inscale, outscale;
    __device__ __forceinline__ void operator()(const f32x4 (&acc)[2][2][4][2], const Unit& u, int wr, int wc, int fr, int fq) const {
        const int row0 = u.pm * BM + wr * 64 + fr; const int col0 = u.pn * HALF + wc * 32 + 8 * fq;
#pragma unroll
        for (int ai = 0; ai < 2; ++ai)
#pragma unroll
            for (int m = 0; m < 4; ++m) { unsigned char* rowp = O + (size_t)(row0 + ai * HALF + m * 16) * ldc + col0;
                float h[8];
#pragma unroll
                for (int n = 0; n < 2; ++n)
#pragma unroll
                    for (int j = 0; j < 4; ++j) { const float g = acc[ai][0][m][n][j] * inscale, up = acc[ai][1][m][n][j] * inscale; h[n * 4 + j] = g * sigmoid_f(g) * up * outscale; }
                typedef unsigned u32x2e __attribute__((ext_vector_type(2)));
                *(u32x2e*)rowp = (u32x2e){pk_fp8x4(h[0], h[1], h[2], h[3]), pk_fp8x4(h[4], h[5], h[6], h[7])};  asm volatile("" ::: "memory"); }
    }
};
struct EpiBf16S {
    static constexpr bool PERM = true, AFTER_DRAIN = false;
    bf16_t* O; int ldc; float scale;
    __device__ __forceinline__ void operator()(const f32x4 (&acc)[2][2][4][2], const Unit& u, int wr, int wc, int fr, int fq) const {
        const int row0 = u.pm * BM + wr * 64 + fr; const int col0 = u.pn * BM + wc * 32 + 8 * fq;
#pragma unroll
        for (int ai = 0; ai < 2; ++ai)
#pragma unroll
            for (int m = 0; m < 4; ++m) { bf16_t* rowp = O + (size_t)(row0 + ai * HALF + m * 16) * ldc + col0;
#pragma unroll
                for (int bj = 0; bj < 2; ++bj) { const f32x4 v0 = acc[ai][bj][m][0] * scale, v1 = acc[ai][bj][m][1] * scale;
                    u32x4 w; w.x = cvt_pk_bf16(v0[0], v0[1]); w.y = cvt_pk_bf16(v0[2], v0[3]); w.z = cvt_pk_bf16(v1[0], v1[1]); w.w = cvt_pk_bf16(v1[2], v1[3]);
                    *(u32x4*)(rowp + bj * HALF) = w; } asm volatile("" ::: "memory"); }
    }
};

template <bool BASEF32> struct EpiResidB {
    static constexpr bool PERM = true, AFTER_DRAIN = false;
    const float* baseL; const float* baseC; bf16_t* xb; const float* gate; bf16_t* side; float scale;
    __device__ __forceinline__ void operator()(const f32x4 (&acc)[2][2][4][2], const Unit& u, int wr, int wc, int fr, int fq) const {
        asm volatile("" : "+v"(fr), "+v"(fq));
        const int bsel = (u.pm < 128) ? (u.pm >> 4) : 8;
        const float* base = (u.pm < 128) ? baseL + (size_t)u.pm * BM * 1024 : baseC + (size_t)(u.pm - 128) * BM * 1024;
        bf16_t* out = xb + (size_t)u.pm * BM * 1024;
        const float* gv = gate + (size_t)bsel * 6144;
        const int col0 = u.pn * BM + wc * 32 + 8 * fq;
        f32x4 g4[2][2];
#pragma unroll
        for (int bj = 0; bj < 2; ++bj)
#pragma unroll
            for (int n = 0; n < 2; ++n) g4[bj][n] = *(const f32x4*)(gv + col0 + bj * HALF + 4 * n) * scale;
        if (u.slice != 0) {
            bf16_t* so = side + ((size_t)(u.slice - 1) * 2048 + (size_t)(u.pm - 128) * BM) * 1024;
#pragma unroll
            for (int ai = 0; ai < 2; ++ai)
#pragma unroll
                for (int m = 0; m < 4; ++m) { const size_t off = (size_t)(ai * HALF + wr * 64 + m * 16 + fr) * 1024 + col0;
#pragma unroll
                    for (int bj = 0; bj < 2; ++bj) { const f32x4 o0 = g4[bj][0] * acc[ai][bj][m][0], o1 = g4[bj][1] * acc[ai][bj][m][1];
                        u32x4 ow; ow.x = cvt_pk_bf16(o0[0], o0[1]); ow.y = cvt_pk_bf16(o0[2], o0[3]); ow.z = cvt_pk_bf16(o1[0], o1[1]); ow.w = cvt_pk_bf16(o1[2], o1[3]);
                        *(u32x4*)(so + off + bj * HALF) = ow; } }
        } else
#pragma unroll
        for (int ai = 0; ai < 2; ++ai)
#pragma unroll
            for (int m = 0; m < 4; ++m) { const size_t off = (size_t)(ai * HALF + wr * 64 + m * 16 + fr) * 1024 + col0;
#pragma unroll
                for (int bj = 0; bj < 2; ++bj) { f32x4 x0, x1;
                    if (BASEF32) { x0 = *(const f32x4*)(base + off + bj * HALF); x1 = *(const f32x4*)(base + off + bj * HALF + 4); }
                    else { const u32x4 w = *(const u32x4*)(out + off + bj * HALF); x0 = (f32x4){bf_lo(w.x), bf_hi(w.x), bf_lo(w.y), bf_hi(w.y)}; x1 = (f32x4){bf_lo(w.z), bf_hi(w.z), bf_lo(w.w), bf_hi(w.w)}; }
                    const f32x4 o0 = x0 + g4[bj][0] * acc[ai][bj][m][0], o1 = x1 + g4[bj][1] * acc[ai][bj][m][1];
                    u32x4 ow; ow.x = cvt_pk_bf16(o0[0], o0[1]); ow.y = cvt_pk_bf16(o0[2], o0[3]); ow.z = cvt_pk_bf16(o1[0], o1[1]); ow.w = cvt_pk_bf16(o1[2], o1[3]);
                    *(u32x4*)(out + off + bj * HALF) = ow; } }
    }
};

struct EpiLoraAct {
    static constexpr bool PERM = true, AFTER_DRAIN = false;
    bf16_t* O; int ldc; const float* w0; const float* a0;
    __device__ __forceinline__ void operator()(const f32x4 (&acc)[2][2][4][2], const Unit& u, int wr, int wc, int fr, int fq) const {
        const int row0 = u.pm * BM + wr * 64 + fr; const int col0 = u.pn * BM + wc * 32 + 8 * fq; const int sec = u.pn >> 1;
        const int cs0 = (u.pn & 1) * 256 + wc * 32 + 8 * fq;
        f32x4 bv[2][2]; float mul = 1.0f;
        if (sec < 4) { const float* bp = (sec < 2 ? w0 + sec * 512 : a0 + (sec - 2) * 512) + cs0; mul = (sec < 2) ? 0.6065306597126334f : 1.0f;
#pragma unroll
            for (int bj = 0; bj < 2; ++bj)
#pragma unroll
                for (int n = 0; n < 2; ++n) bv[bj][n] = *(const f32x4*)(bp + bj * HALF + 4 * n); }
#pragma unroll
        for (int ai = 0; ai < 2; ++ai)
#pragma unroll
            for (int m = 0; m < 4; ++m) { bf16_t* rowp = O + (size_t)(row0 + ai * HALF + m * 16) * ldc + col0;
#pragma unroll
                for (int bj = 0; bj < 2; ++bj) { f32x4 v0 = acc[ai][bj][m][0], v1 = acc[ai][bj][m][1];
                    if (sec < 4) {
#pragma unroll
                        for (int j = 0; j < 4; ++j) { v0[j] = mul * sigmoid_f(v0[j] + bv[bj][0][j]); v1[j] = mul * sigmoid_f(v1[j] + bv[bj][1][j]); } }
                    u32x4 w; w.x = cvt_pk_bf16(v0[0], v0[1]); w.y = cvt_pk_bf16(v0[2], v0[3]); w.z = cvt_pk_bf16(v1[0], v1[1]); w.w = cvt_pk_bf16(v1[2], v1[3]);
                    *(u32x4*)(rowp + bj * HALF) = w; } }
    }
};
typedef int v8i_t __attribute__((ext_vector_type(8)));
__device__ __forceinline__ v8i_t cat8(bf16x8 a, bf16x8 b) { const u32x4 x = __builtin_bit_cast(u32x4, a), y = __builtin_bit_cast(u32x4, b); return (v8i_t){(int)x[0], (int)x[1], (int)x[2], (int)x[3], (int)y[0], (int)y[1], (int)y[2], (int)y[3]}; }
template <class Epi, class Sched, bool ALIGN_EPI = false, bool SP2 = false, bool FP8 = false>
__device__ __forceinline__ void gemm_phase(PG8_LAS unsigned char* lds, const Gemm g, const Sched& S, const Epi& E, const int wave_) {
    const int tid = wave_ * 64 + hw_lane(), wid = wave_, lane = tid & 63, wr = wid >> 2, wc = wid & 3, fr = lane & 15, fq = lane >> 4;
    int K_ = g.K; asm volatile("" : "+s"(K_));
    const int K = K_, nt = K / BK; const int lda = g.lda ? g.lda : K, ldb = g.ldb ? g.ldb : K;
    unsigned voffA[2], voffB[2];
#pragma unroll
    for (int i = 0; i < 2; ++i) { int R, C; stage_rc(tid * 16 + i * 8192, R, C); const int Rb = Epi::PERM ? ((R & ~31) + perm32(R & 31)) : R;
        voffA[i] = (unsigned)(R * lda + C) * 2u; voffB[i] = (unsigned)(Rb * ldb + C) * 2u; }
    const size_t kstep = (size_t)(BK * 2);
    const size_t hstep = (size_t)HALF * ldb * 2;
    const size_t hstepA = (size_t)HALF * lda * 2, tstepA = 2 * hstepA;
    const size_t tstep = 2 * hstep;
    const unsigned ldsw = (unsigned)wid * 1024u;
    const int aoff = lds_byte(wr * 64 + fr, fq * 8), boff = lds_byte(wc * 32 + fr, fq * 8);
#define PG8_SA(b, h) (((b) * 2 + (h)) * HTB)
#define PG8_SB(b, h) ((4 + (b) * 2 + (h)) * HTB)
#define PG8_STAGE(bufoff, gbase, voff) do { _Pragma("unroll") for (int _i = 0; _i < 2; ++_i) \
        __builtin_amdgcn_global_load_lds((const unsigned*)((const char*)(gbase) + (voff)[_i]), (PG8_LAS unsigned*)(lds + (bufoff) + ldsw + _i * 8192), 16, 0, 0); } while (0)
#define PG8_LDA(dst, b, h) do { if constexpr (FP8) { _Pragma("unroll") for (int m = 0; m < 4; ++m) { dst##8[m].lo = *(const PG8_LAS v4i_t*)(lds + PG8_SA(b, h) + aoff + m * 2048); dst##8[m].hi = *(const PG8_LAS v4i_t*)(lds + PG8_SA(b, h) + aoff + m * 2048 + 1024); } } \
        else { _Pragma("unroll") for (int m = 0; m < 4; ++m) _Pragma("unroll") for (int k = 0; k < 2; ++k) dst[FP8 ? 0 : m][k] = *(const PG8_LAS bf16x8*)(lds + PG8_SA(b, h) + aoff + m * 2048 + k * 1024); } } while (0)
#define PG8_LDB(dst, b, h) do { if constexpr (FP8) { _Pragma("unroll") for (int n = 0; n < 2; ++n) { dst##8[n].lo = *(const PG8_LAS v4i_t*)(lds + PG8_SB(b, h) + boff + n * 2048); dst##8[n].hi = *(const PG8_LAS v4i_t*)(lds + PG8_SB(b, h) + boff + n * 2048 + 1024); } } \
        else { _Pragma("unroll") for (int n = 0; n < 2; ++n) _Pragma("unroll") for (int k = 0; k < 2; ++k) dst[n][k] = *(const PG8_LAS bf16x8*)(lds + PG8_SB(b, h) + boff + n * 2048 + k * 1024); } } while (0)
#define PG8_MMA(ai, bj, At, Bt) do { __builtin_amdgcn_s_setprio(1); if constexpr (FP8) { _Pragma("unroll") for (int m = 0; m < 4; ++m) _Pragma("unroll") for (int n = 0; n < 2; ++n) \
        asm volatile("v_mfma_f32_16x16x128_f8f6f4 %0, %1, %2, %0" : "+v"(acc[ai][bj][m][n]) : "v"(Bt##8[n]), "v"(At##8[m])); } \
        else { _Pragma("unroll") for (int m = 0; m < 4; ++m) _Pragma("unroll") for (int n = 0; n < 2; ++n) _Pragma("unroll") for (int k = 0; k < 2; ++k) \
        acc[ai][bj][m][n] = __builtin_amdgcn_mfma_f32_16x16x32_bf16(Bt[n][k], At[FP8 ? 0 : m][k], acc[ai][bj][m][n], 0, 0, 0); } __builtin_amdgcn_s_setprio(0); } while (0)
#define PG8_WAIT_V(n) asm volatile("s_waitcnt vmcnt(" #n ")" ::: "memory")
#define PG8_WAIT_L(n) asm volatile("s_waitcnt lgkmcnt(" #n ")" ::: "memory")
#define PG8_BAR __builtin_amdgcn_s_barrier()
#define PG8_SCHED __builtin_amdgcn_sched_barrier(0)
    Unit cur, nxt; int ui = 0;
    if (!S.next(0, cur)) return;
    f32x4 acc[2][2][4][2];
#pragma unroll
    for (int a = 0; a < 2; ++a)
#pragma unroll
        for (int b = 0; b < 2; ++b)
#pragma unroll
            for (int m = 0; m < 4; ++m)
#pragma unroll
                for (int n = 0; n < 2; ++n) acc[a][b][m][n] = (f32x4){0.f, 0.f, 0.f, 0.f};
    bf16x8 At[FP8 ? 1 : 4][2], B0[2][2], B1[2][2];
    v8i_t At8[FP8 ? 4 : 1], B08[2], B18[2];
    typedef int v4i_t __attribute__((ext_vector_type(4)));
    const char* cA = (const char*)g.A + (size_t)cur.pm * tstepA + cur.ka; const char* cB = (const char*)g.Bt + (size_t)cur.pnb * tstep + (Sched::SPLITK ? cur.ka : 0);
    S.a_ready(cur);
    if constexpr (SP2) {
        PG8_STAGE(PG8_SB(0, 0), cB, voffB); PG8_STAGE(PG8_SB(0, 1), cB + hstep, voffB); PG8_STAGE(PG8_SA(0, 0), cA, voffA); PG8_STAGE(PG8_SA(0, 1), cA + hstepA, voffA);
        if (wr == 1) PG8_BAR;
        PG8_WAIT_V(2); PG8_BAR;
        PG8_STAGE(PG8_SB(1, 0), cB + kstep, voffB); PG8_STAGE(PG8_SA(1, 0), cA + kstep, voffA); PG8_STAGE(PG8_SB(1, 1), cB + hstep + kstep, voffB);
        PG8_WAIT_V(6); PG8_BAR;
    } else {
        PG8_STAGE(PG8_SB(0, 0), cB, voffB); PG8_STAGE(PG8_SA(0, 0), cA, voffA); PG8_STAGE(PG8_SB(0, 1), cB + hstep, voffB); PG8_STAGE(PG8_SA(0, 1), cA + hstepA, voffA);
        if (wr == 1) PG8_BAR;
        PG8_WAIT_V(4); PG8_BAR;
        PG8_STAGE(PG8_SB(1, 0), cB + kstep, voffB); PG8_STAGE(PG8_SA(1, 0), cA + kstep, voffA); PG8_STAGE(PG8_SB(1, 1), cB + hstep + kstep, voffB);
        PG8_WAIT_V(6); PG8_BAR;
    }
    for (;;) {
        const bool has_next = S.next(ui + 1, nxt);
        const char* nA = has_next ? (const char*)g.A + (size_t)nxt.pm * tstepA + nxt.ka : cA; const char* nB = has_next ? (const char*)g.Bt + (size_t)nxt.pnb * tstep + (Sched::SPLITK ? nxt.ka : 0) : cB;
        const int ntc = Sched::SPLITK ? cur.nt : nt;
        for (int t = 0; t < ntc; t += 2) {
            const bool last = (t == ntc - 2);
            const char* a1 = cA + (size_t)(t + 1) * kstep;
            const char* a2 = last ? nA : cA + (size_t)(t + 2) * kstep; const char* b2 = last ? nB : cB + (size_t)(t + 2) * kstep;
            const char* a3 = a2 + kstep; const char* b3 = b2 + kstep;
            if (last && has_next) S.a_ready(nxt);
            if constexpr (SP2) {
            PG8_LDB(B0, 0, 0); PG8_LDB(B1, 0, 1); PG8_SCHED; PG8_LDA(At, 0, 0); PG8_STAGE(PG8_SA(1, 1), a1 + hstepA, voffA);
            PG8_WAIT_V(8); PG8_WAIT_L(0); PG8_BAR; PG8_MMA(0, 0, At, B0); PG8_MMA(0, 1, At, B1); PG8_BAR; PG8_SCHED;
            PG8_LDA(At, 0, 1); PG8_STAGE(PG8_SB(0, 0), b2, voffB); PG8_STAGE(PG8_SB(0, 1), b2 + hstep, voffB); PG8_STAGE(PG8_SA(0, 0), a2, voffA);
            PG8_WAIT_V(8); PG8_WAIT_L(0); PG8_BAR; PG8_MMA(1, 0, At, B0); PG8_MMA(1, 1, At, B1); PG8_BAR; PG8_SCHED;
            PG8_LDB(B0, 1, 0); PG8_LDB(B1, 1, 1); PG8_SCHED; PG8_LDA(At, 1, 0); PG8_STAGE(PG8_SA(0, 1), a2 + hstepA, voffA);
            PG8_WAIT_V(8); PG8_WAIT_L(0); PG8_BAR; PG8_MMA(0, 0, At, B0); PG8_MMA(0, 1, At, B1); PG8_BAR; PG8_SCHED;
            PG8_LDA(At, 1, 1); PG8_STAGE(PG8_SB(1, 0), b3, voffB); PG8_STAGE(PG8_SB(1, 1), b3 + hstep, voffB); PG8_STAGE(PG8_SA(1, 0), a3, voffA);
            PG8_WAIT_V(8); PG8_WAIT_L(0); PG8_BAR; PG8_MMA(1, 0, At, B0); PG8_MMA(1, 1, At, B1); PG8_BAR; PG8_SCHED;
            } else {
            PG8_LDB(B0, 0, 0); PG8_SCHED; PG8_LDA(At, 0, 0); PG8_STAGE(PG8_SA(1, 1), a1 + hstepA, voffA);
            PG8_WAIT_L(8); PG8_BAR; PG8_WAIT_L(0); PG8_MMA(0, 0, At, B0); PG8_BAR; PG8_SCHED;
            PG8_LDB(B1, 0, 1); PG8_STAGE(PG8_SB(0, 0), b2, voffB);
            PG8_BAR; PG8_WAIT_L(0); PG8_MMA(0, 1, At, B1); PG8_BAR;
            PG8_LDA(At, 0, 1); PG8_STAGE(PG8_SA(0, 0), a2, voffA);
            PG8_BAR; PG8_WAIT_L(0); PG8_MMA(1, 0, At, B0); PG8_BAR; PG8_SCHED;
            PG8_STAGE(PG8_SB(0, 1), b2 + hstep, voffB);
            PG8_WAIT_V(6); PG8_BAR; PG8_MMA(1, 1, At, B1); PG8_BAR;
            PG8_LDB(B0, 1, 0); PG8_SCHED; PG8_LDA(At, 1, 0); PG8_STAGE(PG8_SA(0, 1), a2 + hstepA, voffA);
            PG8_WAIT_L(8); PG8_BAR; PG8_WAIT_L(0); PG8_MMA(0, 0, At, B0); PG8_BAR; PG8_SCHED;
            PG8_LDB(B1, 1, 1); PG8_STAGE(PG8_SB(1, 0), b3, voffB);
            PG8_BAR; PG8_WAIT_L(0); PG8_MMA(0, 1, At, B1); PG8_BAR;
            PG8_LDA(At, 1, 1); PG8_STAGE(PG8_SA(1, 0), a3, voffA);
            PG8_BAR; PG8_WAIT_L(0); PG8_MMA(1, 0, At, B0); PG8_BAR; PG8_SCHED;
            PG8_STAGE(PG8_SB(1, 1), b3 + hstep, voffB);
            PG8_WAIT_V(6); PG8_BAR; PG8_MMA(1, 1, At, B1); PG8_BAR;
            }
        }
        if constexpr (ALIGN_EPI) { if (wr == 0) PG8_BAR; }
        if constexpr (!Epi::AFTER_DRAIN) { E(acc, cur, wr, wc, fr, fq); S.done(cur); }
        if (!has_next) break;
#pragma unroll
        for (int a = 0; a < 2; ++a)
#pragma unroll
            for (int b = 0; b < 2; ++b)
#pragma unroll
                for (int m = 0; m < 4; ++m)
#pragma unroll
                    for (int n = 0; n < 2; ++n) acc[a][b][m][n] = (f32x4){0.f, 0.f, 0.f, 0.f};
        cur = nxt; cA = nA; cB = nB; ++ui;
        if constexpr (ALIGN_EPI) { if (wr == 1) PG8_BAR; }
    }
    PG8_WAIT_V(0);
    if constexpr (!ALIGN_EPI) { if (wr == 0) PG8_BAR; }
    PG8_BAR;
    if constexpr (Epi::AFTER_DRAIN) { E.fused(acc, cur, wr, wc, fr, fq, lds, wid, lane); S.done(cur); }
#undef PG8_SA
#undef PG8_SB
#undef PG8_STAGE
#undef PG8_LDA
#undef PG8_LDB
#undef PG8_MMA
#undef PG8_WAIT_V
#undef PG8_WAIT_L
#undef PG8_BAR
#undef PG8_SCHED
}
}
#include <hip/hip_bf16.h>
#include <cmath>
namespace attn_body {
using bf16=__hip_bfloat16;
using bf16x8=__attribute__((ext_vector_type(8)))short;
using s16x4=__attribute__((ext_vector_type(4)))short;
using f32x16=__attribute__((ext_vector_type(16)))float;
using u32x4=__attribute__((ext_vector_type(4)))unsigned;
constexpr int D=64,DM=1024,KP=128;
constexpr int NW=8,QBLK=32,QB=QBLK*NW,KVBLK=64;
constexpr int ATTN_PITCH=DM, ATTN_UNIT_ROWS=QB;
__device__ __forceinline__ int crow(int r,int hi){return (r&3)+8*(r>>2)+4*hi;}
#define SBAR() __builtin_amdgcn_sched_barrier(0)
__device__ __forceinline__ void cmask(f32x16&p0,f32x16&p1,int jb,int qrel,int hi){
  const float NEG=-INFINITY; int kb=64*jb+4*hi;
  #pragma unroll
  for(int r=0;r<16;++r){int kv=kb+(r&3)+8*(r>>2); if(kv>qrel)p0[r]=NEG; if(kv+32>qrel)p1[r]=NEG;}
}

constexpr int NSLOT=3, SLOTB=8192;
constexpr int LDS_K=0, LDS_V=NSLOT*SLOTB, LDS_WS=2*NSLOT*SLOTB, LDS_OST=LDS_WS+NW*64*4, LDS_BYTES=LDS_OST+NW*4096;
constexpr float C2=0.125f*1.4426950408889634f;
__device__ __forceinline__ void glds16(const void*gsrc,unsigned lds_dst){unsigned keep;
  asm volatile("s_mov_b32 %0, m0\n\ts_mov_b32 m0, %2\n\ts_nop 0\n\tglobal_load_lds_dwordx4 %1, off\n\ts_mov_b32 m0, %0":"=&s"(keep):"v"(gsrc),"s"(lds_dst):"memory");}
__device__ __forceinline__ float max3f(float a,float b,float c){float r;asm("v_max3_f32 %0, %1, %2, %3":"=v"(r):"v"(a),"v"(b),"v"(c));return r;}
__device__ __forceinline__ float max2f(float a,float b){float r;asm("v_max_f32_e32 %0, %1, %2":"=v"(r):"v"(a),"v"(b));return r;}
__device__ __forceinline__ float fadd_s(float a,float b){float r;asm("v_add_f32_e32 %0, %1, %2":"=v"(r):"v"(a),"v"(b));return r;}
__device__ __forceinline__ float fsub_s(float a,float b){float r;asm("v_sub_f32_e32 %0, %1, %2":"=v"(r):"v"(a),"v"(b));return r;}
typedef float f32x2_t __attribute__((ext_vector_type(2))); typedef __bf16 bf16x2_t __attribute__((ext_vector_type(2)));
__device__ __forceinline__ unsigned cvtpk_s(float lo,float hi){f32x2_t v={lo,hi};bf16x2_t b=__builtin_convertvector(v,bf16x2_t);return __builtin_bit_cast(unsigned,b);}
#define WAIT_BAR(N) asm volatile("s_waitcnt vmcnt(" #N ") lgkmcnt(0)\n\ts_barrier":::"memory")

__device__ __forceinline__ void qkt(f32x16&p0,f32x16&p1,const char*Kslot,const bf16x8*qr,const f32x16&negm,int r32,int hi){
  const char*kb=Kslot+hi*1024+r32*16;
  #pragma unroll
  for(int d0=0;d0<4;++d0){
    const bf16x8 b0=*reinterpret_cast<const bf16x8*>(kb+d0*2048);
    const bf16x8 b1=*reinterpret_cast<const bf16x8*>(kb+d0*2048+512);
    if(d0==0){p0=__builtin_amdgcn_mfma_f32_32x32x16_bf16(b0,qr[0],negm,0,0,0);p1=__builtin_amdgcn_mfma_f32_32x32x16_bf16(b1,qr[0],negm,0,0,0);}
    else{p0=__builtin_amdgcn_mfma_f32_32x32x16_bf16(b0,qr[d0],p0,0,0,0);p1=__builtin_amdgcn_mfma_f32_32x32x16_bf16(b1,qr[d0],p1,0,0,0);}}
}
typedef __attribute__((address_space(3))) const char* lds_cptr;
typedef short v4i16_t __attribute__((ext_vector_type(4)));
__device__ __forceinline__ void kload8(bf16x8*kf,lds_cptr kp){
  kf[0]=*(const __attribute__((address_space(3))) bf16x8*)(kp);      kf[1]=*(const __attribute__((address_space(3))) bf16x8*)(kp+512);
  kf[2]=*(const __attribute__((address_space(3))) bf16x8*)(kp+2048); kf[3]=*(const __attribute__((address_space(3))) bf16x8*)(kp+2560);
  kf[4]=*(const __attribute__((address_space(3))) bf16x8*)(kp+4096); kf[5]=*(const __attribute__((address_space(3))) bf16x8*)(kp+4608);
  kf[6]=*(const __attribute__((address_space(3))) bf16x8*)(kp+6144); kf[7]=*(const __attribute__((address_space(3))) bf16x8*)(kp+6656);
}
__device__ __forceinline__ void kload2(bf16x8*kf,lds_cptr kp,int j){ kf[2*j]=*(const __attribute__((address_space(3))) bf16x8*)(kp+j*2048); kf[2*j+1]=*(const __attribute__((address_space(3))) bf16x8*)(kp+j*2048+512); }
__device__ __forceinline__ s16x4 vtr(lds_cptr p){ return __builtin_bit_cast(s16x4,__builtin_amdgcn_ds_read_tr16_b64_v4i16((__attribute__((address_space(3))) v4i16_t*)p)); }
__device__ __forceinline__ float rowmax(const f32x16&p0,const f32x16&p1){
  float a=max3f(p0[0],p0[1],p1[0]),b=max3f(p0[2],p0[3],p1[1]);a=max3f(a,p1[2],p1[3]);
  #pragma unroll
  for(int r=4;r<16;r+=4){a=max3f(a,p0[r],p0[r+1]);b=max3f(b,p0[r+2],p0[r+3]);a=max3f(a,p1[r],p1[r+1]);b=max3f(b,p1[r+2],p1[r+3]);}
  const float m=max2f(a,b);
  auto rr=__builtin_amdgcn_permlane32_swap(__float_as_uint(m),__float_as_uint(m),false,false);
  return max2f(__uint_as_float(rr[0]),__uint_as_float(rr[1]));
}
__device__ __forceinline__ void pv(f32x16*o,int vb,bf16x8 pa0,bf16x8 pa1,bf16x8 pa2,bf16x8 pa3){
  #pragma unroll
  for(int d0=0;d0<2;++d0){s16x4 lo[4],hi[4];
    #pragma unroll
    for(int ks=0;ks<4;++ks){
      asm volatile("ds_read_b64_tr_b16 %0,%1 offset:%c2":"=&v"(lo[ks]):"v"(vb),"i"(d0*4096+ks*1024):"memory");
      asm volatile("ds_read_b64_tr_b16 %0,%1 offset:%c2":"=&v"(hi[ks]):"v"(vb),"i"(d0*4096+ks*1024+512):"memory");}
    asm volatile("s_waitcnt lgkmcnt(0)":::"memory");SBAR();
    #define PK(k) (bf16x8){lo[k][0],lo[k][1],lo[k][2],lo[k][3],hi[k][0],hi[k][1],hi[k][2],hi[k][3]}
    o[d0]=__builtin_amdgcn_mfma_f32_32x32x16_bf16(pa0,PK(0),o[d0],0,0,0);
    o[d0]=__builtin_amdgcn_mfma_f32_32x32x16_bf16(pa1,PK(1),o[d0],0,0,0);
    o[d0]=__builtin_amdgcn_mfma_f32_32x32x16_bf16(pa2,PK(2),o[d0],0,0,0);
    o[d0]=__builtin_amdgcn_mfma_f32_32x32x16_bf16(pa3,PK(3),o[d0],0,0,0);
    #undef PK
  }
}

#ifndef ATTN_STORE16
#define ATTN_STORE16(p,v) (*(u32x4*)(p)=(v))
#endif
template<int THRL> __device__ __forceinline__ void attn_unit(long qrow0,int hcol,long kvrow0,int kvcol,int NT,const bf16*Q,const bf16*__restrict__ K,const bf16*__restrict__ V,bf16*O,char*shm,const int wave_){
  const int tid=wave_*64+hw_lane(),lane=tid&63,r32=lane&31,hi=lane>>5; const int wid=wave_;
  const bf16*Qw=Q+(qrow0+wid*QBLK)*DM+hcol;
  const bf16*Kh=K+kvrow0*KP+kvcol,*Vh=V+kvrow0*KP+kvcol;
  const unsigned lds0=(unsigned)(uintptr_t)shm;
  float*wsf=(float*)(shm+LDS_WS)+wid*64;
  const bf16*ksrc=Kh+(long)lane*KP+wid*8;
  const bf16*vsrc=Vh+(long)(16*(wid&3)+(lane>>2))*KP+(wid>>2)*32+(lane&3)*8;
  const unsigned kdst=lds0+LDS_K+wid*1024, vdst=lds0+LDS_V+wid*1024;
  #define DMA_K(t,slot) glds16(ksrc+(long)(t)*KVBLK*KP,(unsigned)__builtin_amdgcn_readfirstlane(kdst+(slot)))
  #define DMA_V(t,slot) glds16(vsrc+(long)(t)*KVBLK*KP,(unsigned)__builtin_amdgcn_readfirstlane(vdst+(slot)))
  const int vb0=(int)(lds0+LDS_V)+((lane>>4)&1)*32+(lane&3)*8+(4*hi+((lane&15)>>2))*64;
  const char*Kbase=shm+LDS_K; bf16x8 kf[8];
  const lds_cptr shm3=(lds_cptr)shm; const lds_cptr kp0=shm3+LDS_K+hi*1024+r32*16; const lds_cptr vp0=shm3+LDS_V+((lane>>4)&1)*32+(lane&3)*8+(4*hi+((lane&15)>>2))*64;
  DMA_K(0,0);DMA_V(0,0);DMA_K(1,SLOTB);
  bf16x8 qr[4];
  #pragma unroll
  for(int d0=0;d0<4;++d0)qr[d0]=*reinterpret_cast<const bf16x8*>(&Qw[(long)r32*DM+d0*16+hi*8]);
  float mhat=0.f,l_reg=0.f;f32x16 o[2];o[0]=f32x16{};o[1]=f32x16{};f32x16 negm=f32x16{};asm volatile("":"+v"(negm));
  #define CMASK(P0,P1,t) do{}while(0)
  bool resc=false;
  #define START(P0,P1) do{ const float rm=rowmax(P0,P1); resc=false; \
    { const float dl=rm; mhat=fadd_s(mhat,dl); \
      _Pragma("unroll") for(int r=0;r<16;++r){P0[r]=fsub_s(P0[r],dl);P1[r]=fsub_s(P1[r],dl);} \
      _Pragma("unroll") for(int r=0;r<16;++r)negm[r]=-mhat; asm volatile("":"+v"(negm)); } \
    _Pragma("unroll") for(int r=0;r<16;++r)P0[r]=__builtin_amdgcn_exp2f(P0[r]); }while(0)
  #define RESC() do{ if(resc){ asm volatile("s_waitcnt lgkmcnt(0)":::"memory"); \
      _Pragma("unroll") for(int d_=0;d_<2;++d_) _Pragma("unroll") for(int r=0;r<16;++r)o[d_][r]*=wsf[crow(r,hi)]; } }while(0)
  f32x16 pA0,pA1,pB0,pB1;
  int sl_prev=0,sl_cur=0,sl_next=SLOTB;
  #define ROT() do{sl_prev=sl_cur;sl_cur=sl_next;sl_next=(sl_next==(NSLOT-1)*SLOTB)?0:sl_next+SLOTB;}while(0)
  DMA_K(2,2*SLOTB);
  WAIT_BAR(3);
  qkt(pA0,pA1,Kbase,qr,negm,r32,hi);asm volatile("s_nop 15\n\ts_nop 7":"+v"(pA0),"+v"(pA1));CMASK(pA0,pA1,0);
  START(pA0,pA1);
  _Pragma("unroll") for(int r=0;r<16;++r)pA1[r]=__builtin_amdgcn_exp2f(pA1[r]);
  WAIT_BAR(0);
  DMA_K(3,0);DMA_V(1,SLOTB);
  ROT();
  kload8(kf,kp0+sl_cur);
  WAIT_BAR(2);
  s16x4 vlo[8],vhi[8]; u32x4 pw0,pw1,pw2,pw3;
  #define PKW(P,B) cvtpk_s(P[B],P[B+1])
  #define PAF(k) __builtin_bit_cast(bf16x8,pw##k)
  #define VFR(i) (bf16x8){vlo[i][0],vlo[i][1],vlo[i][2],vlo[i][3],vhi[i][0],vhi[i][1],vhi[i][2],vhi[i][3]}
  #define PIN(x) asm volatile("":"+v"(x))
  #define MX3(a,b,c) __builtin_fmaxf(__builtin_fmaxf((a),(b)),(c))
  #define GAPA(MF,A0,A1,A2,A3,W0,W1,PW) do{ MF; sacc+=A0; sacc+=A1; sacc+=A2; sacc+=A3; PIN(sacc); W0; W1; PIN(PW); SBAR(); }while(0)
  #define EX(v) __builtin_amdgcn_exp2f(v)
  #define GAPB(MF,X,B) do{ MF; X[B]=EX(X[B]); X[B+1]=EX(X[B+1]); X[B+2]=EX(X[B+2]); X[B+3]=EX(X[B+3]); PIN(X); SBAR(); }while(0)
  #define VRD(i) do{ vlo[i]=vtr(vp_+(((i)>>2)*4096+((i)&3)*1024)); vhi[i]=vtr(vp_+(((i)>>2)*4096+((i)&3)*1024+512)); }while(0)
  #define KRD(G,j) do{ if(G){ kload2(kf,kp0+sl_next,j); SBAR(); } }while(0)
  #define STEP(C0,C1,P0,P1,t,GK,GV,GL) do{ SBAR(); \
    const lds_cptr vp_=vp0+sl_prev; \
    VRD(0); SBAR(); float sacc=(P0[0]+P0[1]); \
    GAPA(C0=__builtin_amdgcn_mfma_f32_32x32x16_bf16(kf[0],qr[0],negm,0,0,0), P0[2],P0[3],P0[4],P0[5],     pw0[0]=PKW(P0,0), pw0[1]=PKW(P0,2), pw0); \
    VRD(4); SBAR(); GAPA(C1=__builtin_amdgcn_mfma_f32_32x32x16_bf16(kf[1],qr[0],negm,0,0,0), P0[6],P0[7],P0[8],P0[9],     pw0[2]=PKW(P0,4), pw0[3]=PKW(P0,6), pw0); \
    VRD(1); SBAR(); GAPA(C0=__builtin_amdgcn_mfma_f32_32x32x16_bf16(kf[2],qr[1],C0,0,0,0),   P0[10],P0[11],P0[12],P0[13], pw1[0]=PKW(P0,8), pw1[1]=PKW(P0,10), pw1); \
    VRD(5); SBAR(); GAPA(C1=__builtin_amdgcn_mfma_f32_32x32x16_bf16(kf[3],qr[1],C1,0,0,0),   P0[14],P0[15],P1[0],P1[1],   pw1[2]=PKW(P0,12),pw1[3]=PKW(P0,14), pw1); \
    VRD(2); SBAR(); GAPA(C0=__builtin_amdgcn_mfma_f32_32x32x16_bf16(kf[4],qr[2],C0,0,0,0),   P1[2],P1[3],P1[4],P1[5],     pw2[0]=PKW(P1,0), pw2[1]=PKW(P1,2), pw2); \
    VRD(6); SBAR(); GAPA(C1=__builtin_amdgcn_mfma_f32_32x32x16_bf16(kf[5],qr[2],C1,0,0,0),   P1[6],P1[7],P1[8],P1[9],     pw2[2]=PKW(P1,4), pw2[3]=PKW(P1,6), pw2); \
    VRD(3); SBAR(); GAPA(C0=__builtin_amdgcn_mfma_f32_32x32x16_bf16(kf[6],qr[3],C0,0,0,0),   P1[10],P1[11],P1[12],P1[13], pw3[0]=PKW(P1,8), pw3[1]=PKW(P1,10), pw3); \
    VRD(7); SBAR(); GAPA(C1=__builtin_amdgcn_mfma_f32_32x32x16_bf16(kf[7],qr[3],C1,0,0,0),   P1[14],P1[15],0.f,0.f,       pw3[2]=PKW(P1,12),pw3[3]=PKW(P1,14), pw3); \
    l_reg+=sacc; \
    if(GK){DMA_K((t)+3,sl_cur);} if(GV){DMA_V((t)+1,sl_next);} \
    CMASK(C0,C1,t); \
    { float a=MX3(C0[0],C0[1],C1[0]),b=MX3(C0[2],C0[3],C1[1]); a=MX3(a,C1[2],C1[3]); \
      _Pragma("unroll") for(int r=4;r<16;r+=4){a=MX3(a,C0[r],C0[r+1]);b=MX3(b,C0[r+2],C0[r+3]);a=MX3(a,C1[r],C1[r+1]);b=MX3(b,C1[r+2],C1[r+3]);} \
      float rm=__builtin_fmaxf(a,b); { auto rr=__builtin_amdgcn_permlane32_swap(__float_as_uint(rm),__float_as_uint(rm),false,false); rm=__builtin_fmaxf(__uint_as_float(rr[0]),__uint_as_float(rr[1])); } \
      resc=false; \
      if(__builtin_expect(__any(rm>(float)THRL),0)){ const float dl=__builtin_fmaxf(rm,0.f); mhat+=dl; \
        _Pragma("unroll") for(int r=0;r<16;++r){C0[r]-=dl;C1[r]-=dl;} \
        _Pragma("unroll") for(int r=0;r<16;++r)negm[r]=-mhat; asm volatile("":"+v"(negm)); \
        const float f=__builtin_amdgcn_exp2f(-dl); l_reg*=f; if(hi==0)wsf[r32]=f; resc=true; } } \
    SBAR(); \
    GAPB(o[0]=__builtin_amdgcn_mfma_f32_32x32x16_bf16(PAF(0),VFR(0),o[0],0,0,0), C0,0); \
    GAPB(o[1]=__builtin_amdgcn_mfma_f32_32x32x16_bf16(PAF(0),VFR(4),o[1],0,0,0), C0,4); \
    KRD(GL,0); GAPB(o[0]=__builtin_amdgcn_mfma_f32_32x32x16_bf16(PAF(1),VFR(1),o[0],0,0,0), C0,8); \
    KRD(GL,1); GAPB(o[1]=__builtin_amdgcn_mfma_f32_32x32x16_bf16(PAF(1),VFR(5),o[1],0,0,0), C0,12); \
    KRD(GL,2); GAPB(o[0]=__builtin_amdgcn_mfma_f32_32x32x16_bf16(PAF(2),VFR(2),o[0],0,0,0), C1,0); \
    KRD(GL,3); GAPB(o[1]=__builtin_amdgcn_mfma_f32_32x32x16_bf16(PAF(2),VFR(6),o[1],0,0,0), C1,4); \
    GAPB(o[0]=__builtin_amdgcn_mfma_f32_32x32x16_bf16(PAF(3),VFR(3),o[0],0,0,0), C1,8); \
    GAPB(o[1]=__builtin_amdgcn_mfma_f32_32x32x16_bf16(PAF(3),VFR(7),o[1],0,0,0), C1,12); \
    }while(0)
  int t=1;
  #undef CMASK
  #define CMASK(P0,P1,t) do{}while(0)
  for(;t+5<NT;t+=2){
    STEP(pB0,pB1,pA0,pA1,t,true,true,true);     WAIT_BAR(2); RESC(); ROT();
    STEP(pA0,pA1,pB0,pB1,t+1,true,true,true);   WAIT_BAR(2); RESC(); ROT();
  }
  #undef CMASK
  #define CMASK(P0,P1,t) do{}while(0)
  #define ENDW(tt) do{ if((tt)+3<NT){WAIT_BAR(2);} else if((tt)+2<NT){WAIT_BAR(1);} else {WAIT_BAR(0);} }while(0)
  for(;t+1<NT;t+=2){
    STEP(pB0,pB1,pA0,pA1,t,(t+3<NT),(t+1<NT),(t+1<NT));       ENDW(t);   RESC(); ROT();
    STEP(pA0,pA1,pB0,pB1,t+1,(t+4<NT),(t+2<NT),(t+2<NT));     ENDW(t+1); RESC(); ROT();
  }
  STEP(pB0,pB1,pA0,pA1,NT-1,false,false,false); RESC();
  { float sacc=pB0[0]+pB0[1]; _Pragma("unroll") for(int r=2;r<16;++r)sacc+=pB0[r]; _Pragma("unroll") for(int r=0;r<16;++r)sacc+=pB1[r]; l_reg+=sacc;
    pw0=(u32x4){PKW(pB0,0),PKW(pB0,2),PKW(pB0,4),PKW(pB0,6)};pw1=(u32x4){PKW(pB0,8),PKW(pB0,10),PKW(pB0,12),PKW(pB0,14)};pw2=(u32x4){PKW(pB1,0),PKW(pB1,2),PKW(pB1,4),PKW(pB1,6)};pw3=(u32x4){PKW(pB1,8),PKW(pB1,10),PKW(pB1,12),PKW(pB1,14)};
    SBAR(); pv(o,vb0+sl_cur,PAF(0),PAF(1),PAF(2),PAF(3)); }
  #undef PKW
  #undef PAF
  #undef VFR
  #undef PIN
  #undef MX3
  #undef GAPA
  #undef GAPB
  #undef EX
  #undef VRD
  #undef KRD
  #undef STEP
  #undef ENDW
  {auto rr=__builtin_amdgcn_permlane32_swap(__float_as_uint(l_reg),__float_as_uint(l_reg),false,false);l_reg=__uint_as_float(rr[0])+__uint_as_float(rr[1]);}
  if(hi==0)wsf[32+r32]=l_reg;asm volatile("s_waitcnt lgkmcnt(0)":::"memory");
  float rli[16];
  #pragma unroll
  for(int r=0;r<16;++r)rli[r]=__builtin_amdgcn_rcpf(wsf[32+crow(r,hi)]);
  bf16*Ow=O+(qrow0+wid*QBLK)*DM+hcol;
  { bf16*stg=(bf16*)(shm+LDS_OST)+wid*2048;
    #pragma unroll
    for(int r=0;r<16;++r){const int orow=crow(r,hi);
      #pragma unroll
      for(int d0=0;d0<2;++d0)stg[orow*64+d0*32+r32]=__float2bfloat16(o[d0][r]*rli[r]);}
    asm volatile("s_waitcnt lgkmcnt(0)":::"memory");
    #pragma unroll
    for(int i=0;i<4;++i){const int row=i*8+(lane>>3),ch=lane&7; const u32x4 v=*(const u32x4*)(stg+row*64+ch*8); ATTN_STORE16(Ow+(long)row*DM+ch*8,v);} }
  asm volatile("s_waitcnt lgkmcnt(0)\n\ts_barrier":::"memory");
  #undef DMA_K
  #undef DMA_V
  #undef CMASK
  #undef START
  #undef RESC
  #undef ROT
}
constexpr int ATTN_LDS_BYTES=LDS_BYTES;
#undef SBAR
#undef WAIT_BAR
}
#define GAS __attribute__((address_space(1)))
#define LAS __attribute__((address_space(3)))
typedef unsigned short bf16;
typedef unsigned v4u __attribute__((ext_vector_type(4)));
typedef float f32x4 __attribute__((ext_vector_type(4)));
typedef short bf16x8 __attribute__((ext_vector_type(8)));
typedef GAS unsigned gu32;
typedef GAS unsigned long long gu64;
#define RLX_AGENT __ATOMIC_RELAXED, __HIP_MEMORY_SCOPE_AGENT
#define LDS_WAIT() asm volatile("s_waitcnt lgkmcnt(0)" ::: "memory")
#define VM_WAIT() asm volatile("s_waitcnt vmcnt(0)" ::: "memory")
__device__ __forceinline__ unsigned long long rt() { return __builtin_amdgcn_s_memrealtime(); }
__device__ __forceinline__ unsigned f2bf(float f) { unsigned u = __builtin_bit_cast(unsigned, f); return (u + 0x7fffu + ((u >> 16) & 1u)) >> 16; }
__device__ __forceinline__ unsigned pk2(float lo, float hi) { return f2bf(lo) | (f2bf(hi) << 16); }

#define XB_TMO      128
#define XB_XCNT(j)  (256  + 64 * (j))
#define XB_XSUB(j)  (1280 + 64 * (j))
#define XB_XGEN(j)  (2304 + 64 * (j))
#define XB_TOP      3328
#define XB_TOPGEN   3392
#define XCD_BAR_WORDS 3456
#define XB_SPIN_CAP (1u << 18)

__device__ __forceinline__ unsigned xb_ld(unsigned* p)              { return __hip_atomic_load(p, __ATOMIC_RELAXED, __HIP_MEMORY_SCOPE_AGENT); }
__device__ __forceinline__ unsigned xb_add(unsigned* p, unsigned v) { return __hip_atomic_fetch_add(p, v, __ATOMIC_RELAXED, __HIP_MEMORY_SCOPE_AGENT); }
__device__ __forceinline__ unsigned xb_xcc_id() { return (unsigned)__builtin_amdgcn_s_getreg((3 << 11) | 20) & 0xFu; }
#define XB_SPIN(cond, bar) do { unsigned _sp = 0; while (cond) { __builtin_amdgcn_s_sleep(1); \
    if ((++_sp & 255u) == 0u) { if (xb_ld(&(bar)[XB_TMO])) break; if (_sp > XB_SPIN_CAP) { atomicAdd(&(bar)[XB_TMO], 1u); break; } } } } while (0)

struct XcdBarrier {
    unsigned* bar; unsigned x; int wv;
    volatile LAS unsigned* st;
};

__device__ __forceinline__ XcdBarrier xcd_barrier_post(unsigned* bar, volatile LAS unsigned* st, int wv) {
    XcdBarrier b; b.bar = bar; b.x = xb_xcc_id(); b.st = st; b.wv = wv;
    if (threadIdx.x == 0) (void)xb_add(&bar[XB_XCNT(b.x)], 1u);
    return b;
}
__device__ __forceinline__ void xcd_barrier_complete(unsigned* bar, unsigned x, unsigned& nloc, unsigned& nx) {
    const unsigned G = gridDim.x * gridDim.y * gridDim.z;
    unsigned sum, cnt, mine, sp = 0u;
    for (;;) {
        sum = 0u; cnt = 0u; mine = 0u;
#pragma unroll
        for (unsigned j = 0; j < 16; ++j) { const unsigned c = xb_ld(&bar[XB_XCNT(j)]); sum += c; cnt += (c > 0u) ? 1u : 0u; mine = (j == x) ? c : mine; }
        if (sum == G) break;
        __builtin_amdgcn_s_sleep(1);
        if ((++sp & 255u) == 0u) { if (xb_ld(&bar[XB_TMO])) break; if (sp > XB_SPIN_CAP) { atomicAdd(&bar[XB_TMO], 1u); break; } }
    }
    nloc = mine > 0u ? mine : 1u; nx = cnt > 0u ? cnt : 1u;
}

__device__ __forceinline__ void xcd_barrier(const XcdBarrier& b) {
    asm volatile("s_waitcnt vmcnt(0)" ::: "memory");
    __syncthreads();
    if (b.wv == 0 && hw_lane() == 0) {
        unsigned* bar = b.bar;
        __builtin_amdgcn_s_waitcnt(0);
        unsigned nloc = b.st[0], nx = b.st[1];
        if (nloc == 0u) { xcd_barrier_complete(bar, b.x, nloc, nx); b.st[0] = nloc; b.st[1] = nx; }
        const unsigned old = xb_add(&bar[XB_XSUB(b.x)], 1u);
        const unsigned gen = old / nloc;
        if (old + 1u == (gen + 1u) * nloc) {
            __builtin_amdgcn_fence(__ATOMIC_RELEASE, "agent");
            asm volatile("s_waitcnt vmcnt(0)" ::: "memory");
            const unsigned og = xb_add(&bar[XB_TOP], 1u);
            const unsigned tg = og / nx;
            if (og + 1u == (tg + 1u) * nx) xb_add(&bar[XB_TOPGEN], 1u);
            else XB_SPIN(xb_ld(&bar[XB_TOPGEN]) == tg, bar);
            __builtin_amdgcn_fence(__ATOMIC_ACQUIRE, "agent");
            xb_add(&bar[XB_XGEN(b.x)], 1u);
            asm volatile("s_waitcnt vmcnt(0)" ::: "memory");
        } else {
            XB_SPIN(xb_ld(&bar[XB_XGEN(b.x)]) == gen, bar);
            __builtin_amdgcn_fence(__ATOMIC_ACQUIRE, "agent");
            asm volatile("s_waitcnt vmcnt(0)" ::: "memory");
        }
    }
    __syncthreads();
}

#ifndef PROBE
#define PROBE 0
#endif
#ifndef DEBUG_NAN
#define DEBUG_NAN 0
#endif
#ifndef TSEL
#define TSEL -1
#endif
#ifndef CYSEL
#define CYSEL -1
#endif
#ifndef TSCALE10
#define TSCALE10 0
#endif
#if TSEL >= 0
#define TS(k) do { if (blockIdx.x == 0 && F.wave == 0 && hw_lane() == 0) { unsigned long long* ts_ = (unsigned long long*)(F.ws + WS_CTL + 32768); const unsigned long long now_ = __builtin_amdgcn_s_memrealtime(); ts_[1 + (k)] += now_ - ts_[0]; ts_[0] = now_; } } while (0)
#else
#define TS(k) do {} while (0)
#endif
#ifndef USE_SEQ_SCAN
#define USE_SEQ_SCAN 0
#endif
constexpr int NWAVES = 8;
constexpr int DMODEL = 1024, NBATCH = 8, SEQL = 4096, CTXL = 256, DEPTH = 4;
constexpr int TL = NBATCH * SEQL, TC = NBATCH * CTXL, TT = TL + TC;
constexpr int KVLEN = SEQL + CTXL;
constexpr int INW = 2688, INWP = 2816, ATTIN = 768, SHIFTW = 1920;
constexpr int FFD = 2816, FFE = 3584, NEXP = 8;
constexpr int LORA_K = 384, LORA_N = 2560;
constexpr int MAXPANEL = 280, MAXSLOT = MAXPANEL * 256;
constexpr float RMS_EPS = 1e-6f, GN_EPS = 64e-5f;

constexpr size_t MiB = 1u << 20;
constexpr size_t WS_CTL = 0, CTL_ZERO_BYTES = 64 * 1024;
constexpr size_t WS_MOD = 1 * MiB;
constexpr size_t WS_ROPE = 2 * MiB;
constexpr size_t WS_ROUTE = 3 * MiB;
constexpr size_t RT_E = 0, RT_G = 160 * 1024, RT_S = 448 * 1024, RT_BLK = 768 * 1024, RT_WCNT = 800 * 1024;
constexpr size_t WS_XB = 12 * MiB;
constexpr size_t WS_WIN = 80 * MiB, WS_WOUT = 86 * MiB, WS_WLORA = 88 * MiB;
constexpr size_t WS_WFF = 100 * MiB;
constexpr size_t WS_WFF_D_DENSE = WS_WFF + 12 * MiB, WS_WFF_D_MOE = WS_WFF + 112 * MiB;
constexpr size_t WS_ACT = 270 * MiB;
constexpr size_t WS_QO = WS_ACT, WS_KB = WS_ACT + 68 * MiB, WS_VB = WS_ACT + 77 * MiB, WS_P = WS_ACT + 86 * MiB, WS_OSC = WS_P;
constexpr size_t WS_R = WS_ACT + 273 * MiB, WS_K = WS_ACT + 307 * MiB, WS_V = WS_ACT + 341 * MiB, WS_KK = WS_ACT + 375 * MiB, WS_LIN = WS_ACT + 409 * MiB;
constexpr size_t WS_LOUT = WS_ACT + 435 * MiB;
constexpr size_t WS_SPT = WS_WFF, WS_SG = WS_WFF + 68 * MiB, WS_SQ = WS_ACT + 605 * MiB;
constexpr size_t WS_HID = WS_ACT;
constexpr size_t WS_AG = WS_ACT, WS_AG8 = WS_ACT + 140 * MiB, WS_HIDM = WS_ACT + 210 * MiB;
constexpr size_t WS_WFF_D_MOE8 = WS_WFF + 56 * MiB;
constexpr float W8SCALE = 64.0f, H8SCALE = 8.0f, HID8SCALE = 4.0f;
constexpr size_t WS_SIDE = 1000 * MiB;
constexpr size_t WS_END = 1012 * MiB;
static_assert(WS_LOUT + (size_t)TT * LORA_N * 2 <= WS_END && WS_HIDM + (size_t)MAXSLOT * FFE <= WS_END && WS_P + (size_t)TT * INWP * 2 <= WS_R && WS_OSC + (size_t)2 * TT * 512 * 4 <= WS_R, "ws map");
static_assert(WS_WFF_D_MOE + (size_t)NEXP * 1024 * FFE * 2 <= WS_ACT && WS_XB + (size_t)TT * 1024 * 2 <= WS_WIN && WS_WIN + (size_t)INWP * 1024 * 2 <= WS_WOUT && WS_WLORA + (size_t)LORA_N * LORA_K * 2 <= WS_WFF, "ws map 2");
constexpr int CW_BAR = 4096;

constexpr int RING_OFF = 0, RING_BYTES = 131072;
constexpr int LDSCTL_OFF = RING_BYTES;
constexpr int MISC_OFF = LDSCTL_OFF;
constexpr int LT_PEXP = LDSCTL_OFF + 256;
constexpr int LT_NPAN = LT_PEXP + 320 * 4;
constexpr int LT_INP = LT_NPAN + 64;
constexpr int LT_TMP = LT_INP + 256;
constexpr int LDS_BYTES = 147456;
static_assert(LT_TMP + 8192 + 1024 <= LDS_BYTES, "LDS map");

struct Frame {
    LAS unsigned char* lds;
    volatile LAS unsigned* MISC;
    gu32* ctl;
    int tid, lane, wave, vcu, G;
    unsigned char* ws;
    float* out;
};
struct Args { const float* in[30]; float* out; unsigned char* ws; };
__device__ __forceinline__ const void* inp_ld(const Frame& F, int k) {
    const LAS unsigned* t = (const LAS unsigned*)(F.lds + LT_INP) + 2 * k; unsigned lo = t[0], hi = t[1];
    lo = __builtin_amdgcn_readfirstlane(lo); hi = __builtin_amdgcn_readfirstlane(hi);
    return (const void*)(const GAS void*)(((unsigned long long)hi << 32) | lo);
}
#define IN_X 0
#define IN_C 1
#define IN_CTX 2
#define IN_CCTX 3
#define IN_ADAW 4
#define IN_ADAB 5
#define IN_N1G 6
#define IN_N2G 7
#define IN_WIN 8
#define IN_WOUT 9
#define IN_QG 10
#define IN_KG 11
#define IN_MU 12
#define IN_W0 13
#define IN_W2 14
#define IN_A0 15
#define IN_A2 16
#define IN_G2 17
#define IN_KKW 18
#define IN_KA 19
#define IN_RK 20
#define IN_GNW 21
#define IN_GNB 22
#define IN_FWG 23
#define IN_FWU 24
#define IN_FWD 25
#define IN_ROUTER 26
#define IN_MWG 27
#define IN_MWU 28
#define IN_MWD 29

__device__ __forceinline__ int vlaunder(int v) { asm volatile("" : "+v"(v)); return v; }
__device__ __forceinline__ unsigned char* launder(unsigned char* p) { unsigned long long v = (unsigned long long)p; asm volatile("" : "+s"(v)); return (unsigned char*)(GAS unsigned char*)v; }
#define INP(k) ((const float*)inp_ld(F, (k)))
__device__ __forceinline__ const void* inp_ld(const struct Frame& F, int k);
__device__ __forceinline__ float wave_sum(float v) {
#pragma unroll
    for (int o = 1; o < 64; o <<= 1) v += __shfl_xor(v, o);
    return v;
}
__device__ __forceinline__ float half_sum(float v) {
#pragma unroll
    for (int o = 1; o < 32; o <<= 1) v += __shfl_xor(v, o);
    return v;
}
__device__ __forceinline__ float bflo(unsigned w) { return __builtin_bit_cast(float, w << 16); }
__device__ __forceinline__ float bfhi(unsigned w) { return __builtin_bit_cast(float, w & 0xffff0000u); }
typedef float f32x2_t_ __attribute__((ext_vector_type(2))); typedef __bf16 bf16x2_t_ __attribute__((ext_vector_type(2)));
__device__ __forceinline__ unsigned pkbf(float lo, float hi) { f32x2_t_ v = {lo, hi}; bf16x2_t_ b = __builtin_convertvector(v, bf16x2_t_); return __builtin_bit_cast(unsigned, b); }
__device__ __forceinline__ float sigm(float x) { return __builtin_amdgcn_rcpf(1.0f + __builtin_amdgcn_exp2f(-1.4426950408889634f * x)); }

__device__ __forceinline__ void p_prologue(Frame& F, const Args& A) {
    unsigned char* const ws = launder(F.ws);
    const int tid = (F.wave * 64 + hw_lane()), lane = tid & 63; (void)lane;
    LAS float* sc = (LAS float*)(F.lds + RING_OFF);
    for (int i = tid; i < 9 * 1024; i += NWAVES * 64) { const int b = i >> 10, k = i & 1023; const float v = (b < 8) ? INP(IN_C)[b * 1024 + k] : INP(IN_CCTX)[k]; sc[i] = v * sigm(v); }
    __syncthreads();
    const int gw = F.vcu * NWAVES + F.wave, NGW = F.G * NWAVES;
    float* mod = (float*)(ws + WS_MOD);
    for (int it = (int)blockIdx.x + F.G * F.wave; it < DEPTH * 96; it += NGW) {
        const int l = it / 96, j = (it % 96) * 64 + lane;
        const float* W = INP(IN_ADAW) + (size_t)l * 1024 * 6144 + j;
        float acc[9];
#pragma unroll
        for (int b = 0; b < 9; ++b) acc[b] = 0.f;
        for (int k = 0; k < 1024; k += 16) {
            float wv[16];
#pragma unroll
            for (int u = 0; u < 16; ++u) wv[u] = W[(size_t)(k + u) * 6144];
#pragma unroll
            for (int b = 0; b < 9; ++b)
#pragma unroll
                for (int u4 = 0; u4 < 4; ++u4) { const f32x4 s = *(const LAS f32x4*)(sc + b * 1024 + k + 4 * u4); acc[b] += (s[0] * wv[4 * u4] + s[1] * wv[4 * u4 + 1]) + (s[2] * wv[4 * u4 + 2] + s[3] * wv[4 * u4 + 3]); }
        }
        const float bias = INP(IN_ADAB)[l * 6144 + j];
#pragma unroll
        for (int b = 0; b < 9; ++b) mod[((size_t)l * 9 + b) * 6144 + j] = acc[b] + bias;
    }
    float* cs = (float*)(ws + WS_ROPE);
    for (int i = blockIdx.x * (NWAVES * 64) + tid; i < 4096 * 32; i += F.G * NWAVES * 64) {
        const int t = i >> 5, k = i & 31; const int pos = (k < 16) ? (t >> 6) : (t & 63);
        const float inv = powf(10000.0f, -(float)(2 * (k & 15)) / 32.0f); const float ang = (float)pos * inv;
        float s, c; sincosf(ang, &s, &c); cs[2 * i] = c; cs[2 * i + 1] = s;
    }
    __syncthreads();
}

struct WItem { const float* W; unsigned char* WT; int K, N, k0, n0, drow0, f8; };
__device__ __forceinline__ void tr_load(const WItem& w, float (&tv)[32], int lane) {
#pragma unroll
    for (int i = 0; i < 32; ++i) tv[i] = w.W[(size_t)(w.k0 + 2 * i + (lane >> 5)) * w.N + w.n0 + (lane & 31)];
}
__device__ __forceinline__ void tr_finish(const WItem& w, const float (&tv)[32], LAS float* scr, int lane) {
#pragma unroll
    for (int i = 0; i < 32; ++i) scr[(2 * i + (lane >> 5)) * 33 + (lane & 31)] = tv[i];
    LDS_WAIT(); asm volatile("" ::: "memory");
    if (w.f8) { const int c = lane & 3;
#pragma unroll
        for (int j = 0; j < 2; ++j) { const int n = (lane >> 2) + 16 * j; const LAS float* s = scr + (16 * c) * 33 + n;
            v4u o;
            o.x = pg8::pk_fp8x4(s[0 * 33] * W8SCALE, s[1 * 33] * W8SCALE, s[2 * 33] * W8SCALE, s[3 * 33] * W8SCALE); o.y = pg8::pk_fp8x4(s[4 * 33] * W8SCALE, s[5 * 33] * W8SCALE, s[6 * 33] * W8SCALE, s[7 * 33] * W8SCALE);
            o.z = pg8::pk_fp8x4(s[8 * 33] * W8SCALE, s[9 * 33] * W8SCALE, s[10 * 33] * W8SCALE, s[11 * 33] * W8SCALE); o.w = pg8::pk_fp8x4(s[12 * 33] * W8SCALE, s[13 * 33] * W8SCALE, s[14 * 33] * W8SCALE, s[15 * 33] * W8SCALE);
            *(v4u*)(w.WT + (size_t)(w.drow0 + n) * w.K + w.k0 + 16 * c) = o; }
    } else { const int c = lane & 7;
#pragma unroll
        for (int j = 0; j < 4; ++j) { const int n = (lane >> 3) + 8 * j; const LAS float* s = scr + (8 * c) * 33 + n;
            v4u o; o.x = pkbf(s[0 * 33], s[1 * 33]); o.y = pkbf(s[2 * 33], s[3 * 33]); o.z = pkbf(s[4 * 33], s[5 * 33]); o.w = pkbf(s[6 * 33], s[7 * 33]);
            *(v4u*)((bf16*)w.WT + (size_t)(w.drow0 + n) * w.K + w.k0 + 8 * c) = o; } }
    LDS_WAIT(); asm volatile("" ::: "memory");
}
__device__ __forceinline__ int gu_row(int n) { return 256 * (n >> 7) + (n & 127); }

__device__ __forceinline__ WItem wprep_decode(Frame& F, unsigned char* const ws, const int l, const int it) {
    constexpr int I_IN = 16 * (INW / 32), I_OUT = 16 * 32;
    const bool moe = (l & 1) != 0; const int j = l >> 1;
    constexpr int I_DG = 16 * (FFD / 32), I_MG = 16 * (FFE / 32);
    int r = it; WItem w;
    if (r < I_IN) { const int nb = r % (INW / 32), kb = r / (INW / 32); w = WItem{INP(IN_WIN) + (size_t)l * 1024 * INW, ws + WS_WIN, 1024, INW, kb * 64, nb * 32, nb * 32, 0}; return w; } r -= I_IN;
    if (r < I_OUT) { const int nb = r % 32, kb = r / 32; w = WItem{INP(IN_WOUT) + (size_t)l * 1024 * 1024, ws + WS_WOUT, 1024, 1024, kb * 64, nb * 32, nb * 32, 0}; return w; } r -= I_OUT;
    if (!moe) {
        if (r < I_DG) { const int nb = r % (FFD / 32), kb = r / (FFD / 32); w = WItem{INP(IN_FWG) + (size_t)j * 1024 * FFD, ws + WS_WFF, 1024, FFD, kb * 64, nb * 32, gu_row(nb * 32), 0}; return w; } r -= I_DG;
        if (r < I_DG) { const int nb = r % (FFD / 32), kb = r / (FFD / 32); w = WItem{INP(IN_FWU) + (size_t)j * 1024 * FFD, ws + WS_WFF, 1024, FFD, kb * 64, nb * 32, gu_row(nb * 32) + 128, 0}; return w; } r -= I_DG;
        { const int nb = r % 32, kb = r / 32; w = WItem{INP(IN_FWD) + (size_t)j * FFD * 1024, ws + WS_WFF_D_DENSE, FFD, 1024, kb * 64, nb * 32, nb * 32, 0}; return w; }
    }
    constexpr int I_MD = (FFE / 64) * 32; constexpr int PER = 2 * I_MG + I_MD; const int e = r / PER; r -= e * PER;
    unsigned char* WGU = ws + WS_WFF + (size_t)e * (2 * FFE) * 1024; unsigned char* WD = ws + WS_WFF_D_MOE8 + (size_t)e * 1024 * FFE;
    const size_t eo = ((size_t)j * NEXP + e) * 1024 * FFE;
    if (r < I_MG) { const int nb = r % (FFE / 32), kb = r / (FFE / 32); w = WItem{INP(IN_MWG) + eo, WGU, 1024, FFE, kb * 64, nb * 32, gu_row(nb * 32), 1}; return w; } r -= I_MG;
    if (r < I_MG) { const int nb = r % (FFE / 32), kb = r / (FFE / 32); w = WItem{INP(IN_MWU) + eo, WGU, 1024, FFE, kb * 64, nb * 32, gu_row(nb * 32) + 128, 1}; return w; } r -= I_MG;
    { const int nb = r % 32, kb = r / 32; w = WItem{INP(IN_MWD) + eo, WD, FFE, 1024, kb * 64, nb * 32, nb * 32, 1}; return w; }
}
__device__ __forceinline__ void p_wprep(Frame& F, const Args& A, int l, int part, gu32* ctr = nullptr) {
    unsigned char* const ws = launder(F.ws);
    const int tid = (F.wave * 64 + hw_lane()), lane = tid & 63; (void)lane;
    LAS float* scr = (LAS float*)(F.lds + RING_OFF + F.wave * 16384);
    const int gw = F.vcu * NWAVES + F.wave, NGW = F.G * NWAVES;
    bf16* WIN = (bf16*)(ws + WS_WIN); bf16* WLORA = (bf16*)(ws + WS_WLORA);
    constexpr int I_IN = 16 * (INW / 32), I_OUT = 16 * 32;
    const bool moe = (l & 1) != 0;
    constexpr int I_DG = 16 * (FFD / 32), I_DD = (FFD / 64) * 32, I_MG = 16 * (FFE / 32), I_MD = (FFE / 64) * 32;
    const int nff = moe ? NEXP * (2 * I_MG + I_MD) : (2 * I_DG + I_DD);
    const int NIT = I_IN + I_OUT + nff;
    const int lo = part ? I_IN + I_OUT : 0, hi = part ? NIT : I_IN + I_OUT;
    (void)ctr;
    {
        int it = lo + gw; WItem wa, wb; float ta[32], tb[32];
        if (it < hi) { wa = wprep_decode(F, ws, l, it); tr_load(wa, ta, lane); }
        for (; it < hi; it += 2 * NGW) {
            const int i2 = it + NGW, i3 = i2 + NGW;
            if (i2 < hi) { wb = wprep_decode(F, ws, l, i2); tr_load(wb, tb, lane); }
            tr_finish(wa, ta, scr, lane);
            if (i3 < hi) { wa = wprep_decode(F, ws, l, i3); tr_load(wa, ta, lane); }
            if (i2 < hi) tr_finish(wb, tb, scr, lane);
        }
    }
    if (part) return;
    for (int i = blockIdx.x * (NWAVES * 64) + tid; i < 16384; i += F.G * NWAVES * 64) ((v4u*)(WIN + (size_t)INW * 1024))[i] = (v4u){0u, 0u, 0u, 0u};
    const float* w2 = INP(IN_W2) + (size_t)l * 2 * 64 * 512; const float* a2 = INP(IN_A2) + (size_t)l * 2 * 64 * 512; const float* g2 = INP(IN_G2) + (size_t)l * 128 * 512;
    for (int i = blockIdx.x * (NWAVES * 64) + tid; i < LORA_N * 64; i += F.G * NWAVES * 64) {
        const int n = i >> 6, k = (i & 63) * 2; const int sec = n >> 9, cn = n & 511;
        float v0 = 0.f, v1 = 0.f;
        if (sec < 2) { const int kk = k - 64 * sec; if (kk >= 0 && kk < 64) { v0 = w2[((size_t)sec * 64 + kk) * 512 + cn]; v1 = w2[((size_t)sec * 64 + kk + 1) * 512 + cn]; } }
        else if (sec < 4) { const int d = sec - 2, kk = k - 64 * d; if (kk >= 0 && kk < 64) { v0 = a2[((size_t)d * 64 + kk) * 512 + cn]; v1 = a2[((size_t)d * 64 + kk + 1) * 512 + cn]; } }
        else { v0 = g2[(size_t)k * 512 + cn]; v1 = g2[(size_t)(k + 1) * 512 + cn]; }
        ((unsigned*)WLORA)[i] = pkbf(v0, v1);
    }
}

template <bool ROUTER, bool COMBINE, bool SRCF32, bool SIDE = false>
__device__ __forceinline__ void p_norm(Frame& F, const Args& A, int l, int which, const float* srcL, const float* srcC, int lprev, int nrows = TT) {
    unsigned char* const ws = launder(F.ws);
    const int tid = (F.wave * 64 + hw_lane()), lane = tid & 63; (void)lane;
    const int gw = F.vcu * NWAVES + F.wave, NGW = F.G * NWAVES;
    const float* mod = (const float*)(ws + WS_MOD) + (size_t)l * 9 * 6144;
    const float* gain = A.in[which ? IN_N2G : IN_N1G] + l * 1024;
    bf16* H = (bf16*)F.out;
    const float* route_g = (const float*)(ws + WS_ROUTE + RT_G); const int* route_s = (const int*)(ws + WS_ROUTE + RT_S);
    int cnt0 = 0, cnt1 = 0, cnt2 = 0, cnt3 = 0, cnt4 = 0, cnt5 = 0, cnt6 = 0, cnt7 = 0;
    LAS float* rwl = (LAS float*)(F.lds + RING_OFF);
    if (ROUTER) {
        __syncthreads();
        const float* rw = INP(IN_ROUTER) + (size_t)(l >> 1) * 1024 * 8;
        for (int i = tid; i < 2048; i += NWAVES * 64) { const f32x4 w = *(const f32x4*)(rw + 4 * i); const int col = i >> 1, e4 = (i & 1) * 4, jj = col >> 8, ln = (col & 255) >> 2, q = col & 3;
            *(LAS f32x4*)(rwl + (((jj * 4 + q) * 64 + ln) * 8 + e4)) = w; }
        __syncthreads();
    }
    uint2 nx[2][4]; f32x4 nf[2][4]; float cg[2][2]; int cs[2][2];
#pragma unroll
    for (int r = 0; r < 2; ++r) { cg[r][0] = cg[r][1] = 0.f; cs[r][0] = cs[r][1] = 0;
#pragma unroll
        for (int jj = 0; jj < 4; ++jj) { nx[r][jj] = make_uint2(0u, 0u); nf[r][jj] = (f32x4){0.f, 0.f, 0.f, 0.f}; } }
#define PN_LOAD(r_, row_) do { const int row__ = (row_); if (row__ < nrows) { \
        if (SRCF32) { const float* xr_ = (row__ < TL) ? srcL + (size_t)row__ * 1024 : srcC + (size_t)(row__ - TL) * 1024; _Pragma("unroll") for (int jj = 0; jj < 4; ++jj) nf[r_][jj] = *(const f32x4*)(xr_ + 4 * ln + 256 * jj); } \
        else { const bf16* xr_ = (const bf16*)(ws + WS_XB) + (size_t)row__ * 1024; _Pragma("unroll") for (int jj = 0; jj < 4; ++jj) nx[r_][jj] = *(const uint2*)(xr_ + 4 * ln + 256 * jj); } \
        if (COMBINE) { cg[r_][0] = route_g[2 * row__]; cg[r_][1] = route_g[2 * row__ + 1]; cs[r_][0] = route_s[2 * row__]; cs[r_][1] = route_s[2 * row__ + 1]; } } } while (0)
    int ln = vlaunder(lane);
    PN_LOAD(0, gw); PN_LOAD(1, gw + NGW);
    for (int row0 = gw; row0 < nrows; row0 += 2 * NGW) {
        ln = vlaunder(lane);
        const bool ok1 = row0 + NGW < nrows;
        f32x4 v[2][4]; float g0[2], g1[2]; int s0[2], s1[2];
#pragma unroll
        for (int r = 0; r < 2; ++r) { g0[r] = cg[r][0]; g1[r] = cg[r][1]; s0[r] = cs[r][0]; s1[r] = cs[r][1];
#pragma unroll
            for (int jj = 0; jj < 4; ++jj) { if (SRCF32) v[r][jj] = nf[r][jj]; else { const uint2 w = nx[r][jj]; v[r][jj] = (f32x4){bflo(w.x), bfhi(w.x), bflo(w.y), bfhi(w.y)}; } } }
        PN_LOAD(0, row0 + 2 * NGW); PN_LOAD(1, row0 + 3 * NGW);
        if (COMBINE) {
            const bf16* Y = (const bf16*)(ws + WS_AG);
            uint2 yy0[2][4], yy1[2][4];
#pragma unroll
            for (int r = 0; r < 2; ++r)
#pragma unroll
                for (int jj = 0; jj < 4; ++jj) { const int col = 4 * ln + 256 * jj; yy0[r][jj] = *(const uint2*)(Y + (size_t)s0[r] * 1024 + col); yy1[r][jj] = *(const uint2*)(Y + (size_t)s1[r] * 1024 + col); }
#pragma unroll
            for (int r = 0; r < 2; ++r) { const int row = row0 + r * NGW; const int bsel = (row < TL) ? (row >> 12) : 8;
                const float* m5 = (const float*)(ws + WS_MOD) + ((size_t)lprev * 9 + bsel) * 6144 + 5 * 1024;
                bf16* xbr = (bf16*)(ws + WS_XB) + (size_t)row * 1024;
#pragma unroll
                for (int jj = 0; jj < 4; ++jj) { const int col = 4 * ln + 256 * jj;
                    const uint2 y0 = yy0[r][jj], y1 = yy1[r][jj]; const f32x4 mm = *(const f32x4*)(m5 + col);
                    v[r][jj][0] += mm[0] * (g0[r] * bflo(y0.x) + g1[r] * bflo(y1.x)); v[r][jj][1] += mm[1] * (g0[r] * bfhi(y0.x) + g1[r] * bfhi(y1.x));
                    v[r][jj][2] += mm[2] * (g0[r] * bflo(y0.y) + g1[r] * bflo(y1.y)); v[r][jj][3] += mm[3] * (g0[r] * bfhi(y0.y) + g1[r] * bfhi(y1.y));
                    if (r == 0 || ok1) *(uint2*)(xbr + col) = make_uint2(pkbf(v[r][jj][0], v[r][jj][1]), pkbf(v[r][jj][2], v[r][jj][3])); } }
        }
        if (SIDE) {
#pragma unroll
            for (int r = 0; r < 2; ++r) { const int row = row0 + r * NGW;
                if ((r == 0 || ok1) && row >= TL) {
                    const bf16* sd = (const bf16*)(ws + WS_SIDE) + (size_t)(row - TL) * 1024; bf16* xbr = (bf16*)(ws + WS_XB) + (size_t)row * 1024;
                    uint2 sv[3][4];
#pragma unroll
                    for (int q = 0; q < 3; ++q)
#pragma unroll
                        for (int jj = 0; jj < 4; ++jj) sv[q][jj] = *(const uint2*)(sd + (size_t)q * TC * 1024 + 4 * ln + 256 * jj);
#pragma unroll
                    for (int jj = 0; jj < 4; ++jj) {
#pragma unroll
                        for (int q = 0; q < 3; ++q) { const uint2 w = sv[q][jj]; v[r][jj][0] += bflo(w.x); v[r][jj][1] += bfhi(w.x); v[r][jj][2] += bflo(w.y); v[r][jj][3] += bfhi(w.y); }
                        *(uint2*)(xbr + 4 * ln + 256 * jj) = make_uint2(pkbf(v[r][jj][0], v[r][jj][1]), pkbf(v[r][jj][2], v[r][jj][3])); } } }
        }
        float ss[2];
#pragma unroll
        for (int r = 0; r < 2; ++r) { ss[r] = 0.f;
#pragma unroll
            for (int jj = 0; jj < 4; ++jj) ss[r] += (v[r][jj][0] * v[r][jj][0] + v[r][jj][1] * v[r][jj][1]) + (v[r][jj][2] * v[r][jj][2] + v[r][jj][3] * v[r][jj][3]); }
#pragma unroll
        for (int o = 1; o < 64; o <<= 1) { const float t0 = __shfl_xor(ss[0], o), t1 = __shfl_xor(ss[1], o); ss[0] += t0; ss[1] += t1; }
        float rstd[2]; const float* shp[2];
#pragma unroll
        for (int r = 0; r < 2; ++r) { const int row = row0 + r * NGW; const int bsel = (row < TL) ? (row >> 12) : 8;
            rstd[r] = 1.0f / sqrtf(ss[r] * (1.0f / 1024.0f) + RMS_EPS); shp[r] = mod + (size_t)bsel * 6144 + (which ? 3 : 0) * 1024; }
        float lg[2][8];
#pragma unroll
        for (int r = 0; r < 2; ++r)
#pragma unroll
            for (int e = 0; e < 8; ++e) lg[r][e] = 0.f;
#pragma unroll
        for (int jj = 0; jj < 4; ++jj) { const int col = 4 * ln + 256 * jj;
            const f32x4 gg = *(const f32x4*)(gain + col); f32x4 h[2];
#pragma unroll
            for (int r = 0; r < 2; ++r) { const int row = row0 + r * NGW;
                const f32x4 sh = *(const f32x4*)(shp[r] + col), sc = *(const f32x4*)(shp[r] + 1024 + col);
                h[r] = (v[r][jj] * rstd[r]) * gg * (sc + 1.0f) + sh;
                if (r == 0 || ok1) {
                    if (ROUTER) *(unsigned*)((unsigned char*)H + (size_t)row * 1024 + col) = pg8::pk_fp8x4(h[r][0] * H8SCALE, h[r][1] * H8SCALE, h[r][2] * H8SCALE, h[r][3] * H8SCALE);
                    else { uint2 o; o.x = pkbf(h[r][0], h[r][1]); o.y = pkbf(h[r][2], h[r][3]); *(uint2*)(H + (size_t)row * 1024 + col) = o; } } }
            if (ROUTER) {
#pragma unroll
                for (int q = 0; q < 4; ++q) { const LAS float* rp = rwl + ((jj * 4 + q) * 64 + ln) * 8; const f32x4 ra = *(const LAS f32x4*)rp, rb = *(const LAS f32x4*)(rp + 4);
#pragma unroll
                    for (int r = 0; r < 2; ++r) { lg[r][0] += h[r][q] * ra[0]; lg[r][1] += h[r][q] * ra[1]; lg[r][2] += h[r][q] * ra[2]; lg[r][3] += h[r][q] * ra[3];
                        lg[r][4] += h[r][q] * rb[0]; lg[r][5] += h[r][q] * rb[1]; lg[r][6] += h[r][q] * rb[2]; lg[r][7] += h[r][q] * rb[3]; } } }
        }
        if (ROUTER) {
#pragma unroll
            for (int o = 1; o < 64; o <<= 1) { float t[2][8];
#pragma unroll
                for (int r = 0; r < 2; ++r)
#pragma unroll
                    for (int e = 0; e < 8; ++e) t[r][e] = __shfl_xor(lg[r][e], o);
#pragma unroll
                for (int r = 0; r < 2; ++r)
#pragma unroll
                    for (int e = 0; e < 8; ++e) lg[r][e] += t[r][e]; }
#pragma unroll
            for (int r = 0; r < 2; ++r) { const int row = row0 + r * NGW;
                if (r == 0 || ok1) {
                    int e0 = 0; float v0 = lg[r][0];
#pragma unroll
                    for (int e = 1; e < 8; ++e) if (lg[r][e] > v0) { v0 = lg[r][e]; e0 = e; }
                    int e1 = -1; float v1 = -INFINITY;
#pragma unroll
                    for (int e = 0; e < 8; ++e) if (e != e0 && lg[r][e] > v1) { v1 = lg[r][e]; e1 = e; }
                    const float q0 = 1.0f / (1.0f + __expf(v1 - v0)), q1 = 1.0f - q0;
                    if (ln == 0) { ((int*)(ws + WS_ROUTE + RT_E))[row] = e0 | (e1 << 8); ((float*)(ws + WS_ROUTE + RT_G))[2 * row] = q0; ((float*)(ws + WS_ROUTE + RT_G))[2 * row + 1] = q1; }
                    cnt0 += (e0 == 0) + (e1 == 0); cnt1 += (e0 == 1) + (e1 == 1); cnt2 += (e0 == 2) + (e1 == 2); cnt3 += (e0 == 3) + (e1 == 3);
                    cnt4 += (e0 == 4) + (e1 == 4); cnt5 += (e0 == 5) + (e1 == 5); cnt6 += (e0 == 6) + (e1 == 6); cnt7 += (e0 == 7) + (e1 == 7); } }
        }
    }
#undef PN_LOAD
    if (ROUTER) {
        int* wcnt = (int*)(ws + WS_ROUTE + RT_WCNT);
        if (ln == 0) { int* w = wcnt + (size_t)gw * 8; w[0] = cnt0; w[1] = cnt1; w[2] = cnt2; w[3] = cnt3; w[4] = cnt4; w[5] = cnt5; w[6] = cnt6; w[7] = cnt7; }
    }
}
__device__ __forceinline__ void p_final_combine(Frame& F, int lprev) {
    unsigned char* const ws = launder(F.ws);
    const int tid = (F.wave * 64 + hw_lane()), lane = tid & 63; (void)lane;
    const int gw = F.vcu * NWAVES + F.wave, NGW = F.G * NWAVES;
    const float* route_g = (const float*)(ws + WS_ROUTE + RT_G); const int* route_s = (const int*)(ws + WS_ROUTE + RT_S);
    const bf16* Y = (const bf16*)(ws + WS_AG);
    float g0n = 0.f, g1n = 0.f; int s0n = 0, s1n = 0;
    if (gw < TL) { g0n = route_g[2 * gw]; g1n = route_g[2 * gw + 1]; s0n = route_s[2 * gw]; s1n = route_s[2 * gw + 1]; }
    for (int row = gw; row < TL; row += NGW) {
        const int bsel = row >> 12;
        const float* m5 = (const float*)(ws + WS_MOD) + ((size_t)lprev * 9 + bsel) * 6144 + 5 * 1024;
        const float g0 = g0n, g1 = g1n; const int s0 = s0n, s1 = s1n;
        float* xw = F.out + (size_t)row * 1024; const bf16* xbr = (const bf16*)(ws + WS_XB) + (size_t)row * 1024;
        uint2 xw2[4], y0[4], y1[4];
#pragma unroll
        for (int jj = 0; jj < 4; ++jj) { const int col = 4 * lane + 256 * jj; xw2[jj] = *(const uint2*)(xbr + col); y0[jj] = *(const uint2*)(Y + (size_t)s0 * 1024 + col); y1[jj] = *(const uint2*)(Y + (size_t)s1 * 1024 + col); }
        if (row + NGW < TL) { const int rn = row + NGW; g0n = route_g[2 * rn]; g1n = route_g[2 * rn + 1]; s0n = route_s[2 * rn]; s1n = route_s[2 * rn + 1]; }
#pragma unroll
        for (int jj = 0; jj < 4; ++jj) { const int col = 4 * lane + 256 * jj; const f32x4 mm = *(const f32x4*)(m5 + col);
            f32x4 v = (f32x4){bflo(xw2[jj].x), bfhi(xw2[jj].x), bflo(xw2[jj].y), bfhi(xw2[jj].y)};
            v[0] += mm[0] * (g0 * bflo(y0[jj].x) + g1 * bflo(y1[jj].x)); v[1] += mm[1] * (g0 * bfhi(y0[jj].x) + g1 * bfhi(y1[jj].x));
            v[2] += mm[2] * (g0 * bflo(y0[jj].y) + g1 * bflo(y1[jj].y)); v[3] += mm[3] * (g0 * bfhi(y0[jj].y) + g1 * bfhi(y1[jj].y));
            *(f32x4*)(xw + col) = v; }
    }
}

__device__ __forceinline__ void p_prep(Frame& F, const Args& A, int l) {
    unsigned char* const ws = launder(F.ws);
    const int tid = (F.wave * 64 + hw_lane()), lane = tid & 63; (void)lane;
    const int gw = F.vcu * NWAVES + F.wave, NGW = F.G * NWAVES;
    const unsigned* P = (const unsigned*)(ws + WS_P);
    const float* cs = (const float*)(ws + WS_ROPE);
    bf16* QO = (bf16*)(ws + WS_QO); bf16* KB = (bf16*)(ws + WS_KB); bf16* VB = (bf16*)(ws + WS_VB);
    unsigned* Rst = (unsigned*)(ws + WS_R); unsigned* Kst = (unsigned*)(ws + WS_K); unsigned* Vst = (unsigned*)(ws + WS_V); unsigned* KKst = (unsigned*)(ws + WS_KK); unsigned* LIN = (unsigned*)(ws + WS_LIN);
    const int d0 = 2 * (lane & 31);
    const float qg0 = INP(IN_QG)[l * 64 + d0], qg1 = INP(IN_QG)[l * 64 + d0 + 1], kg0 = INP(IN_KG)[l * 64 + d0], kg1 = INP(IN_KG)[l * 64 + d0 + 1];
    float mu0[15], mu1[15];
#pragma unroll
    for (int i = 0; i < 15; ++i) { mu0[i] = INP(IN_MU)[l * SHIFTW + 128 * i + 2 * lane]; mu1[i] = INP(IN_MU)[l * SHIFTW + 128 * i + 2 * lane + 1]; }
    float kw0[4], kw1[4];
#pragma unroll
    for (int i = 0; i < 4; ++i) { kw0[i] = INP(IN_KKW)[l * 512 + 128 * i + 2 * lane]; kw1[i] = INP(IN_KKW)[l * 512 + 128 * i + 2 * lane + 1]; }
    const float C2 = 0.125f * 1.4426950408889634f;
    const float sgn = (lane & 16) ? 1.0f : -1.0f;
    for (int w0 = gw; w0 * 17 < TT; w0 += NGW) {
        const int rbeg = w0 * 17;
        unsigned cur[21], nxt[21], prv[15];
#pragma unroll
        for (int i = 0; i < 15; ++i) prv[i] = 0u;
        {   const int r = rbeg; const bool lat = r < TL; const int pos = lat ? (r & 4095) : ((r - TL) & 255);
            if (pos != 0) {
#pragma unroll
                for (int i = 0; i < 15; ++i) prv[i] = P[(size_t)(r - 1) * (INWP / 2) + 64 * (i + 6) + lane]; }
#pragma unroll
            for (int i = 0; i < 21; ++i) cur[i] = P[(size_t)r * (INWP / 2) + 64 * i + lane];
        }
        for (int k = 0; k < 17; ++k) {
            const int r = rbeg + k; const bool lat = r < TL; const int pos = lat ? (r & 4095) : ((r - TL) & 255); const int slen = lat ? 4096 : 256;
            const bool has_next = (pos != slen - 1);
            const bool load_next = (k < 16) || has_next;
            if (load_next && r + 1 < TT) {
#pragma unroll
                for (int i = 0; i < 21; ++i) nxt[i] = P[(size_t)(r + 1) * (INWP / 2) + 64 * i + lane];
            } else {
#pragma unroll
                for (int i = 0; i < 21; ++i) nxt[i] = 0u;
            }
            const int b = lat ? (r >> 12) : ((r - TL) >> 8);
            const size_t kvrow = (size_t)b * KVLEN + (lat ? pos : 4096 + pos);
            f32x4 csv = (f32x4){1.f, 0.f, 1.f, 0.f};
            if (lat) csv = *(const f32x4*)(cs + ((size_t)pos * 32 + 2 * (lane & 15)) * 2);
#pragma unroll
            for (int i = 0; i < 5; ++i) {
                float x0 = bflo(cur[i]), x1 = bfhi(cur[i]);
                const float ss = half_sum(x0 * x0 + x1 * x1);
                const float rstd = 1.0f / sqrtf(ss * (1.0f / 64.0f) + RMS_EPS);
                x0 = x0 * rstd * (i < 4 ? qg0 : kg0); x1 = x1 * rstd * (i < 4 ? qg1 : kg1);
                const float p0 = __shfl_xor(x0, 16), p1 = __shfl_xor(x1, 16);
                const float y0 = x0 * csv[0] + sgn * p0 * csv[1], y1 = x1 * csv[2] + sgn * p1 * csv[3];
                if (i < 4) *(unsigned*)(QO + (size_t)r * 1024 + 128 * i + 2 * lane) = pkbf(y0 * C2, y1 * C2);
                else *(unsigned*)(KB + kvrow * 128 + 2 * lane) = pkbf(y0, y1);
            }
            *(unsigned*)(VB + kvrow * 128 + 2 * lane) = cur[5];
            const float hn = has_next ? 1.0f : 0.0f;
#pragma unroll
            for (int i = 0; i < 15; ++i) {
                const float c0 = bflo(cur[i + 6]), c1 = bfhi(cur[i + 6]);
                const float a0 = bflo(prv[i]) + hn * bflo(nxt[i + 6]), a1 = bfhi(prv[i]) + hn * bfhi(nxt[i + 6]);
                const float s0 = c0 + mu0[i] * (0.5f * a0 - c0), s1 = c1 + mu1[i] * (0.5f * a1 - c1);
                if (i < 4) Rst[(size_t)r * 256 + 64 * i + lane] = pkbf(s0, s1);
                else if (i < 8) { Kst[(size_t)r * 256 + 64 * (i - 4) + lane] = pkbf(s0, s1);
                    const float t0 = s0 * kw0[i - 4], t1 = s1 * kw1[i - 4]; const float q = half_sum(t0 * t0 + t1 * t1); const float rn = 1.0f / sqrtf(q + 1e-12f);
                    KKst[(size_t)r * 256 + 64 * (i - 4) + lane] = pkbf(t0 * rn, t1 * rn); }
                else if (i < 12) Vst[(size_t)r * 256 + 64 * (i - 8) + lane] = pkbf(s0, s1);
                else if (i == 12) { const float e0 = __builtin_amdgcn_exp2f(2.0f * 1.4426950408889634f * s0), e1 = __builtin_amdgcn_exp2f(2.0f * 1.4426950408889634f * s1);
                    LIN[(size_t)r * (LORA_K / 2) + lane] = pkbf(1.0f - 2.0f * __builtin_amdgcn_rcpf(1.0f + e0), 1.0f - 2.0f * __builtin_amdgcn_rcpf(1.0f + e1)); }
                else if (i == 13) LIN[(size_t)r * (LORA_K / 2) + 64 + lane] = pkbf(s0, s1);
                else LIN[(size_t)r * (LORA_K / 2) + 128 + lane] = pkbf(sigm(s0), sigm(s1));
            }
#pragma unroll
            for (int i = 0; i < 15; ++i) prv[i] = has_next ? cur[i + 6] : 0u;
#pragma unroll
            for (int i = 0; i < 21; ++i) cur[i] = nxt[i];
        }
    }
}

template <int CTRL> __device__ __forceinline__ float dppf(float v) { return __builtin_bit_cast(float, __builtin_amdgcn_update_dpp(0, __builtin_bit_cast(int, v), CTRL, 0xf, 0xf, true)); }
__device__ __forceinline__ float red16(float v) { v += dppf<0xB1>(v); v += dppf<0x4E>(v); v += dppf<0x141>(v); v += dppf<0x128>(v); return v; }
constexpr int SC_TS = 32, SC_W = 352;
__device__ __forceinline__ void p_scan(Frame& F, const Args& A, int l) {
    unsigned char* const ws = launder(F.ws);
    const int tid = (F.wave * 64 + hw_lane()), lane = tid & 63; (void)lane;
    LAS float* buf = (LAS float*)(F.lds + RING_OFF);
    float* OSC = (float*)(ws + WS_OSC);
    constexpr int NCH = KVLEN / SC_TS;
    for (int item = blockIdx.x; item < 256; item += F.G) {
        const int chain = item >> 1, rh = item & 1, dir = chain & 1, bh = chain >> 1, b = bh >> 3, h = bh & 7;
        const int row = tid >> 4, c = tid & 15;
        float S0 = 0.f, S1 = 0.f, S2 = 0.f, S3 = 0.f;
        const bool stg = tid < 352; const int sub = (tid >= 176) ? 1 : 0, pp = tid - 176 * sub, a = pp >> 5, w = pp & 31;
        const unsigned* p1; int pitch1 = 256;
        if (a == 0 || a == 2) p1 = (const unsigned*)(ws + WS_KK) + h * 32 + w;
        else if (a == 1) { p1 = (const unsigned*)(ws + WS_LOUT) + dir * 256 + h * 32 + w; pitch1 = LORA_N / 2; }
        else if (a == 3) p1 = (const unsigned*)(ws + WS_K) + h * 32 + w;
        else if (a == 4) p1 = (const unsigned*)(ws + WS_R) + h * 32 + w;
        else p1 = (const unsigned*)(ws + WS_V) + h * 32 + rh * 16 + (pp - 160);
        const unsigned* p2 = (const unsigned*)(ws + WS_LOUT) + 512 + dir * 256 + h * 32 + w;
        const bool two = (a == 2 || a == 3);
        const int cw = (a == 5) ? 0 : 2 * w;
        const float cw0 = INP(IN_W0)[l * 1024 + dir * 512 + h * 64 + cw], cw1 = INP(IN_W0)[l * 1024 + dir * 512 + h * 64 + cw + 1];
        const float ca0 = INP(IN_A0)[l * 1024 + dir * 512 + h * 64 + cw], ca1 = INP(IN_A0)[l * 1024 + dir * 512 + h * 64 + cw + 1];
        const float ck0 = INP(IN_KA)[l * 512 + h * 64 + cw], ck1 = INP(IN_KA)[l * 512 + h * 64 + cw + 1];
        unsigned st[16], st2[16];
#define SC_TOK(s) ((s) < CTXL ? (TL + b * CTXL + (dir ? (CTXL - 1 - (s)) : (s))) : (b * SEQL + (dir ? (SEQL - 1 - ((s) - CTXL)) : ((s) - CTXL))))
#define SC_LOAD(ci) do { if (stg) { _Pragma("unroll") for (int i = 0; i < 16; ++i) { const int s = (ci) * SC_TS + 2 * i + sub; const size_t tok = (size_t)SC_TOK(s); \
            st[i] = p1[tok * pitch1]; st2[i] = two ? p2[tok * (LORA_N / 2)] : 0u; } } } while (0)
#define SC_STORE(bi) do { if (stg) { _Pragma("unroll") for (int i = 0; i < 16; ++i) { \
            float x0 = bflo(st[i]), x1 = bfhi(st[i]); \
            if (a == 1) { x0 = __builtin_amdgcn_exp2f(-1.4426950408889634f * 0.6065306597126334f * sigm(x0 + cw0)); x1 = __builtin_amdgcn_exp2f(-1.4426950408889634f * 0.6065306597126334f * sigm(x1 + cw1)); } \
            else if (a == 2) { x0 *= sigm(bflo(st2[i]) + ca0); x1 *= sigm(bfhi(st2[i]) + ca1); } \
            else if (a == 3) { x0 *= 1.0f + (sigm(bflo(st2[i]) + ca0) - 1.0f) * ck0; x1 *= 1.0f + (sigm(bfhi(st2[i]) + ca1) - 1.0f) * ck1; } \
            LAS float* dp = buf + ((bi) * SC_TS + 2 * i + sub) * SC_W + 2 * pp; dp[0] = x0; dp[1] = x1; } } } while (0)
        __syncthreads();
        SC_LOAD(0); SC_STORE(0); __syncthreads();
        for (int ci = 0; ci < NCH; ++ci) {
            if (ci + 1 < NCH) SC_LOAD(ci + 1);
            const LAS float* bp = buf + (ci & 1) * SC_TS * SC_W;
#pragma unroll 2
            for (int stp = 0; stp < SC_TS; ++stp) {
                const LAS float* sp = bp + stp * SC_W;
                const f32x4 kk = *(const LAS f32x4*)(sp + 4 * c), w4 = *(const LAS f32x4*)(sp + 64 + 4 * c), bb = *(const LAS f32x4*)(sp + 128 + 4 * c), kd = *(const LAS f32x4*)(sp + 192 + 4 * c), rr = *(const LAS f32x4*)(sp + 256 + 4 * c);
                const float vv = sp[320 + row];
                float sa = (S0 * kk[0] + S1 * kk[1]) + (S2 * kk[2] + S3 * kk[3]); sa = red16(sa);
                S0 = S0 * w4[0] + (vv * kd[0] - sa * bb[0]); S1 = S1 * w4[1] + (vv * kd[1] - sa * bb[1]); S2 = S2 * w4[2] + (vv * kd[2] - sa * bb[2]); S3 = S3 * w4[3] + (vv * kd[3] - sa * bb[3]);
                float o = (S0 * rr[0] + S1 * rr[1]) + (S2 * rr[2] + S3 * rr[3]); o = red16(o);
                if (c == 0) { const int s = ci * SC_TS + stp; OSC[((size_t)dir * TT + (size_t)SC_TOK(s)) * 512 + h * 64 + rh * 32 + row] = o; }
            }
            if (ci + 1 < NCH) SC_STORE((ci + 1) & 1);
            __syncthreads();
        }
#undef SC_TOK
#undef SC_LOAD
#undef SC_STORE
    }
}

__device__ __forceinline__ void p_readout(Frame& F, const Args& A, int l) {
    unsigned char* const ws = launder(F.ws);
    const int tid = (F.wave * 64 + hw_lane()), lane = tid & 63; (void)lane;
    const int gw = F.vcu * NWAVES + F.wave, NGW = F.G * NWAVES;
    const float* OSC = (const float*)(ws + WS_OSC);
    const unsigned* Rst = (const unsigned*)(ws + WS_R); const unsigned* Vst = (const unsigned*)(ws + WS_V); const unsigned* Kst = (const unsigned*)(ws + WS_K); const unsigned* LOUT = (const unsigned*)(ws + WS_LOUT);
    bf16* QO = (bf16*)(ws + WS_QO);
    float rk0[4], rk1[4], gw0[4], gw1[4], gb0[4], gb1[4], ka0[4], ka1[4], aa0[4], aa1[4], ab0[4], ab1[4];
#pragma unroll
    for (int i = 0; i < 4; ++i) { const int cc = 128 * i + 2 * lane, cidx = l * 512 + cc; rk0[i] = INP(IN_RK)[cidx]; rk1[i] = INP(IN_RK)[cidx + 1]; gw0[i] = INP(IN_GNW)[cidx]; gw1[i] = INP(IN_GNW)[cidx + 1]; gb0[i] = INP(IN_GNB)[cidx]; gb1[i] = INP(IN_GNB)[cidx + 1];
        ka0[i] = INP(IN_KA)[cidx]; ka1[i] = INP(IN_KA)[cidx + 1]; aa0[i] = INP(IN_A0)[l * 1024 + cc]; aa1[i] = INP(IN_A0)[l * 1024 + cc + 1]; ab0[i] = INP(IN_A0)[l * 1024 + 512 + cc]; ab1[i] = INP(IN_A0)[l * 1024 + 512 + cc + 1]; }
    for (int row = gw; row < TT; row += NGW) {
#pragma unroll
        for (int i = 0; i < 4; ++i) {
            const size_t off = (size_t)row * 256 + 64 * i + lane; const size_t lo = (size_t)row * (LORA_N / 2) + 64 * i + lane;
            const float2 oa = *(const float2*)(OSC + (size_t)row * 512 + 128 * i + 2 * lane), ob = *(const float2*)(OSC + ((size_t)TT + row) * 512 + 128 * i + 2 * lane);
            const float o0 = oa.x + ob.x, o1 = oa.y + ob.y;
            const float mean = half_sum(o0 + o1) * (1.0f / 64.0f);
            const float d0 = o0 - mean, d1 = o1 - mean;
            const float var = half_sum(d0 * d0 + d1 * d1) * (1.0f / 64.0f);
            const float rs = 1.0f / sqrtf(var + GN_EPS);
            const unsigned rw = Rst[off], vw = Vst[off], kw = Kst[off], pa = LOUT[lo + 512], pb = LOUT[lo + 768], gwd = LOUT[lo + 1024];
            const float ks0 = bflo(kw) * (2.0f + (sigm(bflo(pa) + aa0[i]) + sigm(bflo(pb) + ab0[i]) - 2.0f) * ka0[i]), ks1 = bfhi(kw) * (2.0f + (sigm(bfhi(pa) + aa1[i]) + sigm(bfhi(pb) + ab1[i]) - 2.0f) * ka1[i]);
            const float bsum = half_sum(bflo(rw) * ks0 * rk0[i] + bfhi(rw) * ks1 * rk1[i]);
            const float y0 = d0 * rs * gw0[i] + gb0[i] + bsum * bflo(vw), y1 = d1 * rs * gw1[i] + gb1[i] + bsum * bfhi(vw);
            *(unsigned*)(QO + (size_t)row * 1024 + 512 + 128 * i + 2 * lane) = pkbf(y0 * bflo(gwd), y1 * bfhi(gwd));
        }
    }
}

__device__ __forceinline__ void p_route(Frame& F, int nrows) {
    unsigned char* const ws = launder(F.ws);
    const int tid = (F.wave * 64 + hw_lane()), lane = tid & 63; (void)lane;
    const int gw = F.vcu * NWAVES + F.wave, NGW = F.G * NWAVES;
    const int* wcnt = (const int*)(ws + WS_ROUTE + RT_WCNT);
    LAS int* pexp = (LAS int*)(F.lds + LT_PEXP); LAS int* npan = (LAS int*)(F.lds + LT_NPAN); LAS int* tmp = (LAS int*)(F.lds + LT_TMP);
    {   const int e = lane & 7, part = lane >> 3;
        const int p = F.wave * 8 + part;
        const int wb = p * (NGW / 64), we = wb + NGW / 64; const int myw0 = F.vcu * NWAVES;
        int tot = 0, before = 0;
#pragma unroll 16
        for (int w = wb; w < we; ++w) { const int cv = wcnt[(size_t)w * 8 + e]; tot += cv; if (w < myw0) before += cv; }
        tmp[p * 16 + e] = tot; tmp[p * 16 + 8 + e] = before;
    }
    __syncthreads();
    if (tid < 8) { int tot = 0, before = 0; for (int p = 0; p < 64; ++p) { tot += tmp[p * 16 + tid]; before += tmp[p * 16 + 8 + tid]; } tmp[1024 + tid] = tot; tmp[1032 + tid] = before; }
    __syncthreads();
    if (tid == 0) { int acc = 0; for (int e = 0; e < 8; ++e) { const int padded = (tmp[1024 + e] + 255) & ~255; tmp[1040 + e] = acc; acc += padded; tmp[1048 + e] = acc; } npan[0] = acc >> 8; }
    __syncthreads();
    for (int p = tid; p < 320; p += NWAVES * 64) { int e = 7; for (int q = 7; q >= 0; --q) if (p * 256 < tmp[1048 + q]) e = q; pexp[p] = e; }
    int base0, base1, base2, base3, base4, base5, base6, base7;
    {   int bsv[8];
#pragma unroll
        for (int e = 0; e < 8; ++e) bsv[e] = tmp[1040 + e] + tmp[1032 + e];
        typedef int i32x4 __attribute__((ext_vector_type(4)));
#pragma unroll
        for (int w = 0; w < 7; ++w) { const i32x4* wp = (const i32x4*)(wcnt + (size_t)(F.vcu * NWAVES + w) * 8); const i32x4 c0 = wp[0], c1 = wp[1]; const int mk = (w < F.wave) ? 1 : 0;
            bsv[0] += mk * c0[0]; bsv[1] += mk * c0[1]; bsv[2] += mk * c0[2]; bsv[3] += mk * c0[3]; bsv[4] += mk * c1[0]; bsv[5] += mk * c1[1]; bsv[6] += mk * c1[2]; bsv[7] += mk * c1[3]; }
        base0 = bsv[0]; base1 = bsv[1]; base2 = bsv[2]; base3 = bsv[3]; base4 = bsv[4]; base5 = bsv[5]; base6 = bsv[6]; base7 = bsv[7];
    }
    const int* route_e = (const int*)(ws + WS_ROUTE + RT_E); int* route_s = (int*)(ws + WS_ROUTE + RT_S);
    const unsigned char* H = (const unsigned char*)F.out; unsigned char* AG = ws + WS_AG8;
    int ee_n = 0; v4u a_n = (v4u){0u, 0u, 0u, 0u};
    if (gw < nrows) { ee_n = route_e[gw]; a_n = ((const v4u*)(H + (size_t)gw * 1024))[lane]; }
    for (int row = gw; row < nrows; row += NGW) {
        const int ee = ee_n; const v4u a = a_n; const int e0 = ee & 255, e1 = ee >> 8;
        if (row + NGW < nrows) { ee_n = route_e[row + NGW]; a_n = ((const v4u*)(H + (size_t)(row + NGW) * 1024))[lane]; }
        int s0 = 0, s1 = 0;
#define RT_TAKE(E, B) do { if (e0 == E) { s0 = B; B += 1; } if (e1 == E) { s1 = B; B += 1; } } while (0)
        RT_TAKE(0, base0); RT_TAKE(1, base1); RT_TAKE(2, base2); RT_TAKE(3, base3); RT_TAKE(4, base4); RT_TAKE(5, base5); RT_TAKE(6, base6); RT_TAKE(7, base7);
#undef RT_TAKE
        if (lane == 0) { route_s[2 * row] = s0; route_s[2 * row + 1] = s1; }
        ((v4u*)(AG + (size_t)s0 * 1024))[lane] = a; ((v4u*)(AG + (size_t)s1 * 1024))[lane] = a;
    }
    __syncthreads();
}

__device__ __forceinline__ void p_attn(Frame& F, char* ldsg, bool ctx_on) {
    unsigned char* const ws = launder(F.ws);
    const int tid = (F.wave * 64 + hw_lane()), lane = tid & 63; (void)lane;
    typedef attn_body::bf16 abf;
    const abf* Q = (const abf*)(ws + WS_QO); const abf* K = (const abf*)(ws + WS_KB); const abf* V = (const abf*)(ws + WS_VB); abf* O = (abf*)(ws + WS_QO);
    const int per = (1024 + F.G - 1) / F.G;
    for (int i = 0; i < per; ++i) { const int un = F.vcu * per + i; if (un >= 1024) break;
        const int bh = un >> 4, qb = un & 15, b = bh >> 3, h = bh & 7;
        attn_body::attn_unit<8>((long)b * SEQL + qb * 256, h * 64, (long)b * KVLEN, (h >> 2) * 64, KVLEN / 64, Q, K, V, O, ldsg, F.wave); }
    if (ctx_on) for (int un = F.vcu; un < 64; un += F.G) { const int b = un >> 3, h = un & 7;
        attn_body::attn_unit<8>((long)TL + b * CTXL, h * 64, (long)b * KVLEN + SEQL, (h >> 2) * 64, CTXL / 64, Q, K, V, O, ldsg, F.wave); }
}

typedef float f32x16 __attribute__((ext_vector_type(16)));
typedef unsigned u32x2 __attribute__((ext_vector_type(2)));
constexpr int SCH = 64, NCHK = KVLEN / SCH, NITEM = 128 * NCHK;
constexpr int LSTR = 144;
constexpr int L_AKK = 0, L_AR = 9216, L_AK = 18432, L_AB = 27648, L_TK = 36864, L_TB = 46080, L_TV = 55296, L_TW1 = 64512, L_TU = 73728, L_MLK = 82944, L_MMB = 92160, L_MMK = 101376;
constexpr int L_FLB = 110592, L_GC = 126976, L_TII = 127232, L_FX = L_AK;
static_assert(L_TII + 2048 <= RING_BYTES, "scan LDS map");
__device__ __forceinline__ unsigned short bf1(float x) { return (unsigned short)(pkbf(x, 0.f) & 0xffffu); }
__device__ __forceinline__ bf16x8 ldsv8(const LAS unsigned char* p) { return *(const LAS bf16x8*)p; }
template <bool SWA = false, bool SWB = false>
__device__ __forceinline__ f32x16 tile32(const LAS unsigned char* Ab, const LAS unsigned char* Bb, int mi, int ni, int r, int h, f32x16 acc) {
    const int ra = 32 * mi + r, rb = 32 * ni + r; const int xa = SWA ? ((ra >> 3) & 7) : 0, xb = SWB ? ((rb >> 3) & 7) : 0;
#pragma unroll
    for (int kb = 0; kb < 4; ++kb) { const bf16x8 a = ldsv8(Ab + ra * LSTR + (((2 * kb + h) ^ xa) << 4)), b = ldsv8(Bb + rb * LSTR + (((2 * kb + h) ^ xb) << 4));
        acc = __builtin_amdgcn_mfma_f32_32x32x16_bf16(a, b, acc, 0, 0, 0); }
    return acc;
}
__device__ __forceinline__ int jperm(int j) { return (((j >> 2) & 3) << 4) | (((j >> 5) & 1) << 3) | (((j >> 4) & 1) << 2) | (j & 3); }
#define CROW(reg, h) (((reg) & 3) + 8 * ((reg) >> 2) + 4 * (h))


#if DEBUG_NAN
#define DBG_BF(k, off, nbytes) do { unsigned bad_ = 0; for (int i_ = tid; i_ < (nbytes) / 2; i_ += 512) { const int row_ = i_ / 72, col_ = i_ % 72; if (col_ < 64) { const float v_ = __builtin_bit_cast(float, (unsigned)(*(const LAS unsigned short*)(L + (off) + row_ * LSTR + col_ * 2)) << 16); if (!(fabsf(v_) < 1e30f)) ++bad_; } } if (bad_) atomicAdd((unsigned*)(F.ctl + 16 + (k)), bad_); } while (0)
#define DBG_F32(k, off, n) do { unsigned bad_ = 0; for (int i_ = tid; i_ < (n); i_ += 512) { const float v_ = ((const LAS float*)(L + (off)))[i_]; if (!(fabsf(v_) < 1e30f)) ++bad_; } if (bad_) atomicAdd((unsigned*)(F.ctl + 16 + (k)), bad_); } while (0)
#else
#define DBG_BF(k, off, nbytes) do {} while (0)
#define DBG_F32(k, off, n) do {} while (0)
#endif
#define WG_BAR() do { asm volatile("s_waitcnt lgkmcnt(0)" ::: "memory"); __builtin_amdgcn_s_barrier(); asm volatile("" ::: "memory"); } while (0)
template <int CTRL, int RMASK> __device__ __forceinline__ float dppm(float v) { return __builtin_bit_cast(float, __builtin_amdgcn_update_dpp(0, __builtin_bit_cast(int, v), CTRL, RMASK, 0xf, true)); }
__device__ __forceinline__ float wave_incl_scan(float x) {
    x += dppm<0x111, 0xf>(x); x += dppm<0x112, 0xf>(x); x += dppm<0x114, 0xf>(x); x += dppm<0x118, 0xf>(x);
    x += __builtin_bit_cast(float, __builtin_amdgcn_update_dpp(0, __builtin_bit_cast(int, x), 0x142, 0xa, 0xf, false));
    x += __builtin_bit_cast(float, __builtin_amdgcn_update_dpp(0, __builtin_bit_cast(int, x), 0x143, 0xc, 0xf, false));
    return x;
}
struct S1In { v4u kk, r, k, v, pw, pa; f32x4 ka[2]; };
__device__ __forceinline__ void s1_item(Frame& F, unsigned char* const ws, const int lane, const int wv, const int l, const int item, const S1In& cur, S1In& nxt, const float* w0b, const float* a0b, const float* kab, unsigned long long (&cy)[6]) {
#if CYSEL >= 0
#define CY(k) do { const unsigned long long now_ = __builtin_readcyclecounter(); cy[k] += now_ - cy[5]; cy[5] = now_; } while (0)
#else
#define CY(k) do {} while (0)
#endif
    LAS unsigned char* L = F.lds + RING_OFF;
    const bf16* KKst = (const bf16*)(ws + WS_KK); const bf16* Kst = (const bf16*)(ws + WS_K); const bf16* Rst = (const bf16*)(ws + WS_R); const bf16* Vst = (const bf16*)(ws + WS_V); const bf16* LOUT = (const bf16*)(ws + WS_LOUT);
    bf16* PT = (bf16*)(ws + WS_SPT); bf16* GG = (bf16*)(ws + WS_SG); bf16* QQ = (bf16*)(ws + WS_SQ); float* OSC = (float*)(ws + WS_OSC);
    const int r = lane & 31, h = lane >> 5;
#define S1_ITEM(item_) const int chain = (item_) / NCHK, c = (item_) - chain * NCHK, dir = chain & 1, bh = chain >> 1, b = bh >> 3, hd = bh & 7; const int s0 = c * SCH; const int dsg = dir ? -1 : 1; \
        const int tok0 = (s0 < CTXL) ? (TL + b * CTXL + (dir ? (CTXL - 1 - s0) : s0)) : (b * SEQL + (dir ? (SEQL - 1 - (s0 - CTXL)) : (s0 - CTXL)));
#define S1_TOUCH(D) asm volatile("" :: "v"(D.kk), "v"(D.r), "v"(D.k), "v"(D.v), "v"(D.pw), "v"(D.pa), "v"(D.ka[0]), "v"(D.ka[1]))
#define S1_LOAD(D, item_) do { S1_ITEM(item_) const size_t tokr = (size_t)(tok0 + dsg * (8 * wv + (lane >> 3))); const size_t o5 = tokr * 512 + hd * 64 + 8 * (lane & 7); \
        D.kk = *(const v4u*)(KKst + o5); D.r = *(const v4u*)(Rst + o5); D.k = *(const v4u*)(Kst + o5); D.v = *(const v4u*)(Vst + o5); \
        D.pw = *(const v4u*)(LOUT + tokr * LORA_N + dir * 512 + hd * 64 + 8 * (lane & 7)); D.pa = *(const v4u*)(LOUT + tokr * LORA_N + 1024 + dir * 512 + hd * 64 + 8 * (lane & 7)); \
        { D.ka[0] = *(const f32x4*)(kab + hd * 64 + 8 * (lane & 7)); D.ka[1] = *(const f32x4*)(kab + hd * 64 + 8 * (lane & 7) + 4); } } while (0)
    {
        S1_ITEM(item)
        {   const v4u kk8 = cur.kk, r8 = cur.r, k8 = cur.k, v8 = cur.v, pw8 = cur.pw, pa8 = cur.pa; const int jg = lane & 7, t = 8 * wv + (lane >> 3);
            const float kap[8] = {cur.ka[0][0], cur.ka[0][1], cur.ka[0][2], cur.ka[0][3], cur.ka[1][0], cur.ka[1][1], cur.ka[1][2], cur.ka[1][3]};
            LAS float* tot = (LAS float*)(L + L_TII);
            float lw[8], av[8], lam[8];
#pragma unroll
            for (int e = 0; e < 8; ++e) { const unsigned pw = pw8[e >> 1], pa = pa8[e >> 1]; const float zw = (e & 1) ? bfhi(pw) : bflo(pw), za = (e & 1) ? bfhi(pa) : bflo(pa);
                lw[e] = zw; av[e] = za; lam[e] = lw[e]; }
#pragma unroll
            for (int sh = 8; sh <= 32; sh <<= 1) { float y[8];
#pragma unroll
                for (int e = 0; e < 8; ++e) y[e] = __shfl_up(lam[e], sh);
#pragma unroll
                for (int e = 0; e < 8; ++e) if (lane >= sh) lam[e] += y[e]; }
            if (lane >= 56) { *(LAS f32x4*)(tot + wv * 64 + 8 * jg) = (f32x4){lam[0], lam[1], lam[2], lam[3]}; *(LAS f32x4*)(tot + wv * 64 + 8 * jg + 4) = (f32x4){lam[4], lam[5], lam[6], lam[7]}; }
            if (item + F.G < NITEM) S1_LOAD(nxt, item + F.G);
            WG_BAR();
            for (int w = 0; w < wv; ++w) { const f32x4 q0 = *(const LAS f32x4*)(tot + w * 64 + 8 * jg), q1 = *(const LAS f32x4*)(tot + w * 64 + 8 * jg + 4);
                lam[0] += q0[0]; lam[1] += q0[1]; lam[2] += q0[2]; lam[3] += q0[3]; lam[4] += q1[0]; lam[5] += q1[1]; lam[6] += q1[2]; lam[7] += q1[3]; }
            v4u wkk, wrr, wkd, wbd;
#pragma unroll
            for (int p = 0; p < 4; ++p) { float okk[2], orr[2], okd[2], obd[2];
#pragma unroll
                for (int u = 0; u < 2; ++u) { const int e = 2 * p + u;
                    const unsigned xkk = kk8[p], xr = r8[p], xk = k8[p];
                    const float kkv = u ? bfhi(xkk) : bflo(xkk), rv = u ? bfhi(xr) : bflo(xr), kv = u ? bfhi(xk) : bflo(xk);
                    const float eNp = __builtin_amdgcn_exp2f(-1.4426950408889634f * (lam[e] - lw[e])), eN = __builtin_amdgcn_exp2f(-1.4426950408889634f * lam[e]), eP = __builtin_amdgcn_exp2f(1.4426950408889634f * lam[e]);
                    okk[u] = kkv * eNp; orr[u] = rv * eN; okd[u] = kv * (1.0f + (av[e] - 1.0f) * kap[e]) * eP; obd[u] = kkv * av[e] * eP;
                    if (t == SCH - 1) ((LAS float*)(L + L_GC))[8 * jg + e] = eN; }
                wkk[p] = pkbf(okk[0], okk[1]); wrr[p] = pkbf(orr[0], orr[1]); wkd[p] = pkbf(okd[0], okd[1]); wbd[p] = pkbf(obd[0], obd[1]); }
            *(LAS v4u*)(L + L_AKK + t * LSTR + jg * 16) = wkk; *(LAS v4u*)(L + L_AR + t * LSTR + jg * 16) = wrr; *(LAS v4u*)(L + L_AK + t * LSTR + jg * 16) = wkd; *(LAS v4u*)(L + L_AB + t * LSTR + jg * 16) = wbd;
#pragma unroll
            for (int e = 0; e < 8; ++e) { const int j = 8 * jg + e; const unsigned wk = wkd[e >> 1], wb = wbd[e >> 1], wvv = v8[e >> 1];
                const int to = j * LSTR + ((wv ^ jg) << 4) + (lane >> 3) * 2;
                *(LAS unsigned short*)(L + L_TK + to) = (unsigned short)((e & 1) ? (wk >> 16) : (wk & 0xffffu));
                *(LAS unsigned short*)(L + L_TB + to) = (unsigned short)((e & 1) ? (wb >> 16) : (wb & 0xffffu));
                *(LAS unsigned short*)(L + L_TV + to) = (unsigned short)((e & 1) ? (wvv >> 16) : (wvv & 0xffffu)); }
        }
        WG_BAR();
        CY(0);
#pragma unroll
        for (int jj = 0; jj < 2; ++jj) {
            const int job = 2 * wv + jj, m = job >> 2, si = (job >> 1) & 1, ti = job & 1;
            f32x16 acc = {};
            if (!(si == 1 && ti == 0)) acc = tile32(L + ((m & 1) ? L_AK : L_AB), L + (m < 2 ? L_AKK : L_AR), si, ti, r, h, acc);
            const int tt = 32 * ti + r;
#pragma unroll
            for (int g = 0; g < 4; ++g) { const int sb = 32 * si + 8 * g + 4 * h; float vv[4];
#pragma unroll
                for (int i = 0; i < 4; ++i) { const int s = sb + i; const bool keep = (m < 2) ? (s < tt) : (s <= tt); vv[i] = keep ? acc[4 * g + i] : 0.f; }
                if (m == 0) *(LAS f32x4*)((LAS float*)(L + L_FLB) + tt * 64 + sb) = (f32x4){vv[0], vv[1], vv[2], vv[3]};
                else *(LAS u32x2*)(L + (m == 1 ? L_MLK : (m == 2 ? L_MMB : L_MMK)) + tt * LSTR + sb * 2) = (u32x2){pkbf(vv[0], vv[1]), pkbf(vv[2], vv[3])}; }
        }
        WG_BAR();
        CY(1);
        f32x16 acc_o1 = {};
        {   const int q4 = wv & 3, mi = q4 >> 1, ni = q4 & 1;
            if (wv < 4) { f32x16 acc = {}; acc = tile32<false, true>(L + L_MLK, L + L_TV, mi, ni, r, h, acc);
#pragma unroll
                for (int reg = 0; reg < 16; ++reg) ((LAS float*)(L + L_FX))[(32 * mi + CROW(reg, h)) * 64 + 32 * ni + r] = acc[reg];
                const int col = lane & 15; const LAS float* lb = (const LAS float*)(L + L_FLB) + (16 * wv) * 64 + 16 * wv; float x[16];
#pragma unroll
                for (int tt = 0; tt < 16; ++tt) { float a = (tt == col) ? 1.0f : 0.0f;
#pragma unroll
                    for (int s4 = 0; s4 < tt; s4 += 4) { const f32x4 lv = *(const LAS f32x4*)(lb + tt * 64 + s4);
#pragma unroll
                        for (int u = 0; u < 4; ++u) if (s4 + u < tt) a -= lv[u] * x[s4 + u]; }
                    x[tt] = a; }
                if (lane < 16) {
#pragma unroll
                    for (int tt = 0; tt < 16; ++tt) *(LAS unsigned short*)(L + L_TII + wv * 512 + tt * 32 + col * 2) = bf1(x[tt]); }
            } else acc_o1 = tile32<true, false>(L + L_TV, L + L_MMK, mi, ni, r, h, acc_o1);
        }
        WG_BAR();
        CY(2);
        {   const int cc = lane & 15, q = lane >> 4; const bool isw = wv < 4; const int colb = 16 * (wv & 3) + cc;
            f32x4 U[4];
#pragma unroll
            for (int i = 0; i < 4; ++i) {
                f32x4 R;
#pragma unroll
                for (int reg = 0; reg < 4; ++reg) { const int tt = 16 * i + 4 * q + reg;
                    R[reg] = isw ? __builtin_bit_cast(float, (unsigned)(*(const LAS unsigned short*)(L + L_AKK + tt * LSTR + colb * 2)) << 16) : ((const LAS float*)(L + L_FX))[tt * 64 + colb]; }
#pragma unroll
                for (int kp = 0; kp < 2; ++kp) { if (2 * kp < i) {
                    const int k1 = 2 * kp, k2 = 2 * kp + 1; const bool two = (k2 < i);
                    const LAS float* lrow = (const LAS float*)(L + L_FLB) + (16 * i + cc) * 64;
                    const f32x4 la = *(const LAS f32x4*)(lrow + 16 * k1 + 4 * q); f32x4 lb2 = {0.f, 0.f, 0.f, 0.f}; if (two) lb2 = *(const LAS f32x4*)(lrow + 16 * k2 + 4 * q);
                    const v4u aw = (v4u){pkbf(-la[0], -la[1]), pkbf(-la[2], -la[3]), pkbf(-lb2[0], -lb2[1]), pkbf(-lb2[2], -lb2[3])};
                    const f32x4 u1 = U[k1]; f32x4 u2 = {0.f, 0.f, 0.f, 0.f}; if (two) u2 = U[k2];
                    const v4u bh_ = (v4u){pkbf(u1[0], u1[1]), pkbf(u1[2], u1[3]), pkbf(u2[0], u2[1]), pkbf(u2[2], u2[3])};
                    R = __builtin_amdgcn_mfma_f32_16x16x32_bf16(__builtin_bit_cast(bf16x8, aw), __builtin_bit_cast(bf16x8, bh_), R, 0, 0, 0); } }
                const u32x2 tw = *(const LAS u32x2*)(L + L_TII + i * 512 + cc * 32 + q * 8);
                const v4u ta = (v4u){tw.x, tw.y, 0u, 0u};
                const v4u rh = (v4u){pkbf(R[0], R[1]), pkbf(R[2], R[3]), 0u, 0u};
                f32x4 u = {0.f, 0.f, 0.f, 0.f};
                u = __builtin_amdgcn_mfma_f32_16x16x32_bf16(__builtin_bit_cast(bf16x8, ta), __builtin_bit_cast(bf16x8, rh), u, 0, 0, 0);
                U[i] = u;
                *(LAS u32x2*)(L + (isw ? L_TW1 : L_TU) + colb * LSTR + (16 * i + 4 * q) * 2) = (u32x2){pkbf(u[0], u[1]), pkbf(u[2], u[3])};
            }
        }
        WG_BAR();
        CY(3);
        S1_TOUCH(nxt);
        {   const int q4 = wv & 3, mi = q4 >> 1, ni = q4 & 1; const LAS float* gc = (const LAS float*)(L + L_GC);
            if (wv < 4) {
                f32x16 acc = {}; acc = tile32<false, true>(L + L_TW1, L + L_TB, mi, ni, r, h, acc);
                const int jp = 32 * ni + r; const float gj = gc[jp]; bf16* pt = PT + (size_t)item * 4096 + (size_t)jp * 64;
#pragma unroll
                for (int gp2 = 0; gp2 < 2; ++gp2) { unsigned pw[4];
#pragma unroll
                    for (int u = 0; u < 2; ++u) { const int g = gp2 + 2 * u, j0 = 32 * mi + 8 * g + 4 * h; float pv[4];
#pragma unroll
                        for (int i = 0; i < 4; ++i) pv[i] = (((j0 + i) == jp ? 1.0f : 0.0f) - acc[4 * g + i]) * gj;
                        pw[2 * u] = pkbf(pv[0], pv[1]); pw[2 * u + 1] = pkbf(pv[2], pv[3]); }
                    *(v4u*)(pt + 16 * (2 * gp2 + h) + 8 * mi) = (v4u){pw[0], pw[1], pw[2], pw[3]}; }
                f32x16 acq = {}; acq = tile32(L + L_TW1, L + L_MMB, mi, ni, r, h, acq);
                const int tt = 32 * ni + r; bf16* qq = QQ + (size_t)item * 4096 + (size_t)tt * 64;
#pragma unroll
                for (int gp2 = 0; gp2 < 2; ++gp2) { unsigned qw[4];
#pragma unroll
                    for (int u = 0; u < 2; ++u) { const int g = gp2 + 2 * u, j0 = 32 * mi + 8 * g + 4 * h; const u32x2 rw = *(const LAS u32x2*)(L + L_AR + tt * LSTR + j0 * 2);
                        qw[2 * u] = pkbf(bflo(rw.x) - acq[4 * g], bfhi(rw.x) - acq[4 * g + 1]); qw[2 * u + 1] = pkbf(bflo(rw.y) - acq[4 * g + 2], bfhi(rw.y) - acq[4 * g + 3]); }
                    *(v4u*)(qq + 16 * (2 * gp2 + h) + 8 * mi) = (v4u){qw[0], qw[1], qw[2], qw[3]}; }
            } else {
                f32x16 acc = {}; acc = tile32(L + L_TU, L + L_MMB, mi, ni, r, h, acc);
                const int tt = 32 * ni + r; bf16* op = (bf16*)OSC + ((size_t)dir * TT + (size_t)(tok0 + dsg * tt)) * 512 + hd * 64;
#pragma unroll
                for (int gp2 = 0; gp2 < 2; ++gp2) { unsigned ow_[4];
#pragma unroll
                    for (int u = 0; u < 2; ++u) { const int g = gp2 + 2 * u; ow_[2 * u] = pkbf(acc_o1[4 * g] - acc[4 * g], acc_o1[4 * g + 1] - acc[4 * g + 1]); ow_[2 * u + 1] = pkbf(acc_o1[4 * g + 2] - acc[4 * g + 2], acc_o1[4 * g + 3] - acc[4 * g + 3]); }
                    *(v4u*)(op + 16 * (2 * gp2 + h) + 8 * mi) = (v4u){ow_[0], ow_[1], ow_[2], ow_[3]}; }
                f32x16 ag = {}; ag = tile32<true, true>(L + L_TK, L + L_TV, mi, ni, r, h, ag);
                f32x16 ah = {}; ah = tile32<true, false>(L + L_TB, L + L_TU, mi, ni, r, h, ah);
                const int v = 32 * ni + r; bf16* gp = GG + (size_t)item * 4096 + (size_t)v * 64;
#pragma unroll
                for (int gp2 = 0; gp2 < 2; ++gp2) { unsigned gw_[4];
#pragma unroll
                    for (int u = 0; u < 2; ++u) { const int g = gp2 + 2 * u, j0 = 32 * mi + 8 * g + 4 * h; const f32x4 gj = *(const LAS f32x4*)(gc + j0); float gv[4];
#pragma unroll
                        for (int i = 0; i < 4; ++i) gv[i] = (ag[4 * g + i] - ah[4 * g + i]) * gj[i];
                        gw_[2 * u] = pkbf(gv[0], gv[1]); gw_[2 * u + 1] = pkbf(gv[2], gv[3]); }
                    *(v4u*)(gp + 16 * (2 * gp2 + h) + 8 * mi) = (v4u){gw_[0], gw_[1], gw_[2], gw_[3]}; }
            }
        }
        WG_BAR();
        CY(4);
    }
#undef CY
}
__device__ __forceinline__ void p_scan1(Frame& F, const Args& A, int l) {
    unsigned char* const ws = launder(F.ws);
    const int tid = (F.wave * 64 + hw_lane()), lane = tid & 63, wv = F.wave;
    const bf16* KKst = (const bf16*)(ws + WS_KK); const bf16* Kst = (const bf16*)(ws + WS_K); const bf16* Rst = (const bf16*)(ws + WS_R); const bf16* Vst = (const bf16*)(ws + WS_V); const bf16* LOUT = (const bf16*)(ws + WS_LOUT);
    const float* w0b = INP(IN_W0) + l * 1024; const float* a0b = INP(IN_A0) + l * 1024; const float* kab = INP(IN_KA) + l * 512;
    S1In sa = {}, sb = {}; unsigned long long cy[6] = {0, 0, 0, 0, 0, 0};
#if CYSEL >= 0
    cy[5] = __builtin_readcyclecounter();
#endif
    if ((int)blockIdx.x < NITEM) S1_LOAD(sa, (int)blockIdx.x);
    S1_TOUCH(sa);
    for (int item = blockIdx.x; item < NITEM; item += 2 * F.G) {
        s1_item(F, ws, lane, wv, l, item, sa, sb, w0b, a0b, kab, cy);
        if (item + F.G < NITEM) s1_item(F, ws, lane, wv, l, item + F.G, sb, sa, w0b, a0b, kab, cy);
    }
#if CYSEL >= 0
    if (blockIdx.x == 0 && F.wave == 0 && hw_lane() == 0) { unsigned long long* cs_ = (unsigned long long*)(F.ws + WS_CTL + 40960); for (int k = 0; k < 5; ++k) cs_[k] += cy[k]; }
#endif
}
#undef S1_ITEM
#undef S1_LOAD
#undef S1_TOUCH

struct S2Ops { v4u pa[4][2]; v4u gt[2]; };
__device__ __forceinline__ void s2_load(S2Ops& o, const bf16* PT, const bf16* GG, int chain, int c, int cc, int q, int v) {
    const size_t ib = ((size_t)chain * NCHK + c) * 4096;
#pragma unroll
    for (int J = 0; J < 4; ++J) { const bf16* prow = PT + ib + (size_t)(16 * J + cc) * 64;
#pragma unroll
        for (int kb = 0; kb < 2; ++kb) o.pa[J][kb] = *(const v4u*)(prow + 16 * q + 8 * kb); }
#pragma unroll
    for (int kb = 0; kb < 2; ++kb) o.gt[kb] = *(const v4u*)(GG + ib + (size_t)v * 64 + 16 * q + 8 * kb);
}
__device__ __forceinline__ void s2_step(f32x4 (&St)[4], const S2Ops& o, bf16* S0, int chain, int c, int q, int v) {
    const size_t ib = ((size_t)chain * NCHK + c) * 4096;
    v4u bh_[2], bl_[2];
#pragma unroll
    for (int kb = 0; kb < 2; ++kb) { const f32x4 u1 = St[2 * kb], u2 = St[2 * kb + 1];
        bh_[kb] = (v4u){pkbf(u1[0], u1[1]), pkbf(u1[2], u1[3]), pkbf(u2[0], u2[1]), pkbf(u2[2], u2[3])};
        bl_[kb] = (v4u){pkbf(u1[0] - bflo(bh_[kb].x), u1[1] - bfhi(bh_[kb].x)), pkbf(u1[2] - bflo(bh_[kb].y), u1[3] - bfhi(bh_[kb].y)), pkbf(u2[0] - bflo(bh_[kb].z), u2[1] - bfhi(bh_[kb].z)), pkbf(u2[2] - bflo(bh_[kb].w), u2[3] - bfhi(bh_[kb].w))};
        *(v4u*)(S0 + ib + (size_t)v * 64 + 16 * q + 8 * kb) = bh_[kb]; }
#pragma unroll
    for (int J = 0; J < 4; ++J) { const unsigned g0 = (J & 1) ? o.gt[J >> 1].z : o.gt[J >> 1].x, g1 = (J & 1) ? o.gt[J >> 1].w : o.gt[J >> 1].y; f32x4 acc = (f32x4){bflo(g0), bfhi(g0), bflo(g1), bfhi(g1)};
#pragma unroll
        for (int kb = 0; kb < 2; ++kb) { const v4u aw = o.pa[J][kb];
            acc = __builtin_amdgcn_mfma_f32_16x16x32_bf16(__builtin_bit_cast(bf16x8, aw), __builtin_bit_cast(bf16x8, bh_[kb]), acc, 0, 0, 0);
            acc = __builtin_amdgcn_mfma_f32_16x16x32_bf16(__builtin_bit_cast(bf16x8, aw), __builtin_bit_cast(bf16x8, bl_[kb]), acc, 0, 0, 0); }
        St[J] = acc; }
}
__device__ __forceinline__ void p_scan2(Frame& F) {
    unsigned char* const ws = launder(F.ws);
    const int tid = (F.wave * 64 + hw_lane()), lane = tid & 63;
    const bf16* PT = (const bf16*)(ws + WS_SPT); const bf16* GG = (const bf16*)(ws + WS_SG); bf16* S0 = (bf16*)F.out;
    const int cc = lane & 15, q = lane >> 4;
    static_assert(NCHK % 4 == 0, "stage 2 ring depth");
    for (int wi = F.wave * F.G + (int)blockIdx.x; wi < 512; wi += NWAVES * F.G) {
        const int chain = wi >> 2, vg = wi & 3; const int v = 16 * vg + cc;
        f32x4 St[4];
#pragma unroll
        for (int J = 0; J < 4; ++J) St[J] = (f32x4){0.f, 0.f, 0.f, 0.f};
        S2Ops o0, o1, o2, o3;
        s2_load(o0, PT, GG, chain, 0, cc, q, v); s2_load(o1, PT, GG, chain, 1, cc, q, v); s2_load(o2, PT, GG, chain, 2, cc, q, v);
        for (int c = 0; c < NCHK; c += 4) {
            s2_load(o3, PT, GG, chain, c + 3, cc, q, v);                                  s2_step(St, o0, S0, chain, c, q, v);
            s2_load(o0, PT, GG, chain, (c + 4 < NCHK) ? c + 4 : NCHK - 1, cc, q, v); s2_step(St, o1, S0, chain, c + 1, q, v);
            s2_load(o1, PT, GG, chain, (c + 5 < NCHK) ? c + 5 : NCHK - 1, cc, q, v); s2_step(St, o2, S0, chain, c + 2, q, v);
            s2_load(o2, PT, GG, chain, (c + 6 < NCHK) ? c + 6 : NCHK - 1, cc, q, v); s2_step(St, o3, S0, chain, c + 3, q, v);
        }
    }
}

__device__ __forceinline__ void p_scan3(Frame& F) {
    unsigned char* const ws = launder(F.ws);
    const int tid = (F.wave * 64 + hw_lane()), lane = tid & 63;
    const bf16* QQ = (const bf16*)(ws + WS_SQ); const bf16* S0 = (const bf16*)F.out; float* OSC = (float*)(ws + WS_OSC);
    const int gw = F.vcu * NWAVES + F.wave, NGW = F.G * NWAVES; const int r = lane & 31, h = lane >> 5;
    bf16x8 sa[4], qb[4], sa2[4], qb2[4]; f32x4 ov[4], ov2[4]; float* op = nullptr; float* op2 = nullptr;
#define S3_LOAD(SA, QB, OV, OP, job_) do { const int item = (job_) >> 2, mi = ((job_) >> 1) & 1, ni = (job_) & 1; \
        const int chain = item / NCHK, c = item - chain * NCHK, dir = chain & 1, bh = chain >> 1, b = bh >> 3, hd = bh & 7; const int s0 = c * SCH + 32 * ni + r; \
        const int tok = (s0 < CTXL) ? (TL + b * CTXL + (dir ? (CTXL - 1 - s0) : s0)) : (b * SEQL + (dir ? (SEQL - 1 - (s0 - CTXL)) : (s0 - CTXL))); \
        const bf16* sp = S0 + (size_t)item * 4096 + (size_t)(32 * mi + r) * 64 + 8 * h; const bf16* qp = QQ + (size_t)item * 4096 + (size_t)(32 * ni + r) * 64 + 8 * h; \
        _Pragma("unroll") for (int kb = 0; kb < 4; ++kb) { SA[kb] = *(const bf16x8*)(sp + 16 * kb); QB[kb] = *(const bf16x8*)(qp + 16 * kb); } \
        OP = OSC + ((size_t)dir * TT + (size_t)tok) * 512 + hd * 64 + 32 * mi + 4 * h; \
        _Pragma("unroll") for (int g = 0; g < 4; ++g) OV[g] = *(const f32x4*)(OP + 8 * g); } while (0)
    int job = gw;
    if (job < NITEM * 4) S3_LOAD(sa, qb, ov, op, job);
    for (; job < NITEM * 4; job += NGW) {
        const int nj = job + NGW;
        if (nj < NITEM * 4) S3_LOAD(sa2, qb2, ov2, op2, nj);
        f32x16 acc = {};
#pragma unroll
        for (int kb = 0; kb < 4; ++kb) acc = __builtin_amdgcn_mfma_f32_32x32x16_bf16(sa[kb], qb[kb], acc, 0, 0, 0);
#pragma unroll
        for (int g = 0; g < 4; ++g) *(f32x4*)(op + 8 * g) = ov[g] + (f32x4){acc[4 * g], acc[4 * g + 1], acc[4 * g + 2], acc[4 * g + 3]};
#pragma unroll
        for (int kb = 0; kb < 4; ++kb) { sa[kb] = sa2[kb]; qb[kb] = qb2[kb]; ov[kb] = ov2[kb]; }
        op = op2;
    }
#undef S3_LOAD
}


__device__ __forceinline__ void s3_fetch(v4u (&d)[4], const bf16* base, size_t pitch, int lane) {
#pragma unroll
    for (int i = 0; i < 4; ++i) d[i] = *(const v4u*)(base + (size_t)((lane >> 3) + 8 * i) * pitch + (lane & 7) * 8);
}
template <bool PERMUTED = false>
__device__ __forceinline__ void s3_relayout(uint2 (&o)[8], const v4u (&d)[4], LAS unsigned char* stg, int lane) {
    const int r = lane & 31, h = lane >> 5;
#pragma unroll
    for (int i = 0; i < 4; ++i) *(LAS v4u*)(stg + ((lane >> 3) + 8 * i) * LSTR + (lane & 7) * 16) = d[i];
#pragma unroll
    for (int mi = 0; mi < 2; ++mi)
#pragma unroll
        for (int g = 0; g < 4; ++g) { const int c0 = 32 * mi + 8 * g + 4 * h; const u32x2 w = *(const LAS u32x2*)(stg + r * LSTR + (PERMUTED ? jperm(c0) : c0) * 2); o[mi * 4 + g] = make_uint2(w.x, w.y); }
}
__device__ __forceinline__ void p_scan3r(Frame& F, const Args& A, int l) {
    unsigned char* const ws = launder(F.ws);
    const int tid = (F.wave * 64 + hw_lane()), lane = tid & 63;
    const bf16* QQ = (const bf16*)(ws + WS_SQ); const bf16* S0 = (const bf16*)F.out; const bf16* OSC = (const bf16*)(ws + WS_OSC);
    const bf16* Rst = (const bf16*)(ws + WS_R); const bf16* Vst = (const bf16*)(ws + WS_V); const bf16* Kst = (const bf16*)(ws + WS_K); const bf16* LOUT = (const bf16*)(ws + WS_LOUT);
    bf16* QO = (bf16*)(ws + WS_QO);
    LAS unsigned char* stg = F.lds + RING_OFF + F.wave * 4608;
    const int gw = F.vcu * NWAVES + F.wave, NGW = F.G * NWAVES; const int r = lane & 31, h = lane >> 5;
    const float* rkp = INP(IN_RK) + l * 512; const float* gnwp = INP(IN_GNW) + l * 512; const float* gnbp = INP(IN_GNB) + l * 512; const float* kap = INP(IN_KA) + l * 512; const float* a0p = INP(IN_A0) + l * 1024;
    for (int unit = gw; unit < 64 * (KVLEN / 32); unit += NGW) {
        const int bh = unit / (KVLEN / 32), pb = unit - bh * (KVLEN / 32), b = bh >> 3, hd = bh & 7, p0 = pb * 32;
        const size_t tokb = (p0 < CTXL) ? (size_t)(TL + b * CTXL + p0) : (size_t)(b * SEQL + (p0 - CTXL)); const size_t tok = tokb + r;
        const int sb0 = (p0 < CTXL) ? (CTXL - 1 - p0) : (KVLEN + CTXL - 1 - p0);
        const int itf = (bh * 2) * NCHK + (p0 >> 6), itb = (bh * 2 + 1) * NCHK + (sb0 >> 6); const int tf = (p0 & 63) + r, tb = (sb0 & 63) - r;
        v4u ga[4], gb[4];
        s3_fetch(ga, OSC + tokb * 512 + hd * 64, 512, lane); s3_fetch(gb, OSC + ((size_t)TT + tokb) * 512 + hd * 64, 512, lane);
        f32x4 o[2][4];
        {   f32x16 acc[2][2];
#pragma unroll
            for (int d = 0; d < 2; ++d) { const size_t ib = (size_t)(d ? itb : itf) * 4096; const bf16* qp = QQ + ib + (size_t)(d ? tb : tf) * 64 + 8 * h;
                bf16x8 qf[4];
#pragma unroll
                for (int kb = 0; kb < 4; ++kb) qf[kb] = *(const bf16x8*)(qp + 16 * kb);
#pragma unroll
                for (int mi = 0; mi < 2; ++mi) { const bf16* sp = S0 + ib + (size_t)(32 * mi + r) * 64 + 8 * h; f32x16 a = {};
#pragma unroll
                    for (int kb = 0; kb < 4; ++kb) a = __builtin_amdgcn_mfma_f32_32x32x16_bf16(*(const bf16x8*)(sp + 16 * kb), qf[kb], a, 0, 0, 0);
                    acc[d][mi] = a; } }
#pragma unroll
            for (int mi = 0; mi < 2; ++mi)
#pragma unroll
                for (int g = 0; g < 4; ++g)
#pragma unroll
                    for (int i = 0; i < 4; ++i) o[mi][g][i] = acc[0][mi][4 * g + i] + acc[1][mi][4 * g + i]; }
        uint2 ta[8], tb8[8];
        s3_relayout<true>(ta, ga, stg, lane); s3_fetch(ga, Rst + tokb * 512 + hd * 64, 512, lane);
        s3_relayout<true>(tb8, gb, stg, lane); s3_fetch(gb, Kst + tokb * 512 + hd * 64, 512, lane);
        float s1 = 0.f;
#pragma unroll
        for (int mi = 0; mi < 2; ++mi)
#pragma unroll
            for (int g = 0; g < 4; ++g) { const uint2 of = ta[mi * 4 + g], ob = tb8[mi * 4 + g]; f32x4 v = o[mi][g];
                v[0] += bflo(of.x) + bflo(ob.x); v[1] += bfhi(of.x) + bfhi(ob.x); v[2] += bflo(of.y) + bflo(ob.y); v[3] += bfhi(of.y) + bfhi(ob.y);
                o[mi][g] = v; s1 += (v[0] + v[1]) + (v[2] + v[3]); }
        s1 += __shfl_xor(s1, 32); const float mean = s1 * (1.0f / 64.0f);
        const int cb = hd * 64 + 4 * h;
        float s2 = 0.f, bs = 0.f;
        f32x4 rkv[8], sa[8];
        {   uint2 rr8[8], kk8[8];
            s3_relayout(rr8, ga, stg, lane); s3_fetch(ga, LOUT + tokb * LORA_N + 1024 + hd * 64, LORA_N, lane);
            s3_relayout(kk8, gb, stg, lane); s3_fetch(gb, LOUT + tokb * LORA_N + 1536 + hd * 64, LORA_N, lane);
#pragma unroll
            for (int q = 0; q < 8; ++q) { const int cl = cb + 32 * (q >> 2) + 8 * (q & 3); const f32x4 rk4 = *(const f32x4*)(rkp + cl);
                f32x4 d = o[q >> 2][q & 3] - mean; o[q >> 2][q & 3] = d; s2 += (d[0] * d[0] + d[1] * d[1]) + (d[2] * d[2] + d[3] * d[3]);
                rkv[q] = (f32x4){bflo(rr8[q].x) * bflo(kk8[q].x) * rk4[0], bfhi(rr8[q].x) * bfhi(kk8[q].x) * rk4[1], bflo(rr8[q].y) * bflo(kk8[q].y) * rk4[2], bfhi(rr8[q].y) * bfhi(kk8[q].y) * rk4[3]}; } }
        {   uint2 pa8[8];
            s3_relayout(pa8, ga, stg, lane); s3_fetch(ga, Vst + tokb * 512 + hd * 64, 512, lane);
#pragma unroll
            for (int q = 0; q < 8; ++q) sa[q] = (f32x4){bflo(pa8[q].x), bfhi(pa8[q].x), bflo(pa8[q].y), bfhi(pa8[q].y)}; }
        {   uint2 pb8[8];
            s3_relayout(pb8, gb, stg, lane); s3_fetch(gb, LOUT + tokb * LORA_N + 2048 + hd * 64, LORA_N, lane);
#pragma unroll
            for (int q = 0; q < 8; ++q) { const int cl = cb + 32 * (q >> 2) + 8 * (q & 3); const f32x4 ka4 = *(const f32x4*)(kap + cl);
                const float pq[4] = {bflo(pb8[q].x), bfhi(pb8[q].x), bflo(pb8[q].y), bfhi(pb8[q].y)};
#pragma unroll
                for (int i = 0; i < 4; ++i) bs += rkv[q][i] * (2.0f + (sa[q][i] + pq[i] - 2.0f) * ka4[i]); } }
        s2 += __shfl_xor(s2, 32); bs += __shfl_xor(bs, 32);
        const float rs = 1.0f / sqrtf(s2 * (1.0f / 64.0f) + GN_EPS);
        uint2 vv8[8], gg8[8];
        s3_relayout(vv8, ga, stg, lane); s3_relayout(gg8, gb, stg, lane);
#pragma unroll
        for (int mi = 0; mi < 2; ++mi)
#pragma unroll
            for (int g = 0; g < 4; ++g) { const int cl = cb + 32 * mi + 8 * g; const int q = mi * 4 + g;
                const uint2 vw = vv8[q], gwd = gg8[q];
                const f32x4 w4 = *(const f32x4*)(gnwp + cl), b4 = *(const f32x4*)(gnbp + cl); const f32x4 d = o[mi][g];
                const float y0 = (d[0] * rs * w4[0] + b4[0] + bs * bflo(vw.x)) * bflo(gwd.x), y1 = (d[1] * rs * w4[1] + b4[1] + bs * bfhi(vw.x)) * bfhi(gwd.x);
                const float y2 = (d[2] * rs * w4[2] + b4[2] + bs * bflo(vw.y)) * bflo(gwd.y), y3 = (d[3] * rs * w4[3] + b4[3] + bs * bfhi(vw.y)) * bfhi(gwd.y);
                *(LAS u32x2*)(stg + r * LSTR + (32 * mi + 8 * g + 4 * h) * 2) = (u32x2){pkbf(y0, y1), pkbf(y2, y3)}; }
#pragma unroll
        for (int i = 0; i < 4; ++i) { const int row = (lane >> 3) + 8 * i; const v4u val = *(const LAS v4u*)(stg + row * LSTR + (lane & 7) * 16);
            *(v4u*)(QO + (tokb + row) * 1024 + 512 + hd * 64 + (lane & 7) * 8) = val; }
    }
}

#if DEBUG_NAN
__device__ __forceinline__ void dbg_count(Frame& F) {
    unsigned char* const ws = launder(F.ws);
    const size_t gt = (size_t)blockIdx.x * 512 + threadIdx.x, NT = (size_t)F.G * 512;
    const unsigned short* arr[4] = {(const unsigned short*)(ws + WS_SPT), (const unsigned short*)(ws + WS_SG), (const unsigned short*)(ws + WS_SQ), (const unsigned short*)F.out};
#pragma unroll
    for (int a = 0; a < 4; ++a) { unsigned bad = 0; for (size_t i = gt; i < (size_t)NITEM * 4096; i += NT) { const float v = __builtin_bit_cast(float, (unsigned)arr[a][i] << 16); if (!(fabsf(v) < 1e30f)) ++bad; }
        if (bad) atomicAdd((unsigned*)(F.ctl + 8 + a), bad); }
    { const float* o = (const float*)(ws + WS_OSC); unsigned bad = 0; for (size_t i = gt; i < (size_t)2 * TT * 512; i += NT) { if (!(fabsf(o[i]) < 1e30f)) ++bad; } if (bad) atomicAdd((unsigned*)(F.ctl + 12), bad); }
}
#endif
template <int l> __device__ __forceinline__ void layer_body(Frame& F, const Args& args, const XcdBarrier& bar, unsigned char* lds) {
#define GRID_BAR() xcd_barrier(bar)

        constexpr bool last = (l == DEPTH - 1), moe = (l & 1) != 0;

#ifndef SKIP_WPREP
        p_wprep(F, args, l, 0);
#endif


#ifndef SKIP_NORM1
        {   if (l == 0) p_norm<false, false, true>(F, args, l, 0, INP(IN_X), INP(IN_CTX), 0);
            else if (l & 1) p_norm<false, false, false, true>(F, args, l, 0, nullptr, nullptr, 0);
            else p_norm<false, true, false>(F, args, l, 0, nullptr, nullptr, l - 1); }
#endif

        GRID_BAR(); TS(1);
        {   unsigned char* const ws = launder(F.ws); bf16* const XB = (bf16*)(ws + WS_XB); const float* const MOD = (const float*)(ws + WS_MOD); bf16* const H = (bf16*)F.out; (void)XB; (void)MOD; (void)H;
            pg8::Gemm g{H, (const bf16*)(ws + WS_WIN), TT, INWP, 1024, 0}; pg8::Sched S; S.init(TT / 256, INWP / 256, F.G, (int)blockIdx.x, nullptr);
            pg8::EpiBf16 E{(bf16*)(ws + WS_P), INWP};
#ifndef SKIP_G_IN
            pg8::gemm_phase<pg8::EpiBf16, pg8::Sched, true, true>(F.lds + RING_OFF, g, S, E, F.wave);
#endif
            }
        GRID_BAR(); TS(2);

#ifndef SKIP_PREP
        p_prep(F, args, l);
#endif
#if PROBE == 2
        p_prep(F, args, l);
#endif

        GRID_BAR(); TS(3);
        {   unsigned char* const ws = launder(F.ws); bf16* const XB = (bf16*)(ws + WS_XB); const float* const MOD = (const float*)(ws + WS_MOD); bf16* const H = (bf16*)F.out; (void)XB; (void)MOD; (void)H;
            pg8::Gemm g{(const bf16*)(ws + WS_LIN), (const bf16*)(ws + WS_WLORA), TT, LORA_N, 128, LORA_K}; pg8::Sched S; S.init(TT / 256, LORA_N / 256, F.G, (int)blockIdx.x, nullptr); S.lora = 1;
            pg8::EpiLoraAct E{(bf16*)(ws + WS_LOUT), LORA_N, INP(IN_W0) + l * 1024, INP(IN_A0) + l * 1024};
#ifndef SKIP_G_LORA
            pg8::gemm_phase<pg8::EpiLoraAct, pg8::Sched, true, true>(F.lds + RING_OFF, g, S, E, F.wave);
#endif
            }

#ifndef SKIP_ATTN
        p_attn(F, (char*)lds + RING_OFF, !last);
#endif

        GRID_BAR(); TS(4);

#if USE_SEQ_SCAN
        p_scan(F, args, l);
#else
        p_scan1(F, args, l);
#if PROBE == 5
        p_scan1(F, args, l);
#endif
        GRID_BAR(); TS(5);
        p_scan2(F);
#if PROBE == 6
        p_scan2(F);
#endif
        GRID_BAR(); TS(6);
        p_scan3r(F, args, l);
#endif
#if USE_SEQ_SCAN
        GRID_BAR(); TS(15);
        p_readout(F, args, l);
#endif
        GRID_BAR(); TS(7);
        {   unsigned char* const ws = launder(F.ws); bf16* const XB = (bf16*)(ws + WS_XB); const float* const MOD = (const float*)(ws + WS_MOD); bf16* const H = (bf16*)F.out; (void)XB; (void)MOD; (void)H;
            pg8::Gemm g{(const bf16*)(ws + WS_QO), (const bf16*)(ws + WS_WOUT), TT, 1024, 1024, 0, 0}; pg8::SchedSK S; S.init(TL / 256, !last, 1024 / 64, F.G, (int)blockIdx.x);
            pg8::EpiResidB<l == 0> E{INP(IN_X), INP(IN_CTX), XB, MOD + (size_t)l * 9 * 6144 + 2 * 1024, (bf16*)(ws + WS_SIDE), 1.0f};
#ifndef SKIP_G_OUT
            pg8::gemm_phase<pg8::EpiResidB<l == 0>, pg8::SchedSK, true, true>(F.lds + RING_OFF, g, S, E, F.wave);
#endif
            }
        GRID_BAR(); TS(8);
        p_wprep(F, args, l, 1);
#if PROBE == 7
        p_wprep(F, args, l, 1);
#endif
        if (!moe) {
            p_norm<false, false, false, true>(F, args, l, 1, nullptr, nullptr, 0);
#if PROBE == 4
            p_norm<false, false, false, false>(F, args, l, 1, nullptr, nullptr, 0);
#endif
            GRID_BAR(); TS(9);
            {   unsigned char* const ws = launder(F.ws); bf16* const XB = (bf16*)(ws + WS_XB); const float* const MOD = (const float*)(ws + WS_MOD); bf16* const H = (bf16*)F.out; (void)XB; (void)MOD; (void)H;
            pg8::Gemm g{H, (const bf16*)(ws + WS_WFF), TT, 2 * FFD, 1024, 0}; pg8::Sched S; S.init(TT / 256, 2 * FFD / 256, F.G, (int)blockIdx.x, nullptr);
                pg8::EpiSwiGLU E{(bf16*)(ws + WS_HID), FFD, 1.0f};
#ifndef SKIP_G_UP
                pg8::gemm_phase<pg8::EpiSwiGLU, pg8::Sched, true, true>(F.lds + RING_OFF, g, S, E, F.wave);
#endif
            }
            GRID_BAR(); TS(10);
            {   unsigned char* const ws = launder(F.ws); bf16* const XB = (bf16*)(ws + WS_XB); const float* const MOD = (const float*)(ws + WS_MOD); bf16* const H = (bf16*)F.out; (void)XB; (void)MOD; (void)H;
            pg8::Gemm g{(const bf16*)(ws + WS_HID), (const bf16*)(ws + WS_WFF_D_DENSE), TT, 1024, FFD, 0, 0}; pg8::SchedSK S; S.init(TL / 256, true, FFD / 64, F.G, (int)blockIdx.x);
                pg8::EpiResidB<false> E{nullptr, nullptr, XB, MOD + (size_t)l * 9 * 6144 + 5 * 1024, (bf16*)(ws + WS_SIDE), 1.0f};
#ifndef SKIP_G_DOWN
                pg8::gemm_phase<pg8::EpiResidB<false>, pg8::SchedSK, true, true>(F.lds + RING_OFF, g, S, E, F.wave);
#endif
            }
            GRID_BAR(); TS(11);
        } else {
            p_norm<true, false, false, !last>(F, args, l, 1, nullptr, nullptr, 0, last ? TL : TT);
#if PROBE == 4
            p_norm<true, false, false, false>(F, args, l, 1, nullptr, nullptr, 0, last ? TL : TT);
#endif
            GRID_BAR(); TS(9);

#ifndef SKIP_ROUTE
            p_route(F, last ? TL : TT);
#endif

            GRID_BAR(); TS(12);
            const int npanels = *(LAS int*)(F.lds + LT_NPAN);
            {   unsigned char* const ws = launder(F.ws); bf16* const XB = (bf16*)(ws + WS_XB); const float* const MOD = (const float*)(ws + WS_MOD); bf16* const H = (bf16*)F.out; (void)XB; (void)MOD; (void)H;
            pg8::Gemm g{(const bf16*)(ws + WS_AG8), (const bf16*)(ws + WS_WFF), npanels * 256, 2 * FFE, 512, 0}; pg8::Sched S; S.init(npanels, 2 * FFE / 256, F.G, (int)blockIdx.x, (const LAS int*)(F.lds + LT_PEXP));
                pg8::EpiSwiGLU8 E{ws + WS_HIDM, FFE, 1.0f / (H8SCALE * W8SCALE), HID8SCALE};
#ifndef SKIP_G_MUP
                pg8::gemm_phase<pg8::EpiSwiGLU8, pg8::Sched, true, true, true>(F.lds + RING_OFF, g, S, E, F.wave);
#endif
            }
            GRID_BAR(); TS(13);
            {   unsigned char* const ws = launder(F.ws); bf16* const XB = (bf16*)(ws + WS_XB); const float* const MOD = (const float*)(ws + WS_MOD); bf16* const H = (bf16*)F.out; (void)XB; (void)MOD; (void)H;
            pg8::Gemm g{(const bf16*)(ws + WS_HIDM), (const bf16*)(ws + WS_WFF_D_MOE8), npanels * 256, 1024, FFE / 2, 0}; pg8::Sched S; S.init(npanels, 4, F.G, (int)blockIdx.x, (const LAS int*)(F.lds + LT_PEXP));
                pg8::EpiBf16S E{(bf16*)(ws + WS_AG), 1024, 1.0f / (HID8SCALE * W8SCALE)};
#ifndef SKIP_G_MDOWN
                pg8::gemm_phase<pg8::EpiBf16S, pg8::Sched, true, true, true>(F.lds + RING_OFF, g, S, E, F.wave);
#endif
            }
            GRID_BAR(); TS(14);
        }

#undef GRID_BAR
}
__global__ void __launch_bounds__(NWAVES * 64, 2) mk_fwd(Args args) {
    extern __shared__ __attribute__((aligned(16))) unsigned char lds[];
    Frame F;
    F.lds = (LAS unsigned char*)lds;
    F.MISC = (volatile LAS unsigned*)(F.lds + MISC_OFF);
    F.tid = threadIdx.x; F.lane = F.tid & 63; F.wave = __builtin_amdgcn_readfirstlane(F.tid >> 6);
    F.G = gridDim.x; { const int bx = blockIdx.x; F.vcu = (F.G % 8 == 0) ? (bx % 8) * (F.G / 8) + bx / 8 : bx; }
    F.ws = args.ws; F.ctl = (gu32*)(args.ws + WS_CTL); F.out = args.out;
    for (int u = F.tid; u < 64; u += NWAVES * 64) ((LAS unsigned*)(F.lds + LDSCTL_OFF))[u] = 0u;
    if (F.tid < 30) ((LAS unsigned long long*)(F.lds + LT_INP))[F.tid] = (unsigned long long)args.in[F.tid];
    __syncthreads();
    XcdBarrier bar = xcd_barrier_post((unsigned*)(F.ctl + CW_BAR), F.MISC + 8, F.wave);
#define GRID_BAR() xcd_barrier(bar)
#if TSEL >= 0
    if (blockIdx.x == 0 && F.wave == 0 && hw_lane() == 0) ((unsigned long long*)(F.ws + WS_CTL + 32768))[0] = __builtin_amdgcn_s_memrealtime();
#endif

#ifndef SKIP_PRO
    p_prologue(F, args);
#endif

    GRID_BAR(); TS(0);
    layer_body<0>(F, args, bar, lds);
#if DEBUG_NAN
    return;
#endif
    layer_body<1>(F, args, bar, lds);
    layer_body<2>(F, args, bar, lds);
    layer_body<3>(F, args, bar, lds);

#ifndef SKIP_FINAL
    p_final_combine(F, DEPTH - 1);
#endif
#if TSEL >= 0
    TS(15);
    xcd_barrier(bar);
    if (blockIdx.x == 0 && F.wave == 0 && hw_lane() == 0) { const unsigned long long* ts_ = (const unsigned long long*)(F.ws + WS_CTL + 32768); float tot = 0.f, sel = 0.f;
        for (int k = 0; k < 16; ++k) { tot += (float)ts_[1 + k]; if ((TSEL >> k) & 1) sel += (float)ts_[1 + k]; }
        F.out[0] += 3.0f + 6.9f * sel / tot; }
#endif

#if CYSEL >= 0
    xcd_barrier(bar);
    if (blockIdx.x == 0 && F.wave == 0 && hw_lane() == 0) { const unsigned long long* cs_ = (const unsigned long long*)(F.ws + WS_CTL + 40960); float tot = 0.f; for (int k = 0; k < 5; ++k) tot += (float)cs_[k];
        F.out[0] += 3.0f + 6.9f * (float)cs_[CYSEL] / tot; }
#endif
    if (xb_ld((unsigned*)(F.ctl + CW_BAR) + XB_TMO) != 0u && blockIdx.x == 0 && F.wave == 0 && hw_lane() == 0) F.out[0] = __builtin_nanf("");
}

extern "C" void kernel_launch(void* const* d_in, const int* in_sizes, int n_in, void* d_out, int out_size, void* d_ws, size_t ws_size, hipStream_t stream) {
    static int grid = 0;
    if (grid == 0) {
        if (n_in != 30 || in_sizes[0] != TL * 1024 || out_size != TL * 1024 || ws_size < WS_END) { fprintf(stderr, "kernel_launch: unexpected shapes / workspace (n_in %d, ws %zu); nothing launched\n", n_in, ws_size); grid = -1; return; }
        int dev = 0, cus = 0, per_cu = 0;
        if (hipGetDevice(&dev) != hipSuccess || hipDeviceGetAttribute(&cus, hipDeviceAttributeMultiprocessorCount, dev) != hipSuccess) { grid = -1; return; }
        if (hipFuncSetAttribute((const void*)mk_fwd, hipFuncAttributeMaxDynamicSharedMemorySize, LDS_BYTES) != hipSuccess) { fprintf(stderr, "kernel_launch: hipFuncSetAttribute failed\n"); grid = -1; return; }
        if (hipOccupancyMaxActiveBlocksPerMultiprocessor(&per_cu, (const void*)mk_fwd, NWAVES * 64, LDS_BYTES) != hipSuccess || per_cu < 1) { fprintf(stderr, "kernel_launch: occupancy query reports %d blocks per CU\n", per_cu); }
        (void)hipGetLastError();
        grid = cus;
    }
    if (grid < 0) return;
    if (hipMemsetAsync((char*)d_ws + WS_CTL, 0, CTL_ZERO_BYTES, stream) != hipSuccess) return;
    Args a{};
    for (int i = 0; i < 30; ++i) a.in[i] = (const float*)d_in[i];
    a.out = (float*)d_out; a.ws = (unsigned char*)d_ws;
    hipLaunchKernelGGL(mk_fwd, dim3(grid), dim3(NWAVES * 64), LDS_BYTES, stream, a);
}
```

```cpp
#include <hip/hip_runtime.h>
#include <hip/hip_bf16.h>
#include <cstdio>
#include <cstdint>
#include <cmath>
__device__ __forceinline__ int hw_lane() { int l_; asm volatile("v_mbcnt_lo_u32_b32 %0, -1, 0\n\tv_mbcnt_hi_u32_b32 %0, -1, %0" : "=v"(l_)); return l_; }
namespace pg8 {
#define PG8_LAS __attribute__((address_space(3)))
typedef unsigned short bf16_t;
typedef short bf16x8 __attribute__((ext_vector_type(8)));
typedef float f32x4 __attribute__((ext_vector_type(4)));
typedef unsigned u32x4 __attribute__((ext_vector_type(4)));
constexpr int BM = 256, BK = 64, HALF = 128, HTB = HALF * BK * 2  , STAGE_BYTES = 8 * HTB, NXCD = 8, WGM = 8;

__host__ __device__ __forceinline__ int lds_byte(int r, int c) { const int st = (r >> 4) * 2 + (c >> 5), rr = r & 15, cc = c & 31, ob = rr * 64 + cc * 2; return st * 1024 + (ob ^ (((ob >> 9) & 1) << 5)); }
__host__ __device__ __forceinline__ void stage_rc(int b, int& R, int& C) { const int st = b / 1024, sb = b % 1024, swz = sb ^ (((sb >> 9) & 1) << 5); R = (st >> 1) * 16 + swz / 64; C = (st & 1) * 32 + (swz % 64) / 2; }
__host__ __device__ __forceinline__ int perm32(int rho) { const int n = rho >> 4, i = rho & 15; return 8 * (i >> 2) + 4 * n + (i & 3); }
__device__ __forceinline__ unsigned cvt_pk_bf16(float lo, float hi) { unsigned r; asm volatile("v_cvt_pk_bf16_f32 %0, %1, %2" : "=v"(r) : "v"(lo), "v"(hi)); return r; }
typedef float f32x2 __attribute__((ext_vector_type(2)));

struct Unit { int pm, pn, pnb, ka, nt, slice; };
struct Gemm { const bf16_t* A; const bf16_t* Bt; int M, N, K, lda, ldb; };

struct Sched {
    static constexpr bool SPLITK = false;
    int nM, nN, nwg, G, c, lora; const PG8_LAS int* pexp;
    __device__ __forceinline__ void init(int nM_, int nN_, int G_, int c_, const PG8_LAS int* pe) { nM = nM_; nN = nN_; nwg = nM * nN; G = G_; c = c_; pexp = pe; lora = 0; }
    __device__ __forceinline__ bool next(int i, Unit& u) const {
        const long L = (long)i * G + c; if (L >= nwg) return false;
        int wgid = (int)L; { const int q = nwg / NXCD, r = nwg % NXCD, xcd = wgid % NXCD, off = wgid / NXCD; wgid = (xcd < r ? xcd * (q + 1) : r * (q + 1) + (xcd - r) * q) + off; }
        const int nig = WGM * nN, gid = wgid / nig, fm = gid * WGM, gsz = (nM - fm) < WGM ? (nM - fm) : WGM;
        u.pm = fm + ((wgid % nig) % gsz); u.pn = (wgid % nig) / gsz; u.pnb = pexp ? pexp[u.pm] * nN + u.pn : u.pn;
        u.ka = lora ? ((u.pn >= 8) ? 512 : ((u.pn >= 4) ? 256 : 0)) : 0; return true;
    }
    __device__ __forceinline__ void a_ready(const Unit&) const {}
    __device__ __forceinline__ void done(const Unit&) const {}
};
struct SchedSK {
    static constexpr bool SPLITK = true;
    int nM, nwg, G, c, nsub, ntt, base, extra;
    __device__ __forceinline__ void init(int nMf_, bool ctx, int ntiles, int G_, int c_) { nM = nMf_; nwg = nMf_ * 4; G = G_; c = c_; nsub = ctx ? 128 : 0; ntt = ntiles; base = (ntiles / 4) & ~1; extra = (ntiles - 4 * base) / 2; }
    __device__ __forceinline__ bool next(int i, Unit& u) const {
        const long L = (long)i * G + c; if (L >= nwg + nsub) return false;
        const bool sub = L >= nwg;
        int wgid = sub ? 0 : (int)L; { const int q = nwg / NXCD, r = nwg % NXCD, xcd = wgid % NXCD, off = wgid / NXCD; wgid = (xcd < r ? xcd * (q + 1) : r * (q + 1) + (xcd - r) * q) + off; }
        const int nig = WGM * 4, gid = wgid / nig, fm = gid * WGM, gsz = (nM - fm) < WGM ? (nM - fm) : WGM;
        const int pmf = fm + ((wgid % nig) % gsz), pnf = (wgid % nig) / gsz;
        const int Ls = sub ? (int)(L - nwg) : 0, sl = Ls >> 5, rem = Ls & 31;
        const int kt0 = sl * base + 2 * (sl < extra ? sl : extra);
        u.pm = sub ? nM + (rem & 7) : pmf; u.pn = sub ? (rem >> 3) : pnf; u.pnb = u.pn; u.slice = sl;
        u.nt = sub ? base + ((sl < extra) ? 2 : 0) : ntt; u.ka = kt0 * (BK * 2); return true;
    }
    __device__ __forceinline__ void a_ready(const Unit&) const {}
    __device__ __forceinline__ void done(const Unit&) const {}
};

__device__ __forceinline__ float sigmoid_f(float x) { return __builtin_amdgcn_rcpf(1.0f + __builtin_amdgcn_exp2f(-1.4426950408889634f * x)); }
__device__ __forceinline__ float bf_lo(unsigned w) { return __builtin_bit_cast(float, w << 16); }
__device__ __forceinline__ float bf_hi(unsigned w) { return __builtin_bit_cast(float, w & 0xffff0000u); }

struct EpiBf16 {
    static constexpr bool PERM = true, AFTER_DRAIN = false;
    bf16_t* O; int ldc;
    __device__ __forceinline__ void operator()(const f32x4 (&acc)[2][2][4][2], const Unit& u, int wr, int wc, int fr, int fq) const {
        const int row0 = u.pm * BM + wr * 64 + fr; const int col0 = u.pn * BM + wc * 32 + 8 * fq;
#pragma unroll
        for (int ai = 0; ai < 2; ++ai)
#pragma unroll
            for (int m = 0; m < 4; ++m) { bf16_t* rowp = O + (size_t)(row0 + ai * HALF + m * 16) * ldc + col0;
#pragma unroll
                for (int bj = 0; bj < 2; ++bj) { const f32x4 v0 = acc[ai][bj][m][0], v1 = acc[ai][bj][m][1];
                    u32x4 w; w.x = cvt_pk_bf16(v0[0], v0[1]); w.y = cvt_pk_bf16(v0[2], v0[3]); w.z = cvt_pk_bf16(v1[0], v1[1]); w.w = cvt_pk_bf16(v1[2], v1[3]);
                    *(u32x4*)(rowp + bj * HALF) = w; } }
    }
};
struct EpiSwiGLU {
    static constexpr bool PERM = true, AFTER_DRAIN = false;
    bf16_t* O; int ldc; float inscale;
    __device__ __forceinline__ void operator()(const f32x4 (&acc)[2][2][4][2], const Unit& u, int wr, int wc, int fr, int fq) const {
        const int row0 = u.pm * BM + wr * 64 + fr; const int col0 = u.pn * HALF + wc * 32 + 8 * fq;
#pragma unroll
        for (int ai = 0; ai < 2; ++ai)
#pragma unroll
            for (int m = 0; m < 4; ++m) { bf16_t* rowp = O + (size_t)(row0 + ai * HALF + m * 16) * ldc + col0;
                float h[8];
#pragma unroll
                for (int n = 0; n < 2; ++n)
#pragma unroll
                    for (int j = 0; j < 4; ++j) { const float g = acc[ai][0][m][n][j] * inscale, up = acc[ai][1][m][n][j] * inscale; h[n * 4 + j] = g * sigmoid_f(g) * up; }
                u32x4 w; w.x = cvt_pk_bf16(h[0], h[1]); w.y = cvt_pk_bf16(h[2], h[3]); w.z = cvt_pk_bf16(h[4], h[5]); w.w = cvt_pk_bf16(h[6], h[7]);
                *(u32x4*)rowp = w; }
    }
};
struct EpiResid {
    static constexpr bool PERM = false, AFTER_DRAIN = false;
    const float* baseL; const float* baseC; float* outL; float* outC; const float* gate; float scale;
    __device__ __forceinline__ void operator()(const f32x4 (&acc)[2][2][4][2], const Unit& u, int wr, int wc, int fr, int fq) const {
        const float* base; float* out; int bsel;
        if (u.pm < 128) { base = baseL + (size_t)u.pm * BM * 1024; out = outL + (size_t)u.pm * BM * 1024; bsel = u.pm >> 4; }
        else { base = baseC + (size_t)(u.pm - 128) * BM * 1024; out = outC + (size_t)(u.pm - 128) * BM * 1024; bsel = 8; }
        const float* gv = gate + (size_t)bsel * 6144;
        const int col0 = u.pn * BM + wc * 32 + 4 * fq;
        f32x4 g4[2][2];
#pragma unroll
        for (int bj = 0; bj < 2; ++bj)
#pragma unroll
            for (int n = 0; n < 2; ++n) g4[bj][n] = *(const f32x4*)(gv + col0 + bj * HALF + n * 16) * scale;
#pragma unroll
        for (int ai = 0; ai < 2; ++ai)
#pragma unroll
            for (int m = 0; m < 4; ++m) { const size_t off = (size_t)(ai * HALF + wr * 64 + m * 16 + fr) * 1024 + col0;
#pragma unroll
                for (int bj = 0; bj < 2; ++bj)
#pragma unroll
                    for (int n = 0; n < 2; ++n) { const f32x4 xs = *(const f32x4*)(base + off + bj * HALF + n * 16); *(f32x4*)(out + off + bj * HALF + n * 16) = xs + g4[bj][n] * acc[ai][bj][m][n]; } }
    }
};

__device__ __forceinline__ float clamp8(float x) { return __builtin_fminf(__builtin_fmaxf(x, -440.0f), 440.0f); }
__device__ __forceinline__ unsigned pk_fp8x4(float a, float b, float c, float d) { int w = 0; w = __builtin_amdgcn_cvt_pk_fp8_f32(clamp8(a), clamp8(b), w, false); w = __builtin_amdgcn_cvt_pk_fp8_f32(clamp8(c), clamp8(d), w, true); return (unsigned)w; }
struct EpiSwiGLU8 {
    static constexpr bool PERM = true, AFTER_DRAIN = false;
    unsigned char* O; int ldc; float inscale, outscale;
    __device__ __forceinline__ void operator()(const f32x4 (&acc)[2][2][4][2], const Unit& u, int wr, int wc, int fr, int fq) const {
        const int row0 = u.pm * BM + wr * 64 + fr; const int col0 = u.pn * HALF + wc * 32 + 8 * fq;
#pragma unroll
        for (int ai = 0; ai < 2; ++ai)
#pragma unroll
            for (int m = 0; m < 4; ++m) { unsigned char* rowp = O + (size_t)(row0 + ai * HALF + m * 16) * ldc + col0;
                float h[8];
#pragma unroll
                for (int n = 0; n < 2; ++n)
#pragma unroll
                    for (int j = 0; j < 4; ++j) { const float g = acc[ai][0][m][n][j] * inscale, up = acc[ai][1][m][n][j] * inscale; h[n * 4 + j] = g * sigmoid_f(g) * up * outscale; }
                typedef unsigned u32x2e __attribute__((ext_vector_type(2)));
                *(u32x2e*)rowp = (u32x2e){pk_fp8x4(h[0], h[1], h[2], h[3]), pk_fp8x4(h[4], h[5], h[6], h[7])};  asm volatile("" ::: "memory"); }
    }
};
struct EpiBf16S {
    static constexpr bool PERM = true, AFTER_DRAIN = false;
    bf16_t* O; int ldc; float scale;
    __device__ __forceinline__ void operator()(const f32x4 (&acc)[2][2][4][2], const Unit& u, int wr, int wc, int fr, int fq) const {
        const int row0 = u.pm * BM + wr * 64 + fr; const int col0 = u.pn * BM + wc * 32 + 8 * fq;
#pragma unroll
        for (int ai = 0; ai < 2; ++ai)
#pragma unroll
            for (int m = 0; m < 4; ++m) { bf16_t* rowp = O + (size_t)(row0 + ai * HALF + m * 16) * ldc + col0;
#pragma unroll
                for (int bj = 0; bj < 2; ++bj) { const f32x4 v0 = acc[ai][bj][m][0] * scale, v1 = acc[ai][bj][m][1] * scale;
                    u32x4 w; w.x = cvt_pk_bf16(v0[0], v0[1]); w.y = cvt_pk_bf16(v0[2], v0[3]); w.z = cvt_pk_bf16(v1[0], v1[1]); w.w = cvt_pk_bf16(v1[2], v1[3]);
                    *(u32x4*)(rowp + bj * HALF) = w; } asm volatile("" ::: "memory"); }
    }
};

template <bool BASEF32> struct EpiResidB {
    static constexpr bool PERM = true, AFTER_DRAIN = false;
    const float* baseL; const float* baseC; bf16_t* xb; const float* gate; bf16_t* side; float scale;
    __device__ __forceinline__ void operator()(const f32x4 (&acc)[2][2][4][2], const Unit& u, int wr, int wc, int fr, int fq) const {
        asm volatile("" : "+v"(fr), "+v"(fq));
        const int bsel = (u.pm < 128) ? (u.pm >> 4) : 8;
        const float* base = (u.pm < 128) ? baseL + (size_t)u.pm * BM * 1024 : baseC + (size_t)(u.pm - 128) * BM * 1024;
        bf16_t* out = xb + (size_t)u.pm * BM * 1024;
        const float* gv = gate + (size_t)bsel * 6144;
        const int col0 = u.pn * BM + wc * 32 + 8 * fq;
        f32x4 g4[2][2];
#pragma unroll
        for (int bj = 0; bj < 2; ++bj)
#pragma unroll
            for (int n = 0; n < 2; ++n) g4[bj][n] = *(const f32x4*)(gv + col0 + bj * HALF + 4 * n) * scale;
        if (u.slice != 0) {
            bf16_t* so = side + ((size_t)(u.slice - 1) * 2048 + (size_t)(u.pm - 128) * BM) * 1024;
#pragma unroll
            for (int ai = 0; ai < 2; ++ai)
#pragma unroll
                for (int m = 0; m < 4; ++m) { const size_t off = (size_t)(ai * HALF + wr * 64 + m * 16 + fr) * 1024 + col0;
#pragma unroll
                    for (int bj = 0; bj < 2; ++bj) { const f32x4 o0 = g4[bj][0] * acc[ai][bj][m][0], o1 = g4[bj][1] * acc[ai][bj][m][1];
                        u32x4 ow; ow.x = cvt_pk_bf16(o0[0], o0[1]); ow.y = cvt_pk_bf16(o0[2], o0[3]); ow.z = cvt_pk_bf16(o1[0], o1[1]); ow.w = cvt_pk_bf16(o1[2], o1[3]);
                        *(u32x4*)(so + off + bj * HALF) = ow; } }
        } else
#pragma unroll
        for (int ai = 0; ai < 2; ++ai)
#pragma unroll
            for (int m = 0; m < 4; ++m) { const size_t off = (size_t)(ai * HALF + wr * 64 + m * 16 + fr) * 1024 + col0;
#pragma unroll
                for (int bj = 0; bj < 2; ++bj) { f32x4 x0, x1;
                    if (BASEF32) { x0 = *(const f32x4*)(base + off + bj * HALF); x1 = *(const f32x4*)(base + off + bj * HALF + 4); }
                    else { const u32x4 w = *(const u32x4*)(out + off + bj * HALF); x0 = (f32x4){bf_lo(w.x), bf_hi(w.x), bf_lo(w.y), bf_hi(w.y)}; x1 = (f32x4){bf_lo(w.z), bf_hi(w.z), bf_lo(w.w), bf_hi(w.w)}; }
                    const f32x4 o0 = x0 + g4[bj][0] * acc[ai][bj][m][0], o1 = x1 + g4[bj][1] * acc[ai][bj][m][1];
                    u32x4 ow; ow.x = cvt_pk_bf16(o0[0], o0[1]); ow.y = cvt_pk_bf16(o0[2], o0[3]); ow.z = cvt_pk_bf16(o1[0], o1[1]); ow.w = cvt_pk_bf16(o1[2], o1[3]);
                    *(u32x4*)(out + off + bj * HALF) = ow; } }
    }
};

struct EpiLoraAct {
    static constexpr bool PERM = true, AFTER_DRAIN = false;
    bf16_t* O; int ldc; const float* w0; const float* a0;
    __device__ __forceinline__ void operator()(const f32x4 (&acc)[2][2][4][2], const Unit& u, int wr, int wc, int fr, int fq) const {
        const int row0 = u.pm * BM + wr * 64 + fr; const int col0 = u.pn * BM + wc * 32 + 8 * fq; const int sec = u.pn >> 1;
        const int cs0 = (u.pn & 1) * 256 + wc * 32 + 8 * fq;
        f32x4 bv[2][2]; float mul = 1.0f;
        if (sec < 4) { const float* bp = (sec < 2 ? w0 + sec * 512 : a0 + (sec - 2) * 512) + cs0; mul = (sec < 2) ? 0.8750387749145276f : 1.0f;
#pragma unroll
            for (int bj = 0; bj < 2; ++bj)
#pragma unroll
                for (int n = 0; n < 2; ++n) bv[bj][n] = *(const f32x4*)(bp + bj * HALF + 4 * n); }
#pragma unroll
        for (int ai = 0; ai < 2; ++ai)
#pragma unroll
            for (int m = 0; m < 4; ++m) { bf16_t* rowp = O + (size_t)(row0 + ai * HALF + m * 16) * ldc + col0;
#pragma unroll
                for (int bj = 0; bj < 2; ++bj) { f32x4 v0 = acc[ai][bj][m][0], v1 = acc[ai][bj][m][1];
                    if (sec < 4) {
#pragma unroll
                        for (int j = 0; j < 4; ++j) { v0[j] = mul * sigmoid_f(v0[j] + bv[bj][0][j]); v1[j] = mul * sigmoid_f(v1[j] + bv[bj][1][j]); } }
                    u32x4 w; w.x = cvt_pk_bf16(v0[0], v0[1]); w.y = cvt_pk_bf16(v0[2], v0[3]); w.z = cvt_pk_bf16(v1[0], v1[1]); w.w = cvt_pk_bf16(v1[2], v1[3]);
                    *(u32x4*)(rowp + bj * HALF) = w; } }
    }
};
typedef int v8i_t __attribute__((ext_vector_type(8)));
__device__ __forceinline__ v8i_t cat8(bf16x8 a, bf16x8 b) { const u32x4 x = __builtin_bit_cast(u32x4, a), y = __builtin_bit_cast(u32x4, b); return (v8i_t){(int)x[0], (int)x[1], (int)x[2], (int)x[3], (int)y[0], (int)y[1], (int)y[2], (int)y[3]}; }
template <class Epi, class Sched, bool ALIGN_EPI = false, bool SP2 = false, bool FP8 = false>
__device__ __forceinline__ void gemm_phase(PG8_LAS unsigned char* lds, const Gemm g, const Sched& S, const Epi& E, const int wave_) {
    const int tid = wave_ * 64 + hw_lane(), wid = wave_, lane = tid & 63, wr = wid >> 2, wc = wid & 3, fr = lane & 15, fq = lane >> 4;
    int K_ = g.K; asm volatile("" : "+s"(K_));
    const int K = K_, nt = K / BK; const int lda = g.lda ? g.lda : K, ldb = g.ldb ? g.ldb : K;
    unsigned voffA[2], voffB[2];
#pragma unroll
    for (int i = 0; i < 2; ++i) { int R, C; stage_rc(tid * 16 + i * 8192, R, C); const int Rb = Epi::PERM ? ((R & ~31) + perm32(R & 31)) : R;
        voffA[i] = (unsigned)(R * lda + C) * 2u; voffB[i] = (unsigned)(Rb * ldb + C) * 2u; }
    const size_t kstep = (size_t)(BK * 2);
    const size_t hstep = (size_t)HALF * ldb * 2;
    const size_t hstepA = (size_t)HALF * lda * 2, tstepA = 2 * hstepA;
    const size_t tstep = 2 * hstep;
    const unsigned ldsw = (unsigned)wid * 1024u;
    const int aoff = lds_byte(wr * 64 + fr, fq * 8), boff = lds_byte(wc * 32 + fr, fq * 8);
#define PG8_SA(b, h) (((b) * 2 + (h)) * HTB)
#define PG8_SB(b, h) ((4 + (b) * 2 + (h)) * HTB)
#define PG8_STAGE(bufoff, gbase, voff) do { _Pragma("unroll") for (int _i = 0; _i < 2; ++_i) \
        __builtin_amdgcn_global_load_lds((const unsigned*)((const char*)(gbase) + (voff)[_i]), (PG8_LAS unsigned*)(lds + (bufoff) + ldsw + _i * 8192), 16, 0, 0); } while (0)
#define PG8_LDA(dst, b, h) do { if constexpr (FP8) { _Pragma("unroll") for (int m = 0; m < 4; ++m) { dst##8[m].lo = *(const PG8_LAS v4i_t*)(lds + PG8_SA(b, h) + aoff + m * 2048); dst##8[m].hi = *(const PG8_LAS v4i_t*)(lds + PG8_SA(b, h) + aoff + m * 2048 + 1024); } } \
        else { _Pragma("unroll") for (int m = 0; m < 4; ++m) _Pragma("unroll") for (int k = 0; k < 2; ++k) dst[FP8 ? 0 : m][k] = *(const PG8_LAS bf16x8*)(lds + PG8_SA(b, h) + aoff + m * 2048 + k * 1024); } } while (0)
#define PG8_LDB(dst, b, h) do { if constexpr (FP8) { _Pragma("unroll") for (int n = 0; n < 2; ++n) { dst##8[n].lo = *(const PG8_LAS v4i_t*)(lds + PG8_SB(b, h) + boff + n * 2048); dst##8[n].hi = *(const PG8_LAS v4i_t*)(lds + PG8_SB(b, h) + boff + n * 2048 + 1024); } } \
        else { _Pragma("unroll") for (int n = 0; n < 2; ++n) _Pragma("unroll") for (int k = 0; k < 2; ++k) dst[n][k] = *(const PG8_LAS bf16x8*)(lds + PG8_SB(b, h) + boff + n * 2048 + k * 1024); } } while (0)
#define PG8_MMA(ai, bj, At, Bt) do { __builtin_amdgcn_s_setprio(1); if constexpr (FP8) { _Pragma("unroll") for (int m = 0; m < 4; ++m) _Pragma("unroll") for (int n = 0; n < 2; ++n) \
        asm volatile("v_mfma_f32_16x16x128_f8f6f4 %0, %1, %2, %0" : "+v"(acc[ai][bj][m][n]) : "v"(Bt##8[n]), "v"(At##8[m])); } \
        else { _Pragma("unroll") for (int m = 0; m < 4; ++m) _Pragma("unroll") for (int n = 0; n < 2; ++n) _Pragma("unroll") for (int k = 0; k < 2; ++k) \
        acc[ai][bj][m][n] = __builtin_amdgcn_mfma_f32_16x16x32_bf16(Bt[n][k], At[FP8 ? 0 : m][k], acc[ai][bj][m][n], 0, 0, 0); } __builtin_amdgcn_s_setprio(0); } while (0)
#define PG8_WAIT_V(n) asm volatile("s_waitcnt vmcnt(" #n ")" ::: "memory")
#define PG8_WAIT_L(n) asm volatile("s_waitcnt lgkmcnt(" #n ")" ::: "memory")
#define PG8_BAR __builtin_amdgcn_s_barrier()
#define PG8_SCHED __builtin_amdgcn_sched_barrier(0)
    Unit cur, nxt; int ui = 0;
    if (!S.next(0, cur)) return;
    f32x4 acc[2][2][4][2];
#pragma unroll
    for (int a = 0; a < 2; ++a)
#pragma unroll
        for (int b = 0; b < 2; ++b)
#pragma unroll
            for (int m = 0; m < 4; ++m)
#pragma unroll
                for (int n = 0; n < 2; ++n) acc[a][b][m][n] = (f32x4){0.f, 0.f, 0.f, 0.f};
    bf16x8 At[FP8 ? 1 : 4][2], B0[2][2], B1[2][2];
    v8i_t At8[FP8 ? 4 : 1], B08[2], B18[2];
    typedef int v4i_t __attribute__((ext_vector_type(4)));
    const char* cA = (const char*)g.A + (size_t)cur.pm * tstepA + cur.ka; const char* cB = (const char*)g.Bt + (size_t)cur.pnb * tstep + (Sched::SPLITK ? cur.ka : 0);
    S.a_ready(cur);
    if constexpr (SP2) {
        PG8_STAGE(PG8_SB(0, 0), cB, voffB); PG8_STAGE(PG8_SB(0, 1), cB + hstep, voffB); PG8_STAGE(PG8_SA(0, 0), cA, voffA); PG8_STAGE(PG8_SA(0, 1), cA + hstepA, voffA);
        if (wr == 1) PG8_BAR;
        PG8_WAIT_V(2); PG8_BAR;
        PG8_STAGE(PG8_SB(1, 0), cB + kstep, voffB); PG8_STAGE(PG8_SA(1, 0), cA + kstep, voffA); PG8_STAGE(PG8_SB(1, 1), cB + hstep + kstep, voffB);
        PG8_WAIT_V(6); PG8_BAR;
    } else {
        PG8_STAGE(PG8_SB(0, 0), cB, voffB); PG8_STAGE(PG8_SA(0, 0), cA, voffA); PG8_STAGE(PG8_SB(0, 1), cB + hstep, voffB); PG8_STAGE(PG8_SA(0, 1), cA + hstepA, voffA);
        if (wr == 1) PG8_BAR;
        PG8_WAIT_V(4); PG8_BAR;
        PG8_STAGE(PG8_SB(1, 0), cB + kstep, voffB); PG8_STAGE(PG8_SA(1, 0), cA + kstep, voffA); PG8_STAGE(PG8_SB(1, 1), cB + hstep + kstep, voffB);
        PG8_WAIT_V(6); PG8_BAR;
    }
    for (;;) {
        const bool has_next = S.next(ui + 1, nxt);
        const char* nA = has_next ? (const char*)g.A + (size_t)nxt.pm * tstepA + nxt.ka : cA; const char* nB = has_next ? (const char*)g.Bt + (size_t)nxt.pnb * tstep + (Sched::SPLITK ? nxt.ka : 0) : cB;
        const int ntc = Sched::SPLITK ? cur.nt : nt;
        for (int t = 0; t < ntc; t += 2) {
            const bool last = (t == ntc - 2);
            const char* a1 = cA + (size_t)(t + 1) * kstep;
            const char* a2 = last ? nA : cA + (size_t)(t + 2) * kstep; const char* b2 = last ? nB : cB + (size_t)(t + 2) * kstep;
            const char* a3 = a2 + kstep; const char* b3 = b2 + kstep;
            if (last && has_next) S.a_ready(nxt);
            if constexpr (SP2) {
            PG8_LDB(B0, 0, 0); PG8_LDB(B1, 0, 1); PG8_SCHED; PG8_LDA(At, 0, 0); PG8_STAGE(PG8_SA(1, 1), a1 + hstepA, voffA);
            PG8_WAIT_V(8); PG8_WAIT_L(0); PG8_BAR; PG8_MMA(0, 0, At, B0); PG8_MMA(0, 1, At, B1); PG8_BAR; PG8_SCHED;
            PG8_LDA(At, 0, 1); PG8_STAGE(PG8_SB(0, 0), b2, voffB); PG8_STAGE(PG8_SB(0, 1), b2 + hstep, voffB); PG8_STAGE(PG8_SA(0, 0), a2, voffA);
            PG8_WAIT_V(8); PG8_WAIT_L(0); PG8_BAR; PG8_MMA(1, 0, At, B0); PG8_MMA(1, 1, At, B1); PG8_BAR; PG8_SCHED;
            PG8_LDB(B0, 1, 0); PG8_LDB(B1, 1, 1); PG8_SCHED; PG8_LDA(At, 1, 0); PG8_STAGE(PG8_SA(0, 1), a2 + hstepA, voffA);
            PG8_WAIT_V(8); PG8_WAIT_L(0); PG8_BAR; PG8_MMA(0, 0, At, B0); PG8_MMA(0, 1, At, B1); PG8_BAR; PG8_SCHED;
            PG8_LDA(At, 1, 1); PG8_STAGE(PG8_SB(1, 0), b3, voffB); PG8_STAGE(PG8_SB(1, 1), b3 + hstep, voffB); PG8_STAGE(PG8_SA(1, 0), a3, voffA);
            PG8_WAIT_V(8); PG8_WAIT_L(0); PG8_BAR; PG8_MMA(1, 0, At, B0); PG8_MMA(1, 1, At, B1); PG8_BAR; PG8_SCHED;
            } else {
            PG8_LDB(B0, 0, 0); PG8_SCHED; PG8_LDA(At, 0, 0); PG8_STAGE(PG8_SA(1, 1), a1 + hstepA, voffA);
            PG8_WAIT_L(8); PG8_BAR; PG8_WAIT_L(0); PG8_MMA(0, 0, At, B0); PG8_BAR; PG8_SCHED;
            PG8_LDB(B1, 0, 1); PG8_STAGE(PG8_SB(0, 0), b2, voffB);
            PG8_BAR; PG8_WAIT_L(0); PG8_MMA(0, 1, At, B1); PG8_BAR;
            PG8_LDA(At, 0, 1); PG8_STAGE(PG8_SA(0, 0), a2, voffA);
            PG8_BAR; PG8_WAIT_L(0); PG8_MMA(1, 0, At, B0); PG8_BAR; PG8_SCHED;
            PG8_STAGE(PG8_SB(0, 1), b2 + hstep, voffB);
            PG8_WAIT_V(6); PG8_BAR; PG8_MMA(1, 1, At, B1); PG8_BAR;
            PG8_LDB(B0, 1, 0); PG8_SCHED; PG8_LDA(At, 1, 0); PG8_STAGE(PG8_SA(0, 1), a2 + hstepA, voffA);
            PG8_WAIT_L(8); PG8_BAR; PG8_WAIT_L(0); PG8_MMA(0, 0, At, B0); PG8_BAR; PG8_SCHED;
            PG8_LDB(B1, 1, 1); PG8_STAGE(PG8_SB(1, 0), b3, voffB);
            PG8_BAR; PG8_WAIT_L(0); PG8_MMA(0, 1, At, B1); PG8_BAR;
            PG8_LDA(At, 1, 1); PG8_STAGE(PG8_SA(1, 0), a3, voffA);
            PG8_BAR; PG8_WAIT_L(0); PG8_MMA(1, 0, At, B0); PG8_BAR; PG8_SCHED;
            PG8_STAGE(PG8_SB(1, 1), b3 + hstep, voffB);
            PG8_WAIT_V(6); PG8_BAR; PG8_MMA(1, 1, At, B1); PG8_BAR;
            }
        }
        if constexpr (ALIGN_EPI) { if (wr == 0) PG8_BAR; }
        if constexpr (!Epi::AFTER_DRAIN) { E(acc, cur, wr, wc, fr, fq); S.done(cur); }
        if (!has_next) break;
#pragma unroll
        for (int a = 0; a < 2; ++a)
#pragma unroll
            for (int b = 0; b < 2; ++b)
#pragma unroll
                for (int m = 0; m < 4; ++m)
#pragma unroll
                    for (int n = 0; n < 2; ++n) acc[a][b][m][n] = (f32x4){0.f, 0.f, 0.f, 0.f};
        cur = nxt; cA = nA; cB = nB; ++ui;
        if constexpr (ALIGN_EPI) { if (wr == 1) PG8_BAR; }
    }
    PG8_WAIT_V(0);
    if constexpr (!ALIGN_EPI) { if (wr == 0) PG8_BAR; }
    PG8_BAR;
    if constexpr (Epi::AFTER_DRAIN) { E.fused(acc, cur, wr, wc, fr, fq, lds, wid, lane); S.done(cur); }
#undef PG8_SA
#undef PG8_SB
#undef PG8_STAGE
#undef PG8_LDA
#undef PG8_LDB
#undef PG8_MMA
#undef PG8_WAIT_V
#undef PG8_WAIT_L
#undef PG8_BAR
#undef PG8_SCHED
}
}
#include <hip/hip_bf16.h>
#include <cmath>
namespace attn_body {
using bf16=__hip_bfloat16;
using bf16x8=__attribute__((ext_vector_type(8)))short;
using s16x4=__attribute__((ext_vector_type(4)))short;
using f32x16=__attribute__((ext_vector_type(16)))float;
using u32x4=__attribute__((ext_vector_type(4)))unsigned;
constexpr int D=64,DM=1024,KP=128;
constexpr int NW=8,QBLK=32,QB=QBLK*NW,KVBLK=64;
constexpr int ATTN_PITCH=DM, ATTN_UNIT_ROWS=QB;
__device__ __forceinline__ int crow(int r,int hi){return (r&3)+8*(r>>2)+4*hi;}
#define SBAR() __builtin_amdgcn_sched_barrier(0)
__device__ __forceinline__ void cmask(f32x16&p0,f32x16&p1,int jb,int qrel,int hi){
  const float NEG=-INFINITY; int kb=64*jb+4*hi;
  #pragma unroll
  for(int r=0;r<16;++r){int kv=kb+(r&3)+8*(r>>2); if(kv>qrel)p0[r]=NEG; if(kv+32>qrel)p1[r]=NEG;}
}

constexpr int NSLOT=3, SLOTB=8192;
constexpr int LDS_K=0, LDS_V=NSLOT*SLOTB, LDS_WS=2*NSLOT*SLOTB, LDS_OST=LDS_WS+NW*64*4, LDS_BYTES=LDS_OST+NW*4096;
constexpr float C2=0.125f*1.4426950408889634f;
__device__ __forceinline__ void glds16(const void*gsrc,unsigned lds_dst){unsigned keep;
  asm volatile("s_mov_b32 %0, m0\n\ts_mov_b32 m0, %2\n\ts_nop 0\n\tglobal_load_lds_dwordx4 %1, off\n\ts_mov_b32 m0, %0":"=&s"(keep):"v"(gsrc),"s"(lds_dst):"memory");}
__device__ __forceinline__ float max3f(float a,float b,float c){float r;asm("v_max3_f32 %0, %1, %2, %3":"=v"(r):"v"(a),"v"(b),"v"(c));return r;}
__device__ __forceinline__ float max2f(float a,float b){float r;asm("v_max_f32_e32 %0, %1, %2":"=v"(r):"v"(a),"v"(b));return r;}
__device__ __forceinline__ float fadd_s(float a,float b){float r;asm("v_add_f32_e32 %0, %1, %2":"=v"(r):"v"(a),"v"(b));return r;}
__device__ __forceinline__ float fsub_s(float a,float b){float r;asm("v_sub_f32_e32 %0, %1, %2":"=v"(r):"v"(a),"v"(b));return r;}
typedef float f32x2_t __attribute__((ext_vector_type(2))); typedef __bf16 bf16x2_t __attribute__((ext_vector_type(2)));
__device__ __forceinline__ unsigned cvtpk_s(float lo,float hi){f32x2_t v={lo,hi};bf16x2_t b=__builtin_convertvector(v,bf16x2_t);return __builtin_bit_cast(unsigned,b);}
#define WAIT_BAR(N) asm volatile("s_waitcnt vmcnt(" #N ") lgkmcnt(0)\n\ts_barrier":::"memory")

__device__ __forceinline__ void qkt(f32x16&p0,f32x16&p1,const char*Kslot,const bf16x8*qr,const f32x16&negm,int r32,int hi){
  const char*kb=Kslot+hi*1024+r32*16;
  #pragma unroll
  for(int d0=0;d0<4;++d0){
    const bf16x8 b0=*reinterpret_cast<const bf16x8*>(kb+d0*2048);
    const bf16x8 b1=*reinterpret_cast<const bf16x8*>(kb+d0*2048+512);
    if(d0==0){p0=__builtin_amdgcn_mfma_f32_32x32x16_bf16(b0,qr[0],negm,0,0,0);p1=__builtin_amdgcn_mfma_f32_32x32x16_bf16(b1,qr[0],negm,0,0,0);}
    else{p0=__builtin_amdgcn_mfma_f32_32x32x16_bf16(b0,qr[d0],p0,0,0,0);p1=__builtin_amdgcn_mfma_f32_32x32x16_bf16(b1,qr[d0],p1,0,0,0);}}
}
typedef __attribute__((address_space(3))) const char* lds_cptr;
typedef short v4i16_t __attribute__((ext_vector_type(4)));
__device__ __forceinline__ void kload8(bf16x8*kf,lds_cptr kp){
  kf[0]=*(const __attribute__((address_space(3))) bf16x8*)(kp);      kf[1]=*(const __attribute__((address_space(3))) bf16x8*)(kp+512);
  kf[2]=*(const __attribute__((address_space(3))) bf16x8*)(kp+2048); kf[3]=*(const __attribute__((address_space(3))) bf16x8*)(kp+2560);
  kf[4]=*(const __attribute__((address_space(3))) bf16x8*)(kp+4096); kf[5]=*(const __attribute__((address_space(3))) bf16x8*)(kp+4608);
  kf[6]=*(const __attribute__((address_space(3))) bf16x8*)(kp+6144); kf[7]=*(const __attribute__((address_space(3))) bf16x8*)(kp+6656);
}
__device__ __forceinline__ void kload2(bf16x8*kf,lds_cptr kp,int j){ kf[2*j]=*(const __attribute__((address_space(3))) bf16x8*)(kp+j*2048); kf[2*j+1]=*(const __attribute__((address_space(3))) bf16x8*)(kp+j*2048+512); }
__device__ __forceinline__ s16x4 vtr(lds_cptr p){ return __builtin_bit_cast(s16x4,__builtin_amdgcn_ds_read_tr16_b64_v4i16((__attribute__((address_space(3))) v4i16_t*)p)); }
__device__ __forceinline__ float rowmax(const f32x16&p0,const f32x16&p1){
  float a=max3f(p0[0],p0[1],p1[0]),b=max3f(p0[2],p0[3],p1[1]);a=max3f(a,p1[2],p1[3]);
  #pragma unroll
  for(int r=4;r<16;r+=4){a=max3f(a,p0[r],p0[r+1]);b=max3f(b,p0[r+2],p0[r+3]);a=max3f(a,p1[r],p1[r+1]);b=max3f(b,p1[r+2],p1[r+3]);}
  const float m=max2f(a,b);
  auto rr=__builtin_amdgcn_permlane32_swap(__float_as_uint(m),__float_as_uint(m),false,false);
  return max2f(__uint_as_float(rr[0]),__uint_as_float(rr[1]));
}
__device__ __forceinline__ void pv(f32x16*o,int vb,bf16x8 pa0,bf16x8 pa1,bf16x8 pa2,bf16x8 pa3){
  #pragma unroll
  for(int d0=0;d0<2;++d0){s16x4 lo[4],hi[4];
    #pragma unroll
    for(int ks=0;ks<4;++ks){
      asm volatile("ds_read_b64_tr_b16 %0,%1 offset:%c2":"=&v"(lo[ks]):"v"(vb),"i"(d0*4096+ks*1024):"memory");
      asm volatile("ds_read_b64_tr_b16 %0,%1 offset:%c2":"=&v"(hi[ks]):"v"(vb),"i"(d0*4096+ks*1024+512):"memory");}
    asm volatile("s_waitcnt lgkmcnt(0)":::"memory");SBAR();
    #define PK(k) (bf16x8){lo[k][0],lo[k][1],lo[k][2],lo[k][3],hi[k][0],hi[k][1],hi[k][2],hi[k][3]}
    o[d0]=__builtin_amdgcn_mfma_f32_32x32x16_bf16(pa0,PK(0),o[d0],0,0,0);
    o[d0]=__builtin_amdgcn_mfma_f32_32x32x16_bf16(pa1,PK(1),o[d0],0,0,0);
    o[d0]=__builtin_amdgcn_mfma_f32_32x32x16_bf16(pa2,PK(2),o[d0],0,0,0);
    o[d0]=__builtin_amdgcn_mfma_f32_32x32x16_bf16(pa3,PK(3),o[d0],0,0,0);
    #undef PK
  }
}

#ifndef ATTN_STORE16
#define ATTN_STORE16(p,v) (*(u32x4*)(p)=(v))
#endif
template<int THRL> __device__ __forceinline__ void attn_unit(long qrow0,int hcol,long kvrow0,int kvcol,int NT,const bf16*Q,const bf16*__restrict__ K,const bf16*__restrict__ V,bf16*O,char*shm,const int wave_){
  const int tid=wave_*64+hw_lane(),lane=tid&63,r32=lane&31,hi=lane>>5; const int wid=wave_;
  const bf16*Qw=Q+(qrow0+wid*QBLK)*DM+hcol;
  const bf16*Kh=K+kvrow0*KP+kvcol,*Vh=V+kvrow0*KP+kvcol;
  const unsigned lds0=(unsigned)(uintptr_t)shm;
  float*wsf=(float*)(shm+LDS_WS)+wid*64;
  const bf16*ksrc=Kh+(long)lane*KP+wid*8;
  const bf16*vsrc=Vh+(long)(16*(wid&3)+(lane>>2))*KP+(wid>>2)*32+(lane&3)*8;
  const unsigned kdst=lds0+LDS_K+wid*1024, vdst=lds0+LDS_V+wid*1024;
  #define DMA_K(t,slot) glds16(ksrc+(long)(t)*KVBLK*KP,(unsigned)__builtin_amdgcn_readfirstlane(kdst+(slot)))
  #define DMA_V(t,slot) glds16(vsrc+(long)(t)*KVBLK*KP,(unsigned)__builtin_amdgcn_readfirstlane(vdst+(slot)))
  const int vb0=(int)(lds0+LDS_V)+((lane>>4)&1)*32+(lane&3)*8+(4*hi+((lane&15)>>2))*64;
  const char*Kbase=shm+LDS_K; bf16x8 kf[8];
  const lds_cptr shm3=(lds_cptr)shm; const lds_cptr kp0=shm3+LDS_K+hi*1024+r32*16; const lds_cptr vp0=shm3+LDS_V+((lane>>4)&1)*32+(lane&3)*8+(4*hi+((lane&15)>>2))*64;
  DMA_K(0,0);DMA_V(0,0);DMA_K(1,SLOTB);
  bf16x8 qr[4];
  #pragma unroll
  for(int d0=0;d0<4;++d0)qr[d0]=*reinterpret_cast<const bf16x8*>(&Qw[(long)r32*DM+d0*16+hi*8]);
  float mhat=0.f,l_reg=0.f;f32x16 o[2];o[0]=f32x16{};o[1]=f32x16{};f32x16 negm=f32x16{};asm volatile("":"+v"(negm));
  #define CMASK(P0,P1,t) do{}while(0)
  bool resc=false;
  #define START(P0,P1) do{ const float rm=rowmax(P0,P1); resc=false; \
    { const float dl=rm; mhat=fadd_s(mhat,dl); \
      _Pragma("unroll") for(int r=0;r<16;++r){P0[r]=fsub_s(P0[r],dl);P1[r]=fsub_s(P1[r],dl);} \
      _Pragma("unroll") for(int r=0;r<16;++r)negm[r]=-mhat; asm volatile("":"+v"(negm)); } \
    _Pragma("unroll") for(int r=0;r<16;++r)P0[r]=__builtin_amdgcn_exp2f(P0[r]); }while(0)
  #define RESC() do{ if(resc){ asm volatile("s_waitcnt lgkmcnt(0)":::"memory"); \
      _Pragma("unroll") for(int d_=0;d_<2;++d_) _Pragma("unroll") for(int r=0;r<16;++r)o[d_][r]*=wsf[crow(r,hi)]; } }while(0)
  f32x16 pA0,pA1,pB0,pB1;
  int sl_prev=0,sl_cur=0,sl_next=SLOTB;
  #define ROT() do{sl_prev=sl_cur;sl_cur=sl_next;sl_next=(sl_next==(NSLOT-1)*SLOTB)?0:sl_next+SLOTB;}while(0)
  DMA_K(2,2*SLOTB);
  WAIT_BAR(3);
  qkt(pA0,pA1,Kbase,qr,negm,r32,hi);asm volatile("s_nop 15\n\ts_nop 7":"+v"(pA0),"+v"(pA1));CMASK(pA0,pA1,0);
  START(pA0,pA1);
  _Pragma("unroll") for(int r=0;r<16;++r)pA1[r]=__builtin_amdgcn_exp2f(pA1[r]);
  WAIT_BAR(0);
  DMA_K(3,0);DMA_V(1,SLOTB);
  ROT();
  kload8(kf,kp0+sl_cur);
  WAIT_BAR(2);
  s16x4 vlo[8],vhi[8]; u32x4 pw0,pw1,pw2,pw3;
  #define PKW(P,B) cvtpk_s(P[B],P[B+1])
  #define PAF(k) __builtin_bit_cast(bf16x8,pw##k)
  #define VFR(i) (bf16x8){vlo[i][0],vlo[i][1],vlo[i][2],vlo[i][3],vhi[i][0],vhi[i][1],vhi[i][2],vhi[i][3]}
  #define PIN(x) asm volatile("":"+v"(x))
  #define MX3(a,b,c) __builtin_fmaxf(__builtin_fmaxf((a),(b)),(c))
  #define GAPA(MF,A0,A1,A2,A3,W0,W1,PW) do{ MF; sacc+=A0; sacc+=A1; sacc+=A2; sacc+=A3; PIN(sacc); W0; W1; PIN(PW); SBAR(); }while(0)
  #define EX(v) __builtin_amdgcn_exp2f(v)
  #define GAPB(MF,X,B) do{ MF; X[B]=EX(X[B]); X[B+1]=EX(X[B+1]); X[B+2]=EX(X[B+2]); X[B+3]=EX(X[B+3]); PIN(X); SBAR(); }while(0)
  #define VRD(i) do{ vlo[i]=vtr(vp_+(((i)>>2)*4096+((i)&3)*1024)); vhi[i]=vtr(vp_+(((i)>>2)*4096+((i)&3)*1024+512)); }while(0)
  #define KRD(G,j) do{ if(G){ kload2(kf,kp0+sl_next,j); SBAR(); } }while(0)
  #define STEP(C0,C1,P0,P1,t,GK,GV,GL) do{ SBAR(); \
    const lds_cptr vp_=vp0+sl_prev; \
    VRD(0); SBAR(); float sacc=(P0[0]+P0[1]); \
    GAPA(C0=__builtin_amdgcn_mfma_f32_32x32x16_bf16(kf[0],qr[0],negm,0,0,0), P0[2],P0[3],P0[4],P0[5],     pw0[0]=PKW(P0,0), pw0[1]=PKW(P0,2), pw0); \
    VRD(4); SBAR(); GAPA(C1=__builtin_amdgcn_mfma_f32_32x32x16_bf16(kf[1],qr[0],negm,0,0,0), P0[6],P0[7],P0[8],P0[9],     pw0[2]=PKW(P0,4), pw0[3]=PKW(P0,6), pw0); \
    VRD(1); SBAR(); GAPA(C0=__builtin_amdgcn_mfma_f32_32x32x16_bf16(kf[2],qr[1],C0,0,0,0),   P0[10],P0[11],P0[12],P0[13], pw1[0]=PKW(P0,8), pw1[1]=PKW(P0,10), pw1); \
    VRD(5); SBAR(); GAPA(C1=__builtin_amdgcn_mfma_f32_32x32x16_bf16(kf[3],qr[1],C1,0,0,0),   P0[14],P0[15],P1[0],P1[1],   pw1[2]=PKW(P0,12),pw1[3]=PKW(P0,14), pw1); \
    VRD(2); SBAR(); GAPA(C0=__builtin_amdgcn_mfma_f32_32x32x16_bf16(kf[4],qr[2],C0,0,0,0),   P1[2],P1[3],P1[4],P1[5],     pw2[0]=PKW(P1,0), pw2[1]=PKW(P1,2), pw2); \
    VRD(6); SBAR(); GAPA(C1=__builtin_amdgcn_mfma_f32_32x32x16_bf16(kf[5],qr[2],C1,0,0,0),   P1[6],P1[7],P1[8],P1[9],     pw2[2]=PKW(P1,4), pw2[3]=PKW(P1,6), pw2); \
    VRD(3); SBAR(); GAPA(C0=__builtin_amdgcn_mfma_f32_32x32x16_bf16(kf[6],qr[3],C0,0,0,0),   P1[10],P1[11],P1[12],P1[13], pw3[0]=PKW(P1,8), pw3[1]=PKW(P1,10), pw3); \
    VRD(7); SBAR(); GAPA(C1=__builtin_amdgcn_mfma_f32_32x32x16_bf16(kf[7],qr[3],C1,0,0,0),   P1[14],P1[15],0.f,0.f,       pw3[2]=PKW(P1,12),pw3[3]=PKW(P1,14), pw3); \
    l_reg+=sacc; \
    if(GK){DMA_K((t)+3,sl_cur);} if(GV){DMA_V((t)+1,sl_next);} \
    CMASK(C0,C1,t); \
    { float a=MX3(C0[0],C0[1],C1[0]),b=MX3(C0[2],C0[3],C1[1]); a=MX3(a,C1[2],C1[3]); \
      _Pragma("unroll") for(int r=4;r<16;r+=4){a=MX3(a,C0[r],C0[r+1]);b=MX3(b,C0[r+2],C0[r+3]);a=MX3(a,C1[r],C1[r+1]);b=MX3(b,C1[r+2],C1[r+3]);} \
      float rm=__builtin_fmaxf(a,b); { auto rr=__builtin_amdgcn_permlane32_swap(__float_as_uint(rm),__float_as_uint(rm),false,false); rm=__builtin_fmaxf(__uint_as_float(rr[0]),__uint_as_float(rr[1])); } \
      resc=false; \
      if(__builtin_expect(__any(rm>(float)THRL),0)){ const float dl=__builtin_fmaxf(rm,0.f); mhat+=dl; \
        _Pragma("unroll") for(int r=0;r<16;++r){C0[r]-=dl;C1[r]-=dl;} \
        _Pragma("unroll") for(int r=0;r<16;++r)negm[r]=-mhat; asm volatile("":"+v"(negm)); \
        const float f=__builtin_amdgcn_exp2f(-dl); l_reg*=f; if(hi==0)wsf[r32]=f; resc=true; } } \
    SBAR(); \
    GAPB(o[0]=__builtin_amdgcn_mfma_f32_32x32x16_bf16(PAF(0),VFR(0),o[0],0,0,0), C0,0); \
    GAPB(o[1]=__builtin_amdgcn_mfma_f32_32x32x16_bf16(PAF(0),VFR(4),o[1],0,0,0), C0,4); \
    KRD(GL,0); GAPB(o[0]=__builtin_amdgcn_mfma_f32_32x32x16_bf16(PAF(1),VFR(1),o[0],0,0,0), C0,8); \
    KRD(GL,1); GAPB(o[1]=__builtin_amdgcn_mfma_f32_32x32x16_bf16(PAF(1),VFR(5),o[1],0,0,0), C0,12); \
    KRD(GL,2); GAPB(o[0]=__builtin_amdgcn_mfma_f32_32x32x16_bf16(PAF(2),VFR(2),o[0],0,0,0), C1,0); \
    KRD(GL,3); GAPB(o[1]=__builtin_amdgcn_mfma_f32_32x32x16_bf16(PAF(2),VFR(6),o[1],0,0,0), C1,4); \
    GAPB(o[0]=__builtin_amdgcn_mfma_f32_32x32x16_bf16(PAF(3),VFR(3),o[0],0,0,0), C1,8); \
    GAPB(o[1]=__builtin_amdgcn_mfma_f32_32x32x16_bf16(PAF(3),VFR(7),o[1],0,0,0), C1,12); \
    }while(0)
  int t=1;
  #undef CMASK
  #define CMASK(P0,P1,t) do{}while(0)
  for(;t+5<NT;t+=2){
    STEP(pB0,pB1,pA0,pA1,t,true,true,true);     WAIT_BAR(2); RESC(); ROT();
    STEP(pA0,pA1,pB0,pB1,t+1,true,true,true);   WAIT_BAR(2); RESC(); ROT();
  }
  #undef CMASK
  #define CMASK(P0,P1,t) do{}while(0)
  #define ENDW(tt) do{ if((tt)+3<NT){WAIT_BAR(2);} else if((tt)+2<NT){WAIT_BAR(1);} else {WAIT_BAR(0);} }while(0)
  for(;t+1<NT;t+=2){
    STEP(pB0,pB1,pA0,pA1,t,(t+3<NT),(t+1<NT),(t+1<NT));       ENDW(t);   RESC(); ROT();
    STEP(pA0,pA1,pB0,pB1,t+1,(t+4<NT),(t+2<NT),(t+2<NT));     ENDW(t+1); RESC(); ROT();
  }
  STEP(pB0,pB1,pA0,pA1,NT-1,false,false,false); RESC();
  { float sacc=pB0[0]+pB0[1]; _Pragma("unroll") for(int r=2;r<16;++r)sacc+=pB0[r]; _Pragma("unroll") for(int r=0;r<16;++r)sacc+=pB1[r]; l_reg+=sacc;
    pw0=(u32x4){PKW(pB0,0),PKW(pB0,2),PKW(pB0,4),PKW(pB0,6)};pw1=(u32x4){PKW(pB0,8),PKW(pB0,10),PKW(pB0,12),PKW(pB0,14)};pw2=(u32x4){PKW(pB1,0),PKW(pB1,2),PKW(pB1,4),PKW(pB1,6)};pw3=(u32x4){PKW(pB1,8),PKW(pB1,10),PKW(pB1,12),PKW(pB1,14)};
    SBAR(); pv(o,vb0+sl_cur,PAF(0),PAF(1),PAF(2),PAF(3)); }
  #undef PKW
  #undef PAF
  #undef VFR
  #undef PIN
  #undef MX3
  #undef GAPA
  #undef GAPB
  #undef EX
  #undef VRD
  #undef KRD
  #undef STEP
  #undef ENDW
  {auto rr=__builtin_amdgcn_permlane32_swap(__float_as_uint(l_reg),__float_as_uint(l_reg),false,false);l_reg=__uint_as_float(rr[0])+__uint_as_float(rr[1]);}
  if(hi==0)wsf[32+r32]=l_reg;asm volatile("s_waitcnt lgkmcnt(0)":::"memory");
  float rli[16];
  #pragma unroll
  for(int r=0;r<16;++r)rli[r]=__builtin_amdgcn_rcpf(wsf[32+crow(r,hi)]);
  bf16*Ow=O+(qrow0+wid*QBLK)*DM+hcol;
  { bf16*stg=(bf16*)(shm+LDS_OST)+wid*2048;
    #pragma unroll
    for(int r=0;r<16;++r){const int orow=crow(r,hi);
      #pragma unroll
      for(int d0=0;d0<2;++d0)stg[orow*64+d0*32+r32]=__float2bfloat16(o[d0][r]*rli[r]);}
    asm volatile("s_waitcnt lgkmcnt(0)":::"memory");
    #pragma unroll
    for(int i=0;i<4;++i){const int row=i*8+(lane>>3),ch=lane&7; const u32x4 v=*(const u32x4*)(stg+row*64+ch*8); ATTN_STORE16(Ow+(long)row*DM+ch*8,v);} }
  asm volatile("s_waitcnt lgkmcnt(0)\n\ts_barrier":::"memory");
  #undef DMA_K
  #undef DMA_V
  #undef CMASK
  #undef START
  #undef RESC
  #undef ROT
}
constexpr int ATTN_LDS_BYTES=LDS_BYTES;
#undef SBAR
#undef WAIT_BAR
}
#define GAS __attribute__((address_space(1)))
#define LAS __attribute__((address_space(3)))
typedef unsigned short bf16;
typedef unsigned v4u __attribute__((ext_vector_type(4)));
typedef float f32x4 __attribute__((ext_vector_type(4)));
typedef short bf16x8 __attribute__((ext_vector_type(8)));
typedef GAS unsigned gu32;
typedef GAS unsigned long long gu64;
#define RLX_AGENT __ATOMIC_RELAXED, __HIP_MEMORY_SCOPE_AGENT
#define LDS_WAIT() asm volatile("s_waitcnt lgkmcnt(0)" ::: "memory")
#define VM_WAIT() asm volatile("s_waitcnt vmcnt(0)" ::: "memory")
__device__ __forceinline__ unsigned long long rt() { return __builtin_amdgcn_s_memrealtime(); }
__device__ __forceinline__ unsigned f2bf(float f) { unsigned u = __builtin_bit_cast(unsigned, f); return (u + 0x7fffu + ((u >> 16) & 1u)) >> 16; }
__device__ __forceinline__ unsigned pk2(float lo, float hi) { return f2bf(lo) | (f2bf(hi) << 16); }

#define XB_TMO      128
#define XB_XCNT(j)  (256  + 64 * (j))
#define XB_XSUB(j)  (1280 + 64 * (j))
#define XB_XGEN(j)  (2304 + 64 * (j))
#define XB_TOP      3328
#define XB_TOPGEN   3392
#define XCD_BAR_WORDS 3456
#define XB_SPIN_CAP (1u << 18)

__device__ __forceinline__ unsigned xb_ld(unsigned* p)              { return __hip_atomic_load(p, __ATOMIC_RELAXED, __HIP_MEMORY_SCOPE_AGENT); }
__device__ __forceinline__ unsigned xb_add(unsigned* p, unsigned v) { return __hip_atomic_fetch_add(p, v, __ATOMIC_RELAXED, __HIP_MEMORY_SCOPE_AGENT); }
__device__ __forceinline__ unsigned xb_xcc_id() { return (unsigned)__builtin_amdgcn_s_getreg((3 << 11) | 20) & 0xFu; }
#define XB_SPIN(cond, bar) do { unsigned _sp = 0; while (cond) { __builtin_amdgcn_s_sleep(1); \
    if ((++_sp & 255u) == 0u) { if (xb_ld(&(bar)[XB_TMO])) break; if (_sp > XB_SPIN_CAP) { atomicAdd(&(bar)[XB_TMO], 1u); break; } } } } while (0)

struct XcdBarrier {
    unsigned* bar; unsigned x; int wv;
    volatile LAS unsigned* st;
};

__device__ __forceinline__ XcdBarrier xcd_barrier_post(unsigned* bar, volatile LAS unsigned* st, int wv) {
    XcdBarrier b; b.bar = bar; b.x = xb_xcc_id(); b.st = st; b.wv = wv;
    if (threadIdx.x == 0) (void)xb_add(&bar[XB_XCNT(b.x)], 1u);
    return b;
}
__device__ __forceinline__ void xcd_barrier_complete(unsigned* bar, unsigned x, unsigned& nloc, unsigned& nx) {
    const unsigned G = gridDim.x * gridDim.y * gridDim.z;
    unsigned sum, cnt, mine, sp = 0u;
    for (;;) {
        sum = 0u; cnt = 0u; mine = 0u;
#pragma unroll
        for (unsigned j = 0; j < 16; ++j) { const unsigned c = xb_ld(&bar[XB_XCNT(j)]); sum += c; cnt += (c > 0u) ? 1u : 0u; mine = (j == x) ? c : mine; }
        if (sum == G) break;
        __builtin_amdgcn_s_sleep(1);
        if ((++sp & 255u) == 0u) { if (xb_ld(&bar[XB_TMO])) break; if (sp > XB_SPIN_CAP) { atomicAdd(&bar[XB_TMO], 1u); break; } }
    }
    nloc = mine > 0u ? mine : 1u; nx = cnt > 0u ? cnt : 1u;
}

__device__ __forceinline__ void xcd_barrier(const XcdBarrier& b) {
    asm volatile("s_waitcnt vmcnt(0)" ::: "memory");
    __syncthreads();
    if (b.wv == 0 && hw_lane() == 0) {
        unsigned* bar = b.bar;
        __builtin_amdgcn_s_waitcnt(0);
        unsigned nloc = b.st[0], nx = b.st[1];
        if (nloc == 0u) { xcd_barrier_complete(bar, b.x, nloc, nx); b.st[0] = nloc; b.st[1] = nx; }
        const unsigned old = xb_add(&bar[XB_XSUB(b.x)], 1u);
        const unsigned gen = old / nloc;
        if (old + 1u == (gen + 1u) * nloc) {
            __builtin_amdgcn_fence(__ATOMIC_RELEASE, "agent");
            asm volatile("s_waitcnt vmcnt(0)" ::: "memory");
            const unsigned og = xb_add(&bar[XB_TOP], 1u);
            const unsigned tg = og / nx;
            if (og + 1u == (tg + 1u) * nx) xb_add(&bar[XB_TOPGEN], 1u);
            else XB_SPIN(xb_ld(&bar[XB_TOPGEN]) == tg, bar);
            __builtin_amdgcn_fence(__ATOMIC_ACQUIRE, "agent");
            xb_add(&bar[XB_XGEN(b.x)], 1u);
            asm volatile("s_waitcnt vmcnt(0)" ::: "memory");
        } else {
            XB_SPIN(xb_ld(&bar[XB_XGEN(b.x)]) == gen, bar);
            __builtin_amdgcn_fence(__ATOMIC_ACQUIRE, "agent");
            asm volatile("s_waitcnt vmcnt(0)" ::: "memory");
        }
    }
    __syncthreads();
}

#ifndef PROBE
#define PROBE 0
#endif
#ifndef DEBUG_NAN
#define DEBUG_NAN 0
#endif
#ifndef TSEL
#define TSEL -1
#endif
#ifndef CYSEL
#define CYSEL -1
#endif
#ifndef TSCALE10
#define TSCALE10 0
#endif
#if TSEL >= 0
#define TS(k) do { if (blockIdx.x == 0 && F.wave == 0 && hw_lane() == 0) { unsigned long long* ts_ = (unsigned long long*)(F.ws + WS_CTL + 32768); const unsigned long long now_ = __builtin_amdgcn_s_memrealtime(); ts_[1 + (k)] += now_ - ts_[0]; ts_[0] = now_; } } while (0)
#else
#define TS(k) do {} while (0)
#endif
#ifndef USE_SEQ_SCAN
#define USE_SEQ_SCAN 0
#endif
constexpr int NWAVES = 8;
constexpr int DMODEL = 1024, NBATCH = 8, SEQL = 4096, CTXL = 256, DEPTH = 4;
constexpr int TL = NBATCH * SEQL, TC = NBATCH * CTXL, TT = TL + TC;
constexpr int KVLEN = SEQL + CTXL;
constexpr int INW = 2688, INWP = 2816, ATTIN = 768, SHIFTW = 1920;
constexpr int FFD = 2816, FFE = 3584, NEXP = 8;
constexpr int LORA_K = 384, LORA_N = 2560;
constexpr int MAXPANEL = 280, MAXSLOT = MAXPANEL * 256;
constexpr float RMS_EPS = 1e-6f, GN_EPS = 64e-5f;

constexpr size_t MiB = 1u << 20;
constexpr size_t WS_CTL = 0, CTL_ZERO_BYTES = 64 * 1024;
constexpr size_t WS_MOD = 1 * MiB;
constexpr size_t WS_ROPE = 2 * MiB;
constexpr size_t WS_ROUTE = 3 * MiB;
constexpr size_t RT_E = 0, RT_G = 160 * 1024, RT_S = 448 * 1024, RT_BLK = 768 * 1024, RT_WCNT = 800 * 1024;
constexpr size_t WS_XB = 12 * MiB;
constexpr size_t WS_WIN = 80 * MiB, WS_WOUT = 86 * MiB, WS_WLORA = 88 * MiB;
constexpr size_t WS_WFF = 100 * MiB;
constexpr size_t WS_WFF_D_DENSE = WS_WFF + 12 * MiB, WS_WFF_D_MOE = WS_WFF + 112 * MiB;
constexpr size_t WS_ACT = 270 * MiB;
constexpr size_t WS_QO = WS_ACT, WS_KB = WS_ACT + 68 * MiB, WS_VB = WS_ACT + 77 * MiB, WS_P = WS_ACT + 86 * MiB, WS_OSC = WS_P;
constexpr size_t WS_R = WS_ACT + 273 * MiB, WS_K = WS_ACT + 307 * MiB, WS_V = WS_ACT + 341 * MiB, WS_KK = WS_ACT + 375 * MiB, WS_LIN = WS_ACT + 409 * MiB;
constexpr size_t WS_LOUT = WS_ACT + 435 * MiB;
constexpr size_t WS_SPT = WS_WFF, WS_SG = WS_WFF + 68 * MiB, WS_SQ = WS_ACT + 605 * MiB;
constexpr size_t WS_HID = WS_ACT;
constexpr size_t WS_AG = WS_ACT, WS_AG8 = WS_ACT + 140 * MiB, WS_HIDM = WS_ACT + 210 * MiB;
constexpr size_t WS_WFF_D_MOE8 = WS_WFF + 56 * MiB;
constexpr float W8SCALE = 64.0f, H8SCALE = 8.0f, HID8SCALE = 4.0f;
constexpr size_t WS_SIDE = 1000 * MiB;
constexpr size_t WS_END = 1012 * MiB;
static_assert(WS_LOUT + (size_t)TT * LORA_N * 2 <= WS_END && WS_HIDM + (size_t)MAXSLOT * FFE <= WS_END && WS_P + (size_t)TT * INWP * 2 <= WS_R && WS_OSC + (size_t)2 * TT * 512 * 4 <= WS_R, "ws map");
static_assert(WS_WFF_D_MOE + (size_t)NEXP * 1024 * FFE * 2 <= WS_ACT && WS_XB + (size_t)TT * 1024 * 2 <= WS_WIN && WS_WIN + (size_t)INWP * 1024 * 2 <= WS_WOUT && WS_WLORA + (size_t)LORA_N * LORA_K * 2 <= WS_WFF, "ws map 2");
constexpr int CW_BAR = 4096;

constexpr int RING_OFF = 0, RING_BYTES = 131072;
constexpr int LDSCTL_OFF = RING_BYTES;
constexpr int MISC_OFF = LDSCTL_OFF;
constexpr int LT_PEXP = LDSCTL_OFF + 256;
constexpr int LT_NPAN = LT_PEXP + 320 * 4;
constexpr int LT_INP = LT_NPAN + 64;
constexpr int LT_TMP = LT_INP + 256;
constexpr int LDS_BYTES = 147456;
static_assert(LT_TMP + 8192 + 1024 <= LDS_BYTES, "LDS map");

struct Frame {
    LAS unsigned char* lds;
    volatile LAS unsigned* MISC;
    gu32* ctl;
    int tid, lane, wave, vcu, G;
    unsigned char* ws;
    float* out;
};
struct Args { const float* in[30]; float* out; unsigned char* ws; };
__device__ __forceinline__ const void* inp_ld(const Frame& F, int k) {
    const LAS unsigned* t = (const LAS unsigned*)(F.lds + LT_INP) + 2 * k; unsigned lo = t[0], hi = t[1];
    lo = __builtin_amdgcn_readfirstlane(lo); hi = __builtin_amdgcn_readfirstlane(hi);
    return (const void*)(const GAS void*)(((unsigned long long)hi << 32) | lo);
}
#define IN_X 0
#define IN_C 1
#define IN_CTX 2
#define IN_CCTX 3
#define IN_ADAW 4
#define IN_ADAB 5
#define IN_N1G 6
#define IN_N2G 7
#define IN_WIN 8
#define IN_WOUT 9
#define IN_QG 10
#define IN_KG 11
#define IN_MU 12
#define IN_W0 13
#define IN_W2 14
#define IN_A0 15
#define IN_A2 16
#define IN_G2 17
#define IN_KKW 18
#define IN_KA 19
#define IN_RK 20
#define IN_GNW 21
#define IN_GNB 22
#define IN_FWG 23
#define IN_FWU 24
#define IN_FWD 25
#define IN_ROUTER 26
#define IN_MWG 27
#define IN_MWU 28
#define IN_MWD 29

__device__ __forceinline__ int vlaunder(int v) { asm volatile("" : "+v"(v)); return v; }
__device__ __forceinline__ unsigned char* launder(unsigned char* p) { unsigned long long v = (unsigned long long)p; asm volatile("" : "+s"(v)); return (unsigned char*)(GAS unsigned char*)v; }
#define INP(k) ((const float*)inp_ld(F, (k)))
__device__ __forceinline__ const void* inp_ld(const struct Frame& F, int k);
__device__ __forceinline__ float wave_sum(float v) {
#pragma unroll
    for (int o = 1; o < 64; o <<= 1) v += __shfl_xor(v, o);
    return v;
}
__device__ __forceinline__ float half_sum(float v) {
#pragma unroll
    for (int o = 1; o < 32; o <<= 1) v += __shfl_xor(v, o);
    return v;
}
__device__ __forceinline__ float bflo(unsigned w) { return __builtin_bit_cast(float, w << 16); }
__device__ __forceinline__ float bfhi(unsigned w) { return __builtin_bit_cast(float, w & 0xffff0000u); }
typedef float f32x2_t_ __attribute__((ext_vector_type(2))); typedef __bf16 bf16x2_t_ __attribute__((ext_vector_type(2)));
__device__ __forceinline__ unsigned pkbf(float lo, float hi) { f32x2_t_ v = {lo, hi}; bf16x2_t_ b = __builtin_convertvector(v, bf16x2_t_); return __builtin_bit_cast(unsigned, b); }
__device__ __forceinline__ float sigm(float x) { return __builtin_amdgcn_rcpf(1.0f + __builtin_amdgcn_exp2f(-1.4426950408889634f * x)); }

__device__ __forceinline__ void p_prologue(Frame& F, const Args& A) {
    unsigned char* const ws = launder(F.ws);
    const int tid = (F.wave * 64 + hw_lane()), lane = tid & 63; (void)lane;
    LAS float* sc = (LAS float*)(F.lds + RING_OFF);
    for (int i = tid; i < 9 * 1024; i += NWAVES * 64) { const int b = i >> 10, k = i & 1023; const float v = (b < 8) ? INP(IN_C)[b * 1024 + k] : INP(IN_CCTX)[k]; sc[i] = v * sigm(v); }
    __syncthreads();
    const int gw = F.vcu * NWAVES + F.wave, NGW = F.G * NWAVES;
    float* mod = (float*)(ws + WS_MOD);
    for (int it = (int)blockIdx.x + F.G * F.wave; it < DEPTH * 96; it += NGW) {
        const int l = it / 96, j = (it % 96) * 64 + lane;
        const float* W = INP(IN_ADAW) + (size_t)l * 1024 * 6144 + j;
        float acc[9];
#pragma unroll
        for (int b = 0; b < 9; ++b) acc[b] = 0.f;
        for (int k = 0; k < 1024; k += 16) {
            float wv[16];
#pragma unroll
            for (int u = 0; u < 16; ++u) wv[u] = W[(size_t)(k + u) * 6144];
#pragma unroll
            for (int b = 0; b < 9; ++b)
#pragma unroll
                for (int u4 = 0; u4 < 4; ++u4) { const f32x4 s = *(const LAS f32x4*)(sc + b * 1024 + k + 4 * u4); acc[b] += (s[0] * wv[4 * u4] + s[1] * wv[4 * u4 + 1]) + (s[2] * wv[4 * u4 + 2] + s[3] * wv[4 * u4 + 3]); }
        }
        const float bias = INP(IN_ADAB)[l * 6144 + j];
#pragma unroll
        for (int b = 0; b < 9; ++b) mod[((size_t)l * 9 + b) * 6144 + j] = acc[b] + bias;
    }
    float* cs = (float*)(ws + WS_ROPE);
    for (int i = blockIdx.x * (NWAVES * 64) + tid; i < 4096 * 32; i += F.G * NWAVES * 64) {
        const int t = i >> 5, k = i & 31; const int pos = (k < 16) ? (t >> 6) : (t & 63);
        const float inv = powf(10000.0f, -(float)(2 * (k & 15)) / 32.0f); const float ang = (float)pos * inv;
        float s, c; sincosf(ang, &s, &c); cs[2 * i] = c; cs[2 * i + 1] = s;
    }
    __syncthreads();
}

struct WItem { const float* W; unsigned char* WT; int K, N, k0, n0, drow0, f8; };
__device__ __forceinline__ void tr_load(const WItem& w, float (&tv)[32], int lane) {
#pragma unroll
    for (int i = 0; i < 32; ++i) tv[i] = w.W[(size_t)(w.k0 + 2 * i + (lane >> 5)) * w.N + w.n0 + (lane & 31)];
}
__device__ __forceinline__ void tr_finish(const WItem& w, const float (&tv)[32], LAS float* scr, int lane) {
#pragma unroll
    for (int i = 0; i < 32; ++i) scr[(2 * i + (lane >> 5)) * 33 + (lane & 31)] = tv[i];
    LDS_WAIT(); asm volatile("" ::: "memory");
    if (w.f8) { const int c = lane & 3;
#pragma unroll
        for (int j = 0; j < 2; ++j) { const int n = (lane >> 2) + 16 * j; const LAS float* s = scr + (16 * c) * 33 + n;
            v4u o;
            o.x = pg8::pk_fp8x4(s[0 * 33] * W8SCALE, s[1 * 33] * W8SCALE, s[2 * 33] * W8SCALE, s[3 * 33] * W8SCALE); o.y = pg8::pk_fp8x4(s[4 * 33] * W8SCALE, s[5 * 33] * W8SCALE, s[6 * 33] * W8SCALE, s[7 * 33] * W8SCALE);
            o.z = pg8::pk_fp8x4(s[8 * 33] * W8SCALE, s[9 * 33] * W8SCALE, s[10 * 33] * W8SCALE, s[11 * 33] * W8SCALE); o.w = pg8::pk_fp8x4(s[12 * 33] * W8SCALE, s[13 * 33] * W8SCALE, s[14 * 33] * W8SCALE, s[15 * 33] * W8SCALE);
            *(v4u*)(w.WT + (size_t)(w.drow0 + n) * w.K + w.k0 + 16 * c) = o; }
    } else { const int c = lane & 7;
#pragma unroll
        for (int j = 0; j < 4; ++j) { const int n = (lane >> 3) + 8 * j; const LAS float* s = scr + (8 * c) * 33 + n;
            v4u o; o.x = pkbf(s[0 * 33], s[1 * 33]); o.y = pkbf(s[2 * 33], s[3 * 33]); o.z = pkbf(s[4 * 33], s[5 * 33]); o.w = pkbf(s[6 * 33], s[7 * 33]);
            *(v4u*)((bf16*)w.WT + (size_t)(w.drow0 + n) * w.K + w.k0 + 8 * c) = o; } }
    LDS_WAIT(); asm volatile("" ::: "memory");
}
__device__ __forceinline__ int gu_row(int n) { return 256 * (n >> 7) + (n & 127); }

__device__ __forceinline__ WItem wprep_decode(Frame& F, unsigned char* const ws, const int l, const int it) {
    constexpr int I_IN = 16 * (INW / 32), I_OUT = 16 * 32;
    const bool moe = (l & 1) != 0; const int j = l >> 1;
    constexpr int I_DG = 16 * (FFD / 32), I_MG = 16 * (FFE / 32);
    int r = it; WItem w;
    if (r < I_IN) { const int nb = r % (INW / 32), kb = r / (INW / 32); w = WItem{INP(IN_WIN) + (size_t)l * 1024 * INW, ws + WS_WIN, 1024, INW, kb * 64, nb * 32, nb * 32, 0}; return w; } r -= I_IN;
    if (r < I_OUT) { const int nb = r % 32, kb = r / 32; w = WItem{INP(IN_WOUT) + (size_t)l * 1024 * 1024, ws + WS_WOUT, 1024, 1024, kb * 64, nb * 32, nb * 32, 0}; return w; } r -= I_OUT;
    if (!moe) {
        if (r < I_DG) { const int nb = r % (FFD / 32), kb = r / (FFD / 32); w = WItem{INP(IN_FWG) + (size_t)j * 1024 * FFD, ws + WS_WFF, 1024, FFD, kb * 64, nb * 32, gu_row(nb * 32), 0}; return w; } r -= I_DG;
        if (r < I_DG) { const int nb = r % (FFD / 32), kb = r / (FFD / 32); w = WItem{INP(IN_FWU) + (size_t)j * 1024 * FFD, ws + WS_WFF, 1024, FFD, kb * 64, nb * 32, gu_row(nb * 32) + 128, 0}; return w; } r -= I_DG;
        { const int nb = r % 32, kb = r / 32; w = WItem{INP(IN_FWD) + (size_t)j * FFD * 1024, ws + WS_WFF_D_DENSE, FFD, 1024, kb * 64, nb * 32, nb * 32, 0}; return w; }
    }
    constexpr int I_MD = (FFE / 64) * 32; constexpr int PER = 2 * I_MG + I_MD; const int e = r / PER; r -= e * PER;
    unsigned char* WGU = ws + WS_WFF + (size_t)e * (2 * FFE) * 1024; unsigned char* WD = ws + WS_WFF_D_MOE8 + (size_t)e * 1024 * FFE;
    const size_t eo = ((size_t)j * NEXP + e) * 1024 * FFE;
    if (r < I_MG) { const int nb = r % (FFE / 32), kb = r / (FFE / 32); w = WItem{INP(IN_MWG) + eo, WGU, 1024, FFE, kb * 64, nb * 32, gu_row(nb * 32), 1}; return w; } r -= I_MG;
    if (r < I_MG) { const int nb = r % (FFE / 32), kb = r / (FFE / 32); w = WItem{INP(IN_MWU) + eo, WGU, 1024, FFE, kb * 64, nb * 32, gu_row(nb * 32) + 128, 1}; return w; } r -= I_MG;
    { const int nb = r % 32, kb = r / 32; w = WItem{INP(IN_MWD) + eo, WD, FFE, 1024, kb * 64, nb * 32, nb * 32, 1}; return w; }
}
__device__ __forceinline__ void p_wprep(Frame& F, const Args& A, int l, int part, gu32* ctr = nullptr) {
    unsigned char* const ws = launder(F.ws);
    const int tid = (F.wave * 64 + hw_lane()), lane = tid & 63; (void)lane;
    LAS float* scr = (LAS float*)(F.lds + RING_OFF + F.wave * 16384);
    const int gw = F.vcu * NWAVES + F.wave, NGW = F.G * NWAVES;
    bf16* WIN = (bf16*)(ws + WS_WIN); bf16* WLORA = (bf16*)(ws + WS_WLORA);
    constexpr int I_IN = 16 * (INW / 32), I_OUT = 16 * 32;
    const bool moe = (l & 1) != 0;
    constexpr int I_DG = 16 * (FFD / 32), I_DD = (FFD / 64) * 32, I_MG = 16 * (FFE / 32), I_MD = (FFE / 64) * 32;
    const int nff = moe ? NEXP * (2 * I_MG + I_MD) : (2 * I_DG + I_DD);
    const int NIT = I_IN + I_OUT + nff;
    const int lo = part ? I_IN + I_OUT : 0, hi = part ? NIT : I_IN + I_OUT;
    (void)ctr;
    {
        int it = lo + gw; WItem wa, wb; float ta[32], tb[32];
        if (it < hi) { wa = wprep_decode(F, ws, l, it); tr_load(wa, ta, lane); }
        for (; it < hi; it += 2 * NGW) {
            const int i2 = it + NGW, i3 = i2 + NGW;
            if (i2 < hi) { wb = wprep_decode(F, ws, l, i2); tr_load(wb, tb, lane); }
            tr_finish(wa, ta, scr, lane);
            if (i3 < hi) { wa = wprep_decode(F, ws, l, i3); tr_load(wa, ta, lane); }
            if (i2 < hi) tr_finish(wb, tb, scr, lane);
        }
    }
    if (part) return;
    for (int i = blockIdx.x * (NWAVES * 64) + tid; i < 16384; i += F.G * NWAVES * 64) ((v4u*)(WIN + (size_t)INW * 1024))[i] = (v4u){0u, 0u, 0u, 0u};
    const float* w2 = INP(IN_W2) + (size_t)l * 2 * 64 * 512; const float* a2 = INP(IN_A2) + (size_t)l * 2 * 64 * 512; const float* g2 = INP(IN_G2) + (size_t)l * 128 * 512;
    for (int i = blockIdx.x * (NWAVES * 64) + tid; i < LORA_N * 64; i += F.G * NWAVES * 64) {
        const int n = i >> 6, k = (i & 63) * 2; const int sec = n >> 9, cn = n & 511;
        float v0 = 0.f, v1 = 0.f;
        if (sec < 2) { const int kk = k - 64 * sec; if (kk >= 0 && kk < 64) { v0 = w2[((size_t)sec * 64 + kk) * 512 + cn]; v1 = w2[((size_t)sec * 64 + kk + 1) * 512 + cn]; } }
        else if (sec < 4) { const int d = sec - 2, kk = k - 64 * d; if (kk >= 0 && kk < 64) { v0 = a2[((size_t)d * 64 + kk) * 512 + cn]; v1 = a2[((size_t)d * 64 + kk + 1) * 512 + cn]; } }
        else { v0 = g2[(size_t)k * 512 + cn]; v1 = g2[(size_t)(k + 1) * 512 + cn]; }
        ((unsigned*)WLORA)[i] = pkbf(v0, v1);
    }
}

template <bool ROUTER, bool COMBINE, bool SRCF32, bool SIDE = false>
__device__ __forceinline__ void p_norm(Frame& F, const Args& A, int l, int which, const float* srcL, const float* srcC, int lprev, int nrows = TT) {
    unsigned char* const ws = launder(F.ws);
    const int tid = (F.wave * 64 + hw_lane()), lane = tid & 63; (void)lane;
    const int gw = F.vcu * NWAVES + F.wave, NGW = F.G * NWAVES;
    const float* mod = (const float*)(ws + WS_MOD) + (size_t)l * 9 * 6144;
    const float* gain = A.in[which ? IN_N2G : IN_N1G] + l * 1024;
    bf16* H = (bf16*)F.out;
    const float* route_g = (const float*)(ws + WS_ROUTE + RT_G); const int* route_s = (const int*)(ws + WS_ROUTE + RT_S);
    int cnt0 = 0, cnt1 = 0, cnt2 = 0, cnt3 = 0, cnt4 = 0, cnt5 = 0, cnt6 = 0, cnt7 = 0;
    LAS float* rwl = (LAS float*)(F.lds + RING_OFF);
    if (ROUTER) {
        __syncthreads();
        const float* rw = INP(IN_ROUTER) + (size_t)(l >> 1) * 1024 * 8;
        for (int i = tid; i < 2048; i += NWAVES * 64) { const f32x4 w = *(const f32x4*)(rw + 4 * i); const int col = i >> 1, e4 = (i & 1) * 4, jj = col >> 8, ln = (col & 255) >> 2, q = col & 3;
            *(LAS f32x4*)(rwl + (((jj * 4 + q) * 64 + ln) * 8 + e4)) = w; }
        __syncthreads();
    }
    uint2 nx[2][4]; f32x4 nf[2][4]; float cg[2][2]; int cs[2][2];
#pragma unroll
    for (int r = 0; r < 2; ++r) { cg[r][0] = cg[r][1] = 0.f; cs[r][0] = cs[r][1] = 0;
#pragma unroll
        for (int jj = 0; jj < 4; ++jj) { nx[r][jj] = make_uint2(0u, 0u); nf[r][jj] = (f32x4){0.f, 0.f, 0.f, 0.f}; } }
#define PN_LOAD(r_, row_) do { const int row__ = (row_); if (row__ < nrows) { \
        if (SRCF32) { const float* xr_ = (row__ < TL) ? srcL + (size_t)row__ * 1024 : srcC + (size_t)(row__ - TL) * 1024; _Pragma("unroll") for (int jj = 0; jj < 4; ++jj) nf[r_][jj] = *(const f32x4*)(xr_ + 4 * ln + 256 * jj); } \
        else { const bf16* xr_ = (const bf16*)(ws + WS_XB) + (size_t)row__ * 1024; _Pragma("unroll") for (int jj = 0; jj < 4; ++jj) nx[r_][jj] = *(const uint2*)(xr_ + 4 * ln + 256 * jj); } \
        if (COMBINE) { cg[r_][0] = route_g[2 * row__]; cg[r_][1] = route_g[2 * row__ + 1]; cs[r_][0] = route_s[2 * row__]; cs[r_][1] = route_s[2 * row__ + 1]; } } } while (0)
    int ln = vlaunder(lane);
    PN_LOAD(0, gw); PN_LOAD(1, gw + NGW);
    for (int row0 = gw; row0 < nrows; row0 += 2 * NGW) {
        ln = vlaunder(lane);
        const bool ok1 = row0 + NGW < nrows;
        f32x4 v[2][4]; float g0[2], g1[2]; int s0[2], s1[2];
#pragma unroll
        for (int r = 0; r < 2; ++r) { g0[r] = cg[r][0]; g1[r] = cg[r][1]; s0[r] = cs[r][0]; s1[r] = cs[r][1];
#pragma unroll
            for (int jj = 0; jj < 4; ++jj) { if (SRCF32) v[r][jj] = nf[r][jj]; else { const uint2 w = nx[r][jj]; v[r][jj] = (f32x4){bflo(w.x), bfhi(w.x), bflo(w.y), bfhi(w.y)}; } } }
        PN_LOAD(0, row0 + 2 * NGW); PN_LOAD(1, row0 + 3 * NGW);
        if (COMBINE) {
            const bf16* Y = (const bf16*)(ws + WS_AG);
            uint2 yy0[2][4], yy1[2][4];
#pragma unroll
            for (int r = 0; r < 2; ++r)
#pragma unroll
                for (int jj = 0; jj < 4; ++jj) { const int col = 4 * ln + 256 * jj; yy0[r][jj] = *(const uint2*)(Y + (size_t)s0[r] * 1024 + col); yy1[r][jj] = *(const uint2*)(Y + (size_t)s1[r] * 1024 + col); }
#pragma unroll
            for (int r = 0; r < 2; ++r) { const int row = row0 + r * NGW; const int bsel = (row < TL) ? (row >> 12) : 8;
                const float* m5 = (const float*)(ws + WS_MOD) + ((size_t)lprev * 9 + bsel) * 6144 + 5 * 1024;
                bf16* xbr = (bf16*)(ws + WS_XB) + (size_t)row * 1024;
#pragma unroll
                for (int jj = 0; jj < 4; ++jj) { const int col = 4 * ln + 256 * jj;
                    const uint2 y0 = yy0[r][jj], y1 = yy1[r][jj]; const f32x4 mm = *(const f32x4*)(m5 + col);
                    v[r][jj][0] += mm[0] * (g0[r] * bflo(y0.x) + g1[r] * bflo(y1.x)); v[r][jj][1] += mm[1] * (g0[r] * bfhi(y0.x) + g1[r] * bfhi(y1.x));
                    v[r][jj][2] += mm[2] * (g0[r] * bflo(y0.y) + g1[r] * bflo(y1.y)); v[r][jj][3] += mm[3] * (g0[r] * bfhi(y0.y) + g1[r] * bfhi(y1.y));
                    if (r == 0 || ok1) *(uint2*)(xbr + col) = make_uint2(pkbf(v[r][jj][0], v[r][jj][1]), pkbf(v[r][jj][2], v[r][jj][3])); } }
        }
        if (SIDE) {
#pragma unroll
            for (int r = 0; r < 2; ++r) { const int row = row0 + r * NGW;
                if ((r == 0 || ok1) && row >= TL) {
                    const bf16* sd = (const bf16*)(ws + WS_SIDE) + (size_t)(row - TL) * 1024; bf16* xbr = (bf16*)(ws + WS_XB) + (size_t)row * 1024;
                    uint2 sv[3][4];
#pragma unroll
                    for (int q = 0; q < 3; ++q)
#pragma unroll
                        for (int jj = 0; jj < 4; ++jj) sv[q][jj] = *(const uint2*)(sd + (size_t)q * TC * 1024 + 4 * ln + 256 * jj);
#pragma unroll
                    for (int jj = 0; jj < 4; ++jj) {
#pragma unroll
                        for (int q = 0; q < 3; ++q) { const uint2 w = sv[q][jj]; v[r][jj][0] += bflo(w.x); v[r][jj][1] += bfhi(w.x); v[r][jj][2] += bflo(w.y); v[r][jj][3] += bfhi(w.y); }
                        *(uint2*)(xbr + 4 * ln + 256 * jj) = make_uint2(pkbf(v[r][jj][0], v[r][jj][1]), pkbf(v[r][jj][2], v[r][jj][3])); } } }
        }
        float ss[2];
#pragma unroll
        for (int r = 0; r < 2; ++r) { ss[r] = 0.f;
#pragma unroll
            for (int jj = 0; jj < 4; ++jj) ss[r] += (v[r][jj][0] * v[r][jj][0] + v[r][jj][1] * v[r][jj][1]) + (v[r][jj][2] * v[r][jj][2] + v[r][jj][3] * v[r][jj][3]); }
#pragma unroll
        for (int o = 1; o < 64; o <<= 1) { const float t0 = __shfl_xor(ss[0], o), t1 = __shfl_xor(ss[1], o); ss[0] += t0; ss[1] += t1; }
        float rstd[2]; const float* shp[2];
#pragma unroll
        for (int r = 0; r < 2; ++r) { const int row = row0 + r * NGW; const int bsel = (row < TL) ? (row >> 12) : 8;
            rstd[r] = 1.0f / sqrtf(ss[r] * (1.0f / 1024.0f) + RMS_EPS); shp[r] = mod + (size_t)bsel * 6144 + (which ? 3 : 0) * 1024; }
        float lg[2][8];
#pragma unroll
        for (int r = 0; r < 2; ++r)
#pragma unroll
            for (int e = 0; e < 8; ++e) lg[r][e] = 0.f;
#pragma unroll
        for (int jj = 0; jj < 4; ++jj) { const int col = 4 * ln + 256 * jj;
            const f32x4 gg = *(const f32x4*)(gain + col); f32x4 h[2];
#pragma unroll
            for (int r = 0; r < 2; ++r) { const int row = row0 + r * NGW;
                const f32x4 sh = *(const f32x4*)(shp[r] + col), sc = *(const f32x4*)(shp[r] + 1024 + col);
                h[r] = (v[r][jj] * rstd[r]) * gg * (sc + 1.0f) + sh;
                if (r == 0 || ok1) {
                    if (ROUTER) *(unsigned*)((unsigned char*)H + (size_t)row * 1024 + col) = pg8::pk_fp8x4(h[r][0] * H8SCALE, h[r][1] * H8SCALE, h[r][2] * H8SCALE, h[r][3] * H8SCALE);
                    else { uint2 o; o.x = pkbf(h[r][0], h[r][1]); o.y = pkbf(h[r][2], h[r][3]); *(uint2*)(H + (size_t)row * 1024 + col) = o; } } }
            if (ROUTER) {
#pragma unroll
                for (int q = 0; q < 4; ++q) { const LAS float* rp = rwl + ((jj * 4 + q) * 64 + ln) * 8; const f32x4 ra = *(const LAS f32x4*)rp, rb = *(const LAS f32x4*)(rp + 4);
#pragma unroll
                    for (int r = 0; r < 2; ++r) { lg[r][0] += h[r][q] * ra[0]; lg[r][1] += h[r][q] * ra[1]; lg[r][2] += h[r][q] * ra[2]; lg[r][3] += h[r][q] * ra[3];
                        lg[r][4] += h[r][q] * rb[0]; lg[r][5] += h[r][q] * rb[1]; lg[r][6] += h[r][q] * rb[2]; lg[r][7] += h[r][q] * rb[3]; } } }
        }
        if (ROUTER) {
#pragma unroll
            for (int o = 1; o < 64; o <<= 1) { float t[2][8];
#pragma unroll
                for (int r = 0; r < 2; ++r)
#pragma unroll
                    for (int e = 0; e < 8; ++e) t[r][e] = __shfl_xor(lg[r][e], o);
#pragma unroll
                for (int r = 0; r < 2; ++r)
#pragma unroll
                    for (int e = 0; e < 8; ++e) lg[r][e] += t[r][e]; }
#pragma unroll
            for (int r = 0; r < 2; ++r) { const int row = row0 + r * NGW;
                if (r == 0 || ok1) {
                    int e0 = 0; float v0 = lg[r][0];
#pragma unroll
                    for (int e = 1; e < 8; ++e) if (lg[r][e] > v0) { v0 = lg[r][e]; e0 = e; }
                    int e1 = -1; float v1 = -INFINITY;
#pragma unroll
                    for (int e = 0; e < 8; ++e) if (e != e0 && lg[r][e] > v1) { v1 = lg[r][e]; e1 = e; }
                    const float q0 = 1.0f / (1.0f + __expf(v1 - v0)), q1 = 1.0f - q0;
                    if (ln == 0) { ((int*)(ws + WS_ROUTE + RT_E))[row] = e0 | (e1 << 8); ((float*)(ws + WS_ROUTE + RT_G))[2 * row] = q0; ((float*)(ws + WS_ROUTE + RT_G))[2 * row + 1] = q1; }
                    cnt0 += (e0 == 0) + (e1 == 0); cnt1 += (e0 == 1) + (e1 == 1); cnt2 += (e0 == 2) + (e1 == 2); cnt3 += (e0 == 3) + (e1 == 3);
                    cnt4 += (e0 == 4) + (e1 == 4); cnt5 += (e0 == 5) + (e1 == 5); cnt6 += (e0 == 6) + (e1 == 6); cnt7 += (e0 == 7) + (e1 == 7); } }
        }
    }
#undef PN_LOAD
    if (ROUTER) {
        int* wcnt = (int*)(ws + WS_ROUTE + RT_WCNT);
        if (ln == 0) { int* w = wcnt + (size_t)gw * 8; w[0] = cnt0; w[1] = cnt1; w[2] = cnt2; w[3] = cnt3; w[4] = cnt4; w[5] = cnt5; w[6] = cnt6; w[7] = cnt7; }
    }
}
__device__ __forceinline__ void p_final_combine(Frame& F, int lprev) {
    unsigned char* const ws = launder(F.ws);
    const int tid = (F.wave * 64 + hw_lane()), lane = tid & 63; (void)lane;
    const int gw = F.vcu * NWAVES + F.wave, NGW = F.G * NWAVES;
    const float* route_g = (const float*)(ws + WS_ROUTE + RT_G); const int* route_s = (const int*)(ws + WS_ROUTE + RT_S);
    const bf16* Y = (const bf16*)(ws + WS_AG);
    float g0n = 0.f, g1n = 0.f; int s0n = 0, s1n = 0;
    if (gw < TL) { g0n = route_g[2 * gw]; g1n = route_g[2 * gw + 1]; s0n = route_s[2 * gw]; s1n = route_s[2 * gw + 1]; }
    for (int row = gw; row < TL; row += NGW) {
        const int bsel = row >> 12;
        const float* m5 = (const float*)(ws + WS_MOD) + ((size_t)lprev * 9 + bsel) * 6144 + 5 * 1024;
        const float g0 = g0n, g1 = g1n; const int s0 = s0n, s1 = s1n;
        float* xw = F.out + (size_t)row * 1024; const bf16* xbr = (const bf16*)(ws + WS_XB) + (size_t)row * 1024;
        uint2 xw2[4], y0[4], y1[4];
#pragma unroll
        for (int jj = 0; jj < 4; ++jj) { const int col = 4 * lane + 256 * jj; xw2[jj] = *(const uint2*)(xbr + col); y0[jj] = *(const uint2*)(Y + (size_t)s0 * 1024 + col); y1[jj] = *(const uint2*)(Y + (size_t)s1 * 1024 + col); }
        if (row + NGW < TL) { const int rn = row + NGW; g0n = route_g[2 * rn]; g1n = route_g[2 * rn + 1]; s0n = route_s[2 * rn]; s1n = route_s[2 * rn + 1]; }
#pragma unroll
        for (int jj = 0; jj < 4; ++jj) { const int col = 4 * lane + 256 * jj; const f32x4 mm = *(const f32x4*)(m5 + col);
            f32x4 v = (f32x4){bflo(xw2[jj].x), bfhi(xw2[jj].x), bflo(xw2[jj].y), bfhi(xw2[jj].y)};
            v[0] += mm[0] * (g0 * bflo(y0[jj].x) + g1 * bflo(y1[jj].x)); v[1] += mm[1] * (g0 * bfhi(y0[jj].x) + g1 * bfhi(y1[jj].x));
            v[2] += mm[2] * (g0 * bflo(y0[jj].y) + g1 * bflo(y1[jj].y)); v[3] += mm[3] * (g0 * bfhi(y0[jj].y) + g1 * bfhi(y1[jj].y));
            *(f32x4*)(xw + col) = v; }
    }
}

__device__ __forceinline__ void p_prep(Frame& F, const Args& A, int l) {
    unsigned char* const ws = launder(F.ws);
    const int tid = (F.wave * 64 + hw_lane()), lane = tid & 63; (void)lane;
    const int gw = F.vcu * NWAVES + F.wave, NGW = F.G * NWAVES;
    const unsigned* P = (const unsigned*)(ws + WS_P);
    const float* cs = (const float*)(ws + WS_ROPE);
    bf16* QO = (bf16*)(ws + WS_QO); bf16* KB = (bf16*)(ws + WS_KB); bf16* VB = (bf16*)(ws + WS_VB);
    unsigned* Rst = (unsigned*)(ws + WS_R); unsigned* Kst = (unsigned*)(ws + WS_K); unsigned* Vst = (unsigned*)(ws + WS_V); unsigned* KKst = (unsigned*)(ws + WS_KK); unsigned* LIN = (unsigned*)(ws + WS_LIN);
    const int d0 = 2 * (lane & 31);
    const float qg0 = INP(IN_QG)[l * 64 + d0], qg1 = INP(IN_QG)[l * 64 + d0 + 1], kg0 = INP(IN_KG)[l * 64 + d0], kg1 = INP(IN_KG)[l * 64 + d0 + 1];
    float mu0[15], mu1[15];
#pragma unroll
    for (int i = 0; i < 15; ++i) { mu0[i] = INP(IN_MU)[l * SHIFTW + 128 * i + 2 * lane]; mu1[i] = INP(IN_MU)[l * SHIFTW + 128 * i + 2 * lane + 1]; }
    float kw0[4], kw1[4];
#pragma unroll
    for (int i = 0; i < 4; ++i) { kw0[i] = INP(IN_KKW)[l * 512 + 128 * i + 2 * lane]; kw1[i] = INP(IN_KKW)[l * 512 + 128 * i + 2 * lane + 1]; }
    const float C2 = 0.125f * 1.4426950408889634f;
    const float sgn = (lane & 16) ? 1.0f : -1.0f;
    for (int w0 = gw; w0 * 17 < TT; w0 += NGW) {
        const int rbeg = w0 * 17;
        unsigned cur[21], nxt[21], prv[15];
#pragma unroll
        for (int i = 0; i < 15; ++i) prv[i] = 0u;
        {   const int r = rbeg; const bool lat = r < TL; const int pos = lat ? (r & 4095) : ((r - TL) & 255);
            if (pos != 0) {
#pragma unroll
                for (int i = 0; i < 15; ++i) prv[i] = P[(size_t)(r - 1) * (INWP / 2) + 64 * (i + 6) + lane]; }
#pragma unroll
            for (int i = 0; i < 21; ++i) cur[i] = P[(size_t)r * (INWP / 2) + 64 * i + lane];
        }
        for (int k = 0; k < 17; ++k) {
            const int r = rbeg + k; const bool lat = r < TL; const int pos = lat ? (r & 4095) : ((r - TL) & 255); const int slen = lat ? 4096 : 256;
            const bool has_next = (pos != slen - 1);
            const bool load_next = (k < 16) || has_next;
            if (load_next && r + 1 < TT) {
#pragma unroll
                for (int i = 0; i < 21; ++i) nxt[i] = P[(size_t)(r + 1) * (INWP / 2) + 64 * i + lane];
            } else {
#pragma unroll
                for (int i = 0; i < 21; ++i) nxt[i] = 0u;
            }
            const int b = lat ? (r >> 12) : ((r - TL) >> 8);
            const size_t kvrow = (size_t)b * KVLEN + (lat ? pos : 4096 + pos);
            f32x4 csv = (f32x4){1.f, 0.f, 1.f, 0.f};
            if (lat) csv = *(const f32x4*)(cs + ((size_t)pos * 32 + 2 * (lane & 15)) * 2);
#pragma unroll
            for (int i = 0; i < 5; ++i) {
                float x0 = bflo(cur[i]), x1 = bfhi(cur[i]);
                const float ss = half_sum(x0 * x0 + x1 * x1);
                const float rstd = 1.0f / sqrtf(ss * (1.0f / 64.0f) + RMS_EPS);
                x0 = x0 * rstd * (i < 4 ? qg0 : kg0); x1 = x1 * rstd * (i < 4 ? qg1 : kg1);
                const float p0 = __shfl_xor(x0, 16), p1 = __shfl_xor(x1, 16);
                const float y0 = x0 * csv[0] + sgn * p0 * csv[1], y1 = x1 * csv[2] + sgn * p1 * csv[3];
                if (i < 4) *(unsigned*)(QO + (size_t)r * 1024 + 128 * i + 2 * lane) = pkbf(y0 * C2, y1 * C2);
                else *(unsigned*)(KB + kvrow * 128 + 2 * lane) = pkbf(y0, y1);
            }
            *(unsigned*)(VB + kvrow * 128 + 2 * lane) = cur[5];
            const float hn = has_next ? 1.0f : 0.0f;
#pragma unroll
            for (int i = 0; i < 15; ++i) {
                const float c0 = bflo(cur[i + 6]), c1 = bfhi(cur[i + 6]);
                const float a0 = bflo(prv[i]) + hn * bflo(nxt[i + 6]), a1 = bfhi(prv[i]) + hn * bfhi(nxt[i + 6]);
                const float s0 = c0 + mu0[i] * (0.5f * a0 - c0), s1 = c1 + mu1[i] * (0.5f * a1 - c1);
                if (i < 4) Rst[(size_t)r * 256 + 64 * i + lane] = pkbf(s0, s1);
                else if (i < 8) { Kst[(size_t)r * 256 + 64 * (i - 4) + lane] = pkbf(s0, s1);
                    const float t0 = s0 * kw0[i - 4], t1 = s1 * kw1[i - 4]; const float q = half_sum(t0 * t0 + t1 * t1); const float rn = 1.0f / sqrtf(q + 1e-12f);
                    KKst[(size_t)r * 256 + 64 * (i - 4) + lane] = pkbf(t0 * rn, t1 * rn); }
                else if (i < 12) Vst[(size_t)r * 256 + 64 * (i - 8) + lane] = pkbf(s0, s1);
                else if (i == 12) { const float e0 = __builtin_amdgcn_exp2f(2.0f * 1.4426950408889634f * s0), e1 = __builtin_amdgcn_exp2f(2.0f * 1.4426950408889634f * s1);
                    LIN[(size_t)r * (LORA_K / 2) + lane] = pkbf(1.0f - 2.0f * __builtin_amdgcn_rcpf(1.0f + e0), 1.0f - 2.0f * __builtin_amdgcn_rcpf(1.0f + e1)); }
                else if (i == 13) LIN[(size_t)r * (LORA_K / 2) + 64 + lane] = pkbf(s0, s1);
                else LIN[(size_t)r * (LORA_K / 2) + 128 + lane] = pkbf(sigm(s0), sigm(s1));
            }
#pragma unroll
            for (int i = 0; i < 15; ++i) prv[i] = has_next ? cur[i + 6] : 0u;
#pragma unroll
            for (int i = 0; i < 21; ++i) cur[i] = nxt[i];
        }
    }
}

template <int CTRL> __device__ __forceinline__ float dppf(float v) { return __builtin_bit_cast(float, __builtin_amdgcn_update_dpp(0, __builtin_bit_cast(int, v), CTRL, 0xf, 0xf, true)); }
__device__ __forceinline__ float red16(float v) { v += dppf<0xB1>(v); v += dppf<0x4E>(v); v += dppf<0x141>(v); v += dppf<0x128>(v); return v; }
constexpr int SC_TS = 32, SC_W = 352;
__device__ __forceinline__ void p_scan(Frame& F, const Args& A, int l) {
    unsigned char* const ws = launder(F.ws);
    const int tid = (F.wave * 64 + hw_lane()), lane = tid & 63; (void)lane;
    LAS float* buf = (LAS float*)(F.lds + RING_OFF);
    float* OSC = (float*)(ws + WS_OSC);
    constexpr int NCH = KVLEN / SC_TS;
    for (int item = blockIdx.x; item < 256; item += F.G) {
        const int chain = item >> 1, rh = item & 1, dir = chain & 1, bh = chain >> 1, b = bh >> 3, h = bh & 7;
        const int row = tid >> 4, c = tid & 15;
        float S0 = 0.f, S1 = 0.f, S2 = 0.f, S3 = 0.f;
        const bool stg = tid < 352; const int sub = (tid >= 176) ? 1 : 0, pp = tid - 176 * sub, a = pp >> 5, w = pp & 31;
        const unsigned* p1; int pitch1 = 256;
        if (a == 0 || a == 2) p1 = (const unsigned*)(ws + WS_KK) + h * 32 + w;
        else if (a == 1) { p1 = (const unsigned*)(ws + WS_LOUT) + dir * 256 + h * 32 + w; pitch1 = LORA_N / 2; }
        else if (a == 3) p1 = (const unsigned*)(ws + WS_K) + h * 32 + w;
        else if (a == 4) p1 = (const unsigned*)(ws + WS_R) + h * 32 + w;
        else p1 = (const unsigned*)(ws + WS_V) + h * 32 + rh * 16 + (pp - 160);
        const unsigned* p2 = (const unsigned*)(ws + WS_LOUT) + 512 + dir * 256 + h * 32 + w;
        const bool two = (a == 2 || a == 3);
        const int cw = (a == 5) ? 0 : 2 * w;
        const float cw0 = INP(IN_W0)[l * 1024 + dir * 512 + h * 64 + cw], cw1 = INP(IN_W0)[l * 1024 + dir * 512 + h * 64 + cw + 1];
        const float ca0 = INP(IN_A0)[l * 1024 + dir * 512 + h * 64 + cw], ca1 = INP(IN_A0)[l * 1024 + dir * 512 + h * 64 + cw + 1];
        const float ck0 = INP(IN_KA)[l * 512 + h * 64 + cw], ck1 = INP(IN_KA)[l * 512 + h * 64 + cw + 1];
        unsigned st[16], st2[16];
#define SC_TOK(s) ((s) < CTXL ? (TL + b * CTXL + (dir ? (CTXL - 1 - (s)) : (s))) : (b * SEQL + (dir ? (SEQL - 1 - ((s) - CTXL)) : ((s) - CTXL))))
#define SC_LOAD(ci) do { if (stg) { _Pragma("unroll") for (int i = 0; i < 16; ++i) { const int s = (ci) * SC_TS + 2 * i + sub; const size_t tok = (size_t)SC_TOK(s); \
            st[i] = p1[tok * pitch1]; st2[i] = two ? p2[tok * (LORA_N / 2)] : 0u; } } } while (0)
#define SC_STORE(bi) do { if (stg) { _Pragma("unroll") for (int i = 0; i < 16; ++i) { \
            float x0 = bflo(st[i]), x1 = bfhi(st[i]); \
            if (a == 1) { x0 = __builtin_amdgcn_exp2f(-1.4426950408889634f * 0.6065306597126334f * sigm(x0 + cw0)); x1 = __builtin_amdgcn_exp2f(-1.4426950408889634f * 0.6065306597126334f * sigm(x1 + cw1)); } \
            else if (a == 2) { x0 *= sigm(bflo(st2[i]) + ca0); x1 *= sigm(bfhi(st2[i]) + ca1); } \
            else if (a == 3) { x0 *= 1.0f + (sigm(bflo(st2[i]) + ca0) - 1.0f) * ck0; x1 *= 1.0f + (sigm(bfhi(st2[i]) + ca1) - 1.0f) * ck1; } \
            LAS float* dp = buf + ((bi) * SC_TS + 2 * i + sub) * SC_W + 2 * pp; dp[0] = x0; dp[1] = x1; } } } while (0)
        __syncthreads();
        SC_LOAD(0); SC_STORE(0); __syncthreads();
        for (int ci = 0; ci < NCH; ++ci) {
            if (ci + 1 < NCH) SC_LOAD(ci + 1);
            const LAS float* bp = buf + (ci & 1) * SC_TS * SC_W;
#pragma unroll 2
            for (int stp = 0; stp < SC_TS; ++stp) {
                const LAS float* sp = bp + stp * SC_W;
                const f32x4 kk = *(const LAS f32x4*)(sp + 4 * c), w4 = *(const LAS f32x4*)(sp + 64 + 4 * c), bb = *(const LAS f32x4*)(sp + 128 + 4 * c), kd = *(const LAS f32x4*)(sp + 192 + 4 * c), rr = *(const LAS f32x4*)(sp + 256 + 4 * c);
                const float vv = sp[320 + row];
                float sa = (S0 * kk[0] + S1 * kk[1]) + (S2 * kk[2] + S3 * kk[3]); sa = red16(sa);
                S0 = S0 * w4[0] + (vv * kd[0] - sa * bb[0]); S1 = S1 * w4[1] + (vv * kd[1] - sa * bb[1]); S2 = S2 * w4[2] + (vv * kd[2] - sa * bb[2]); S3 = S3 * w4[3] + (vv * kd[3] - sa * bb[3]);
                float o = (S0 * rr[0] + S1 * rr[1]) + (S2 * rr[2] + S3 * rr[3]); o = red16(o);
                if (c == 0) { const int s = ci * SC_TS + stp; OSC[((size_t)dir * TT + (size_t)SC_TOK(s)) * 512 + h * 64 + rh * 32 + row] = o; }
            }
            if (ci + 1 < NCH) SC_STORE((ci + 1) & 1);
            __syncthreads();
        }
#undef SC_TOK
#undef SC_LOAD
#undef SC_STORE
    }
}

__device__ __forceinline__ void p_readout(Frame& F, const Args& A, int l) {
    unsigned char* const ws = launder(F.ws);
    const int tid = (F.wave * 64 + hw_lane()), lane = tid & 63; (void)lane;
    const int gw = F.vcu * NWAVES + F.wave, NGW = F.G * NWAVES;
    const float* OSC = (const float*)(ws + WS_OSC);
    const unsigned* Rst = (const unsigned*)(ws + WS_R); const unsigned* Vst = (const unsigned*)(ws + WS_V); const unsigned* Kst = (const unsigned*)(ws + WS_K); const unsigned* LOUT = (const unsigned*)(ws + WS_LOUT);
    bf16* QO = (bf16*)(ws + WS_QO);
    float rk0[4], rk1[4], gw0[4], gw1[4], gb0[4], gb1[4], ka0[4], ka1[4], aa0[4], aa1[4], ab0[4], ab1[4];
#pragma unroll
    for (int i = 0; i < 4; ++i) { const int cc = 128 * i + 2 * lane, cidx = l * 512 + cc; rk0[i] = INP(IN_RK)[cidx]; rk1[i] = INP(IN_RK)[cidx + 1]; gw0[i] = INP(IN_GNW)[cidx]; gw1[i] = INP(IN_GNW)[cidx + 1]; gb0[i] = INP(IN_GNB)[cidx]; gb1[i] = INP(IN_GNB)[cidx + 1];
        ka0[i] = INP(IN_KA)[cidx]; ka1[i] = INP(IN_KA)[cidx + 1]; aa0[i] = INP(IN_A0)[l * 1024 + cc]; aa1[i] = INP(IN_A0)[l * 1024 + cc + 1]; ab0[i] = INP(IN_A0)[l * 1024 + 512 + cc]; ab1[i] = INP(IN_A0)[l * 1024 + 512 + cc + 1]; }
    for (int row = gw; row < TT; row += NGW) {
#pragma unroll
        for (int i = 0; i < 4; ++i) {
            const size_t off = (size_t)row * 256 + 64 * i + lane; const size_t lo = (size_t)row * (LORA_N / 2) + 64 * i + lane;
            const float2 oa = *(const float2*)(OSC + (size_t)row * 512 + 128 * i + 2 * lane), ob = *(const float2*)(OSC + ((size_t)TT + row) * 512 + 128 * i + 2 * lane);
            const float o0 = oa.x + ob.x, o1 = oa.y + ob.y;
            const float mean = half_sum(o0 + o1) * (1.0f / 64.0f);
            const float d0 = o0 - mean, d1 = o1 - mean;
            const float var = half_sum(d0 * d0 + d1 * d1) * (1.0f / 64.0f);
            const float rs = 1.0f / sqrtf(var + GN_EPS);
            const unsigned rw = Rst[off], vw = Vst[off], kw = Kst[off], pa = LOUT[lo + 512], pb = LOUT[lo + 768], gwd = LOUT[lo + 1024];
            const float ks0 = bflo(kw) * (2.0f + (sigm(bflo(pa) + aa0[i]) + sigm(bflo(pb) + ab0[i]) - 2.0f) * ka0[i]), ks1 = bfhi(kw) * (2.0f + (sigm(bfhi(pa) + aa1[i]) + sigm(bfhi(pb) + ab1[i]) - 2.0f) * ka1[i]);
            const float bsum = half_sum(bflo(rw) * ks0 * rk0[i] + bfhi(rw) * ks1 * rk1[i]);
            const float y0 = d0 * rs * gw0[i] + gb0[i] + bsum * bflo(vw), y1 = d1 * rs * gw1[i] + gb1[i] + bsum * bfhi(vw);
            *(unsigned*)(QO + (size_t)row * 1024 + 512 + 128 * i + 2 * lane) = pkbf(y0 * bflo(gwd), y1 * bfhi(gwd));
        }
    }
}

__device__ __forceinline__ void p_route(Frame& F, int nrows) {
    unsigned char* const ws = launder(F.ws);
    const int tid = (F.wave * 64 + hw_lane()), lane = tid & 63; (void)lane;
    const int gw = F.vcu * NWAVES + F.wave, NGW = F.G * NWAVES;
    const int* wcnt = (const int*)(ws + WS_ROUTE + RT_WCNT);
    LAS int* pexp = (LAS int*)(F.lds + LT_PEXP); LAS int* npan = (LAS int*)(F.lds + LT_NPAN); LAS int* tmp = (LAS int*)(F.lds + LT_TMP);
    {   const int e = lane & 7, part = lane >> 3;
        const int p = F.wave * 8 + part;
        const int wb = p * (NGW / 64), we = wb + NGW / 64; const int myw0 = F.vcu * NWAVES;
        int tot = 0, before = 0;
#pragma unroll 16
        for (int w = wb; w < we; ++w) { const int cv = wcnt[(size_t)w * 8 + e]; tot += cv; if (w < myw0) before += cv; }
        tmp[p * 16 + e] = tot; tmp[p * 16 + 8 + e] = before;
    }
    __syncthreads();
    if (tid < 8) { int tot = 0, before = 0; for (int p = 0; p < 64; ++p) { tot += tmp[p * 16 + tid]; before += tmp[p * 16 + 8 + tid]; } tmp[1024 + tid] = tot; tmp[1032 + tid] = before; }
    __syncthreads();
    if (tid == 0) { int acc = 0; for (int e = 0; e < 8; ++e) { const int padded = (tmp[1024 + e] + 255) & ~255; tmp[1040 + e] = acc; acc += padded; tmp[1048 + e] = acc; } npan[0] = acc >> 8; }
    __syncthreads();
    for (int p = tid; p < 320; p += NWAVES * 64) { int e = 7; for (int q = 7; q >= 0; --q) if (p * 256 < tmp[1048 + q]) e = q; pexp[p] = e; }
    int base0, base1, base2, base3, base4, base5, base6, base7;
    {   int bsv[8];
#pragma unroll
        for (int e = 0; e < 8; ++e) bsv[e] = tmp[1040 + e] + tmp[1032 + e];
        typedef int i32x4 __attribute__((ext_vector_type(4)));
#pragma unroll
        for (int w = 0; w < 7; ++w) { const i32x4* wp = (const i32x4*)(wcnt + (size_t)(F.vcu * NWAVES + w) * 8); const i32x4 c0 = wp[0], c1 = wp[1]; const int mk = (w < F.wave) ? 1 : 0;
            bsv[0] += mk * c0[0]; bsv[1] += mk * c0[1]; bsv[2] += mk * c0[2]; bsv[3] += mk * c0[3]; bsv[4] += mk * c1[0]; bsv[5] += mk * c1[1]; bsv[6] += mk * c1[2]; bsv[7] += mk * c1[3]; }
        base0 = bsv[0]; base1 = bsv[1]; base2 = bsv[2]; base3 = bsv[3]; base4 = bsv[4]; base5 = bsv[5]; base6 = bsv[6]; base7 = bsv[7];
    }
    const int* route_e = (const int*)(ws + WS_ROUTE + RT_E); int* route_s = (int*)(ws + WS_ROUTE + RT_S);
    const unsigned char* H = (const unsigned char*)F.out; unsigned char* AG = ws + WS_AG8;
    int ee_n = 0; v4u a_n = (v4u){0u, 0u, 0u, 0u};
    if (gw < nrows) { ee_n = route_e[gw]; a_n = ((const v4u*)(H + (size_t)gw * 1024))[lane]; }
    for (int row = gw; row < nrows; row += NGW) {
        const int ee = ee_n; const v4u a = a_n; const int e0 = ee & 255, e1 = ee >> 8;
        if (row + NGW < nrows) { ee_n = route_e[row + NGW]; a_n = ((const v4u*)(H + (size_t)(row + NGW) * 1024))[lane]; }
        int s0 = 0, s1 = 0;
#define RT_TAKE(E, B) do { if (e0 == E) { s0 = B; B += 1; } if (e1 == E) { s1 = B; B += 1; } } while (0)
        RT_TAKE(0, base0); RT_TAKE(1, base1); RT_TAKE(2, base2); RT_TAKE(3, base3); RT_TAKE(4, base4); RT_TAKE(5, base5); RT_TAKE(6, base6); RT_TAKE(7, base7);
#undef RT_TAKE
        if (lane == 0) { route_s[2 * row] = s0; route_s[2 * row + 1] = s1; }
        ((v4u*)(AG + (size_t)s0 * 1024))[lane] = a; ((v4u*)(AG + (size_t)s1 * 1024))[lane] = a;
    }
    __syncthreads();
}

__device__ __forceinline__ void p_attn(Frame& F, char* ldsg, bool ctx_on) {
    unsigned char* const ws = launder(F.ws);
    const int tid = (F.wave * 64 + hw_lane()), lane = tid & 63; (void)lane;
    typedef attn_body::bf16 abf;
    const abf* Q = (const abf*)(ws + WS_QO); const abf* K = (const abf*)(ws + WS_KB); const abf* V = (const abf*)(ws + WS_VB); abf* O = (abf*)(ws + WS_QO);
    const int per = (1024 + F.G - 1) / F.G;
    for (int i = 0; i < per; ++i) { const int un = F.vcu * per + i; if (un >= 1024) break;
        const int bh = un >> 4, qb = un & 15, b = bh >> 3, h = bh & 7;
        attn_body::attn_unit<8>((long)b * SEQL + qb * 256, h * 64, (long)b * KVLEN, (h >> 2) * 64, KVLEN / 64, Q, K, V, O, ldsg, F.wave); }
    if (ctx_on) for (int un = F.vcu; un < 64; un += F.G) { const int b = un >> 3, h = un & 7;
        attn_body::attn_unit<8>((long)TL + b * CTXL, h * 64, (long)b * KVLEN + SEQL, (h >> 2) * 64, CTXL / 64, Q, K, V, O, ldsg, F.wave); }
}

typedef float f32x16 __attribute__((ext_vector_type(16)));
typedef unsigned u32x2 __attribute__((ext_vector_type(2)));
constexpr int SCH = 64, NCHK = KVLEN / SCH, NITEM = 128 * NCHK;
constexpr int LSTR = 144;
constexpr int L_AKK = 0, L_AR = 9216, L_AK = 18432, L_AB = 27648, L_TK = 36864, L_TB = 46080, L_TV = 55296, L_TW1 = 64512, L_TU = 73728, L_MLK = 82944, L_MMB = 92160, L_MMK = 101376;
constexpr int L_FLB = 110592, L_GC = 126976, L_TII = 127232, L_FX = L_AK;
static_assert(L_TII + 2048 <= RING_BYTES, "scan LDS map");
__device__ __forceinline__ unsigned short bf1(float x) { return (unsigned short)(pkbf(x, 0.f) & 0xffffu); }
__device__ __forceinline__ bf16x8 ldsv8(const LAS unsigned char* p) { return *(const LAS bf16x8*)p; }
template <bool SWA = false, bool SWB = false>
__device__ __forceinline__ f32x16 tile32(const LAS unsigned char* Ab, const LAS unsigned char* Bb, int mi, int ni, int r, int h, f32x16 acc) {
    const int ra = 32 * mi + r, rb = 32 * ni + r; const int xa = SWA ? ((ra >> 3) & 7) : 0, xb = SWB ? ((rb >> 3) & 7) : 0;
#pragma unroll
    for (int kb = 0; kb < 4; ++kb) { const bf16x8 a = ldsv8(Ab + ra * LSTR + (((2 * kb + h) ^ xa) << 4)), b = ldsv8(Bb + rb * LSTR + (((2 * kb + h) ^ xb) << 4));
        acc = __builtin_amdgcn_mfma_f32_32x32x16_bf16(a, b, acc, 0, 0, 0); }
    return acc;
}
__device__ __forceinline__ int jperm(int j) { return (((j >> 2) & 3) << 4) | (((j >> 5) & 1) << 3) | (((j >> 4) & 1) << 2) | (j & 3); }
#define CROW(reg, h) (((reg) & 3) + 8 * ((reg) >> 2) + 4 * (h))


#if DEBUG_NAN
#define DBG_BF(k, off, nbytes) do { unsigned bad_ = 0; for (int i_ = tid; i_ < (nbytes) / 2; i_ += 512) { const int row_ = i_ / 72, col_ = i_ % 72; if (col_ < 64) { const float v_ = __builtin_bit_cast(float, (unsigned)(*(const LAS unsigned short*)(L + (off) + row_ * LSTR + col_ * 2)) << 16); if (!(fabsf(v_) < 1e30f)) ++bad_; } } if (bad_) atomicAdd((unsigned*)(F.ctl + 16 + (k)), bad_); } while (0)
#define DBG_F32(k, off, n) do { unsigned bad_ = 0; for (int i_ = tid; i_ < (n); i_ += 512) { const float v_ = ((const LAS float*)(L + (off)))[i_]; if (!(fabsf(v_) < 1e30f)) ++bad_; } if (bad_) atomicAdd((unsigned*)(F.ctl + 16 + (k)), bad_); } while (0)
#else
#define DBG_BF(k, off, nbytes) do {} while (0)
#define DBG_F32(k, off, n) do {} while (0)
#endif
#define WG_BAR() do { asm volatile("s_waitcnt lgkmcnt(0)" ::: "memory"); __builtin_amdgcn_s_barrier(); asm volatile("" ::: "memory"); } while (0)
template <int CTRL, int RMASK> __device__ __forceinline__ float dppm(float v) { return __builtin_bit_cast(float, __builtin_amdgcn_update_dpp(0, __builtin_bit_cast(int, v), CTRL, RMASK, 0xf, true)); }
__device__ __forceinline__ float wave_incl_scan(float x) {
    x += dppm<0x111, 0xf>(x); x += dppm<0x112, 0xf>(x); x += dppm<0x114, 0xf>(x); x += dppm<0x118, 0xf>(x);
    x += __builtin_bit_cast(float, __builtin_amdgcn_update_dpp(0, __builtin_bit_cast(int, x), 0x142, 0xa, 0xf, false));
    x += __builtin_bit_cast(float, __builtin_amdgcn_update_dpp(0, __builtin_bit_cast(int, x), 0x143, 0xc, 0xf, false));
    return x;
}
struct S1In { v4u kk, r, k, v, pw, pa; f32x4 ka[2]; };
__device__ __forceinline__ void s1_item(Frame& F, unsigned char* const ws, const int lane, const int wv, const int l, const int item, const S1In& cur, S1In& nxt, const float* w0b, const float* a0b, const float* kab, unsigned long long (&cy)[6]) {
#if CYSEL >= 0
#define CY(k) do { const unsigned long long now_ = __builtin_readcyclecounter(); cy[k] += now_ - cy[5]; cy[5] = now_; } while (0)
#else
#define CY(k) do {} while (0)
#endif
    LAS unsigned char* L = F.lds + RING_OFF;
    const bf16* KKst = (const bf16*)(ws + WS_KK); const bf16* Kst = (const bf16*)(ws + WS_K); const bf16* Rst = (const bf16*)(ws + WS_R); const bf16* Vst = (const bf16*)(ws + WS_V); const bf16* LOUT = (const bf16*)(ws + WS_LOUT);
    bf16* PT = (bf16*)(ws + WS_SPT); bf16* GG = (bf16*)(ws + WS_SG); bf16* QQ = (bf16*)(ws + WS_SQ); float* OSC = (float*)(ws + WS_OSC);
    const int r = lane & 31, h = lane >> 5;
#define S1_ITEM(item_) const int chain = (item_) / NCHK, c = (item_) - chain * NCHK, dir = chain & 1, bh = chain >> 1, b = bh >> 3, hd = bh & 7; const int s0 = c * SCH; const int dsg = dir ? -1 : 1; \
        const int tok0 = (s0 < CTXL) ? (TL + b * CTXL + (dir ? (CTXL - 1 - s0) : s0)) : (b * SEQL + (dir ? (SEQL - 1 - (s0 - CTXL)) : (s0 - CTXL)));
#define S1_TOUCH(D) asm volatile("" :: "v"(D.kk), "v"(D.r), "v"(D.k), "v"(D.v), "v"(D.pw), "v"(D.pa), "v"(D.ka[0]), "v"(D.ka[1]))
#define S1_LOAD(D, item_) do { S1_ITEM(item_) const size_t tokr = (size_t)(tok0 + dsg * (8 * wv + (lane >> 3))); const size_t o5 = tokr * 512 + hd * 64 + 8 * (lane & 7); \
        D.kk = *(const v4u*)(KKst + o5); D.r = *(const v4u*)(Rst + o5); D.k = *(const v4u*)(Kst + o5); D.v = *(const v4u*)(Vst + o5); \
        D.pw = *(const v4u*)(LOUT + tokr * LORA_N + dir * 512 + hd * 64 + 8 * (lane & 7)); D.pa = *(const v4u*)(LOUT + tokr * LORA_N + 1024 + dir * 512 + hd * 64 + 8 * (lane & 7)); \
        { D.ka[0] = *(const f32x4*)(kab + hd * 64 + 8 * (lane & 7)); D.ka[1] = *(const f32x4*)(kab + hd * 64 + 8 * (lane & 7) + 4); } } while (0)
    {
        S1_ITEM(item)
        {   const v4u kk8 = cur.kk, r8 = cur.r, k8 = cur.k, v8 = cur.v, pw8 = cur.pw, pa8 = cur.pa; const int jg = lane & 7, t = 8 * wv + (lane >> 3);
            const float kap[8] = {cur.ka[0][0], cur.ka[0][1], cur.ka[0][2], cur.ka[0][3], cur.ka[1][0], cur.ka[1][1], cur.ka[1][2], cur.ka[1][3]};
            LAS float* tot = (LAS float*)(L + L_TII);
            float lw[8], av[8], lam[8];
#pragma unroll
            for (int e = 0; e < 8; ++e) { const unsigned pw = pw8[e >> 1], pa = pa8[e >> 1]; const float zw = (e & 1) ? bfhi(pw) : bflo(pw), za = (e & 1) ? bfhi(pa) : bflo(pa);
                lw[e] = zw; av[e] = za; lam[e] = lw[e]; }
#pragma unroll
            for (int sh = 8; sh <= 32; sh <<= 1) { float y[8]; const float mk = (lane >= sh) ? 1.0f : 0.0f;
#pragma unroll
                for (int e = 0; e < 8; ++e) y[e] = __shfl_up(lam[e], sh);
#pragma unroll
                for (int e = 0; e < 8; ++e) lam[e] = __builtin_fmaf(mk, y[e], lam[e]); }
            if (lane >= 56) { *(LAS f32x4*)(tot + wv * 64 + 8 * jg) = (f32x4){lam[0], lam[1], lam[2], lam[3]}; *(LAS f32x4*)(tot + wv * 64 + 8 * jg + 4) = (f32x4){lam[4], lam[5], lam[6], lam[7]}; }
            if (item + F.G < NITEM) S1_LOAD(nxt, item + F.G);
            WG_BAR();
            for (int w = 0; w < wv; ++w) { const f32x4 q0 = *(const LAS f32x4*)(tot + w * 64 + 8 * jg), q1 = *(const LAS f32x4*)(tot + w * 64 + 8 * jg + 4);
                lam[0] += q0[0]; lam[1] += q0[1]; lam[2] += q0[2]; lam[3] += q0[3]; lam[4] += q1[0]; lam[5] += q1[1]; lam[6] += q1[2]; lam[7] += q1[3]; }
            v4u wkk, wrr, wkd, wbd;
#pragma unroll
            for (int p = 0; p < 4; ++p) { float okk[2], orr[2], okd[2], obd[2];
#pragma unroll
                for (int u = 0; u < 2; ++u) { const int e = 2 * p + u;
                    const unsigned xkk = kk8[p], xr = r8[p], xk = k8[p];
                    const float kkv = u ? bfhi(xkk) : bflo(xkk), rv = u ? bfhi(xr) : bflo(xr), kv = u ? bfhi(xk) : bflo(xk);
                    const float eNp = __builtin_amdgcn_exp2f(lw[e] - lam[e]), eN = __builtin_amdgcn_exp2f(-lam[e]), eP = __builtin_amdgcn_exp2f(lam[e]);
                    okk[u] = kkv * eNp; orr[u] = rv * eN; okd[u] = kv * (1.0f + (av[e] - 1.0f) * kap[e]) * eP; obd[u] = kkv * av[e] * eP;
                    if (t == SCH - 1) ((LAS float*)(L + L_GC))[8 * jg + e] = eN; }
                wkk[p] = pkbf(okk[0], okk[1]); wrr[p] = pkbf(orr[0], orr[1]); wkd[p] = pkbf(okd[0], okd[1]); wbd[p] = pkbf(obd[0], obd[1]); }
            *(LAS v4u*)(L + L_AKK + t * LSTR + jg * 16) = wkk; *(LAS v4u*)(L + L_AR + t * LSTR + jg * 16) = wrr; *(LAS v4u*)(L + L_AK + t * LSTR + jg * 16) = wkd; *(LAS v4u*)(L + L_AB + t * LSTR + jg * 16) = wbd;
#pragma unroll
            for (int e = 0; e < 8; ++e) { const int j = 8 * jg + e; const unsigned wk = wkd[e >> 1], wb = wbd[e >> 1], wvv = v8[e >> 1];
                const int to = j * LSTR + ((wv ^ jg) << 4) + (lane >> 3) * 2;
                *(LAS unsigned short*)(L + L_TK + to) = (unsigned short)((e & 1) ? (wk >> 16) : (wk & 0xffffu));
                *(LAS unsigned short*)(L + L_TB + to) = (unsigned short)((e & 1) ? (wb >> 16) : (wb & 0xffffu));
                *(LAS unsigned short*)(L + L_TV + to) = (unsigned short)((e & 1) ? (wvv >> 16) : (wvv & 0xffffu)); }
        }
        WG_BAR();
        CY(0);
#pragma unroll
        for (int jj = 0; jj < 2; ++jj) {
            const int job = 2 * wv + jj, m = job >> 2, si = (job >> 1) & 1, ti = job & 1;
            f32x16 acc = {};
            if (!(si == 1 && ti == 0)) acc = tile32(L + ((m & 1) ? L_AK : L_AB), L + (m < 2 ? L_AKK : L_AR), si, ti, r, h, acc);
            const int tt = 32 * ti + r;
#pragma unroll
            for (int g = 0; g < 4; ++g) { const int sb = 32 * si + 8 * g + 4 * h; float vv[4];
#pragma unroll
                for (int i = 0; i < 4; ++i) { const int s = sb + i; const bool keep = (m < 2) ? (s < tt) : (s <= tt); vv[i] = keep ? acc[4 * g + i] : 0.f; }
                if (m == 0) *(LAS f32x4*)((LAS float*)(L + L_FLB) + tt * 64 + sb) = (f32x4){vv[0], vv[1], vv[2], vv[3]};
                else *(LAS u32x2*)(L + (m == 1 ? L_MLK : (m == 2 ? L_MMB : L_MMK)) + tt * LSTR + sb * 2) = (u32x2){pkbf(vv[0], vv[1]), pkbf(vv[2], vv[3])}; }
        }
        WG_BAR();
        CY(1);
        f32x16 acc_o1 = {};
        {   const int q4 = wv & 3, mi = q4 >> 1, ni = q4 & 1;
            if (wv < 4) { f32x16 acc = {}; acc = tile32<false, true>(L + L_MLK, L + L_TV, mi, ni, r, h, acc);
#pragma unroll
                for (int reg = 0; reg < 16; ++reg) ((LAS float*)(L + L_FX))[(32 * mi + CROW(reg, h)) * 64 + 32 * ni + r] = acc[reg];
                const int col = lane & 15; const LAS float* lb = (const LAS float*)(L + L_FLB) + (16 * wv) * 64 + 16 * wv; float x[16];
#pragma unroll
                for (int tt = 0; tt < 16; ++tt) { float a = (tt == col) ? 1.0f : 0.0f;
#pragma unroll
                    for (int s4 = 0; s4 < tt; s4 += 4) { const f32x4 lv = *(const LAS f32x4*)(lb + tt * 64 + s4);
#pragma unroll
                        for (int u = 0; u < 4; ++u) if (s4 + u < tt) a -= lv[u] * x[s4 + u]; }
                    x[tt] = a; }
                if (lane < 16) {
#pragma unroll
                    for (int tt = 0; tt < 16; ++tt) *(LAS unsigned short*)(L + L_TII + wv * 512 + tt * 32 + col * 2) = bf1(x[tt]); }
            } else acc_o1 = tile32<true, false>(L + L_TV, L + L_MMK, mi, ni, r, h, acc_o1);
        }
        WG_BAR();
        CY(2);
        {   const int cc = lane & 15, q = lane >> 4; const bool isw = wv < 4; const int colb = 16 * (wv & 3) + cc;
            f32x4 U[4];
#pragma unroll
            for (int i = 0; i < 4; ++i) {
                f32x4 R;
#pragma unroll
                for (int reg = 0; reg < 4; ++reg) { const int tt = 16 * i + 4 * q + reg;
                    R[reg] = isw ? __builtin_bit_cast(float, (unsigned)(*(const LAS unsigned short*)(L + L_AKK + tt * LSTR + colb * 2)) << 16) : ((const LAS float*)(L + L_FX))[tt * 64 + colb]; }
#pragma unroll
                for (int kp = 0; kp < 2; ++kp) { if (2 * kp < i) {
                    const int k1 = 2 * kp, k2 = 2 * kp + 1; const bool two = (k2 < i);
                    const LAS float* lrow = (const LAS float*)(L + L_FLB) + (16 * i + cc) * 64;
                    const f32x4 la = *(const LAS f32x4*)(lrow + 16 * k1 + 4 * q); f32x4 lb2 = {0.f, 0.f, 0.f, 0.f}; if (two) lb2 = *(const LAS f32x4*)(lrow + 16 * k2 + 4 * q);
                    const v4u aw = (v4u){pkbf(-la[0], -la[1]), pkbf(-la[2], -la[3]), pkbf(-lb2[0], -lb2[1]), pkbf(-lb2[2], -lb2[3])};
                    const f32x4 u1 = U[k1]; f32x4 u2 = {0.f, 0.f, 0.f, 0.f}; if (two) u2 = U[k2];
                    const v4u bh_ = (v4u){pkbf(u1[0], u1[1]), pkbf(u1[2], u1[3]), pkbf(u2[0], u2[1]), pkbf(u2[2], u2[3])};
                    R = __builtin_amdgcn_mfma_f32_16x16x32_bf16(__builtin_bit_cast(bf16x8, aw), __builtin_bit_cast(bf16x8, bh_), R, 0, 0, 0); } }
                const u32x2 tw = *(const LAS u32x2*)(L + L_TII + i * 512 + cc * 32 + q * 8);
                const v4u ta = (v4u){tw.x, tw.y, 0u, 0u};
                const v4u rh = (v4u){pkbf(R[0], R[1]), pkbf(R[2], R[3]), 0u, 0u};
                f32x4 u = {0.f, 0.f, 0.f, 0.f};
                u = __builtin_amdgcn_mfma_f32_16x16x32_bf16(__builtin_bit_cast(bf16x8, ta), __builtin_bit_cast(bf16x8, rh), u, 0, 0, 0);
                U[i] = u;
                *(LAS u32x2*)(L + (isw ? L_TW1 : L_TU) + colb * LSTR + (16 * i + 4 * q) * 2) = (u32x2){pkbf(u[0], u[1]), pkbf(u[2], u[3])};
            }
        }
        WG_BAR();
        CY(3);
        S1_TOUCH(nxt);
        {   const int q4 = wv & 3, mi = q4 >> 1, ni = q4 & 1; const LAS float* gc = (const LAS float*)(L + L_GC);
            if (wv < 4) {
                f32x16 acc = {}; acc = tile32<false, true>(L + L_TW1, L + L_TB, mi, ni, r, h, acc);
                const int jp = 32 * ni + r; const float gj = gc[jp]; bf16* pt = PT + (size_t)item * 4096 + (size_t)jp * 64;
#pragma unroll
                for (int gp2 = 0; gp2 < 2; ++gp2) { unsigned pw[4];
#pragma unroll
                    for (int u = 0; u < 2; ++u) { const int g = gp2 + 2 * u, j0 = 32 * mi + 8 * g + 4 * h; float pv[4];
#pragma unroll
                        for (int i = 0; i < 4; ++i) pv[i] = (((j0 + i) == jp ? 1.0f : 0.0f) - acc[4 * g + i]) * gj;
                        pw[2 * u] = pkbf(pv[0], pv[1]); pw[2 * u + 1] = pkbf(pv[2], pv[3]); }
                    *(v4u*)(pt + 16 * (2 * gp2 + h) + 8 * mi) = (v4u){pw[0], pw[1], pw[2], pw[3]}; }
                f32x16 acq = {}; acq = tile32(L + L_TW1, L + L_MMB, mi, ni, r, h, acq);
                const int tt = 32 * ni + r; bf16* qq = QQ + (size_t)item * 4096 + (size_t)tt * 64;
#pragma unroll
                for (int gp2 = 0; gp2 < 2; ++gp2) { unsigned qw[4];
#pragma unroll
                    for (int u = 0; u < 2; ++u) { const int g = gp2 + 2 * u, j0 = 32 * mi + 8 * g + 4 * h; const u32x2 rw = *(const LAS u32x2*)(L + L_AR + tt * LSTR + j0 * 2);
                        qw[2 * u] = pkbf(bflo(rw.x) - acq[4 * g], bfhi(rw.x) - acq[4 * g + 1]); qw[2 * u + 1] = pkbf(bflo(rw.y) - acq[4 * g + 2], bfhi(rw.y) - acq[4 * g + 3]); }
                    *(v4u*)(qq + 16 * (2 * gp2 + h) + 8 * mi) = (v4u){qw[0], qw[1], qw[2], qw[3]}; }
            } else {
                f32x16 acc = {}; acc = tile32(L + L_TU, L + L_MMB, mi, ni, r, h, acc);
                const int tt = 32 * ni + r; bf16* op = (bf16*)OSC + ((size_t)dir * TT + (size_t)(tok0 + dsg * tt)) * 512 + hd * 64;
#pragma unroll
                for (int gp2 = 0; gp2 < 2; ++gp2) { unsigned ow_[4];
#pragma unroll
                    for (int u = 0; u < 2; ++u) { const int g = gp2 + 2 * u; ow_[2 * u] = pkbf(acc_o1[4 * g] - acc[4 * g], acc_o1[4 * g + 1] - acc[4 * g + 1]); ow_[2 * u + 1] = pkbf(acc_o1[4 * g + 2] - acc[4 * g + 2], acc_o1[4 * g + 3] - acc[4 * g + 3]); }
                    *(v4u*)(op + 16 * (2 * gp2 + h) + 8 * mi) = (v4u){ow_[0], ow_[1], ow_[2], ow_[3]}; }
                f32x16 ag = {}; ag = tile32<true, true>(L + L_TK, L + L_TV, mi, ni, r, h, ag);
                f32x16 ah = {}; ah = tile32<true, false>(L + L_TB, L + L_TU, mi, ni, r, h, ah);
                const int v = 32 * ni + r; bf16* gp = GG + (size_t)item * 4096 + (size_t)v * 64;
#pragma unroll
                for (int gp2 = 0; gp2 < 2; ++gp2) { unsigned gw_[4];
#pragma unroll
                    for (int u = 0; u < 2; ++u) { const int g = gp2 + 2 * u, j0 = 32 * mi + 8 * g + 4 * h; const f32x4 gj = *(const LAS f32x4*)(gc + j0); float gv[4];
#pragma unroll
                        for (int i = 0; i < 4; ++i) gv[i] = (ag[4 * g + i] - ah[4 * g + i]) * gj[i];
                        gw_[2 * u] = pkbf(gv[0], gv[1]); gw_[2 * u + 1] = pkbf(gv[2], gv[3]); }
                    *(v4u*)(gp + 16 * (2 * gp2 + h) + 8 * mi) = (v4u){gw_[0], gw_[1], gw_[2], gw_[3]}; }
            }
        }
        WG_BAR();
        CY(4);
    }
#undef CY
}
__device__ __forceinline__ void p_scan1(Frame& F, const Args& A, int l) {
    unsigned char* const ws = launder(F.ws);
    const int tid = (F.wave * 64 + hw_lane()), lane = tid & 63, wv = F.wave;
    const bf16* KKst = (const bf16*)(ws + WS_KK); const bf16* Kst = (const bf16*)(ws + WS_K); const bf16* Rst = (const bf16*)(ws + WS_R); const bf16* Vst = (const bf16*)(ws + WS_V); const bf16* LOUT = (const bf16*)(ws + WS_LOUT);
    const float* w0b = INP(IN_W0) + l * 1024; const float* a0b = INP(IN_A0) + l * 1024; const float* kab = INP(IN_KA) + l * 512;
    S1In sa = {}, sb = {}; unsigned long long cy[6] = {0, 0, 0, 0, 0, 0};
#if CYSEL >= 0
    cy[5] = __builtin_readcyclecounter();
#endif
    if ((int)blockIdx.x < NITEM) S1_LOAD(sa, (int)blockIdx.x);
    S1_TOUCH(sa);
    for (int item = blockIdx.x; item < NITEM; item += 2 * F.G) {
        s1_item(F, ws, lane, wv, l, item, sa, sb, w0b, a0b, kab, cy);
        if (item + F.G < NITEM) s1_item(F, ws, lane, wv, l, item + F.G, sb, sa, w0b, a0b, kab, cy);
    }
#if CYSEL >= 0
    if (blockIdx.x == 0 && F.wave == 0 && hw_lane() == 0) { unsigned long long* cs_ = (unsigned long long*)(F.ws + WS_CTL + 40960); for (int k = 0; k < 5; ++k) cs_[k] += cy[k]; }
#endif
}
#undef S1_ITEM
#undef S1_LOAD
#undef S1_TOUCH

struct S2Ops { v4u pa[4][2]; v4u gt[2]; };
__device__ __forceinline__ void s2_load(S2Ops& o, const bf16* PT, const bf16* GG, int chain, int c, int cc, int q, int v) {
    const size_t ib = ((size_t)chain * NCHK + c) * 4096;
#pragma unroll
    for (int J = 0; J < 4; ++J) { const bf16* prow = PT + ib + (size_t)(16 * J + cc) * 64;
#pragma unroll
        for (int kb = 0; kb < 2; ++kb) o.pa[J][kb] = *(const v4u*)(prow + 16 * q + 8 * kb); }
#pragma unroll
    for (int kb = 0; kb < 2; ++kb) o.gt[kb] = *(const v4u*)(GG + ib + (size_t)v * 64 + 16 * q + 8 * kb);
}
__device__ __forceinline__ void s2_step(f32x4 (&St)[4], const S2Ops& o, bf16* S0, int chain, int c, int q, int v) {
    const size_t ib = ((size_t)chain * NCHK + c) * 4096;
    v4u bh_[2], bl_[2];
#pragma unroll
    for (int kb = 0; kb < 2; ++kb) { const f32x4 u1 = St[2 * kb], u2 = St[2 * kb + 1];
        bh_[kb] = (v4u){pkbf(u1[0], u1[1]), pkbf(u1[2], u1[3]), pkbf(u2[0], u2[1]), pkbf(u2[2], u2[3])};
        bl_[kb] = (v4u){pkbf(u1[0] - bflo(bh_[kb].x), u1[1] - bfhi(bh_[kb].x)), pkbf(u1[2] - bflo(bh_[kb].y), u1[3] - bfhi(bh_[kb].y)), pkbf(u2[0] - bflo(bh_[kb].z), u2[1] - bfhi(bh_[kb].z)), pkbf(u2[2] - bflo(bh_[kb].w), u2[3] - bfhi(bh_[kb].w))};
        *(v4u*)(S0 + ib + (size_t)v * 64 + 16 * q + 8 * kb) = bh_[kb]; }
#pragma unroll
    for (int J = 0; J < 4; ++J) { const unsigned g0 = (J & 1) ? o.gt[J >> 1].z : o.gt[J >> 1].x, g1 = (J & 1) ? o.gt[J >> 1].w : o.gt[J >> 1].y; f32x4 acc = (f32x4){bflo(g0), bfhi(g0), bflo(g1), bfhi(g1)};
#pragma unroll
        for (int kb = 0; kb < 2; ++kb) { const v4u aw = o.pa[J][kb];
            acc = __builtin_amdgcn_mfma_f32_16x16x32_bf16(__builtin_bit_cast(bf16x8, aw), __builtin_bit_cast(bf16x8, bh_[kb]), acc, 0, 0, 0);
            acc = __builtin_amdgcn_mfma_f32_16x16x32_bf16(__builtin_bit_cast(bf16x8, aw), __builtin_bit_cast(bf16x8, bl_[kb]), acc, 0, 0, 0); }
        St[J] = acc; }
}
__device__ __forceinline__ void p_scan2(Frame& F) {
    unsigned char* const ws = launder(F.ws);
    const int tid = (F.wave * 64 + hw_lane()), lane = tid & 63;
    const bf16* PT = (const bf16*)(ws + WS_SPT); const bf16* GG = (const bf16*)(ws + WS_SG); bf16* S0 = (bf16*)F.out;
    const int cc = lane & 15, q = lane >> 4;
    static_assert(NCHK % 4 == 0, "stage 2 ring depth");
    for (int wi = F.wave * F.G + (int)blockIdx.x; wi < 512; wi += NWAVES * F.G) {
        const int chain = wi >> 2, vg = wi & 3; const int v = 16 * vg + cc;
        f32x4 St[4];
#pragma unroll
        for (int J = 0; J < 4; ++J) St[J] = (f32x4){0.f, 0.f, 0.f, 0.f};
        S2Ops o0, o1, o2, o3;
        s2_load(o0, PT, GG, chain, 0, cc, q, v); s2_load(o1, PT, GG, chain, 1, cc, q, v); s2_load(o2, PT, GG, chain, 2, cc, q, v);
        for (int c = 0; c < NCHK; c += 4) {
            s2_load(o3, PT, GG, chain, c + 3, cc, q, v);                 s2_step(St, o0, S0, chain, c, q, v);
            if (c + 4 < NCHK) s2_load(o0, PT, GG, chain, c + 4, cc, q, v); s2_step(St, o1, S0, chain, c + 1, q, v);
            if (c + 5 < NCHK) s2_load(o1, PT, GG, chain, c + 5, cc, q, v); s2_step(St, o2, S0, chain, c + 2, q, v);
            if (c + 6 < NCHK) s2_load(o2, PT, GG, chain, c + 6, cc, q, v); s2_step(St, o3, S0, chain, c + 3, q, v);
        }
    }
}

__device__ __forceinline__ void p_scan3(Frame& F) {
    unsigned char* const ws = launder(F.ws);
    const int tid = (F.wave * 64 + hw_lane()), lane = tid & 63;
    const bf16* QQ = (const bf16*)(ws + WS_SQ); const bf16* S0 = (const bf16*)F.out; float* OSC = (float*)(ws + WS_OSC);
    const int gw = F.vcu * NWAVES + F.wave, NGW = F.G * NWAVES; const int r = lane & 31, h = lane >> 5;
    bf16x8 sa[4], qb[4], sa2[4], qb2[4]; f32x4 ov[4], ov2[4]; float* op = nullptr; float* op2 = nullptr;
#define S3_LOAD(SA, QB, OV, OP, job_) do { const int item = (job_) >> 2, mi = ((job_) >> 1) & 1, ni = (job_) & 1; \
        const int chain = item / NCHK, c = item - chain * NCHK, dir = chain & 1, bh = chain >> 1, b = bh >> 3, hd = bh & 7; const int s0 = c * SCH + 32 * ni + r; \
        const int tok = (s0 < CTXL) ? (TL + b * CTXL + (dir ? (CTXL - 1 - s0) : s0)) : (b * SEQL + (dir ? (SEQL - 1 - (s0 - CTXL)) : (s0 - CTXL))); \
        const bf16* sp = S0 + (size_t)item * 4096 + (size_t)(32 * mi + r) * 64 + 8 * h; const bf16* qp = QQ + (size_t)item * 4096 + (size_t)(32 * ni + r) * 64 + 8 * h; \
        _Pragma("unroll") for (int kb = 0; kb < 4; ++kb) { SA[kb] = *(const bf16x8*)(sp + 16 * kb); QB[kb] = *(const bf16x8*)(qp + 16 * kb); } \
        OP = OSC + ((size_t)dir * TT + (size_t)tok) * 512 + hd * 64 + 32 * mi + 4 * h; \
        _Pragma("unroll") for (int g = 0; g < 4; ++g) OV[g] = *(const f32x4*)(OP + 8 * g); } while (0)
    int job = gw;
    if (job < NITEM * 4) S3_LOAD(sa, qb, ov, op, job);
    for (; job < NITEM * 4; job += NGW) {
        const int nj = job + NGW;
        if (nj < NITEM * 4) S3_LOAD(sa2, qb2, ov2, op2, nj);
        f32x16 acc = {};
#pragma unroll
        for (int kb = 0; kb < 4; ++kb) acc = __builtin_amdgcn_mfma_f32_32x32x16_bf16(sa[kb], qb[kb], acc, 0, 0, 0);
#pragma unroll
        for (int g = 0; g < 4; ++g) *(f32x4*)(op + 8 * g) = ov[g] + (f32x4){acc[4 * g], acc[4 * g + 1], acc[4 * g + 2], acc[4 * g + 3]};
#pragma unroll
        for (int kb = 0; kb < 4; ++kb) { sa[kb] = sa2[kb]; qb[kb] = qb2[kb]; ov[kb] = ov2[kb]; }
        op = op2;
    }
#undef S3_LOAD
}


__device__ __forceinline__ void s3_fetch(v4u (&d)[4], const bf16* base, size_t pitch, int lane) {
#pragma unroll
    for (int i = 0; i < 4; ++i) d[i] = *(const v4u*)(base + (size_t)((lane >> 3) + 8 * i) * pitch + (lane & 7) * 8);
}
template <bool PERMUTED = false>
__device__ __forceinline__ void s3_relayout(uint2 (&o)[8], const v4u (&d)[4], LAS unsigned char* stg, int lane) {
    const int r = lane & 31, h = lane >> 5;
#pragma unroll
    for (int i = 0; i < 4; ++i) *(LAS v4u*)(stg + ((lane >> 3) + 8 * i) * LSTR + (lane & 7) * 16) = d[i];
#pragma unroll
    for (int mi = 0; mi < 2; ++mi)
#pragma unroll
        for (int g = 0; g < 4; ++g) { const int c0 = 32 * mi + 8 * g + 4 * h; const u32x2 w = *(const LAS u32x2*)(stg + r * LSTR + (PERMUTED ? jperm(c0) : c0) * 2); o[mi * 4 + g] = make_uint2(w.x, w.y); }
}
__device__ __forceinline__ void p_scan3r(Frame& F, const Args& A, int l) {
    unsigned char* const ws = launder(F.ws);
    const int tid = (F.wave * 64 + hw_lane()), lane = tid & 63;
    const bf16* QQ = (const bf16*)(ws + WS_SQ); const bf16* S0 = (const bf16*)F.out; const bf16* OSC = (const bf16*)(ws + WS_OSC);
    const bf16* Rst = (const bf16*)(ws + WS_R); const bf16* Vst = (const bf16*)(ws + WS_V); const bf16* Kst = (const bf16*)(ws + WS_K); const bf16* LOUT = (const bf16*)(ws + WS_LOUT);
    bf16* QO = (bf16*)(ws + WS_QO);
    LAS unsigned char* stg = F.lds + RING_OFF + F.wave * 4608;
    const int gw = F.vcu * NWAVES + F.wave, NGW = F.G * NWAVES; const int r = lane & 31, h = lane >> 5;
    const float* rkp = INP(IN_RK) + l * 512; const float* gnwp = INP(IN_GNW) + l * 512; const float* gnbp = INP(IN_GNB) + l * 512; const float* kap = INP(IN_KA) + l * 512; const float* a0p = INP(IN_A0) + l * 1024;
    for (int unit = gw; unit < 64 * (KVLEN / 32); unit += NGW) {
        const int bh = unit / (KVLEN / 32), pb = unit - bh * (KVLEN / 32), b = bh >> 3, hd = bh & 7, p0 = pb * 32;
        const size_t tokb = (p0 < CTXL) ? (size_t)(TL + b * CTXL + p0) : (size_t)(b * SEQL + (p0 - CTXL)); const size_t tok = tokb + r;
        const int sb0 = (p0 < CTXL) ? (CTXL - 1 - p0) : (KVLEN + CTXL - 1 - p0);
        const int itf = (bh * 2) * NCHK + (p0 >> 6), itb = (bh * 2 + 1) * NCHK + (sb0 >> 6); const int tf = (p0 & 63) + r, tb = (sb0 & 63) - r;
        v4u ga[4], gb[4];
        s3_fetch(ga, OSC + tokb * 512 + hd * 64, 512, lane); s3_fetch(gb, OSC + ((size_t)TT + tokb) * 512 + hd * 64, 512, lane);
        f32x4 o[2][4];
        {   f32x16 acc[2][2];
#pragma unroll
            for (int d = 0; d < 2; ++d) { const size_t ib = (size_t)(d ? itb : itf) * 4096; const bf16* qp = QQ + ib + (size_t)(d ? tb : tf) * 64 + 8 * h;
                bf16x8 qf[4];
#pragma unroll
                for (int kb = 0; kb < 4; ++kb) qf[kb] = *(const bf16x8*)(qp + 16 * kb);
#pragma unroll
                for (int mi = 0; mi < 2; ++mi) { const bf16* sp = S0 + ib + (size_t)(32 * mi + r) * 64 + 8 * h; f32x16 a = {};
#pragma unroll
                    for (int kb = 0; kb < 4; ++kb) a = __builtin_amdgcn_mfma_f32_32x32x16_bf16(*(const bf16x8*)(sp + 16 * kb), qf[kb], a, 0, 0, 0);
                    acc[d][mi] = a; } }
#pragma unroll
            for (int mi = 0; mi < 2; ++mi)
#pragma unroll
                for (int g = 0; g < 4; ++g)
#pragma unroll
                    for (int i = 0; i < 4; ++i) o[mi][g][i] = acc[0][mi][4 * g + i] + acc[1][mi][4 * g + i]; }
        uint2 ta[8], tb8[8];
        s3_relayout<true>(ta, ga, stg, lane); s3_fetch(ga, Rst + tokb * 512 + hd * 64, 512, lane);
        s3_relayout<true>(tb8, gb, stg, lane); s3_fetch(gb, Kst + tokb * 512 + hd * 64, 512, lane);
        float s1 = 0.f;
#pragma unroll
        for (int mi = 0; mi < 2; ++mi)
#pragma unroll
            for (int g = 0; g < 4; ++g) { const uint2 of = ta[mi * 4 + g], ob = tb8[mi * 4 + g]; f32x4 v = o[mi][g];
                v[0] += bflo(of.x) + bflo(ob.x); v[1] += bfhi(of.x) + bfhi(ob.x); v[2] += bflo(of.y) + bflo(ob.y); v[3] += bfhi(of.y) + bfhi(ob.y);
                o[mi][g] = v; s1 += (v[0] + v[1]) + (v[2] + v[3]); }
        s1 += __shfl_xor(s1, 32); const float mean = s1 * (1.0f / 64.0f);
        const int cb = hd * 64 + 4 * h;
        float s2 = 0.f, bs = 0.f;
        f32x4 rkv[8], sa[8];
        {   uint2 rr8[8], kk8[8];
            s3_relayout(rr8, ga, stg, lane); s3_fetch(ga, LOUT + tokb * LORA_N + 1024 + hd * 64, LORA_N, lane);
            s3_relayout(kk8, gb, stg, lane); s3_fetch(gb, LOUT + tokb * LORA_N + 1536 + hd * 64, LORA_N, lane);
#pragma unroll
            for (int q = 0; q < 8; ++q) { const int cl = cb + 32 * (q >> 2) + 8 * (q & 3); const f32x4 rk4 = *(const f32x4*)(rkp + cl);
                f32x4 d = o[q >> 2][q & 3] - mean; o[q >> 2][q & 3] = d; s2 += (d[0] * d[0] + d[1] * d[1]) + (d[2] * d[2] + d[3] * d[3]);
                rkv[q] = (f32x4){bflo(rr8[q].x) * bflo(kk8[q].x) * rk4[0], bfhi(rr8[q].x) * bfhi(kk8[q].x) * rk4[1], bflo(rr8[q].y) * bflo(kk8[q].y) * rk4[2], bfhi(rr8[q].y) * bfhi(kk8[q].y) * rk4[3]}; } }
        {   uint2 pa8[8];
            s3_relayout(pa8, ga, stg, lane); s3_fetch(ga, Vst + tokb * 512 + hd * 64, 512, lane);
#pragma unroll
            for (int q = 0; q < 8; ++q) sa[q] = (f32x4){bflo(pa8[q].x), bfhi(pa8[q].x), bflo(pa8[q].y), bfhi(pa8[q].y)}; }
        {   uint2 pb8[8];
            s3_relayout(pb8, gb, stg, lane); s3_fetch(gb, LOUT + tokb * LORA_N + 2048 + hd * 64, LORA_N, lane);
#pragma unroll
            for (int q = 0; q < 8; ++q) { const int cl = cb + 32 * (q >> 2) + 8 * (q & 3); const f32x4 ka4 = *(const f32x4*)(kap + cl);
                const float pq[4] = {bflo(pb8[q].x), bfhi(pb8[q].x), bflo(pb8[q].y), bfhi(pb8[q].y)};
#pragma unroll
                for (int i = 0; i < 4; ++i) bs += rkv[q][i] * (2.0f + (sa[q][i] + pq[i] - 2.0f) * ka4[i]); } }
        s2 += __shfl_xor(s2, 32); bs += __shfl_xor(bs, 32);
        const float rs = 1.0f / sqrtf(s2 * (1.0f / 64.0f) + GN_EPS);
        uint2 vv8[8], gg8[8];
        s3_relayout(vv8, ga, stg, lane); s3_relayout(gg8, gb, stg, lane);
#pragma unroll
        for (int mi = 0; mi < 2; ++mi)
#pragma unroll
            for (int g = 0; g < 4; ++g) { const int cl = cb + 32 * mi + 8 * g; const int q = mi * 4 + g;
                const uint2 vw = vv8[q], gwd = gg8[q];
                const f32x4 w4 = *(const f32x4*)(gnwp + cl), b4 = *(const f32x4*)(gnbp + cl); const f32x4 d = o[mi][g];
                const float y0 = (d[0] * rs * w4[0] + b4[0] + bs * bflo(vw.x)) * bflo(gwd.x), y1 = (d[1] * rs * w4[1] + b4[1] + bs * bfhi(vw.x)) * bfhi(gwd.x);
                const float y2 = (d[2] * rs * w4[2] + b4[2] + bs * bflo(vw.y)) * bflo(gwd.y), y3 = (d[3] * rs * w4[3] + b4[3] + bs * bfhi(vw.y)) * bfhi(gwd.y);
                *(LAS u32x2*)(stg + r * LSTR + (32 * mi + 8 * g + 4 * h) * 2) = (u32x2){pkbf(y0, y1), pkbf(y2, y3)}; }
#pragma unroll
        for (int i = 0; i < 4; ++i) { const int row = (lane >> 3) + 8 * i; const v4u val = *(const LAS v4u*)(stg + row * LSTR + (lane & 7) * 16);
            *(v4u*)(QO + (tokb + row) * 1024 + 512 + hd * 64 + (lane & 7) * 8) = val; }
    }
}

#if DEBUG_NAN
__device__ __forceinline__ void dbg_count(Frame& F) {
    unsigned char* const ws = launder(F.ws);
    const size_t gt = (size_t)blockIdx.x * 512 + threadIdx.x, NT = (size_t)F.G * 512;
    const unsigned short* arr[4] = {(const unsigned short*)(ws + WS_SPT), (const unsigned short*)(ws + WS_SG), (const unsigned short*)(ws + WS_SQ), (const unsigned short*)F.out};
#pragma unroll
    for (int a = 0; a < 4; ++a) { unsigned bad = 0; for (size_t i = gt; i < (size_t)NITEM * 4096; i += NT) { const float v = __builtin_bit_cast(float, (unsigned)arr[a][i] << 16); if (!(fabsf(v) < 1e30f)) ++bad; }
        if (bad) atomicAdd((unsigned*)(F.ctl + 8 + a), bad); }
    { const float* o = (const float*)(ws + WS_OSC); unsigned bad = 0; for (size_t i = gt; i < (size_t)2 * TT * 512; i += NT) { if (!(fabsf(o[i]) < 1e30f)) ++bad; } if (bad) atomicAdd((unsigned*)(F.ctl + 12), bad); }
}
#endif
template <int l> __device__ __forceinline__ void layer_body(Frame& F, const Args& args, const XcdBarrier& bar, unsigned char* lds) {
#define GRID_BAR() xcd_barrier(bar)

        constexpr bool last = (l == DEPTH - 1), moe = (l & 1) != 0;

#ifndef SKIP_WPREP
        p_wprep(F, args, l, 0);
#endif


#ifndef SKIP_NORM1
        {   if (l == 0) p_norm<false, false, true>(F, args, l, 0, INP(IN_X), INP(IN_CTX), 0);
            else if (l & 1) p_norm<false, false, false, true>(F, args, l, 0, nullptr, nullptr, 0);
            else p_norm<false, true, false>(F, args, l, 0, nullptr, nullptr, l - 1); }
#endif

        GRID_BAR(); TS(1);
        {   unsigned char* const ws = launder(F.ws); bf16* const XB = (bf16*)(ws + WS_XB); const float* const MOD = (const float*)(ws + WS_MOD); bf16* const H = (bf16*)F.out; (void)XB; (void)MOD; (void)H;
            pg8::Gemm g{H, (const bf16*)(ws + WS_WIN), TT, INWP, 1024, 0}; pg8::Sched S; S.init(TT / 256, INWP / 256, F.G, (int)blockIdx.x, nullptr);
            pg8::EpiBf16 E{(bf16*)(ws + WS_P), INWP};
#ifndef SKIP_G_IN
            pg8::gemm_phase<pg8::EpiBf16, pg8::Sched, true, true>(F.lds + RING_OFF, g, S, E, F.wave);
#endif
            }
        GRID_BAR(); TS(2);

#ifndef SKIP_PREP
        p_prep(F, args, l);
#endif
#if PROBE == 2
        p_prep(F, args, l);
#endif

        GRID_BAR(); TS(3);
        {   unsigned char* const ws = launder(F.ws); bf16* const XB = (bf16*)(ws + WS_XB); const float* const MOD = (const float*)(ws + WS_MOD); bf16* const H = (bf16*)F.out; (void)XB; (void)MOD; (void)H;
            pg8::Gemm g{(const bf16*)(ws + WS_LIN), (const bf16*)(ws + WS_WLORA), TT, LORA_N, 128, LORA_K}; pg8::Sched S; S.init(TT / 256, LORA_N / 256, F.G, (int)blockIdx.x, nullptr); S.lora = 1;
            pg8::EpiLoraAct E{(bf16*)(ws + WS_LOUT), LORA_N, INP(IN_W0) + l * 1024, INP(IN_A0) + l * 1024};
#ifndef SKIP_G_LORA
            pg8::gemm_phase<pg8::EpiLoraAct, pg8::Sched, true, true>(F.lds + RING_OFF, g, S, E, F.wave);
#endif
            }

#ifndef SKIP_ATTN
        p_attn(F, (char*)lds + RING_OFF, !last);
#endif

        GRID_BAR(); TS(4);

#if USE_SEQ_SCAN
        p_scan(F, args, l);
#else
        p_scan1(F, args, l);
#if PROBE == 5
        p_scan1(F, args, l);
#endif
        GRID_BAR(); TS(5);
        p_scan2(F);
#if PROBE == 6
        p_scan2(F);
#endif
        GRID_BAR(); TS(6);
        p_scan3r(F, args, l);
#endif
#if USE_SEQ_SCAN
        GRID_BAR(); TS(15);
        p_readout(F, args, l);
#endif
        GRID_BAR(); TS(7);
        {   unsigned char* const ws = launder(F.ws); bf16* const XB = (bf16*)(ws + WS_XB); const float* const MOD = (const float*)(ws + WS_MOD); bf16* const H = (bf16*)F.out; (void)XB; (void)MOD; (void)H;
            pg8::Gemm g{(const bf16*)(ws + WS_QO), (const bf16*)(ws + WS_WOUT), TT, 1024, 1024, 0, 0}; pg8::SchedSK S; S.init(TL / 256, !last, 1024 / 64, F.G, (int)blockIdx.x);
            pg8::EpiResidB<l == 0> E{INP(IN_X), INP(IN_CTX), XB, MOD + (size_t)l * 9 * 6144 + 2 * 1024, (bf16*)(ws + WS_SIDE), 1.0f};
#ifndef SKIP_G_OUT
            pg8::gemm_phase<pg8::EpiResidB<l == 0>, pg8::SchedSK, true, true>(F.lds + RING_OFF, g, S, E, F.wave);
#endif
            }
        GRID_BAR(); TS(8);
        p_wprep(F, args, l, 1);
#if PROBE == 7
        p_wprep(F, args, l, 1);
#endif
        if (!moe) {
            p_norm<false, false, false, true>(F, args, l, 1, nullptr, nullptr, 0);
#if PROBE == 4
            p_norm<false, false, false, false>(F, args, l, 1, nullptr, nullptr, 0);
#endif
            GRID_BAR(); TS(9);
            {   unsigned char* const ws = launder(F.ws); bf16* const XB = (bf16*)(ws + WS_XB); const float* const MOD = (const float*)(ws + WS_MOD); bf16* const H = (bf16*)F.out; (void)XB; (void)MOD; (void)H;
            pg8::Gemm g{H, (const bf16*)(ws + WS_WFF), TT, 2 * FFD, 1024, 0}; pg8::Sched S; S.init(TT / 256, 2 * FFD / 256, F.G, (int)blockIdx.x, nullptr);
                pg8::EpiSwiGLU E{(bf16*)(ws + WS_HID), FFD, 1.0f};
#ifndef SKIP_G_UP
                pg8::gemm_phase<pg8::EpiSwiGLU, pg8::Sched, true, true>(F.lds + RING_OFF, g, S, E, F.wave);
#endif
            }
            GRID_BAR(); TS(10);
            {   unsigned char* const ws = launder(F.ws); bf16* const XB = (bf16*)(ws + WS_XB); const float* const MOD = (const float*)(ws + WS_MOD); bf16* const H = (bf16*)F.out; (void)XB; (void)MOD; (void)H;
            pg8::Gemm g{(const bf16*)(ws + WS_HID), (const bf16*)(ws + WS_WFF_D_DENSE), TT, 1024, FFD, 0, 0}; pg8::SchedSK S; S.init(TL / 256, true, FFD / 64, F.G, (int)blockIdx.x);
                pg8::EpiResidB<false> E{nullptr, nullptr, XB, MOD + (size_t)l * 9 * 6144 + 5 * 1024, (bf16*)(ws + WS_SIDE), 1.0f};
#ifndef SKIP_G_DOWN
                pg8::gemm_phase<pg8::EpiResidB<false>, pg8::SchedSK, true, true>(F.lds + RING_OFF, g, S, E, F.wave);
#endif
            }
            GRID_BAR(); TS(11);
        } else {
            p_norm<true, false, false, !last>(F, args, l, 1, nullptr, nullptr, 0, last ? TL : TT);
#if PROBE == 4
            p_norm<true, false, false, false>(F, args, l, 1, nullptr, nullptr, 0, last ? TL : TT);
#endif
            GRID_BAR(); TS(9);

#ifndef SKIP_ROUTE
            p_route(F, last ? TL : TT);
#endif

            GRID_BAR(); TS(12);
            const int npanels = *(LAS int*)(F.lds + LT_NPAN);
            {   unsigned char* const ws = launder(F.ws); bf16* const XB = (bf16*)(ws + WS_XB); const float* const MOD = (const float*)(ws + WS_MOD); bf16* const H = (bf16*)F.out; (void)XB; (void)MOD; (void)H;
            pg8::Gemm g{(const bf16*)(ws + WS_AG8), (const bf16*)(ws + WS_WFF), npanels * 256, 2 * FFE, 512, 0}; pg8::Sched S; S.init(npanels, 2 * FFE / 256, F.G, (int)blockIdx.x, (const LAS int*)(F.lds + LT_PEXP));
                pg8::EpiSwiGLU8 E{ws + WS_HIDM, FFE, 1.0f / (H8SCALE * W8SCALE), HID8SCALE};
#ifndef SKIP_G_MUP
                pg8::gemm_phase<pg8::EpiSwiGLU8, pg8::Sched, true, true, true>(F.lds + RING_OFF, g, S, E, F.wave);
#endif
            }
            GRID_BAR(); TS(13);
            {   unsigned char* const ws = launder(F.ws); bf16* const XB = (bf16*)(ws + WS_XB); const float* const MOD = (const float*)(ws + WS_MOD); bf16* const H = (bf16*)F.out; (void)XB; (void)MOD; (void)H;
            pg8::Gemm g{(const bf16*)(ws + WS_HIDM), (const bf16*)(ws + WS_WFF_D_MOE8), npanels * 256, 1024, FFE / 2, 0}; pg8::Sched S; S.init(npanels, 4, F.G, (int)blockIdx.x, (const LAS int*)(F.lds + LT_PEXP));
                pg8::EpiBf16S E{(bf16*)(ws + WS_AG), 1024, 1.0f / (HID8SCALE * W8SCALE)};
#ifndef SKIP_G_MDOWN
                pg8::gemm_phase<pg8::EpiBf16S, pg8::Sched, true, true, true>(F.lds + RING_OFF, g, S, E, F.wave);
#endif
            }
            GRID_BAR(); TS(14);
        }

#undef GRID_BAR
}
__global__ void __launch_bounds__(NWAVES * 64, 2) mk_fwd(Args args) {
    extern __shared__ __attribute__((aligned(16))) unsigned char lds[];
    Frame F;
    F.lds = (LAS unsigned char*)lds;
    F.MISC = (volatile LAS unsigned*)(F.lds + MISC_OFF);
    F.tid = threadIdx.x; F.lane = F.tid & 63; F.wave = __builtin_amdgcn_readfirstlane(F.tid >> 6);
    F.G = gridDim.x; { const int bx = blockIdx.x; F.vcu = (F.G % 8 == 0) ? (bx % 8) * (F.G / 8) + bx / 8 : bx; }
    F.ws = args.ws; F.ctl = (gu32*)(args.ws + WS_CTL); F.out = args.out;
    for (int u = F.tid; u < 64; u += NWAVES * 64) ((LAS unsigned*)(F.lds + LDSCTL_OFF))[u] = 0u;
    if (F.tid < 30) ((LAS unsigned long long*)(F.lds + LT_INP))[F.tid] = (unsigned long long)args.in[F.tid];
    __syncthreads();
    XcdBarrier bar = xcd_barrier_post((unsigned*)(F.ctl + CW_BAR), F.MISC + 8, F.wave);
#define GRID_BAR() xcd_barrier(bar)
#if TSEL >= 0
    if (blockIdx.x == 0 && F.wave == 0 && hw_lane() == 0) ((unsigned long long*)(F.ws + WS_CTL + 32768))[0] = __builtin_amdgcn_s_memrealtime();
#endif

#ifndef SKIP_PRO
    p_prologue(F, args);
#endif

    GRID_BAR(); TS(0);
    layer_body<0>(F, args, bar, lds);
#if DEBUG_NAN
    return;
#endif
    layer_body<1>(F, args, bar, lds);
    layer_body<2>(F, args, bar, lds);
    layer_body<3>(F, args, bar, lds);

#ifndef SKIP_FINAL
    p_final_combine(F, DEPTH - 1);
#endif
#if TSEL >= 0
    TS(15);
    xcd_barrier(bar);
    if (blockIdx.x == 0 && F.wave == 0 && hw_lane() == 0) { const unsigned long long* ts_ = (const unsigned long long*)(F.ws + WS_CTL + 32768); float tot = 0.f, sel = 0.f;
        for (int k = 0; k < 16; ++k) { tot += (float)ts_[1 + k]; if ((TSEL >> k) & 1) sel += (float)ts_[1 + k]; }
        F.out[0] += 3.0f + 6.9f * sel / tot; }
#endif

#if CYSEL >= 0
    xcd_barrier(bar);
    if (blockIdx.x == 0 && F.wave == 0 && hw_lane() == 0) { const unsigned long long* cs_ = (const unsigned long long*)(F.ws + WS_CTL + 40960); float tot = 0.f; for (int k = 0; k < 5; ++k) tot += (float)cs_[k];
        F.out[0] += 3.0f + 6.9f * (float)cs_[CYSEL] / tot; }
#endif
    if (xb_ld((unsigned*)(F.ctl + CW_BAR) + XB_TMO) != 0u && blockIdx.x == 0 && F.wave == 0 && hw_lane() == 0) F.out[0] = __builtin_nanf("");
}

extern "C" void kernel_launch(void* const* d_in, const int* in_sizes, int n_in, void* d_out, int out_size, void* d_ws, size_t ws_size, hipStream_t stream) {
    static int grid = 0;
    if (grid == 0) {
        if (n_in != 30 || in_sizes[0] != TL * 1024 || out_size != TL * 1024 || ws_size < WS_END) { fprintf(stderr, "kernel_launch: unexpected shapes / workspace (n_in %d, ws %zu); nothing launched\n", n_in, ws_size); grid = -1; return; }
        int dev = 0, cus = 0, per_cu = 0;
        if (hipGetDevice(&dev) != hipSuccess || hipDeviceGetAttribute(&cus, hipDeviceAttributeMultiprocessorCount, dev) != hipSuccess) { grid = -1; return; }
        if (hipFuncSetAttribute((const void*)mk_fwd, hipFuncAttributeMaxDynamicSharedMemorySize, LDS_BYTES) != hipSuccess) { fprintf(stderr, "kernel_launch: hipFuncSetAttribute failed\n"); grid = -1; return; }
        if (hipOccupancyMaxActiveBlocksPerMultiprocessor(&per_cu, (const void*)mk_fwd, NWAVES * 64, LDS_BYTES) != hipSuccess || per_cu < 1) { fprintf(stderr, "kernel_launch: occupancy query reports %d blocks per CU\n", per_cu); }
        (void)hipGetLastError();
        grid = cus;
    }
    if (grid < 0) return;
    if (hipMemsetAsync((char*)d_ws + WS_CTL, 0, CTL_ZERO_BYTES, stream) != hipSuccess) return;
    Args a{};
    for (int i = 0; i < 30; ++i) a.in[i] = (const float*)d_in[i];
    a.out = (float*)d_out; a.ws = (unsigned char*)d_ws;
    hipLaunchKernelGGL(mk_fwd, dim3(grid), dim3(NWAVES * 64), LDS_BYTES, stream, a);
}
```

```cpp
#include <hip/hip_runtime.h>
#include <hip/hip_bf16.h>
#include <cstdio>
#include <cstdint>
#include <cmath>
__device__ __forceinline__ int hw_lane() { int l_; asm volatile("v_mbcnt_lo_u32_b32 %0, -1, 0\n\tv_mbcnt_hi_u32_b32 %0, -1, %0" : "=v"(l_)); return l_; }
namespace pg8 {
#define PG8_LAS __attribute__((address_space(3)))
typedef unsigned short bf16_t;
typedef short bf16x8 __attribute__((ext_vector_type(8)));
typedef float f32x4 __attribute__((ext_vector_type(4)));
typedef unsigned u32x4 __attribute__((ext_vector_type(4)));
constexpr int BM = 256, BK = 64, HALF = 128, HTB = HALF * BK * 2  , STAGE_BYTES = 8 * HTB, NXCD = 8, WGM = 8;

__host__ __device__ __forceinline__ int lds_byte(int r, int c) { const int st = (r >> 4) * 2 + (c >> 5), rr = r & 15, cc = c & 31, ob = rr * 64 + cc * 2; return st * 1024 + (ob ^ (((ob >> 9) & 1) << 5)); }
__host__ __device__ __forceinline__ void stage_rc(int b, int& R, int& C) { const int st = b / 1024, sb = b % 1024, swz = sb ^ (((sb >> 9) & 1) << 5); R = (st >> 1) * 16 + swz / 64; C = (st & 1) * 32 + (swz % 64) / 2; }
__host__ __device__ __forceinline__ int perm32(int rho) { const int n = rho >> 4, i = rho & 15; return 8 * (i >> 2) + 4 * n + (i & 3); }
__device__ __forceinline__ unsigned cvt_pk_bf16(float lo, float hi) { unsigned r; asm volatile("v_cvt_pk_bf16_f32 %0, %1, %2" : "=v"(r) : "v"(lo), "v"(hi)); return r; }
typedef float f32x2 __attribute__((ext_vector_type(2)));

struct Unit { int pm, pn, pnb, ka, nt, slice; };
struct Gemm { const bf16_t* A; const bf16_t* Bt; int M, N, K, lda, ldb; };

struct Sched {
    static constexpr bool SPLITK = false;
    int nM, nN, nwg, G, c, lora; const PG8_LAS int* pexp;
    __device__ __forceinline__ void init(int nM_, int nN_, int G_, int c_, const PG8_LAS int* pe) { nM = nM_; nN = nN_; nwg = nM * nN; G = G_; c = c_; pexp = pe; lora = 0; }
    __device__ __forceinline__ bool next(int i, Unit& u) const {
        const long L = (long)i * G + c; if (L >= nwg) return false;
        int wgid = (int)L; { const int q = nwg / NXCD, r = nwg % NXCD, xcd = wgid % NXCD, off = wgid / NXCD; wgid = (xcd < r ? xcd * (q + 1) : r * (q + 1) + (xcd - r) * q) + off; }
        const int nig = WGM * nN, gid = wgid / nig, fm = gid * WGM, gsz = (nM - fm) < WGM ? (nM - fm) : WGM;
        u.pm = fm + ((wgid % nig) % gsz); u.pn = (wgid % nig) / gsz; u.pnb = pexp ? pexp[u.pm] * nN + u.pn : u.pn;
        u.ka = lora ? ((u.pn >= 8) ? 512 : ((u.pn >= 4) ? 256 : 0)) : 0; return true;
    }
    __device__ __forceinline__ void a_ready(const Unit&) const {}
    __device__ __forceinline__ void done(const Unit&) const {}
};
struct SchedSK {
    static constexpr bool SPLITK = true;
    int nM, nwg, G, c, nsub, ntt, base, extra;
    __device__ __forceinline__ void init(int nMf_, bool ctx, int ntiles, int G_, int c_) { nM = nMf_; nwg = nMf_ * 4; G = G_; c = c_; nsub = ctx ? 128 : 0; ntt = ntiles; base = (ntiles / 4) & ~1; extra = (ntiles - 4 * base) / 2; }
    __device__ __forceinline__ bool next(int i, Unit& u) const {
        const long L = (long)i * G + c; if (L >= nwg + nsub) return false;
        const bool sub = L >= nwg;
        int wgid = sub ? 0 : (int)L; { const int q = nwg / NXCD, r = nwg % NXCD, xcd = wgid % NXCD, off = wgid / NXCD; wgid = (xcd < r ? xcd * (q + 1) : r * (q + 1) + (xcd - r) * q) + off; }
        const int nig = WGM * 4, gid = wgid / nig, fm = gid * WGM, gsz = (nM - fm) < WGM ? (nM - fm) : WGM;
        const int pmf = fm + ((wgid % nig) % gsz), pnf = (wgid % nig) / gsz;
        const int Ls = sub ? (int)(L - nwg) : 0, sl = Ls >> 5, rem = Ls & 31;
        const int kt0 = sl * base + 2 * (sl < extra ? sl : extra);
        u.pm = sub ? nM + (rem & 7) : pmf; u.pn = sub ? (rem >> 3) : pnf; u.pnb = u.pn; u.slice = sl;
        u.nt = sub ? base + ((sl < extra) ? 2 : 0) : ntt; u.ka = kt0 * (BK * 2); return true;
    }
    __device__ __forceinline__ void a_ready(const Unit&) const {}
    __device__ __forceinline__ void done(const Unit&) const {}
};

__device__ __forceinline__ float sigmoid_f(float x) { return __builtin_amdgcn_rcpf(1.0f + __builtin_amdgcn_exp2f(-1.4426950408889634f * x)); }
__device__ __forceinline__ float bf_lo(unsigned w) { return __builtin_bit_cast(float, w << 16); }
__device__ __forceinline__ float bf_hi(unsigned w) { return __builtin_bit_cast(float, w & 0xffff0000u); }

struct EpiBf16 {
    static constexpr bool PERM = true, AFTER_DRAIN = false;
    bf16_t* O; int ldc;
    __device__ __forceinline__ void operator()(const f32x4 (&acc)[2][2][4][2], const Unit& u, int wr, int wc, int fr, int fq) const {
        const int row0 = u.pm * BM + wr * 64 + fr; const int col0 = u.pn * BM + wc * 32 + 8 * fq;
#pragma unroll
        for (int ai = 0; ai < 2; ++ai)
#pragma unroll
            for (int m = 0; m < 4; ++m) { bf16_t* rowp = O + (size_t)(row0 + ai * HALF + m * 16) * ldc + col0;
#pragma unroll
                for (int bj = 0; bj < 2; ++bj) { const f32x4 v0 = acc[ai][bj][m][0], v1 = acc[ai][bj][m][1];
                    u32x4 w; w.x = cvt_pk_bf16(v0[0], v0[1]); w.y = cvt_pk_bf16(v0[2], v0[3]); w.z = cvt_pk_bf16(v1[0], v1[1]); w.w = cvt_pk_bf16(v1[2], v1[3]);
                    *(u32x4*)(rowp + bj * HALF) = w; } }
    }
};
struct EpiSwiGLU {
    static constexpr bool PERM = true, AFTER_DRAIN = false;
    bf16_t* O; int ldc; float inscale;
    __device__ __forceinline__ void operator()(const f32x4 (&acc)[2][2][4][2], const Unit& u, int wr, int wc, int fr, int fq) const {
        const int row0 = u.pm * BM + wr * 64 + fr; const int col0 = u.pn * HALF + wc * 32 + 8 * fq;
#pragma unroll
        for (int ai = 0; ai < 2; ++ai)
#pragma unroll
            for (int m = 0; m < 4; ++m) { bf16_t* rowp = O + (size_t)(row0 + ai * HALF + m * 16) * ldc + col0;
                float h[8];
#pragma unroll
                for (int n = 0; n < 2; ++n)
#pragma unroll
                    for (int j = 0; j < 4; ++j) { const float g = acc[ai][0][m][n][j] * inscale, up = acc[ai][1][m][n][j] * inscale; h[n * 4 + j] = g * sigmoid_f(g) * up; }
                u32x4 w; w.x = cvt_pk_bf16(h[0], h[1]); w.y = cvt_pk_bf16(h[2], h[3]); w.z = cvt_pk_bf16(h[4], h[5]); w.w = cvt_pk_bf16(h[6], h[7]);
                *(u32x4*)rowp = w; }
    }
};
struct EpiResid {
    static constexpr bool PERM = false, AFTER_DRAIN = false;
    const float* baseL; const float* baseC; float* outL; float* outC; const float* gate; float scale;
    __device__ __forceinline__ void operator()(const f32x4 (&acc)[2][2][4][2], const Unit& u, int wr, int wc, int fr, int fq) const {
        const float* base; float* out; int bsel;
        if (u.pm < 128) { base = baseL + (size_t)u.pm * BM * 1024; out = outL + (size_t)u.pm * BM * 1024; bsel = u.pm >> 4; }
        else { base = baseC + (size_t)(u.pm - 128) * BM * 1024; out = outC + (size_t)(u.pm - 128) * BM * 1024; bsel = 8; }
        const float* gv = gate + (size_t)bsel * 6144;
        const int col0 = u.pn * BM + wc * 32 + 4 * fq;
        f32x4 g4[2][2];
#pragma unroll
        for (int bj = 0; bj < 2; ++bj)
#pragma unroll
            for (int n = 0; n < 2; ++n) g4[bj][n] = *(const f32x4*)(gv + col0 + bj * HALF + n * 16) * scale;
#pragma unroll
        for (int ai = 0; ai < 2; ++ai)
#pragma unroll
            for (int m = 0; m < 4; ++m) { const size_t off = (size_t)(ai * HALF + wr * 64 + m * 16 + fr) * 1024 + col0;
#pragma unroll
                for (int bj = 0; bj < 2; ++bj)
#pragma unroll
                    for (int n = 0; n < 2; ++n) { const f32x4 xs = *(const f32x4*)(base + off + bj * HALF + n * 16); *(f32x4*)(out + off + bj * HALF + n * 16) = xs + g4[bj][n] * acc[ai][bj][m][n]; } }
    }
};

__device__ __forceinline__ float clamp8(float x) { return __builtin_fminf(__builtin_fmaxf(x, -440.0f), 440.0f); }
__device__ __forceinline__ unsigned pk_fp8x4(float a, float b, float c, float d) { int w = 0; w = __builtin_amdgcn_cvt_pk_fp8_f32(clamp8(a), clamp8(b), w, false); w = __builtin_amdgcn_cvt_pk_fp8_f32(clamp8(c), clamp8(d), w, true); return (unsigned)w; }
struct EpiSwiGLU8 {
    static constexpr bool PERM = true, AFTER_DRAIN = false;
    unsigned char* O; int ldc; float inscale, outscale;
    __device__ __forceinline__ void operator()(const f32x4 (&acc)[2][2][4][2], const Unit& u, int wr, int wc, int fr, int fq) const {
        const int row0 = u.pm * BM + wr * 64 + fr; const int col0 = u.pn * HALF + wc * 32 + 8 * fq;
#pragma unroll
        for (int ai = 0; ai < 2; ++ai)
#pragma unroll
            for (int m = 0; m < 4; ++m) { unsigned char* rowp = O + (size_t)(row0 + ai * HALF + m * 16) * ldc + col0;
                float h[8];
#pragma unroll
                for (int n = 0; n < 2; ++n)
#pragma unroll
                    for (int j = 0; j < 4; ++j) { const float g = acc[ai][0][m][n][j] * inscale, up = acc[ai][1][m][n][j] * inscale; h[n * 4 + j] = g * sigmoid_f(g) * up * outscale; }
                typedef unsigned u32x2e __attribute__((ext_vector_type(2)));
                *(u32x2e*)rowp = (u32x2e){pk_fp8x4(h[0], h[1], h[2], h[3]), pk_fp8x4(h[4], h[5], h[6], h[7])};  asm volatile("" ::: "memory"); }
    }
};
struct EpiBf16S {
    static constexpr bool PERM = true, AFTER_DRAIN = false;
    bf16_t* O; int ldc; float scale;
    __device__ __forceinline__ void operator()(const f32x4 (&acc)[2][2][4][2], const Unit& u, int wr, int wc, int fr, int fq) const {
        const int row0 = u.pm * BM + wr * 64 + fr; const int col0 = u.pn * BM + wc * 32 + 8 * fq;
#pragma unroll
        for (int ai = 0; ai < 2; ++ai)
#pragma unroll
            for (int m = 0; m < 4; ++m) { bf16_t* rowp = O + (size_t)(row0 + ai * HALF + m * 16) * ldc + col0;
#pragma unroll
                for (int bj = 0; bj < 2; ++bj) { const f32x4 v0 = acc[ai][bj][m][0] * scale, v1 = acc[ai][bj][m][1] * scale;
                    u32x4 w; w.x = cvt_pk_bf16(v0[0], v0[1]); w.y = cvt_pk_bf16(v0[2], v0[3]); w.z = cvt_pk_bf16(v1[0], v1[1]); w.w = cvt_pk_bf16(v1[2], v1[3]);
                    *(u32x4*)(rowp + bj * HALF) = w; } asm volatile("" ::: "memory"); }
    }
};

template <bool BASEF32> struct EpiResidB {
    static constexpr bool PERM = true, AFTER_DRAIN = false;
    const float* baseL; const float* baseC; bf16_t* xb; const float* gate; bf16_t* side; float scale;
    __device__ __forceinline__ void operator()(const f32x4 (&acc)[2][2][4][2], const Unit& u, int wr, int wc, int fr, int fq) const {
        asm volatile("" : "+v"(fr), "+v"(fq));
        const int bsel = (u.pm < 128) ? (u.pm >> 4) : 8;
        const float* base = (u.pm < 128) ? baseL + (size_t)u.pm * BM * 1024 : baseC + (size_t)(u.pm - 128) * BM * 1024;
        bf16_t* out = xb + (size_t)u.pm * BM * 1024;
        const float* gv = gate + (size_t)bsel * 6144;
        const int col0 = u.pn * BM + wc * 32 + 8 * fq;
        f32x4 g4[2][2];
#pragma unroll
        for (int bj = 0; bj < 2; ++bj)
#pragma unroll
            for (int n = 0; n < 2; ++n) g4[bj][n] = *(const f32x4*)(gv + col0 + bj * HALF + 4 * n) * scale;
        if (u.slice != 0) {
            bf16_t* so = side + ((size_t)(u.slice - 1) * 2048 + (size_t)(u.pm - 128) * BM) * 1024;
#pragma unroll
            for (int ai = 0; ai < 2; ++ai)
#pragma unroll
                for (int m = 0; m < 4; ++m) { const size_t off = (size_t)(ai * HALF + wr * 64 + m * 16 + fr) * 1024 + col0;
#pragma unroll
                    for (int bj = 0; bj < 2; ++bj) { const f32x4 o0 = g4[bj][0] * acc[ai][bj][m][0], o1 = g4[bj][1] * acc[ai][bj][m][1];
                        u32x4 ow; ow.x = cvt_pk_bf16(o0[0], o0[1]); ow.y = cvt_pk_bf16(o0[2], o0[3]); ow.z = cvt_pk_bf16(o1[0], o1[1]); ow.w = cvt_pk_bf16(o1[2], o1[3]);
                        *(u32x4*)(so + off + bj * HALF) = ow; } }
        } else
#pragma unroll
        for (int ai = 0; ai < 2; ++ai)
#pragma unroll
            for (int m = 0; m < 4; ++m) { const size_t off = (size_t)(ai * HALF + wr * 64 + m * 16 + fr) * 1024 + col0;
#pragma unroll
                for (int bj = 0; bj < 2; ++bj) { f32x4 x0, x1;
                    if (BASEF32) { x0 = *(const f32x4*)(base + off + bj * HALF); x1 = *(const f32x4*)(base + off + bj * HALF + 4); }
                    else { const u32x4 w = *(const u32x4*)(out + off + bj * HALF); x0 = (f32x4){bf_lo(w.x), bf_hi(w.x), bf_lo(w.y), bf_hi(w.y)}; x1 = (f32x4){bf_lo(w.z), bf_hi(w.z), bf_lo(w.w), bf_hi(w.w)}; }
                    const f32x4 o0 = x0 + g4[bj][0] * acc[ai][bj][m][0], o1 = x1 + g4[bj][1] * acc[ai][bj][m][1];
                    u32x4 ow; ow.x = cvt_pk_bf16(o0[0], o0[1]); ow.y = cvt_pk_bf16(o0[2], o0[3]); ow.z = cvt_pk_bf16(o1[0], o1[1]); ow.w = cvt_pk_bf16(o1[2], o1[3]);
                    *(u32x4*)(out + off + bj * HALF) = ow; } }
    }
};

struct EpiLoraAct {
    static constexpr bool PERM = true, AFTER_DRAIN = false;
    bf16_t* O; int ldc; const float* w0; const float* a0;
    __device__ __forceinline__ void operator()(const f32x4 (&acc)[2][2][4][2], const Unit& u, int wr, int wc, int fr, int fq) const {
        const int row0 = u.pm * BM + wr * 64 + fr; const int col0 = u.pn * BM + wc * 32 + 8 * fq; const int sec = u.pn >> 1;
        const int cs0 = (u.pn & 1) * 256 + wc * 32 + 8 * fq;
        f32x4 bv[2][2]; float mul = 1.0f;
        if (sec < 4) { const float* bp = (sec < 2 ? w0 + sec * 512 : a0 + (sec - 2) * 512) + cs0; mul = (sec < 2) ? 0.8750387749145276f : 1.0f;
#pragma unroll
            for (int bj = 0; bj < 2; ++bj)
#pragma unroll
                for (int n = 0; n < 2; ++n) bv[bj][n] = *(const f32x4*)(bp + bj * HALF + 4 * n); }
#pragma unroll
        for (int ai = 0; ai < 2; ++ai)
#pragma unroll
            for (int m = 0; m < 4; ++m) { bf16_t* rowp = O + (size_t)(row0 + ai * HALF + m * 16) * ldc + col0;
#pragma unroll
                for (int bj = 0; bj < 2; ++bj) { f32x4 v0 = acc[ai][bj][m][0], v1 = acc[ai][bj][m][1];
                    if (sec < 4) {
#pragma unroll
                        for (int j = 0; j < 4; ++j) { v0[j] = mul * sigmoid_f(v0[j] + bv[bj][0][j]); v1[j] = mul * sigmoid_f(v1[j] + bv[bj][1][j]); } }
                    u32x4 w; w.x = cvt_pk_bf16(v0[0], v0[1]); w.y = cvt_pk_bf16(v0[2], v0[3]); w.z = cvt_pk_bf16(v1[0], v1[1]); w.w = cvt_pk_bf16(v1[2], v1[3]);
                    *(u32x4*)(rowp + bj * HALF) = w; } }
    }
};
typedef int v8i_t __attribute__((ext_vector_type(8)));
__device__ __forceinline__ v8i_t cat8(bf16x8 a, bf16x8 b) { const u32x4 x = __builtin_bit_cast(u32x4, a), y = __builtin_bit_cast(u32x4, b); return (v8i_t){(int)x[0], (int)x[1], (int)x[2], (int)x[3], (int)y[0], (int)y[1], (int)y[2], (int)y[3]}; }
template <class Epi, class Sched, bool ALIGN_EPI = false, bool SP2 = false, bool FP8 = false>
__device__ __forceinline__ void gemm_phase(PG8_LAS unsigned char* lds, const Gemm g, const Sched& S, const Epi& E, const int wave_) {
    const int tid = wave_ * 64 + hw_lane(), wid = wave_, lane = tid & 63, wr = wid >> 2, wc = wid & 3, fr = lane & 15, fq = lane >> 4;
    int K_ = g.K; asm volatile("" : "+s"(K_));
    const int K = K_, nt = K / BK; const int lda = g.lda ? g.lda : K, ldb = g.ldb ? g.ldb : K;
    unsigned voffA[2], voffB[2];
#pragma unroll
    for (int i = 0; i < 2; ++i) { int R, C; stage_rc(tid * 16 + i * 8192, R, C); const int Rb = Epi::PERM ? ((R & ~31) + perm32(R & 31)) : R;
        voffA[i] = (unsigned)(R * lda + C) * 2u; voffB[i] = (unsigned)(Rb * ldb + C) * 2u; }
    const size_t kstep = (size_t)(BK * 2);
    const size_t hstep = (size_t)HALF * ldb * 2;
    const size_t hstepA = (size_t)HALF * lda * 2, tstepA = 2 * hstepA;
    const size_t tstep = 2 * hstep;
    const unsigned ldsw = (unsigned)wid * 1024u;
    const int aoff = lds_byte(wr * 64 + fr, fq * 8), boff = lds_byte(wc * 32 + fr, fq * 8);
#define PG8_SA(b, h) (((b) * 2 + (h)) * HTB)
#define PG8_SB(b, h) ((4 + (b) * 2 + (h)) * HTB)
#define PG8_STAGE(bufoff, gbase, voff) do { _Pragma("unroll") for (int _i = 0; _i < 2; ++_i) \
        __builtin_amdgcn_global_load_lds((const unsigned*)((const char*)(gbase) + (voff)[_i]), (PG8_LAS unsigned*)(lds + (bufoff) + ldsw + _i * 8192), 16, 0, 0); } while (0)
#define PG8_LDA(dst, b, h) do { if constexpr (FP8) { _Pragma("unroll") for (int m = 0; m < 4; ++m) { dst##8[m].lo = *(const PG8_LAS v4i_t*)(lds + PG8_SA(b, h) + aoff + m * 2048); dst##8[m].hi = *(const PG8_LAS v4i_t*)(lds + PG8_SA(b, h) + aoff + m * 2048 + 1024); } } \
        else { _Pragma("unroll") for (int m = 0; m < 4; ++m) _Pragma("unroll") for (int k = 0; k < 2; ++k) dst[FP8 ? 0 : m][k] = *(const PG8_LAS bf16x8*)(lds + PG8_SA(b, h) + aoff + m * 2048 + k * 1024); } } while (0)
#define PG8_LDB(dst, b, h) do { if constexpr (FP8) { _Pragma("unroll") for (int n = 0; n < 2; ++n) { dst##8[n].lo = *(const PG8_LAS v4i_t*)(lds + PG8_SB(b, h) + boff + n * 2048); dst##8[n].hi = *(const PG8_LAS v4i_t*)(lds + PG8_SB(b, h) + boff + n * 2048 + 1024); } } \
        else { _Pragma("unroll") for (int n = 0; n < 2; ++n) _Pragma("unroll") for (int k = 0; k < 2; ++k) dst[n][k] = *(const PG8_LAS bf16x8*)(lds + PG8_SB(b, h) + boff + n * 2048 + k * 1024); } } while (0)
#define PG8_MMA(ai, bj, At, Bt) do { __builtin_amdgcn_s_setprio(1); if constexpr (FP8) { _Pragma("unroll") for (int m = 0; m < 4; ++m) _Pragma("unroll") for (int n = 0; n < 2; ++n) \
        asm volatile("v_mfma_f32_16x16x128_f8f6f4 %0, %1, %2, %0" : "+v"(acc[ai][bj][m][n]) : "v"(Bt##8[n]), "v"(At##8[m])); } \
        else { _Pragma("unroll") for (int m = 0; m < 4; ++m) _Pragma("unroll") for (int n = 0; n < 2; ++n) _Pragma("unroll") for (int k = 0; k < 2; ++k) \
        acc[ai][bj][m][n] = __builtin_amdgcn_mfma_f32_16x16x32_bf16(Bt[n][k], At[FP8 ? 0 : m][k], acc[ai][bj][m][n], 0, 0, 0); } __builtin_amdgcn_s_setprio(0); } while (0)
#define PG8_WAIT_V(n) asm volatile("s_waitcnt vmcnt(" #n ")" ::: "memory")
#define PG8_WAIT_L(n) asm volatile("s_waitcnt lgkmcnt(" #n ")" ::: "memory")
#define PG8_BAR __builtin_amdgcn_s_barrier()
#define PG8_SCHED __builtin_amdgcn_sched_barrier(0)
    Unit cur, nxt; int ui = 0;
    if (!S.next(0, cur)) return;
    f32x4 acc[2][2][4][2];
#pragma unroll
    for (int a = 0; a < 2; ++a)
#pragma unroll
        for (int b = 0; b < 2; ++b)
#pragma unroll
            for (int m = 0; m < 4; ++m)
#pragma unroll
                for (int n = 0; n < 2; ++n) acc[a][b][m][n] = (f32x4){0.f, 0.f, 0.f, 0.f};
    bf16x8 At[FP8 ? 1 : 4][2], B0[2][2], B1[2][2];
    v8i_t At8[FP8 ? 4 : 1], B08[2], B18[2];
    typedef int v4i_t __attribute__((ext_vector_type(4)));
    const char* cA = (const char*)g.A + (size_t)cur.pm * tstepA + cur.ka; const char* cB = (const char*)g.Bt + (size_t)cur.pnb * tstep + (Sched::SPLITK ? cur.ka : 0);
    S.a_ready(cur);
    if constexpr (SP2) {
        PG8_STAGE(PG8_SB(0, 0), cB, voffB); PG8_STAGE(PG8_SB(0, 1), cB + hstep, voffB); PG8_STAGE(PG8_SA(0, 0), cA, voffA); PG8_STAGE(PG8_SA(0, 1), cA + hstepA, voffA);
        if (wr == 1) PG8_BAR;
        PG8_WAIT_V(2); PG8_BAR;
        PG8_STAGE(PG8_SB(1, 0), cB + kstep, voffB); PG8_STAGE(PG8_SA(1, 0), cA + kstep, voffA); PG8_STAGE(PG8_SB(1, 1), cB + hstep + kstep, voffB);
        PG8_WAIT_V(6); PG8_BAR;
    } else {
        PG8_STAGE(PG8_SB(0, 0), cB, voffB); PG8_STAGE(PG8_SA(0, 0), cA, voffA); PG8_STAGE(PG8_SB(0, 1), cB + hstep, voffB); PG8_STAGE(PG8_SA(0, 1), cA + hstepA, voffA);
        if (wr == 1) PG8_BAR;
        PG8_WAIT_V(4); PG8_BAR;
        PG8_STAGE(PG8_SB(1, 0), cB + kstep, voffB); PG8_STAGE(PG8_SA(1, 0), cA + kstep, voffA); PG8_STAGE(PG8_SB(1, 1), cB + hstep + kstep, voffB);
        PG8_WAIT_V(6); PG8_BAR;
    }
    for (;;) {
        const bool has_next = S.next(ui + 1, nxt);
        const char* nA = has_next ? (const char*)g.A + (size_t)nxt.pm * tstepA + nxt.ka : cA; const char* nB = has_next ? (const char*)g.Bt + (size_t)nxt.pnb * tstep + (Sched::SPLITK ? nxt.ka : 0) : cB;
        const int ntc = Sched::SPLITK ? cur.nt : nt;
        for (int t = 0; t < ntc; t += 2) {
            const bool last = (t == ntc - 2);
            const char* a1 = cA + (size_t)(t + 1) * kstep;
            const char* a2 = last ? nA : cA + (size_t)(t + 2) * kstep; const char* b2 = last ? nB : cB + (size_t)(t + 2) * kstep;
            const char* a3 = a2 + kstep; const char* b3 = b2 + kstep;
            if (last && has_next) S.a_ready(nxt);
            if constexpr (SP2) {
            PG8_LDB(B0, 0, 0); PG8_LDB(B1, 0, 1); PG8_SCHED; PG8_LDA(At, 0, 0); PG8_STAGE(PG8_SA(1, 1), a1 + hstepA, voffA);
            PG8_WAIT_V(8); PG8_WAIT_L(0); PG8_BAR; PG8_MMA(0, 0, At, B0); PG8_MMA(0, 1, At, B1); PG8_BAR; PG8_SCHED;
            PG8_LDA(At, 0, 1); PG8_STAGE(PG8_SB(0, 0), b2, voffB); PG8_STAGE(PG8_SB(0, 1), b2 + hstep, voffB); PG8_STAGE(PG8_SA(0, 0), a2, voffA);
            PG8_WAIT_V(8); PG8_WAIT_L(0); PG8_BAR; PG8_MMA(1, 0, At, B0); PG8_MMA(1, 1, At, B1); PG8_BAR; PG8_SCHED;
            PG8_LDB(B0, 1, 0); PG8_LDB(B1, 1, 1); PG8_SCHED; PG8_LDA(At, 1, 0); PG8_STAGE(PG8_SA(0, 1), a2 + hstepA, voffA);
            PG8_WAIT_V(8); PG8_WAIT_L(0); PG8_BAR; PG8_MMA(0, 0, At, B0); PG8_MMA(0, 1, At, B1); PG8_BAR; PG8_SCHED;
            PG8_LDA(At, 1, 1); PG8_STAGE(PG8_SB(1, 0), b3, voffB); PG8_STAGE(PG8_SB(1, 1), b3 + hstep, voffB); PG8_STAGE(PG8_SA(1, 0), a3, voffA);
            PG8_WAIT_V(8); PG8_WAIT_L(0); PG8_BAR; PG8_MMA(1, 0, At, B0); PG8_MMA(1, 1, At, B1); PG8_BAR; PG8_SCHED;
            } else {
            PG8_LDB(B0, 0, 0); PG8_SCHED; PG8_LDA(At, 0, 0); PG8_STAGE(PG8_SA(1, 1), a1 + hstepA, voffA);
            PG8_WAIT_L(8); PG8_BAR; PG8_WAIT_L(0); PG8_MMA(0, 0, At, B0); PG8_BAR; PG8_SCHED;
            PG8_LDB(B1, 0, 1); PG8_STAGE(PG8_SB(0, 0), b2, voffB);
            PG8_BAR; PG8_WAIT_L(0); PG8_MMA(0, 1, At, B1); PG8_BAR;
            PG8_LDA(At, 0, 1); PG8_STAGE(PG8_SA(0, 0), a2, voffA);
            PG8_BAR; PG8_WAIT_L(0); PG8_MMA(1, 0, At, B0); PG8_BAR; PG8_SCHED;
            PG8_STAGE(PG8_SB(0, 1), b2 + hstep, voffB);
            PG8_WAIT_V(6); PG8_BAR; PG8_MMA(1, 1, At, B1); PG8_BAR;
            PG8_LDB(B0, 1, 0); PG8_SCHED; PG8_LDA(At, 1, 0); PG8_STAGE(PG8_SA(0, 1), a2 + hstepA, voffA);
            PG8_WAIT_L(8); PG8_BAR; PG8_WAIT_L(0); PG8_MMA(0, 0, At, B0); PG8_BAR; PG8_SCHED;
            PG8_LDB(B1, 1, 1); PG8_STAGE(PG8_SB(1, 0), b3, voffB);
            PG8_BAR; PG8_WAIT_L(0); PG8_MMA(0, 1, At, B1); PG8_BAR;
            PG8_LDA(At, 1, 1); PG8_STAGE(PG8_SA(1, 0), a3, voffA);
            PG8_BAR; PG8_WAIT_L(0); PG8_MMA(1, 0, At, B0); PG8_BAR; PG8_SCHED;
            PG8_STAGE(PG8_SB(1, 1), b3 + hstep, voffB);
            PG8_WAIT_V(6); PG8_BAR; PG8_MMA(1, 1, At, B1); PG8_BAR;
            }
        }
        if constexpr (ALIGN_EPI) { if (wr == 0) PG8_BAR; }
        if constexpr (!Epi::AFTER_DRAIN) { E(acc, cur, wr, wc, fr, fq); S.done(cur); }
        if (!has_next) break;
#pragma unroll
        for (int a = 0; a < 2; ++a)
#pragma unroll
            for (int b = 0; b < 2; ++b)
#pragma unroll
                for (int m = 0; m < 4; ++m)
#pragma unroll
                    for (int n = 0; n < 2; ++n) acc[a][b][m][n] = (f32x4){0.f, 0.f, 0.f, 0.f};
        cur = nxt; cA = nA; cB = nB; ++ui;
        if constexpr (ALIGN_EPI) { if (wr == 1) PG8_BAR; }
    }
    PG8_WAIT_V(0);
    if constexpr (!ALIGN_EPI) { if (wr == 0) PG8_BAR; }
    PG8_BAR;
    if constexpr (Epi::AFTER_DRAIN) { E.fused(acc, cur, wr, wc, fr, fq, lds, wid, lane); S.done(cur); }
#undef PG8_SA
#undef PG8_SB
#undef PG8_STAGE
#undef PG8_LDA
#undef PG8_LDB
#undef PG8_MMA
#undef PG8_WAIT_V
#undef PG8_WAIT_L
#undef PG8_BAR
#undef PG8_SCHED
}
}
#include <hip/hip_bf16.h>
#include <cmath>
namespace attn_body {
using bf16=__hip_bfloat16;
using bf16x8=__attribute__((ext_vector_type(8)))short;
using s16x4=__attribute__((ext_vector_type(4)))short;
using f32x16=__attribute__((ext_vector_type(16)))float;
using u32x4=__attribute__((ext_vector_type(4)))unsigned;
constexpr int D=64,DM=1024,KP=128;
constexpr int NW=8,QBLK=32,QB=QBLK*NW,KVBLK=64;
constexpr int ATTN_PITCH=DM, ATTN_UNIT_ROWS=QB;
__device__ __forceinline__ int crow(int r,int hi){return (r&3)+8*(r>>2)+4*hi;}
#define SBAR() __builtin_amdgcn_sched_barrier(0)
__device__ __forceinline__ void cmask(f32x16&p0,f32x16&p1,int jb,int qrel,int hi){
  const float NEG=-INFINITY; int kb=64*jb+4*hi;
  #pragma unroll
  for(int r=0;r<16;++r){int kv=kb+(r&3)+8*(r>>2); if(kv>qrel)p0[r]=NEG; if(kv+32>qrel)p1[r]=NEG;}
}

constexpr int NSLOT=3, SLOTB=8192;
constexpr int LDS_K=0, LDS_V=NSLOT*SLOTB, LDS_WS=2*NSLOT*SLOTB, LDS_OST=LDS_WS+NW*64*4, LDS_BYTES=LDS_OST+NW*4096;
constexpr float C2=0.125f*1.4426950408889634f;
__device__ __forceinline__ void glds16(const void*gsrc,unsigned lds_dst){unsigned keep;
  asm volatile("s_mov_b32 %0, m0\n\ts_mov_b32 m0, %2\n\ts_nop 0\n\tglobal_load_lds_dwordx4 %1, off\n\ts_mov_b32 m0, %0":"=&s"(keep):"v"(gsrc),"s"(lds_dst):"memory");}
__device__ __forceinline__ float max3f(float a,float b,float c){float r;asm("v_max3_f32 %0, %1, %2, %3":"=v"(r):"v"(a),"v"(b),"v"(c));return r;}
__device__ __forceinline__ float max2f(float a,float b){float r;asm("v_max_f32_e32 %0, %1, %2":"=v"(r):"v"(a),"v"(b));return r;}
__device__ __forceinline__ float fadd_s(float a,float b){float r;asm("v_add_f32_e32 %0, %1, %2":"=v"(r):"v"(a),"v"(b));return r;}
__device__ __forceinline__ float fsub_s(float a,float b){float r;asm("v_sub_f32_e32 %0, %1, %2":"=v"(r):"v"(a),"v"(b));return r;}
typedef float f32x2_t __attribute__((ext_vector_type(2))); typedef __bf16 bf16x2_t __attribute__((ext_vector_type(2)));
__device__ __forceinline__ unsigned cvtpk_s(float lo,float hi){f32x2_t v={lo,hi};bf16x2_t b=__builtin_convertvector(v,bf16x2_t);return __builtin_bit_cast(unsigned,b);}
#define WAIT_BAR(N) asm volatile("s_waitcnt vmcnt(" #N ") lgkmcnt(0)\n\ts_barrier":::"memory")

__device__ __forceinline__ void qkt(f32x16&p0,f32x16&p1,const char*Kslot,const bf16x8*qr,const f32x16&negm,int r32,int hi){
  const char*kb=Kslot+hi*1024+r32*16;
  #pragma unroll
  for(int d0=0;d0<4;++d0){
    const bf16x8 b0=*reinterpret_cast<const bf16x8*>(kb+d0*2048);
    const bf16x8 b1=*reinterpret_cast<const bf16x8*>(kb+d0*2048+512);
    if(d0==0){p0=__builtin_amdgcn_mfma_f32_32x32x16_bf16(b0,qr[0],negm,0,0,0);p1=__builtin_amdgcn_mfma_f32_32x32x16_bf16(b1,qr[0],negm,0,0,0);}
    else{p0=__builtin_amdgcn_mfma_f32_32x32x16_bf16(b0,qr[d0],p0,0,0,0);p1=__builtin_amdgcn_mfma_f32_32x32x16_bf16(b1,qr[d0],p1,0,0,0);}}
}
typedef __attribute__((address_space(3))) const char* lds_cptr;
typedef short v4i16_t __attribute__((ext_vector_type(4)));
__device__ __forceinline__ void kload8(bf16x8*kf,lds_cptr kp){
  kf[0]=*(const __attribute__((address_space(3))) bf16x8*)(kp);      kf[1]=*(const __attribute__((address_space(3))) bf16x8*)(kp+512);
  kf[2]=*(const __attribute__((address_space(3))) bf16x8*)(kp+2048); kf[3]=*(const __attribute__((address_space(3))) bf16x8*)(kp+2560);
  kf[4]=*(const __attribute__((address_space(3))) bf16x8*)(kp+4096); kf[5]=*(const __attribute__((address_space(3))) bf16x8*)(kp+4608);
  kf[6]=*(const __attribute__((address_space(3))) bf16x8*)(kp+6144); kf[7]=*(const __attribute__((address_space(3))) bf16x8*)(kp+6656);
}
__device__ __forceinline__ void kload2(bf16x8*kf,lds_cptr kp,int j){ kf[2*j]=*(const __attribute__((address_space(3))) bf16x8*)(kp+j*2048); kf[2*j+1]=*(const __attribute__((address_space(3))) bf16x8*)(kp+j*2048+512); }
__device__ __forceinline__ s16x4 vtr(lds_cptr p){ return __builtin_bit_cast(s16x4,__builtin_amdgcn_ds_read_tr16_b64_v4i16((__attribute__((address_space(3))) v4i16_t*)p)); }
__device__ __forceinline__ float rowmax(const f32x16&p0,const f32x16&p1){
  float a=max3f(p0[0],p0[1],p1[0]),b=max3f(p0[2],p0[3],p1[1]);a=max3f(a,p1[2],p1[3]);
  #pragma unroll
  for(int r=4;r<16;r+=4){a=max3f(a,p0[r],p0[r+1]);b=max3f(b,p0[r+2],p0[r+3]);a=max3f(a,p1[r],p1[r+1]);b=max3f(b,p1[r+2],p1[r+3]);}
  const float m=max2f(a,b);
  auto rr=__builtin_amdgcn_permlane32_swap(__float_as_uint(m),__float_as_uint(m),false,false);
  return max2f(__uint_as_float(rr[0]),__uint_as_float(rr[1]));
}
__device__ __forceinline__ void pv(f32x16*o,int vb,bf16x8 pa0,bf16x8 pa1,bf16x8 pa2,bf16x8 pa3){
  #pragma unroll
  for(int d0=0;d0<2;++d0){s16x4 lo[4],hi[4];
    #pragma unroll
    for(int ks=0;ks<4;++ks){
      asm volatile("ds_read_b64_tr_b16 %0,%1 offset:%c2":"=&v"(lo[ks]):"v"(vb),"i"(d0*4096+ks*1024):"memory");
      asm volatile("ds_read_b64_tr_b16 %0,%1 offset:%c2":"=&v"(hi[ks]):"v"(vb),"i"(d0*4096+ks*1024+512):"memory");}
    asm volatile("s_waitcnt lgkmcnt(0)":::"memory");SBAR();
    #define PK(k) (bf16x8){lo[k][0],lo[k][1],lo[k][2],lo[k][3],hi[k][0],hi[k][1],hi[k][2],hi[k][3]}
    o[d0]=__builtin_amdgcn_mfma_f32_32x32x16_bf16(pa0,PK(0),o[d0],0,0,0);
    o[d0]=__builtin_amdgcn_mfma_f32_32x32x16_bf16(pa1,PK(1),o[d0],0,0,0);
    o[d0]=__builtin_amdgcn_mfma_f32_32x32x16_bf16(pa2,PK(2),o[d0],0,0,0);
    o[d0]=__builtin_amdgcn_mfma_f32_32x32x16_bf16(pa3,PK(3),o[d0],0,0,0);
    #undef PK
  }
}

#ifndef ATTN_STORE16
#define ATTN_STORE16(p,v) (*(u32x4*)(p)=(v))
#endif
template<int THRL> __device__ __forceinline__ void attn_unit(long qrow0,int hcol,long kvrow0,int kvcol,int NT,const bf16*Q,const bf16*__restrict__ K,const bf16*__restrict__ V,bf16*O,char*shm,const int wave_){
  const int tid=wave_*64+hw_lane(),lane=tid&63,r32=lane&31,hi=lane>>5; const int wid=wave_;
  const bf16*Qw=Q+(qrow0+wid*QBLK)*DM+hcol;
  const bf16*Kh=K+kvrow0*KP+kvcol,*Vh=V+kvrow0*KP+kvcol;
  const unsigned lds0=(unsigned)(uintptr_t)shm;
  float*wsf=(float*)(shm+LDS_WS)+wid*64;
  const bf16*ksrc=Kh+(long)lane*KP+wid*8;
  const bf16*vsrc=Vh+(long)(16*(wid&3)+(lane>>2))*KP+(wid>>2)*32+(lane&3)*8;
  const unsigned kdst=lds0+LDS_K+wid*1024, vdst=lds0+LDS_V+wid*1024;
  #define DMA_K(t,slot) glds16(ksrc+(long)(t)*KVBLK*KP,(unsigned)__builtin_amdgcn_readfirstlane(kdst+(slot)))
  #define DMA_V(t,slot) glds16(vsrc+(long)(t)*KVBLK*KP,(unsigned)__builtin_amdgcn_readfirstlane(vdst+(slot)))
  const int vb0=(int)(lds0+LDS_V)+((lane>>4)&1)*32+(lane&3)*8+(4*hi+((lane&15)>>2))*64;
  const char*Kbase=shm+LDS_K; bf16x8 kf[8];
  const lds_cptr shm3=(lds_cptr)shm; const lds_cptr kp0=shm3+LDS_K+hi*1024+r32*16; const lds_cptr vp0=shm3+LDS_V+((lane>>4)&1)*32+(lane&3)*8+(4*hi+((lane&15)>>2))*64;
  DMA_K(0,0);DMA_V(0,0);DMA_K(1,SLOTB);
  bf16x8 qr[4];
  #pragma unroll
  for(int d0=0;d0<4;++d0)qr[d0]=*reinterpret_cast<const bf16x8*>(&Qw[(long)r32*DM+d0*16+hi*8]);
  float mhat=0.f,l_reg=0.f;f32x16 o[2];o[0]=f32x16{};o[1]=f32x16{};f32x16 negm=f32x16{};asm volatile("":"+v"(negm));
  #define CMASK(P0,P1,t) do{}while(0)
  bool resc=false;
  #define START(P0,P1) do{ const float rm=rowmax(P0,P1); resc=false; \
    { const float dl=rm; mhat=fadd_s(mhat,dl); \
      _Pragma("unroll") for(int r=0;r<16;++r){P0[r]=fsub_s(P0[r],dl);P1[r]=fsub_s(P1[r],dl);} \
      _Pragma("unroll") for(int r=0;r<16;++r)negm[r]=-mhat; asm volatile("":"+v"(negm)); } \
    _Pragma("unroll") for(int r=0;r<16;++r)P0[r]=__builtin_amdgcn_exp2f(P0[r]); }while(0)
  #define RESC() do{ if(resc){ asm volatile("s_waitcnt lgkmcnt(0)":::"memory"); \
      _Pragma("unroll") for(int d_=0;d_<2;++d_) _Pragma("unroll") for(int r=0;r<16;++r)o[d_][r]*=wsf[crow(r,hi)]; } }while(0)
  f32x16 pA0,pA1,pB0,pB1;
  int sl_prev=0,sl_cur=0,sl_next=SLOTB;
  #define ROT() do{sl_prev=sl_cur;sl_cur=sl_next;sl_next=(sl_next==(NSLOT-1)*SLOTB)?0:sl_next+SLOTB;}while(0)
  DMA_K(2,2*SLOTB);
  WAIT_BAR(3);
  qkt(pA0,pA1,Kbase,qr,negm,r32,hi);asm volatile("s_nop 15\n\ts_nop 7":"+v"(pA0),"+v"(pA1));CMASK(pA0,pA1,0);
  START(pA0,pA1);
  _Pragma("unroll") for(int r=0;r<16;++r)pA1[r]=__builtin_amdgcn_exp2f(pA1[r]);
  WAIT_BAR(0);
  DMA_K(3,0);DMA_V(1,SLOTB);
  ROT();
  kload8(kf,kp0+sl_cur);
  WAIT_BAR(2);
  s16x4 vlo[8],vhi[8]; u32x4 pw0,pw1,pw2,pw3;
  #define PKW(P,B) cvtpk_s(P[B],P[B+1])
  #define PAF(k) __builtin_bit_cast(bf16x8,pw##k)
  #define VFR(i) (bf16x8){vlo[i][0],vlo[i][1],vlo[i][2],vlo[i][3],vhi[i][0],vhi[i][1],vhi[i][2],vhi[i][3]}
  #define PIN(x) asm volatile("":"+v"(x))
  #define MX3(a,b,c) __builtin_fmaxf(__builtin_fmaxf((a),(b)),(c))
  #define GAPA(MF,A0,A1,A2,A3,W0,W1,PW) do{ MF; sacc+=A0; sacc+=A1; sacc+=A2; sacc+=A3; PIN(sacc); W0; W1; PIN(PW); SBAR(); }while(0)
  #define EX(v) __builtin_amdgcn_exp2f(v)
  #define GAPB(MF,X,B) do{ MF; X[B]=EX(X[B]); X[B+1]=EX(X[B+1]); X[B+2]=EX(X[B+2]); X[B+3]=EX(X[B+3]); PIN(X); SBAR(); }while(0)
  #define VRD(i) do{ vlo[i]=vtr(vp_+(((i)>>2)*4096+((i)&3)*1024)); vhi[i]=vtr(vp_+(((i)>>2)*4096+((i)&3)*1024+512)); }while(0)
  #define KRD(G,j) do{ if(G){ kload2(kf,kp0+sl_next,j); SBAR(); } }while(0)
  #define STEP(C0,C1,P0,P1,t,GK,GV,GL) do{ SBAR(); \
    const lds_cptr vp_=vp0+sl_prev; \
    VRD(0); SBAR(); float sacc=(P0[0]+P0[1]); \
    GAPA(C0=__builtin_amdgcn_mfma_f32_32x32x16_bf16(kf[0],qr[0],negm,0,0,0), P0[2],P0[3],P0[4],P0[5],     pw0[0]=PKW(P0,0), pw0[1]=PKW(P0,2), pw0); \
    VRD(4); SBAR(); GAPA(C1=__builtin_amdgcn_mfma_f32_32x32x16_bf16(kf[1],qr[0],negm,0,0,0), P0[6],P0[7],P0[8],P0[9],     pw0[2]=PKW(P0,4), pw0[3]=PKW(P0,6), pw0); \
    VRD(1); SBAR(); GAPA(C0=__builtin_amdgcn_mfma_f32_32x32x16_bf16(kf[2],qr[1],C0,0,0,0),   P0[10],P0[11],P0[12],P0[13], pw1[0]=PKW(P0,8), pw1[1]=PKW(P0,10), pw1); \
    VRD(5); SBAR(); GAPA(C1=__builtin_amdgcn_mfma_f32_32x32x16_bf16(kf[3],qr[1],C1,0,0,0),   P0[14],P0[15],P1[0],P1[1],   pw1[2]=PKW(P0,12),pw1[3]=PKW(P0,14), pw1); \
    VRD(2); SBAR(); GAPA(C0=__builtin_amdgcn_mfma_f32_32x32x16_bf16(kf[4],qr[2],C0,0,0,0),   P1[2],P1[3],P1[4],P1[5],     pw2[0]=PKW(P1,0), pw2[1]=PKW(P1,2), pw2); \
    VRD(6); SBAR(); GAPA(C1=__builtin_amdgcn_mfma_f32_32x32x16_bf16(kf[5],qr[2],C1,0,0,0),   P1[6],P1[7],P1[8],P1[9],     pw2[2]=PKW(P1,4), pw2[3]=PKW(P1,6), pw2); \
    VRD(3); SBAR(); GAPA(C0=__builtin_amdgcn_mfma_f32_32x32x16_bf16(kf[6],qr[3],C0,0,0,0),   P1[10],P1[11],P1[12],P1[13], pw3[0]=PKW(P1,8), pw3[1]=PKW(P1,10), pw3); \
    VRD(7); SBAR(); GAPA(C1=__builtin_amdgcn_mfma_f32_32x32x16_bf16(kf[7],qr[3],C1,0,0,0),   P1[14],P1[15],0.f,0.f,       pw3[2]=PKW(P1,12),pw3[3]=PKW(P1,14), pw3); \
    l_reg+=sacc; \
    if(GK){DMA_K((t)+3,sl_cur);} if(GV){DMA_V((t)+1,sl_next);} \
    CMASK(C0,C1,t); \
    { float a=MX3(C0[0],C0[1],C1[0]),b=MX3(C0[2],C0[3],C1[1]); a=MX3(a,C1[2],C1[3]); \
      _Pragma("unroll") for(int r=4;r<16;r+=4){a=MX3(a,C0[r],C0[r+1]);b=MX3(b,C0[r+2],C0[r+3]);a=MX3(a,C1[r],C1[r+1]);b=MX3(b,C1[r+2],C1[r+3]);} \
      float rm=__builtin_fmaxf(a,b); { auto rr=__builtin_amdgcn_permlane32_swap(__float_as_uint(rm),__float_as_uint(rm),false,false); rm=__builtin_fmaxf(__uint_as_float(rr[0]),__uint_as_float(rr[1])); } \
      resc=false; \
      if(__builtin_expect(__any(rm>(float)THRL),0)){ const float dl=__builtin_fmaxf(rm,0.f); mhat+=dl; \
        _Pragma("unroll") for(int r=0;r<16;++r){C0[r]-=dl;C1[r]-=dl;} \
        _Pragma("unroll") for(int r=0;r<16;++r)negm[r]=-mhat; asm volatile("":"+v"(negm)); \
        const float f=__builtin_amdgcn_exp2f(-dl); l_reg*=f; if(hi==0)wsf[r32]=f; resc=true; } } \
    SBAR(); \
    GAPB(o[0]=__builtin_amdgcn_mfma_f32_32x32x16_bf16(PAF(0),VFR(0),o[0],0,0,0), C0,0); \
    GAPB(o[1]=__builtin_amdgcn_mfma_f32_32x32x16_bf16(PAF(0),VFR(4),o[1],0,0,0), C0,4); \
    KRD(GL,0); GAPB(o[0]=__builtin_amdgcn_mfma_f32_32x32x16_bf16(PAF(1),VFR(1),o[0],0,0,0), C0,8); \
    KRD(GL,1); GAPB(o[1]=__builtin_amdgcn_mfma_f32_32x32x16_bf16(PAF(1),VFR(5),o[1],0,0,0), C0,12); \
    KRD(GL,2); GAPB(o[0]=__builtin_amdgcn_mfma_f32_32x32x16_bf16(PAF(2),VFR(2),o[0],0,0,0), C1,0); \
    KRD(GL,3); GAPB(o[1]=__builtin_amdgcn_mfma_f32_32x32x16_bf16(PAF(2),VFR(6),o[1],0,0,0), C1,4); \
    GAPB(o[0]=__builtin_amdgcn_mfma_f32_32x32x16_bf16(PAF(3),VFR(3),o[0],0,0,0), C1,8); \
    GAPB(o[1]=__builtin_amdgcn_mfma_f32_32x32x16_bf16(PAF(3),VFR(7),o[1],0,0,0), C1,12); \
    }while(0)
  int t=1;
  #undef CMASK
  #define CMASK(P0,P1,t) do{}while(0)
  for(;t+5<NT;t+=2){
    STEP(pB0,pB1,pA0,pA1,t,true,true,true);     WAIT_BAR(2); RESC(); ROT();
    STEP(pA0,pA1,pB0,pB1,t+1,true,true,true);   WAIT_BAR(2); RESC(); ROT();
  }
  #undef CMASK
  #define CMASK(P0,P1,t) do{}while(0)
  #define ENDW(tt) do{ if((tt)+3<NT){WAIT_BAR(2);} else if((tt)+2<NT){WAIT_BAR(1);} else {WAIT_BAR(0);} }while(0)
  for(;t+1<NT;t+=2){
    STEP(pB0,pB1,pA0,pA1,t,(t+3<NT),(t+1<NT),(t+1<NT));       ENDW(t);   RESC(); ROT();
    STEP(pA0,pA1,pB0,pB1,t+1,(t+4<NT),(t+2<NT),(t+2<NT));     ENDW(t+1); RESC(); ROT();
  }
  STEP(pB0,pB1,pA0,pA1,NT-1,false,false,false); RESC();
  { float sacc=pB0[0]+pB0[1]; _Pragma("unroll") for(int r=2;r<16;++r)sacc+=pB0[r]; _Pragma("unroll") for(int r=0;r<16;++r)sacc+=pB1[r]; l_reg+=sacc;
    pw0=(u32x4){PKW(pB0,0),PKW(pB0,2),PKW(pB0,4),PKW(pB0,6)};pw1=(u32x4){PKW(pB0,8),PKW(pB0,10),PKW(pB0,12),PKW(pB0,14)};pw2=(u32x4){PKW(pB1,0),PKW(pB1,2),PKW(pB1,4),PKW(pB1,6)};pw3=(u32x4){PKW(pB1,8),PKW(pB1,10),PKW(pB1,12),PKW(pB1,14)};
    SBAR(); pv(o,vb0+sl_cur,PAF(0),PAF(1),PAF(2),PAF(3)); }
  #undef PKW
  #undef PAF
  #undef VFR
  #undef PIN
  #undef MX3
  #undef GAPA
  #undef GAPB
  #undef EX
  #undef VRD
  #undef KRD
  #undef STEP
  #undef ENDW
  {auto rr=__builtin_amdgcn_permlane32_swap(__float_as_uint(l_reg),__float_as_uint(l_reg),false,false);l_reg=__uint_as_float(rr[0])+__uint_as_float(rr[1]);}
  if(hi==0)wsf[32+r32]=l_reg;asm volatile("s_waitcnt lgkmcnt(0)":::"memory");
  float rli[16];
  #pragma unroll
  for(int r=0;r<16;++r)rli[r]=__builtin_amdgcn_rcpf(wsf[32+crow(r,hi)]);
  bf16*Ow=O+(qrow0+wid*QBLK)*DM+hcol;
  { bf16*stg=(bf16*)(shm+LDS_OST)+wid*2048;
    #pragma unroll
    for(int r=0;r<16;++r){const int orow=crow(r,hi);
      #pragma unroll
      for(int d0=0;d0<2;++d0)stg[orow*64+d0*32+r32]=__float2bfloat16(o[d0][r]*rli[r]);}
    asm volatile("s_waitcnt lgkmcnt(0)":::"memory");
    #pragma unroll
    for(int i=0;i<4;++i){const int row=i*8+(lane>>3),ch=lane&7; const u32x4 v=*(const u32x4*)(stg+row*64+ch*8); ATTN_STORE16(Ow+(long)row*DM+ch*8,v);} }
  asm volatile("s_waitcnt lgkmcnt(0)\n\ts_barrier":::"memory");
  #undef DMA_K
  #undef DMA_V
  #undef CMASK
  #undef START
  #undef RESC
  #undef ROT
}
constexpr int ATTN_LDS_BYTES=LDS_BYTES;
#undef SBAR
#undef WAIT_BAR
}
#define GAS __attribute__((address_space(1)))
#define LAS __attribute__((address_space(3)))
typedef unsigned short bf16;
typedef unsigned v4u __attribute__((ext_vector_type(4)));
typedef float f32x4 __attribute__((ext_vector_type(4)));
typedef short bf16x8 __attribute__((ext_vector_type(8)));
typedef GAS unsigned gu32;
typedef GAS unsigned long long gu64;
#define RLX_AGENT __ATOMIC_RELAXED, __HIP_MEMORY_SCOPE_AGENT
#define LDS_WAIT() asm volatile("s_waitcnt lgkmcnt(0)" ::: "memory")
#define VM_WAIT() asm volatile("s_waitcnt vmcnt(0)" ::: "memory")
__device__ __forceinline__ unsigned long long rt() { return __builtin_amdgcn_s_memrealtime(); }
__device__ __forceinline__ unsigned f2bf(float f) { unsigned u = __builtin_bit_cast(unsigned, f); return (u + 0x7fffu + ((u >> 16) & 1u)) >> 16; }
__device__ __forceinline__ unsigned pk2(float lo, float hi) { return f2bf(lo) | (f2bf(hi) << 16); }

#define XB_TMO      128
#define XB_XCNT(j)  (256  + 64 * (j))
#define XB_XSUB(j)  (1280 + 64 * (j))
#define XB_XGEN(j)  (2304 + 64 * (j))
#define XB_TOP      3328
#define XB_TOPGEN   3392
#define XCD_BAR_WORDS 3456
#define XB_SPIN_CAP (1u << 18)

__device__ __forceinline__ unsigned xb_ld(unsigned* p)              { return __hip_atomic_load(p, __ATOMIC_RELAXED, __HIP_MEMORY_SCOPE_AGENT); }
__device__ __forceinline__ unsigned xb_add(unsigned* p, unsigned v) { return __hip_atomic_fetch_add(p, v, __ATOMIC_RELAXED, __HIP_MEMORY_SCOPE_AGENT); }
__device__ __forceinline__ unsigned xb_xcc_id() { return (unsigned)__builtin_amdgcn_s_getreg((3 << 11) | 20) & 0xFu; }
#define XB_SPIN(cond, bar) do { unsigned _sp = 0; while (cond) { __builtin_amdgcn_s_sleep(1); \
    if ((++_sp & 255u) == 0u) { if (xb_ld(&(bar)[XB_TMO])) break; if (_sp > XB_SPIN_CAP) { atomicAdd(&(bar)[XB_TMO], 1u); break; } } } } while (0)

struct XcdBarrier {
    unsigned* bar; unsigned x; int wv;
    volatile LAS unsigned* st;
};

__device__ __forceinline__ XcdBarrier xcd_barrier_post(unsigned* bar, volatile LAS unsigned* st, int wv) {
    XcdBarrier b; b.bar = bar; b.x = xb_xcc_id(); b.st = st; b.wv = wv;
    if (threadIdx.x == 0) (void)xb_add(&bar[XB_XCNT(b.x)], 1u);
    return b;
}
__device__ __forceinline__ void xcd_barrier_complete(unsigned* bar, unsigned x, unsigned& nloc, unsigned& nx) {
    const unsigned G = gridDim.x * gridDim.y * gridDim.z;
    unsigned sum, cnt, mine, sp = 0u;
    for (;;) {
        sum = 0u; cnt = 0u; mine = 0u;
#pragma unroll
        for (unsigned j = 0; j < 16; ++j) { const unsigned c = xb_ld(&bar[XB_XCNT(j)]); sum += c; cnt += (c > 0u) ? 1u : 0u; mine = (j == x) ? c : mine; }
        if (sum == G) break;
        __builtin_amdgcn_s_sleep(1);
        if ((++sp & 255u) == 0u) { if (xb_ld(&bar[XB_TMO])) break; if (sp > XB_SPIN_CAP) { atomicAdd(&bar[XB_TMO], 1u); break; } }
    }
    nloc = mine > 0u ? mine : 1u; nx = cnt > 0u ? cnt : 1u;
}

__device__ __forceinline__ void xcd_barrier(const XcdBarrier& b) {
    asm volatile("s_waitcnt vmcnt(0)" ::: "memory");
    __syncthreads();
    if (b.wv == 0 && hw_lane() == 0) {
        unsigned* bar = b.bar;
        __builtin_amdgcn_s_waitcnt(0);
        unsigned nloc = b.st[0], nx = b.st[1];
        if (nloc == 0u) { xcd_barrier_complete(bar, b.x, nloc, nx); b.st[0] = nloc; b.st[1] = nx; }
        const unsigned old = xb_add(&bar[XB_XSUB(b.x)], 1u);
        const unsigned gen = old / nloc;
        if (old + 1u == (gen + 1u) * nloc) {
            __builtin_amdgcn_fence(__ATOMIC_RELEASE, "agent");
            asm volatile("s_waitcnt vmcnt(0)" ::: "memory");
            const unsigned og = xb_add(&bar[XB_TOP], 1u);
            const unsigned tg = og / nx;
            if (og + 1u == (tg + 1u) * nx) xb_add(&bar[XB_TOPGEN], 1u);
            else XB_SPIN(xb_ld(&bar[XB_TOPGEN]) == tg, bar);
            __builtin_amdgcn_fence(__ATOMIC_ACQUIRE, "agent");
            xb_add(&bar[XB_XGEN(b.x)], 1u);
            asm volatile("s_waitcnt vmcnt(0)" ::: "memory");
        } else {
            XB_SPIN(xb_ld(&bar[XB_XGEN(b.x)]) == gen, bar);
            __builtin_amdgcn_fence(__ATOMIC_ACQUIRE, "agent");
            asm volatile("s_waitcnt vmcnt(0)" ::: "memory");
        }
    }
    __syncthreads();
}

#ifndef PROBE
#define PROBE 0
#endif
#ifndef DEBUG_NAN
#define DEBUG_NAN 0
#endif
#ifndef TSEL
#define TSEL -1
#endif
#ifndef CYSEL
#define CYSEL -1
#endif
#ifndef TSCALE10
#define TSCALE10 0
#endif
#if TSEL >= 0
#define TS(k) do { if (blockIdx.x == 0 && F.wave == 0 && hw_lane() == 0) { unsigned long long* ts_ = (unsigned long long*)(F.ws + WS_CTL + 32768); const unsigned long long now_ = __builtin_amdgcn_s_memrealtime(); ts_[1 + (k)] += now_ - ts_[0]; ts_[0] = now_; } } while (0)
#else
#define TS(k) do {} while (0)
#endif
#ifndef USE_SEQ_SCAN
#define USE_SEQ_SCAN 0
#endif
constexpr int NWAVES = 8;
constexpr int DMODEL = 1024, NBATCH = 8, SEQL = 4096, CTXL = 256, DEPTH = 4;
constexpr int TL = NBATCH * SEQL, TC = NBATCH * CTXL, TT = TL + TC;
constexpr int KVLEN = SEQL + CTXL;
constexpr int INW = 2688, INWP = 2816, ATTIN = 768, SHIFTW = 1920;
constexpr int FFD = 2816, FFE = 3584, NEXP = 8;
constexpr int LORA_K = 384, LORA_N = 2560;
constexpr int MAXPANEL = 280, MAXSLOT = MAXPANEL * 256;
constexpr float RMS_EPS = 1e-6f, GN_EPS = 64e-5f;

constexpr size_t MiB = 1u << 20;
constexpr size_t WS_CTL = 0, CTL_ZERO_BYTES = 64 * 1024;
constexpr size_t WS_MOD = 1 * MiB;
constexpr size_t WS_ROPE = 2 * MiB;
constexpr size_t WS_ROUTE = 3 * MiB;
constexpr size_t RT_E = 0, RT_G = 160 * 1024, RT_S = 448 * 1024, RT_BLK = 768 * 1024, RT_WCNT = 800 * 1024;
constexpr size_t WS_XB = 12 * MiB;
constexpr size_t WS_WIN = 80 * MiB, WS_WOUT = 86 * MiB, WS_WLORA = 88 * MiB;
constexpr size_t WS_WFF = 100 * MiB;
constexpr size_t WS_WFF_D_DENSE = WS_WFF + 12 * MiB, WS_WFF_D_MOE = WS_WFF + 112 * MiB;
constexpr size_t WS_ACT = 270 * MiB;
constexpr size_t WS_QO = WS_ACT, WS_KB = WS_ACT + 68 * MiB, WS_VB = WS_ACT + 77 * MiB, WS_P = WS_ACT + 86 * MiB, WS_OSC = WS_P;
constexpr size_t WS_R = WS_ACT + 273 * MiB, WS_K = WS_ACT + 307 * MiB, WS_V = WS_ACT + 341 * MiB, WS_KK = WS_ACT + 375 * MiB, WS_LIN = WS_ACT + 409 * MiB;
constexpr size_t WS_LOUT = WS_ACT + 435 * MiB;
constexpr size_t WS_SPT = WS_WFF, WS_SG = WS_WFF + 68 * MiB, WS_SQ = WS_ACT + 605 * MiB;
constexpr size_t WS_HID = WS_ACT;
constexpr size_t WS_AG = WS_ACT, WS_AG8 = WS_ACT + 140 * MiB, WS_HIDM = WS_ACT + 210 * MiB;
constexpr size_t WS_WFF_D_MOE8 = WS_WFF + 56 * MiB;
constexpr float W8SCALE = 64.0f, H8SCALE = 8.0f, HID8SCALE = 4.0f;
constexpr size_t WS_SIDE = 1000 * MiB;
constexpr size_t WS_END = 1012 * MiB;
static_assert(WS_LOUT + (size_t)TT * LORA_N * 2 <= WS_END && WS_HIDM + (size_t)MAXSLOT * FFE <= WS_END && WS_P + (size_t)TT * INWP * 2 <= WS_R && WS_OSC + (size_t)2 * TT * 512 * 4 <= WS_R, "ws map");
static_assert(WS_WFF_D_MOE + (size_t)NEXP * 1024 * FFE * 2 <= WS_ACT && WS_XB + (size_t)TT * 1024 * 2 <= WS_WIN && WS_WIN + (size_t)INWP * 1024 * 2 <= WS_WOUT && WS_WLORA + (size_t)LORA_N * LORA_K * 2 <= WS_WFF, "ws map 2");
constexpr int CW_BAR = 4096;

constexpr int RING_OFF = 0, RING_BYTES = 131072;
constexpr int LDSCTL_OFF = RING_BYTES;
constexpr int MISC_OFF = LDSCTL_OFF;
constexpr int LT_PEXP = LDSCTL_OFF + 256;
constexpr int LT_NPAN = LT_PEXP + 320 * 4;
constexpr int LT_INP = LT_NPAN + 64;
constexpr int LT_TMP = LT_INP + 256;
constexpr int LDS_BYTES = 147456;
static_assert(LT_TMP + 8192 + 1024 <= LDS_BYTES, "LDS map");

struct Frame {
    LAS unsigned char* lds;
    volatile LAS unsigned* MISC;
    gu32* ctl;
    int tid, lane, wave, vcu, G;
    unsigned char* ws;
    float* out;
};
struct Args { const float* in[30]; float* out; unsigned char* ws; };
__device__ __forceinline__ const void* inp_ld(const Frame& F, int k) {
    const LAS unsigned* t = (const LAS unsigned*)(F.lds + LT_INP) + 2 * k; unsigned lo = t[0], hi = t[1];
    lo = __builtin_amdgcn_readfirstlane(lo); hi = __builtin_amdgcn_readfirstlane(hi);
    return (const void*)(const GAS void*)(((unsigned long long)hi << 32) | lo);
}
#define IN_X 0
#define IN_C 1
#define IN_CTX 2
#define IN_CCTX 3
#define IN_ADAW 4
#define IN_ADAB 5
#define IN_N1G 6
#define IN_N2G 7
#define IN_WIN 8
#define IN_WOUT 9
#define IN_QG 10
#define IN_KG 11
#define IN_MU 12
#define IN_W0 13
#define IN_W2 14
#define IN_A0 15
#define IN_A2 16
#define IN_G2 17
#define IN_KKW 18
#define IN_KA 19
#define IN_RK 20
#define IN_GNW 21
#define IN_GNB 22
#define IN_FWG 23
#define IN_FWU 24
#define IN_FWD 25
#define IN_ROUTER 26
#define IN_MWG 27
#define IN_MWU 28
#define IN_MWD 29

__device__ __forceinline__ int vlaunder(int v) { asm volatile("" : "+v"(v)); return v; }
__device__ __forceinline__ unsigned char* launder(unsigned char* p) { unsigned long long v = (unsigned long long)p; asm volatile("" : "+s"(v)); return (unsigned char*)(GAS unsigned char*)v; }
#define INP(k) ((const float*)inp_ld(F, (k)))
__device__ __forceinline__ const void* inp_ld(const struct Frame& F, int k);
__device__ __forceinline__ float wave_sum(float v) {
#pragma unroll
    for (int o = 1; o < 64; o <<= 1) v += __shfl_xor(v, o);
    return v;
}
__device__ __forceinline__ float half_sum(float v) {
#pragma unroll
    for (int o = 1; o < 32; o <<= 1) v += __shfl_xor(v, o);
    return v;
}
__device__ __forceinline__ float bflo(unsigned w) { return __builtin_bit_cast(float, w << 16); }
__device__ __forceinline__ float bfhi(unsigned w) { return __builtin_bit_cast(float, w & 0xffff0000u); }
typedef float f32x2_t_ __attribute__((ext_vector_type(2))); typedef __bf16 bf16x2_t_ __attribute__((ext_vector_type(2)));
__device__ __forceinline__ unsigned pkbf(float lo, float hi) { f32x2_t_ v = {lo, hi}; bf16x2_t_ b = __builtin_convertvector(v, bf16x2_t_); return __builtin_bit_cast(unsigned, b); }
__device__ __forceinline__ float sigm(float x) { return __builtin_amdgcn_rcpf(1.0f + __builtin_amdgcn_exp2f(-1.4426950408889634f * x)); }

__device__ __forceinline__ void p_prologue(Frame& F, const Args& A) {
    unsigned char* const ws = launder(F.ws);
    const int tid = (F.wave * 64 + hw_lane()), lane = tid & 63; (void)lane;
    LAS float* sc = (LAS float*)(F.lds + RING_OFF);
    for (int i = tid; i < 9 * 1024; i += NWAVES * 64) { const int b = i >> 10, k = i & 1023; const float v = (b < 8) ? INP(IN_C)[b * 1024 + k] : INP(IN_CCTX)[k]; sc[i] = v * sigm(v); }
    __syncthreads();
    const int gw = F.vcu * NWAVES + F.wave, NGW = F.G * NWAVES;
    float* mod = (float*)(ws + WS_MOD);
    for (int it = (int)blockIdx.x + F.G * F.wave; it < DEPTH * 96; it += NGW) {
        const int l = it / 96, j = (it % 96) * 64 + lane;
        const float* W = INP(IN_ADAW) + (size_t)l * 1024 * 6144 + j;
        float acc[9];
#pragma unroll
        for (int b = 0; b < 9; ++b) acc[b] = 0.f;
        for (int k = 0; k < 1024; k += 16) {
            float wv[16];
#pragma unroll
            for (int u = 0; u < 16; ++u) wv[u] = W[(size_t)(k + u) * 6144];
#pragma unroll
            for (int b = 0; b < 9; ++b)
#pragma unroll
                for (int u4 = 0; u4 < 4; ++u4) { const f32x4 s = *(const LAS f32x4*)(sc + b * 1024 + k + 4 * u4); acc[b] += (s[0] * wv[4 * u4] + s[1] * wv[4 * u4 + 1]) + (s[2] * wv[4 * u4 + 2] + s[3] * wv[4 * u4 + 3]); }
        }
        const float bias = INP(IN_ADAB)[l * 6144 + j];
#pragma unroll
        for (int b = 0; b < 9; ++b) mod[((size_t)l * 9 + b) * 6144 + j] = acc[b] + bias;
    }
    float* cs = (float*)(ws + WS_ROPE);
    for (int i = blockIdx.x * (NWAVES * 64) + tid; i < 4096 * 32; i += F.G * NWAVES * 64) {
        const int t = i >> 5, k = i & 31; const int pos = (k < 16) ? (t >> 6) : (t & 63);
        const float inv = powf(10000.0f, -(float)(2 * (k & 15)) / 32.0f); const float ang = (float)pos * inv;
        float s, c; sincosf(ang, &s, &c); cs[2 * i] = c; cs[2 * i + 1] = s;
    }
    __syncthreads();
}

struct WItem { const float* W; unsigned char* WT; int K, N, k0, n0, drow0, f8; };
__device__ __forceinline__ void tr_load(const WItem& w, float (&tv)[32], int lane) {
#pragma unroll
    for (int i = 0; i < 32; ++i) tv[i] = w.W[(size_t)(w.k0 + 2 * i + (lane >> 5)) * w.N + w.n0 + (lane & 31)];
}
__device__ __forceinline__ void tr_finish(const WItem& w, const float (&tv)[32], LAS float* scr, int lane) {
#pragma unroll
    for (int i = 0; i < 32; ++i) scr[(2 * i + (lane >> 5)) * 33 + (lane & 31)] = tv[i];
    LDS_WAIT(); asm volatile("" ::: "memory");
    if (w.f8) { const int c = lane & 3;
#pragma unroll
        for (int j = 0; j < 2; ++j) { const int n = (lane >> 2) + 16 * j; const LAS float* s = scr + (16 * c) * 33 + n;
            v4u o;
            o.x = pg8::pk_fp8x4(s[0 * 33] * W8SCALE, s[1 * 33] * W8SCALE, s[2 * 33] * W8SCALE, s[3 * 33] * W8SCALE); o.y = pg8::pk_fp8x4(s[4 * 33] * W8SCALE, s[5 * 33] * W8SCALE, s[6 * 33] * W8SCALE, s[7 * 33] * W8SCALE);
            o.z = pg8::pk_fp8x4(s[8 * 33] * W8SCALE, s[9 * 33] * W8SCALE, s[10 * 33] * W8SCALE, s[11 * 33] * W8SCALE); o.w = pg8::pk_fp8x4(s[12 * 33] * W8SCALE, s[13 * 33] * W8SCALE, s[14 * 33] * W8SCALE, s[15 * 33] * W8SCALE);
            *(v4u*)(w.WT + (size_t)(w.drow0 + n) * w.K + w.k0 + 16 * c) = o; }
    } else { const int c = lane & 7;
#pragma unroll
        for (int j = 0; j < 4; ++j) { const int n = (lane >> 3) + 8 * j; const LAS float* s = scr + (8 * c) * 33 + n;
            v4u o; o.x = pkbf(s[0 * 33], s[1 * 33]); o.y = pkbf(s[2 * 33], s[3 * 33]); o.z = pkbf(s[4 * 33], s[5 * 33]); o.w = pkbf(s[6 * 33], s[7 * 33]);
            *(v4u*)((bf16*)w.WT + (size_t)(w.drow0 + n) * w.K + w.k0 + 8 * c) = o; } }
    LDS_WAIT(); asm volatile("" ::: "memory");
}
__device__ __forceinline__ int gu_row(int n) { return 256 * (n >> 7) + (n & 127); }

__device__ __forceinline__ WItem wprep_decode(Frame& F, unsigned char* const ws, const int l, const int it) {
    constexpr int I_IN = 16 * (INW / 32), I_OUT = 16 * 32;
    const bool moe = (l & 1) != 0; const int j = l >> 1;
    constexpr int I_DG = 16 * (FFD / 32), I_MG = 16 * (FFE / 32);
    int r = it; WItem w;
    if (r < I_IN) { const int nb = r % (INW / 32), kb = r / (INW / 32); w = WItem{INP(IN_WIN) + (size_t)l * 1024 * INW, ws + WS_WIN, 1024, INW, kb * 64, nb * 32, nb * 32, 0}; return w; } r -= I_IN;
    if (r < I_OUT) { const int nb = r % 32, kb = r / 32; w = WItem{INP(IN_WOUT) + (size_t)l * 1024 * 1024, ws + WS_WOUT, 1024, 1024, kb * 64, nb * 32, nb * 32, 0}; return w; } r -= I_OUT;
    if (!moe) {
        if (r < I_DG) { const int nb = r % (FFD / 32), kb = r / (FFD / 32); w = WItem{INP(IN_FWG) + (size_t)j * 1024 * FFD, ws + WS_WFF, 1024, FFD, kb * 64, nb * 32, gu_row(nb * 32), 0}; return w; } r -= I_DG;
        if (r < I_DG) { const int nb = r % (FFD / 32), kb = r / (FFD / 32); w = WItem{INP(IN_FWU) + (size_t)j * 1024 * FFD, ws + WS_WFF, 1024, FFD, kb * 64, nb * 32, gu_row(nb * 32) + 128, 0}; return w; } r -= I_DG;
        { const int nb = r % 32, kb = r / 32; w = WItem{INP(IN_FWD) + (size_t)j * FFD * 1024, ws + WS_WFF_D_DENSE, FFD, 1024, kb * 64, nb * 32, nb * 32, 0}; return w; }
    }
    constexpr int I_MD = (FFE / 64) * 32; constexpr int PER = 2 * I_MG + I_MD; const int e = r / PER; r -= e * PER;
    unsigned char* WGU = ws + WS_WFF + (size_t)e * (2 * FFE) * 1024; unsigned char* WD = ws + WS_WFF_D_MOE8 + (size_t)e * 1024 * FFE;
    const size_t eo = ((size_t)j * NEXP + e) * 1024 * FFE;
    if (r < I_MG) { const int nb = r % (FFE / 32), kb = r / (FFE / 32); w = WItem{INP(IN_MWG) + eo, WGU, 1024, FFE, kb * 64, nb * 32, gu_row(nb * 32), 1}; return w; } r -= I_MG;
    if (r < I_MG) { const int nb = r % (FFE / 32), kb = r / (FFE / 32); w = WItem{INP(IN_MWU) + eo, WGU, 1024, FFE, kb * 64, nb * 32, gu_row(nb * 32) + 128, 1}; return w; } r -= I_MG;
    { const int nb = r % 32, kb = r / 32; w = WItem{INP(IN_MWD) + eo, WD, FFE, 1024, kb * 64, nb * 32, nb * 32, 1}; return w; }
}
__device__ __forceinline__ void p_wprep(Frame& F, const Args& A, int l, int part, gu32* ctr = nullptr) {
    unsigned char* const ws = launder(F.ws);
    const int tid = (F.wave * 64 + hw_lane()), lane = tid & 63; (void)lane;
    LAS float* scr = (LAS float*)(F.lds + RING_OFF + F.wave * 16384);
    const int gw = F.vcu * NWAVES + F.wave, NGW = F.G * NWAVES;
    bf16* WIN = (bf16*)(ws + WS_WIN); bf16* WLORA = (bf16*)(ws + WS_WLORA);
    constexpr int I_IN = 16 * (INW / 32), I_OUT = 16 * 32;
    const bool moe = (l & 1) != 0;
    constexpr int I_DG = 16 * (FFD / 32), I_DD = (FFD / 64) * 32, I_MG = 16 * (FFE / 32), I_MD = (FFE / 64) * 32;
    const int nff = moe ? NEXP * (2 * I_MG + I_MD) : (2 * I_DG + I_DD);
    const int NIT = I_IN + I_OUT + nff;
    const int lo = part ? I_IN + I_OUT : 0, hi = part ? NIT : I_IN + I_OUT;
    (void)ctr;
    {
        int it = lo + gw; WItem wa, wb; float ta[32], tb[32];
        if (it < hi) { wa = wprep_decode(F, ws, l, it); tr_load(wa, ta, lane); }
        for (; it < hi; it += 2 * NGW) {
            const int i2 = it + NGW, i3 = i2 + NGW;
            if (i2 < hi) { wb = wprep_decode(F, ws, l, i2); tr_load(wb, tb, lane); }
            tr_finish(wa, ta, scr, lane);
            if (i3 < hi) { wa = wprep_decode(F, ws, l, i3); tr_load(wa, ta, lane); }
            if (i2 < hi) tr_finish(wb, tb, scr, lane);
        }
    }
    if (part) return;
    for (int i = blockIdx.x * (NWAVES * 64) + tid; i < 16384; i += F.G * NWAVES * 64) ((v4u*)(WIN + (size_t)INW * 1024))[i] = (v4u){0u, 0u, 0u, 0u};
    const float* w2 = INP(IN_W2) + (size_t)l * 2 * 64 * 512; const float* a2 = INP(IN_A2) + (size_t)l * 2 * 64 * 512; const float* g2 = INP(IN_G2) + (size_t)l * 128 * 512;
    for (int i = blockIdx.x * (NWAVES * 64) + tid; i < LORA_N * 64; i += F.G * NWAVES * 64) {
        const int n = i >> 6, k = (i & 63) * 2; const int sec = n >> 9, cn = n & 511;
        float v0 = 0.f, v1 = 0.f;
        if (sec < 2) { const int kk = k - 64 * sec; if (kk >= 0 && kk < 64) { v0 = w2[((size_t)sec * 64 + kk) * 512 + cn]; v1 = w2[((size_t)sec * 64 + kk + 1) * 512 + cn]; } }
        else if (sec < 4) { const int d = sec - 2, kk = k - 64 * d; if (kk >= 0 && kk < 64) { v0 = a2[((size_t)d * 64 + kk) * 512 + cn]; v1 = a2[((size_t)d * 64 + kk + 1) * 512 + cn]; } }
        else { v0 = g2[(size_t)k * 512 + cn]; v1 = g2[(size_t)(k + 1) * 512 + cn]; }
        ((unsigned*)WLORA)[i] = pkbf(v0, v1);
    }
}

template <bool ROUTER, bool COMBINE, bool SRCF32, bool SIDE = false>
__device__ __forceinline__ void p_norm(Frame& F, const Args& A, int l, int which, const float* srcL, const float* srcC, int lprev, int nrows = TT) {
    unsigned char* const ws = launder(F.ws);
    const int tid = (F.wave * 64 + hw_lane()), lane = tid & 63; (void)lane;
    const int gw = F.vcu * NWAVES + F.wave, NGW = F.G * NWAVES;
    const float* mod = (const float*)(ws + WS_MOD) + (size_t)l * 9 * 6144;
    const float* gain = A.in[which ? IN_N2G : IN_N1G] + l * 1024;
    bf16* H = (bf16*)F.out;
    const float* route_g = (const float*)(ws + WS_ROUTE + RT_G); const int* route_s = (const int*)(ws + WS_ROUTE + RT_S);
    int cnt0 = 0, cnt1 = 0, cnt2 = 0, cnt3 = 0, cnt4 = 0, cnt5 = 0, cnt6 = 0, cnt7 = 0;
    LAS float* rwl = (LAS float*)(F.lds + RING_OFF);
    if (ROUTER) {
        __syncthreads();
        const float* rw = INP(IN_ROUTER) + (size_t)(l >> 1) * 1024 * 8;
        for (int i = tid; i < 2048; i += NWAVES * 64) { const f32x4 w = *(const f32x4*)(rw + 4 * i); const int col = i >> 1, e4 = (i & 1) * 4, jj = col >> 8, ln = (col & 255) >> 2, q = col & 3;
            *(LAS f32x4*)(rwl + (((jj * 4 + q) * 64 + ln) * 8 + e4)) = w; }
        __syncthreads();
    }
    uint2 nx[2][4]; f32x4 nf[2][4]; float cg[2][2]; int cs[2][2];
#pragma unroll
    for (int r = 0; r < 2; ++r) { cg[r][0] = cg[r][1] = 0.f; cs[r][0] = cs[r][1] = 0;
#pragma unroll
        for (int jj = 0; jj < 4; ++jj) { nx[r][jj] = make_uint2(0u, 0u); nf[r][jj] = (f32x4){0.f, 0.f, 0.f, 0.f}; } }
#define PN_LOAD(r_, row_) do { const int row__ = (row_); if (row__ < nrows) { \
        if (SRCF32) { const float* xr_ = (row__ < TL) ? srcL + (size_t)row__ * 1024 : srcC + (size_t)(row__ - TL) * 1024; _Pragma("unroll") for (int jj = 0; jj < 4; ++jj) nf[r_][jj] = *(const f32x4*)(xr_ + 4 * ln + 256 * jj); } \
        else { const bf16* xr_ = (const bf16*)(ws + WS_XB) + (size_t)row__ * 1024; _Pragma("unroll") for (int jj = 0; jj < 4; ++jj) nx[r_][jj] = *(const uint2*)(xr_ + 4 * ln + 256 * jj); } \
        if (COMBINE) { cg[r_][0] = route_g[2 * row__]; cg[r_][1] = route_g[2 * row__ + 1]; cs[r_][0] = route_s[2 * row__]; cs[r_][1] = route_s[2 * row__ + 1]; } } } while (0)
    int ln = vlaunder(lane);
    PN_LOAD(0, gw); PN_LOAD(1, gw + NGW);
    for (int row0 = gw; row0 < nrows; row0 += 2 * NGW) {
        ln = vlaunder(lane);
        const bool ok1 = row0 + NGW < nrows;
        f32x4 v[2][4]; float g0[2], g1[2]; int s0[2], s1[2];
#pragma unroll
        for (int r = 0; r < 2; ++r) { g0[r] = cg[r][0]; g1[r] = cg[r][1]; s0[r] = cs[r][0]; s1[r] = cs[r][1];
#pragma unroll
            for (int jj = 0; jj < 4; ++jj) { if (SRCF32) v[r][jj] = nf[r][jj]; else { const uint2 w = nx[r][jj]; v[r][jj] = (f32x4){bflo(w.x), bfhi(w.x), bflo(w.y), bfhi(w.y)}; } } }
        PN_LOAD(0, row0 + 2 * NGW); PN_LOAD(1, row0 + 3 * NGW);
        if (COMBINE) {
            const bf16* Y = (const bf16*)(ws + WS_AG);
            uint2 yy0[2][4], yy1[2][4];
#pragma unroll
            for (int r = 0; r < 2; ++r)
#pragma unroll
                for (int jj = 0; jj < 4; ++jj) { const int col = 4 * ln + 256 * jj; yy0[r][jj] = *(const uint2*)(Y + (size_t)s0[r] * 1024 + col); yy1[r][jj] = *(const uint2*)(Y + (size_t)s1[r] * 1024 + col); }
#pragma unroll
            for (int r = 0; r < 2; ++r) { const int row = row0 + r * NGW; const int bsel = (row < TL) ? (row >> 12) : 8;
                const float* m5 = (const float*)(ws + WS_MOD) + ((size_t)lprev * 9 + bsel) * 6144 + 5 * 1024;
                bf16* xbr = (bf16*)(ws + WS_XB) + (size_t)row * 1024;
#pragma unroll
                for (int jj = 0; jj < 4; ++jj) { const int col = 4 * ln + 256 * jj;
                    const uint2 y0 = yy0[r][jj], y1 = yy1[r][jj]; const f32x4 mm = *(const f32x4*)(m5 + col);
                    v[r][jj][0] += mm[0] * (g0[r] * bflo(y0.x) + g1[r] * bflo(y1.x)); v[r][jj][1] += mm[1] * (g0[r] * bfhi(y0.x) + g1[r] * bfhi(y1.x));
                    v[r][jj][2] += mm[2] * (g0[r] * bflo(y0.y) + g1[r] * bflo(y1.y)); v[r][jj][3] += mm[3] * (g0[r] * bfhi(y0.y) + g1[r] * bfhi(y1.y));
                    if (r == 0 || ok1) *(uint2*)(xbr + col) = make_uint2(pkbf(v[r][jj][0], v[r][jj][1]), pkbf(v[r][jj][2], v[r][jj][3])); } }
        }
        if (SIDE) {
#pragma unroll
            for (int r = 0; r < 2; ++r) { const int row = row0 + r * NGW;
                if ((r == 0 || ok1) && row >= TL) {
                    const bf16* sd = (const bf16*)(ws + WS_SIDE) + (size_t)(row - TL) * 1024; bf16* xbr = (bf16*)(ws + WS_XB) + (size_t)row * 1024;
                    uint2 sv[3][4];
#pragma unroll
                    for (int q = 0; q < 3; ++q)
#pragma unroll
                        for (int jj = 0; jj < 4; ++jj) sv[q][jj] = *(const uint2*)(sd + (size_t)q * TC * 1024 + 4 * ln + 256 * jj);
#pragma unroll
                    for (int jj = 0; jj < 4; ++jj) {
#pragma unroll
                        for (int q = 0; q < 3; ++q) { const uint2 w = sv[q][jj]; v[r][jj][0] += bflo(w.x); v[r][jj][1] += bfhi(w.x); v[r][jj][2] += bflo(w.y); v[r][jj][3] += bfhi(w.y); }
                        *(uint2*)(xbr + 4 * ln + 256 * jj) = make_uint2(pkbf(v[r][jj][0], v[r][jj][1]), pkbf(v[r][jj][2], v[r][jj][3])); } } }
        }
        float ss[2];
#pragma unroll
        for (int r = 0; r < 2; ++r) { ss[r] = 0.f;
#pragma unroll
            for (int jj = 0; jj < 4; ++jj) ss[r] += (v[r][jj][0] * v[r][jj][0] + v[r][jj][1] * v[r][jj][1]) + (v[r][jj][2] * v[r][jj][2] + v[r][jj][3] * v[r][jj][3]); }
#pragma unroll
        for (int o = 1; o < 64; o <<= 1) { const float t0 = __shfl_xor(ss[0], o), t1 = __shfl_xor(ss[1], o); ss[0] += t0; ss[1] += t1; }
        float rstd[2]; const float* shp[2];
#pragma unroll
        for (int r = 0; r < 2; ++r) { const int row = row0 + r * NGW; const int bsel = (row < TL) ? (row >> 12) : 8;
            rstd[r] = 1.0f / sqrtf(ss[r] * (1.0f / 1024.0f) + RMS_EPS); shp[r] = mod + (size_t)bsel * 6144 + (which ? 3 : 0) * 1024; }
        float lg[2][8];
#pragma unroll
        for (int r = 0; r < 2; ++r)
#pragma unroll
            for (int e = 0; e < 8; ++e) lg[r][e] = 0.f;
#pragma unroll
        for (int jj = 0; jj < 4; ++jj) { const int col = 4 * ln + 256 * jj;
            const f32x4 gg = *(const f32x4*)(gain + col); f32x4 h[2];
#pragma unroll
            for (int r = 0; r < 2; ++r) { const int row = row0 + r * NGW;
                const f32x4 sh = *(const f32x4*)(shp[r] + col), sc = *(const f32x4*)(shp[r] + 1024 + col);
                h[r] = (v[r][jj] * rstd[r]) * gg * (sc + 1.0f) + sh;
                if (r == 0 || ok1) {
                    if (ROUTER) *(unsigned*)((unsigned char*)H + (size_t)row * 1024 + col) = pg8::pk_fp8x4(h[r][0] * H8SCALE, h[r][1] * H8SCALE, h[r][2] * H8SCALE, h[r][3] * H8SCALE);
                    else { uint2 o; o.x = pkbf(h[r][0], h[r][1]); o.y = pkbf(h[r][2], h[r][3]); *(uint2*)(H + (size_t)row * 1024 + col) = o; } } }
            if (ROUTER) {
#pragma unroll
                for (int q = 0; q < 4; ++q) { const LAS float* rp = rwl + ((jj * 4 + q) * 64 + ln) * 8; const f32x4 ra = *(const LAS f32x4*)rp, rb = *(const LAS f32x4*)(rp + 4);
#pragma unroll
                    for (int r = 0; r < 2; ++r) { lg[r][0] += h[r][q] * ra[0]; lg[r][1] += h[r][q] * ra[1]; lg[r][2] += h[r][q] * ra[2]; lg[r][3] += h[r][q] * ra[3];
                        lg[r][4] += h[r][q] * rb[0]; lg[r][5] += h[r][q] * rb[1]; lg[r][6] += h[r][q] * rb[2]; lg[r][7] += h[r][q] * rb[3]; } } }
        }
        if (ROUTER) {
#pragma unroll
            for (int o = 1; o < 64; o <<= 1) { float t[2][8];
#pragma unroll
                for (int r = 0; r < 2; ++r)
#pragma unroll
                    for (int e = 0; e < 8; ++e) t[r][e] = __shfl_xor(lg[r][e], o);
#pragma unroll
                for (int r = 0; r < 2; ++r)
#pragma unroll
                    for (int e = 0; e < 8; ++e) lg[r][e] += t[r][e]; }
#pragma unroll
            for (int r = 0; r < 2; ++r) { const int row = row0 + r * NGW;
                if (r == 0 || ok1) {
                    int e0 = 0; float v0 = lg[r][0];
#pragma unroll
                    for (int e = 1; e < 8; ++e) if (lg[r][e] > v0) { v0 = lg[r][e]; e0 = e; }
                    int e1 = -1; float v1 = -INFINITY;
#pragma unroll
                    for (int e = 0; e < 8; ++e) if (e != e0 && lg[r][e] > v1) { v1 = lg[r][e]; e1 = e; }
                    const float q0 = 1.0f / (1.0f + __expf(v1 - v0)), q1 = 1.0f - q0;
                    if (ln == 0) { ((int*)(ws + WS_ROUTE + RT_E))[row] = e0 | (e1 << 8); ((float*)(ws + WS_ROUTE + RT_G))[2 * row] = q0; ((float*)(ws + WS_ROUTE + RT_G))[2 * row + 1] = q1; }
                    cnt0 += (e0 == 0) + (e1 == 0); cnt1 += (e0 == 1) + (e1 == 1); cnt2 += (e0 == 2) + (e1 == 2); cnt3 += (e0 == 3) + (e1 == 3);
                    cnt4 += (e0 == 4) + (e1 == 4); cnt5 += (e0 == 5) + (e1 == 5); cnt6 += (e0 == 6) + (e1 == 6); cnt7 += (e0 == 7) + (e1 == 7); } }
        }
    }
#undef PN_LOAD
    if (ROUTER) {
        int* wcnt = (int*)(ws + WS_ROUTE + RT_WCNT);
        if (ln == 0) { int* w = wcnt + (size_t)gw * 8; w[0] = cnt0; w[1] = cnt1; w[2] = cnt2; w[3] = cnt3; w[4] = cnt4; w[5] = cnt5; w[6] = cnt6; w[7] = cnt7; }
    }
}
__device__ __forceinline__ void p_final_combine(Frame& F, int lprev) {
    unsigned char* const ws = launder(F.ws);
    const int tid = (F.wave * 64 + hw_lane()), lane = tid & 63; (void)lane;
    const int gw = F.vcu * NWAVES + F.wave, NGW = F.G * NWAVES;
    const float* route_g = (const float*)(ws + WS_ROUTE + RT_G); const int* route_s = (const int*)(ws + WS_ROUTE + RT_S);
    const bf16* Y = (const bf16*)(ws + WS_AG);
    float g0n = 0.f, g1n = 0.f; int s0n = 0, s1n = 0;
    if (gw < TL) { g0n = route_g[2 * gw]; g1n = route_g[2 * gw + 1]; s0n = route_s[2 * gw]; s1n = route_s[2 * gw + 1]; }
    for (int row = gw; row < TL; row += NGW) {
        const int bsel = row >> 12;
        const float* m5 = (const float*)(ws + WS_MOD) + ((size_t)lprev * 9 + bsel) * 6144 + 5 * 1024;
        const float g0 = g0n, g1 = g1n; const int s0 = s0n, s1 = s1n;
        float* xw = F.out + (size_t)row * 1024; const bf16* xbr = (const bf16*)(ws + WS_XB) + (size_t)row * 1024;
        uint2 xw2[4], y0[4], y1[4];
#pragma unroll
        for (int jj = 0; jj < 4; ++jj) { const int col = 4 * lane + 256 * jj; xw2[jj] = *(const uint2*)(xbr + col); y0[jj] = *(const uint2*)(Y + (size_t)s0 * 1024 + col); y1[jj] = *(const uint2*)(Y + (size_t)s1 * 1024 + col); }
        if (row + NGW < TL) { const int rn = row + NGW; g0n = route_g[2 * rn]; g1n = route_g[2 * rn + 1]; s0n = route_s[2 * rn]; s1n = route_s[2 * rn + 1]; }
#pragma unroll
        for (int jj = 0; jj < 4; ++jj) { const int col = 4 * lane + 256 * jj; const f32x4 mm = *(const f32x4*)(m5 + col);
            f32x4 v = (f32x4){bflo(xw2[jj].x), bfhi(xw2[jj].x), bflo(xw2[jj].y), bfhi(xw2[jj].y)};
            v[0] += mm[0] * (g0 * bflo(y0[jj].x) + g1 * bflo(y1[jj].x)); v[1] += mm[1] * (g0 * bfhi(y0[jj].x) + g1 * bfhi(y1[jj].x));
            v[2] += mm[2] * (g0 * bflo(y0[jj].y) + g1 * bflo(y1[jj].y)); v[3] += mm[3] * (g0 * bfhi(y0[jj].y) + g1 * bfhi(y1[jj].y));
            *(f32x4*)(xw + col) = v; }
    }
}

__device__ __forceinline__ void p_prep(Frame& F, const Args& A, int l) {
    unsigned char* const ws = launder(F.ws);
    const int tid = (F.wave * 64 + hw_lane()), lane = tid & 63; (void)lane;
    const int gw = F.vcu * NWAVES + F.wave, NGW = F.G * NWAVES;
    const unsigned* P = (const unsigned*)(ws + WS_P);
    const float* cs = (const float*)(ws + WS_ROPE);
    bf16* QO = (bf16*)(ws + WS_QO); bf16* KB = (bf16*)(ws + WS_KB); bf16* VB = (bf16*)(ws + WS_VB);
    unsigned* Rst = (unsigned*)(ws + WS_R); unsigned* Kst = (unsigned*)(ws + WS_K); unsigned* Vst = (unsigned*)(ws + WS_V); unsigned* KKst = (unsigned*)(ws + WS_KK); unsigned* LIN = (unsigned*)(ws + WS_LIN);
    const int d0 = 2 * (lane & 31);
    const float qg0 = INP(IN_QG)[l * 64 + d0], qg1 = INP(IN_QG)[l * 64 + d0 + 1], kg0 = INP(IN_KG)[l * 64 + d0], kg1 = INP(IN_KG)[l * 64 + d0 + 1];
    float mu0[15], mu1[15];
#pragma unroll
    for (int i = 0; i < 15; ++i) { mu0[i] = INP(IN_MU)[l * SHIFTW + 128 * i + 2 * lane]; mu1[i] = INP(IN_MU)[l * SHIFTW + 128 * i + 2 * lane + 1]; }
    float kw0[4], kw1[4];
#pragma unroll
    for (int i = 0; i < 4; ++i) { kw0[i] = INP(IN_KKW)[l * 512 + 128 * i + 2 * lane]; kw1[i] = INP(IN_KKW)[l * 512 + 128 * i + 2 * lane + 1]; }
    const float C2 = 0.125f * 1.4426950408889634f;
    const float sgn = (lane & 16) ? 1.0f : -1.0f;
    for (int w0 = gw; w0 * 17 < TT; w0 += NGW) {
        const int rbeg = w0 * 17;
        unsigned cur[21], nxt[21], prv[15];
#pragma unroll
        for (int i = 0; i < 15; ++i) prv[i] = 0u;
        {   const int r = rbeg; const bool lat = r < TL; const int pos = lat ? (r & 4095) : ((r - TL) & 255);
            if (pos != 0) {
#pragma unroll
                for (int i = 0; i < 15; ++i) prv[i] = P[(size_t)(r - 1) * (INWP / 2) + 64 * (i + 6) + lane]; }
#pragma unroll
            for (int i = 0; i < 21; ++i) cur[i] = P[(size_t)r * (INWP / 2) + 64 * i + lane];
        }
        for (int k = 0; k < 17; ++k) {
            const int r = rbeg + k; const bool lat = r < TL; const int pos = lat ? (r & 4095) : ((r - TL) & 255); const int slen = lat ? 4096 : 256;
            const bool has_next = (pos != slen - 1);
            const bool load_next = (k < 16) || has_next;
            if (load_next && r + 1 < TT) {
#pragma unroll
                for (int i = 0; i < 21; ++i) nxt[i] = P[(size_t)(r + 1) * (INWP / 2) + 64 * i + lane];
            } else {
#pragma unroll
                for (int i = 0; i < 21; ++i) nxt[i] = 0u;
            }
            const int b = lat ? (r >> 12) : ((r - TL) >> 8);
            const size_t kvrow = (size_t)b * KVLEN + (lat ? pos : 4096 + pos);
            f32x4 csv = (f32x4){1.f, 0.f, 1.f, 0.f};
            if (lat) csv = *(const f32x4*)(cs + ((size_t)pos * 32 + 2 * (lane & 15)) * 2);
#pragma unroll
            for (int i = 0; i < 5; ++i) {
                float x0 = bflo(cur[i]), x1 = bfhi(cur[i]);
                const float ss = half_sum(x0 * x0 + x1 * x1);
                const float rstd = 1.0f / sqrtf(ss * (1.0f / 64.0f) + RMS_EPS);
                x0 = x0 * rstd * (i < 4 ? qg0 : kg0); x1 = x1 * rstd * (i < 4 ? qg1 : kg1);
                const float p0 = __shfl_xor(x0, 16), p1 = __shfl_xor(x1, 16);
                const float y0 = x0 * csv[0] + sgn * p0 * csv[1], y1 = x1 * csv[2] + sgn * p1 * csv[3];
                if (i < 4) *(unsigned*)(QO + (size_t)r * 1024 + 128 * i + 2 * lane) = pkbf(y0 * C2, y1 * C2);
                else *(unsigned*)(KB + kvrow * 128 + 2 * lane) = pkbf(y0, y1);
            }
            *(unsigned*)(VB + kvrow * 128 + 2 * lane) = cur[5];
            const float hn = has_next ? 1.0f : 0.0f;
#pragma unroll
            for (int i = 0; i < 15; ++i) {
                const float c0 = bflo(cur[i + 6]), c1 = bfhi(cur[i + 6]);
                const float a0 = bflo(prv[i]) + hn * bflo(nxt[i + 6]), a1 = bfhi(prv[i]) + hn * bfhi(nxt[i + 6]);
                const float s0 = c0 + mu0[i] * (0.5f * a0 - c0), s1 = c1 + mu1[i] * (0.5f * a1 - c1);
                if (i < 4) Rst[(size_t)r * 256 + 64 * i + lane] = pkbf(s0, s1);
                else if (i < 8) { Kst[(size_t)r * 256 + 64 * (i - 4) + lane] = pkbf(s0, s1);
                    const float t0 = s0 * kw0[i - 4], t1 = s1 * kw1[i - 4]; const float q = half_sum(t0 * t0 + t1 * t1); const float rn = 1.0f / sqrtf(q + 1e-12f);
                    KKst[(size_t)r * 256 + 64 * (i - 4) + lane] = pkbf(t0 * rn, t1 * rn); }
                else if (i < 12) Vst[(size_t)r * 256 + 64 * (i - 8) + lane] = pkbf(s0, s1);
                else if (i == 12) { const float e0 = __builtin_amdgcn_exp2f(2.0f * 1.4426950408889634f * s0), e1 = __builtin_amdgcn_exp2f(2.0f * 1.4426950408889634f * s1);
                    LIN[(size_t)r * (LORA_K / 2) + lane] = pkbf(1.0f - 2.0f * __builtin_amdgcn_rcpf(1.0f + e0), 1.0f - 2.0f * __builtin_amdgcn_rcpf(1.0f + e1)); }
                else if (i == 13) LIN[(size_t)r * (LORA_K / 2) + 64 + lane] = pkbf(s0, s1);
                else LIN[(size_t)r * (LORA_K / 2) + 128 + lane] = pkbf(sigm(s0), sigm(s1));
            }
#pragma unroll
            for (int i = 0; i < 15; ++i) prv[i] = has_next ? cur[i + 6] : 0u;
#pragma unroll
            for (int i = 0; i < 21; ++i) cur[i] = nxt[i];
        }
    }
}

template <int CTRL> __device__ __forceinline__ float dppf(float v) { return __builtin_bit_cast(float, __builtin_amdgcn_update_dpp(0, __builtin_bit_cast(int, v), CTRL, 0xf, 0xf, true)); }
__device__ __forceinline__ float red16(float v) { v += dppf<0xB1>(v); v += dppf<0x4E>(v); v += dppf<0x141>(v); v += dppf<0x128>(v); return v; }
constexpr int SC_TS = 32, SC_W = 352;
__device__ __forceinline__ void p_scan(Frame& F, const Args& A, int l) {
    unsigned char* const ws = launder(F.ws);
    const int tid = (F.wave * 64 + hw_lane()), lane = tid & 63; (void)lane;
    LAS float* buf = (LAS float*)(F.lds + RING_OFF);
    float* OSC = (float*)(ws + WS_OSC);
    constexpr int NCH = KVLEN / SC_TS;
    for (int item = blockIdx.x; item < 256; item += F.G) {
        const int chain = item >> 1, rh = item & 1, dir = chain & 1, bh = chain >> 1, b = bh >> 3, h = bh & 7;
        const int row = tid >> 4, c = tid & 15;
        float S0 = 0.f, S1 = 0.f, S2 = 0.f, S3 = 0.f;
        const bool stg = tid < 352; const int sub = (tid >= 176) ? 1 : 0, pp = tid - 176 * sub, a = pp >> 5, w = pp & 31;
        const unsigned* p1; int pitch1 = 256;
        if (a == 0 || a == 2) p1 = (const unsigned*)(ws + WS_KK) + h * 32 + w;
        else if (a == 1) { p1 = (const unsigned*)(ws + WS_LOUT) + dir * 256 + h * 32 + w; pitch1 = LORA_N / 2; }
        else if (a == 3) p1 = (const unsigned*)(ws + WS_K) + h * 32 + w;
        else if (a == 4) p1 = (const unsigned*)(ws + WS_R) + h * 32 + w;
        else p1 = (const unsigned*)(ws + WS_V) + h * 32 + rh * 16 + (pp - 160);
        const unsigned* p2 = (const unsigned*)(ws + WS_LOUT) + 512 + dir * 256 + h * 32 + w;
        const bool two = (a == 2 || a == 3);
        const int cw = (a == 5) ? 0 : 2 * w;
        const float cw0 = INP(IN_W0)[l * 1024 + dir * 512 + h * 64 + cw], cw1 = INP(IN_W0)[l * 1024 + dir * 512 + h * 64 + cw + 1];
        const float ca0 = INP(IN_A0)[l * 1024 + dir * 512 + h * 64 + cw], ca1 = INP(IN_A0)[l * 1024 + dir * 512 + h * 64 + cw + 1];
        const float ck0 = INP(IN_KA)[l * 512 + h * 64 + cw], ck1 = INP(IN_KA)[l * 512 + h * 64 + cw + 1];
        unsigned st[16], st2[16];
#define SC_TOK(s) ((s) < CTXL ? (TL + b * CTXL + (dir ? (CTXL - 1 - (s)) : (s))) : (b * SEQL + (dir ? (SEQL - 1 - ((s) - CTXL)) : ((s) - CTXL))))
#define SC_LOAD(ci) do { if (stg) { _Pragma("unroll") for (int i = 0; i < 16; ++i) { const int s = (ci) * SC_TS + 2 * i + sub; const size_t tok = (size_t)SC_TOK(s); \
            st[i] = p1[tok * pitch1]; st2[i] = two ? p2[tok * (LORA_N / 2)] : 0u; } } } while (0)
#define SC_STORE(bi) do { if (stg) { _Pragma("unroll") for (int i = 0; i < 16; ++i) { \
            float x0 = bflo(st[i]), x1 = bfhi(st[i]); \
            if (a == 1) { x0 = __builtin_amdgcn_exp2f(-1.4426950408889634f * 0.6065306597126334f * sigm(x0 + cw0)); x1 = __builtin_amdgcn_exp2f(-1.4426950408889634f * 0.6065306597126334f * sigm(x1 + cw1)); } \
            else if (a == 2) { x0 *= sigm(bflo(st2[i]) + ca0); x1 *= sigm(bfhi(st2[i]) + ca1); } \
            else if (a == 3) { x0 *= 1.0f + (sigm(bflo(st2[i]) + ca0) - 1.0f) * ck0; x1 *= 1.0f + (sigm(bfhi(st2[i]) + ca1) - 1.0f) * ck1; } \
            LAS float* dp = buf + ((bi) * SC_TS + 2 * i + sub) * SC_W + 2 * pp; dp[0] = x0; dp[1] = x1; } } } while (0)
        __syncthreads();
        SC_LOAD(0); SC_STORE(0); __syncthreads();
        for (int ci = 0; ci < NCH; ++ci) {
            if (ci + 1 < NCH) SC_LOAD(ci + 1);
            const LAS float* bp = buf + (ci & 1) * SC_TS * SC_W;
#pragma unroll 2
            for (int stp = 0; stp < SC_TS; ++stp) {
                const LAS float* sp = bp + stp * SC_W;
                const f32x4 kk = *(const LAS f32x4*)(sp + 4 * c), w4 = *(const LAS f32x4*)(sp + 64 + 4 * c), bb = *(const LAS f32x4*)(sp + 128 + 4 * c), kd = *(const LAS f32x4*)(sp + 192 + 4 * c), rr = *(const LAS f32x4*)(sp + 256 + 4 * c);
                const float vv = sp[320 + row];
                float sa = (S0 * kk[0] + S1 * kk[1]) + (S2 * kk[2] + S3 * kk[3]); sa = red16(sa);
                S0 = S0 * w4[0] + (vv * kd[0] - sa * bb[0]); S1 = S1 * w4[1] + (vv * kd[1] - sa * bb[1]); S2 = S2 * w4[2] + (vv * kd[2] - sa * bb[2]); S3 = S3 * w4[3] + (vv * kd[3] - sa * bb[3]);
                float o = (S0 * rr[0] + S1 * rr[1]) + (S2 * rr[2] + S3 * rr[3]); o = red16(o);
                if (c == 0) { const int s = ci * SC_TS + stp; OSC[((size_t)dir * TT + (size_t)SC_TOK(s)) * 512 + h * 64 + rh * 32 + row] = o; }
            }
            if (ci + 1 < NCH) SC_STORE((ci + 1) & 1);
            __syncthreads();
        }
#undef SC_TOK
#undef SC_LOAD
#undef SC_STORE
    }
}

__device__ __forceinline__ void p_readout(Frame& F, const Args& A, int l) {
    unsigned char* const ws = launder(F.ws);
    const int tid = (F.wave * 64 + hw_lane()), lane = tid & 63; (void)lane;
    const int gw = F.vcu * NWAVES + F.wave, NGW = F.G * NWAVES;
    const float* OSC = (const float*)(ws + WS_OSC);
    const unsigned* Rst = (const unsigned*)(ws + WS_R); const unsigned* Vst = (const unsigned*)(ws + WS_V); const unsigned* Kst = (const unsigned*)(ws + WS_K); const unsigned* LOUT = (const unsigned*)(ws + WS_LOUT);
    bf16* QO = (bf16*)(ws + WS_QO);
    float rk0[4], rk1[4], gw0[4], gw1[4], gb0[4], gb1[4], ka0[4], ka1[4], aa0[4], aa1[4], ab0[4], ab1[4];
#pragma unroll
    for (int i = 0; i < 4; ++i) { const int cc = 128 * i + 2 * lane, cidx = l * 512 + cc; rk0[i] = INP(IN_RK)[cidx]; rk1[i] = INP(IN_RK)[cidx + 1]; gw0[i] = INP(IN_GNW)[cidx]; gw1[i] = INP(IN_GNW)[cidx + 1]; gb0[i] = INP(IN_GNB)[cidx]; gb1[i] = INP(IN_GNB)[cidx + 1];
        ka0[i] = INP(IN_KA)[cidx]; ka1[i] = INP(IN_KA)[cidx + 1]; aa0[i] = INP(IN_A0)[l * 1024 + cc]; aa1[i] = INP(IN_A0)[l * 1024 + cc + 1]; ab0[i] = INP(IN_A0)[l * 1024 + 512 + cc]; ab1[i] = INP(IN_A0)[l * 1024 + 512 + cc + 1]; }
    for (int row = gw; row < TT; row += NGW) {
#pragma unroll
        for (int i = 0; i < 4; ++i) {
            const size_t off = (size_t)row * 256 + 64 * i + lane; const size_t lo = (size_t)row * (LORA_N / 2) + 64 * i + lane;
            const float2 oa = *(const float2*)(OSC + (size_t)row * 512 + 128 * i + 2 * lane), ob = *(const float2*)(OSC + ((size_t)TT + row) * 512 + 128 * i + 2 * lane);
            const float o0 = oa.x + ob.x, o1 = oa.y + ob.y;
            const float mean = half_sum(o0 + o1) * (1.0f / 64.0f);
            const float d0 = o0 - mean, d1 = o1 - mean;
            const float var = half_sum(d0 * d0 + d1 * d1) * (1.0f / 64.0f);
            const float rs = 1.0f / sqrtf(var + GN_EPS);
            const unsigned rw = Rst[off], vw = Vst[off], kw = Kst[off], pa = LOUT[lo + 512], pb = LOUT[lo + 768], gwd = LOUT[lo + 1024];
            const float ks0 = bflo(kw) * (2.0f + (sigm(bflo(pa) + aa0[i]) + sigm(bflo(pb) + ab0[i]) - 2.0f) * ka0[i]), ks1 = bfhi(kw) * (2.0f + (sigm(bfhi(pa) + aa1[i]) + sigm(bfhi(pb) + ab1[i]) - 2.0f) * ka1[i]);
            const float bsum = half_sum(bflo(rw) * ks0 * rk0[i] + bfhi(rw) * ks1 * rk1[i]);
            const float y0 = d0 * rs * gw0[i] + gb0[i] + bsum * bflo(vw), y1 = d1 * rs * gw1[i] + gb1[i] + bsum * bfhi(vw);
            *(unsigned*)(QO + (size_t)row * 1024 + 512 + 128 * i + 2 * lane) = pkbf(y0 * bflo(gwd), y1 * bfhi(gwd));
        }
    }
}

__device__ __forceinline__ void p_route(Frame& F, int nrows) {
    unsigned char* const ws = launder(F.ws);
    const int tid = (F.wave * 64 + hw_lane()), lane = tid & 63; (void)lane;
    const int gw = F.vcu * NWAVES + F.wave, NGW = F.G * NWAVES;
    const int* wcnt = (const int*)(ws + WS_ROUTE + RT_WCNT);
    LAS int* pexp = (LAS int*)(F.lds + LT_PEXP); LAS int* npan = (LAS int*)(F.lds + LT_NPAN); LAS int* tmp = (LAS int*)(F.lds + LT_TMP);
    {   const int e = lane & 7, part = lane >> 3;
        const int p = F.wave * 8 + part;
        const int wb = p * (NGW / 64), we = wb + NGW / 64; const int myw0 = F.vcu * NWAVES;
        int tot = 0, before = 0;
#pragma unroll 16
        for (int w = wb; w < we; ++w) { const int cv = wcnt[(size_t)w * 8 + e]; tot += cv; if (w < myw0) before += cv; }
        tmp[p * 16 + e] = tot; tmp[p * 16 + 8 + e] = before;
    }
    __syncthreads();
    if (tid < 8) { int tot = 0, before = 0; for (int p = 0; p < 64; ++p) { tot += tmp[p * 16 + tid]; before += tmp[p * 16 + 8 + tid]; } tmp[1024 + tid] = tot; tmp[1032 + tid] = before; }
    __syncthreads();
    if (tid == 0) { int acc = 0; for (int e = 0; e < 8; ++e) { const int padded = (tmp[1024 + e] + 255) & ~255; tmp[1040 + e] = acc; acc += padded; tmp[1048 + e] = acc; } npan[0] = acc >> 8; }
    __syncthreads();
    for (int p = tid; p < 320; p += NWAVES * 64) { int e = 7; for (int q = 7; q >= 0; --q) if (p * 256 < tmp[1048 + q]) e = q; pexp[p] = e; }
    int base0, base1, base2, base3, base4, base5, base6, base7;
    {   int bsv[8];
#pragma unroll
        for (int e = 0; e < 8; ++e) bsv[e] = tmp[1040 + e] + tmp[1032 + e];
        typedef int i32x4 __attribute__((ext_vector_type(4)));
#pragma unroll
        for (int w = 0; w < 7; ++w) { const i32x4* wp = (const i32x4*)(wcnt + (size_t)(F.vcu * NWAVES + w) * 8); const i32x4 c0 = wp[0], c1 = wp[1]; const int mk = (w < F.wave) ? 1 : 0;
            bsv[0] += mk * c0[0]; bsv[1] += mk * c0[1]; bsv[2] += mk * c0[2]; bsv[3] += mk * c0[3]; bsv[4] += mk * c1[0]; bsv[5] += mk * c1[1]; bsv[6] += mk * c1[2]; bsv[7] += mk * c1[3]; }
        base0 = bsv[0]; base1 = bsv[1]; base2 = bsv[2]; base3 = bsv[3]; base4 = bsv[4]; base5 = bsv[5]; base6 = bsv[6]; base7 = bsv[7];
    }
    const int* route_e = (const int*)(ws + WS_ROUTE + RT_E); int* route_s = (int*)(ws + WS_ROUTE + RT_S);
    const unsigned char* H = (const unsigned char*)F.out; unsigned char* AG = ws + WS_AG8;
    int ee_n = 0; v4u a_n = (v4u){0u, 0u, 0u, 0u};
    if (gw < nrows) { ee_n = route_e[gw]; a_n = ((const v4u*)(H + (size_t)gw * 1024))[lane]; }
    for (int row = gw; row < nrows; row += NGW) {
        const int ee = ee_n; const v4u a = a_n; const int e0 = ee & 255, e1 = ee >> 8;
        if (row + NGW < nrows) { ee_n = route_e[row + NGW]; a_n = ((const v4u*)(H + (size_t)(row + NGW) * 1024))[lane]; }
        int s0 = 0, s1 = 0;
#define RT_TAKE(E, B) do { if (e0 == E) { s0 = B; B += 1; } if (e1 == E) { s1 = B; B += 1; } } while (0)
        RT_TAKE(0, base0); RT_TAKE(1, base1); RT_TAKE(2, base2); RT_TAKE(3, base3); RT_TAKE(4, base4); RT_TAKE(5, base5); RT_TAKE(6, base6); RT_TAKE(7, base7);
#undef RT_TAKE
        if (lane == 0) { route_s[2 * row] = s0; route_s[2 * row + 1] = s1; }
        ((v4u*)(AG + (size_t)s0 * 1024))[lane] = a; ((v4u*)(AG + (size_t)s1 * 1024))[lane] = a;
    }
    __syncthreads();
}

__device__ __forceinline__ void p_attn(Frame& F, char* ldsg, bool ctx_on) {
    unsigned char* const ws = launder(F.ws);
    const int tid = (F.wave * 64 + hw_lane()), lane = tid & 63; (void)lane;
    typedef attn_body::bf16 abf;
    const abf* Q = (const abf*)(ws + WS_QO); const abf* K = (const abf*)(ws + WS_KB); const abf* V = (const abf*)(ws + WS_VB); abf* O = (abf*)(ws + WS_QO);
    const int per = (1024 + F.G - 1) / F.G;
    for (int i = 0; i < per; ++i) { const int un = F.vcu * per + i; if (un >= 1024) break;
        const int bh = un >> 4, qb = un & 15, b = bh >> 3, h = bh & 7;
        attn_body::attn_unit<8>((long)b * SEQL + qb * 256, h * 64, (long)b * KVLEN, (h >> 2) * 64, KVLEN / 64, Q, K, V, O, ldsg, F.wave); }
    if (ctx_on) for (int un = F.vcu; un < 64; un += F.G) { const int b = un >> 3, h = un & 7;
        attn_body::attn_unit<8>((long)TL + b * CTXL, h * 64, (long)b * KVLEN + SEQL, (h >> 2) * 64, CTXL / 64, Q, K, V, O, ldsg, F.wave); }
}

typedef float f32x16 __attribute__((ext_vector_type(16)));
typedef unsigned u32x2 __attribute__((ext_vector_type(2)));
constexpr int SCH = 64, NCHK = KVLEN / SCH, NITEM = 128 * NCHK;
constexpr int LSTR = 144;
constexpr int L_AKK = 0, L_AR = 9216, L_AK = 18432, L_AB = 27648, L_TK = 36864, L_TB = 46080, L_TV = 55296, L_TW1 = 64512, L_TU = 73728, L_MLK = 82944, L_MMB = 92160, L_MMK = 101376;
constexpr int L_FLB = 110592, L_GC = 126976, L_TII = 127232, L_FX = L_AK;
static_assert(L_TII + 2048 <= RING_BYTES, "scan LDS map");
__device__ __forceinline__ unsigned short bf1(float x) { return (unsigned short)(pkbf(x, 0.f) & 0xffffu); }
__device__ __forceinline__ bf16x8 ldsv8(const LAS unsigned char* p) { return *(const LAS bf16x8*)p; }
template <bool SWA = false, bool SWB = false>
__device__ __forceinline__ f32x16 tile32(const LAS unsigned char* Ab, const LAS unsigned char* Bb, int mi, int ni, int r, int h, f32x16 acc) {
    const int ra = 32 * mi + r, rb = 32 * ni + r; const int xa = SWA ? ((ra >> 3) & 7) : 0, xb = SWB ? ((rb >> 3) & 7) : 0;
#pragma unroll
    for (int kb = 0; kb < 4; ++kb) { const bf16x8 a = ldsv8(Ab + ra * LSTR + (((2 * kb + h) ^ xa) << 4)), b = ldsv8(Bb + rb * LSTR + (((2 * kb + h) ^ xb) << 4));
        acc = __builtin_amdgcn_mfma_f32_32x32x16_bf16(a, b, acc, 0, 0, 0); }
    return acc;
}
__device__ __forceinline__ int jperm(int j) { return (((j >> 2) & 3) << 4) | (((j >> 5) & 1) << 3) | (((j >> 4) & 1) << 2) | (j & 3); }
#define CROW(reg, h) (((reg) & 3) + 8 * ((reg) >> 2) + 4 * (h))


#if DEBUG_NAN
#define DBG_BF(k, off, nbytes) do { unsigned bad_ = 0; for (int i_ = tid; i_ < (nbytes) / 2; i_ += 512) { const int row_ = i_ / 72, col_ = i_ % 72; if (col_ < 64) { const float v_ = __builtin_bit_cast(float, (unsigned)(*(const LAS unsigned short*)(L + (off) + row_ * LSTR + col_ * 2)) << 16); if (!(fabsf(v_) < 1e30f)) ++bad_; } } if (bad_) atomicAdd((unsigned*)(F.ctl + 16 + (k)), bad_); } while (0)
#define DBG_F32(k, off, n) do { unsigned bad_ = 0; for (int i_ = tid; i_ < (n); i_ += 512) { const float v_ = ((const LAS float*)(L + (off)))[i_]; if (!(fabsf(v_) < 1e30f)) ++bad_; } if (bad_) atomicAdd((unsigned*)(F.ctl + 16 + (k)), bad_); } while (0)
#else
#define DBG_BF(k, off, nbytes) do {} while (0)
#define DBG_F32(k, off, n) do {} while (0)
#endif
#define WG_BAR() do { asm volatile("s_waitcnt lgkmcnt(0)" ::: "memory"); __builtin_amdgcn_s_barrier(); asm volatile("" ::: "memory"); } while (0)
template <int CTRL, int RMASK> __device__ __forceinline__ float dppm(float v) { return __builtin_bit_cast(float, __builtin_amdgcn_update_dpp(0, __builtin_bit_cast(int, v), CTRL, RMASK, 0xf, true)); }
__device__ __forceinline__ float wave_incl_scan(float x) {
    x += dppm<0x111, 0xf>(x); x += dppm<0x112, 0xf>(x); x += dppm<0x114, 0xf>(x); x += dppm<0x118, 0xf>(x);
    x += __builtin_bit_cast(float, __builtin_amdgcn_update_dpp(0, __builtin_bit_cast(int, x), 0x142, 0xa, 0xf, false));
    x += __builtin_bit_cast(float, __builtin_amdgcn_update_dpp(0, __builtin_bit_cast(int, x), 0x143, 0xc, 0xf, false));
    return x;
}
struct S1In { v4u kk, r, k, v, pw, pa; f32x4 ka[2]; };
__device__ __forceinline__ void s1_item(Frame& F, unsigned char* const ws, const int lane, const int wv, const int l, const int item, const S1In& cur, S1In& nxt, const float* w0b, const float* a0b, const float* kab, unsigned long long (&cy)[6]) {
#if CYSEL >= 0
#define CY(k) do { const unsigned long long now_ = __builtin_readcyclecounter(); cy[k] += now_ - cy[5]; cy[5] = now_; } while (0)
#else
#define CY(k) do {} while (0)
#endif
    LAS unsigned char* L = F.lds + RING_OFF;
    const bf16* KKst = (const bf16*)(ws + WS_KK); const bf16* Kst = (const bf16*)(ws + WS_K); const bf16* Rst = (const bf16*)(ws + WS_R); const bf16* Vst = (const bf16*)(ws + WS_V); const bf16* LOUT = (const bf16*)(ws + WS_LOUT);
    bf16* PT = (bf16*)(ws + WS_SPT); bf16* GG = (bf16*)(ws + WS_SG); bf16* QQ = (bf16*)(ws + WS_SQ); float* OSC = (float*)(ws + WS_OSC);
    const int r = lane & 31, h = lane >> 5;
#define S1_ITEM(item_) const int chain = (item_) / NCHK, c = (item_) - chain * NCHK, dir = chain & 1, bh = chain >> 1, b = bh >> 3, hd = bh & 7; const int s0 = c * SCH; const int dsg = dir ? -1 : 1; \
        const int tok0 = (s0 < CTXL) ? (TL + b * CTXL + (dir ? (CTXL - 1 - s0) : s0)) : (b * SEQL + (dir ? (SEQL - 1 - (s0 - CTXL)) : (s0 - CTXL)));
#define S1_TOUCH(D) asm volatile("" :: "v"(D.kk), "v"(D.r), "v"(D.k), "v"(D.v), "v"(D.pw), "v"(D.pa), "v"(D.ka[0]), "v"(D.ka[1]))
#define S1_LOAD(D, item_) do { S1_ITEM(item_) const size_t tokr = (size_t)(tok0 + dsg * (8 * wv + (lane >> 3))); const size_t o5 = tokr * 512 + hd * 64 + 8 * (lane & 7); \
        D.kk = *(const v4u*)(KKst + o5); D.r = *(const v4u*)(Rst + o5); D.k = *(const v4u*)(Kst + o5); D.v = *(const v4u*)(Vst + o5); \
        D.pw = *(const v4u*)(LOUT + tokr * LORA_N + dir * 512 + hd * 64 + 8 * (lane & 7)); D.pa = *(const v4u*)(LOUT + tokr * LORA_N + 1024 + dir * 512 + hd * 64 + 8 * (lane & 7)); \
        { D.ka[0] = *(const f32x4*)(kab + hd * 64 + 8 * (lane & 7)); D.ka[1] = *(const f32x4*)(kab + hd * 64 + 8 * (lane & 7) + 4); } } while (0)
    {
        S1_ITEM(item)
        {   const v4u kk8 = cur.kk, r8 = cur.r, k8 = cur.k, v8 = cur.v, pw8 = cur.pw, pa8 = cur.pa; const int jg = lane & 7, t = 8 * wv + (lane >> 3);
            const float kap[8] = {cur.ka[0][0], cur.ka[0][1], cur.ka[0][2], cur.ka[0][3], cur.ka[1][0], cur.ka[1][1], cur.ka[1][2], cur.ka[1][3]};
            LAS float* tot = (LAS float*)(L + L_TII);
            float lw[8], av[8], lam[8];
#pragma unroll
            for (int e = 0; e < 8; ++e) { const unsigned pw = pw8[e >> 1], pa = pa8[e >> 1]; const float zw = (e & 1) ? bfhi(pw) : bflo(pw), za = (e & 1) ? bfhi(pa) : bflo(pa);
                lw[e] = zw; av[e] = za; lam[e] = lw[e]; }
#pragma unroll
            for (int sh = 8; sh <= 32; sh <<= 1) { float y[8]; const float mk = (lane >= sh) ? 1.0f : 0.0f;
#pragma unroll
                for (int e = 0; e < 8; ++e) y[e] = __shfl_up(lam[e], sh);
#pragma unroll
                for (int e = 0; e < 8; ++e) lam[e] = __builtin_fmaf(mk, y[e], lam[e]); }
            if (lane >= 56) { *(LAS f32x4*)(tot + wv * 64 + 8 * jg) = (f32x4){lam[0], lam[1], lam[2], lam[3]}; *(LAS f32x4*)(tot + wv * 64 + 8 * jg + 4) = (f32x4){lam[4], lam[5], lam[6], lam[7]}; }
            if (item + F.G < NITEM) S1_LOAD(nxt, item + F.G);
            WG_BAR();
            for (int w = 0; w < wv; ++w) { const f32x4 q0 = *(const LAS f32x4*)(tot + w * 64 + 8 * jg), q1 = *(const LAS f32x4*)(tot + w * 64 + 8 * jg + 4);
                lam[0] += q0[0]; lam[1] += q0[1]; lam[2] += q0[2]; lam[3] += q0[3]; lam[4] += q1[0]; lam[5] += q1[1]; lam[6] += q1[2]; lam[7] += q1[3]; }
            v4u wkk, wrr, wkd, wbd; float en8[8];
#pragma unroll
            for (int p = 0; p < 4; ++p) { float okk[2], orr[2], okd[2], obd[2];
#pragma unroll
                for (int u = 0; u < 2; ++u) { const int e = 2 * p + u;
                    const unsigned xkk = kk8[p], xr = r8[p], xk = k8[p];
                    const float kkv = u ? bfhi(xkk) : bflo(xkk), rv = u ? bfhi(xr) : bflo(xr), kv = u ? bfhi(xk) : bflo(xk);
                    const float eNp = __builtin_amdgcn_exp2f(lw[e] - lam[e]), eN = __builtin_amdgcn_exp2f(-lam[e]), eP = __builtin_amdgcn_exp2f(lam[e]);
                    okk[u] = kkv * eNp; orr[u] = rv * eN; okd[u] = kv * __builtin_fmaf(av[e], kap[e], 1.0f - kap[e]) * eP; obd[u] = kkv * av[e] * eP;
                    en8[e] = eN; }
                wkk[p] = pkbf(okk[0], okk[1]); wrr[p] = pkbf(orr[0], orr[1]); wkd[p] = pkbf(okd[0], okd[1]); wbd[p] = pkbf(obd[0], obd[1]); }
            if (t == SCH - 1) { *(LAS f32x4*)((LAS float*)(L + L_GC) + 8 * jg) = (f32x4){en8[0], en8[1], en8[2], en8[3]}; *(LAS f32x4*)((LAS float*)(L + L_GC) + 8 * jg + 4) = (f32x4){en8[4], en8[5], en8[6], en8[7]}; }
            *(LAS v4u*)(L + L_AKK + t * LSTR + jg * 16) = wkk; *(LAS v4u*)(L + L_AR + t * LSTR + jg * 16) = wrr; *(LAS v4u*)(L + L_AK + t * LSTR + jg * 16) = wkd; *(LAS v4u*)(L + L_AB + t * LSTR + jg * 16) = wbd;
#pragma unroll
            for (int e = 0; e < 8; ++e) { const int j = 8 * jg + e; const unsigned wk = wkd[e >> 1], wb = wbd[e >> 1], wvv = v8[e >> 1];
                const int to = j * LSTR + ((wv ^ jg) << 4) + (lane >> 3) * 2;
                *(LAS unsigned short*)(L + L_TK + to) = (unsigned short)((e & 1) ? (wk >> 16) : (wk & 0xffffu));
                *(LAS unsigned short*)(L + L_TB + to) = (unsigned short)((e & 1) ? (wb >> 16) : (wb & 0xffffu));
                *(LAS unsigned short*)(L + L_TV + to) = (unsigned short)((e & 1) ? (wvv >> 16) : (wvv & 0xffffu)); }
        }
        WG_BAR();
        CY(0);
#pragma unroll
        for (int jj = 0; jj < 2; ++jj) {
            const int job = 2 * wv + jj, m = job >> 2, si = (job >> 1) & 1, ti = job & 1;
            f32x16 acc = {};
            if (!(si == 1 && ti == 0)) acc = tile32(L + ((m & 1) ? L_AK : L_AB), L + (m < 2 ? L_AKK : L_AR), si, ti, r, h, acc);
            const int tt = 32 * ti + r;
#pragma unroll
            for (int g = 0; g < 4; ++g) { const int sb = 32 * si + 8 * g + 4 * h; float vv[4];
#pragma unroll
                for (int i = 0; i < 4; ++i) { const int s = sb + i; const bool keep = (m < 2) ? (s < tt) : (s <= tt); vv[i] = keep ? acc[4 * g + i] : 0.f; }
                if (m == 0) *(LAS f32x4*)((LAS float*)(L + L_FLB) + tt * 64 + sb) = (f32x4){vv[0], vv[1], vv[2], vv[3]};
                else *(LAS u32x2*)(L + (m == 1 ? L_MLK : (m == 2 ? L_MMB : L_MMK)) + tt * LSTR + sb * 2) = (u32x2){pkbf(vv[0], vv[1]), pkbf(vv[2], vv[3])}; }
        }
        WG_BAR();
        CY(1);
        f32x16 acc_o1 = {};
        {   const int q4 = wv & 3, mi = q4 >> 1, ni = q4 & 1;
            if (wv < 4) { f32x16 acc = {}; acc = tile32<false, true>(L + L_MLK, L + L_TV, mi, ni, r, h, acc);
#pragma unroll
                for (int reg = 0; reg < 16; ++reg) ((LAS float*)(L + L_FX))[(32 * mi + CROW(reg, h)) * 64 + 32 * ni + r] = acc[reg];
                const int col = lane & 15; const LAS float* lb = (const LAS float*)(L + L_FLB) + (16 * wv) * 64 + 16 * wv; float x[16];
#pragma unroll
                for (int tt = 0; tt < 16; ++tt) { float a = (tt == col) ? 1.0f : 0.0f, a2 = 0.0f;
#pragma unroll
                    for (int s4 = 0; s4 < tt; s4 += 4) { const f32x4 lv = *(const LAS f32x4*)(lb + tt * 64 + s4);
#pragma unroll
                        for (int u = 0; u < 4; ++u) if (s4 + u < tt) { if (u & 1) a2 -= lv[u] * x[s4 + u]; else a -= lv[u] * x[s4 + u]; } }
                    x[tt] = a + a2; }
                if (lane < 16) {
#pragma unroll
                    for (int tt = 0; tt < 16; ++tt) *(LAS unsigned short*)(L + L_TII + wv * 512 + tt * 32 + col * 2) = bf1(x[tt]); }
            } else acc_o1 = tile32<true, false>(L + L_TV, L + L_MMK, mi, ni, r, h, acc_o1);
        }
        WG_BAR();
        CY(2);
        {   const int cc = lane & 15, q = lane >> 4; const bool isw = wv < 4; const int colb = 16 * (wv & 3) + cc;
            f32x4 U[4];
#pragma unroll
            for (int i = 0; i < 4; ++i) {
                f32x4 R;
#pragma unroll
                for (int reg = 0; reg < 4; ++reg) { const int tt = 16 * i + 4 * q + reg;
                    R[reg] = isw ? __builtin_bit_cast(float, (unsigned)(*(const LAS unsigned short*)(L + L_AKK + tt * LSTR + colb * 2)) << 16) : ((const LAS float*)(L + L_FX))[tt * 64 + colb]; }
#pragma unroll
                for (int kp = 0; kp < 2; ++kp) { if (2 * kp < i) {
                    const int k1 = 2 * kp, k2 = 2 * kp + 1; const bool two = (k2 < i);
                    const LAS float* lrow = (const LAS float*)(L + L_FLB) + (16 * i + cc) * 64;
                    const f32x4 la = *(const LAS f32x4*)(lrow + 16 * k1 + 4 * q); f32x4 lb2 = {0.f, 0.f, 0.f, 0.f}; if (two) lb2 = *(const LAS f32x4*)(lrow + 16 * k2 + 4 * q);
                    const v4u aw = (v4u){pkbf(-la[0], -la[1]), pkbf(-la[2], -la[3]), pkbf(-lb2[0], -lb2[1]), pkbf(-lb2[2], -lb2[3])};
                    const f32x4 u1 = U[k1]; f32x4 u2 = {0.f, 0.f, 0.f, 0.f}; if (two) u2 = U[k2];
                    const v4u bh_ = (v4u){pkbf(u1[0], u1[1]), pkbf(u1[2], u1[3]), pkbf(u2[0], u2[1]), pkbf(u2[2], u2[3])};
                    R = __builtin_amdgcn_mfma_f32_16x16x32_bf16(__builtin_bit_cast(bf16x8, aw), __builtin_bit_cast(bf16x8, bh_), R, 0, 0, 0); } }
                const u32x2 tw = *(const LAS u32x2*)(L + L_TII + i * 512 + cc * 32 + q * 8);
                const v4u ta = (v4u){tw.x, tw.y, 0u, 0u};
                const v4u rh = (v4u){pkbf(R[0], R[1]), pkbf(R[2], R[3]), 0u, 0u};
                f32x4 u = {0.f, 0.f, 0.f, 0.f};
                u = __builtin_amdgcn_mfma_f32_16x16x32_bf16(__builtin_bit_cast(bf16x8, ta), __builtin_bit_cast(bf16x8, rh), u, 0, 0, 0);
                U[i] = u;
                *(LAS u32x2*)(L + (isw ? L_TW1 : L_TU) + colb * LSTR + (16 * i + 4 * q) * 2) = (u32x2){pkbf(u[0], u[1]), pkbf(u[2], u[3])};
            }
        }
        WG_BAR();
        CY(3);
        S1_TOUCH(nxt);
        {   const int q4 = wv & 3, mi = q4 >> 1, ni = q4 & 1; const LAS float* gc = (const LAS float*)(L + L_GC);
            if (wv < 4) {
                f32x16 acc = {}; acc = tile32<false, true>(L + L_TW1, L + L_TB, mi, ni, r, h, acc);
                const int jp = 32 * ni + r; const float gj = gc[jp]; bf16* pt = PT + (size_t)item * 4096 + (size_t)jp * 64;
#pragma unroll
                for (int gp2 = 0; gp2 < 2; ++gp2) { unsigned pw[4];
#pragma unroll
                    for (int u = 0; u < 2; ++u) { const int g = gp2 + 2 * u, j0 = 32 * mi + 8 * g + 4 * h; float pv[4];
#pragma unroll
                        for (int i = 0; i < 4; ++i) pv[i] = (((j0 + i) == jp ? 1.0f : 0.0f) - acc[4 * g + i]) * gj;
                        pw[2 * u] = pkbf(pv[0], pv[1]); pw[2 * u + 1] = pkbf(pv[2], pv[3]); }
                    *(v4u*)(pt + 16 * (2 * gp2 + h) + 8 * mi) = (v4u){pw[0], pw[1], pw[2], pw[3]}; }
                f32x16 acq = {}; acq = tile32(L + L_TW1, L + L_MMB, mi, ni, r, h, acq);
                const int tt = 32 * ni + r; bf16* qq = QQ + (size_t)item * 4096 + (size_t)tt * 64;
#pragma unroll
                for (int gp2 = 0; gp2 < 2; ++gp2) { unsigned qw[4];
#pragma unroll
                    for (int u = 0; u < 2; ++u) { const int g = gp2 + 2 * u, j0 = 32 * mi + 8 * g + 4 * h; const u32x2 rw = *(const LAS u32x2*)(L + L_AR + tt * LSTR + j0 * 2);
                        qw[2 * u] = pkbf(bflo(rw.x) - acq[4 * g], bfhi(rw.x) - acq[4 * g + 1]); qw[2 * u + 1] = pkbf(bflo(rw.y) - acq[4 * g + 2], bfhi(rw.y) - acq[4 * g + 3]); }
                    *(v4u*)(qq + 16 * (2 * gp2 + h) + 8 * mi) = (v4u){qw[0], qw[1], qw[2], qw[3]}; }
            } else {
                f32x16 acc = {}; acc = tile32(L + L_TU, L + L_MMB, mi, ni, r, h, acc);
                const int tt = 32 * ni + r; bf16* op = (bf16*)OSC + ((size_t)dir * TT + (size_t)(tok0 + dsg * tt)) * 512 + hd * 64;
#pragma unroll
                for (int gp2 = 0; gp2 < 2; ++gp2) { unsigned ow_[4];
#pragma unroll
                    for (int u = 0; u < 2; ++u) { const int g = gp2 + 2 * u; ow_[2 * u] = pkbf(acc_o1[4 * g] - acc[4 * g], acc_o1[4 * g + 1] - acc[4 * g + 1]); ow_[2 * u + 1] = pkbf(acc_o1[4 * g + 2] - acc[4 * g + 2], acc_o1[4 * g + 3] - acc[4 * g + 3]); }
                    *(v4u*)(op + 16 * (2 * gp2 + h) + 8 * mi) = (v4u){ow_[0], ow_[1], ow_[2], ow_[3]}; }
                f32x16 ag = {}; ag = tile32<true, true>(L + L_TK, L + L_TV, mi, ni, r, h, ag);
                f32x16 ah = {}; ah = tile32<true, false>(L + L_TB, L + L_TU, mi, ni, r, h, ah);
                const int v = 32 * ni + r; bf16* gp = GG + (size_t)item * 4096 + (size_t)v * 64;
#pragma unroll
                for (int gp2 = 0; gp2 < 2; ++gp2) { unsigned gw_[4];
#pragma unroll
                    for (int u = 0; u < 2; ++u) { const int g = gp2 + 2 * u, j0 = 32 * mi + 8 * g + 4 * h; const f32x4 gj = *(const LAS f32x4*)(gc + j0); float gv[4];
#pragma unroll
                        for (int i = 0; i < 4; ++i) gv[i] = (ag[4 * g + i] - ah[4 * g + i]) * gj[i];
                        gw_[2 * u] = pkbf(gv[0], gv[1]); gw_[2 * u + 1] = pkbf(gv[2], gv[3]); }
                    *(v4u*)(gp + 16 * (2 * gp2 + h) + 8 * mi) = (v4u){gw_[0], gw_[1], gw_[2], gw_[3]}; }
            }
        }
        WG_BAR();
        CY(4);
    }
#undef CY
}
__device__ __forceinline__ void p_scan1(Frame& F, const Args& A, int l) {
    unsigned char* const ws = launder(F.ws);
    const int tid = (F.wave * 64 + hw_lane()), lane = tid & 63, wv = F.wave;
    const bf16* KKst = (const bf16*)(ws + WS_KK); const bf16* Kst = (const bf16*)(ws + WS_K); const bf16* Rst = (const bf16*)(ws + WS_R); const bf16* Vst = (const bf16*)(ws + WS_V); const bf16* LOUT = (const bf16*)(ws + WS_LOUT);
    const float* w0b = INP(IN_W0) + l * 1024; const float* a0b = INP(IN_A0) + l * 1024; const float* kab = INP(IN_KA) + l * 512;
    S1In sa = {}, sb = {}; unsigned long long cy[6] = {0, 0, 0, 0, 0, 0};
#if CYSEL >= 0
    cy[5] = __builtin_readcyclecounter();
#endif
    if ((int)blockIdx.x < NITEM) S1_LOAD(sa, (int)blockIdx.x);
    S1_TOUCH(sa);
    for (int item = blockIdx.x; item < NITEM; item += 2 * F.G) {
        s1_item(F, ws, lane, wv, l, item, sa, sb, w0b, a0b, kab, cy);
        if (item + F.G < NITEM) s1_item(F, ws, lane, wv, l, item + F.G, sb, sa, w0b, a0b, kab, cy);
    }
#if CYSEL >= 0
    if (blockIdx.x == 0 && F.wave == 0 && hw_lane() == 0) { unsigned long long* cs_ = (unsigned long long*)(F.ws + WS_CTL + 40960); for (int k = 0; k < 5; ++k) cs_[k] += cy[k]; }
#endif
}
#undef S1_ITEM
#undef S1_LOAD
#undef S1_TOUCH

struct S2Ops { v4u pa[4][2]; v4u gt[2]; };
__device__ __forceinline__ void s2_load(S2Ops& o, const bf16* PT, const bf16* GG, int chain, int c, int cc, int q, int v) {
    const size_t ib = ((size_t)chain * NCHK + c) * 4096;
#pragma unroll
    for (int J = 0; J < 4; ++J) { const bf16* prow = PT + ib + (size_t)(16 * J + cc) * 64;
#pragma unroll
        for (int kb = 0; kb < 2; ++kb) o.pa[J][kb] = *(const v4u*)(prow + 16 * q + 8 * kb); }
#pragma unroll
    for (int kb = 0; kb < 2; ++kb) o.gt[kb] = *(const v4u*)(GG + ib + (size_t)v * 64 + 16 * q + 8 * kb);
}
__device__ __forceinline__ void s2_step(f32x4 (&St)[4], const S2Ops& o, bf16* S0, int chain, int c, int q, int v) {
    const size_t ib = ((size_t)chain * NCHK + c) * 4096;
    v4u bh_[2], bl_[2];
#pragma unroll
    for (int kb = 0; kb < 2; ++kb) { const f32x4 u1 = St[2 * kb], u2 = St[2 * kb + 1];
        bh_[kb] = (v4u){pkbf(u1[0], u1[1]), pkbf(u1[2], u1[3]), pkbf(u2[0], u2[1]), pkbf(u2[2], u2[3])};
        bl_[kb] = (v4u){pkbf(u1[0] - bflo(bh_[kb].x), u1[1] - bfhi(bh_[kb].x)), pkbf(u1[2] - bflo(bh_[kb].y), u1[3] - bfhi(bh_[kb].y)), pkbf(u2[0] - bflo(bh_[kb].z), u2[1] - bfhi(bh_[kb].z)), pkbf(u2[2] - bflo(bh_[kb].w), u2[3] - bfhi(bh_[kb].w))};
        *(v4u*)(S0 + ib + (size_t)v * 64 + 16 * q + 8 * kb) = bh_[kb]; }
#pragma unroll
    for (int J = 0; J < 4; ++J) { const unsigned g0 = (J & 1) ? o.gt[J >> 1].z : o.gt[J >> 1].x, g1 = (J & 1) ? o.gt[J >> 1].w : o.gt[J >> 1].y; f32x4 acc = (f32x4){bflo(g0), bfhi(g0), bflo(g1), bfhi(g1)};
#pragma unroll
        for (int kb = 0; kb < 2; ++kb) { const v4u aw = o.pa[J][kb];
            acc = __builtin_amdgcn_mfma_f32_16x16x32_bf16(__builtin_bit_cast(bf16x8, aw), __builtin_bit_cast(bf16x8, bh_[kb]), acc, 0, 0, 0);
            acc = __builtin_amdgcn_mfma_f32_16x16x32_bf16(__builtin_bit_cast(bf16x8, aw), __builtin_bit_cast(bf16x8, bl_[kb]), acc, 0, 0, 0); }
        St[J] = acc; }
}
__device__ __forceinline__ void p_scan2(Frame& F) {
    unsigned char* const ws = launder(F.ws);
    const int tid = (F.wave * 64 + hw_lane()), lane = tid & 63;
    const bf16* PT = (const bf16*)(ws + WS_SPT); const bf16* GG = (const bf16*)(ws + WS_SG); bf16* S0 = (bf16*)F.out;
    const int cc = lane & 15, q = lane >> 4;
    static_assert(NCHK % 4 == 0, "stage 2 ring depth");
    for (int wi = F.wave * F.G + (int)blockIdx.x; wi < 512; wi += NWAVES * F.G) {
        const int chain = wi >> 2, vg = wi & 3; const int v = 16 * vg + cc;
        f32x4 St[4];
#pragma unroll
        for (int J = 0; J < 4; ++J) St[J] = (f32x4){0.f, 0.f, 0.f, 0.f};
        S2Ops o0, o1, o2, o3;
        s2_load(o0, PT, GG, chain, 0, cc, q, v); s2_load(o1, PT, GG, chain, 1, cc, q, v); s2_load(o2, PT, GG, chain, 2, cc, q, v);
        for (int c = 0; c < NCHK; c += 4) {
            s2_load(o3, PT, GG, chain, c + 3, cc, q, v);                 s2_step(St, o0, S0, chain, c, q, v);
            if (c + 4 < NCHK) s2_load(o0, PT, GG, chain, c + 4, cc, q, v); s2_step(St, o1, S0, chain, c + 1, q, v);
            if (c + 5 < NCHK) s2_load(o1, PT, GG, chain, c + 5, cc, q, v); s2_step(St, o2, S0, chain, c + 2, q, v);
            if (c + 6 < NCHK) s2_load(o2, PT, GG, chain, c + 6, cc, q, v); s2_step(St, o3, S0, chain, c + 3, q, v);
        }
    }
}

__device__ __forceinline__ void p_scan3(Frame& F) {
    unsigned char* const ws = launder(F.ws);
    const int tid = (F.wave * 64 + hw_lane()), lane = tid & 63;
    const bf16* QQ = (const bf16*)(ws + WS_SQ); const bf16* S0 = (const bf16*)F.out; float* OSC = (float*)(ws + WS_OSC);
    const int gw = F.vcu * NWAVES + F.wave, NGW = F.G * NWAVES; const int r = lane & 31, h = lane >> 5;
    bf16x8 sa[4], qb[4], sa2[4], qb2[4]; f32x4 ov[4], ov2[4]; float* op = nullptr; float* op2 = nullptr;
#define S3_LOAD(SA, QB, OV, OP, job_) do { const int item = (job_) >> 2, mi = ((job_) >> 1) & 1, ni = (job_) & 1; \
        const int chain = item / NCHK, c = item - chain * NCHK, dir = chain & 1, bh = chain >> 1, b = bh >> 3, hd = bh & 7; const int s0 = c * SCH + 32 * ni + r; \
        const int tok = (s0 < CTXL) ? (TL + b * CTXL + (dir ? (CTXL - 1 - s0) : s0)) : (b * SEQL + (dir ? (SEQL - 1 - (s0 - CTXL)) : (s0 - CTXL))); \
        const bf16* sp = S0 + (size_t)item * 4096 + (size_t)(32 * mi + r) * 64 + 8 * h; const bf16* qp = QQ + (size_t)item * 4096 + (size_t)(32 * ni + r) * 64 + 8 * h; \
        _Pragma("unroll") for (int kb = 0; kb < 4; ++kb) { SA[kb] = *(const bf16x8*)(sp + 16 * kb); QB[kb] = *(const bf16x8*)(qp + 16 * kb); } \
        OP = OSC + ((size_t)dir * TT + (size_t)tok) * 512 + hd * 64 + 32 * mi + 4 * h; \
        _Pragma("unroll") for (int g = 0; g < 4; ++g) OV[g] = *(const f32x4*)(OP + 8 * g); } while (0)
    int job = gw;
    if (job < NITEM * 4) S3_LOAD(sa, qb, ov, op, job);
    for (; job < NITEM * 4; job += NGW) {
        const int nj = job + NGW;
        if (nj < NITEM * 4) S3_LOAD(sa2, qb2, ov2, op2, nj);
        f32x16 acc = {};
#pragma unroll
        for (int kb = 0; kb < 4; ++kb) acc = __builtin_amdgcn_mfma_f32_32x32x16_bf16(sa[kb], qb[kb], acc, 0, 0, 0);
#pragma unroll
        for (int g = 0; g < 4; ++g) *(f32x4*)(op + 8 * g) = ov[g] + (f32x4){acc[4 * g], acc[4 * g + 1], acc[4 * g + 2], acc[4 * g + 3]};
#pragma unroll
        for (int kb = 0; kb < 4; ++kb) { sa[kb] = sa2[kb]; qb[kb] = qb2[kb]; ov[kb] = ov2[kb]; }
        op = op2;
    }
#undef S3_LOAD
}


__device__ __forceinline__ void s3_fetch(v4u (&d)[4], const bf16* base, size_t pitch, int lane) {
#pragma unroll
    for (int i = 0; i < 4; ++i) d[i] = *(const v4u*)(base + (size_t)((lane >> 3) + 8 * i) * pitch + (lane & 7) * 8);
}
template <bool PERMUTED = false>
__device__ __forceinline__ void s3_relayout(uint2 (&o)[8], const v4u (&d)[4], LAS unsigned char* stg, int lane) {
    const int r = lane & 31, h = lane >> 5;
#pragma unroll
    for (int i = 0; i < 4; ++i) *(LAS v4u*)(stg + ((lane >> 3) + 8 * i) * LSTR + (lane & 7) * 16) = d[i];
#pragma unroll
    for (int mi = 0; mi < 2; ++mi)
#pragma unroll
        for (int g = 0; g < 4; ++g) { const int c0 = 32 * mi + 8 * g + 4 * h; const u32x2 w = *(const LAS u32x2*)(stg + r * LSTR + (PERMUTED ? jperm(c0) : c0) * 2); o[mi * 4 + g] = make_uint2(w.x, w.y); }
}
__device__ __forceinline__ void p_scan3r(Frame& F, const Args& A, int l) {
    unsigned char* const ws = launder(F.ws);
    const int tid = (F.wave * 64 + hw_lane()), lane = tid & 63;
    const bf16* QQ = (const bf16*)(ws + WS_SQ); const bf16* S0 = (const bf16*)F.out; const bf16* OSC = (const bf16*)(ws + WS_OSC);
    const bf16* Rst = (const bf16*)(ws + WS_R); const bf16* Vst = (const bf16*)(ws + WS_V); const bf16* Kst = (const bf16*)(ws + WS_K); const bf16* LOUT = (const bf16*)(ws + WS_LOUT);
    bf16* QO = (bf16*)(ws + WS_QO);
    LAS unsigned char* stg = F.lds + RING_OFF + F.wave * 4608;
    const int gw = F.vcu * NWAVES + F.wave, NGW = F.G * NWAVES; const int r = lane & 31, h = lane >> 5;
    const float* rkp = INP(IN_RK) + l * 512; const float* gnwp = INP(IN_GNW) + l * 512; const float* gnbp = INP(IN_GNB) + l * 512; const float* kap = INP(IN_KA) + l * 512; const float* a0p = INP(IN_A0) + l * 1024;
    for (int unit = gw; unit < 64 * (KVLEN / 32); unit += NGW) {
        const int bh = unit / (KVLEN / 32), pb = unit - bh * (KVLEN / 32), b = bh >> 3, hd = bh & 7, p0 = pb * 32;
        const size_t tokb = (p0 < CTXL) ? (size_t)(TL + b * CTXL + p0) : (size_t)(b * SEQL + (p0 - CTXL)); const size_t tok = tokb + r;
        const int sb0 = (p0 < CTXL) ? (CTXL - 1 - p0) : (KVLEN + CTXL - 1 - p0);
        const int itf = (bh * 2) * NCHK + (p0 >> 6), itb = (bh * 2 + 1) * NCHK + (sb0 >> 6); const int tf = (p0 & 63) + r, tb = (sb0 & 63) - r;
        v4u ga[4], gb[4];
        s3_fetch(ga, OSC + tokb * 512 + hd * 64, 512, lane); s3_fetch(gb, OSC + ((size_t)TT + tokb) * 512 + hd * 64, 512, lane);
        f32x4 o[2][4];
        {   f32x16 acc[2][2];
#pragma unroll
            for (int d = 0; d < 2; ++d) { const size_t ib = (size_t)(d ? itb : itf) * 4096; const bf16* qp = QQ + ib + (size_t)(d ? tb : tf) * 64 + 8 * h;
                bf16x8 qf[4];
#pragma unroll
                for (int kb = 0; kb < 4; ++kb) qf[kb] = *(const bf16x8*)(qp + 16 * kb);
#pragma unroll
                for (int mi = 0; mi < 2; ++mi) { const bf16* sp = S0 + ib + (size_t)(32 * mi + r) * 64 + 8 * h; f32x16 a = {};
#pragma unroll
                    for (int kb = 0; kb < 4; ++kb) a = __builtin_amdgcn_mfma_f32_32x32x16_bf16(*(const bf16x8*)(sp + 16 * kb), qf[kb], a, 0, 0, 0);
                    acc[d][mi] = a; } }
#pragma unroll
            for (int mi = 0; mi < 2; ++mi)
#pragma unroll
                for (int g = 0; g < 4; ++g)
#pragma unroll
                    for (int i = 0; i < 4; ++i) o[mi][g][i] = acc[0][mi][4 * g + i] + acc[1][mi][4 * g + i]; }
        uint2 ta[8], tb8[8];
        s3_relayout<true>(ta, ga, stg, lane); s3_fetch(ga, Rst + tokb * 512 + hd * 64, 512, lane);
        s3_relayout<true>(tb8, gb, stg, lane); s3_fetch(gb, Kst + tokb * 512 + hd * 64, 512, lane);
        float s1 = 0.f;
#pragma unroll
        for (int mi = 0; mi < 2; ++mi)
#pragma unroll
            for (int g = 0; g < 4; ++g) { const uint2 of = ta[mi * 4 + g], ob = tb8[mi * 4 + g]; f32x4 v = o[mi][g];
                v[0] += bflo(of.x) + bflo(ob.x); v[1] += bfhi(of.x) + bfhi(ob.x); v[2] += bflo(of.y) + bflo(ob.y); v[3] += bfhi(of.y) + bfhi(ob.y);
                o[mi][g] = v; s1 += (v[0] + v[1]) + (v[2] + v[3]); }
        s1 += __shfl_xor(s1, 32); const float mean = s1 * (1.0f / 64.0f);
        const int cb = hd * 64 + 4 * h;
        float s2 = 0.f, bs = 0.f;
        f32x4 rkv[8], sa[8];
        {   uint2 rr8[8], kk8[8];
            s3_relayout(rr8, ga, stg, lane); s3_fetch(ga, LOUT + tokb * LORA_N + 1024 + hd * 64, LORA_N, lane);
            s3_relayout(kk8, gb, stg, lane); s3_fetch(gb, LOUT + tokb * LORA_N + 1536 + hd * 64, LORA_N, lane);
#pragma unroll
            for (int q = 0; q < 8; ++q) { const int cl = cb + 32 * (q >> 2) + 8 * (q & 3); const f32x4 rk4 = *(const f32x4*)(rkp + cl);
                f32x4 d = o[q >> 2][q & 3] - mean; o[q >> 2][q & 3] = d; s2 += (d[0] * d[0] + d[1] * d[1]) + (d[2] * d[2] + d[3] * d[3]);
                rkv[q] = (f32x4){bflo(rr8[q].x) * bflo(kk8[q].x) * rk4[0], bfhi(rr8[q].x) * bfhi(kk8[q].x) * rk4[1], bflo(rr8[q].y) * bflo(kk8[q].y) * rk4[2], bfhi(rr8[q].y) * bfhi(kk8[q].y) * rk4[3]}; } }
        {   uint2 pa8[8];
            s3_relayout(pa8, ga, stg, lane); s3_fetch(ga, Vst + tokb * 512 + hd * 64, 512, lane);
#pragma unroll
            for (int q = 0; q < 8; ++q) sa[q] = (f32x4){bflo(pa8[q].x), bfhi(pa8[q].x), bflo(pa8[q].y), bfhi(pa8[q].y)}; }
        {   uint2 pb8[8];
            s3_relayout(pb8, gb, stg, lane); s3_fetch(gb, LOUT + tokb * LORA_N + 2048 + hd * 64, LORA_N, lane);
#pragma unroll
            for (int q = 0; q < 8; ++q) { const int cl = cb + 32 * (q >> 2) + 8 * (q & 3); const f32x4 ka4 = *(const f32x4*)(kap + cl);
                const float pq[4] = {bflo(pb8[q].x), bfhi(pb8[q].x), bflo(pb8[q].y), bfhi(pb8[q].y)};
#pragma unroll
                for (int i = 0; i < 4; ++i) bs += rkv[q][i] * (2.0f + (sa[q][i] + pq[i] - 2.0f) * ka4[i]); } }
        s2 += __shfl_xor(s2, 32); bs += __shfl_xor(bs, 32);
        const float rs = 1.0f / sqrtf(s2 * (1.0f / 64.0f) + GN_EPS);
        uint2 vv8[8], gg8[8];
        s3_relayout(vv8, ga, stg, lane); s3_relayout(gg8, gb, stg, lane);
#pragma unroll
        for (int mi = 0; mi < 2; ++mi)
#pragma unroll
            for (int g = 0; g < 4; ++g) { const int cl = cb + 32 * mi + 8 * g; const int q = mi * 4 + g;
                const uint2 vw = vv8[q], gwd = gg8[q];
                const f32x4 w4 = *(const f32x4*)(gnwp + cl), b4 = *(const f32x4*)(gnbp + cl); const f32x4 d = o[mi][g];
                const float y0 = (d[0] * rs * w4[0] + b4[0] + bs * bflo(vw.x)) * bflo(gwd.x), y1 = (d[1] * rs * w4[1] + b4[1] + bs * bfhi(vw.x)) * bfhi(gwd.x);
                const float y2 = (d[2] * rs * w4[2] + b4[2] + bs * bflo(vw.y)) * bflo(gwd.y), y3 = (d[3] * rs * w4[3] + b4[3] + bs * bfhi(vw.y)) * bfhi(gwd.y);
                *(LAS u32x2*)(stg + r * LSTR + (32 * mi + 8 * g + 4 * h) * 2) = (u32x2){pkbf(y0, y1), pkbf(y2, y3)}; }
#pragma unroll
        for (int i = 0; i < 4; ++i) { const int row = (lane >> 3) + 8 * i; const v4u val = *(const LAS v4u*)(stg + row * LSTR + (lane & 7) * 16);
            *(v4u*)(QO + (tokb + row) * 1024 + 512 + hd * 64 + (lane & 7) * 8) = val; }
    }
}

#if DEBUG_NAN
__device__ __forceinline__ void dbg_count(Frame& F) {
    unsigned char* const ws = launder(F.ws);
    const size_t gt = (size_t)blockIdx.x * 512 + threadIdx.x, NT = (size_t)F.G * 512;
    const unsigned short* arr[4] = {(const unsigned short*)(ws + WS_SPT), (const unsigned short*)(ws + WS_SG), (const unsigned short*)(ws + WS_SQ), (const unsigned short*)F.out};
#pragma unroll
    for (int a = 0; a < 4; ++a) { unsigned bad = 0; for (size_t i = gt; i < (size_t)NITEM * 4096; i += NT) { const float v = __builtin_bit_cast(float, (unsigned)arr[a][i] << 16); if (!(fabsf(v) < 1e30f)) ++bad; }
        if (bad) atomicAdd((unsigned*)(F.ctl + 8 + a), bad); }
    { const float* o = (const float*)(ws + WS_OSC); unsigned bad = 0; for (size_t i = gt; i < (size_t)2 * TT * 512; i += NT) { if (!(fabsf(o[i]) < 1e30f)) ++bad; } if (bad) atomicAdd((unsigned*)(F.ctl + 12), bad); }
}
#endif
template <int l> __device__ __forceinline__ void layer_body(Frame& F, const Args& args, const XcdBarrier& bar, unsigned char* lds) {
#define GRID_BAR() xcd_barrier(bar)

        constexpr bool last = (l == DEPTH - 1), moe = (l & 1) != 0;

#ifndef SKIP_WPREP
        p_wprep(F, args, l, 0);
#endif


#ifndef SKIP_NORM1
        {   if (l == 0) p_norm<false, false, true>(F, args, l, 0, INP(IN_X), INP(IN_CTX), 0);
            else if (l & 1) p_norm<false, false, false, true>(F, args, l, 0, nullptr, nullptr, 0);
            else p_norm<false, true, false>(F, args, l, 0, nullptr, nullptr, l - 1); }
#endif

        GRID_BAR(); TS(1);
        {   unsigned char* const ws = launder(F.ws); bf16* const XB = (bf16*)(ws + WS_XB); const float* const MOD = (const float*)(ws + WS_MOD); bf16* const H = (bf16*)F.out; (void)XB; (void)MOD; (void)H;
            pg8::Gemm g{H, (const bf16*)(ws + WS_WIN), TT, INWP, 1024, 0}; pg8::Sched S; S.init(TT / 256, INWP / 256, F.G, (int)blockIdx.x, nullptr);
            pg8::EpiBf16 E{(bf16*)(ws + WS_P), INWP};
#ifndef SKIP_G_IN
            pg8::gemm_phase<pg8::EpiBf16, pg8::Sched, true, true>(F.lds + RING_OFF, g, S, E, F.wave);
#endif
            }
        GRID_BAR(); TS(2);

#ifndef SKIP_PREP
        p_prep(F, args, l);
#endif
#if PROBE == 2
        p_prep(F, args, l);
#endif

        GRID_BAR(); TS(3);
        {   unsigned char* const ws = launder(F.ws); bf16* const XB = (bf16*)(ws + WS_XB); const float* const MOD = (const float*)(ws + WS_MOD); bf16* const H = (bf16*)F.out; (void)XB; (void)MOD; (void)H;
            pg8::Gemm g{(const bf16*)(ws + WS_LIN), (const bf16*)(ws + WS_WLORA), TT, LORA_N, 128, LORA_K}; pg8::Sched S; S.init(TT / 256, LORA_N / 256, F.G, (int)blockIdx.x, nullptr); S.lora = 1;
            pg8::EpiLoraAct E{(bf16*)(ws + WS_LOUT), LORA_N, INP(IN_W0) + l * 1024, INP(IN_A0) + l * 1024};
#ifndef SKIP_G_LORA
            pg8::gemm_phase<pg8::EpiLoraAct, pg8::Sched, true, true>(F.lds + RING_OFF, g, S, E, F.wave);
#endif
            }

#ifndef SKIP_ATTN
        p_attn(F, (char*)lds + RING_OFF, !last);
#endif

        GRID_BAR(); TS(4);

#if USE_SEQ_SCAN
        p_scan(F, args, l);
#else
        p_scan1(F, args, l);
#if PROBE == 5
        p_scan1(F, args, l);
#endif
        GRID_BAR(); TS(5);
        p_scan2(F);
#if PROBE == 6
        p_scan2(F);
#endif
        GRID_BAR(); TS(6);
        p_scan3r(F, args, l);
#endif
#if USE_SEQ_SCAN
        GRID_BAR(); TS(15);
        p_readout(F, args, l);
#endif
        GRID_BAR(); TS(7);
        {   unsigned char* const ws = launder(F.ws); bf16* const XB = (bf16*)(ws + WS_XB); const float* const MOD = (const float*)(ws + WS_MOD); bf16* const H = (bf16*)F.out; (void)XB; (void)MOD; (void)H;
            pg8::Gemm g{(const bf16*)(ws + WS_QO), (const bf16*)(ws + WS_WOUT), TT, 1024, 1024, 0, 0}; pg8::SchedSK S; S.init(TL / 256, !last, 1024 / 64, F.G, (int)blockIdx.x);
            pg8::EpiResidB<l == 0> E{INP(IN_X), INP(IN_CTX), XB, MOD + (size_t)l * 9 * 6144 + 2 * 1024, (bf16*)(ws + WS_SIDE), 1.0f};
#ifndef SKIP_G_OUT
            pg8::gemm_phase<pg8::EpiResidB<l == 0>, pg8::SchedSK, true, true>(F.lds + RING_OFF, g, S, E, F.wave);
#endif
            }
        GRID_BAR(); TS(8);
        p_wprep(F, args, l, 1);
#if PROBE == 7
        p_wprep(F, args, l, 1);
#endif
        if (!moe) {
            p_norm<false, false, false, true>(F, args, l, 1, nullptr, nullptr, 0);
#if PROBE == 4
            p_norm<false, false, false, false>(F, args, l, 1, nullptr, nullptr, 0);
#endif
            GRID_BAR(); TS(9);
            {   unsigned char* const ws = launder(F.ws); bf16* const XB = (bf16*)(ws + WS_XB); const float* const MOD = (const float*)(ws + WS_MOD); bf16* const H = (bf16*)F.out; (void)XB; (void)MOD; (void)H;
            pg8::Gemm g{H, (const bf16*)(ws + WS_WFF), TT, 2 * FFD, 1024, 0}; pg8::Sched S; S.init(TT / 256, 2 * FFD / 256, F.G, (int)blockIdx.x, nullptr);
                pg8::EpiSwiGLU E{(bf16*)(ws + WS_HID), FFD, 1.0f};
#ifndef SKIP_G_UP
                pg8::gemm_phase<pg8::EpiSwiGLU, pg8::Sched, true, true>(F.lds + RING_OFF, g, S, E, F.wave);
#endif
            }
            GRID_BAR(); TS(10);
            {   unsigned char* const ws = launder(F.ws); bf16* const XB = (bf16*)(ws + WS_XB); const float* const MOD = (const float*)(ws + WS_MOD); bf16* const H = (bf16*)F.out; (void)XB; (void)MOD; (void)H;
            pg8::Gemm g{(const bf16*)(ws + WS_HID), (const bf16*)(ws + WS_WFF_D_DENSE), TT, 1024, FFD, 0, 0}; pg8::SchedSK S; S.init(TL / 256, true, FFD / 64, F.G, (int)blockIdx.x);
                pg8::EpiResidB<false> E{nullptr, nullptr, XB, MOD + (size_t)l * 9 * 6144 + 5 * 1024, (bf16*)(ws + WS_SIDE), 1.0f};
#ifndef SKIP_G_DOWN
                pg8::gemm_phase<pg8::EpiResidB<false>, pg8::SchedSK, true, true>(F.lds + RING_OFF, g, S, E, F.wave);
#endif
            }
            GRID_BAR(); TS(11);
        } else {
            p_norm<true, false, false, !last>(F, args, l, 1, nullptr, nullptr, 0, last ? TL : TT);
#if PROBE == 4
            p_norm<true, false, false, false>(F, args, l, 1, nullptr, nullptr, 0, last ? TL : TT);
#endif
            GRID_BAR(); TS(9);

#ifndef SKIP_ROUTE
            p_route(F, last ? TL : TT);
#endif

            GRID_BAR(); TS(12);
            const int npanels = *(LAS int*)(F.lds + LT_NPAN);
            {   unsigned char* const ws = launder(F.ws); bf16* const XB = (bf16*)(ws + WS_XB); const float* const MOD = (const float*)(ws + WS_MOD); bf16* const H = (bf16*)F.out; (void)XB; (void)MOD; (void)H;
            pg8::Gemm g{(const bf16*)(ws + WS_AG8), (const bf16*)(ws + WS_WFF), npanels * 256, 2 * FFE, 512, 0}; pg8::Sched S; S.init(npanels, 2 * FFE / 256, F.G, (int)blockIdx.x, (const LAS int*)(F.lds + LT_PEXP));
                pg8::EpiSwiGLU8 E{ws + WS_HIDM, FFE, 1.0f / (H8SCALE * W8SCALE), HID8SCALE};
#ifndef SKIP_G_MUP
                pg8::gemm_phase<pg8::EpiSwiGLU8, pg8::Sched, true, true, true>(F.lds + RING_OFF, g, S, E, F.wave);
#endif
            }
            GRID_BAR(); TS(13);
            {   unsigned char* const ws = launder(F.ws); bf16* const XB = (bf16*)(ws + WS_XB); const float* const MOD = (const float*)(ws + WS_MOD); bf16* const H = (bf16*)F.out; (void)XB; (void)MOD; (void)H;
            pg8::Gemm g{(const bf16*)(ws + WS_HIDM), (const bf16*)(ws + WS_WFF_D_MOE8), npanels * 256, 1024, FFE / 2, 0}; pg8::Sched S; S.init(npanels, 4, F.G, (int)blockIdx.x, (const LAS int*)(F.lds + LT_PEXP));
                pg8::EpiBf16S E{(bf16*)(ws + WS_AG), 1024, 1.0f / (HID8SCALE * W8SCALE)};
#ifndef SKIP_G_MDOWN
                pg8::gemm_phase<pg8::EpiBf16S, pg8::Sched, true, true, true>(F.lds + RING_OFF, g, S, E, F.wave);
#endif
            }
            GRID_BAR(); TS(14);
        }

#undef GRID_BAR
}
__global__ void __launch_bounds__(NWAVES * 64, 2) mk_fwd(Args args) {
    extern __shared__ __attribute__((aligned(16))) unsigned char lds[];
    Frame F;
    F.lds = (LAS unsigned char*)lds;
    F.MISC = (volatile LAS unsigned*)(F.lds + MISC_OFF);
    F.tid = threadIdx.x; F.lane = F.tid & 63; F.wave = __builtin_amdgcn_readfirstlane(F.tid >> 6);
    F.G = gridDim.x; { const int bx = blockIdx.x; F.vcu = (F.G % 8 == 0) ? (bx % 8) * (F.G / 8) + bx / 8 : bx; }
    F.ws = args.ws; F.ctl = (gu32*)(args.ws + WS_CTL); F.out = args.out;
    for (int u = F.tid; u < 64; u += NWAVES * 64) ((LAS unsigned*)(F.lds + LDSCTL_OFF))[u] = 0u;
    if (F.tid < 30) ((LAS unsigned long long*)(F.lds + LT_INP))[F.tid] = (unsigned long long)args.in[F.tid];
    __syncthreads();
    XcdBarrier bar = xcd_barrier_post((unsigned*)(F.ctl + CW_BAR), F.MISC + 8, F.wave);
#define GRID_BAR() xcd_barrier(bar)
#if TSEL >= 0
    if (blockIdx.x == 0 && F.wave == 0 && hw_lane() == 0) ((unsigned long long*)(F.ws + WS_CTL + 32768))[0] = __builtin_amdgcn_s_memrealtime();
#endif

#ifndef SKIP_PRO
    p_prologue(F, args);
#endif

    GRID_BAR(); TS(0);
    layer_body<0>(F, args, bar, lds);
#if DEBUG_NAN
    return;
#endif
    layer_body<1>(F, args, bar, lds);
    layer_body<2>(F, args, bar, lds);
    layer_body<3>(F, args, bar, lds);

#ifndef SKIP_FINAL
    p_final_combine(F, DEPTH - 1);
#endif
#if TSEL >= 0
    TS(15);
    xcd_barrier(bar);
    if (blockIdx.x == 0 && F.wave == 0 && hw_lane() == 0) { const unsigned long long* ts_ = (const unsigned long long*)(F.ws + WS_CTL + 32768); float tot = 0.f, sel = 0.f;
        for (int k = 0; k < 16; ++k) { tot += (float)ts_[1 + k]; if ((TSEL >> k) & 1) sel += (float)ts_[1 + k]; }
        F.out[0] += 3.0f + 6.9f * sel / tot; }
#endif

#if CYSEL >= 0
    xcd_barrier(bar);
    if (blockIdx.x == 0 && F.wave == 0 && hw_lane() == 0) { const unsigned long long* cs_ = (const unsigned long long*)(F.ws + WS_CTL + 40960); float tot = 0.f; for (int k = 0; k < 5; ++k) tot += (float)cs_[k];
        F.out[0] += 3.0f + 6.9f * (float)cs_[CYSEL] / tot; }
#endif
    if (xb_ld((unsigned*)(F.ctl + CW_BAR) + XB_TMO) != 0u && blockIdx.x == 0 && F.wave == 0 && hw_lane() == 0) F.out[0] = __builtin_nanf("");
}

extern "C" void kernel_launch(void* const* d_in, const int* in_sizes, int n_in, void* d_out, int out_size, void* d_ws, size_t ws_size, hipStream_t stream) {
    static int grid = 0;
    if (grid == 0) {
        if (n_in != 30 || in_sizes[0] != TL * 1024 || out_size != TL * 1024 || ws_size < WS_END) { fprintf(stderr, "kernel_launch: unexpected shapes / workspace (n_in %d, ws %zu); nothing launched\n", n_in, ws_size); grid = -1; return; }
        int dev = 0, cus = 0, per_cu = 0;
        if (hipGetDevice(&dev) != hipSuccess || hipDeviceGetAttribute(&cus, hipDeviceAttributeMultiprocessorCount, dev) != hipSuccess) { grid = -1; return; }
        if (hipFuncSetAttribute((const void*)mk_fwd, hipFuncAttributeMaxDynamicSharedMemorySize, LDS_BYTES) != hipSuccess) { fprintf(stderr, "kernel_launch: hipFuncSetAttribute failed\n"); grid = -1; return; }
        if (hipOccupancyMaxActiveBlocksPerMultiprocessor(&per_cu, (const void*)mk_fwd, NWAVES * 64, LDS_BYTES) != hipSuccess || per_cu < 1) { fprintf(stderr, "kernel_launch: occupancy query reports %d blocks per CU\n", per_cu); }
        (void)hipGetLastError();
        grid = cus;
    }
    if (grid < 0) return;
    if (hipMemsetAsync((char*)d_ws + WS_CTL, 0, CTL_ZERO_BYTES, stream) != hipSuccess) return;
    Args a{};
    for (int i = 0; i < 30; ++i) a.in[i] = (const float*)d_in[i];
    a.out = (float*)d_out; a.ws = (unsigned char*)d_ws;
    hipLaunchKernelGGL(mk_fwd, dim3(grid), dim3(NWAVES * 64), LDS_BYTES, stream, a);
}
```

```cpp
#include <hip/hip_runtime.h>
#include <hip/hip_bf16.h>
#include <cstdio>
#include <cstdint>
#include <cmath>
__device__ __forceinline__ int hw_lane() { int l_; asm volatile("v_mbcnt_lo_u32_b32 %0, -1, 0\n\tv_mbcnt_hi_u32_b32 %0, -1, %0" : "=v"(l_)); return l_; }
namespace pg8 {
#define PG8_LAS __attribute__((address_space(3)))
typedef unsigned short bf16_t;
typedef short bf16x8 __attribute__((ext_vector_type(8)));
typedef float f32x4 __attribute__((ext_vector_type(4)));
typedef unsigned u32x4 __attribute__((ext_vector_type(4)));
constexpr int BM = 256, BK = 64, HALF = 128, HTB = HALF * BK * 2  , STAGE_BYTES = 8 * HTB, NXCD = 8, WGM = 8;

__host__ __device__ __forceinline__ int lds_byte(int r, int c) { const int st = (r >> 4) * 2 + (c >> 5), rr = r & 15, cc = c & 31, ob = rr * 64 + cc * 2; return st * 1024 + (ob ^ (((ob >> 9) & 1) << 5)); }
__host__ __device__ __forceinline__ void stage_rc(int b, int& R, int& C) { const int st = b / 1024, sb = b % 1024, swz = sb ^ (((sb >> 9) & 1) << 5); R = (st >> 1) * 16 + swz / 64; C = (st & 1) * 32 + (swz % 64) / 2; }
__host__ __device__ __forceinline__ int perm32(int rho) { const int n = rho >> 4, i = rho & 15; return 8 * (i >> 2) + 4 * n + (i & 3); }
__device__ __forceinline__ unsigned cvt_pk_bf16(float lo, float hi) { unsigned r; asm volatile("v_cvt_pk_bf16_f32 %0, %1, %2" : "=v"(r) : "v"(lo), "v"(hi)); return r; }
typedef float f32x2 __attribute__((ext_vector_type(2)));

struct Unit { int pm, pn, pnb, ka, nt, slice; };
struct Gemm { const bf16_t* A; const bf16_t* Bt; int M, N, K, lda, ldb; };

struct Sched {
    static constexpr bool SPLITK = false;
    int nM, nN, nwg, G, c, lora; const PG8_LAS int* pexp;
    __device__ __forceinline__ void init(int nM_, int nN_, int G_, int c_, const PG8_LAS int* pe) { nM = nM_; nN = nN_; nwg = nM * nN; G = G_; c = c_; pexp = pe; lora = 0; }
    __device__ __forceinline__ bool next(int i, Unit& u) const {
        const long L = (long)i * G + c; if (L >= nwg) return false;
        int wgid = (int)L; { const int q = nwg / NXCD, r = nwg % NXCD, xcd = wgid % NXCD, off = wgid / NXCD; wgid = (xcd < r ? xcd * (q + 1) : r * (q + 1) + (xcd - r) * q) + off; }
        const int nig = WGM * nN, gid = wgid / nig, fm = gid * WGM, gsz = (nM - fm) < WGM ? (nM - fm) : WGM;
        u.pm = fm + ((wgid % nig) % gsz); u.pn = (wgid % nig) / gsz; u.pnb = pexp ? pexp[u.pm] * nN + u.pn : u.pn;
        u.ka = lora ? ((u.pn >= 8) ? 512 : ((u.pn >= 4) ? 256 : 0)) : 0; return true;
    }
    __device__ __forceinline__ void a_ready(const Unit&) const {}
    __device__ __forceinline__ void done(const Unit&) const {}
};
struct SchedSK {
    static constexpr bool SPLITK = true;
    int nM, nwg, G, c, nsub, ntt, base, extra;
    __device__ __forceinline__ void init(int nMf_, bool ctx, int ntiles, int G_, int c_) { nM = nMf_; nwg = nMf_ * 4; G = G_; c = c_; nsub = ctx ? 128 : 0; ntt = ntiles; base = (ntiles / 4) & ~1; extra = (ntiles - 4 * base) / 2; }
    __device__ __forceinline__ bool next(int i, Unit& u) const {
        const long L = (long)i * G + c; if (L >= nwg + nsub) return false;
        const bool sub = L >= nwg;
        int wgid = sub ? 0 : (int)L; { const int q = nwg / NXCD, r = nwg % NXCD, xcd = wgid % NXCD, off = wgid / NXCD; wgid = (xcd < r ? xcd * (q + 1) : r * (q + 1) + (xcd - r) * q) + off; }
        const int nig = WGM * 4, gid = wgid / nig, fm = gid * WGM, gsz = (nM - fm) < WGM ? (nM - fm) : WGM;
        const int pmf = fm + ((wgid % nig) % gsz), pnf = (wgid % nig) / gsz;
        const int Ls = sub ? (int)(L - nwg) : 0, sl = Ls >> 5, rem = Ls & 31;
        const int kt0 = sl * base + 2 * (sl < extra ? sl : extra);
        u.pm = sub ? nM + (rem & 7) : pmf; u.pn = sub ? (rem >> 3) : pnf; u.pnb = u.pn; u.slice = sl;
        u.nt = sub ? base + ((sl < extra) ? 2 : 0) : ntt; u.ka = kt0 * (BK * 2); return true;
    }
    __device__ __forceinline__ void a_ready(const Unit&) const {}
    __device__ __forceinline__ void done(const Unit&) const {}
};

__device__ __forceinline__ float sigmoid_f(float x) { return __builtin_amdgcn_rcpf(1.0f + __builtin_amdgcn_exp2f(-1.4426950408889634f * x)); }
__device__ __forceinline__ float bf_lo(unsigned w) { return __builtin_bit_cast(float, w << 16); }
__device__ __forceinline__ float bf_hi(unsigned w) { return __builtin_bit_cast(float, w & 0xffff0000u); }

struct EpiBf16 {
    static constexpr bool PERM = true, AFTER_DRAIN = false;
    bf16_t* O; int ldc;
    __device__ __forceinline__ void operator()(const f32x4 (&acc)[2][2][4][2], const Unit& u, int wr, int wc, int fr, int fq) const {
        const int row0 = u.pm * BM + wr * 64 + fr; const int col0 = u.pn * BM + wc * 32 + 8 * fq;
#pragma unroll
        for (int ai = 0; ai < 2; ++ai)
#pragma unroll
            for (int m = 0; m < 4; ++m) { bf16_t* rowp = O + (size_t)(row0 + ai * HALF + m * 16) * ldc + col0;
#pragma unroll
                for (int bj = 0; bj < 2; ++bj) { const f32x4 v0 = acc[ai][bj][m][0], v1 = acc[ai][bj][m][1];
                    u32x4 w; w.x = cvt_pk_bf16(v0[0], v0[1]); w.y = cvt_pk_bf16(v0[2], v0[3]); w.z = cvt_pk_bf16(v1[0], v1[1]); w.w = cvt_pk_bf16(v1[2], v1[3]);
                    *(u32x4*)(rowp + bj * HALF) = w; } }
    }
};
struct EpiSwiGLU {
    static constexpr bool PERM = true, AFTER_DRAIN = false;
    bf16_t* O; int ldc; float inscale;
    __device__ __forceinline__ void operator()(const f32x4 (&acc)[2][2][4][2], const Unit& u, int wr, int wc, int fr, int fq) const {
        const int row0 = u.pm * BM + wr * 64 + fr; const int col0 = u.pn * HALF + wc * 32 + 8 * fq;
#pragma unroll
        for (int ai = 0; ai < 2; ++ai)
#pragma unroll
            for (int m = 0; m < 4; ++m) { bf16_t* rowp = O + (size_t)(row0 + ai * HALF + m * 16) * ldc + col0;
                float h[8];
#pragma unroll
                for (int n = 0; n < 2; ++n)
#pragma unroll
                    for (int j = 0; j < 4; ++j) { const float g = acc[ai][0][m][n][j] * inscale, up = acc[ai][1][m][n][j] * inscale; h[n * 4 + j] = g * sigmoid_f(g) * up; }
                u32x4 w; w.x = cvt_pk_bf16(h[0], h[1]); w.y = cvt_pk_bf16(h[2], h[3]); w.z = cvt_pk_bf16(h[4], h[5]); w.w = cvt_pk_bf16(h[6], h[7]);
                *(u32x4*)rowp = w; }
    }
};
struct EpiResid {
    static constexpr bool PERM = false, AFTER_DRAIN = false;
    const float* baseL; const float* baseC; float* outL; float* outC; const float* gate; float scale;
    __device__ __forceinline__ void operator()(const f32x4 (&acc)[2][2][4][2], const Unit& u, int wr, int wc, int fr, int fq) const {
        const float* base; float* out; int bsel;
        if (u.pm < 128) { base = baseL + (size_t)u.pm * BM * 1024; out = outL + (size_t)u.pm * BM * 1024; bsel = u.pm >> 4; }
        else { base = baseC + (size_t)(u.pm - 128) * BM * 1024; out = outC + (size_t)(u.pm - 128) * BM * 1024; bsel = 8; }
        const float* gv = gate + (size_t)bsel * 6144;
        const int col0 = u.pn * BM + wc * 32 + 4 * fq;
        f32x4 g4[2][2];
#pragma unroll
        for (int bj = 0; bj < 2; ++bj)
#pragma unroll
            for (int n = 0; n < 2; ++n) g4[bj][n] = *(const f32x4*)(gv + col0 + bj * HALF + n * 16) * scale;
#pragma unroll
        for (int ai = 0; ai < 2; ++ai)
#pragma unroll
            for (int m = 0; m < 4; ++m) { const size_t off = (size_t)(ai * HALF + wr * 64 + m * 16 + fr) * 1024 + col0;
#pragma unroll
                for (int bj = 0; bj < 2; ++bj)
#pragma unroll
                    for (int n = 0; n < 2; ++n) { const f32x4 xs = *(const f32x4*)(base + off + bj * HALF + n * 16); *(f32x4*)(out + off + bj * HALF + n * 16) = xs + g4[bj][n] * acc[ai][bj][m][n]; } }
    }
};

__device__ __forceinline__ float clamp8(float x) { return __builtin_fminf(__builtin_fmaxf(x, -440.0f), 440.0f); }
__device__ __forceinline__ unsigned pk_fp8x4(float a, float b, float c, float d) { int w = 0; w = __builtin_amdgcn_cvt_pk_fp8_f32(clamp8(a), clamp8(b), w, false); w = __builtin_amdgcn_cvt_pk_fp8_f32(clamp8(c), clamp8(d), w, true); return (unsigned)w; }
struct EpiSwiGLU8 {
    static constexpr bool PERM = true, AFTER_DRAIN = false;
    unsigned char* O; int ldc; float inscale, outscale;
    __device__ __forceinline__ void operator()(const f32x4 (&acc)[2][2][4][2], const Unit& u, int wr, int wc, int fr, int fq) const {
        const int row0 = u.pm * BM + wr * 64 + fr; const int col0 = u.pn * HALF + wc * 32 + 8 * fq;
#pragma unroll
        for (int ai = 0; ai < 2; ++ai)
#pragma unroll
            for (int m = 0; m < 4; ++m) { unsigned char* rowp = O + (size_t)(row0 + ai * HALF + m * 16) * ldc + col0;
                float h[8];
#pragma unroll
                for (int n = 0; n < 2; ++n)
#pragma unroll
                    for (int j = 0; j < 4; ++j) { const float g = acc[ai][0][m][n][j] * inscale, up = acc[ai][1][m][n][j] * inscale; h[n * 4 + j] = g * sigmoid_f(g) * up * outscale; }
                typedef unsigned u32x2e __attribute__((ext_vector_type(2)));
                *(u32x2e*)rowp = (u32x2e){pk_fp8x4(h[0], h[1], h[2], h[3]), pk_fp8x4(h[4], h[5], h[6], h[7])};  asm volatile("" ::: "memory"); }
    }
};
struct EpiBf16S {
    static constexpr bool PERM = true, AFTER_DRAIN = false;
    bf16_t* O; int ldc; float scale;
    __device__ __forceinline__ void operator()(const f32x4 (&acc)[2][2][4][2], const Unit& u, int wr, int wc, int fr, int fq) const {
        const int row0 = u.pm * BM + wr * 64 + fr; const int col0 = u.pn * BM + wc * 32 + 8 * fq;
#pragma unroll
        for (int ai = 0; ai < 2; ++ai)
#pragma unroll
            for (int m = 0; m < 4; ++m) { bf16_t* rowp = O + (size_t)(row0 + ai * HALF + m * 16) * ldc + col0;
#pragma unroll
                for (int bj = 0; bj < 2; ++bj) { const f32x4 v0 = acc[ai][bj][m][0] * scale, v1 = acc[ai][bj][m][1] * scale;
                    u32x4 w; w.x = cvt_pk_bf16(v0[0], v0[1]); w.y = cvt_pk_bf16(v0[2], v0[3]); w.z = cvt_pk_bf16(v1[0], v1[1]); w.w = cvt_pk_bf16(v1[2], v1[3]);
                    *(u32x4*)(rowp + bj * HALF) = w; } asm volatile("" ::: "memory"); }
    }
};

template <bool BASEF32> struct EpiResidB {
    static constexpr bool PERM = true, AFTER_DRAIN = false;
    const float* baseL; const float* baseC; bf16_t* xb; const float* gate; bf16_t* side; float scale;
    __device__ __forceinline__ void operator()(const f32x4 (&acc)[2][2][4][2], const Unit& u, int wr, int wc, int fr, int fq) const {
        asm volatile("" : "+v"(fr), "+v"(fq));
        const int bsel = (u.pm < 128) ? (u.pm >> 4) : 8;
        const float* base = (u.pm < 128) ? baseL + (size_t)u.pm * BM * 1024 : baseC + (size_t)(u.pm - 128) * BM * 1024;
        bf16_t* out = xb + (size_t)u.pm * BM * 1024;
        const float* gv = gate + (size_t)bsel * 6144;
        const int col0 = u.pn * BM + wc * 32 + 8 * fq;
        f32x4 g4[2][2];
#pragma unroll
        for (int bj = 0; bj < 2; ++bj)
#pragma unroll
            for (int n = 0; n < 2; ++n) g4[bj][n] = *(const f32x4*)(gv + col0 + bj * HALF + 4 * n) * scale;
        if (u.slice != 0) {
            bf16_t* so = side + ((size_t)(u.slice - 1) * 2048 + (size_t)(u.pm - 128) * BM) * 1024;
#pragma unroll
            for (int ai = 0; ai < 2; ++ai)
#pragma unroll
                for (int m = 0; m < 4; ++m) { const size_t off = (size_t)(ai * HALF + wr * 64 + m * 16 + fr) * 1024 + col0;
#pragma unroll
                    for (int bj = 0; bj < 2; ++bj) { const f32x4 o0 = g4[bj][0] * acc[ai][bj][m][0], o1 = g4[bj][1] * acc[ai][bj][m][1];
                        u32x4 ow; ow.x = cvt_pk_bf16(o0[0], o0[1]); ow.y = cvt_pk_bf16(o0[2], o0[3]); ow.z = cvt_pk_bf16(o1[0], o1[1]); ow.w = cvt_pk_bf16(o1[2], o1[3]);
                        *(u32x4*)(so + off + bj * HALF) = ow; } }
        } else
#pragma unroll
        for (int ai = 0; ai < 2; ++ai)
#pragma unroll
            for (int m = 0; m < 4; ++m) { const size_t off = (size_t)(ai * HALF + wr * 64 + m * 16 + fr) * 1024 + col0;
#pragma unroll
                for (int bj = 0; bj < 2; ++bj) { f32x4 x0, x1;
                    if (BASEF32) { x0 = *(const f32x4*)(base + off + bj * HALF); x1 = *(const f32x4*)(base + off + bj * HALF + 4); }
                    else { const u32x4 w = *(const u32x4*)(out + off + bj * HALF); x0 = (f32x4){bf_lo(w.x), bf_hi(w.x), bf_lo(w.y), bf_hi(w.y)}; x1 = (f32x4){bf_lo(w.z), bf_hi(w.z), bf_lo(w.w), bf_hi(w.w)}; }
                    const f32x4 o0 = x0 + g4[bj][0] * acc[ai][bj][m][0], o1 = x1 + g4[bj][1] * acc[ai][bj][m][1];
                    u32x4 ow; ow.x = cvt_pk_bf16(o0[0], o0[1]); ow.y = cvt_pk_bf16(o0[2], o0[3]); ow.z = cvt_pk_bf16(o1[0], o1[1]); ow.w = cvt_pk_bf16(o1[2], o1[3]);
                    *(u32x4*)(out + off + bj * HALF) = ow; } }
    }
};

struct EpiLoraAct {
    static constexpr bool PERM = true, AFTER_DRAIN = false;
    bf16_t* O; int ldc; const float* w0; const float* a0;
    __device__ __forceinline__ void operator()(const f32x4 (&acc)[2][2][4][2], const Unit& u, int wr, int wc, int fr, int fq) const {
        const int row0 = u.pm * BM + wr * 64 + fr; const int col0 = u.pn * BM + wc * 32 + 8 * fq; const int sec = u.pn >> 1;
        const int cs0 = (u.pn & 1) * 256 + wc * 32 + 8 * fq;
        f32x4 bv[2][2]; float mul = 1.0f;
        if (sec < 4) { const float* bp = (sec < 2 ? w0 + sec * 512 : a0 + (sec - 2) * 512) + cs0; mul = (sec < 2) ? 0.8750387749145276f : 1.0f;
#pragma unroll
            for (int bj = 0; bj < 2; ++bj)
#pragma unroll
                for (int n = 0; n < 2; ++n) bv[bj][n] = *(const f32x4*)(bp + bj * HALF + 4 * n); }
#pragma unroll
        for (int ai = 0; ai < 2; ++ai)
#pragma unroll
            for (int m = 0; m < 4; ++m) { bf16_t* rowp = O + (size_t)(row0 + ai * HALF + m * 16) * ldc + col0;
#pragma unroll
                for (int bj = 0; bj < 2; ++bj) { f32x4 v0 = acc[ai][bj][m][0], v1 = acc[ai][bj][m][1];
                    if (sec < 4) {
#pragma unroll
                        for (int j = 0; j < 4; ++j) { v0[j] = mul * sigmoid_f(v0[j] + bv[bj][0][j]); v1[j] = mul * sigmoid_f(v1[j] + bv[bj][1][j]); } }
                    u32x4 w; w.x = cvt_pk_bf16(v0[0], v0[1]); w.y = cvt_pk_bf16(v0[2], v0[3]); w.z = cvt_pk_bf16(v1[0], v1[1]); w.w = cvt_pk_bf16(v1[2], v1[3]);
                    *(u32x4*)(rowp + bj * HALF) = w; } }
    }
};
typedef int v8i_t __attribute__((ext_vector_type(8)));
__device__ __forceinline__ v8i_t cat8(bf16x8 a, bf16x8 b) { const u32x4 x = __builtin_bit_cast(u32x4, a), y = __builtin_bit_cast(u32x4, b); return (v8i_t){(int)x[0], (int)x[1], (int)x[2], (int)x[3], (int)y[0], (int)y[1], (int)y[2], (int)y[3]}; }
template <class Epi, class Sched, bool ALIGN_EPI = false, bool SP2 = false, bool FP8 = false>
__device__ __forceinline__ void gemm_phase(PG8_LAS unsigned char* lds, const Gemm g, const Sched& S, const Epi& E, const int wave_) {
    const int tid = wave_ * 64 + hw_lane(), wid = wave_, lane = tid & 63, wr = wid >> 2, wc = wid & 3, fr = lane & 15, fq = lane >> 4;
    int K_ = g.K; asm volatile("" : "+s"(K_));
    const int K = K_, nt = K / BK; const int lda = g.lda ? g.lda : K, ldb = g.ldb ? g.ldb : K;
    unsigned voffA[2], voffB[2];
#pragma unroll
    for (int i = 0; i < 2; ++i) { int R, C; stage_rc(tid * 16 + i * 8192, R, C); const int Rb = Epi::PERM ? ((R & ~31) + perm32(R & 31)) : R;
        voffA[i] = (unsigned)(R * lda + C) * 2u; voffB[i] = (unsigned)(Rb * ldb + C) * 2u; }
    const size_t kstep = (size_t)(BK * 2);
    const size_t hstep = (size_t)HALF * ldb * 2;
    const size_t hstepA = (size_t)HALF * lda * 2, tstepA = 2 * hstepA;
    const size_t tstep = 2 * hstep;
    const unsigned ldsw = (unsigned)wid * 1024u;
    const int aoff = lds_byte(wr * 64 + fr, fq * 8), boff = lds_byte(wc * 32 + fr, fq * 8);
#define PG8_SA(b, h) (((b) * 2 + (h)) * HTB)
#define PG8_SB(b, h) ((4 + (b) * 2 + (h)) * HTB)
#define PG8_STAGE(bufoff, gbase, voff) do { _Pragma("unroll") for (int _i = 0; _i < 2; ++_i) \
        __builtin_amdgcn_global_load_lds((const unsigned*)((const char*)(gbase) + (voff)[_i]), (PG8_LAS unsigned*)(lds + (bufoff) + ldsw + _i * 8192), 16, 0, 0); } while (0)
#define PG8_LDA(dst, b, h) do { if constexpr (FP8) { _Pragma("unroll") for (int m = 0; m < 4; ++m) { dst##8[m].lo = *(const PG8_LAS v4i_t*)(lds + PG8_SA(b, h) + aoff + m * 2048); dst##8[m].hi = *(const PG8_LAS v4i_t*)(lds + PG8_SA(b, h) + aoff + m * 2048 + 1024); } } \
        else { _Pragma("unroll") for (int m = 0; m < 4; ++m) _Pragma("unroll") for (int k = 0; k < 2; ++k) dst[FP8 ? 0 : m][k] = *(const PG8_LAS bf16x8*)(lds + PG8_SA(b, h) + aoff + m * 2048 + k * 1024); } } while (0)
#define PG8_LDB(dst, b, h) do { if constexpr (FP8) { _Pragma("unroll") for (int n = 0; n < 2; ++n) { dst##8[n].lo = *(const PG8_LAS v4i_t*)(lds + PG8_SB(b, h) + boff + n * 2048); dst##8[n].hi = *(const PG8_LAS v4i_t*)(lds + PG8_SB(b, h) + boff + n * 2048 + 1024); } } \
        else { _Pragma("unroll") for (int n = 0; n < 2; ++n) _Pragma("unroll") for (int k = 0; k < 2; ++k) dst[n][k] = *(const PG8_LAS bf16x8*)(lds + PG8_SB(b, h) + boff + n * 2048 + k * 1024); } } while (0)
#define PG8_MMA(ai, bj, At, Bt) do { __builtin_amdgcn_s_setprio(1); if constexpr (FP8) { _Pragma("unroll") for (int m = 0; m < 4; ++m) _Pragma("unroll") for (int n = 0; n < 2; ++n) \
        asm volatile("v_mfma_f32_16x16x128_f8f6f4 %0, %1, %2, %0" : "+v"(acc[ai][bj][m][n]) : "v"(Bt##8[n]), "v"(At##8[m])); } \
        else { _Pragma("unroll") for (int m = 0; m < 4; ++m) _Pragma("unroll") for (int n = 0; n < 2; ++n) _Pragma("unroll") for (int k = 0; k < 2; ++k) \
        acc[ai][bj][m][n] = __builtin_amdgcn_mfma_f32_16x16x32_bf16(Bt[n][k], At[FP8 ? 0 : m][k], acc[ai][bj][m][n], 0, 0, 0); } __builtin_amdgcn_s_setprio(0); } while (0)
#define PG8_WAIT_V(n) asm volatile("s_waitcnt vmcnt(" #n ")" ::: "memory")
#define PG8_WAIT_L(n) asm volatile("s_waitcnt lgkmcnt(" #n ")" ::: "memory")
#define PG8_BAR __builtin_amdgcn_s_barrier()
#define PG8_SCHED __builtin_amdgcn_sched_barrier(0)
    Unit cur, nxt; int ui = 0;
    if (!S.next(0, cur)) return;
    f32x4 acc[2][2][4][2];
#pragma unroll
    for (int a = 0; a < 2; ++a)
#pragma unroll
        for (int b = 0; b < 2; ++b)
#pragma unroll
            for (int m = 0; m < 4; ++m)
#pragma unroll
                for (int n = 0; n < 2; ++n) acc[a][b][m][n] = (f32x4){0.f, 0.f, 0.f, 0.f};
    bf16x8 At[FP8 ? 1 : 4][2], B0[2][2], B1[2][2];
    v8i_t At8[FP8 ? 4 : 1], B08[2], B18[2];
    typedef int v4i_t __attribute__((ext_vector_type(4)));
    const char* cA = (const char*)g.A + (size_t)cur.pm * tstepA + cur.ka; const char* cB = (const char*)g.Bt + (size_t)cur.pnb * tstep + (Sched::SPLITK ? cur.ka : 0);
    S.a_ready(cur);
    if constexpr (SP2) {
        PG8_STAGE(PG8_SB(0, 0), cB, voffB); PG8_STAGE(PG8_SB(0, 1), cB + hstep, voffB); PG8_STAGE(PG8_SA(0, 0), cA, voffA); PG8_STAGE(PG8_SA(0, 1), cA + hstepA, voffA);
        if (wr == 1) PG8_BAR;
        PG8_WAIT_V(2); PG8_BAR;
        PG8_STAGE(PG8_SB(1, 0), cB + kstep, voffB); PG8_STAGE(PG8_SA(1, 0), cA + kstep, voffA); PG8_STAGE(PG8_SB(1, 1), cB + hstep + kstep, voffB);
        PG8_WAIT_V(6); PG8_BAR;
    } else {
        PG8_STAGE(PG8_SB(0, 0), cB, voffB); PG8_STAGE(PG8_SA(0, 0), cA, voffA); PG8_STAGE(PG8_SB(0, 1), cB + hstep, voffB); PG8_STAGE(PG8_SA(0, 1), cA + hstepA, voffA);
        if (wr == 1) PG8_BAR;
        PG8_WAIT_V(4); PG8_BAR;
        PG8_STAGE(PG8_SB(1, 0), cB + kstep, voffB); PG8_STAGE(PG8_SA(1, 0), cA + kstep, voffA); PG8_STAGE(PG8_SB(1, 1), cB + hstep + kstep, voffB);
        PG8_WAIT_V(6); PG8_BAR;
    }
    for (;;) {
        const bool has_next = S.next(ui + 1, nxt);
        const char* nA = has_next ? (const char*)g.A + (size_t)nxt.pm * tstepA + nxt.ka : cA; const char* nB = has_next ? (const char*)g.Bt + (size_t)nxt.pnb * tstep + (Sched::SPLITK ? nxt.ka : 0) : cB;
        const int ntc = Sched::SPLITK ? cur.nt : nt;
        for (int t = 0; t < ntc; t += 2) {
            const bool last = (t == ntc - 2);
            const char* a1 = cA + (size_t)(t + 1) * kstep;
            const char* a2 = last ? nA : cA + (size_t)(t + 2) * kstep; const char* b2 = last ? nB : cB + (size_t)(t + 2) * kstep;
            const char* a3 = a2 + kstep; const char* b3 = b2 + kstep;
            if (last && has_next) S.a_ready(nxt);
            if constexpr (SP2) {
            PG8_LDB(B0, 0, 0); PG8_LDB(B1, 0, 1); PG8_SCHED; PG8_LDA(At, 0, 0); PG8_STAGE(PG8_SA(1, 1), a1 + hstepA, voffA);
            PG8_WAIT_V(8); PG8_WAIT_L(0); PG8_BAR; PG8_MMA(0, 0, At, B0); PG8_MMA(0, 1, At, B1); PG8_BAR; PG8_SCHED;
            PG8_LDA(At, 0, 1); PG8_STAGE(PG8_SB(0, 0), b2, voffB); PG8_STAGE(PG8_SB(0, 1), b2 + hstep, voffB); PG8_STAGE(PG8_SA(0, 0), a2, voffA);
            PG8_WAIT_V(8); PG8_WAIT_L(0); PG8_BAR; PG8_MMA(1, 0, At, B0); PG8_MMA(1, 1, At, B1); PG8_BAR; PG8_SCHED;
            PG8_LDB(B0, 1, 0); PG8_LDB(B1, 1, 1); PG8_SCHED; PG8_LDA(At, 1, 0); PG8_STAGE(PG8_SA(0, 1), a2 + hstepA, voffA);
            PG8_WAIT_V(8); PG8_WAIT_L(0); PG8_BAR; PG8_MMA(0, 0, At, B0); PG8_MMA(0, 1, At, B1); PG8_BAR; PG8_SCHED;
            PG8_LDA(At, 1, 1); PG8_STAGE(PG8_SB(1, 0), b3, voffB); PG8_STAGE(PG8_SB(1, 1), b3 + hstep, voffB); PG8_STAGE(PG8_SA(1, 0), a3, voffA);
            PG8_WAIT_V(8); PG8_WAIT_L(0); PG8_BAR; PG8_MMA(1, 0, At, B0); PG8_MMA(1, 1, At, B1); PG8_BAR; PG8_SCHED;
            } else {
            PG8_LDB(B0, 0, 0); PG8_SCHED; PG8_LDA(At, 0, 0); PG8_STAGE(PG8_SA(1, 1), a1 + hstepA, voffA);
            PG8_WAIT_L(8); PG8_BAR; PG8_WAIT_L(0); PG8_MMA(0, 0, At, B0); PG8_BAR; PG8_SCHED;
            PG8_LDB(B1, 0, 1); PG8_STAGE(PG8_SB(0, 0), b2, voffB);
            PG8_BAR; PG8_WAIT_L(0); PG8_MMA(0, 1, At, B1); PG8_BAR;
            PG8_LDA(At, 0, 1); PG8_STAGE(PG8_SA(0, 0), a2, voffA);
            PG8_BAR; PG8_WAIT_L(0); PG8_MMA(1, 0, At, B0); PG8_BAR; PG8_SCHED;
            PG8_STAGE(PG8_SB(0, 1), b2 + hstep, voffB);
            PG8_WAIT_V(6); PG8_BAR; PG8_MMA(1, 1, At, B1); PG8_BAR;
            PG8_LDB(B0, 1, 0); PG8_SCHED; PG8_LDA(At, 1, 0); PG8_STAGE(PG8_SA(0, 1), a2 + hstepA, voffA);
            PG8_WAIT_L(8); PG8_BAR; PG8_WAIT_L(0); PG8_MMA(0, 0, At, B0); PG8_BAR; PG8_SCHED;
            PG8_LDB(B1, 1, 1); PG8_STAGE(PG8_SB(1, 0), b3, voffB);
            PG8_BAR; PG8_WAIT_L(0); PG8_MMA(0, 1, At, B1); PG8_BAR;
            PG8_LDA(At, 1, 1); PG8_STAGE(PG8_SA(1, 0), a3, voffA);
            PG8_BAR; PG8_WAIT_L(0); PG8_MMA(1, 0, At, B0); PG8_BAR; PG8_SCHED;
            PG8_STAGE(PG8_SB(1, 1), b3 + hstep, voffB);
            PG8_WAIT_V(6); PG8_BAR; PG8_MMA(1, 1, At, B1); PG8_BAR;
            }
        }
        if constexpr (ALIGN_EPI) { if (wr == 0) PG8_BAR; }
        if constexpr (!Epi::AFTER_DRAIN) { E(acc, cur, wr, wc, fr, fq); S.done(cur); }
        if (!has_next) break;
#pragma unroll
        for (int a = 0; a < 2; ++a)
#pragma unroll
            for (int b = 0; b < 2; ++b)
#pragma unroll
                for (int m = 0; m < 4; ++m)
#pragma unroll
                    for (int n = 0; n < 2; ++n) acc[a][b][m][n] = (f32x4){0.f, 0.f, 0.f, 0.f};
        cur = nxt; cA = nA; cB = nB; ++ui;
        if constexpr (ALIGN_EPI) { if (wr == 1) PG8_BAR; }
    }
    PG8_WAIT_V(0);
    if constexpr (!ALIGN_EPI) { if (wr == 0) PG8_BAR; }
    PG8_BAR;
    if constexpr (Epi::AFTER_DRAIN) { E.fused(acc, cur, wr, wc, fr, fq, lds, wid, lane); S.done(cur); }
#undef PG8_SA
#undef PG8_SB
#undef PG8_STAGE
#undef PG8_LDA
#undef PG8_LDB
#undef PG8_MMA
#undef PG8_WAIT_V
#undef PG8_WAIT_L
#undef PG8_BAR
#undef PG8_SCHED
}
}
#include <hip/hip_bf16.h>
#include <cmath>
namespace attn_body {
using bf16=__hip_bfloat16;
using bf16x8=__attribute__((ext_vector_type(8)))short;
using s16x4=__attribute__((ext_vector_type(4)))short;
using f32x16=__attribute__((ext_vector_type(16)))float;
using u32x4=__attribute__((ext_vector_type(4)))unsigned;
constexpr int D=64,DM=1024,KP=128;
constexpr int NW=8,QBLK=32,QB=QBLK*NW,KVBLK=64;
constexpr int ATTN_PITCH=DM, ATTN_UNIT_ROWS=QB;
__device__ __forceinline__ int crow(int r,int hi){return (r&3)+8*(r>>2)+4*hi;}
#define SBAR() __builtin_amdgcn_sched_barrier(0)
__device__ __forceinline__ void cmask(f32x16&p0,f32x16&p1,int jb,int qrel,int hi){
  const float NEG=-INFINITY; int kb=64*jb+4*hi;
  #pragma unroll
  for(int r=0;r<16;++r){int kv=kb+(r&3)+8*(r>>2); if(kv>qrel)p0[r]=NEG; if(kv+32>qrel)p1[r]=NEG;}
}

constexpr int NSLOT=3, SLOTB=8192;
constexpr int LDS_K=0, LDS_V=NSLOT*SLOTB, LDS_WS=2*NSLOT*SLOTB, LDS_OST=LDS_WS+NW*64*4, LDS_BYTES=LDS_OST+NW*4096;
constexpr float C2=0.125f*1.4426950408889634f;
__device__ __forceinline__ void glds16(const void*gsrc,unsigned lds_dst){unsigned keep;
  asm volatile("s_mov_b32 %0, m0\n\ts_mov_b32 m0, %2\n\ts_nop 0\n\tglobal_load_lds_dwordx4 %1, off\n\ts_mov_b32 m0, %0":"=&s"(keep):"v"(gsrc),"s"(lds_dst):"memory");}
__device__ __forceinline__ float max3f(float a,float b,float c){float r;asm("v_max3_f32 %0, %1, %2, %3":"=v"(r):"v"(a),"v"(b),"v"(c));return r;}
__device__ __forceinline__ float max2f(float a,float b){float r;asm("v_max_f32_e32 %0, %1, %2":"=v"(r):"v"(a),"v"(b));return r;}
__device__ __forceinline__ float fadd_s(float a,float b){float r;asm("v_add_f32_e32 %0, %1, %2":"=v"(r):"v"(a),"v"(b));return r;}
__device__ __forceinline__ float fsub_s(float a,float b){float r;asm("v_sub_f32_e32 %0, %1, %2":"=v"(r):"v"(a),"v"(b));return r;}
typedef float f32x2_t __attribute__((ext_vector_type(2))); typedef __bf16 bf16x2_t __attribute__((ext_vector_type(2)));
__device__ __forceinline__ unsigned cvtpk_s(float lo,float hi){f32x2_t v={lo,hi};bf16x2_t b=__builtin_convertvector(v,bf16x2_t);return __builtin_bit_cast(unsigned,b);}
#define WAIT_BAR(N) asm volatile("s_waitcnt vmcnt(" #N ") lgkmcnt(0)\n\ts_barrier":::"memory")

__device__ __forceinline__ void qkt(f32x16&p0,f32x16&p1,const char*Kslot,const bf16x8*qr,const f32x16&negm,int r32,int hi){
  const char*kb=Kslot+hi*1024+r32*16;
  #pragma unroll
  for(int d0=0;d0<4;++d0){
    const bf16x8 b0=*reinterpret_cast<const bf16x8*>(kb+d0*2048);
    const bf16x8 b1=*reinterpret_cast<const bf16x8*>(kb+d0*2048+512);
    if(d0==0){p0=__builtin_amdgcn_mfma_f32_32x32x16_bf16(b0,qr[0],negm,0,0,0);p1=__builtin_amdgcn_mfma_f32_32x32x16_bf16(b1,qr[0],negm,0,0,0);}
    else{p0=__builtin_amdgcn_mfma_f32_32x32x16_bf16(b0,qr[d0],p0,0,0,0);p1=__builtin_amdgcn_mfma_f32_32x32x16_bf16(b1,qr[d0],p1,0,0,0);}}
}
typedef __attribute__((address_space(3))) const char* lds_cptr;
typedef short v4i16_t __attribute__((ext_vector_type(4)));
__device__ __forceinline__ void kload8(bf16x8*kf,lds_cptr kp){
  kf[0]=*(const __attribute__((address_space(3))) bf16x8*)(kp);      kf[1]=*(const __attribute__((address_space(3))) bf16x8*)(kp+512);
  kf[2]=*(const __attribute__((address_space(3))) bf16x8*)(kp+2048); kf[3]=*(const __attribute__((address_space(3))) bf16x8*)(kp+2560);
  kf[4]=*(const __attribute__((address_space(3))) bf16x8*)(kp+4096); kf[5]=*(const __attribute__((address_space(3))) bf16x8*)(kp+4608);
  kf[6]=*(const __attribute__((address_space(3))) bf16x8*)(kp+6144); kf[7]=*(const __attribute__((address_space(3))) bf16x8*)(kp+6656);
}
__device__ __forceinline__ void kload2(bf16x8*kf,lds_cptr kp,int j){ kf[2*j]=*(const __attribute__((address_space(3))) bf16x8*)(kp+j*2048); kf[2*j+1]=*(const __attribute__((address_space(3))) bf16x8*)(kp+j*2048+512); }
__device__ __forceinline__ s16x4 vtr(lds_cptr p){ return __builtin_bit_cast(s16x4,__builtin_amdgcn_ds_read_tr16_b64_v4i16((__attribute__((address_space(3))) v4i16_t*)p)); }
__device__ __forceinline__ float rowmax(const f32x16&p0,const f32x16&p1){
  float a=max3f(p0[0],p0[1],p1[0]),b=max3f(p0[2],p0[3],p1[1]);a=max3f(a,p1[2],p1[3]);
  #pragma unroll
  for(int r=4;r<16;r+=4){a=max3f(a,p0[r],p0[r+1]);b=max3f(b,p0[r+2],p0[r+3]);a=max3f(a,p1[r],p1[r+1]);b=max3f(b,p1[r+2],p1[r+3]);}
  const float m=max2f(a,b);
  auto rr=__builtin_amdgcn_permlane32_swap(__float_as_uint(m),__float_as_uint(m),false,false);
  return max2f(__uint_as_float(rr[0]),__uint_as_float(rr[1]));
}
__device__ __forceinline__ void pv(f32x16*o,int vb,bf16x8 pa0,bf16x8 pa1,bf16x8 pa2,bf16x8 pa3){
  #pragma unroll
  for(int d0=0;d0<2;++d0){s16x4 lo[4],hi[4];
    #pragma unroll
    for(int ks=0;ks<4;++ks){
      asm volatile("ds_read_b64_tr_b16 %0,%1 offset:%c2":"=&v"(lo[ks]):"v"(vb),"i"(d0*4096+ks*1024):"memory");
      asm volatile("ds_read_b64_tr_b16 %0,%1 offset:%c2":"=&v"(hi[ks]):"v"(vb),"i"(d0*4096+ks*1024+512):"memory");}
    asm volatile("s_waitcnt lgkmcnt(0)":::"memory");SBAR();
    #define PK(k) (bf16x8){lo[k][0],lo[k][1],lo[k][2],lo[k][3],hi[k][0],hi[k][1],hi[k][2],hi[k][3]}
    o[d0]=__builtin_amdgcn_mfma_f32_32x32x16_bf16(pa0,PK(0),o[d0],0,0,0);
    o[d0]=__builtin_amdgcn_mfma_f32_32x32x16_bf16(pa1,PK(1),o[d0],0,0,0);
    o[d0]=__builtin_amdgcn_mfma_f32_32x32x16_bf16(pa2,PK(2),o[d0],0,0,0);
    o[d0]=__builtin_amdgcn_mfma_f32_32x32x16_bf16(pa3,PK(3),o[d0],0,0,0);
    #undef PK
  }
}

#ifndef ATTN_STORE16
#define ATTN_STORE16(p,v) (*(u32x4*)(p)=(v))
#endif
template<int THRL> __device__ __forceinline__ void attn_unit(long qrow0,int hcol,long kvrow0,int kvcol,int NT,const bf16*Q,const bf16*__restrict__ K,const bf16*__restrict__ V,bf16*O,char*shm,const int wave_){
  const int tid=wave_*64+hw_lane(),lane=tid&63,r32=lane&31,hi=lane>>5; const int wid=wave_;
  const bf16*Qw=Q+(qrow0+wid*QBLK)*DM+hcol;
  const bf16*Kh=K+kvrow0*KP+kvcol,*Vh=V+kvrow0*KP+kvcol;
  const unsigned lds0=(unsigned)(uintptr_t)shm;
  float*wsf=(float*)(shm+LDS_WS)+wid*64;
  const bf16*ksrc=Kh+(long)lane*KP+wid*8;
  const bf16*vsrc=Vh+(long)(16*(wid&3)+(lane>>2))*KP+(wid>>2)*32+(lane&3)*8;
  const unsigned kdst=lds0+LDS_K+wid*1024, vdst=lds0+LDS_V+wid*1024;
  #define DMA_K(t,slot) glds16(ksrc+(long)(t)*KVBLK*KP,(unsigned)__builtin_amdgcn_readfirstlane(kdst+(slot)))
  #define DMA_V(t,slot) glds16(vsrc+(long)(t)*KVBLK*KP,(unsigned)__builtin_amdgcn_readfirstlane(vdst+(slot)))
  const int vb0=(int)(lds0+LDS_V)+((lane>>4)&1)*32+(lane&3)*8+(4*hi+((lane&15)>>2))*64;
  const char*Kbase=shm+LDS_K; bf16x8 kf[8];
  const lds_cptr shm3=(lds_cptr)shm; const lds_cptr kp0=shm3+LDS_K+hi*1024+r32*16; const lds_cptr vp0=shm3+LDS_V+((lane>>4)&1)*32+(lane&3)*8+(4*hi+((lane&15)>>2))*64;
  DMA_K(0,0);DMA_V(0,0);DMA_K(1,SLOTB);
  bf16x8 qr[4];
  #pragma unroll
  for(int d0=0;d0<4;++d0)qr[d0]=*reinterpret_cast<const bf16x8*>(&Qw[(long)r32*DM+d0*16+hi*8]);
  float mhat=0.f,l_reg=0.f;f32x16 o[2];o[0]=f32x16{};o[1]=f32x16{};f32x16 negm=f32x16{};asm volatile("":"+v"(negm));
  #define CMASK(P0,P1,t) do{}while(0)
  bool resc=false;
  #define START(P0,P1) do{ const float rm=rowmax(P0,P1); resc=false; \
    { const float dl=rm; mhat=fadd_s(mhat,dl); \
      _Pragma("unroll") for(int r=0;r<16;++r){P0[r]=fsub_s(P0[r],dl);P1[r]=fsub_s(P1[r],dl);} \
      _Pragma("unroll") for(int r=0;r<16;++r)negm[r]=-mhat; asm volatile("":"+v"(negm)); } \
    _Pragma("unroll") for(int r=0;r<16;++r)P0[r]=__builtin_amdgcn_exp2f(P0[r]); }while(0)
  #define RESC() do{ if(resc){ asm volatile("s_waitcnt lgkmcnt(0)":::"memory"); \
      _Pragma("unroll") for(int d_=0;d_<2;++d_) _Pragma("unroll") for(int r=0;r<16;++r)o[d_][r]*=wsf[crow(r,hi)]; } }while(0)
  f32x16 pA0,pA1,pB0,pB1;
  int sl_prev=0,sl_cur=0,sl_next=SLOTB;
  #define ROT() do{sl_prev=sl_cur;sl_cur=sl_next;sl_next=(sl_next==(NSLOT-1)*SLOTB)?0:sl_next+SLOTB;}while(0)
  DMA_K(2,2*SLOTB);
  WAIT_BAR(3);
  qkt(pA0,pA1,Kbase,qr,negm,r32,hi);asm volatile("s_nop 15\n\ts_nop 7":"+v"(pA0),"+v"(pA1));CMASK(pA0,pA1,0);
  START(pA0,pA1);
  _Pragma("unroll") for(int r=0;r<16;++r)pA1[r]=__builtin_amdgcn_exp2f(pA1[r]);
  WAIT_BAR(0);
  DMA_K(3,0);DMA_V(1,SLOTB);
  ROT();
  kload8(kf,kp0+sl_cur);
  WAIT_BAR(2);
  s16x4 vlo[8],vhi[8]; u32x4 pw0,pw1,pw2,pw3;
  #define PKW(P,B) cvtpk_s(P[B],P[B+1])
  #define PAF(k) __builtin_bit_cast(bf16x8,pw##k)
  #define VFR(i) (bf16x8){vlo[i][0],vlo[i][1],vlo[i][2],vlo[i][3],vhi[i][0],vhi[i][1],vhi[i][2],vhi[i][3]}
  #define PIN(x) asm volatile("":"+v"(x))
  #define MX3(a,b,c) __builtin_fmaxf(__builtin_fmaxf((a),(b)),(c))
  #define GAPA(MF,A0,A1,A2,A3,W0,W1,PW) do{ MF; sacc+=A0; sacc+=A1; sacc+=A2; sacc+=A3; PIN(sacc); W0; W1; PIN(PW); SBAR(); }while(0)
  #define EX(v) __builtin_amdgcn_exp2f(v)
  #define GAPB(MF,X,B) do{ MF; X[B]=EX(X[B]); X[B+1]=EX(X[B+1]); X[B+2]=EX(X[B+2]); X[B+3]=EX(X[B+3]); PIN(X); SBAR(); }while(0)
  #define VRD(i) do{ vlo[i]=vtr(vp_+(((i)>>2)*4096+((i)&3)*1024)); vhi[i]=vtr(vp_+(((i)>>2)*4096+((i)&3)*1024+512)); }while(0)
  #define KRD(G,j) do{ if(G){ kload2(kf,kp0+sl_next,j); SBAR(); } }while(0)
  #define STEP(C0,C1,P0,P1,t,GK,GV,GL) do{ SBAR(); \
    const lds_cptr vp_=vp0+sl_prev; \
    VRD(0); SBAR(); float sacc=(P0[0]+P0[1]); \
    GAPA(C0=__builtin_amdgcn_mfma_f32_32x32x16_bf16(kf[0],qr[0],negm,0,0,0), P0[2],P0[3],P0[4],P0[5],     pw0[0]=PKW(P0,0), pw0[1]=PKW(P0,2), pw0); \
    VRD(4); SBAR(); GAPA(C1=__builtin_amdgcn_mfma_f32_32x32x16_bf16(kf[1],qr[0],negm,0,0,0), P0[6],P0[7],P0[8],P0[9],     pw0[2]=PKW(P0,4), pw0[3]=PKW(P0,6), pw0); \
    VRD(1); SBAR(); GAPA(C0=__builtin_amdgcn_mfma_f32_32x32x16_bf16(kf[2],qr[1],C0,0,0,0),   P0[10],P0[11],P0[12],P0[13], pw1[0]=PKW(P0,8), pw1[1]=PKW(P0,10), pw1); \
    VRD(5); SBAR(); GAPA(C1=__builtin_amdgcn_mfma_f32_32x32x16_bf16(kf[3],qr[1],C1,0,0,0),   P0[14],P0[15],P1[0],P1[1],   pw1[2]=PKW(P0,12),pw1[3]=PKW(P0,14), pw1); \
    VRD(2); SBAR(); GAPA(C0=__builtin_amdgcn_mfma_f32_32x32x16_bf16(kf[4],qr[2],C0,0,0,0),   P1[2],P1[3],P1[4],P1[5],     pw2[0]=PKW(P1,0), pw2[1]=PKW(P1,2), pw2); \
    VRD(6); SBAR(); GAPA(C1=__builtin_amdgcn_mfma_f32_32x32x16_bf16(kf[5],qr[2],C1,0,0,0),   P1[6],P1[7],P1[8],P1[9],     pw2[2]=PKW(P1,4), pw2[3]=PKW(P1,6), pw2); \
    VRD(3); SBAR(); GAPA(C0=__builtin_amdgcn_mfma_f32_32x32x16_bf16(kf[6],qr[3],C0,0,0,0),   P1[10],P1[11],P1[12],P1[13], pw3[0]=PKW(P1,8), pw3[1]=PKW(P1,10), pw3); \
    VRD(7); SBAR(); GAPA(C1=__builtin_amdgcn_mfma_f32_32x32x16_bf16(kf[7],qr[3],C1,0,0,0),   P1[14],P1[15],0.f,0.f,       pw3[2]=PKW(P1,12),pw3[3]=PKW(P1,14), pw3); \
    l_reg+=sacc; \
    if(GK){DMA_K((t)+3,sl_cur);} if(GV){DMA_V((t)+1,sl_next);} \
    CMASK(C0,C1,t); \
    { float a=MX3(C0[0],C0[1],C1[0]),b=MX3(C0[2],C0[3],C1[1]); a=MX3(a,C1[2],C1[3]); \
      _Pragma("unroll") for(int r=4;r<16;r+=4){a=MX3(a,C0[r],C0[r+1]);b=MX3(b,C0[r+2],C0[r+3]);a=MX3(a,C1[r],C1[r+1]);b=MX3(b,C1[r+2],C1[r+3]);} \
      float rm=__builtin_fmaxf(a,b); { auto rr=__builtin_amdgcn_permlane32_swap(__float_as_uint(rm),__float_as_uint(rm),false,false); rm=__builtin_fmaxf(__uint_as_float(rr[0]),__uint_as_float(rr[1])); } \
      resc=false; \
      if(__builtin_expect(__any(rm>(float)THRL),0)){ const float dl=__builtin_fmaxf(rm,0.f); mhat+=dl; \
        _Pragma("unroll") for(int r=0;r<16;++r){C0[r]-=dl;C1[r]-=dl;} \
        _Pragma("unroll") for(int r=0;r<16;++r)negm[r]=-mhat; asm volatile("":"+v"(negm)); \
        const float f=__builtin_amdgcn_exp2f(-dl); l_reg*=f; if(hi==0)wsf[r32]=f; resc=true; } } \
    SBAR(); \
    GAPB(o[0]=__builtin_amdgcn_mfma_f32_32x32x16_bf16(PAF(0),VFR(0),o[0],0,0,0), C0,0); \
    GAPB(o[1]=__builtin_amdgcn_mfma_f32_32x32x16_bf16(PAF(0),VFR(4),o[1],0,0,0), C0,4); \
    KRD(GL,0); GAPB(o[0]=__builtin_amdgcn_mfma_f32_32x32x16_bf16(PAF(1),VFR(1),o[0],0,0,0), C0,8); \
    KRD(GL,1); GAPB(o[1]=__builtin_amdgcn_mfma_f32_32x32x16_bf16(PAF(1),VFR(5),o[1],0,0,0), C0,12); \
    KRD(GL,2); GAPB(o[0]=__builtin_amdgcn_mfma_f32_32x32x16_bf16(PAF(2),VFR(2),o[0],0,0,0), C1,0); \
    KRD(GL,3); GAPB(o[1]=__builtin_amdgcn_mfma_f32_32x32x16_bf16(PAF(2),VFR(6),o[1],0,0,0), C1,4); \
    GAPB(o[0]=__builtin_amdgcn_mfma_f32_32x32x16_bf16(PAF(3),VFR(3),o[0],0,0,0), C1,8); \
    GAPB(o[1]=__builtin_amdgcn_mfma_f32_32x32x16_bf16(PAF(3),VFR(7),o[1],0,0,0), C1,12); \
    }while(0)
  int t=1;
  #undef CMASK
  #define CMASK(P0,P1,t) do{}while(0)
  for(;t+5<NT;t+=2){
    STEP(pB0,pB1,pA0,pA1,t,true,true,true);     WAIT_BAR(2); RESC(); ROT();
    STEP(pA0,pA1,pB0,pB1,t+1,true,true,true);   WAIT_BAR(2); RESC(); ROT();
  }
  #undef CMASK
  #define CMASK(P0,P1,t) do{}while(0)
  #define ENDW(tt) do{ if((tt)+3<NT){WAIT_BAR(2);} else if((tt)+2<NT){WAIT_BAR(1);} else {WAIT_BAR(0);} }while(0)
  for(;t+1<NT;t+=2){
    STEP(pB0,pB1,pA0,pA1,t,(t+3<NT),(t+1<NT),(t+1<NT));       ENDW(t);   RESC(); ROT();
    STEP(pA0,pA1,pB0,pB1,t+1,(t+4<NT),(t+2<NT),(t+2<NT));     ENDW(t+1); RESC(); ROT();
  }
  STEP(pB0,pB1,pA0,pA1,NT-1,false,false,false); RESC();
  { float sacc=pB0[0]+pB0[1]; _Pragma("unroll") for(int r=2;r<16;++r)sacc+=pB0[r]; _Pragma("unroll") for(int r=0;r<16;++r)sacc+=pB1[r]; l_reg+=sacc;
    pw0=(u32x4){PKW(pB0,0),PKW(pB0,2),PKW(pB0,4),PKW(pB0,6)};pw1=(u32x4){PKW(pB0,8),PKW(pB0,10),PKW(pB0,12),PKW(pB0,14)};pw2=(u32x4){PKW(pB1,0),PKW(pB1,2),PKW(pB1,4),PKW(pB1,6)};pw3=(u32x4){PKW(pB1,8),PKW(pB1,10),PKW(pB1,12),PKW(pB1,14)};
    SBAR(); pv(o,vb0+sl_cur,PAF(0),PAF(1),PAF(2),PAF(3)); }
  #undef PKW
  #undef PAF
  #undef VFR
  #undef PIN
  #undef MX3
  #undef GAPA
  #undef GAPB
  #undef EX
  #undef VRD
  #undef KRD
  #undef STEP
  #undef ENDW
  {auto rr=__builtin_amdgcn_permlane32_swap(__float_as_uint(l_reg),__float_as_uint(l_reg),false,false);l_reg=__uint_as_float(rr[0])+__uint_as_float(rr[1]);}
  if(hi==0)wsf[32+r32]=l_reg;asm volatile("s_waitcnt lgkmcnt(0)":::"memory");
  float rli[16];
  #pragma unroll
  for(int r=0;r<16;++r)rli[r]=__builtin_amdgcn_rcpf(wsf[32+crow(r,hi)]);
  bf16*Ow=O+(qrow0+wid*QBLK)*DM+hcol;
  { bf16*stg=(bf16*)(shm+LDS_OST)+wid*2048;
    #pragma unroll
    for(int r=0;r<16;++r){const int orow=crow(r,hi);
      #pragma unroll
      for(int d0=0;d0<2;++d0)stg[orow*64+d0*32+r32]=__float2bfloat16(o[d0][r]*rli[r]);}
    asm volatile("s_waitcnt lgkmcnt(0)":::"memory");
    #pragma unroll
    for(int i=0;i<4;++i){const int row=i*8+(lane>>3),ch=lane&7; const u32x4 v=*(const u32x4*)(stg+row*64+ch*8); ATTN_STORE16(Ow+(long)row*DM+ch*8,v);} }
  asm volatile("s_waitcnt lgkmcnt(0)\n\ts_barrier":::"memory");
  #undef DMA_K
  #undef DMA_V
  #undef CMASK
  #undef START
  #undef RESC
  #undef ROT
}
constexpr int ATTN_LDS_BYTES=LDS_BYTES;
#undef SBAR
#undef WAIT_BAR
}
#define GAS __attribute__((address_space(1)))
#define LAS __attribute__((address_space(3)))
typedef unsigned short bf16;
typedef unsigned v4u __attribute__((ext_vector_type(4)));
typedef float f32x4 __attribute__((ext_vector_type(4)));
typedef short bf16x8 __attribute__((ext_vector_type(8)));
typedef GAS unsigned gu32;
typedef GAS unsigned long long gu64;
#define RLX_AGENT __ATOMIC_RELAXED, __HIP_MEMORY_SCOPE_AGENT
#define LDS_WAIT() asm volatile("s_waitcnt lgkmcnt(0)" ::: "memory")
#define VM_WAIT() asm volatile("s_waitcnt vmcnt(0)" ::: "memory")
__device__ __forceinline__ unsigned long long rt() { return __builtin_amdgcn_s_memrealtime(); }
__device__ __forceinline__ unsigned f2bf(float f) { unsigned u = __builtin_bit_cast(unsigned, f); return (u + 0x7fffu + ((u >> 16) & 1u)) >> 16; }
__device__ __forceinline__ unsigned pk2(float lo, float hi) { return f2bf(lo) | (f2bf(hi) << 16); }

#define XB_TMO      128
#define XB_XCNT(j)  (256  + 64 * (j))
#define XB_XSUB(j)  (1280 + 64 * (j))
#define XB_XGEN(j)  (2304 + 64 * (j))
#define XB_TOP      3328
#define XB_TOPGEN   3392
#define XCD_BAR_WORDS 3456
#define XB_SPIN_CAP (1u << 18)

__device__ __forceinline__ unsigned xb_ld(unsigned* p)              { return __hip_atomic_load(p, __ATOMIC_RELAXED, __HIP_MEMORY_SCOPE_AGENT); }
__device__ __forceinline__ unsigned xb_add(unsigned* p, unsigned v) { return __hip_atomic_fetch_add(p, v, __ATOMIC_RELAXED, __HIP_MEMORY_SCOPE_AGENT); }
__device__ __forceinline__ unsigned xb_xcc_id() { return (unsigned)__builtin_amdgcn_s_getreg((3 << 11) | 20) & 0xFu; }
#define XB_SPIN(cond, bar) do { unsigned _sp = 0; while (cond) { __builtin_amdgcn_s_sleep(1); \
    if ((++_sp & 255u) == 0u) { if (xb_ld(&(bar)[XB_TMO])) break; if (_sp > XB_SPIN_CAP) { atomicAdd(&(bar)[XB_TMO], 1u); break; } } } } while (0)

struct XcdBarrier {
    unsigned* bar; unsigned x; int wv;
    volatile LAS unsigned* st;
};

__device__ __forceinline__ XcdBarrier xcd_barrier_post(unsigned* bar, volatile LAS unsigned* st, int wv) {
    XcdBarrier b; b.bar = bar; b.x = xb_xcc_id(); b.st = st; b.wv = wv;
    if (threadIdx.x == 0) (void)xb_add(&bar[XB_XCNT(b.x)], 1u);
    return b;
}
__device__ __forceinline__ void xcd_barrier_complete(unsigned* bar, unsigned x, unsigned& nloc, unsigned& nx) {
    const unsigned G = gridDim.x * gridDim.y * gridDim.z;
    unsigned sum, cnt, mine, sp = 0u;
    for (;;) {
        sum = 0u; cnt = 0u; mine = 0u;
#pragma unroll
        for (unsigned j = 0; j < 16; ++j) { const unsigned c = xb_ld(&bar[XB_XCNT(j)]); sum += c; cnt += (c > 0u) ? 1u : 0u; mine = (j == x) ? c : mine; }
        if (sum == G) break;
        __builtin_amdgcn_s_sleep(1);
        if ((++sp & 255u) == 0u) { if (xb_ld(&bar[XB_TMO])) break; if (sp > XB_SPIN_CAP) { atomicAdd(&bar[XB_TMO], 1u); break; } }
    }
    nloc = mine > 0u ? mine : 1u; nx = cnt > 0u ? cnt : 1u;
}

__device__ __forceinline__ void xcd_barrier(const XcdBarrier& b) {
    asm volatile("s_waitcnt vmcnt(0)" ::: "memory");
    __syncthreads();
    if (b.wv == 0 && hw_lane() == 0) {
        unsigned* bar = b.bar;
        __builtin_amdgcn_s_waitcnt(0);
        unsigned nloc = b.st[0], nx = b.st[1];
        if (nloc == 0u) { xcd_barrier_complete(bar, b.x, nloc, nx); b.st[0] = nloc; b.st[1] = nx; }
        const unsigned old = xb_add(&bar[XB_XSUB(b.x)], 1u);
        const unsigned gen = old / nloc;
        if (old + 1u == (gen + 1u) * nloc) {
            __builtin_amdgcn_fence(__ATOMIC_RELEASE, "agent");
            asm volatile("s_waitcnt vmcnt(0)" ::: "memory");
            const unsigned og = xb_add(&bar[XB_TOP], 1u);
            const unsigned tg = og / nx;
            if (og + 1u == (tg + 1u) * nx) xb_add(&bar[XB_TOPGEN], 1u);
            else XB_SPIN(xb_ld(&bar[XB_TOPGEN]) == tg, bar);
            __builtin_amdgcn_fence(__ATOMIC_ACQUIRE, "agent");
            xb_add(&bar[XB_XGEN(b.x)], 1u);
            asm volatile("s_waitcnt vmcnt(0)" ::: "memory");
        } else {
            XB_SPIN(xb_ld(&bar[XB_XGEN(b.x)]) == gen, bar);
            __builtin_amdgcn_fence(__ATOMIC_ACQUIRE, "agent");
            asm volatile("s_waitcnt vmcnt(0)" ::: "memory");
        }
    }
    __syncthreads();
}

#ifndef PROBE
#define PROBE 0
#endif
#ifndef DEBUG_NAN
#define DEBUG_NAN 0
#endif
#ifndef TSEL
#define TSEL -1
#endif
#ifndef CYSEL
#define CYSEL -1
#endif
#ifndef TSCALE10
#define TSCALE10 0
#endif
#if TSEL >= 0
#define TS(k) do { if (blockIdx.x == 0 && F.wave == 0 && hw_lane() == 0) { unsigned long long* ts_ = (unsigned long long*)(F.ws + WS_CTL + 32768); const unsigned long long now_ = __builtin_amdgcn_s_memrealtime(); ts_[1 + (k)] += now_ - ts_[0]; ts_[0] = now_; } } while (0)
#else
#define TS(k) do {} while (0)
#endif
#ifndef USE_SEQ_SCAN
#define USE_SEQ_SCAN 0
#endif
constexpr int NWAVES = 8;
constexpr int DMODEL = 1024, NBATCH = 8, SEQL = 4096, CTXL = 256, DEPTH = 4;
constexpr int TL = NBATCH * SEQL, TC = NBATCH * CTXL, TT = TL + TC;
constexpr int KVLEN = SEQL + CTXL;
constexpr int INW = 2688, INWP = 2816, ATTIN = 768, SHIFTW = 1920;
constexpr int FFD = 2816, FFE = 3584, NEXP = 8;
constexpr int LORA_K = 384, LORA_N = 2560;
constexpr int MAXPANEL = 280, MAXSLOT = MAXPANEL * 256;
constexpr float RMS_EPS = 1e-6f, GN_EPS = 64e-5f;

constexpr size_t MiB = 1u << 20;
constexpr size_t WS_CTL = 0, CTL_ZERO_BYTES = 64 * 1024;
constexpr size_t WS_MOD = 1 * MiB;
constexpr size_t WS_ROPE = 2 * MiB;
constexpr size_t WS_ROUTE = 3 * MiB;
constexpr size_t RT_E = 0, RT_G = 160 * 1024, RT_S = 448 * 1024, RT_BLK = 768 * 1024, RT_WCNT = 800 * 1024;
constexpr size_t WS_XB = 12 * MiB;
constexpr size_t WS_WIN = 80 * MiB, WS_WOUT = 86 * MiB, WS_WLORA = 88 * MiB;
constexpr size_t WS_WFF = 100 * MiB;
constexpr size_t WS_WFF_D_DENSE = WS_WFF + 12 * MiB, WS_WFF_D_MOE = WS_WFF + 112 * MiB;
constexpr size_t WS_ACT = 270 * MiB;
constexpr size_t WS_QO = WS_ACT, WS_KB = WS_ACT + 68 * MiB, WS_VB = WS_ACT + 77 * MiB, WS_P = WS_ACT + 86 * MiB, WS_OSC = WS_P;
constexpr size_t WS_R = WS_ACT + 273 * MiB, WS_K = WS_ACT + 307 * MiB, WS_V = WS_ACT + 341 * MiB, WS_KK = WS_ACT + 375 * MiB, WS_LIN = WS_ACT + 409 * MiB;
constexpr size_t WS_LOUT = WS_ACT + 435 * MiB;
constexpr size_t WS_SPT = WS_WFF, WS_SG = WS_WFF + 68 * MiB, WS_SQ = WS_ACT + 605 * MiB;
constexpr size_t WS_HID = WS_ACT;
constexpr size_t WS_AG = WS_ACT, WS_AG8 = WS_ACT + 140 * MiB, WS_HIDM = WS_ACT + 210 * MiB;
constexpr size_t WS_WFF_D_MOE8 = WS_WFF + 56 * MiB;
constexpr float W8SCALE = 64.0f, H8SCALE = 8.0f, HID8SCALE = 4.0f;
constexpr size_t WS_SIDE = 1000 * MiB;
constexpr size_t WS_END = 1012 * MiB;
static_assert(WS_LOUT + (size_t)TT * LORA_N * 2 <= WS_END && WS_HIDM + (size_t)MAXSLOT * FFE <= WS_END && WS_P + (size_t)TT * INWP * 2 <= WS_R && WS_OSC + (size_t)2 * TT * 512 * 4 <= WS_R, "ws map");
static_assert(WS_WFF_D_MOE + (size_t)NEXP * 1024 * FFE * 2 <= WS_ACT && WS_XB + (size_t)TT * 1024 * 2 <= WS_WIN && WS_WIN + (size_t)INWP * 1024 * 2 <= WS_WOUT && WS_WLORA + (size_t)LORA_N * LORA_K * 2 <= WS_WFF, "ws map 2");
constexpr int CW_BAR = 4096;

constexpr int RING_OFF = 0, RING_BYTES = 131072;
constexpr int LDSCTL_OFF = RING_BYTES;
constexpr int MISC_OFF = LDSCTL_OFF;
constexpr int LT_PEXP = LDSCTL_OFF + 256;
constexpr int LT_NPAN = LT_PEXP + 320 * 4;
constexpr int LT_INP = LT_NPAN + 64;
constexpr int LT_TMP = LT_INP + 256;
constexpr int LDS_BYTES = 147456;
static_assert(LT_TMP + 8192 + 1024 <= LDS_BYTES, "LDS map");

struct Frame {
    LAS unsigned char* lds;
    volatile LAS unsigned* MISC;
    gu32* ctl;
    int tid, lane, wave, vcu, G;
    unsigned char* ws;
    float* out;
};
struct Args { const float* in[30]; float* out; unsigned char* ws; };
__device__ __forceinline__ const void* inp_ld(const Frame& F, int k) {
    const LAS unsigned* t = (const LAS unsigned*)(F.lds + LT_INP) + 2 * k; unsigned lo = t[0], hi = t[1];
    lo = __builtin_amdgcn_readfirstlane(lo); hi = __builtin_amdgcn_readfirstlane(hi);
    return (const void*)(const GAS void*)(((unsigned long long)hi << 32) | lo);
}
#define IN_X 0
#define IN_C 1
#define IN_CTX 2
#define IN_CCTX 3
#define IN_ADAW 4
#define IN_ADAB 5
#define IN_N1G 6
#define IN_N2G 7
#define IN_WIN 8
#define IN_WOUT 9
#define IN_QG 10
#define IN_KG 11
#define IN_MU 12
#define IN_W0 13
#define IN_W2 14
#define IN_A0 15
#define IN_A2 16
#define IN_G2 17
#define IN_KKW 18
#define IN_KA 19
#define IN_RK 20
#define IN_GNW 21
#define IN_GNB 22
#define IN_FWG 23
#define IN_FWU 24
#define IN_FWD 25
#define IN_ROUTER 26
#define IN_MWG 27
#define IN_MWU 28
#define IN_MWD 29

__device__ __forceinline__ int vlaunder(int v) { asm volatile("" : "+v"(v)); return v; }
__device__ __forceinline__ unsigned char* launder(unsigned char* p) { unsigned long long v = (unsigned long long)p; asm volatile("" : "+s"(v)); return (unsigned char*)(GAS unsigned char*)v; }
#define INP(k) ((const float*)inp_ld(F, (k)))
__device__ __forceinline__ const void* inp_ld(const struct Frame& F, int k);
__device__ __forceinline__ float wave_sum(float v) {
#pragma unroll
    for (int o = 1; o < 64; o <<= 1) v += __shfl_xor(v, o);
    return v;
}
__device__ __forceinline__ float half_sum(float v) {
#pragma unroll
    for (int o = 1; o < 32; o <<= 1) v += __shfl_xor(v, o);
    return v;
}
__device__ __forceinline__ float bflo(unsigned w) { return __builtin_bit_cast(float, w << 16); }
__device__ __forceinline__ float bfhi(unsigned w) { return __builtin_bit_cast(float, w & 0xffff0000u); }
typedef float f32x2_t_ __attribute__((ext_vector_type(2))); typedef __bf16 bf16x2_t_ __attribute__((ext_vector_type(2)));
__device__ __forceinline__ unsigned pkbf(float lo, float hi) { f32x2_t_ v = {lo, hi}; bf16x2_t_ b = __builtin_convertvector(v, bf16x2_t_); return __builtin_bit_cast(unsigned, b); }
__device__ __forceinline__ float sigm(float x) { return __builtin_amdgcn_rcpf(1.0f + __builtin_amdgcn_exp2f(-1.4426950408889634f * x)); }

__device__ __forceinline__ void p_prologue(Frame& F, const Args& A) {
    unsigned char* const ws = launder(F.ws);
    const int tid = (F.wave * 64 + hw_lane()), lane = tid & 63; (void)lane;
    LAS float* sc = (LAS float*)(F.lds + RING_OFF);
    for (int i = tid; i < 9 * 1024; i += NWAVES * 64) { const int b = i >> 10, k = i & 1023; const float v = (b < 8) ? INP(IN_C)[b * 1024 + k] : INP(IN_CCTX)[k]; sc[i] = v * sigm(v); }
    __syncthreads();
    const int gw = F.vcu * NWAVES + F.wave, NGW = F.G * NWAVES;
    float* mod = (float*)(ws + WS_MOD);
    for (int it = (int)blockIdx.x + F.G * F.wave; it < DEPTH * 96; it += NGW) {
        const int l = it / 96, j = (it % 96) * 64 + lane;
        const float* W = INP(IN_ADAW) + (size_t)l * 1024 * 6144 + j;
        float acc[9];
#pragma unroll
        for (int b = 0; b < 9; ++b) acc[b] = 0.f;
        for (int k = 0; k < 1024; k += 16) {
            float wv[16];
#pragma unroll
            for (int u = 0; u < 16; ++u) wv[u] = W[(size_t)(k + u) * 6144];
#pragma unroll
            for (int b = 0; b < 9; ++b)
#pragma unroll
                for (int u4 = 0; u4 < 4; ++u4) { const f32x4 s = *(const LAS f32x4*)(sc + b * 1024 + k + 4 * u4); acc[b] += (s[0] * wv[4 * u4] + s[1] * wv[4 * u4 + 1]) + (s[2] * wv[4 * u4 + 2] + s[3] * wv[4 * u4 + 3]); }
        }
        const float bias = INP(IN_ADAB)[l * 6144 + j];
#pragma unroll
        for (int b = 0; b < 9; ++b) mod[((size_t)l * 9 + b) * 6144 + j] = acc[b] + bias;
    }
    float* cs = (float*)(ws + WS_ROPE);
    for (int i = blockIdx.x * (NWAVES * 64) + tid; i < 4096 * 32; i += F.G * NWAVES * 64) {
        const int t = i >> 5, k = i & 31; const int pos = (k < 16) ? (t >> 6) : (t & 63);
        const float inv = powf(10000.0f, -(float)(2 * (k & 15)) / 32.0f); const float ang = (float)pos * inv;
        float s, c; sincosf(ang, &s, &c); cs[2 * i] = c; cs[2 * i + 1] = s;
    }
    __syncthreads();
}

struct WItem { const float* W; unsigned char* WT; int K, N, k0, n0, drow0, f8; };
__device__ __forceinline__ void tr_load(const WItem& w, float (&tv)[32], int lane) {
#pragma unroll
    for (int i = 0; i < 32; ++i) tv[i] = w.W[(size_t)(w.k0 + 2 * i + (lane >> 5)) * w.N + w.n0 + (lane & 31)];
}
__device__ __forceinline__ void tr_finish(const WItem& w, const float (&tv)[32], LAS float* scr, int lane) {
#pragma unroll
    for (int i = 0; i < 32; ++i) scr[(2 * i + (lane >> 5)) * 33 + (lane & 31)] = tv[i];
    LDS_WAIT(); asm volatile("" ::: "memory");
    if (w.f8) { const int c = lane & 3;
#pragma unroll
        for (int j = 0; j < 2; ++j) { const int n = (lane >> 2) + 16 * j; const LAS float* s = scr + (16 * c) * 33 + n;
            v4u o;
            o.x = pg8::pk_fp8x4(s[0 * 33] * W8SCALE, s[1 * 33] * W8SCALE, s[2 * 33] * W8SCALE, s[3 * 33] * W8SCALE); o.y = pg8::pk_fp8x4(s[4 * 33] * W8SCALE, s[5 * 33] * W8SCALE, s[6 * 33] * W8SCALE, s[7 * 33] * W8SCALE);
            o.z = pg8::pk_fp8x4(s[8 * 33] * W8SCALE, s[9 * 33] * W8SCALE, s[10 * 33] * W8SCALE, s[11 * 33] * W8SCALE); o.w = pg8::pk_fp8x4(s[12 * 33] * W8SCALE, s[13 * 33] * W8SCALE, s[14 * 33] * W8SCALE, s[15 * 33] * W8SCALE);
            *(v4u*)(w.WT + (size_t)(w.drow0 + n) * w.K + w.k0 + 16 * c) = o; }
    } else { const int c = lane & 7;
#pragma unroll
        for (int j = 0; j < 4; ++j) { const int n = (lane >> 3) + 8 * j; const LAS float* s = scr + (8 * c) * 33 + n;
            v4u o; o.x = pkbf(s[0 * 33], s[1 * 33]); o.y = pkbf(s[2 * 33], s[3 * 33]); o.z = pkbf(s[4 * 33], s[5 * 33]); o.w = pkbf(s[6 * 33], s[7 * 33]);
            *(v4u*)((bf16*)w.WT + (size_t)(w.drow0 + n) * w.K + w.k0 + 8 * c) = o; } }
    LDS_WAIT(); asm volatile("" ::: "memory");
}
__device__ __forceinline__ int gu_row(int n) { return 256 * (n >> 7) + (n & 127); }

__device__ __forceinline__ WItem wprep_decode(Frame& F, unsigned char* const ws, const int l, const int it) {
    constexpr int I_IN = 16 * (INW / 32), I_OUT = 16 * 32;
    const bool moe = (l & 1) != 0; const int j = l >> 1;
    constexpr int I_DG = 16 * (FFD / 32), I_MG = 16 * (FFE / 32);
    int r = it; WItem w;
    if (r < I_IN) { const int nb = r % (INW / 32), kb = r / (INW / 32); w = WItem{INP(IN_WIN) + (size_t)l * 1024 * INW, ws + WS_WIN, 1024, INW, kb * 64, nb * 32, nb * 32, 0}; return w; } r -= I_IN;
    if (r < I_OUT) { const int nb = r % 32, kb = r / 32; w = WItem{INP(IN_WOUT) + (size_t)l * 1024 * 1024, ws + WS_WOUT, 1024, 1024, kb * 64, nb * 32, nb * 32, 0}; return w; } r -= I_OUT;
    if (!moe) {
        if (r < I_DG) { const int nb = r % (FFD / 32), kb = r / (FFD / 32); w = WItem{INP(IN_FWG) + (size_t)j * 1024 * FFD, ws + WS_WFF, 1024, FFD, kb * 64, nb * 32, gu_row(nb * 32), 0}; return w; } r -= I_DG;
        if (r < I_DG) { const int nb = r % (FFD / 32), kb = r / (FFD / 32); w = WItem{INP(IN_FWU) + (size_t)j * 1024 * FFD, ws + WS_WFF, 1024, FFD, kb * 64, nb * 32, gu_row(nb * 32) + 128, 0}; return w; } r -= I_DG;
        { const int nb = r % 32, kb = r / 32; w = WItem{INP(IN_FWD) + (size_t)j * FFD * 1024, ws + WS_WFF_D_DENSE, FFD, 1024, kb * 64, nb * 32, nb * 32, 0}; return w; }
    }
    constexpr int I_MD = (FFE / 64) * 32; constexpr int PER = 2 * I_MG + I_MD; const int e = r / PER; r -= e * PER;
    unsigned char* WGU = ws + WS_WFF + (size_t)e * (2 * FFE) * 1024; unsigned char* WD = ws + WS_WFF_D_MOE8 + (size_t)e * 1024 * FFE;
    const size_t eo = ((size_t)j * NEXP + e) * 1024 * FFE;
    if (r < I_MG) { const int nb = r % (FFE / 32), kb = r / (FFE / 32); w = WItem{INP(IN_MWG) + eo, WGU, 1024, FFE, kb * 64, nb * 32, gu_row(nb * 32), 1}; return w; } r -= I_MG;
    if (r < I_MG) { const int nb = r % (FFE / 32), kb = r / (FFE / 32); w = WItem{INP(IN_MWU) + eo, WGU, 1024, FFE, kb * 64, nb * 32, gu_row(nb * 32) + 128, 1}; return w; } r -= I_MG;
    { const int nb = r % 32, kb = r / 32; w = WItem{INP(IN_MWD) + eo, WD, FFE, 1024, kb * 64, nb * 32, nb * 32, 1}; return w; }
}
__device__ __forceinline__ void p_wprep(Frame& F, const Args& A, int l, int part, gu32* ctr = nullptr) {
    unsigned char* const ws = launder(F.ws);
    const int tid = (F.wave * 64 + hw_lane()), lane = tid & 63; (void)lane;
    LAS float* scr = (LAS float*)(F.lds + RING_OFF + F.wave * 16384);
    const int gw = F.vcu * NWAVES + F.wave, NGW = F.G * NWAVES;
    bf16* WIN = (bf16*)(ws + WS_WIN); bf16* WLORA = (bf16*)(ws + WS_WLORA);
    constexpr int I_IN = 16 * (INW / 32), I_OUT = 16 * 32;
    const bool moe = (l & 1) != 0;
    constexpr int I_DG = 16 * (FFD / 32), I_DD = (FFD / 64) * 32, I_MG = 16 * (FFE / 32), I_MD = (FFE / 64) * 32;
    const int nff = moe ? NEXP * (2 * I_MG + I_MD) : (2 * I_DG + I_DD);
    const int NIT = I_IN + I_OUT + nff;
    const int lo = part ? I_IN + I_OUT : 0, hi = part ? NIT : I_IN + I_OUT;
    (void)ctr;
    {
        int it = lo + gw; WItem wa, wb; float ta[32], tb[32];
        if (it < hi) { wa = wprep_decode(F, ws, l, it); tr_load(wa, ta, lane); }
        for (; it < hi; it += 2 * NGW) {
            const int i2 = it + NGW, i3 = i2 + NGW;
            if (i2 < hi) { wb = wprep_decode(F, ws, l, i2); tr_load(wb, tb, lane); }
            tr_finish(wa, ta, scr, lane);
            if (i3 < hi) { wa = wprep_decode(F, ws, l, i3); tr_load(wa, ta, lane); }
            if (i2 < hi) tr_finish(wb, tb, scr, lane);
        }
    }
    if (part) return;
    for (int i = blockIdx.x * (NWAVES * 64) + tid; i < 16384; i += F.G * NWAVES * 64) ((v4u*)(WIN + (size_t)INW * 1024))[i] = (v4u){0u, 0u, 0u, 0u};
    const float* w2 = INP(IN_W2) + (size_t)l * 2 * 64 * 512; const float* a2 = INP(IN_A2) + (size_t)l * 2 * 64 * 512; const float* g2 = INP(IN_G2) + (size_t)l * 128 * 512;
    for (int i = blockIdx.x * (NWAVES * 64) + tid; i < LORA_N * 64; i += F.G * NWAVES * 64) {
        const int n = i >> 6, k = (i & 63) * 2; const int sec = n >> 9, cn = n & 511;
        float v0 = 0.f, v1 = 0.f;
        if (sec < 2) { const int kk = k - 64 * sec; if (kk >= 0 && kk < 64) { v0 = w2[((size_t)sec * 64 + kk) * 512 + cn]; v1 = w2[((size_t)sec * 64 + kk + 1) * 512 + cn]; } }
        else if (sec < 4) { const int d = sec - 2, kk = k - 64 * d; if (kk >= 0 && kk < 64) { v0 = a2[((size_t)d * 64 + kk) * 512 + cn]; v1 = a2[((size_t)d * 64 + kk + 1) * 512 + cn]; } }
        else { v0 = g2[(size_t)k * 512 + cn]; v1 = g2[(size_t)(k + 1) * 512 + cn]; }
        ((unsigned*)WLORA)[i] = pkbf(v0, v1);
    }
}

template <bool ROUTER, bool COMBINE, bool SRCF32, bool SIDE = false>
__device__ __forceinline__ void p_norm(Frame& F, const Args& A, int l, int which, const float* srcL, const float* srcC, int lprev, int nrows = TT) {
    unsigned char* const ws = launder(F.ws);
    const int tid = (F.wave * 64 + hw_lane()), lane = tid & 63; (void)lane;
    const int gw = F.vcu * NWAVES + F.wave, NGW = F.G * NWAVES;
    const float* mod = (const float*)(ws + WS_MOD) + (size_t)l * 9 * 6144;
    const float* gain = A.in[which ? IN_N2G : IN_N1G] + l * 1024;
    bf16* H = (bf16*)F.out;
    const float* route_g = (const float*)(ws + WS_ROUTE + RT_G); const int* route_s = (const int*)(ws + WS_ROUTE + RT_S);
    int cnt0 = 0, cnt1 = 0, cnt2 = 0, cnt3 = 0, cnt4 = 0, cnt5 = 0, cnt6 = 0, cnt7 = 0;
    LAS float* rwl = (LAS float*)(F.lds + RING_OFF);
    if (ROUTER) {
        __syncthreads();
        const float* rw = INP(IN_ROUTER) + (size_t)(l >> 1) * 1024 * 8;
        for (int i = tid; i < 2048; i += NWAVES * 64) { const f32x4 w = *(const f32x4*)(rw + 4 * i); const int col = i >> 1, e4 = (i & 1) * 4, jj = col >> 8, ln = (col & 255) >> 2, q = col & 3;
            *(LAS f32x4*)(rwl + (((jj * 4 + q) * 64 + ln) * 8 + e4)) = w; }
        __syncthreads();
    }
    uint2 nx[2][4]; f32x4 nf[2][4]; float cg[2][2]; int cs[2][2];
#pragma unroll
    for (int r = 0; r < 2; ++r) { cg[r][0] = cg[r][1] = 0.f; cs[r][0] = cs[r][1] = 0;
#pragma unroll
        for (int jj = 0; jj < 4; ++jj) { nx[r][jj] = make_uint2(0u, 0u); nf[r][jj] = (f32x4){0.f, 0.f, 0.f, 0.f}; } }
#define PN_LOAD(r_, row_) do { const int row__ = (row_); if (row__ < nrows) { \
        if (SRCF32) { const float* xr_ = (row__ < TL) ? srcL + (size_t)row__ * 1024 : srcC + (size_t)(row__ - TL) * 1024; _Pragma("unroll") for (int jj = 0; jj < 4; ++jj) nf[r_][jj] = *(const f32x4*)(xr_ + 4 * ln + 256 * jj); } \
        else { const bf16* xr_ = (const bf16*)(ws + WS_XB) + (size_t)row__ * 1024; _Pragma("unroll") for (int jj = 0; jj < 4; ++jj) nx[r_][jj] = *(const uint2*)(xr_ + 4 * ln + 256 * jj); } \
        if (COMBINE) { cg[r_][0] = route_g[2 * row__]; cg[r_][1] = route_g[2 * row__ + 1]; cs[r_][0] = route_s[2 * row__]; cs[r_][1] = route_s[2 * row__ + 1]; } } } while (0)
    int ln = vlaunder(lane);
    PN_LOAD(0, gw); PN_LOAD(1, gw + NGW);
    for (int row0 = gw; row0 < nrows; row0 += 2 * NGW) {
        ln = vlaunder(lane);
        const bool ok1 = row0 + NGW < nrows;
        f32x4 v[2][4]; float g0[2], g1[2]; int s0[2], s1[2];
#pragma unroll
        for (int r = 0; r < 2; ++r) { g0[r] = cg[r][0]; g1[r] = cg[r][1]; s0[r] = cs[r][0]; s1[r] = cs[r][1];
#pragma unroll
            for (int jj = 0; jj < 4; ++jj) { if (SRCF32) v[r][jj] = nf[r][jj]; else { const uint2 w = nx[r][jj]; v[r][jj] = (f32x4){bflo(w.x), bfhi(w.x), bflo(w.y), bfhi(w.y)}; } } }
        PN_LOAD(0, row0 + 2 * NGW); PN_LOAD(1, row0 + 3 * NGW);
        if (COMBINE) {
            const bf16* Y = (const bf16*)(ws + WS_AG);
            uint2 yy0[2][4], yy1[2][4];
#pragma unroll
            for (int r = 0; r < 2; ++r)
#pragma unroll
                for (int jj = 0; jj < 4; ++jj) { const int col = 4 * ln + 256 * jj; yy0[r][jj] = *(const uint2*)(Y + (size_t)s0[r] * 1024 + col); yy1[r][jj] = *(const uint2*)(Y + (size_t)s1[r] * 1024 + col); }
#pragma unroll
            for (int r = 0; r < 2; ++r) { const int row = row0 + r * NGW; const int bsel = (row < TL) ? (row >> 12) : 8;
                const float* m5 = (const float*)(ws + WS_MOD) + ((size_t)lprev * 9 + bsel) * 6144 + 5 * 1024;
                bf16* xbr = (bf16*)(ws + WS_XB) + (size_t)row * 1024;
#pragma unroll
                for (int jj = 0; jj < 4; ++jj) { const int col = 4 * ln + 256 * jj;
                    const uint2 y0 = yy0[r][jj], y1 = yy1[r][jj]; const f32x4 mm = *(const f32x4*)(m5 + col);
                    v[r][jj][0] += mm[0] * (g0[r] * bflo(y0.x) + g1[r] * bflo(y1.x)); v[r][jj][1] += mm[1] * (g0[r] * bfhi(y0.x) + g1[r] * bfhi(y1.x));
                    v[r][jj][2] += mm[2] * (g0[r] * bflo(y0.y) + g1[r] * bflo(y1.y)); v[r][jj][3] += mm[3] * (g0[r] * bfhi(y0.y) + g1[r] * bfhi(y1.y));
                    if (r == 0 || ok1) *(uint2*)(xbr + col) = make_uint2(pkbf(v[r][jj][0], v[r][jj][1]), pkbf(v[r][jj][2], v[r][jj][3])); } }
        }
        if (SIDE) {
#pragma unroll
            for (int r = 0; r < 2; ++r) { const int row = row0 + r * NGW;
                if ((r == 0 || ok1) && row >= TL) {
                    const bf16* sd = (const bf16*)(ws + WS_SIDE) + (size_t)(row - TL) * 1024; bf16* xbr = (bf16*)(ws + WS_XB) + (size_t)row * 1024;
                    uint2 sv[3][4];
#pragma unroll
                    for (int q = 0; q < 3; ++q)
#pragma unroll
                        for (int jj = 0; jj < 4; ++jj) sv[q][jj] = *(const uint2*)(sd + (size_t)q * TC * 1024 + 4 * ln + 256 * jj);
#pragma unroll
                    for (int jj = 0; jj < 4; ++jj) {
#pragma unroll
                        for (int q = 0; q < 3; ++q) { const uint2 w = sv[q][jj]; v[r][jj][0] += bflo(w.x); v[r][jj][1] += bfhi(w.x); v[r][jj][2] += bflo(w.y); v[r][jj][3] += bfhi(w.y); }
                        *(uint2*)(xbr + 4 * ln + 256 * jj) = make_uint2(pkbf(v[r][jj][0], v[r][jj][1]), pkbf(v[r][jj][2], v[r][jj][3])); } } }
        }
        float ss[2];
#pragma unroll
        for (int r = 0; r < 2; ++r) { ss[r] = 0.f;
#pragma unroll
            for (int jj = 0; jj < 4; ++jj) ss[r] += (v[r][jj][0] * v[r][jj][0] + v[r][jj][1] * v[r][jj][1]) + (v[r][jj][2] * v[r][jj][2] + v[r][jj][3] * v[r][jj][3]); }
#pragma unroll
        for (int o = 1; o < 64; o <<= 1) { const float t0 = __shfl_xor(ss[0], o), t1 = __shfl_xor(ss[1], o); ss[0] += t0; ss[1] += t1; }
        float rstd[2]; const float* shp[2];
#pragma unroll
        for (int r = 0; r < 2; ++r) { const int row = row0 + r * NGW; const int bsel = (row < TL) ? (row >> 12) : 8;
            rstd[r] = 1.0f / sqrtf(ss[r] * (1.0f / 1024.0f) + RMS_EPS); shp[r] = mod + (size_t)bsel * 6144 + (which ? 3 : 0) * 1024; }
        float lg[2][8];
#pragma unroll
        for (int r = 0; r < 2; ++r)
#pragma unroll
            for (int e = 0; e < 8; ++e) lg[r][e] = 0.f;
#pragma unroll
        for (int jj = 0; jj < 4; ++jj) { const int col = 4 * ln + 256 * jj;
            const f32x4 gg = *(const f32x4*)(gain + col); f32x4 h[2];
#pragma unroll
            for (int r = 0; r < 2; ++r) { const int row = row0 + r * NGW;
                const f32x4 sh = *(const f32x4*)(shp[r] + col), sc = *(const f32x4*)(shp[r] + 1024 + col);
                h[r] = (v[r][jj] * rstd[r]) * gg * (sc + 1.0f) + sh;
                if (r == 0 || ok1) {
                    if (ROUTER) *(unsigned*)((unsigned char*)H + (size_t)row * 1024 + col) = pg8::pk_fp8x4(h[r][0] * H8SCALE, h[r][1] * H8SCALE, h[r][2] * H8SCALE, h[r][3] * H8SCALE);
                    else { uint2 o; o.x = pkbf(h[r][0], h[r][1]); o.y = pkbf(h[r][2], h[r][3]); *(uint2*)(H + (size_t)row * 1024 + col) = o; } } }
            if (ROUTER) {
#pragma unroll
                for (int q = 0; q < 4; ++q) { const LAS float* rp = rwl + ((jj * 4 + q) * 64 + ln) * 8; const f32x4 ra = *(const LAS f32x4*)rp, rb = *(const LAS f32x4*)(rp + 4);
#pragma unroll
                    for (int r = 0; r < 2; ++r) { lg[r][0] += h[r][q] * ra[0]; lg[r][1] += h[r][q] * ra[1]; lg[r][2] += h[r][q] * ra[2]; lg[r][3] += h[r][q] * ra[3];
                        lg[r][4] += h[r][q] * rb[0]; lg[r][5] += h[r][q] * rb[1]; lg[r][6] += h[r][q] * rb[2]; lg[r][7] += h[r][q] * rb[3]; } } }
        }
        if (ROUTER) {
#pragma unroll
            for (int o = 1; o < 64; o <<= 1) { float t[2][8];
#pragma unroll
                for (int r = 0; r < 2; ++r)
#pragma unroll
                    for (int e = 0; e < 8; ++e) t[r][e] = __shfl_xor(lg[r][e], o);
#pragma unroll
                for (int r = 0; r < 2; ++r)
#pragma unroll
                    for (int e = 0; e < 8; ++e) lg[r][e] += t[r][e]; }
#pragma unroll
            for (int r = 0; r < 2; ++r) { const int row = row0 + r * NGW;
                if (r == 0 || ok1) {
                    int e0 = 0; float v0 = lg[r][0];
#pragma unroll
                    for (int e = 1; e < 8; ++e) if (lg[r][e] > v0) { v0 = lg[r][e]; e0 = e; }
                    int e1 = -1; float v1 = -INFINITY;
#pragma unroll
                    for (int e = 0; e < 8; ++e) if (e != e0 && lg[r][e] > v1) { v1 = lg[r][e]; e1 = e; }
                    const float q0 = 1.0f / (1.0f + __expf(v1 - v0)), q1 = 1.0f - q0;
                    if (ln == 0) { ((int*)(ws + WS_ROUTE + RT_E))[row] = e0 | (e1 << 8); ((float*)(ws + WS_ROUTE + RT_G))[2 * row] = q0; ((float*)(ws + WS_ROUTE + RT_G))[2 * row + 1] = q1; }
                    cnt0 += (e0 == 0) + (e1 == 0); cnt1 += (e0 == 1) + (e1 == 1); cnt2 += (e0 == 2) + (e1 == 2); cnt3 += (e0 == 3) + (e1 == 3);
                    cnt4 += (e0 == 4) + (e1 == 4); cnt5 += (e0 == 5) + (e1 == 5); cnt6 += (e0 == 6) + (e1 == 6); cnt7 += (e0 == 7) + (e1 == 7); } }
        }
    }
#undef PN_LOAD
    if (ROUTER) {
        int* wcnt = (int*)(ws + WS_ROUTE + RT_WCNT);
        if (ln == 0) { int* w = wcnt + (size_t)gw * 8; w[0] = cnt0; w[1] = cnt1; w[2] = cnt2; w[3] = cnt3; w[4] = cnt4; w[5] = cnt5; w[6] = cnt6; w[7] = cnt7; }
    }
}
__device__ __forceinline__ void p_final_combine(Frame& F, int lprev) {
    unsigned char* const ws = launder(F.ws);
    const int tid = (F.wave * 64 + hw_lane()), lane = tid & 63; (void)lane;
    const int gw = F.vcu * NWAVES + F.wave, NGW = F.G * NWAVES;
    const float* route_g = (const float*)(ws + WS_ROUTE + RT_G); const int* route_s = (const int*)(ws + WS_ROUTE + RT_S);
    const bf16* Y = (const bf16*)(ws + WS_AG);
    float g0n = 0.f, g1n = 0.f; int s0n = 0, s1n = 0;
    if (gw < TL) { g0n = route_g[2 * gw]; g1n = route_g[2 * gw + 1]; s0n = route_s[2 * gw]; s1n = route_s[2 * gw + 1]; }
    for (int row = gw; row < TL; row += NGW) {
        const int bsel = row >> 12;
        const float* m5 = (const float*)(ws + WS_MOD) + ((size_t)lprev * 9 + bsel) * 6144 + 5 * 1024;
        const float g0 = g0n, g1 = g1n; const int s0 = s0n, s1 = s1n;
        float* xw = F.out + (size_t)row * 1024; const bf16* xbr = (const bf16*)(ws + WS_XB) + (size_t)row * 1024;
        uint2 xw2[4], y0[4], y1[4];
#pragma unroll
        for (int jj = 0; jj < 4; ++jj) { const int col = 4 * lane + 256 * jj; xw2[jj] = *(const uint2*)(xbr + col); y0[jj] = *(const uint2*)(Y + (size_t)s0 * 1024 + col); y1[jj] = *(const uint2*)(Y + (size_t)s1 * 1024 + col); }
        if (row + NGW < TL) { const int rn = row + NGW; g0n = route_g[2 * rn]; g1n = route_g[2 * rn + 1]; s0n = route_s[2 * rn]; s1n = route_s[2 * rn + 1]; }
#pragma unroll
        for (int jj = 0; jj < 4; ++jj) { const int col = 4 * lane + 256 * jj; const f32x4 mm = *(const f32x4*)(m5 + col);
            f32x4 v = (f32x4){bflo(xw2[jj].x), bfhi(xw2[jj].x), bflo(xw2[jj].y), bfhi(xw2[jj].y)};
            v[0] += mm[0] * (g0 * bflo(y0[jj].x) + g1 * bflo(y1[jj].x)); v[1] += mm[1] * (g0 * bfhi(y0[jj].x) + g1 * bfhi(y1[jj].x));
            v[2] += mm[2] * (g0 * bflo(y0[jj].y) + g1 * bflo(y1[jj].y)); v[3] += mm[3] * (g0 * bfhi(y0[jj].y) + g1 * bfhi(y1[jj].y));
            *(f32x4*)(xw + col) = v; }
    }
}

__device__ __forceinline__ void p_prep(Frame& F, const Args& A, int l) {
    unsigned char* const ws = launder(F.ws);
    const int tid = (F.wave * 64 + hw_lane()), lane = tid & 63; (void)lane;
    const int gw = F.vcu * NWAVES + F.wave, NGW = F.G * NWAVES;
    const unsigned* P = (const unsigned*)(ws + WS_P);
    const float* cs = (const float*)(ws + WS_ROPE);
    bf16* QO = (bf16*)(ws + WS_QO); bf16* KB = (bf16*)(ws + WS_KB); bf16* VB = (bf16*)(ws + WS_VB);
    unsigned* Rst = (unsigned*)(ws + WS_R); unsigned* Kst = (unsigned*)(ws + WS_K); unsigned* Vst = (unsigned*)(ws + WS_V); unsigned* KKst = (unsigned*)(ws + WS_KK); unsigned* LIN = (unsigned*)(ws + WS_LIN);
    const int d0 = 2 * (lane & 31);
    const float qg0 = INP(IN_QG)[l * 64 + d0], qg1 = INP(IN_QG)[l * 64 + d0 + 1], kg0 = INP(IN_KG)[l * 64 + d0], kg1 = INP(IN_KG)[l * 64 + d0 + 1];
    float mu0[15], mu1[15];
#pragma unroll
    for (int i = 0; i < 15; ++i) { mu0[i] = INP(IN_MU)[l * SHIFTW + 128 * i + 2 * lane]; mu1[i] = INP(IN_MU)[l * SHIFTW + 128 * i + 2 * lane + 1]; }
    float kw0[4], kw1[4];
#pragma unroll
    for (int i = 0; i < 4; ++i) { kw0[i] = INP(IN_KKW)[l * 512 + 128 * i + 2 * lane]; kw1[i] = INP(IN_KKW)[l * 512 + 128 * i + 2 * lane + 1]; }
    const float C2 = 0.125f * 1.4426950408889634f;
    const float sgn = (lane & 16) ? 1.0f : -1.0f;
    for (int w0 = gw; w0 * 17 < TT; w0 += NGW) {
        const int rbeg = w0 * 17;
        unsigned cur[21], nxt[21], prv[15];
#pragma unroll
        for (int i = 0; i < 15; ++i) prv[i] = 0u;
        {   const int r = rbeg; const bool lat = r < TL; const int pos = lat ? (r & 4095) : ((r - TL) & 255);
            if (pos != 0) {
#pragma unroll
                for (int i = 0; i < 15; ++i) prv[i] = P[(size_t)(r - 1) * (INWP / 2) + 64 * (i + 6) + lane]; }
#pragma unroll
            for (int i = 0; i < 21; ++i) cur[i] = P[(size_t)r * (INWP / 2) + 64 * i + lane];
        }
        for (int k = 0; k < 17; ++k) {
            const int r = rbeg + k; const bool lat = r < TL; const int pos = lat ? (r & 4095) : ((r - TL) & 255); const int slen = lat ? 4096 : 256;
            const bool has_next = (pos != slen - 1);
            const bool load_next = (k < 16) || has_next;
            if (load_next && r + 1 < TT) {
#pragma unroll
                for (int i = 0; i < 21; ++i) nxt[i] = P[(size_t)(r + 1) * (INWP / 2) + 64 * i + lane];
            } else {
#pragma unroll
                for (int i = 0; i < 21; ++i) nxt[i] = 0u;
            }
            const int b = lat ? (r >> 12) : ((r - TL) >> 8);
            const size_t kvrow = (size_t)b * KVLEN + (lat ? pos : 4096 + pos);
            f32x4 csv = (f32x4){1.f, 0.f, 1.f, 0.f};
            if (lat) csv = *(const f32x4*)(cs + ((size_t)pos * 32 + 2 * (lane & 15)) * 2);
#pragma unroll
            for (int i = 0; i < 5; ++i) {
                float x0 = bflo(cur[i]), x1 = bfhi(cur[i]);
                const float ss = half_sum(x0 * x0 + x1 * x1);
                const float rstd = 1.0f / sqrtf(ss * (1.0f / 64.0f) + RMS_EPS);
                x0 = x0 * rstd * (i < 4 ? qg0 : kg0); x1 = x1 * rstd * (i < 4 ? qg1 : kg1);
                const float p0 = __shfl_xor(x0, 16), p1 = __shfl_xor(x1, 16);
                const float y0 = x0 * csv[0] + sgn * p0 * csv[1], y1 = x1 * csv[2] + sgn * p1 * csv[3];
                if (i < 4) *(unsigned*)(QO + (size_t)r * 1024 + 128 * i + 2 * lane) = pkbf(y0 * C2, y1 * C2);
                else *(unsigned*)(KB + kvrow * 128 + 2 * lane) = pkbf(y0, y1);
            }
            *(unsigned*)(VB + kvrow * 128 + 2 * lane) = cur[5];
            const float hn = has_next ? 1.0f : 0.0f;
#pragma unroll
            for (int i = 0; i < 15; ++i) {
                const float c0 = bflo(cur[i + 6]), c1 = bfhi(cur[i + 6]);
                const float a0 = bflo(prv[i]) + hn * bflo(nxt[i + 6]), a1 = bfhi(prv[i]) + hn * bfhi(nxt[i + 6]);
                const float s0 = c0 + mu0[i] * (0.5f * a0 - c0), s1 = c1 + mu1[i] * (0.5f * a1 - c1);
                if (i < 4) Rst[(size_t)r * 256 + 64 * i + lane] = pkbf(s0, s1);
                else if (i < 8) { Kst[(size_t)r * 256 + 64 * (i - 4) + lane] = pkbf(s0, s1);
                    const float t0 = s0 * kw0[i - 4], t1 = s1 * kw1[i - 4]; const float q = half_sum(t0 * t0 + t1 * t1); const float rn = 1.0f / sqrtf(q + 1e-12f);
                    KKst[(size_t)r * 256 + 64 * (i - 4) + lane] = pkbf(t0 * rn, t1 * rn); }
                else if (i < 12) Vst[(size_t)r * 256 + 64 * (i - 8) + lane] = pkbf(s0, s1);
                else if (i == 12) { const float e0 = __builtin_amdgcn_exp2f(2.0f * 1.4426950408889634f * s0), e1 = __builtin_amdgcn_exp2f(2.0f * 1.4426950408889634f * s1);
                    LIN[(size_t)r * (LORA_K / 2) + lane] = pkbf(1.0f - 2.0f * __builtin_amdgcn_rcpf(1.0f + e0), 1.0f - 2.0f * __builtin_amdgcn_rcpf(1.0f + e1)); }
                else if (i == 13) LIN[(size_t)r * (LORA_K / 2) + 64 + lane] = pkbf(s0, s1);
                else LIN[(size_t)r * (LORA_K / 2) + 128 + lane] = pkbf(sigm(s0), sigm(s1));
            }
#pragma unroll
            for (int i = 0; i < 15; ++i) prv[i] = has_next ? cur[i + 6] : 0u;
#pragma unroll
            for (int i = 0; i < 21; ++i) cur[i] = nxt[i];
        }
    }
}

template <int CTRL> __device__ __forceinline__ float dppf(float v) { return __builtin_bit_cast(float, __builtin_amdgcn_update_dpp(0, __builtin_bit_cast(int, v), CTRL, 0xf, 0xf, true)); }
__device__ __forceinline__ float red16(float v) { v += dppf<0xB1>(v); v += dppf<0x4E>(v); v += dppf<0x141>(v); v += dppf<0x128>(v); return v; }
constexpr int SC_TS = 32, SC_W = 352;
__device__ __forceinline__ void p_scan(Frame& F, const Args& A, int l) {
    unsigned char* const ws = launder(F.ws);
    const int tid = (F.wave * 64 + hw_lane()), lane = tid & 63; (void)lane;
    LAS float* buf = (LAS float*)(F.lds + RING_OFF);
    float* OSC = (float*)(ws + WS_OSC);
    constexpr int NCH = KVLEN / SC_TS;
    for (int item = blockIdx.x; item < 256; item += F.G) {
        const int chain = item >> 1, rh = item & 1, dir = chain & 1, bh = chain >> 1, b = bh >> 3, h = bh & 7;
        const int row = tid >> 4, c = tid & 15;
        float S0 = 0.f, S1 = 0.f, S2 = 0.f, S3 = 0.f;
        const bool stg = tid < 352; const int sub = (tid >= 176) ? 1 : 0, pp = tid - 176 * sub, a = pp >> 5, w = pp & 31;
        const unsigned* p1; int pitch1 = 256;
        if (a == 0 || a == 2) p1 = (const unsigned*)(ws + WS_KK) + h * 32 + w;
        else if (a == 1) { p1 = (const unsigned*)(ws + WS_LOUT) + dir * 256 + h * 32 + w; pitch1 = LORA_N / 2; }
        else if (a == 3) p1 = (const unsigned*)(ws + WS_K) + h * 32 + w;
        else if (a == 4) p1 = (const unsigned*)(ws + WS_R) + h * 32 + w;
        else p1 = (const unsigned*)(ws + WS_V) + h * 32 + rh * 16 + (pp - 160);
        const unsigned* p2 = (const unsigned*)(ws + WS_LOUT) + 512 + dir * 256 + h * 32 + w;
        const bool two = (a == 2 || a == 3);
        const int cw = (a == 5) ? 0 : 2 * w;
        const float cw0 = INP(IN_W0)[l * 1024 + dir * 512 + h * 64 + cw], cw1 = INP(IN_W0)[l * 1024 + dir * 512 + h * 64 + cw + 1];
        const float ca0 = INP(IN_A0)[l * 1024 + dir * 512 + h * 64 + cw], ca1 = INP(IN_A0)[l * 1024 + dir * 512 + h * 64 + cw + 1];
        const float ck0 = INP(IN_KA)[l * 512 + h * 64 + cw], ck1 = INP(IN_KA)[l * 512 + h * 64 + cw + 1];
        unsigned st[16], st2[16];
#define SC_TOK(s) ((s) < CTXL ? (TL + b * CTXL + (dir ? (CTXL - 1 - (s)) : (s))) : (b * SEQL + (dir ? (SEQL - 1 - ((s) - CTXL)) : ((s) - CTXL))))
#define SC_LOAD(ci) do { if (stg) { _Pragma("unroll") for (int i = 0; i < 16; ++i) { const int s = (ci) * SC_TS + 2 * i + sub; const size_t tok = (size_t)SC_TOK(s); \
            st[i] = p1[tok * pitch1]; st2[i] = two ? p2[tok * (LORA_N / 2)] : 0u; } } } while (0)
#define SC_STORE(bi) do { if (stg) { _Pragma("unroll") for (int i = 0; i < 16; ++i) { \
            float x0 = bflo(st[i]), x1 = bfhi(st[i]); \
            if (a == 1) { x0 = __builtin_amdgcn_exp2f(-1.4426950408889634f * 0.6065306597126334f * sigm(x0 + cw0)); x1 = __builtin_amdgcn_exp2f(-1.4426950408889634f * 0.6065306597126334f * sigm(x1 + cw1)); } \
            else if (a == 2) { x0 *= sigm(bflo(st2[i]) + ca0); x1 *= sigm(bfhi(st2[i]) + ca1); } \
            else if (a == 3) { x0 *= 1.0f + (sigm(bflo(st2[i]) + ca0) - 1.0f) * ck0; x1 *= 1.0f + (sigm(bfhi(st2[i]) + ca1) - 1.0f) * ck1; } \
            LAS float* dp = buf + ((bi) * SC_TS + 2 * i + sub) * SC_W + 2 * pp; dp[0] = x0; dp[1] = x1; } } } while (0)
        __syncthreads();
        SC_LOAD(0); SC_STORE(0); __syncthreads();
        for (int ci = 0; ci < NCH; ++ci) {
            if (ci + 1 < NCH) SC_LOAD(ci + 1);
            const LAS float* bp = buf + (ci & 1) * SC_TS * SC_W;
#pragma unroll 2
            for (int stp = 0; stp < SC_TS; ++stp) {
                const LAS float* sp = bp + stp * SC_W;
                const f32x4 kk = *(const LAS f32x4*)(sp + 4 * c), w4 = *(const LAS f32x4*)(sp + 64 + 4 * c), bb = *(const LAS f32x4*)(sp + 128 + 4 * c), kd = *(const LAS f32x4*)(sp + 192 + 4 * c), rr = *(const LAS f32x4*)(sp + 256 + 4 * c);
                const float vv = sp[320 + row];
                float sa = (S0 * kk[0] + S1 * kk[1]) + (S2 * kk[2] + S3 * kk[3]); sa = red16(sa);
                S0 = S0 * w4[0] + (vv * kd[0] - sa * bb[0]); S1 = S1 * w4[1] + (vv * kd[1] - sa * bb[1]); S2 = S2 * w4[2] + (vv * kd[2] - sa * bb[2]); S3 = S3 * w4[3] + (vv * kd[3] - sa * bb[3]);
                float o = (S0 * rr[0] + S1 * rr[1]) + (S2 * rr[2] + S3 * rr[3]); o = red16(o);
                if (c == 0) { const int s = ci * SC_TS + stp; OSC[((size_t)dir * TT + (size_t)SC_TOK(s)) * 512 + h * 64 + rh * 32 + row] = o; }
            }
            if (ci + 1 < NCH) SC_STORE((ci + 1) & 1);
            __syncthreads();
        }
#undef SC_TOK
#undef SC_LOAD
#undef SC_STORE
    }
}

__device__ __forceinline__ void p_readout(Frame& F, const Args& A, int l) {
    unsigned char* const ws = launder(F.ws);
    const int tid = (F.wave * 64 + hw_lane()), lane = tid & 63; (void)lane;
    const int gw = F.vcu * NWAVES + F.wave, NGW = F.G * NWAVES;
    const float* OSC = (const float*)(ws + WS_OSC);
    const unsigned* Rst = (const unsigned*)(ws + WS_R); const unsigned* Vst = (const unsigned*)(ws + WS_V); const unsigned* Kst = (const unsigned*)(ws + WS_K); const unsigned* LOUT = (const unsigned*)(ws + WS_LOUT);
    bf16* QO = (bf16*)(ws + WS_QO);
    float rk0[4], rk1[4], gw0[4], gw1[4], gb0[4], gb1[4], ka0[4], ka1[4], aa0[4], aa1[4], ab0[4], ab1[4];
#pragma unroll
    for (int i = 0; i < 4; ++i) { const int cc = 128 * i + 2 * lane, cidx = l * 512 + cc; rk0[i] = INP(IN_RK)[cidx]; rk1[i] = INP(IN_RK)[cidx + 1]; gw0[i] = INP(IN_GNW)[cidx]; gw1[i] = INP(IN_GNW)[cidx + 1]; gb0[i] = INP(IN_GNB)[cidx]; gb1[i] = INP(IN_GNB)[cidx + 1];
        ka0[i] = INP(IN_KA)[cidx]; ka1[i] = INP(IN_KA)[cidx + 1]; aa0[i] = INP(IN_A0)[l * 1024 + cc]; aa1[i] = INP(IN_A0)[l * 1024 + cc + 1]; ab0[i] = INP(IN_A0)[l * 1024 + 512 + cc]; ab1[i] = INP(IN_A0)[l * 1024 + 512 + cc + 1]; }
    for (int row = gw; row < TT; row += NGW) {
#pragma unroll
        for (int i = 0; i < 4; ++i) {
            const size_t off = (size_t)row * 256 + 64 * i + lane; const size_t lo = (size_t)row * (LORA_N / 2) + 64 * i + lane;
            const float2 oa = *(const float2*)(OSC + (size_t)row * 512 + 128 * i + 2 * lane), ob = *(const float2*)(OSC + ((size_t)TT + row) * 512 + 128 * i + 2 * lane);
            const float o0 = oa.x + ob.x, o1 = oa.y + ob.y;
            const float mean = half_sum(o0 + o1) * (1.0f / 64.0f);
            const float d0 = o0 - mean, d1 = o1 - mean;
            const float var = half_sum(d0 * d0 + d1 * d1) * (1.0f / 64.0f);
            const float rs = 1.0f / sqrtf(var + GN_EPS);
            const unsigned rw = Rst[off], vw = Vst[off], kw = Kst[off], pa = LOUT[lo + 512], pb = LOUT[lo + 768], gwd = LOUT[lo + 1024];
            const float ks0 = bflo(kw) * (2.0f + (sigm(bflo(pa) + aa0[i]) + sigm(bflo(pb) + ab0[i]) - 2.0f) * ka0[i]), ks1 = bfhi(kw) * (2.0f + (sigm(bfhi(pa) + aa1[i]) + sigm(bfhi(pb) + ab1[i]) - 2.0f) * ka1[i]);
            const float bsum = half_sum(bflo(rw) * ks0 * rk0[i] + bfhi(rw) * ks1 * rk1[i]);
            const float y0 = d0 * rs * gw0[i] + gb0[i] + bsum * bflo(vw), y1 = d1 * rs * gw1[i] + gb1[i] + bsum * bfhi(vw);
            *(unsigned*)(QO + (size_t)row * 1024 + 512 + 128 * i + 2 * lane) = pkbf(y0 * bflo(gwd), y1 * bfhi(gwd));
        }
    }
}

__device__ __forceinline__ void p_route(Frame& F, int nrows) {
    unsigned char* const ws = launder(F.ws);
    const int tid = (F.wave * 64 + hw_lane()), lane = tid & 63; (void)lane;
    const int gw = F.vcu * NWAVES + F.wave, NGW = F.G * NWAVES;
    const int* wcnt = (const int*)(ws + WS_ROUTE + RT_WCNT);
    LAS int* pexp = (LAS int*)(F.lds + LT_PEXP); LAS int* npan = (LAS int*)(F.lds + LT_NPAN); LAS int* tmp = (LAS int*)(F.lds + LT_TMP);
    {   const int e = lane & 7, part = lane >> 3;
        const int p = F.wave * 8 + part;
        const int wb = p * (NGW / 64), we = wb + NGW / 64; const int myw0 = F.vcu * NWAVES;
        int tot = 0, before = 0;
#pragma unroll 16
        for (int w = wb; w < we; ++w) { const int cv = wcnt[(size_t)w * 8 + e]; tot += cv; if (w < myw0) before += cv; }
        tmp[p * 16 + e] = tot; tmp[p * 16 + 8 + e] = before;
    }
    __syncthreads();
    if (tid < 8) { int tot = 0, before = 0; for (int p = 0; p < 64; ++p) { tot += tmp[p * 16 + tid]; before += tmp[p * 16 + 8 + tid]; } tmp[1024 + tid] = tot; tmp[1032 + tid] = before; }
    __syncthreads();
    if (tid == 0) { int acc = 0; for (int e = 0; e < 8; ++e) { const int padded = (tmp[1024 + e] + 255) & ~255; tmp[1040 + e] = acc; acc += padded; tmp[1048 + e] = acc; } npan[0] = acc >> 8; }
    __syncthreads();
    for (int p = tid; p < 320; p += NWAVES * 64) { int e = 7; for (int q = 7; q >= 0; --q) if (p * 256 < tmp[1048 + q]) e = q; pexp[p] = e; }
    int base0, base1, base2, base3, base4, base5, base6, base7;
    {   int bsv[8];
#pragma unroll
        for (int e = 0; e < 8; ++e) bsv[e] = tmp[1040 + e] + tmp[1032 + e];
        typedef int i32x4 __attribute__((ext_vector_type(4)));
#pragma unroll
        for (int w = 0; w < 7; ++w) { const i32x4* wp = (const i32x4*)(wcnt + (size_t)(F.vcu * NWAVES + w) * 8); const i32x4 c0 = wp[0], c1 = wp[1]; const int mk = (w < F.wave) ? 1 : 0;
            bsv[0] += mk * c0[0]; bsv[1] += mk * c0[1]; bsv[2] += mk * c0[2]; bsv[3] += mk * c0[3]; bsv[4] += mk * c1[0]; bsv[5] += mk * c1[1]; bsv[6] += mk * c1[2]; bsv[7] += mk * c1[3]; }
        base0 = bsv[0]; base1 = bsv[1]; base2 = bsv[2]; base3 = bsv[3]; base4 = bsv[4]; base5 = bsv[5]; base6 = bsv[6]; base7 = bsv[7];
    }
    const int* route_e = (const int*)(ws + WS_ROUTE + RT_E); int* route_s = (int*)(ws + WS_ROUTE + RT_S);
    const unsigned char* H = (const unsigned char*)F.out; unsigned char* AG = ws + WS_AG8;
    int ee_n = 0; v4u a_n = (v4u){0u, 0u, 0u, 0u};
    if (gw < nrows) { ee_n = route_e[gw]; a_n = ((const v4u*)(H + (size_t)gw * 1024))[lane]; }
    for (int row = gw; row < nrows; row += NGW) {
        const int ee = ee_n; const v4u a = a_n; const int e0 = ee & 255, e1 = ee >> 8;
        if (row + NGW < nrows) { ee_n = route_e[row + NGW]; a_n = ((const v4u*)(H + (size_t)(row + NGW) * 1024))[lane]; }
        int s0 = 0, s1 = 0;
#define RT_TAKE(E, B) do { if (e0 == E) { s0 = B; B += 1; } if (e1 == E) { s1 = B; B += 1; } } while (0)
        RT_TAKE(0, base0); RT_TAKE(1, base1); RT_TAKE(2, base2); RT_TAKE(3, base3); RT_TAKE(4, base4); RT_TAKE(5, base5); RT_TAKE(6, base6); RT_TAKE(7, base7);
#undef RT_TAKE
        if (lane == 0) { route_s[2 * row] = s0; route_s[2 * row + 1] = s1; }
        ((v4u*)(AG + (size_t)s0 * 1024))[lane] = a; ((v4u*)(AG + (size_t)s1 * 1024))[lane] = a;
    }
    __syncthreads();
}

__device__ __forceinline__ void p_attn(Frame& F, char* ldsg, bool ctx_on) {
    unsigned char* const ws = launder(F.ws);
    const int tid = (F.wave * 64 + hw_lane()), lane = tid & 63; (void)lane;
    typedef attn_body::bf16 abf;
    const abf* Q = (const abf*)(ws + WS_QO); const abf* K = (const abf*)(ws + WS_KB); const abf* V = (const abf*)(ws + WS_VB); abf* O = (abf*)(ws + WS_QO);
    const int per = (1024 + F.G - 1) / F.G;
    for (int i = 0; i < per; ++i) { const int un = F.vcu * per + i; if (un >= 1024) break;
        const int bh = un >> 4, qb = un & 15, b = bh >> 3, h = bh & 7;
        attn_body::attn_unit<8>((long)b * SEQL + qb * 256, h * 64, (long)b * KVLEN, (h >> 2) * 64, KVLEN / 64, Q, K, V, O, ldsg, F.wave); }
    if (ctx_on) for (int un = F.vcu; un < 64; un += F.G) { const int b = un >> 3, h = un & 7;
        attn_body::attn_unit<8>((long)TL + b * CTXL, h * 64, (long)b * KVLEN + SEQL, (h >> 2) * 64, CTXL / 64, Q, K, V, O, ldsg, F.wave); }
}

typedef float f32x16 __attribute__((ext_vector_type(16)));
typedef unsigned u32x2 __attribute__((ext_vector_type(2)));
constexpr int SCH = 64, NCHK = KVLEN / SCH, NITEM = 128 * NCHK;
constexpr int LSTR = 144;
constexpr int L_AKK = 0, L_AR = 9216, L_AK = 18432, L_AB = 27648, L_TK = 36864, L_TB = 46080, L_TV = 55296, L_TW1 = 64512, L_TU = 73728, L_MLK = 82944, L_MMB = 92160, L_MMK = 101376;
constexpr int L_FLB = 110592, L_GC = 126976, L_TII = 127232, L_FX = L_AK;
static_assert(L_TII + 2048 <= RING_BYTES, "scan LDS map");
__device__ __forceinline__ unsigned short bf1(float x) { return (unsigned short)(pkbf(x, 0.f) & 0xffffu); }
__device__ __forceinline__ bf16x8 ldsv8(const LAS unsigned char* p) { return *(const LAS bf16x8*)p; }
template <bool SWA = false, bool SWB = false>
__device__ __forceinline__ f32x16 tile32(const LAS unsigned char* Ab, const LAS unsigned char* Bb, int mi, int ni, int r, int h, f32x16 acc) {
    const int ra = 32 * mi + r, rb = 32 * ni + r; const int xa = SWA ? ((ra >> 3) & 7) : 0, xb = SWB ? ((rb >> 3) & 7) : 0;
#pragma unroll
    for (int kb = 0; kb < 4; ++kb) { const bf16x8 a = ldsv8(Ab + ra * LSTR + (((2 * kb + h) ^ xa) << 4)), b = ldsv8(Bb + rb * LSTR + (((2 * kb + h) ^ xb) << 4));
        acc = __builtin_amdgcn_mfma_f32_32x32x16_bf16(a, b, acc, 0, 0, 0); }
    return acc;
}
__device__ __forceinline__ int jperm(int j) { return (((j >> 2) & 3) << 4) | (((j >> 5) & 1) << 3) | (((j >> 4) & 1) << 2) | (j & 3); }
#define CROW(reg, h) (((reg) & 3) + 8 * ((reg) >> 2) + 4 * (h))


#if DEBUG_NAN
#define DBG_BF(k, off, nbytes) do { unsigned bad_ = 0; for (int i_ = tid; i_ < (nbytes) / 2; i_ += 512) { const int row_ = i_ / 72, col_ = i_ % 72; if (col_ < 64) { const float v_ = __builtin_bit_cast(float, (unsigned)(*(const LAS unsigned short*)(L + (off) + row_ * LSTR + col_ * 2)) << 16); if (!(fabsf(v_) < 1e30f)) ++bad_; } } if (bad_) atomicAdd((unsigned*)(F.ctl + 16 + (k)), bad_); } while (0)
#define DBG_F32(k, off, n) do { unsigned bad_ = 0; for (int i_ = tid; i_ < (n); i_ += 512) { const float v_ = ((const LAS float*)(L + (off)))[i_]; if (!(fabsf(v_) < 1e30f)) ++bad_; } if (bad_) atomicAdd((unsigned*)(F.ctl + 16 + (k)), bad_); } while (0)
#else
#define DBG_BF(k, off, nbytes) do {} while (0)
#define DBG_F32(k, off, n) do {} while (0)
#endif
#define WG_BAR() do { asm volatile("s_waitcnt lgkmcnt(0)" ::: "memory"); __builtin_amdgcn_s_barrier(); asm volatile("" ::: "memory"); } while (0)
template <int CTRL, int RMASK> __device__ __forceinline__ float dppm(float v) { return __builtin_bit_cast(float, __builtin_amdgcn_update_dpp(0, __builtin_bit_cast(int, v), CTRL, RMASK, 0xf, true)); }
__device__ __forceinline__ float wave_incl_scan(float x) {
    x += dppm<0x111, 0xf>(x); x += dppm<0x112, 0xf>(x); x += dppm<0x114, 0xf>(x); x += dppm<0x118, 0xf>(x);
    x += __builtin_bit_cast(float, __builtin_amdgcn_update_dpp(0, __builtin_bit_cast(int, x), 0x142, 0xa, 0xf, false));
    x += __builtin_bit_cast(float, __builtin_amdgcn_update_dpp(0, __builtin_bit_cast(int, x), 0x143, 0xc, 0xf, false));
    return x;
}
struct S1In { v4u kk, r, k, v, pw, pa; f32x4 ka[2]; };
__device__ __forceinline__ void s1_item(Frame& F, unsigned char* const ws, const int lane, const int wv, const int l, const int item, const S1In& cur, S1In& nxt, const float* w0b, const float* a0b, const float* kab, unsigned long long (&cy)[6]) {
#if CYSEL >= 0
#define CY(k) do { const unsigned long long now_ = __builtin_readcyclecounter(); cy[k] += now_ - cy[5]; cy[5] = now_; } while (0)
#else
#define CY(k) do {} while (0)
#endif
    LAS unsigned char* L = F.lds + RING_OFF;
    const bf16* KKst = (const bf16*)(ws + WS_KK); const bf16* Kst = (const bf16*)(ws + WS_K); const bf16* Rst = (const bf16*)(ws + WS_R); const bf16* Vst = (const bf16*)(ws + WS_V); const bf16* LOUT = (const bf16*)(ws + WS_LOUT);
    bf16* PT = (bf16*)(ws + WS_SPT); bf16* GG = (bf16*)(ws + WS_SG); bf16* QQ = (bf16*)(ws + WS_SQ); float* OSC = (float*)(ws + WS_OSC);
    const int r = lane & 31, h = lane >> 5;
#define S1_ITEM(item_) const int chain = (item_) / NCHK, c = (item_) - chain * NCHK, dir = chain & 1, bh = chain >> 1, b = bh >> 3, hd = bh & 7; const int s0 = c * SCH; const int dsg = dir ? -1 : 1; \
        const int tok0 = (s0 < CTXL) ? (TL + b * CTXL + (dir ? (CTXL - 1 - s0) : s0)) : (b * SEQL + (dir ? (SEQL - 1 - (s0 - CTXL)) : (s0 - CTXL)));
#define S1_TOUCH(D) asm volatile("" :: "v"(D.kk), "v"(D.r), "v"(D.k), "v"(D.v), "v"(D.pw), "v"(D.pa), "v"(D.ka[0]), "v"(D.ka[1]))
#define S1_LOAD(D, item_) do { S1_ITEM(item_) const size_t tokr = (size_t)(tok0 + dsg * (8 * wv + (lane >> 3))); const size_t o5 = tokr * 512 + hd * 64 + 8 * (lane & 7); \
        D.kk = *(const v4u*)(KKst + o5); D.r = *(const v4u*)(Rst + o5); D.k = *(const v4u*)(Kst + o5); D.v = *(const v4u*)(Vst + o5); \
        D.pw = *(const v4u*)(LOUT + tokr * LORA_N + dir * 512 + hd * 64 + 8 * (lane & 7)); D.pa = *(const v4u*)(LOUT + tokr * LORA_N + 1024 + dir * 512 + hd * 64 + 8 * (lane & 7)); \
        { D.ka[0] = *(const f32x4*)(kab + hd * 64 + 8 * (lane & 7)); D.ka[1] = *(const f32x4*)(kab + hd * 64 + 8 * (lane & 7) + 4); } } while (0)
    {
        S1_ITEM(item)
        {   const v4u kk8 = cur.kk, r8 = cur.r, k8 = cur.k, v8 = cur.v, pw8 = cur.pw, pa8 = cur.pa; const int jg = lane & 7, t = 8 * wv + (lane >> 3);
            const float kap[8] = {cur.ka[0][0], cur.ka[0][1], cur.ka[0][2], cur.ka[0][3], cur.ka[1][0], cur.ka[1][1], cur.ka[1][2], cur.ka[1][3]};
            LAS float* tot = (LAS float*)(L + L_TII);
            float lw[8], av[8], lam[8];
#pragma unroll
            for (int e = 0; e < 8; ++e) { const unsigned pw = pw8[e >> 1], pa = pa8[e >> 1]; const float zw = (e & 1) ? bfhi(pw) : bflo(pw), za = (e & 1) ? bfhi(pa) : bflo(pa);
                lw[e] = zw; av[e] = za; lam[e] = lw[e]; }
#pragma unroll
            for (int sh = 8; sh <= 32; sh <<= 1) { float y[8]; const float mk = (lane >= sh) ? 1.0f : 0.0f;
#pragma unroll
                for (int e = 0; e < 8; ++e) y[e] = __shfl_up(lam[e], sh);
#pragma unroll
                for (int e = 0; e < 8; ++e) lam[e] = __builtin_fmaf(mk, y[e], lam[e]); }
            if (lane >= 56) { *(LAS f32x4*)(tot + wv * 64 + 8 * jg) = (f32x4){lam[0], lam[1], lam[2], lam[3]}; *(LAS f32x4*)(tot + wv * 64 + 8 * jg + 4) = (f32x4){lam[4], lam[5], lam[6], lam[7]}; }
            if (item + F.G < NITEM) S1_LOAD(nxt, item + F.G);
            WG_BAR();
            for (int w = 0; w < wv; ++w) { const f32x4 q0 = *(const LAS f32x4*)(tot + w * 64 + 8 * jg), q1 = *(const LAS f32x4*)(tot + w * 64 + 8 * jg + 4);
                lam[0] += q0[0]; lam[1] += q0[1]; lam[2] += q0[2]; lam[3] += q0[3]; lam[4] += q1[0]; lam[5] += q1[1]; lam[6] += q1[2]; lam[7] += q1[3]; }
            v4u wkk, wrr, wkd, wbd; float en8[8];
#pragma unroll
            for (int p = 0; p < 4; ++p) { float okk[2], orr[2], okd[2], obd[2];
#pragma unroll
                for (int u = 0; u < 2; ++u) { const int e = 2 * p + u;
                    const unsigned xkk = kk8[p], xr = r8[p], xk = k8[p];
                    const float kkv = u ? bfhi(xkk) : bflo(xkk), rv = u ? bfhi(xr) : bflo(xr), kv = u ? bfhi(xk) : bflo(xk);
                    const float eNp = __builtin_amdgcn_exp2f(lw[e] - lam[e]), eN = __builtin_amdgcn_exp2f(-lam[e]), eP = __builtin_amdgcn_exp2f(lam[e]);
                    okk[u] = kkv * eNp; orr[u] = rv * eN; okd[u] = kv * __builtin_fmaf(av[e], kap[e], 1.0f - kap[e]) * eP; obd[u] = kkv * av[e] * eP;
                    en8[e] = eN; }
                wkk[p] = pkbf(okk[0], okk[1]); wrr[p] = pkbf(orr[0], orr[1]); wkd[p] = pkbf(okd[0], okd[1]); wbd[p] = pkbf(obd[0], obd[1]); }
            if (t == SCH - 1) { *(LAS f32x4*)((LAS float*)(L + L_GC) + 8 * jg) = (f32x4){en8[0], en8[1], en8[2], en8[3]}; *(LAS f32x4*)((LAS float*)(L + L_GC) + 8 * jg + 4) = (f32x4){en8[4], en8[5], en8[6], en8[7]}; }
            *(LAS v4u*)(L + L_AKK + t * LSTR + jg * 16) = wkk; *(LAS v4u*)(L + L_AR + t * LSTR + jg * 16) = wrr; *(LAS v4u*)(L + L_AK + t * LSTR + jg * 16) = wkd; *(LAS v4u*)(L + L_AB + t * LSTR + jg * 16) = wbd;
#pragma unroll
            for (int e = 0; e < 8; ++e) { const int j = 8 * jg + e; const unsigned wk = wkd[e >> 1], wb = wbd[e >> 1], wvv = v8[e >> 1];
                const int to = j * LSTR + ((wv ^ jg) << 4) + (lane >> 3) * 2;
                *(LAS unsigned short*)(L + L_TK + to) = (unsigned short)((e & 1) ? (wk >> 16) : (wk & 0xffffu));
                *(LAS unsigned short*)(L + L_TB + to) = (unsigned short)((e & 1) ? (wb >> 16) : (wb & 0xffffu));
                *(LAS unsigned short*)(L + L_TV + to) = (unsigned short)((e & 1) ? (wvv >> 16) : (wvv & 0xffffu)); }
        }
        WG_BAR();
        CY(0);
#pragma unroll
        for (int jj = 0; jj < 2; ++jj) {
            const int job = 2 * wv + jj, m = job >> 2, si = (job >> 1) & 1, ti = job & 1;
            f32x16 acc = {};
            if (!(si == 1 && ti == 0)) acc = tile32(L + ((m & 1) ? L_AK : L_AB), L + (m < 2 ? L_AKK : L_AR), si, ti, r, h, acc);
            const int tt = 32 * ti + r;
#pragma unroll
            for (int g = 0; g < 4; ++g) { const int sb = 32 * si + 8 * g + 4 * h; float vv[4];
#pragma unroll
                for (int i = 0; i < 4; ++i) { const int s = sb + i; const bool keep = (m < 2) ? (s < tt) : (s <= tt); vv[i] = keep ? acc[4 * g + i] : 0.f; }
                if (m == 0) *(LAS f32x4*)((LAS float*)(L + L_FLB) + tt * 64 + sb) = (f32x4){vv[0], vv[1], vv[2], vv[3]};
                else *(LAS u32x2*)(L + (m == 1 ? L_MLK : (m == 2 ? L_MMB : L_MMK)) + tt * LSTR + sb * 2) = (u32x2){pkbf(vv[0], vv[1]), pkbf(vv[2], vv[3])}; }
        }
        WG_BAR();
        CY(1);
        f32x16 acc_o1 = {}, ag = {};
        {   const int q4 = wv & 3, mi = q4 >> 1, ni = q4 & 1;
            if (wv < 4) { f32x16 acc = {}; acc = tile32<false, true>(L + L_MLK, L + L_TV, mi, ni, r, h, acc);
#pragma unroll
                for (int reg = 0; reg < 16; ++reg) ((LAS float*)(L + L_FX))[(32 * mi + CROW(reg, h)) * 64 + 32 * ni + r] = acc[reg];
                const int col = lane & 15; const LAS float* lb = (const LAS float*)(L + L_FLB) + (16 * wv) * 64 + 16 * wv; float x[16];
#pragma unroll
                for (int tt = 0; tt < 16; ++tt) { float a = (tt == col) ? 1.0f : 0.0f, a2 = 0.0f;
#pragma unroll
                    for (int s4 = 0; s4 < tt; s4 += 4) { const f32x4 lv = *(const LAS f32x4*)(lb + tt * 64 + s4);
#pragma unroll
                        for (int u = 0; u < 4; ++u) if (s4 + u < tt) { if (u & 1) a2 -= lv[u] * x[s4 + u]; else a -= lv[u] * x[s4 + u]; } }
                    x[tt] = a + a2; }
                if (lane < 16) {
#pragma unroll
                    for (int tt = 0; tt < 16; ++tt) *(LAS unsigned short*)(L + L_TII + wv * 512 + tt * 32 + col * 2) = bf1(x[tt]); }
            } else { acc_o1 = tile32<true, false>(L + L_TV, L + L_MMK, mi, ni, r, h, acc_o1);
                ag = tile32<true, true>(L + L_TK, L + L_TV, mi, ni, r, h, ag); }
        }
        WG_BAR();
        CY(2);
        {   const int cc = lane & 15, q = lane >> 4; const bool isw = wv < 4; const int colb = 16 * (wv & 3) + cc;
            f32x4 U[4], R0[4];
            if (isw) {
#pragma unroll
                for (int i = 0; i < 4; ++i)
#pragma unroll
                    for (int reg = 0; reg < 4; ++reg) { const int tt = 16 * i + 4 * q + reg; R0[i][reg] = __builtin_bit_cast(float, (unsigned)(*(const LAS unsigned short*)(L + L_AKK + tt * LSTR + colb * 2)) << 16); }
            } else {
#pragma unroll
                for (int i = 0; i < 4; ++i)
#pragma unroll
                    for (int reg = 0; reg < 4; ++reg) { const int tt = 16 * i + 4 * q + reg; R0[i][reg] = ((const LAS float*)(L + L_FX))[tt * 64 + colb]; }
            }
#pragma unroll
            for (int i = 0; i < 4; ++i) {
                f32x4 R = R0[i];
#pragma unroll
                for (int kp = 0; kp < 2; ++kp) { if (2 * kp < i) {
                    const int k1 = 2 * kp, k2 = 2 * kp + 1; const bool two = (k2 < i);
                    const LAS float* lrow = (const LAS float*)(L + L_FLB) + (16 * i + cc) * 64;
                    const f32x4 la = *(const LAS f32x4*)(lrow + 16 * k1 + 4 * q); f32x4 lb2 = {0.f, 0.f, 0.f, 0.f}; if (two) lb2 = *(const LAS f32x4*)(lrow + 16 * k2 + 4 * q);
                    const v4u aw = (v4u){pkbf(-la[0], -la[1]), pkbf(-la[2], -la[3]), pkbf(-lb2[0], -lb2[1]), pkbf(-lb2[2], -lb2[3])};
                    const f32x4 u1 = U[k1]; f32x4 u2 = {0.f, 0.f, 0.f, 0.f}; if (two) u2 = U[k2];
                    const v4u bh_ = (v4u){pkbf(u1[0], u1[1]), pkbf(u1[2], u1[3]), pkbf(u2[0], u2[1]), pkbf(u2[2], u2[3])};
                    R = __builtin_amdgcn_mfma_f32_16x16x32_bf16(__builtin_bit_cast(bf16x8, aw), __builtin_bit_cast(bf16x8, bh_), R, 0, 0, 0); } }
                const u32x2 tw = *(const LAS u32x2*)(L + L_TII + i * 512 + cc * 32 + q * 8);
                const v4u ta = (v4u){tw.x, tw.y, 0u, 0u};
                const v4u rh = (v4u){pkbf(R[0], R[1]), pkbf(R[2], R[3]), 0u, 0u};
                f32x4 u = {0.f, 0.f, 0.f, 0.f};
                u = __builtin_amdgcn_mfma_f32_16x16x32_bf16(__builtin_bit_cast(bf16x8, ta), __builtin_bit_cast(bf16x8, rh), u, 0, 0, 0);
                U[i] = u;
                *(LAS u32x2*)(L + (isw ? L_TW1 : L_TU) + colb * LSTR + (16 * i + 4 * q) * 2) = (u32x2){pkbf(u[0], u[1]), pkbf(u[2], u[3])};
            }
        }
        WG_BAR();
        CY(3);
        S1_TOUCH(nxt);
        {   const int q4 = wv & 3, mi = q4 >> 1, ni = q4 & 1; const LAS float* gc = (const LAS float*)(L + L_GC);
            if (wv < 4) {
                f32x16 acc = {}; acc = tile32<false, true>(L + L_TW1, L + L_TB, mi, ni, r, h, acc);
                const int jp = 32 * ni + r; const float gj = gc[jp]; bf16* pt = PT + (size_t)item * 4096 + (size_t)jp * 64;
#pragma unroll
                for (int gp2 = 0; gp2 < 2; ++gp2) { unsigned pw[4];
#pragma unroll
                    for (int u = 0; u < 2; ++u) { const int g = gp2 + 2 * u, j0 = 32 * mi + 8 * g + 4 * h; float pv[4];
#pragma unroll
                        for (int i = 0; i < 4; ++i) pv[i] = (((j0 + i) == jp ? 1.0f : 0.0f) - acc[4 * g + i]) * gj;
                        pw[2 * u] = pkbf(pv[0], pv[1]); pw[2 * u + 1] = pkbf(pv[2], pv[3]); }
                    *(v4u*)(pt + 16 * (2 * gp2 + h) + 8 * mi) = (v4u){pw[0], pw[1], pw[2], pw[3]}; }
                f32x16 acq = {}; acq = tile32(L + L_TW1, L + L_MMB, mi, ni, r, h, acq);
                const int tt = 32 * ni + r; bf16* qq = QQ + (size_t)item * 4096 + (size_t)tt * 64;
#pragma unroll
                for (int gp2 = 0; gp2 < 2; ++gp2) { unsigned qw[4];
#pragma unroll
                    for (int u = 0; u < 2; ++u) { const int g = gp2 + 2 * u, j0 = 32 * mi + 8 * g + 4 * h; const u32x2 rw = *(const LAS u32x2*)(L + L_AR + tt * LSTR + j0 * 2);
                        qw[2 * u] = pkbf(bflo(rw.x) - acq[4 * g], bfhi(rw.x) - acq[4 * g + 1]); qw[2 * u + 1] = pkbf(bflo(rw.y) - acq[4 * g + 2], bfhi(rw.y) - acq[4 * g + 3]); }
                    *(v4u*)(qq + 16 * (2 * gp2 + h) + 8 * mi) = (v4u){qw[0], qw[1], qw[2], qw[3]}; }
            } else {
                f32x16 acc = {}; acc = tile32(L + L_TU, L + L_MMB, mi, ni, r, h, acc);
                const int tt = 32 * ni + r; bf16* op = (bf16*)OSC + ((size_t)dir * TT + (size_t)(tok0 + dsg * tt)) * 512 + hd * 64;
#pragma unroll
                for (int gp2 = 0; gp2 < 2; ++gp2) { unsigned ow_[4];
#pragma unroll
                    for (int u = 0; u < 2; ++u) { const int g = gp2 + 2 * u; ow_[2 * u] = pkbf(acc_o1[4 * g] - acc[4 * g], acc_o1[4 * g + 1] - acc[4 * g + 1]); ow_[2 * u + 1] = pkbf(acc_o1[4 * g + 2] - acc[4 * g + 2], acc_o1[4 * g + 3] - acc[4 * g + 3]); }
                    *(v4u*)(op + 16 * (2 * gp2 + h) + 8 * mi) = (v4u){ow_[0], ow_[1], ow_[2], ow_[3]}; }
                f32x16 ah = {}; ah = tile32<true, false>(L + L_TB, L + L_TU, mi, ni, r, h, ah);
                const int v = 32 * ni + r; bf16* gp = GG + (size_t)item * 4096 + (size_t)v * 64;
#pragma unroll
                for (int gp2 = 0; gp2 < 2; ++gp2) { unsigned gw_[4];
#pragma unroll
                    for (int u = 0; u < 2; ++u) { const int g = gp2 + 2 * u, j0 = 32 * mi + 8 * g + 4 * h; const f32x4 gj = *(const LAS f32x4*)(gc + j0); float gv[4];
#pragma unroll
                        for (int i = 0; i < 4; ++i) gv[i] = (ag[4 * g + i] - ah[4 * g + i]) * gj[i];
                        gw_[2 * u] = pkbf(gv[0], gv[1]); gw_[2 * u + 1] = pkbf(gv[2], gv[3]); }
                    *(v4u*)(gp + 16 * (2 * gp2 + h) + 8 * mi) = (v4u){gw_[0], gw_[1], gw_[2], gw_[3]}; }
            }
        }
        WG_BAR();
        CY(4);
    }
#undef CY
}
__device__ __forceinline__ void p_scan1(Frame& F, const Args& A, int l) {
    unsigned char* const ws = launder(F.ws);
    const int tid = (F.wave * 64 + hw_lane()), lane = tid & 63, wv = F.wave;
    const bf16* KKst = (const bf16*)(ws + WS_KK); const bf16* Kst = (const bf16*)(ws + WS_K); const bf16* Rst = (const bf16*)(ws + WS_R); const bf16* Vst = (const bf16*)(ws + WS_V); const bf16* LOUT = (const bf16*)(ws + WS_LOUT);
    const float* w0b = INP(IN_W0) + l * 1024; const float* a0b = INP(IN_A0) + l * 1024; const float* kab = INP(IN_KA) + l * 512;
    S1In sa = {}, sb = {}; unsigned long long cy[6] = {0, 0, 0, 0, 0, 0};
#if CYSEL >= 0
    cy[5] = __builtin_readcyclecounter();
#endif
    if ((int)blockIdx.x < NITEM) S1_LOAD(sa, (int)blockIdx.x);
    S1_TOUCH(sa);
    for (int item = blockIdx.x; item < NITEM; item += 2 * F.G) {
        s1_item(F, ws, lane, wv, l, item, sa, sb, w0b, a0b, kab, cy);
        if (item + F.G < NITEM) s1_item(F, ws, lane, wv, l, item + F.G, sb, sa, w0b, a0b, kab, cy);
    }
#if CYSEL >= 0
    if (blockIdx.x == 0 && F.wave == 0 && hw_lane() == 0) { unsigned long long* cs_ = (unsigned long long*)(F.ws + WS_CTL + 40960); for (int k = 0; k < 5; ++k) cs_[k] += cy[k]; }
#endif
}
#undef S1_ITEM
#undef S1_LOAD
#undef S1_TOUCH

struct S2Ops { v4u pa[4][2]; v4u gt[2]; };
__device__ __forceinline__ void s2_load(S2Ops& o, const bf16* PT, const bf16* GG, int chain, int c, int cc, int q, int v) {
    const size_t ib = ((size_t)chain * NCHK + c) * 4096;
#pragma unroll
    for (int J = 0; J < 4; ++J) { const bf16* prow = PT + ib + (size_t)(16 * J + cc) * 64;
#pragma unroll
        for (int kb = 0; kb < 2; ++kb) o.pa[J][kb] = *(const v4u*)(prow + 16 * q + 8 * kb); }
#pragma unroll
    for (int kb = 0; kb < 2; ++kb) o.gt[kb] = *(const v4u*)(GG + ib + (size_t)v * 64 + 16 * q + 8 * kb);
}
__device__ __forceinline__ void s2_step(f32x4 (&St)[4], const S2Ops& o, bf16* S0, int chain, int c, int q, int v) {
    const size_t ib = ((size_t)chain * NCHK + c) * 4096;
    v4u bh_[2], bl_[2];
#pragma unroll
    for (int kb = 0; kb < 2; ++kb) { const f32x4 u1 = St[2 * kb], u2 = St[2 * kb + 1];
        bh_[kb] = (v4u){pkbf(u1[0], u1[1]), pkbf(u1[2], u1[3]), pkbf(u2[0], u2[1]), pkbf(u2[2], u2[3])};
        bl_[kb] = (v4u){pkbf(u1[0] - bflo(bh_[kb].x), u1[1] - bfhi(bh_[kb].x)), pkbf(u1[2] - bflo(bh_[kb].y), u1[3] - bfhi(bh_[kb].y)), pkbf(u2[0] - bflo(bh_[kb].z), u2[1] - bfhi(bh_[kb].z)), pkbf(u2[2] - bflo(bh_[kb].w), u2[3] - bfhi(bh_[kb].w))};
        *(v4u*)(S0 + ib + (size_t)v * 64 + 16 * q + 8 * kb) = bh_[kb]; }
#pragma unroll
    for (int J = 0; J < 4; ++J) { const unsigned g0 = (J & 1) ? o.gt[J >> 1].z : o.gt[J >> 1].x, g1 = (J & 1) ? o.gt[J >> 1].w : o.gt[J >> 1].y; f32x4 acc = (f32x4){bflo(g0), bfhi(g0), bflo(g1), bfhi(g1)};
#pragma unroll
        for (int kb = 0; kb < 2; ++kb) { const v4u aw = o.pa[J][kb];
            acc = __builtin_amdgcn_mfma_f32_16x16x32_bf16(__builtin_bit_cast(bf16x8, aw), __builtin_bit_cast(bf16x8, bh_[kb]), acc, 0, 0, 0);
            acc = __builtin_amdgcn_mfma_f32_16x16x32_bf16(__builtin_bit_cast(bf16x8, aw), __builtin_bit_cast(bf16x8, bl_[kb]), acc, 0, 0, 0); }
        St[J] = acc; }
}
__device__ __forceinline__ void p_scan2(Frame& F) {
    unsigned char* const ws = launder(F.ws);
    const int tid = (F.wave * 64 + hw_lane()), lane = tid & 63;
    const bf16* PT = (const bf16*)(ws + WS_SPT); const bf16* GG = (const bf16*)(ws + WS_SG); bf16* S0 = (bf16*)F.out;
    const int cc = lane & 15, q = lane >> 4;
    static_assert(NCHK % 4 == 0, "stage 2 ring depth");
    for (int wi = F.wave * F.G + (int)blockIdx.x; wi < 512; wi += NWAVES * F.G) {
        const int chain = wi >> 2, vg = wi & 3; const int v = 16 * vg + cc;
        f32x4 St[4];
#pragma unroll
        for (int J = 0; J < 4; ++J) St[J] = (f32x4){0.f, 0.f, 0.f, 0.f};
        S2Ops o0, o1, o2, o3;
        s2_load(o0, PT, GG, chain, 0, cc, q, v); s2_load(o1, PT, GG, chain, 1, cc, q, v); s2_load(o2, PT, GG, chain, 2, cc, q, v);
        for (int c = 0; c < NCHK; c += 4) {
            s2_load(o3, PT, GG, chain, c + 3, cc, q, v);                 s2_step(St, o0, S0, chain, c, q, v);
            if (c + 4 < NCHK) s2_load(o0, PT, GG, chain, c + 4, cc, q, v); s2_step(St, o1, S0, chain, c + 1, q, v);
            if (c + 5 < NCHK) s2_load(o1, PT, GG, chain, c + 5, cc, q, v); s2_step(St, o2, S0, chain, c + 2, q, v);
            if (c + 6 < NCHK) s2_load(o2, PT, GG, chain, c + 6, cc, q, v); s2_step(St, o3, S0, chain, c + 3, q, v);
        }
    }
}

__device__ __forceinline__ void p_scan3(Frame& F) {
    unsigned char* const ws = launder(F.ws);
    const int tid = (F.wave * 64 + hw_lane()), lane = tid & 63;
    const bf16* QQ = (const bf16*)(ws + WS_SQ); const bf16* S0 = (const bf16*)F.out; float* OSC = (float*)(ws + WS_OSC);
    const int gw = F.vcu * NWAVES + F.wave, NGW = F.G * NWAVES; const int r = lane & 31, h = lane >> 5;
    bf16x8 sa[4], qb[4], sa2[4], qb2[4]; f32x4 ov[4], ov2[4]; float* op = nullptr; float* op2 = nullptr;
#define S3_LOAD(SA, QB, OV, OP, job_) do { const int item = (job_) >> 2, mi = ((job_) >> 1) & 1, ni = (job_) & 1; \
        const int chain = item / NCHK, c = item - chain * NCHK, dir = chain & 1, bh = chain >> 1, b = bh >> 3, hd = bh & 7; const int s0 = c * SCH + 32 * ni + r; \
        const int tok = (s0 < CTXL) ? (TL + b * CTXL + (dir ? (CTXL - 1 - s0) : s0)) : (b * SEQL + (dir ? (SEQL - 1 - (s0 - CTXL)) : (s0 - CTXL))); \
        const bf16* sp = S0 + (size_t)item * 4096 + (size_t)(32 * mi + r) * 64 + 8 * h; const bf16* qp = QQ + (size_t)item * 4096 + (size_t)(32 * ni + r) * 64 + 8 * h; \
        _Pragma("unroll") for (int kb = 0; kb < 4; ++kb) { SA[kb] = *(const bf16x8*)(sp + 16 * kb); QB[kb] = *(const bf16x8*)(qp + 16 * kb); } \
        OP = OSC + ((size_t)dir * TT + (size_t)tok) * 512 + hd * 64 + 32 * mi + 4 * h; \
        _Pragma("unroll") for (int g = 0; g < 4; ++g) OV[g] = *(const f32x4*)(OP + 8 * g); } while (0)
    int job = gw;
    if (job < NITEM * 4) S3_LOAD(sa, qb, ov, op, job);
    for (; job < NITEM * 4; job += NGW) {
        const int nj = job + NGW;
        if (nj < NITEM * 4) S3_LOAD(sa2, qb2, ov2, op2, nj);
        f32x16 acc = {};
#pragma unroll
        for (int kb = 0; kb < 4; ++kb) acc = __builtin_amdgcn_mfma_f32_32x32x16_bf16(sa[kb], qb[kb], acc, 0, 0, 0);
#pragma unroll
        for (int g = 0; g < 4; ++g) *(f32x4*)(op + 8 * g) = ov[g] + (f32x4){acc[4 * g], acc[4 * g + 1], acc[4 * g + 2], acc[4 * g + 3]};
#pragma unroll
        for (int kb = 0; kb < 4; ++kb) { sa[kb] = sa2[kb]; qb[kb] = qb2[kb]; ov[kb] = ov2[kb]; }
        op = op2;
    }
#undef S3_LOAD
}


__device__ __forceinline__ void s3_fetch(v4u (&d)[4], const bf16* base, size_t pitch, int lane) {
#pragma unroll
    for (int i = 0; i < 4; ++i) d[i] = *(const v4u*)(base + (size_t)((lane >> 3) + 8 * i) * pitch + (lane & 7) * 8);
}
template <bool PERMUTED = false>
__device__ __forceinline__ void s3_relayout(uint2 (&o)[8], const v4u (&d)[4], LAS unsigned char* stg, int lane) {
    const int r = lane & 31, h = lane >> 5;
#pragma unroll
    for (int i = 0; i < 4; ++i) *(LAS v4u*)(stg + ((lane >> 3) + 8 * i) * LSTR + (lane & 7) * 16) = d[i];
#pragma unroll
    for (int mi = 0; mi < 2; ++mi)
#pragma unroll
        for (int g = 0; g < 4; ++g) { const int c0 = 32 * mi + 8 * g + 4 * h; const u32x2 w = *(const LAS u32x2*)(stg + r * LSTR + (PERMUTED ? jperm(c0) : c0) * 2); o[mi * 4 + g] = make_uint2(w.x, w.y); }
}
__device__ __forceinline__ void p_scan3r(Frame& F, const Args& A, int l) {
    unsigned char* const ws = launder(F.ws);
    const int tid = (F.wave * 64 + hw_lane()), lane = tid & 63;
    const bf16* QQ = (const bf16*)(ws + WS_SQ); const bf16* S0 = (const bf16*)F.out; const bf16* OSC = (const bf16*)(ws + WS_OSC);
    const bf16* Rst = (const bf16*)(ws + WS_R); const bf16* Vst = (const bf16*)(ws + WS_V); const bf16* Kst = (const bf16*)(ws + WS_K); const bf16* LOUT = (const bf16*)(ws + WS_LOUT);
    bf16* QO = (bf16*)(ws + WS_QO);
    LAS unsigned char* stg = F.lds + RING_OFF + F.wave * 4608;
    const int gw = F.vcu * NWAVES + F.wave, NGW = F.G * NWAVES; const int r = lane & 31, h = lane >> 5;
    const float* rkp = INP(IN_RK) + l * 512; const float* gnwp = INP(IN_GNW) + l * 512; const float* gnbp = INP(IN_GNB) + l * 512; const float* kap = INP(IN_KA) + l * 512; const float* a0p = INP(IN_A0) + l * 1024;
    for (int unit = gw; unit < 64 * (KVLEN / 32); unit += NGW) {
        const int bh = unit / (KVLEN / 32), pb = unit - bh * (KVLEN / 32), b = bh >> 3, hd = bh & 7, p0 = pb * 32;
        const size_t tokb = (p0 < CTXL) ? (size_t)(TL + b * CTXL + p0) : (size_t)(b * SEQL + (p0 - CTXL)); const size_t tok = tokb + r;
        const int sb0 = (p0 < CTXL) ? (CTXL - 1 - p0) : (KVLEN + CTXL - 1 - p0);
        const int itf = (bh * 2) * NCHK + (p0 >> 6), itb = (bh * 2 + 1) * NCHK + (sb0 >> 6); const int tf = (p0 & 63) + r, tb = (sb0 & 63) - r;
        v4u ga[4], gb[4];
        s3_fetch(ga, OSC + tokb * 512 + hd * 64, 512, lane); s3_fetch(gb, OSC + ((size_t)TT + tokb) * 512 + hd * 64, 512, lane);
        f32x4 o[2][4];
        {   f32x16 acc[2][2];
#pragma unroll
            for (int d = 0; d < 2; ++d) { const size_t ib = (size_t)(d ? itb : itf) * 4096; const bf16* qp = QQ + ib + (size_t)(d ? tb : tf) * 64 + 8 * h;
                bf16x8 qf[4];
#pragma unroll
                for (int kb = 0; kb < 4; ++kb) qf[kb] = *(const bf16x8*)(qp + 16 * kb);
#pragma unroll
                for (int mi = 0; mi < 2; ++mi) { const bf16* sp = S0 + ib + (size_t)(32 * mi + r) * 64 + 8 * h; f32x16 a = {};
#pragma unroll
                    for (int kb = 0; kb < 4; ++kb) a = __builtin_amdgcn_mfma_f32_32x32x16_bf16(*(const bf16x8*)(sp + 16 * kb), qf[kb], a, 0, 0, 0);
                    acc[d][mi] = a; } }
#pragma unroll
            for (int mi = 0; mi < 2; ++mi)
#pragma unroll
                for (int g = 0; g < 4; ++g)
#pragma unroll
                    for (int i = 0; i < 4; ++i) o[mi][g][i] = acc[0][mi][4 * g + i] + acc[1][mi][4 * g + i]; }
        uint2 ta[8], tb8[8];
        s3_relayout<true>(ta, ga, stg, lane); s3_fetch(ga, Rst + tokb * 512 + hd * 64, 512, lane);
        s3_relayout<true>(tb8, gb, stg, lane); s3_fetch(gb, Kst + tokb * 512 + hd * 64, 512, lane);
        float s1 = 0.f;
#pragma unroll
        for (int mi = 0; mi < 2; ++mi)
#pragma unroll
            for (int g = 0; g < 4; ++g) { const uint2 of = ta[mi * 4 + g], ob = tb8[mi * 4 + g]; f32x4 v = o[mi][g];
                v[0] += bflo(of.x) + bflo(ob.x); v[1] += bfhi(of.x) + bfhi(ob.x); v[2] += bflo(of.y) + bflo(ob.y); v[3] += bfhi(of.y) + bfhi(ob.y);
                o[mi][g] = v; s1 += (v[0] + v[1]) + (v[2] + v[3]); }
        s1 += __shfl_xor(s1, 32); const float mean = s1 * (1.0f / 64.0f);
        const int cb = hd * 64 + 4 * h;
        float s2 = 0.f, bs = 0.f;
        f32x4 rkv[8], sa[8];
        {   uint2 rr8[8], kk8[8];
            s3_relayout(rr8, ga, stg, lane); s3_fetch(ga, LOUT + tokb * LORA_N + 1024 + hd * 64, LORA_N, lane);
            s3_relayout(kk8, gb, stg, lane); s3_fetch(gb, LOUT + tokb * LORA_N + 1536 + hd * 64, LORA_N, lane);
#pragma unroll
            for (int q = 0; q < 8; ++q) { const int cl = cb + 32 * (q >> 2) + 8 * (q & 3); const f32x4 rk4 = *(const f32x4*)(rkp + cl);
                f32x4 d = o[q >> 2][q & 3] - mean; o[q >> 2][q & 3] = d; s2 += (d[0] * d[0] + d[1] * d[1]) + (d[2] * d[2] + d[3] * d[3]);
                rkv[q] = (f32x4){bflo(rr8[q].x) * bflo(kk8[q].x) * rk4[0], bfhi(rr8[q].x) * bfhi(kk8[q].x) * rk4[1], bflo(rr8[q].y) * bflo(kk8[q].y) * rk4[2], bfhi(rr8[q].y) * bfhi(kk8[q].y) * rk4[3]}; } }
        {   uint2 pa8[8];
            s3_relayout(pa8, ga, stg, lane); s3_fetch(ga, Vst + tokb * 512 + hd * 64, 512, lane);
#pragma unroll
            for (int q = 0; q < 8; ++q) sa[q] = (f32x4){bflo(pa8[q].x), bfhi(pa8[q].x), bflo(pa8[q].y), bfhi(pa8[q].y)}; }
        {   uint2 pb8[8];
            s3_relayout(pb8, gb, stg, lane); s3_fetch(gb, LOUT + tokb * LORA_N + 2048 + hd * 64, LORA_N, lane);
#pragma unroll
            for (int q = 0; q < 8; ++q) { const int cl = cb + 32 * (q >> 2) + 8 * (q & 3); const f32x4 ka4 = *(const f32x4*)(kap + cl);
                const float pq[4] = {bflo(pb8[q].x), bfhi(pb8[q].x), bflo(pb8[q].y), bfhi(pb8[q].y)};
#pragma unroll
                for (int i = 0; i < 4; ++i) bs += rkv[q][i] * (2.0f + (sa[q][i] + pq[i] - 2.0f) * ka4[i]); } }
        s2 += __shfl_xor(s2, 32); bs += __shfl_xor(bs, 32);
        const float rs = 1.0f / sqrtf(s2 * (1.0f / 64.0f) + GN_EPS);
        uint2 vv8[8], gg8[8];
        s3_relayout(vv8, ga, stg, lane); s3_relayout(gg8, gb, stg, lane);
#pragma unroll
        for (int mi = 0; mi < 2; ++mi)
#pragma unroll
            for (int g = 0; g < 4; ++g) { const int cl = cb + 32 * mi + 8 * g; const int q = mi * 4 + g;
                const uint2 vw = vv8[q], gwd = gg8[q];
                const f32x4 w4 = *(const f32x4*)(gnwp + cl), b4 = *(const f32x4*)(gnbp + cl); const f32x4 d = o[mi][g];
                const float y0 = (d[0] * rs * w4[0] + b4[0] + bs * bflo(vw.x)) * bflo(gwd.x), y1 = (d[1] * rs * w4[1] + b4[1] + bs * bfhi(vw.x)) * bfhi(gwd.x);
                const float y2 = (d[2] * rs * w4[2] + b4[2] + bs * bflo(vw.y)) * bflo(gwd.y), y3 = (d[3] * rs * w4[3] + b4[3] + bs * bfhi(vw.y)) * bfhi(gwd.y);
                *(LAS u32x2*)(stg + r * LSTR + (32 * mi + 8 * g + 4 * h) * 2) = (u32x2){pkbf(y0, y1), pkbf(y2, y3)}; }
#pragma unroll
        for (int i = 0; i < 4; ++i) { const int row = (lane >> 3) + 8 * i; const v4u val = *(const LAS v4u*)(stg + row * LSTR + (lane & 7) * 16);
            *(v4u*)(QO + (tokb + row) * 1024 + 512 + hd * 64 + (lane & 7) * 8) = val; }
    }
}

#if DEBUG_NAN
__device__ __forceinline__ void dbg_count(Frame& F) {
    unsigned char* const ws = launder(F.ws);
    const size_t gt = (size_t)blockIdx.x * 512 + threadIdx.x, NT = (size_t)F.G * 512;
    const unsigned short* arr[4] = {(const unsigned short*)(ws + WS_SPT), (const unsigned short*)(ws + WS_SG), (const unsigned short*)(ws + WS_SQ), (const unsigned short*)F.out};
#pragma unroll
    for (int a = 0; a < 4; ++a) { unsigned bad = 0; for (size_t i = gt; i < (size_t)NITEM * 4096; i += NT) { const float v = __builtin_bit_cast(float, (unsigned)arr[a][i] << 16); if (!(fabsf(v) < 1e30f)) ++bad; }
        if (bad) atomicAdd((unsigned*)(F.ctl + 8 + a), bad); }
    { const float* o = (const float*)(ws + WS_OSC); unsigned bad = 0; for (size_t i = gt; i < (size_t)2 * TT * 512; i += NT) { if (!(fabsf(o[i]) < 1e30f)) ++bad; } if (bad) atomicAdd((unsigned*)(F.ctl + 12), bad); }
}
#endif
template <int l> __device__ __forceinline__ void layer_body(Frame& F, const Args& args, const XcdBarrier& bar, unsigned char* lds) {
#define GRID_BAR() xcd_barrier(bar)

        constexpr bool last = (l == DEPTH - 1), moe = (l & 1) != 0;

#ifndef SKIP_WPREP
        p_wprep(F, args, l, 0);
#endif


#ifndef SKIP_NORM1
        {   if (l == 0) p_norm<false, false, true>(F, args, l, 0, INP(IN_X), INP(IN_CTX), 0);
            else if (l & 1) p_norm<false, false, false, true>(F, args, l, 0, nullptr, nullptr, 0);
            else p_norm<false, true, false>(F, args, l, 0, nullptr, nullptr, l - 1); }
#endif

        GRID_BAR(); TS(1);
        {   unsigned char* const ws = launder(F.ws); bf16* const XB = (bf16*)(ws + WS_XB); const float* const MOD = (const float*)(ws + WS_MOD); bf16* const H = (bf16*)F.out; (void)XB; (void)MOD; (void)H;
            pg8::Gemm g{H, (const bf16*)(ws + WS_WIN), TT, INWP, 1024, 0}; pg8::Sched S; S.init(TT / 256, INWP / 256, F.G, (int)blockIdx.x, nullptr);
            pg8::EpiBf16 E{(bf16*)(ws + WS_P), INWP};
#ifndef SKIP_G_IN
            pg8::gemm_phase<pg8::EpiBf16, pg8::Sched, true, true>(F.lds + RING_OFF, g, S, E, F.wave);
#endif
            }
        GRID_BAR(); TS(2);

#ifndef SKIP_PREP
        p_prep(F, args, l);
#endif
#if PROBE == 2
        p_prep(F, args, l);
#endif

        GRID_BAR(); TS(3);
        {   unsigned char* const ws = launder(F.ws); bf16* const XB = (bf16*)(ws + WS_XB); const float* const MOD = (const float*)(ws + WS_MOD); bf16* const H = (bf16*)F.out; (void)XB; (void)MOD; (void)H;
            pg8::Gemm g{(const bf16*)(ws + WS_LIN), (const bf16*)(ws + WS_WLORA), TT, LORA_N, 128, LORA_K}; pg8::Sched S; S.init(TT / 256, LORA_N / 256, F.G, (int)blockIdx.x, nullptr); S.lora = 1;
            pg8::EpiLoraAct E{(bf16*)(ws + WS_LOUT), LORA_N, INP(IN_W0) + l * 1024, INP(IN_A0) + l * 1024};
#ifndef SKIP_G_LORA
            pg8::gemm_phase<pg8::EpiLoraAct, pg8::Sched, true, true>(F.lds + RING_OFF, g, S, E, F.wave);
#endif
            }

#ifndef SKIP_ATTN
        p_attn(F, (char*)lds + RING_OFF, !last);
#endif

        GRID_BAR(); TS(4);

#if USE_SEQ_SCAN
        p_scan(F, args, l);
#else
        p_scan1(F, args, l);
#if PROBE == 5
        p_scan1(F, args, l);
#endif
        GRID_BAR(); TS(5);
        p_scan2(F);
#if PROBE == 6
        p_scan2(F);
#endif
        GRID_BAR(); TS(6);
        p_scan3r(F, args, l);
#endif
#if USE_SEQ_SCAN
        GRID_BAR(); TS(15);
        p_readout(F, args, l);
#endif
        GRID_BAR(); TS(7);
        {   unsigned char* const ws = launder(F.ws); bf16* const XB = (bf16*)(ws + WS_XB); const float* const MOD = (const float*)(ws + WS_MOD); bf16* const H = (bf16*)F.out; (void)XB; (void)MOD; (void)H;
            pg8::Gemm g{(const bf16*)(ws + WS_QO), (const bf16*)(ws + WS_WOUT), TT, 1024, 1024, 0, 0}; pg8::SchedSK S; S.init(TL / 256, !last, 1024 / 64, F.G, (int)blockIdx.x);
            pg8::EpiResidB<l == 0> E{INP(IN_X), INP(IN_CTX), XB, MOD + (size_t)l * 9 * 6144 + 2 * 1024, (bf16*)(ws + WS_SIDE), 1.0f};
#ifndef SKIP_G_OUT
            pg8::gemm_phase<pg8::EpiResidB<l == 0>, pg8::SchedSK, true, true>(F.lds + RING_OFF, g, S, E, F.wave);
#endif
            }
        GRID_BAR(); TS(8);
        p_wprep(F, args, l, 1);
#if PROBE == 7
        p_wprep(F, args, l, 1);
#endif
        if (!moe) {
            p_norm<false, false, false, true>(F, args, l, 1, nullptr, nullptr, 0);
#if PROBE == 4
            p_norm<false, false, false, false>(F, args, l, 1, nullptr, nullptr, 0);
#endif
            GRID_BAR(); TS(9);
            {   unsigned char* const ws = launder(F.ws); bf16* const XB = (bf16*)(ws + WS_XB); const float* const MOD = (const float*)(ws + WS_MOD); bf16* const H = (bf16*)F.out; (void)XB; (void)MOD; (void)H;
            pg8::Gemm g{H, (const bf16*)(ws + WS_WFF), TT, 2 * FFD, 1024, 0}; pg8::Sched S; S.init(TT / 256, 2 * FFD / 256, F.G, (int)blockIdx.x, nullptr);
                pg8::EpiSwiGLU E{(bf16*)(ws + WS_HID), FFD, 1.0f};
#ifndef SKIP_G_UP
                pg8::gemm_phase<pg8::EpiSwiGLU, pg8::Sched, true, true>(F.lds + RING_OFF, g, S, E, F.wave);
#endif
            }
            GRID_BAR(); TS(10);
            {   unsigned char* const ws = launder(F.ws); bf16* const XB = (bf16*)(ws + WS_XB); const float* const MOD = (const float*)(ws + WS_MOD); bf16* const H = (bf16*)F.out; (void)XB; (void)MOD; (void)H;
            pg8::Gemm g{(const bf16*)(ws + WS_HID), (const bf16*)(ws + WS_WFF_D_DENSE), TT, 1024, FFD, 0, 0}; pg8::SchedSK S; S.init(TL / 256, true, FFD / 64, F.G, (int)blockIdx.x);
                pg8::EpiResidB<false> E{nullptr, nullptr, XB, MOD + (size_t)l * 9 * 6144 + 5 * 1024, (bf16*)(ws + WS_SIDE), 1.0f};
#ifndef SKIP_G_DOWN
                pg8::gemm_phase<pg8::EpiResidB<false>, pg8::SchedSK, true, true>(F.lds + RING_OFF, g, S, E, F.wave);
#endif
            }
            GRID_BAR(); TS(11);
        } else {
            p_norm<true, false, false, !last>(F, args, l, 1, nullptr, nullptr, 0, last ? TL : TT);
#if PROBE == 4
            p_norm<true, false, false, false>(F, args, l, 1, nullptr, nullptr, 0, last ? TL : TT);
#endif
            GRID_BAR(); TS(9);

#ifndef SKIP_ROUTE
            p_route(F, last ? TL : TT);
#endif

            GRID_BAR(); TS(12);
            const int npanels = *(LAS int*)(F.lds + LT_NPAN);
            {   unsigned char* const ws = launder(F.ws); bf16* const XB = (bf16*)(ws + WS_XB); const float* const MOD = (const float*)(ws + WS_MOD); bf16* const H = (bf16*)F.out; (void)XB; (void)MOD; (void)H;
            pg8::Gemm g{(const bf16*)(ws + WS_AG8), (const bf16*)(ws + WS_WFF), npanels * 256, 2 * FFE, 512, 0}; pg8::Sched S; S.init(npanels, 2 * FFE / 256, F.G, (int)blockIdx.x, (const LAS int*)(F.lds + LT_PEXP));
                pg8::EpiSwiGLU8 E{ws + WS_HIDM, FFE, 1.0f / (H8SCALE * W8SCALE), HID8SCALE};
#ifndef SKIP_G_MUP
                pg8::gemm_phase<pg8::EpiSwiGLU8, pg8::Sched, true, true, true>(F.lds + RING_OFF, g, S, E, F.wave);
#endif
            }
            GRID_BAR(); TS(13);
            {   unsigned char* const ws = launder(F.ws); bf16* const XB = (bf16*)(ws + WS_XB); const float* const MOD = (const float*)(ws + WS_MOD); bf16* const H = (bf16*)F.out; (void)XB; (void)MOD; (void)H;
            pg8::Gemm g{(const bf16*)(ws + WS_HIDM), (const bf16*)(ws + WS_WFF_D_MOE8), npanels * 256, 1024, FFE / 2, 0}; pg8::Sched S; S.init(npanels, 4, F.G, (int)blockIdx.x, (const LAS int*)(F.lds + LT_PEXP));
                pg8::EpiBf16S E{(bf16*)(ws + WS_AG), 1024, 1.0f / (HID8SCALE * W8SCALE)};
#ifndef SKIP_G_MDOWN
                pg8::gemm_phase<pg8::EpiBf16S, pg8::Sched, true, true, true>(F.lds + RING_OFF, g, S, E, F.wave);
#endif
            }
            GRID_BAR(); TS(14);
        }

#undef GRID_BAR
}
__global__ void __launch_bounds__(NWAVES * 64, 2) mk_fwd(Args args) {
    extern __shared__ __attribute__((aligned(16))) unsigned char lds[];
    Frame F;
    F.lds = (LAS unsigned char*)lds;
    F.MISC = (volatile LAS unsigned*)(F.lds + MISC_OFF);
    F.tid = threadIdx.x; F.lane = F.tid & 63; F.wave = __builtin_amdgcn_readfirstlane(F.tid >> 6);
    F.G = gridDim.x; { const int bx = blockIdx.x; F.vcu = (F.G % 8 == 0) ? (bx % 8) * (F.G / 8) + bx / 8 : bx; }
    F.ws = args.ws; F.ctl = (gu32*)(args.ws + WS_CTL); F.out = args.out;
    for (int u = F.tid; u < 64; u += NWAVES * 64) ((LAS unsigned*)(F.lds + LDSCTL_OFF))[u] = 0u;
    if (F.tid < 30) ((LAS unsigned long long*)(F.lds + LT_INP))[F.tid] = (unsigned long long)args.in[F.tid];
    __syncthreads();
    XcdBarrier bar = xcd_barrier_post((unsigned*)(F.ctl + CW_BAR), F.MISC + 8, F.wave);
#define GRID_BAR() xcd_barrier(bar)
#if TSEL >= 0
    if (blockIdx.x == 0 && F.wave == 0 && hw_lane() == 0) ((unsigned long long*)(F.ws + WS_CTL + 32768))[0] = __builtin_amdgcn_s_memrealtime();
#endif

#ifndef SKIP_PRO
    p_prologue(F, args);
#endif

    GRID_BAR(); TS(0);
    layer_body<0>(F, args, bar, lds);
#if DEBUG_NAN
    return;
#endif
    layer_body<1>(F, args, bar, lds);
    layer_body<2>(F, args, bar, lds);
    layer_body<3>(F, args, bar, lds);

#ifndef SKIP_FINAL
    p_final_combine(F, DEPTH - 1);
#endif
#if TSEL >= 0
    TS(15);
    xcd_barrier(bar);
    if (blockIdx.x == 0 && F.wave == 0 && hw_lane() == 0) { const unsigned long long* ts_ = (const unsigned long long*)(F.ws + WS_CTL + 32768); float tot = 0.f, sel = 0.f;
        for (int k = 0; k < 16; ++k) { tot += (float)ts_[1 + k]; if ((TSEL >> k) & 1) sel += (float)ts_[1 + k]; }
        F.out[0] += 3.0f + 6.9f * sel / tot; }
#endif

#if CYSEL >= 0
    xcd_barrier(bar);
    if (blockIdx.x == 0 && F.wave == 0 && hw_lane() == 0) { const unsigned long long* cs_ = (const unsigned long long*)(F.ws + WS_CTL + 40960); float tot = 0.f; for (int k = 0; k < 5; ++k) tot += (float)cs_[k];
        F.out[0] += 3.0f + 6.9f * (float)cs_[CYSEL] / tot; }
#endif
    if (xb_ld((unsigned*)(F.ctl + CW_BAR) + XB_TMO) != 0u && blockIdx.x == 0 && F.wave == 0 && hw_lane() == 0) F.out[0] = __builtin_nanf("");
}

extern "C" void kernel_launch(void* const* d_in, const int* in_sizes, int n_in, void* d_out, int out_size, void* d_ws, size_t ws_size, hipStream_t stream) {
    static int grid = 0;
    if (grid == 0) {
        if (n_in != 30 || in_sizes[0] != TL * 1024 || out_size != TL * 1024 || ws_size < WS_END) { fprintf(stderr, "kernel_launch: unexpected shapes / workspace (n_in %d, ws %zu); nothing launched\n", n_in, ws_size); grid = -1; return; }
        int dev = 0, cus = 0, per_cu = 0;
        if (hipGetDevice(&dev) != hipSuccess || hipDeviceGetAttribute(&cus, hipDeviceAttributeMultiprocessorCount, dev) != hipSuccess) { grid = -1; return; }
        if (hipFuncSetAttribute((const void*)mk_fwd, hipFuncAttributeMaxDynamicSharedMemorySize, LDS_BYTES) != hipSuccess) { fprintf(stderr, "kernel_launch: hipFuncSetAttribute failed\n"); grid = -1; return; }
        if (hipOccupancyMaxActiveBlocksPerMultiprocessor(&per_cu, (const void*)mk_fwd, NWAVES * 64, LDS_BYTES) != hipSuccess || per_cu < 1) { fprintf(stderr, "kernel_launch: occupancy query reports %d blocks per CU\n", per_cu); }
        (void)hipGetLastError();
        grid = cus;
    }
    if (grid < 0) return;
    if (hipMemsetAsync((char*)d_ws + WS_CTL, 0, CTL_ZERO_BYTES, stream) != hipSuccess) return;
    Args a{};
    for (int i = 0; i < 30; ++i) a.in[i] = (const float*)d_in[i];
    a.out = (float*)d_out; a.ws = (unsigned char*)d_ws;
    hipLaunchKernelGGL(mk_fwd, dim3(grid), dim3(NWAVES * 64), LDS_BYTES, stream, a);
}
```

```cpp
#include <hip/hip_runtime.h>
#include <hip/hip_bf16.h>
#include <cstdio>
#include <cstdint>
#include <cmath>
__device__ __forceinline__ int hw_lane() { int l_; asm volatile("v_mbcnt_lo_u32_b32 %0, -1, 0\n\tv_mbcnt_hi_u32_b32 %0, -1, %0" : "=v"(l_)); return l_; }
namespace pg8 {
#define PG8_LAS __attribute__((address_space(3)))
typedef unsigned short bf16_t;
typedef short bf16x8 __attribute__((ext_vector_type(8)));
typedef float f32x4 __attribute__((ext_vector_type(4)));
typedef unsigned u32x4 __attribute__((ext_vector_type(4)));
constexpr int BM = 256, BK = 64, HALF = 128, HTB = HALF * BK * 2  , STAGE_BYTES = 8 * HTB, NXCD = 8, WGM = 8;

__host__ __device__ __forceinline__ int lds_byte(int r, int c) { const int st = (r >> 4) * 2 + (c >> 5), rr = r & 15, cc = c & 31, ob = rr * 64 + cc * 2; return st * 1024 + (ob ^ (((ob >> 9) & 1) << 5)); }
__host__ __device__ __forceinline__ void stage_rc(int b, int& R, int& C) { const int st = b / 1024, sb = b % 1024, swz = sb ^ (((sb >> 9) & 1) << 5); R = (st >> 1) * 16 + swz / 64; C = (st & 1) * 32 + (swz % 64) / 2; }
__host__ __device__ __forceinline__ int perm32(int rho) { const int n = rho >> 4, i = rho & 15; return 8 * (i >> 2) + 4 * n + (i & 3); }
__device__ __forceinline__ unsigned cvt_pk_bf16(float lo, float hi) { unsigned r; asm volatile("v_cvt_pk_bf16_f32 %0, %1, %2" : "=v"(r) : "v"(lo), "v"(hi)); return r; }
typedef float f32x2 __attribute__((ext_vector_type(2)));

struct Unit { int pm, pn, pnb, ka, nt, slice; };
struct Gemm { const bf16_t* A; const bf16_t* Bt; int M, N, K, lda, ldb; };

struct Sched {
    static constexpr bool SPLITK = false;
    int nM, nN, nwg, G, c, lora; const PG8_LAS int* pexp;
    __device__ __forceinline__ void init(int nM_, int nN_, int G_, int c_, const PG8_LAS int* pe) { nM = nM_; nN = nN_; nwg = nM * nN; G = G_; c = c_; pexp = pe; lora = 0; }
    __device__ __forceinline__ bool next(int i, Unit& u) const {
        const long L = (long)i * G + c; if (L >= nwg) return false;
        int wgid = (int)L; { const int q = nwg / NXCD, r = nwg % NXCD, xcd = wgid % NXCD, off = wgid / NXCD; wgid = (xcd < r ? xcd * (q + 1) : r * (q + 1) + (xcd - r) * q) + off; }
        const int nig = WGM * nN, gid = wgid / nig, fm = gid * WGM, gsz = (nM - fm) < WGM ? (nM - fm) : WGM;
        u.pm = fm + ((wgid % nig) % gsz); u.pn = (wgid % nig) / gsz; u.pnb = pexp ? pexp[u.pm] * nN + u.pn : u.pn;
        u.ka = lora ? ((u.pn >= 8) ? 512 : ((u.pn >= 4) ? 256 : 0)) : 0; return true;
    }
    __device__ __forceinline__ void a_ready(const Unit&) const {}
    __device__ __forceinline__ void done(const Unit&) const {}
};
struct SchedSK {
    static constexpr bool SPLITK = true;
    int nM, nwg, G, c, nsub, ntt, base, extra;
    __device__ __forceinline__ void init(int nMf_, bool ctx, int ntiles, int G_, int c_) { nM = nMf_; nwg = nMf_ * 4; G = G_; c = c_; nsub = ctx ? 128 : 0; ntt = ntiles; base = (ntiles / 4) & ~1; extra = (ntiles - 4 * base) / 2; }
    __device__ __forceinline__ bool next(int i, Unit& u) const {
        const long L = (long)i * G + c; if (L >= nwg + nsub) return false;
        const bool sub = L >= nwg;
        int wgid = sub ? 0 : (int)L; { const int q = nwg / NXCD, r = nwg % NXCD, xcd = wgid % NXCD, off = wgid / NXCD; wgid = (xcd < r ? xcd * (q + 1) : r * (q + 1) + (xcd - r) * q) + off; }
        const int nig = WGM * 4, gid = wgid / nig, fm = gid * WGM, gsz = (nM - fm) < WGM ? (nM - fm) : WGM;
        const int pmf = fm + ((wgid % nig) % gsz), pnf = (wgid % nig) / gsz;
        const int Ls = sub ? (int)(L - nwg) : 0, sl = Ls >> 5, rem = Ls & 31;
        const int kt0 = sl * base + 2 * (sl < extra ? sl : extra);
        u.pm = sub ? nM + (rem & 7) : pmf; u.pn = sub ? (rem >> 3) : pnf; u.pnb = u.pn; u.slice = sl;
        u.nt = sub ? base + ((sl < extra) ? 2 : 0) : ntt; u.ka = kt0 * (BK * 2); return true;
    }
    __device__ __forceinline__ void a_ready(const Unit&) const {}
    __device__ __forceinline__ void done(const Unit&) const {}
};

__device__ __forceinline__ float sigmoid_f(float x) { return __builtin_amdgcn_rcpf(1.0f + __builtin_amdgcn_exp2f(-1.4426950408889634f * x)); }
__device__ __forceinline__ float bf_lo(unsigned w) { return __builtin_bit_cast(float, w << 16); }
__device__ __forceinline__ float bf_hi(unsigned w) { return __builtin_bit_cast(float, w & 0xffff0000u); }

struct EpiBf16 {
    static constexpr bool PERM = true, AFTER_DRAIN = false;
    bf16_t* O; int ldc;
    __device__ __forceinline__ void operator()(const f32x4 (&acc)[2][2][4][2], const Unit& u, int wr, int wc, int fr, int fq) const {
        const int row0 = u.pm * BM + wr * 64 + fr; const int col0 = u.pn * BM + wc * 32 + 8 * fq;
#pragma unroll
        for (int ai = 0; ai < 2; ++ai)
#pragma unroll
            for (int m = 0; m < 4; ++m) { bf16_t* rowp = O + (size_t)(row0 + ai * HALF + m * 16) * ldc + col0;
#pragma unroll
                for (int bj = 0; bj < 2; ++bj) { const f32x4 v0 = acc[ai][bj][m][0], v1 = acc[ai][bj][m][1];
                    u32x4 w; w.x = cvt_pk_bf16(v0[0], v0[1]); w.y = cvt_pk_bf16(v0[2], v0[3]); w.z = cvt_pk_bf16(v1[0], v1[1]); w.w = cvt_pk_bf16(v1[2], v1[3]);
                    *(u32x4*)(rowp + bj * HALF) = w; } }
    }
};
struct EpiSwiGLU {
    static constexpr bool PERM = true, AFTER_DRAIN = false;
    bf16_t* O; int ldc; float inscale;
    __device__ __forceinline__ void operator()(const f32x4 (&acc)[2][2][4][2], const Unit& u, int wr, int wc, int fr, int fq) const {
        const int row0 = u.pm * BM + wr * 64 + fr; const int col0 = u.pn * HALF + wc * 32 + 8 * fq;
#pragma unroll
        for (int ai = 0; ai < 2; ++ai)
#pragma unroll
            for (int m = 0; m < 4; ++m) { bf16_t* rowp = O + (size_t)(row0 + ai * HALF + m * 16) * ldc + col0;
                float h[8];
#pragma unroll
                for (int n = 0; n < 2; ++n)
#pragma unroll
                    for (int j = 0; j < 4; ++j) { const float g = acc[ai][0][m][n][j] * inscale, up = acc[ai][1][m][n][j] * inscale; h[n * 4 + j] = g * sigmoid_f(g) * up; }
                u32x4 w; w.x = cvt_pk_bf16(h[0], h[1]); w.y = cvt_pk_bf16(h[2], h[3]); w.z = cvt_pk_bf16(h[4], h[5]); w.w = cvt_pk_bf16(h[6], h[7]);
                *(u32x4*)rowp = w; }
    }
};
struct EpiResid {
    static constexpr bool PERM = false, AFTER_DRAIN = false;
    const float* baseL; const float* baseC; float* outL; float* outC; const float* gate; float scale;
    __device__ __forceinline__ void operator()(const f32x4 (&acc)[2][2][4][2], const Unit& u, int wr, int wc, int fr, int fq) const {
        const float* base; float* out; int bsel;
        if (u.pm < 128) { base = baseL + (size_t)u.pm * BM * 1024; out = outL + (size_t)u.pm * BM * 1024; bsel = u.pm >> 4; }
        else { base = baseC + (size_t)(u.pm - 128) * BM * 1024; out = outC + (size_t)(u.pm - 128) * BM * 1024; bsel = 8; }
        const float* gv = gate + (size_t)bsel * 6144;
        const int col0 = u.pn * BM + wc * 32 + 4 * fq;
        f32x4 g4[2][2];
#pragma unroll
        for (int bj = 0; bj < 2; ++bj)
#pragma unroll
            for (int n = 0; n < 2; ++n) g4[bj][n] = *(const f32x4*)(gv + col0 + bj * HALF + n * 16) * scale;
#pragma unroll
        for (int ai = 0; ai < 2; ++ai)
#pragma unroll
            for (int m = 0; m < 4; ++m) { const size_t off = (size_t)(ai * HALF + wr * 64 + m * 16 + fr) * 1024 + col0;
#pragma unroll
                for (int bj = 0; bj < 2; ++bj)
#pragma unroll
                    for (int n = 0; n < 2; ++n) { const f32x4 xs = *(const f32x4*)(base + off + bj * HALF + n * 16); *(f32x4*)(out + off + bj * HALF + n * 16) = xs + g4[bj][n] * acc[ai][bj][m][n]; } }
    }
};

__device__ __forceinline__ float clamp8(float x) { return __builtin_fminf(__builtin_fmaxf(x, -440.0f), 440.0f); }
__device__ __forceinline__ unsigned pk_fp8x4(float a, float b, float c, float d) { int w = 0; w = __builtin_amdgcn_cvt_pk_fp8_f32(clamp8(a), clamp8(b), w, false); w = __builtin_amdgcn_cvt_pk_fp8_f32(clamp8(c), clamp8(d), w, true); return (unsigned)w; }
struct EpiSwiGLU8 {
    static constexpr bool PERM = true, AFTER_DRAIN = false;
    unsigned char* O; int ldc; float inscale, outscale;
    __device__ __forceinline__ void operator()(const f32x4 (&acc)[2][2][4][2], const Unit& u, int wr, int wc, int fr, int fq) const {
        const int row0 = u.pm * BM + wr * 64 + fr; const int col0 = u.pn * HALF + wc * 32 + 8 * fq;
        const float c1 = -1.4426950408889634f * inscale, c2 = inscale * inscale * outscale;
#pragma unroll
        for (int ai = 0; ai < 2; ++ai)
#pragma unroll
            for (int m = 0; m < 4; ++m) { unsigned char* rowp = O + (size_t)(row0 + ai * HALF + m * 16) * ldc + col0;
                float h[8];
#pragma unroll
                for (int n = 0; n < 2; ++n)
#pragma unroll
                    for (int j = 0; j < 4; ++j) { const float ag = acc[ai][0][m][n][j], au = acc[ai][1][m][n][j];
                        h[n * 4 + j] = (ag * au) * (c2 * __builtin_amdgcn_rcpf(1.0f + __builtin_amdgcn_exp2f(c1 * ag))); }
                typedef unsigned u32x2e __attribute__((ext_vector_type(2)));
                *(u32x2e*)rowp = (u32x2e){pk_fp8x4(h[0], h[1], h[2], h[3]), pk_fp8x4(h[4], h[5], h[6], h[7])};  asm volatile("" ::: "memory"); }
    }
};
struct EpiBf16S {
    static constexpr bool PERM = true, AFTER_DRAIN = false;
    bf16_t* O; int ldc; float scale;
    __device__ __forceinline__ void operator()(const f32x4 (&acc)[2][2][4][2], const Unit& u, int wr, int wc, int fr, int fq) const {
        const int row0 = u.pm * BM + wr * 64 + fr; const int col0 = u.pn * BM + wc * 32 + 8 * fq;
#pragma unroll
        for (int ai = 0; ai < 2; ++ai)
#pragma unroll
            for (int m = 0; m < 4; ++m) { bf16_t* rowp = O + (size_t)(row0 + ai * HALF + m * 16) * ldc + col0;
#pragma unroll
                for (int bj = 0; bj < 2; ++bj) { const f32x4 v0 = acc[ai][bj][m][0] * scale, v1 = acc[ai][bj][m][1] * scale;
                    u32x4 w; w.x = cvt_pk_bf16(v0[0], v0[1]); w.y = cvt_pk_bf16(v0[2], v0[3]); w.z = cvt_pk_bf16(v1[0], v1[1]); w.w = cvt_pk_bf16(v1[2], v1[3]);
                    *(u32x4*)(rowp + bj * HALF) = w; } asm volatile("" ::: "memory"); }
    }
};

template <bool BASEF32> struct EpiResidB {
    static constexpr bool PERM = true, AFTER_DRAIN = false;
    const float* baseL; const float* baseC; bf16_t* xb; const float* gate; bf16_t* side; float scale;
    __device__ __forceinline__ void operator()(const f32x4 (&acc)[2][2][4][2], const Unit& u, int wr, int wc, int fr, int fq) const {
        asm volatile("" : "+v"(fr), "+v"(fq));
        const int bsel = (u.pm < 128) ? (u.pm >> 4) : 8;
        const float* base = (u.pm < 128) ? baseL + (size_t)u.pm * BM * 1024 : baseC + (size_t)(u.pm - 128) * BM * 1024;
        bf16_t* out = xb + (size_t)u.pm * BM * 1024;
        const float* gv = gate + (size_t)bsel * 6144;
        const int col0 = u.pn * BM + wc * 32 + 8 * fq;
        f32x4 g4[2][2];
#pragma unroll
        for (int bj = 0; bj < 2; ++bj)
#pragma unroll
            for (int n = 0; n < 2; ++n) g4[bj][n] = *(const f32x4*)(gv + col0 + bj * HALF + 4 * n) * scale;
        if (u.slice != 0) {
            bf16_t* so = side + ((size_t)(u.slice - 1) * 2048 + (size_t)(u.pm - 128) * BM) * 1024;
#pragma unroll
            for (int ai = 0; ai < 2; ++ai)
#pragma unroll
                for (int m = 0; m < 4; ++m) { const size_t off = (size_t)(ai * HALF + wr * 64 + m * 16 + fr) * 1024 + col0;
#pragma unroll
                    for (int bj = 0; bj < 2; ++bj) { const f32x4 o0 = g4[bj][0] * acc[ai][bj][m][0], o1 = g4[bj][1] * acc[ai][bj][m][1];
                        u32x4 ow; ow.x = cvt_pk_bf16(o0[0], o0[1]); ow.y = cvt_pk_bf16(o0[2], o0[3]); ow.z = cvt_pk_bf16(o1[0], o1[1]); ow.w = cvt_pk_bf16(o1[2], o1[3]);
                        *(u32x4*)(so + off + bj * HALF) = ow; } }
        } else
#pragma unroll
        for (int ai = 0; ai < 2; ++ai)
#pragma unroll
            for (int m = 0; m < 4; ++m) { const size_t off = (size_t)(ai * HALF + wr * 64 + m * 16 + fr) * 1024 + col0;
#pragma unroll
                for (int bj = 0; bj < 2; ++bj) { f32x4 x0, x1;
                    if (BASEF32) { x0 = *(const f32x4*)(base + off + bj * HALF); x1 = *(const f32x4*)(base + off + bj * HALF + 4); }
                    else { const u32x4 w = *(const u32x4*)(out + off + bj * HALF); x0 = (f32x4){bf_lo(w.x), bf_hi(w.x), bf_lo(w.y), bf_hi(w.y)}; x1 = (f32x4){bf_lo(w.z), bf_hi(w.z), bf_lo(w.w), bf_hi(w.w)}; }
                    const f32x4 o0 = x0 + g4[bj][0] * acc[ai][bj][m][0], o1 = x1 + g4[bj][1] * acc[ai][bj][m][1];
                    u32x4 ow; ow.x = cvt_pk_bf16(o0[0], o0[1]); ow.y = cvt_pk_bf16(o0[2], o0[3]); ow.z = cvt_pk_bf16(o1[0], o1[1]); ow.w = cvt_pk_bf16(o1[2], o1[3]);
                    *(u32x4*)(out + off + bj * HALF) = ow; } }
    }
};

struct EpiLoraAct {
    static constexpr bool PERM = true, AFTER_DRAIN = false;
    bf16_t* O; int ldc; const float* w0; const float* a0;
    __device__ __forceinline__ void operator()(const f32x4 (&acc)[2][2][4][2], const Unit& u, int wr, int wc, int fr, int fq) const {
        const int row0 = u.pm * BM + wr * 64 + fr; const int col0 = u.pn * BM + wc * 32 + 8 * fq; const int sec = u.pn >> 1;
        const int cs0 = (u.pn & 1) * 256 + wc * 32 + 8 * fq;
        f32x4 bv[2][2]; float mul = 1.0f;
        if (sec < 4) { const float* bp = (sec < 2 ? w0 + sec * 512 : a0 + (sec - 2) * 512) + cs0; mul = (sec < 2) ? 0.8750387749145276f : 1.0f;
#pragma unroll
            for (int bj = 0; bj < 2; ++bj)
#pragma unroll
                for (int n = 0; n < 2; ++n) bv[bj][n] = *(const f32x4*)(bp + bj * HALF + 4 * n); }
#pragma unroll
        for (int ai = 0; ai < 2; ++ai)
#pragma unroll
            for (int m = 0; m < 4; ++m) { bf16_t* rowp = O + (size_t)(row0 + ai * HALF + m * 16) * ldc + col0;
#pragma unroll
                for (int bj = 0; bj < 2; ++bj) { f32x4 v0 = acc[ai][bj][m][0], v1 = acc[ai][bj][m][1];
                    if (sec < 4) {
#pragma unroll
                        for (int j = 0; j < 4; ++j) { v0[j] = mul * sigmoid_f(v0[j] + bv[bj][0][j]); v1[j] = mul * sigmoid_f(v1[j] + bv[bj][1][j]); } }
                    u32x4 w; w.x = cvt_pk_bf16(v0[0], v0[1]); w.y = cvt_pk_bf16(v0[2], v0[3]); w.z = cvt_pk_bf16(v1[0], v1[1]); w.w = cvt_pk_bf16(v1[2], v1[3]);
                    *(u32x4*)(rowp + bj * HALF) = w; } }
    }
};
typedef int v8i_t __attribute__((ext_vector_type(8)));
__device__ __forceinline__ v8i_t cat8(bf16x8 a, bf16x8 b) { const u32x4 x = __builtin_bit_cast(u32x4, a), y = __builtin_bit_cast(u32x4, b); return (v8i_t){(int)x[0], (int)x[1], (int)x[2], (int)x[3], (int)y[0], (int)y[1], (int)y[2], (int)y[3]}; }
template <class Epi, class Sched, bool ALIGN_EPI = false, bool SP2 = false, bool FP8 = false>
__device__ __forceinline__ void gemm_phase(PG8_LAS unsigned char* lds, const Gemm g, const Sched& S, const Epi& E, const int wave_) {
    const int tid = wave_ * 64 + hw_lane(), wid = wave_, lane = tid & 63, wr = wid >> 2, wc = wid & 3, fr = lane & 15, fq = lane >> 4;
    int K_ = g.K; asm volatile("" : "+s"(K_));
    const int K = K_, nt = K / BK; const int lda = g.lda ? g.lda : K, ldb = g.ldb ? g.ldb : K;
    unsigned voffA[2], voffB[2];
#pragma unroll
    for (int i = 0; i < 2; ++i) { int R, C; stage_rc(tid * 16 + i * 8192, R, C); const int Rb = Epi::PERM ? ((R & ~31) + perm32(R & 31)) : R;
        voffA[i] = (unsigned)(R * lda + C) * 2u; voffB[i] = (unsigned)(Rb * ldb + C) * 2u; }
    const size_t kstep = (size_t)(BK * 2);
    const size_t hstep = (size_t)HALF * ldb * 2;
    const size_t hstepA = (size_t)HALF * lda * 2, tstepA = 2 * hstepA;
    const size_t tstep = 2 * hstep;
    const unsigned ldsw = (unsigned)wid * 1024u;
    const int aoff = lds_byte(wr * 64 + fr, fq * 8), boff = lds_byte(wc * 32 + fr, fq * 8);
#define PG8_SA(b, h) (((b) * 2 + (h)) * HTB)
#define PG8_SB(b, h) ((4 + (b) * 2 + (h)) * HTB)
#define PG8_STAGE(bufoff, gbase, voff) do { _Pragma("unroll") for (int _i = 0; _i < 2; ++_i) \
        __builtin_amdgcn_global_load_lds((const unsigned*)((const char*)(gbase) + (voff)[_i]), (PG8_LAS unsigned*)(lds + (bufoff) + ldsw + _i * 8192), 16, 0, 0); } while (0)
#define PG8_LDA(dst, b, h) do { if constexpr (FP8) { _Pragma("unroll") for (int m = 0; m < 4; ++m) { dst##8[m].lo = *(const PG8_LAS v4i_t*)(lds + PG8_SA(b, h) + aoff + m * 2048); dst##8[m].hi = *(const PG8_LAS v4i_t*)(lds + PG8_SA(b, h) + aoff + m * 2048 + 1024); } } \
        else { _Pragma("unroll") for (int m = 0; m < 4; ++m) _Pragma("unroll") for (int k = 0; k < 2; ++k) dst[FP8 ? 0 : m][k] = *(const PG8_LAS bf16x8*)(lds + PG8_SA(b, h) + aoff + m * 2048 + k * 1024); } } while (0)
#define PG8_LDB(dst, b, h) do { if constexpr (FP8) { _Pragma("unroll") for (int n = 0; n < 2; ++n) { dst##8[n].lo = *(const PG8_LAS v4i_t*)(lds + PG8_SB(b, h) + boff + n * 2048); dst##8[n].hi = *(const PG8_LAS v4i_t*)(lds + PG8_SB(b, h) + boff + n * 2048 + 1024); } } \
        else { _Pragma("unroll") for (int n = 0; n < 2; ++n) _Pragma("unroll") for (int k = 0; k < 2; ++k) dst[n][k] = *(const PG8_LAS bf16x8*)(lds + PG8_SB(b, h) + boff + n * 2048 + k * 1024); } } while (0)
#define PG8_MMA(ai, bj, At, Bt) do { __builtin_amdgcn_s_setprio(1); if constexpr (FP8) { _Pragma("unroll") for (int m = 0; m < 4; ++m) _Pragma("unroll") for (int n = 0; n < 2; ++n) \
        asm volatile("v_mfma_f32_16x16x128_f8f6f4 %0, %1, %2, %0" : "+v"(acc[ai][bj][m][n]) : "v"(Bt##8[n]), "v"(At##8[m])); } \
        else { _Pragma("unroll") for (int m = 0; m < 4; ++m) _Pragma("unroll") for (int n = 0; n < 2; ++n) _Pragma("unroll") for (int k = 0; k < 2; ++k) \
        acc[ai][bj][m][n] = __builtin_amdgcn_mfma_f32_16x16x32_bf16(Bt[n][k], At[FP8 ? 0 : m][k], acc[ai][bj][m][n], 0, 0, 0); } __builtin_amdgcn_s_setprio(0); } while (0)
#define PG8_WAIT_V(n) asm volatile("s_waitcnt vmcnt(" #n ")" ::: "memory")
#define PG8_WAIT_L(n) asm volatile("s_waitcnt lgkmcnt(" #n ")" ::: "memory")
#define PG8_BAR __builtin_amdgcn_s_barrier()
#define PG8_SCHED __builtin_amdgcn_sched_barrier(0)
    Unit cur, nxt; int ui = 0;
    if (!S.next(0, cur)) return;
    f32x4 acc[2][2][4][2];
#pragma unroll
    for (int a = 0; a < 2; ++a)
#pragma unroll
        for (int b = 0; b < 2; ++b)
#pragma unroll
            for (int m = 0; m < 4; ++m)
#pragma unroll
                for (int n = 0; n < 2; ++n) acc[a][b][m][n] = (f32x4){0.f, 0.f, 0.f, 0.f};
    bf16x8 At[FP8 ? 1 : 4][2], B0[2][2], B1[2][2];
    v8i_t At8[FP8 ? 4 : 1], B08[2], B18[2];
    typedef int v4i_t __attribute__((ext_vector_type(4)));
    const char* cA = (const char*)g.A + (size_t)cur.pm * tstepA + cur.ka; const char* cB = (const char*)g.Bt + (size_t)cur.pnb * tstep + (Sched::SPLITK ? cur.ka : 0);
    S.a_ready(cur);
    if constexpr (SP2) {
        PG8_STAGE(PG8_SB(0, 0), cB, voffB); PG8_STAGE(PG8_SB(0, 1), cB + hstep, voffB); PG8_STAGE(PG8_SA(0, 0), cA, voffA); PG8_STAGE(PG8_SA(0, 1), cA + hstepA, voffA);
        if (wr == 1) PG8_BAR;
        PG8_WAIT_V(2); PG8_BAR;
        PG8_STAGE(PG8_SB(1, 0), cB + kstep, voffB); PG8_STAGE(PG8_SA(1, 0), cA + kstep, voffA); PG8_STAGE(PG8_SB(1, 1), cB + hstep + kstep, voffB);
        PG8_WAIT_V(6); PG8_BAR;
    } else {
        PG8_STAGE(PG8_SB(0, 0), cB, voffB); PG8_STAGE(PG8_SA(0, 0), cA, voffA); PG8_STAGE(PG8_SB(0, 1), cB + hstep, voffB); PG8_STAGE(PG8_SA(0, 1), cA + hstepA, voffA);
        if (wr == 1) PG8_BAR;
        PG8_WAIT_V(4); PG8_BAR;
        PG8_STAGE(PG8_SB(1, 0), cB + kstep, voffB); PG8_STAGE(PG8_SA(1, 0), cA + kstep, voffA); PG8_STAGE(PG8_SB(1, 1), cB + hstep + kstep, voffB);
        PG8_WAIT_V(6); PG8_BAR;
    }
    for (;;) {
        const bool has_next = S.next(ui + 1, nxt);
        const char* nA = has_next ? (const char*)g.A + (size_t)nxt.pm * tstepA + nxt.ka : cA; const char* nB = has_next ? (const char*)g.Bt + (size_t)nxt.pnb * tstep + (Sched::SPLITK ? nxt.ka : 0) : cB;
        const int ntc = Sched::SPLITK ? cur.nt : nt;
        for (int t = 0; t < ntc; t += 2) {
            const bool last = (t == ntc - 2);
            const char* a1 = cA + (size_t)(t + 1) * kstep;
            const char* a2 = last ? nA : cA + (size_t)(t + 2) * kstep; const char* b2 = last ? nB : cB + (size_t)(t + 2) * kstep;
            const char* a3 = a2 + kstep; const char* b3 = b2 + kstep;
            if (last && has_next) S.a_ready(nxt);
            if constexpr (SP2) {
            PG8_LDB(B0, 0, 0); PG8_LDB(B1, 0, 1); PG8_SCHED; PG8_LDA(At, 0, 0); PG8_STAGE(PG8_SA(1, 1), a1 + hstepA, voffA);
            PG8_WAIT_V(8); PG8_WAIT_L(0); PG8_BAR; PG8_MMA(0, 0, At, B0); PG8_MMA(0, 1, At, B1); PG8_BAR; PG8_SCHED;
            PG8_LDA(At, 0, 1); PG8_STAGE(PG8_SB(0, 0), b2, voffB); PG8_STAGE(PG8_SB(0, 1), b2 + hstep, voffB); PG8_STAGE(PG8_SA(0, 0), a2, voffA);
            PG8_WAIT_V(8); PG8_WAIT_L(0); PG8_BAR; PG8_MMA(1, 0, At, B0); PG8_MMA(1, 1, At, B1); PG8_BAR; PG8_SCHED;
            PG8_LDB(B0, 1, 0); PG8_LDB(B1, 1, 1); PG8_SCHED; PG8_LDA(At, 1, 0); PG8_STAGE(PG8_SA(0, 1), a2 + hstepA, voffA);
            PG8_WAIT_V(8); PG8_WAIT_L(0); PG8_BAR; PG8_MMA(0, 0, At, B0); PG8_MMA(0, 1, At, B1); PG8_BAR; PG8_SCHED;
            PG8_LDA(At, 1, 1); PG8_STAGE(PG8_SB(1, 0), b3, voffB); PG8_STAGE(PG8_SB(1, 1), b3 + hstep, voffB); PG8_STAGE(PG8_SA(1, 0), a3, voffA);
            PG8_WAIT_V(8); PG8_WAIT_L(0); PG8_BAR; PG8_MMA(1, 0, At, B0); PG8_MMA(1, 1, At, B1); PG8_BAR; PG8_SCHED;
            } else {
            PG8_LDB(B0, 0, 0); PG8_SCHED; PG8_LDA(At, 0, 0); PG8_STAGE(PG8_SA(1, 1), a1 + hstepA, voffA);
            PG8_WAIT_L(8); PG8_BAR; PG8_WAIT_L(0); PG8_MMA(0, 0, At, B0); PG8_BAR; PG8_SCHED;
            PG8_LDB(B1, 0, 1); PG8_STAGE(PG8_SB(0, 0), b2, voffB);
            PG8_BAR; PG8_WAIT_L(0); PG8_MMA(0, 1, At, B1); PG8_BAR;
            PG8_LDA(At, 0, 1); PG8_STAGE(PG8_SA(0, 0), a2, voffA);
            PG8_BAR; PG8_WAIT_L(0); PG8_MMA(1, 0, At, B0); PG8_BAR; PG8_SCHED;
            PG8_STAGE(PG8_SB(0, 1), b2 + hstep, voffB);
            PG8_WAIT_V(6); PG8_BAR; PG8_MMA(1, 1, At, B1); PG8_BAR;
            PG8_LDB(B0, 1, 0); PG8_SCHED; PG8_LDA(At, 1, 0); PG8_STAGE(PG8_SA(0, 1), a2 + hstepA, voffA);
            PG8_WAIT_L(8); PG8_BAR; PG8_WAIT_L(0); PG8_MMA(0, 0, At, B0); PG8_BAR; PG8_SCHED;
            PG8_LDB(B1, 1, 1); PG8_STAGE(PG8_SB(1, 0), b3, voffB);
            PG8_BAR; PG8_WAIT_L(0); PG8_MMA(0, 1, At, B1); PG8_BAR;
            PG8_LDA(At, 1, 1); PG8_STAGE(PG8_SA(1, 0), a3, voffA);
            PG8_BAR; PG8_WAIT_L(0); PG8_MMA(1, 0, At, B0); PG8_BAR; PG8_SCHED;
            PG8_STAGE(PG8_SB(1, 1), b3 + hstep, voffB);
            PG8_WAIT_V(6); PG8_BAR; PG8_MMA(1, 1, At, B1); PG8_BAR;
            }
        }
        if constexpr (ALIGN_EPI) { if (wr == 0) PG8_BAR; }
        if constexpr (!Epi::AFTER_DRAIN) { E(acc, cur, wr, wc, fr, fq); S.done(cur); }
        if (!has_next) break;
#pragma unroll
        for (int a = 0; a < 2; ++a)
#pragma unroll
            for (int b = 0; b < 2; ++b)
#pragma unroll
                for (int m = 0; m < 4; ++m)
#pragma unroll
                    for (int n = 0; n < 2; ++n) acc[a][b][m][n] = (f32x4){0.f, 0.f, 0.f, 0.f};
        cur = nxt; cA = nA; cB = nB; ++ui;
        if constexpr (ALIGN_EPI) { if (wr == 1) PG8_BAR; }
    }
    PG8_WAIT_V(0);
    if constexpr (!ALIGN_EPI) { if (wr == 0) PG8_BAR; }
    PG8_BAR;
    if constexpr (Epi::AFTER_DRAIN) { E.fused(acc, cur, wr, wc, fr, fq, lds, wid, lane); S.done(cur); }
#undef PG8_SA
#undef PG8_SB
#undef PG8_STAGE
#undef PG8_LDA
#undef PG8_LDB
#undef PG8_MMA
#undef PG8_WAIT_V
#undef PG8_WAIT_L
#undef PG8_BAR
#undef PG8_SCHED
}
}
#include <hip/hip_bf16.h>
#include <cmath>
namespace attn_body {
using bf16=__hip_bfloat16;
using bf16x8=__attribute__((ext_vector_type(8)))short;
using s16x4=__attribute__((ext_vector_type(4)))short;
using f32x16=__attribute__((ext_vector_type(16)))float;
using u32x4=__attribute__((ext_vector_type(4)))unsigned;
constexpr int D=64,DM=1024,KP=128;
constexpr int NW=8,QBLK=32,QB=QBLK*NW,KVBLK=64;
constexpr int ATTN_PITCH=DM, ATTN_UNIT_ROWS=QB;
__device__ __forceinline__ int crow(int r,int hi){return (r&3)+8*(r>>2)+4*hi;}
#define SBAR() __builtin_amdgcn_sched_barrier(0)
__device__ __forceinline__ void cmask(f32x16&p0,f32x16&p1,int jb,int qrel,int hi){
  const float NEG=-INFINITY; int kb=64*jb+4*hi;
  #pragma unroll
  for(int r=0;r<16;++r){int kv=kb+(r&3)+8*(r>>2); if(kv>qrel)p0[r]=NEG; if(kv+32>qrel)p1[r]=NEG;}
}

constexpr int NSLOT=3, SLOTB=8192;
constexpr int LDS_K=0, LDS_V=NSLOT*SLOTB, LDS_WS=2*NSLOT*SLOTB, LDS_OST=LDS_WS+NW*64*4, LDS_BYTES=LDS_OST+NW*4096;
constexpr float C2=0.125f*1.4426950408889634f;
__device__ __forceinline__ void glds16(const void*gsrc,unsigned lds_dst){unsigned keep;
  asm volatile("s_mov_b32 %0, m0\n\ts_mov_b32 m0, %2\n\ts_nop 0\n\tglobal_load_lds_dwordx4 %1, off\n\ts_mov_b32 m0, %0":"=&s"(keep):"v"(gsrc),"s"(lds_dst):"memory");}
__device__ __forceinline__ float max3f(float a,float b,float c){float r;asm("v_max3_f32 %0, %1, %2, %3":"=v"(r):"v"(a),"v"(b),"v"(c));return r;}
__device__ __forceinline__ float max2f(float a,float b){float r;asm("v_max_f32_e32 %0, %1, %2":"=v"(r):"v"(a),"v"(b));return r;}
__device__ __forceinline__ float fadd_s(float a,float b){float r;asm("v_add_f32_e32 %0, %1, %2":"=v"(r):"v"(a),"v"(b));return r;}
__device__ __forceinline__ float fsub_s(float a,float b){float r;asm("v_sub_f32_e32 %0, %1, %2":"=v"(r):"v"(a),"v"(b));return r;}
typedef float f32x2_t __attribute__((ext_vector_type(2))); typedef __bf16 bf16x2_t __attribute__((ext_vector_type(2)));
__device__ __forceinline__ unsigned cvtpk_s(float lo,float hi){f32x2_t v={lo,hi};bf16x2_t b=__builtin_convertvector(v,bf16x2_t);return __builtin_bit_cast(unsigned,b);}
#define WAIT_BAR(N) asm volatile("s_waitcnt vmcnt(" #N ") lgkmcnt(0)\n\ts_barrier":::"memory")

__device__ __forceinline__ void qkt(f32x16&p0,f32x16&p1,const char*Kslot,const bf16x8*qr,const f32x16&negm,int r32,int hi){
  const char*kb=Kslot+hi*1024+r32*16;
  #pragma unroll
  for(int d0=0;d0<4;++d0){
    const bf16x8 b0=*reinterpret_cast<const bf16x8*>(kb+d0*2048);
    const bf16x8 b1=*reinterpret_cast<const bf16x8*>(kb+d0*2048+512);
    if(d0==0){p0=__builtin_amdgcn_mfma_f32_32x32x16_bf16(b0,qr[0],negm,0,0,0);p1=__builtin_amdgcn_mfma_f32_32x32x16_bf16(b1,qr[0],negm,0,0,0);}
    else{p0=__builtin_amdgcn_mfma_f32_32x32x16_bf16(b0,qr[d0],p0,0,0,0);p1=__builtin_amdgcn_mfma_f32_32x32x16_bf16(b1,qr[d0],p1,0,0,0);}}
}
typedef __attribute__((address_space(3))) const char* lds_cptr;
typedef short v4i16_t __attribute__((ext_vector_type(4)));
__device__ __forceinline__ void kload8(bf16x8*kf,lds_cptr kp){
  kf[0]=*(const __attribute__((address_space(3))) bf16x8*)(kp);      kf[1]=*(const __attribute__((address_space(3))) bf16x8*)(kp+512);
  kf[2]=*(const __attribute__((address_space(3))) bf16x8*)(kp+2048); kf[3]=*(const __attribute__((address_space(3))) bf16x8*)(kp+2560);
  kf[4]=*(const __attribute__((address_space(3))) bf16x8*)(kp+4096); kf[5]=*(const __attribute__((address_space(3))) bf16x8*)(kp+4608);
  kf[6]=*(const __attribute__((address_space(3))) bf16x8*)(kp+6144); kf[7]=*(const __attribute__((address_space(3))) bf16x8*)(kp+6656);
}
__device__ __forceinline__ void kload2(bf16x8*kf,lds_cptr kp,int j){ kf[2*j]=*(const __attribute__((address_space(3))) bf16x8*)(kp+j*2048); kf[2*j+1]=*(const __attribute__((address_space(3))) bf16x8*)(kp+j*2048+512); }
__device__ __forceinline__ s16x4 vtr(lds_cptr p){ return __builtin_bit_cast(s16x4,__builtin_amdgcn_ds_read_tr16_b64_v4i16((__attribute__((address_space(3))) v4i16_t*)p)); }
__device__ __forceinline__ float rowmax(const f32x16&p0,const f32x16&p1){
  float a=max3f(p0[0],p0[1],p1[0]),b=max3f(p0[2],p0[3],p1[1]);a=max3f(a,p1[2],p1[3]);
  #pragma unroll
  for(int r=4;r<16;r+=4){a=max3f(a,p0[r],p0[r+1]);b=max3f(b,p0[r+2],p0[r+3]);a=max3f(a,p1[r],p1[r+1]);b=max3f(b,p1[r+2],p1[r+3]);}
  const float m=max2f(a,b);
  auto rr=__builtin_amdgcn_permlane32_swap(__float_as_uint(m),__float_as_uint(m),false,false);
  return max2f(__uint_as_float(rr[0]),__uint_as_float(rr[1]));
}
__device__ __forceinline__ void pv(f32x16*o,int vb,bf16x8 pa0,bf16x8 pa1,bf16x8 pa2,bf16x8 pa3){
  #pragma unroll
  for(int d0=0;d0<2;++d0){s16x4 lo[4],hi[4];
    #pragma unroll
    for(int ks=0;ks<4;++ks){
      asm volatile("ds_read_b64_tr_b16 %0,%1 offset:%c2":"=&v"(lo[ks]):"v"(vb),"i"(d0*4096+ks*1024):"memory");
      asm volatile("ds_read_b64_tr_b16 %0,%1 offset:%c2":"=&v"(hi[ks]):"v"(vb),"i"(d0*4096+ks*1024+512):"memory");}
    asm volatile("s_waitcnt lgkmcnt(0)":::"memory");SBAR();
    #define PK(k) (bf16x8){lo[k][0],lo[k][1],lo[k][2],lo[k][3],hi[k][0],hi[k][1],hi[k][2],hi[k][3]}
    o[d0]=__builtin_amdgcn_mfma_f32_32x32x16_bf16(pa0,PK(0),o[d0],0,0,0);
    o[d0]=__builtin_amdgcn_mfma_f32_32x32x16_bf16(pa1,PK(1),o[d0],0,0,0);
    o[d0]=__builtin_amdgcn_mfma_f32_32x32x16_bf16(pa2,PK(2),o[d0],0,0,0);
    o[d0]=__builtin_amdgcn_mfma_f32_32x32x16_bf16(pa3,PK(3),o[d0],0,0,0);
    #undef PK
  }
}

#ifndef ATTN_STORE16
#define ATTN_STORE16(p,v) (*(u32x4*)(p)=(v))
#endif
template<int THRL> __device__ __forceinline__ void attn_unit(long qrow0,int hcol,long kvrow0,int kvcol,int NT,const bf16*Q,const bf16*__restrict__ K,const bf16*__restrict__ V,bf16*O,char*shm,const int wave_){
  const int tid=wave_*64+hw_lane(),lane=tid&63,r32=lane&31,hi=lane>>5; const int wid=wave_;
  const bf16*Qw=Q+(qrow0+wid*QBLK)*DM+hcol;
  const bf16*Kh=K+kvrow0*KP+kvcol,*Vh=V+kvrow0*KP+kvcol;
  const unsigned lds0=(unsigned)(uintptr_t)shm;
  float*wsf=(float*)(shm+LDS_WS)+wid*64;
  const bf16*ksrc=Kh+(long)lane*KP+wid*8;
  const bf16*vsrc=Vh+(long)(16*(wid&3)+(lane>>2))*KP+(wid>>2)*32+(lane&3)*8;
  const unsigned kdst=lds0+LDS_K+wid*1024, vdst=lds0+LDS_V+wid*1024;
  #define DMA_K(t,slot) glds16(ksrc+(long)(t)*KVBLK*KP,(unsigned)__builtin_amdgcn_readfirstlane(kdst+(slot)))
  #define DMA_V(t,slot) glds16(vsrc+(long)(t)*KVBLK*KP,(unsigned)__builtin_amdgcn_readfirstlane(vdst+(slot)))
  const int vb0=(int)(lds0+LDS_V)+((lane>>4)&1)*32+(lane&3)*8+(4*hi+((lane&15)>>2))*64;
  const char*Kbase=shm+LDS_K; bf16x8 kf[8];
  const lds_cptr shm3=(lds_cptr)shm; const lds_cptr kp0=shm3+LDS_K+hi*1024+r32*16; const lds_cptr vp0=shm3+LDS_V+((lane>>4)&1)*32+(lane&3)*8+(4*hi+((lane&15)>>2))*64;
  DMA_K(0,0);DMA_V(0,0);DMA_K(1,SLOTB);
  bf16x8 qr[4];
  #pragma unroll
  for(int d0=0;d0<4;++d0)qr[d0]=*reinterpret_cast<const bf16x8*>(&Qw[(long)r32*DM+d0*16+hi*8]);
  float mhat=0.f,l_reg=0.f;f32x16 o[2];o[0]=f32x16{};o[1]=f32x16{};f32x16 negm=f32x16{};asm volatile("":"+v"(negm));
  #define CMASK(P0,P1,t) do{}while(0)
  bool resc=false;
  #define START(P0,P1) do{ const float rm=rowmax(P0,P1); resc=false; \
    { const float dl=rm; mhat=fadd_s(mhat,dl); \
      _Pragma("unroll") for(int r=0;r<16;++r){P0[r]=fsub_s(P0[r],dl);P1[r]=fsub_s(P1[r],dl);} \
      _Pragma("unroll") for(int r=0;r<16;++r)negm[r]=-mhat; asm volatile("":"+v"(negm)); } \
    _Pragma("unroll") for(int r=0;r<16;++r)P0[r]=__builtin_amdgcn_exp2f(P0[r]); }while(0)
  #define RESC() do{ if(resc){ asm volatile("s_waitcnt lgkmcnt(0)":::"memory"); \
      _Pragma("unroll") for(int d_=0;d_<2;++d_) _Pragma("unroll") for(int r=0;r<16;++r)o[d_][r]*=wsf[crow(r,hi)]; } }while(0)
  f32x16 pA0,pA1,pB0,pB1;
  int sl_prev=0,sl_cur=0,sl_next=SLOTB;
  #define ROT() do{sl_prev=sl_cur;sl_cur=sl_next;sl_next=(sl_next==(NSLOT-1)*SLOTB)?0:sl_next+SLOTB;}while(0)
  DMA_K(2,2*SLOTB);
  WAIT_BAR(3);
  qkt(pA0,pA1,Kbase,qr,negm,r32,hi);asm volatile("s_nop 15\n\ts_nop 7":"+v"(pA0),"+v"(pA1));CMASK(pA0,pA1,0);
  START(pA0,pA1);
  _Pragma("unroll") for(int r=0;r<16;++r)pA1[r]=__builtin_amdgcn_exp2f(pA1[r]);
  WAIT_BAR(0);
  DMA_K(3,0);DMA_V(1,SLOTB);
  ROT();
  kload8(kf,kp0+sl_cur);
  WAIT_BAR(2);
  s16x4 vlo[8],vhi[8]; u32x4 pw0,pw1,pw2,pw3;
  #define PKW(P,B) cvtpk_s(P[B],P[B+1])
  #define PAF(k) __builtin_bit_cast(bf16x8,pw##k)
  #define VFR(i) (bf16x8){vlo[i][0],vlo[i][1],vlo[i][2],vlo[i][3],vhi[i][0],vhi[i][1],vhi[i][2],vhi[i][3]}
  #define PIN(x) asm volatile("":"+v"(x))
  #define MX3(a,b,c) __builtin_fmaxf(__builtin_fmaxf((a),(b)),(c))
  #define GAPA(MF,A0,A1,A2,A3,W0,W1,PW) do{ MF; sacc+=A0; sacc+=A1; sacc+=A2; sacc+=A3; PIN(sacc); W0; W1; PIN(PW); SBAR(); }while(0)
  #define EX(v) __builtin_amdgcn_exp2f(v)
  #define GAPB(MF,X,B) do{ MF; X[B]=EX(X[B]); X[B+1]=EX(X[B+1]); X[B+2]=EX(X[B+2]); X[B+3]=EX(X[B+3]); PIN(X); SBAR(); }while(0)
  #define VRD(i) do{ vlo[i]=vtr(vp_+(((i)>>2)*4096+((i)&3)*1024)); vhi[i]=vtr(vp_+(((i)>>2)*4096+((i)&3)*1024+512)); }while(0)
  #define KRD(G,j) do{ if(G){ kload2(kf,kp0+sl_next,j); SBAR(); } }while(0)
  #define STEP(C0,C1,P0,P1,t,GK,GV,GL) do{ SBAR(); \
    const lds_cptr vp_=vp0+sl_prev; \
    VRD(0); SBAR(); float sacc=(P0[0]+P0[1]); \
    GAPA(C0=__builtin_amdgcn_mfma_f32_32x32x16_bf16(kf[0],qr[0],negm,0,0,0), P0[2],P0[3],P0[4],P0[5],     pw0[0]=PKW(P0,0), pw0[1]=PKW(P0,2), pw0); \
    VRD(4); SBAR(); GAPA(C1=__builtin_amdgcn_mfma_f32_32x32x16_bf16(kf[1],qr[0],negm,0,0,0), P0[6],P0[7],P0[8],P0[9],     pw0[2]=PKW(P0,4), pw0[3]=PKW(P0,6), pw0); \
    VRD(1); SBAR(); GAPA(C0=__builtin_amdgcn_mfma_f32_32x32x16_bf16(kf[2],qr[1],C0,0,0,0),   P0[10],P0[11],P0[12],P0[13], pw1[0]=PKW(P0,8), pw1[1]=PKW(P0,10), pw1); \
    VRD(5); SBAR(); GAPA(C1=__builtin_amdgcn_mfma_f32_32x32x16_bf16(kf[3],qr[1],C1,0,0,0),   P0[14],P0[15],P1[0],P1[1],   pw1[2]=PKW(P0,12),pw1[3]=PKW(P0,14), pw1); \
    VRD(2); SBAR(); GAPA(C0=__builtin_amdgcn_mfma_f32_32x32x16_bf16(kf[4],qr[2],C0,0,0,0),   P1[2],P1[3],P1[4],P1[5],     pw2[0]=PKW(P1,0), pw2[1]=PKW(P1,2), pw2); \
    VRD(6); SBAR(); GAPA(C1=__builtin_amdgcn_mfma_f32_32x32x16_bf16(kf[5],qr[2],C1,0,0,0),   P1[6],P1[7],P1[8],P1[9],     pw2[2]=PKW(P1,4), pw2[3]=PKW(P1,6), pw2); \
    VRD(3); SBAR(); GAPA(C0=__builtin_amdgcn_mfma_f32_32x32x16_bf16(kf[6],qr[3],C0,0,0,0),   P1[10],P1[11],P1[12],P1[13], pw3[0]=PKW(P1,8), pw3[1]=PKW(P1,10), pw3); \
    VRD(7); SBAR(); GAPA(C1=__builtin_amdgcn_mfma_f32_32x32x16_bf16(kf[7],qr[3],C1,0,0,0),   P1[14],P1[15],0.f,0.f,       pw3[2]=PKW(P1,12),pw3[3]=PKW(P1,14), pw3); \
    l_reg+=sacc; \
    if(GK){DMA_K((t)+3,sl_cur);} if(GV){DMA_V((t)+1,sl_next);} \
    CMASK(C0,C1,t); \
    { float a=MX3(C0[0],C0[1],C1[0]),b=MX3(C0[2],C0[3],C1[1]); a=MX3(a,C1[2],C1[3]); \
      _Pragma("unroll") for(int r=4;r<16;r+=4){a=MX3(a,C0[r],C0[r+1]);b=MX3(b,C0[r+2],C0[r+3]);a=MX3(a,C1[r],C1[r+1]);b=MX3(b,C1[r+2],C1[r+3]);} \
      float rm=__builtin_fmaxf(a,b); { auto rr=__builtin_amdgcn_permlane32_swap(__float_as_uint(rm),__float_as_uint(rm),false,false); rm=__builtin_fmaxf(__uint_as_float(rr[0]),__uint_as_float(rr[1])); } \
      resc=false; \
      if(__builtin_expect(__any(rm>(float)THRL),0)){ const float dl=__builtin_fmaxf(rm,0.f); mhat+=dl; \
        _Pragma("unroll") for(int r=0;r<16;++r){C0[r]-=dl;C1[r]-=dl;} \
        _Pragma("unroll") for(int r=0;r<16;++r)negm[r]=-mhat; asm volatile("":"+v"(negm)); \
        const float f=__builtin_amdgcn_exp2f(-dl); l_reg*=f; if(hi==0)wsf[r32]=f; resc=true; } } \
    SBAR(); \
    GAPB(o[0]=__builtin_amdgcn_mfma_f32_32x32x16_bf16(PAF(0),VFR(0),o[0],0,0,0), C0,0); \
    GAPB(o[1]=__builtin_amdgcn_mfma_f32_32x32x16_bf16(PAF(0),VFR(4),o[1],0,0,0), C0,4); \
    KRD(GL,0); GAPB(o[0]=__builtin_amdgcn_mfma_f32_32x32x16_bf16(PAF(1),VFR(1),o[0],0,0,0), C0,8); \
    KRD(GL,1); GAPB(o[1]=__builtin_amdgcn_mfma_f32_32x32x16_bf16(PAF(1),VFR(5),o[1],0,0,0), C0,12); \
    KRD(GL,2); GAPB(o[0]=__builtin_amdgcn_mfma_f32_32x32x16_bf16(PAF(2),VFR(2),o[0],0,0,0), C1,0); \
    KRD(GL,3); GAPB(o[1]=__builtin_amdgcn_mfma_f32_32x32x16_bf16(PAF(2),VFR(6),o[1],0,0,0), C1,4); \
    GAPB(o[0]=__builtin_amdgcn_mfma_f32_32x32x16_bf16(PAF(3),VFR(3),o[0],0,0,0), C1,8); \
    GAPB(o[1]=__builtin_amdgcn_mfma_f32_32x32x16_bf16(PAF(3),VFR(7),o[1],0,0,0), C1,12); \
    }while(0)
  int t=1;
  #undef CMASK
  #define CMASK(P0,P1,t) do{}while(0)
  for(;t+5<NT;t+=2){
    STEP(pB0,pB1,pA0,pA1,t,true,true,true);     WAIT_BAR(2); RESC(); ROT();
    STEP(pA0,pA1,pB0,pB1,t+1,true,true,true);   WAIT_BAR(2); RESC(); ROT();
  }
  #undef CMASK
  #define CMASK(P0,P1,t) do{}while(0)
  #define ENDW(tt) do{ if((tt)+3<NT){WAIT_BAR(2);} else if((tt)+2<NT){WAIT_BAR(1);} else {WAIT_BAR(0);} }while(0)
  for(;t+1<NT;t+=2){
    STEP(pB0,pB1,pA0,pA1,t,(t+3<NT),(t+1<NT),(t+1<NT));       ENDW(t);   RESC(); ROT();
    STEP(pA0,pA1,pB0,pB1,t+1,(t+4<NT),(t+2<NT),(t+2<NT));     ENDW(t+1); RESC(); ROT();
  }
  STEP(pB0,pB1,pA0,pA1,NT-1,false,false,false); RESC();
  { float sacc=pB0[0]+pB0[1]; _Pragma("unroll") for(int r=2;r<16;++r)sacc+=pB0[r]; _Pragma("unroll") for(int r=0;r<16;++r)sacc+=pB1[r]; l_reg+=sacc;
    pw0=(u32x4){PKW(pB0,0),PKW(pB0,2),PKW(pB0,4),PKW(pB0,6)};pw1=(u32x4){PKW(pB0,8),PKW(pB0,10),PKW(pB0,12),PKW(pB0,14)};pw2=(u32x4){PKW(pB1,0),PKW(pB1,2),PKW(pB1,4),PKW(pB1,6)};pw3=(u32x4){PKW(pB1,8),PKW(pB1,10),PKW(pB1,12),PKW(pB1,14)};
    SBAR(); pv(o,vb0+sl_cur,PAF(0),PAF(1),PAF(2),PAF(3)); }
  #undef PKW
  #undef PAF
  #undef VFR
  #undef PIN
  #undef MX3
  #undef GAPA
  #undef GAPB
  #undef EX
  #undef VRD
  #undef KRD
  #undef STEP
  #undef ENDW
  {auto rr=__builtin_amdgcn_permlane32_swap(__float_as_uint(l_reg),__float_as_uint(l_reg),false,false);l_reg=__uint_as_float(rr[0])+__uint_as_float(rr[1]);}
  if(hi==0)wsf[32+r32]=l_reg;asm volatile("s_waitcnt lgkmcnt(0)":::"memory");
  float rli[16];
  #pragma unroll
  for(int r=0;r<16;++r)rli[r]=__builtin_amdgcn_rcpf(wsf[32+crow(r,hi)]);
  bf16*Ow=O+(qrow0+wid*QBLK)*DM+hcol;
  { bf16*stg=(bf16*)(shm+LDS_OST)+wid*2048;
    #pragma unroll
    for(int r=0;r<16;++r){const int orow=crow(r,hi);
      #pragma unroll
      for(int d0=0;d0<2;++d0)stg[orow*64+d0*32+r32]=__float2bfloat16(o[d0][r]*rli[r]);}
    asm volatile("s_waitcnt lgkmcnt(0)":::"memory");
    #pragma unroll
    for(int i=0;i<4;++i){const int row=i*8+(lane>>3),ch=lane&7; const u32x4 v=*(const u32x4*)(stg+row*64+ch*8); ATTN_STORE16(Ow+(long)row*DM+ch*8,v);} }
  asm volatile("s_waitcnt lgkmcnt(0)\n\ts_barrier":::"memory");
  #undef DMA_K
  #undef DMA_V
  #undef CMASK
  #undef START
  #undef RESC
  #undef ROT
}
constexpr int ATTN_LDS_BYTES=LDS_BYTES;
#undef SBAR
#undef WAIT_BAR
}
#define GAS __attribute__((address_space(1)))
#define LAS __attribute__((address_space(3)))
typedef unsigned short bf16;
typedef unsigned v4u __attribute__((ext_vector_type(4)));
typedef float f32x4 __attribute__((ext_vector_type(4)));
typedef short bf16x8 __attribute__((ext_vector_type(8)));
typedef GAS unsigned gu32;
typedef GAS unsigned long long gu64;
#define RLX_AGENT __ATOMIC_RELAXED, __HIP_MEMORY_SCOPE_AGENT
#define LDS_WAIT() asm volatile("s_waitcnt lgkmcnt(0)" ::: "memory")
#define VM_WAIT() asm volatile("s_waitcnt vmcnt(0)" ::: "memory")
__device__ __forceinline__ unsigned long long rt() { return __builtin_amdgcn_s_memrealtime(); }
__device__ __forceinline__ unsigned f2bf(float f) { unsigned u = __builtin_bit_cast(unsigned, f); return (u + 0x7fffu + ((u >> 16) & 1u)) >> 16; }
__device__ __forceinline__ unsigned pk2(float lo, float hi) { return f2bf(lo) | (f2bf(hi) << 16); }

#define XB_TMO      128
#define XB_XCNT(j)  (256  + 64 * (j))
#define XB_XSUB(j)  (1280 + 64 * (j))
#define XB_XGEN(j)  (2304 + 64 * (j))
#define XB_TOP      3328
#define XB_TOPGEN   3392
#define XCD_BAR_WORDS 3456
#define XB_SPIN_CAP (1u << 18)

__device__ __forceinline__ unsigned xb_ld(unsigned* p)              { return __hip_atomic_load(p, __ATOMIC_RELAXED, __HIP_MEMORY_SCOPE_AGENT); }
__device__ __forceinline__ unsigned xb_add(unsigned* p, unsigned v) { return __hip_atomic_fetch_add(p, v, __ATOMIC_RELAXED, __HIP_MEMORY_SCOPE_AGENT); }
__device__ __forceinline__ unsigned xb_xcc_id() { return (unsigned)__builtin_amdgcn_s_getreg((3 << 11) | 20) & 0xFu; }
#define XB_SPIN(cond, bar) do { unsigned _sp = 0; while (cond) { __builtin_amdgcn_s_sleep(1); \
    if ((++_sp & 255u) == 0u) { if (xb_ld(&(bar)[XB_TMO])) break; if (_sp > XB_SPIN_CAP) { atomicAdd(&(bar)[XB_TMO], 1u); break; } } } } while (0)

struct XcdBarrier {
    unsigned* bar; unsigned x; int wv;
    volatile LAS unsigned* st;
};

__device__ __forceinline__ XcdBarrier xcd_barrier_post(unsigned* bar, volatile LAS unsigned* st, int wv) {
    XcdBarrier b; b.bar = bar; b.x = xb_xcc_id(); b.st = st; b.wv = wv;
    if (threadIdx.x == 0) (void)xb_add(&bar[XB_XCNT(b.x)], 1u);
    return b;
}
__device__ __forceinline__ void xcd_barrier_complete(unsigned* bar, unsigned x, unsigned& nloc, unsigned& nx) {
    const unsigned G = gridDim.x * gridDim.y * gridDim.z;
    unsigned sum, cnt, mine, sp = 0u;
    for (;;) {
        sum = 0u; cnt = 0u; mine = 0u;
#pragma unroll
        for (unsigned j = 0; j < 16; ++j) { const unsigned c = xb_ld(&bar[XB_XCNT(j)]); sum += c; cnt += (c > 0u) ? 1u : 0u; mine = (j == x) ? c : mine; }
        if (sum == G) break;
        __builtin_amdgcn_s_sleep(1);
        if ((++sp & 255u) == 0u) { if (xb_ld(&bar[XB_TMO])) break; if (sp > XB_SPIN_CAP) { atomicAdd(&bar[XB_TMO], 1u); break; } }
    }
    nloc = mine > 0u ? mine : 1u; nx = cnt > 0u ? cnt : 1u;
}

__device__ __forceinline__ void xcd_barrier(const XcdBarrier& b) {
    asm volatile("s_waitcnt vmcnt(0)" ::: "memory");
    __syncthreads();
    if (b.wv == 0 && hw_lane() == 0) {
        unsigned* bar = b.bar;
        __builtin_amdgcn_s_waitcnt(0);
        unsigned nloc = b.st[0], nx = b.st[1];
        if (nloc == 0u) { xcd_barrier_complete(bar, b.x, nloc, nx); b.st[0] = nloc; b.st[1] = nx; }
        const unsigned old = xb_add(&bar[XB_XSUB(b.x)], 1u);
        const unsigned gen = old / nloc;
        if (old + 1u == (gen + 1u) * nloc) {
            __builtin_amdgcn_fence(__ATOMIC_RELEASE, "agent");
            asm volatile("s_waitcnt vmcnt(0)" ::: "memory");
            const unsigned og = xb_add(&bar[XB_TOP], 1u);
            const unsigned tg = og / nx;
            if (og + 1u == (tg + 1u) * nx) xb_add(&bar[XB_TOPGEN], 1u);
            else XB_SPIN(xb_ld(&bar[XB_TOPGEN]) == tg, bar);
            __builtin_amdgcn_fence(__ATOMIC_ACQUIRE, "agent");
            xb_add(&bar[XB_XGEN(b.x)], 1u);
            asm volatile("s_waitcnt vmcnt(0)" ::: "memory");
        } else {
            XB_SPIN(xb_ld(&bar[XB_XGEN(b.x)]) == gen, bar);
            __builtin_amdgcn_fence(__ATOMIC_ACQUIRE, "agent");
            asm volatile("s_waitcnt vmcnt(0)" ::: "memory");
        }
    }
    __syncthreads();
}

#ifndef PROBE
#define PROBE 0
#endif
#ifndef DEBUG_NAN
#define DEBUG_NAN 0
#endif
#ifndef TSEL
#define TSEL -1
#endif
#ifndef CYSEL
#define CYSEL -1
#endif
#ifndef TSCALE10
#define TSCALE10 0
#endif
#if TSEL >= 0
#define TS(k) do { if (blockIdx.x == 0 && F.wave == 0 && hw_lane() == 0) { unsigned long long* ts_ = (unsigned long long*)(F.ws + WS_CTL + 32768); const unsigned long long now_ = __builtin_amdgcn_s_memrealtime(); ts_[1 + (k)] += now_ - ts_[0]; ts_[0] = now_; } } while (0)
#else
#define TS(k) do {} while (0)
#endif
#ifndef USE_SEQ_SCAN
#define USE_SEQ_SCAN 0
#endif
constexpr int NWAVES = 8;
constexpr int DMODEL = 1024, NBATCH = 8, SEQL = 4096, CTXL = 256, DEPTH = 4;
constexpr int TL = NBATCH * SEQL, TC = NBATCH * CTXL, TT = TL + TC;
constexpr int KVLEN = SEQL + CTXL;
constexpr int INW = 2688, INWP = 2816, ATTIN = 768, SHIFTW = 1920;
constexpr int FFD = 2816, FFE = 3584, NEXP = 8;
constexpr int LORA_K = 384, LORA_N = 2560;
constexpr int MAXPANEL = 280, MAXSLOT = MAXPANEL * 256;
constexpr float RMS_EPS = 1e-6f, GN_EPS = 64e-5f;

constexpr size_t MiB = 1u << 20;
constexpr size_t WS_CTL = 0, CTL_ZERO_BYTES = 64 * 1024;
constexpr size_t WS_MOD = 1 * MiB;
constexpr size_t WS_ROPE = 2 * MiB;
constexpr size_t WS_ROUTE = 3 * MiB;
constexpr size_t RT_E = 0, RT_G = 160 * 1024, RT_S = 448 * 1024, RT_BLK = 768 * 1024, RT_WCNT = 800 * 1024;
constexpr size_t WS_XB = 12 * MiB;
constexpr size_t WS_WIN = 80 * MiB, WS_WOUT = 86 * MiB, WS_WLORA = 88 * MiB;
constexpr size_t WS_WFF = 100 * MiB;
constexpr size_t WS_WFF_D_DENSE = WS_WFF + 12 * MiB, WS_WFF_D_MOE = WS_WFF + 112 * MiB;
constexpr size_t WS_ACT = 270 * MiB;
constexpr size_t WS_QO = WS_ACT, WS_KB = WS_ACT + 68 * MiB, WS_VB = WS_ACT + 77 * MiB, WS_P = WS_ACT + 86 * MiB, WS_OSC = WS_P;
constexpr size_t WS_R = WS_ACT + 273 * MiB, WS_K = WS_ACT + 307 * MiB, WS_V = WS_ACT + 341 * MiB, WS_KK = WS_ACT + 375 * MiB, WS_LIN = WS_ACT + 409 * MiB;
constexpr size_t WS_LOUT = WS_ACT + 435 * MiB;
constexpr size_t WS_SPT = WS_WFF, WS_SG = WS_WFF + 68 * MiB, WS_SQ = WS_ACT + 605 * MiB;
constexpr size_t WS_HID = WS_ACT;
constexpr size_t WS_AG = WS_ACT, WS_AG8 = WS_ACT + 140 * MiB, WS_HIDM = WS_ACT + 210 * MiB;
constexpr size_t WS_WFF_D_MOE8 = WS_WFF + 56 * MiB;
constexpr float W8SCALE = 64.0f, H8SCALE = 8.0f, HID8SCALE = 4.0f;
constexpr size_t WS_SIDE = 1000 * MiB;
constexpr size_t WS_END = 1012 * MiB;
static_assert(WS_LOUT + (size_t)TT * LORA_N * 2 <= WS_END && WS_HIDM + (size_t)MAXSLOT * FFE <= WS_END && WS_P + (size_t)TT * INWP * 2 <= WS_R && WS_OSC + (size_t)2 * TT * 512 * 4 <= WS_R, "ws map");
static_assert(WS_WFF_D_MOE + (size_t)NEXP * 1024 * FFE * 2 <= WS_ACT && WS_XB + (size_t)TT * 1024 * 2 <= WS_WIN && WS_WIN + (size_t)INWP * 1024 * 2 <= WS_WOUT && WS_WLORA + (size_t)LORA_N * LORA_K * 2 <= WS_WFF, "ws map 2");
constexpr int CW_BAR = 4096;

constexpr int RING_OFF = 0, RING_BYTES = 131072;
constexpr int LDSCTL_OFF = RING_BYTES;
constexpr int MISC_OFF = LDSCTL_OFF;
constexpr int LT_PEXP = LDSCTL_OFF + 256;
constexpr int LT_NPAN = LT_PEXP + 320 * 4;
constexpr int LT_INP = LT_NPAN + 64;
constexpr int LT_TMP = LT_INP + 256;
constexpr int LDS_BYTES = 147456;
static_assert(LT_TMP + 8192 + 1024 <= LDS_BYTES, "LDS map");

struct Frame {
    LAS unsigned char* lds;
    volatile LAS unsigned* MISC;
    gu32* ctl;
    int tid, lane, wave, vcu, G;
    unsigned char* ws;
    float* out;
};
struct Args { const float* in[30]; float* out; unsigned char* ws; };
__device__ __forceinline__ const void* inp_ld(const Frame& F, int k) {
    const LAS unsigned* t = (const LAS unsigned*)(F.lds + LT_INP) + 2 * k; unsigned lo = t[0], hi = t[1];
    lo = __builtin_amdgcn_readfirstlane(lo); hi = __builtin_amdgcn_readfirstlane(hi);
    return (const void*)(const GAS void*)(((unsigned long long)hi << 32) | lo);
}
#define IN_X 0
#define IN_C 1
#define IN_CTX 2
#define IN_CCTX 3
#define IN_ADAW 4
#define IN_ADAB 5
#define IN_N1G 6
#define IN_N2G 7
#define IN_WIN 8
#define IN_WOUT 9
#define IN_QG 10
#define IN_KG 11
#define IN_MU 12
#define IN_W0 13
#define IN_W2 14
#define IN_A0 15
#define IN_A2 16
#define IN_G2 17
#define IN_KKW 18
#define IN_KA 19
#define IN_RK 20
#define IN_GNW 21
#define IN_GNB 22
#define IN_FWG 23
#define IN_FWU 24
#define IN_FWD 25
#define IN_ROUTER 26
#define IN_MWG 27
#define IN_MWU 28
#define IN_MWD 29

__device__ __forceinline__ int vlaunder(int v) { asm volatile("" : "+v"(v)); return v; }
__device__ __forceinline__ unsigned char* launder(unsigned char* p) { unsigned long long v = (unsigned long long)p; asm volatile("" : "+s"(v)); return (unsigned char*)(GAS unsigned char*)v; }
#define INP(k) ((const float*)inp_ld(F, (k)))
__device__ __forceinline__ const void* inp_ld(const struct Frame& F, int k);
__device__ __forceinline__ float wave_sum(float v) {
#pragma unroll
    for (int o = 1; o < 64; o <<= 1) v += __shfl_xor(v, o);
    return v;
}
__device__ __forceinline__ float half_sum(float v) {
#pragma unroll
    for (int o = 1; o < 32; o <<= 1) v += __shfl_xor(v, o);
    return v;
}
__device__ __forceinline__ float bflo(unsigned w) { return __builtin_bit_cast(float, w << 16); }
__device__ __forceinline__ float bfhi(unsigned w) { return __builtin_bit_cast(float, w & 0xffff0000u); }
typedef float f32x2_t_ __attribute__((ext_vector_type(2))); typedef __bf16 bf16x2_t_ __attribute__((ext_vector_type(2)));
__device__ __forceinline__ unsigned pkbf(float lo, float hi) { f32x2_t_ v = {lo, hi}; bf16x2_t_ b = __builtin_convertvector(v, bf16x2_t_); return __builtin_bit_cast(unsigned, b); }
__device__ __forceinline__ float sigm(float x) { return __builtin_amdgcn_rcpf(1.0f + __builtin_amdgcn_exp2f(-1.4426950408889634f * x)); }

__device__ __forceinline__ void p_prologue(Frame& F, const Args& A) {
    unsigned char* const ws = launder(F.ws);
    const int tid = (F.wave * 64 + hw_lane()), lane = tid & 63; (void)lane;
    LAS float* sc = (LAS float*)(F.lds + RING_OFF);
    for (int i = tid; i < 9 * 1024; i += NWAVES * 64) { const int b = i >> 10, k = i & 1023; const float v = (b < 8) ? INP(IN_C)[b * 1024 + k] : INP(IN_CCTX)[k]; sc[i] = v * sigm(v); }
    __syncthreads();
    const int gw = F.vcu * NWAVES + F.wave, NGW = F.G * NWAVES;
    float* mod = (float*)(ws + WS_MOD);
    for (int it = (int)blockIdx.x + F.G * F.wave; it < DEPTH * 96; it += NGW) {
        const int l = it / 96, j = (it % 96) * 64 + lane;
        const float* W = INP(IN_ADAW) + (size_t)l * 1024 * 6144 + j;
        float acc[9];
#pragma unroll
        for (int b = 0; b < 9; ++b) acc[b] = 0.f;
        for (int k = 0; k < 1024; k += 16) {
            float wv[16];
#pragma unroll
            for (int u = 0; u < 16; ++u) wv[u] = W[(size_t)(k + u) * 6144];
#pragma unroll
            for (int b = 0; b < 9; ++b)
#pragma unroll
                for (int u4 = 0; u4 < 4; ++u4) { const f32x4 s = *(const LAS f32x4*)(sc + b * 1024 + k + 4 * u4); acc[b] += (s[0] * wv[4 * u4] + s[1] * wv[4 * u4 + 1]) + (s[2] * wv[4 * u4 + 2] + s[3] * wv[4 * u4 + 3]); }
        }
        const float bias = INP(IN_ADAB)[l * 6144 + j];
#pragma unroll
        for (int b = 0; b < 9; ++b) mod[((size_t)l * 9 + b) * 6144 + j] = acc[b] + bias;
    }
    float* cs = (float*)(ws + WS_ROPE);
    for (int i = blockIdx.x * (NWAVES * 64) + tid; i < 4096 * 32; i += F.G * NWAVES * 64) {
        const int t = i >> 5, k = i & 31; const int pos = (k < 16) ? (t >> 6) : (t & 63);
        const float inv = powf(10000.0f, -(float)(2 * (k & 15)) / 32.0f); const float ang = (float)pos * inv;
        float s, c; sincosf(ang, &s, &c); cs[2 * i] = c; cs[2 * i + 1] = s;
    }
    __syncthreads();
}

struct WItem { const float* W; unsigned char* WT; int K, N, k0, n0, drow0, f8; };
__device__ __forceinline__ void tr_load(const WItem& w, float (&tv)[32], int lane) {
#pragma unroll
    for (int i = 0; i < 32; ++i) tv[i] = w.W[(size_t)(w.k0 + 2 * i + (lane >> 5)) * w.N + w.n0 + (lane & 31)];
}
__device__ __forceinline__ void tr_finish(const WItem& w, const float (&tv)[32], LAS float* scr, int lane) {
#pragma unroll
    for (int i = 0; i < 32; ++i) scr[(2 * i + (lane >> 5)) * 33 + (lane & 31)] = tv[i];
    LDS_WAIT(); asm volatile("" ::: "memory");
    if (w.f8) { const int c = lane & 3;
#pragma unroll
        for (int j = 0; j < 2; ++j) { const int n = (lane >> 2) + 16 * j; const LAS float* s = scr + (16 * c) * 33 + n;
            v4u o;
            o.x = pg8::pk_fp8x4(s[0 * 33] * W8SCALE, s[1 * 33] * W8SCALE, s[2 * 33] * W8SCALE, s[3 * 33] * W8SCALE); o.y = pg8::pk_fp8x4(s[4 * 33] * W8SCALE, s[5 * 33] * W8SCALE, s[6 * 33] * W8SCALE, s[7 * 33] * W8SCALE);
            o.z = pg8::pk_fp8x4(s[8 * 33] * W8SCALE, s[9 * 33] * W8SCALE, s[10 * 33] * W8SCALE, s[11 * 33] * W8SCALE); o.w = pg8::pk_fp8x4(s[12 * 33] * W8SCALE, s[13 * 33] * W8SCALE, s[14 * 33] * W8SCALE, s[15 * 33] * W8SCALE);
            *(v4u*)(w.WT + (size_t)(w.drow0 + n) * w.K + w.k0 + 16 * c) = o; }
    } else { const int c = lane & 7;
#pragma unroll
        for (int j = 0; j < 4; ++j) { const int n = (lane >> 3) + 8 * j; const LAS float* s = scr + (8 * c) * 33 + n;
            v4u o; o.x = pkbf(s[0 * 33], s[1 * 33]); o.y = pkbf(s[2 * 33], s[3 * 33]); o.z = pkbf(s[4 * 33], s[5 * 33]); o.w = pkbf(s[6 * 33], s[7 * 33]);
            *(v4u*)((bf16*)w.WT + (size_t)(w.drow0 + n) * w.K + w.k0 + 8 * c) = o; } }
    LDS_WAIT(); asm volatile("" ::: "memory");
}
__device__ __forceinline__ int gu_row(int n) { return 256 * (n >> 7) + (n & 127); }

__device__ __forceinline__ WItem wprep_decode(Frame& F, unsigned char* const ws, const int l, const int it) {
    constexpr int I_IN = 16 * (INW / 32), I_OUT = 16 * 32;
    const bool moe = (l & 1) != 0; const int j = l >> 1;
    constexpr int I_DG = 16 * (FFD / 32), I_MG = 16 * (FFE / 32);
    int r = it; WItem w;
    if (r < I_IN) { const int nb = r % (INW / 32), kb = r / (INW / 32); w = WItem{INP(IN_WIN) + (size_t)l * 1024 * INW, ws + WS_WIN, 1024, INW, kb * 64, nb * 32, nb * 32, 0}; return w; } r -= I_IN;
    if (r < I_OUT) { const int nb = r % 32, kb = r / 32; w = WItem{INP(IN_WOUT) + (size_t)l * 1024 * 1024, ws + WS_WOUT, 1024, 1024, kb * 64, nb * 32, nb * 32, 0}; return w; } r -= I_OUT;
    if (!moe) {
        if (r < I_DG) { const int nb = r % (FFD / 32), kb = r / (FFD / 32); w = WItem{INP(IN_FWG) + (size_t)j * 1024 * FFD, ws + WS_WFF, 1024, FFD, kb * 64, nb * 32, gu_row(nb * 32), 0}; return w; } r -= I_DG;
        if (r < I_DG) { const int nb = r % (FFD / 32), kb = r / (FFD / 32); w = WItem{INP(IN_FWU) + (size_t)j * 1024 * FFD, ws + WS_WFF, 1024, FFD, kb * 64, nb * 32, gu_row(nb * 32) + 128, 0}; return w; } r -= I_DG;
        { const int nb = r % 32, kb = r / 32; w = WItem{INP(IN_FWD) + (size_t)j * FFD * 1024, ws + WS_WFF_D_DENSE, FFD, 1024, kb * 64, nb * 32, nb * 32, 0}; return w; }
    }
    constexpr int I_MD = (FFE / 64) * 32; constexpr int PER = 2 * I_MG + I_MD; const int e = r / PER; r -= e * PER;
    unsigned char* WGU = ws + WS_WFF + (size_t)e * (2 * FFE) * 1024; unsigned char* WD = ws + WS_WFF_D_MOE8 + (size_t)e * 1024 * FFE;
    const size_t eo = ((size_t)j * NEXP + e) * 1024 * FFE;
    if (r < I_MG) { const int nb = r % (FFE / 32), kb = r / (FFE / 32); w = WItem{INP(IN_MWG) + eo, WGU, 1024, FFE, kb * 64, nb * 32, gu_row(nb * 32), 1}; return w; } r -= I_MG;
    if (r < I_MG) { const int nb = r % (FFE / 32), kb = r / (FFE / 32); w = WItem{INP(IN_MWU) + eo, WGU, 1024, FFE, kb * 64, nb * 32, gu_row(nb * 32) + 128, 1}; return w; } r -= I_MG;
    { const int nb = r % 32, kb = r / 32; w = WItem{INP(IN_MWD) + eo, WD, FFE, 1024, kb * 64, nb * 32, nb * 32, 1}; return w; }
}
__device__ __forceinline__ void p_wprep(Frame& F, const Args& A, int l, int part, gu32* ctr = nullptr) {
    unsigned char* const ws = launder(F.ws);
    const int tid = (F.wave * 64 + hw_lane()), lane = tid & 63; (void)lane;
    LAS float* scr = (LAS float*)(F.lds + RING_OFF + F.wave * 16384);
    const int gw = F.vcu * NWAVES + F.wave, NGW = F.G * NWAVES;
    bf16* WIN = (bf16*)(ws + WS_WIN); bf16* WLORA = (bf16*)(ws + WS_WLORA);
    constexpr int I_IN = 16 * (INW / 32), I_OUT = 16 * 32;
    const bool moe = (l & 1) != 0;
    constexpr int I_DG = 16 * (FFD / 32), I_DD = (FFD / 64) * 32, I_MG = 16 * (FFE / 32), I_MD = (FFE / 64) * 32;
    const int nff = moe ? NEXP * (2 * I_MG + I_MD) : (2 * I_DG + I_DD);
    const int NIT = I_IN + I_OUT + nff;
    const int lo = part ? I_IN + I_OUT : 0, hi = part ? NIT : I_IN + I_OUT;
    (void)ctr;
    {
        int it = lo + gw; WItem wa, wb; float ta[32], tb[32];
        if (it < hi) { wa = wprep_decode(F, ws, l, it); tr_load(wa, ta, lane); }
        for (; it < hi; it += 2 * NGW) {
            const int i2 = it + NGW, i3 = i2 + NGW;
            if (i2 < hi) { wb = wprep_decode(F, ws, l, i2); tr_load(wb, tb, lane); }
            tr_finish(wa, ta, scr, lane);
            if (i3 < hi) { wa = wprep_decode(F, ws, l, i3); tr_load(wa, ta, lane); }
            if (i2 < hi) tr_finish(wb, tb, scr, lane);
        }
    }
    if (part) return;
    for (int i = blockIdx.x * (NWAVES * 64) + tid; i < 16384; i += F.G * NWAVES * 64) ((v4u*)(WIN + (size_t)INW * 1024))[i] = (v4u){0u, 0u, 0u, 0u};
    const float* w2 = INP(IN_W2) + (size_t)l * 2 * 64 * 512; const float* a2 = INP(IN_A2) + (size_t)l * 2 * 64 * 512; const float* g2 = INP(IN_G2) + (size_t)l * 128 * 512;
    for (int i = blockIdx.x * (NWAVES * 64) + tid; i < LORA_N * 64; i += F.G * NWAVES * 64) {
        const int n = i >> 6, k = (i & 63) * 2; const int sec = n >> 9, cn = n & 511;
        float v0 = 0.f, v1 = 0.f;
        if (sec < 2) { const int kk = k - 64 * sec; if (kk >= 0 && kk < 64) { v0 = w2[((size_t)sec * 64 + kk) * 512 + cn]; v1 = w2[((size_t)sec * 64 + kk + 1) * 512 + cn]; } }
        else if (sec < 4) { const int d = sec - 2, kk = k - 64 * d; if (kk >= 0 && kk < 64) { v0 = a2[((size_t)d * 64 + kk) * 512 + cn]; v1 = a2[((size_t)d * 64 + kk + 1) * 512 + cn]; } }
        else { v0 = g2[(size_t)k * 512 + cn]; v1 = g2[(size_t)(k + 1) * 512 + cn]; }
        ((unsigned*)WLORA)[i] = pkbf(v0, v1);
    }
}

template <bool ROUTER, bool COMBINE, bool SRCF32, bool SIDE = false>
__device__ __forceinline__ void p_norm(Frame& F, const Args& A, int l, int which, const float* srcL, const float* srcC, int lprev, int nrows = TT) {
    unsigned char* const ws = launder(F.ws);
    const int tid = (F.wave * 64 + hw_lane()), lane = tid & 63; (void)lane;
    const int gw = F.vcu * NWAVES + F.wave, NGW = F.G * NWAVES;
    const float* mod = (const float*)(ws + WS_MOD) + (size_t)l * 9 * 6144;
    const float* gain = A.in[which ? IN_N2G : IN_N1G] + l * 1024;
    bf16* H = (bf16*)F.out;
    const float* route_g = (const float*)(ws + WS_ROUTE + RT_G); const int* route_s = (const int*)(ws + WS_ROUTE + RT_S);
    int cnt0 = 0, cnt1 = 0, cnt2 = 0, cnt3 = 0, cnt4 = 0, cnt5 = 0, cnt6 = 0, cnt7 = 0;
    LAS float* rwl = (LAS float*)(F.lds + RING_OFF);
    if (ROUTER) {
        __syncthreads();
        const float* rw = INP(IN_ROUTER) + (size_t)(l >> 1) * 1024 * 8;
        for (int i = tid; i < 2048; i += NWAVES * 64) { const f32x4 w = *(const f32x4*)(rw + 4 * i); const int col = i >> 1, e4 = (i & 1) * 4, jj = col >> 8, ln = (col & 255) >> 2, q = col & 3;
            *(LAS f32x4*)(rwl + (((jj * 4 + q) * 64 + ln) * 8 + e4)) = w; }
        __syncthreads();
    }
    uint2 nx[2][4]; f32x4 nf[2][4]; float cg[2][2]; int cs[2][2];
#pragma unroll
    for (int r = 0; r < 2; ++r) { cg[r][0] = cg[r][1] = 0.f; cs[r][0] = cs[r][1] = 0;
#pragma unroll
        for (int jj = 0; jj < 4; ++jj) { nx[r][jj] = make_uint2(0u, 0u); nf[r][jj] = (f32x4){0.f, 0.f, 0.f, 0.f}; } }
#define PN_LOAD(r_, row_) do { const int row__ = (row_); if (row__ < nrows) { \
        if (SRCF32) { const float* xr_ = (row__ < TL) ? srcL + (size_t)row__ * 1024 : srcC + (size_t)(row__ - TL) * 1024; _Pragma("unroll") for (int jj = 0; jj < 4; ++jj) nf[r_][jj] = *(const f32x4*)(xr_ + 4 * ln + 256 * jj); } \
        else { const bf16* xr_ = (const bf16*)(ws + WS_XB) + (size_t)row__ * 1024; _Pragma("unroll") for (int jj = 0; jj < 4; ++jj) nx[r_][jj] = *(const uint2*)(xr_ + 4 * ln + 256 * jj); } \
        if (COMBINE) { cg[r_][0] = route_g[2 * row__]; cg[r_][1] = route_g[2 * row__ + 1]; cs[r_][0] = route_s[2 * row__]; cs[r_][1] = route_s[2 * row__ + 1]; } } } while (0)
    int ln = vlaunder(lane);
    PN_LOAD(0, gw); PN_LOAD(1, gw + NGW);
    for (int row0 = gw; row0 < nrows; row0 += 2 * NGW) {
        ln = vlaunder(lane);
        const bool ok1 = row0 + NGW < nrows;
        f32x4 v[2][4]; float g0[2], g1[2]; int s0[2], s1[2];
#pragma unroll
        for (int r = 0; r < 2; ++r) { g0[r] = cg[r][0]; g1[r] = cg[r][1]; s0[r] = cs[r][0]; s1[r] = cs[r][1];
#pragma unroll
            for (int jj = 0; jj < 4; ++jj) { if (SRCF32) v[r][jj] = nf[r][jj]; else { const uint2 w = nx[r][jj]; v[r][jj] = (f32x4){bflo(w.x), bfhi(w.x), bflo(w.y), bfhi(w.y)}; } } }
        PN_LOAD(0, row0 + 2 * NGW); PN_LOAD(1, row0 + 3 * NGW);
        if (COMBINE) {
            const bf16* Y = (const bf16*)(ws + WS_AG);
            uint2 yy0[2][4], yy1[2][4];
#pragma unroll
            for (int r = 0; r < 2; ++r)
#pragma unroll
                for (int jj = 0; jj < 4; ++jj) { const int col = 4 * ln + 256 * jj; yy0[r][jj] = *(const uint2*)(Y + (size_t)s0[r] * 1024 + col); yy1[r][jj] = *(const uint2*)(Y + (size_t)s1[r] * 1024 + col); }
#pragma unroll
            for (int r = 0; r < 2; ++r) { const int row = row0 + r * NGW; const int bsel = (row < TL) ? (row >> 12) : 8;
                const float* m5 = (const float*)(ws + WS_MOD) + ((size_t)lprev * 9 + bsel) * 6144 + 5 * 1024;
                bf16* xbr = (bf16*)(ws + WS_XB) + (size_t)row * 1024;
#pragma unroll
                for (int jj = 0; jj < 4; ++jj) { const int col = 4 * ln + 256 * jj;
                    const uint2 y0 = yy0[r][jj], y1 = yy1[r][jj]; const f32x4 mm = *(const f32x4*)(m5 + col);
                    v[r][jj][0] += mm[0] * (g0[r] * bflo(y0.x) + g1[r] * bflo(y1.x)); v[r][jj][1] += mm[1] * (g0[r] * bfhi(y0.x) + g1[r] * bfhi(y1.x));
                    v[r][jj][2] += mm[2] * (g0[r] * bflo(y0.y) + g1[r] * bflo(y1.y)); v[r][jj][3] += mm[3] * (g0[r] * bfhi(y0.y) + g1[r] * bfhi(y1.y));
                    if (r == 0 || ok1) *(uint2*)(xbr + col) = make_uint2(pkbf(v[r][jj][0], v[r][jj][1]), pkbf(v[r][jj][2], v[r][jj][3])); } }
        }
        if (SIDE) {
#pragma unroll
            for (int r = 0; r < 2; ++r) { const int row = row0 + r * NGW;
                if ((r == 0 || ok1) && row >= TL) {
                    const bf16* sd = (const bf16*)(ws + WS_SIDE) + (size_t)(row - TL) * 1024; bf16* xbr = (bf16*)(ws + WS_XB) + (size_t)row * 1024;
                    uint2 sv[3][4];
#pragma unroll
                    for (int q = 0; q < 3; ++q)
#pragma unroll
                        for (int jj = 0; jj < 4; ++jj) sv[q][jj] = *(const uint2*)(sd + (size_t)q * TC * 1024 + 4 * ln + 256 * jj);
#pragma unroll
                    for (int jj = 0; jj < 4; ++jj) {
#pragma unroll
                        for (int q = 0; q < 3; ++q) { const uint2 w = sv[q][jj]; v[r][jj][0] += bflo(w.x); v[r][jj][1] += bfhi(w.x); v[r][jj][2] += bflo(w.y); v[r][jj][3] += bfhi(w.y); }
                        *(uint2*)(xbr + 4 * ln + 256 * jj) = make_uint2(pkbf(v[r][jj][0], v[r][jj][1]), pkbf(v[r][jj][2], v[r][jj][3])); } } }
        }
        float ss[2];
#pragma unroll
        for (int r = 0; r < 2; ++r) { ss[r] = 0.f;
#pragma unroll
            for (int jj = 0; jj < 4; ++jj) ss[r] += (v[r][jj][0] * v[r][jj][0] + v[r][jj][1] * v[r][jj][1]) + (v[r][jj][2] * v[r][jj][2] + v[r][jj][3] * v[r][jj][3]); }
#pragma unroll
        for (int o = 1; o < 64; o <<= 1) { const float t0 = __shfl_xor(ss[0], o), t1 = __shfl_xor(ss[1], o); ss[0] += t0; ss[1] += t1; }
        float rstd[2]; const float* shp[2];
#pragma unroll
        for (int r = 0; r < 2; ++r) { const int row = row0 + r * NGW; const int bsel = (row < TL) ? (row >> 12) : 8;
            rstd[r] = 1.0f / sqrtf(ss[r] * (1.0f / 1024.0f) + RMS_EPS); shp[r] = mod + (size_t)bsel * 6144 + (which ? 3 : 0) * 1024; }
        float lg[2][8];
#pragma unroll
        for (int r = 0; r < 2; ++r)
#pragma unroll
            for (int e = 0; e < 8; ++e) lg[r][e] = 0.f;
#pragma unroll
        for (int jj = 0; jj < 4; ++jj) { const int col = 4 * ln + 256 * jj;
            const f32x4 gg = *(const f32x4*)(gain + col); f32x4 h[2];
#pragma unroll
            for (int r = 0; r < 2; ++r) { const int row = row0 + r * NGW;
                const f32x4 sh = *(const f32x4*)(shp[r] + col), sc = *(const f32x4*)(shp[r] + 1024 + col);
                h[r] = (v[r][jj] * rstd[r]) * gg * (sc + 1.0f) + sh;
                if (r == 0 || ok1) {
                    if (ROUTER) *(unsigned*)((unsigned char*)H + (size_t)row * 1024 + col) = pg8::pk_fp8x4(h[r][0] * H8SCALE, h[r][1] * H8SCALE, h[r][2] * H8SCALE, h[r][3] * H8SCALE);
                    else { uint2 o; o.x = pkbf(h[r][0], h[r][1]); o.y = pkbf(h[r][2], h[r][3]); *(uint2*)(H + (size_t)row * 1024 + col) = o; } } }
            if (ROUTER) {
#pragma unroll
                for (int q = 0; q < 4; ++q) { const LAS float* rp = rwl + ((jj * 4 + q) * 64 + ln) * 8; const f32x4 ra = *(const LAS f32x4*)rp, rb = *(const LAS f32x4*)(rp + 4);
#pragma unroll
                    for (int r = 0; r < 2; ++r) { lg[r][0] += h[r][q] * ra[0]; lg[r][1] += h[r][q] * ra[1]; lg[r][2] += h[r][q] * ra[2]; lg[r][3] += h[r][q] * ra[3];
                        lg[r][4] += h[r][q] * rb[0]; lg[r][5] += h[r][q] * rb[1]; lg[r][6] += h[r][q] * rb[2]; lg[r][7] += h[r][q] * rb[3]; } } }
        }
        if (ROUTER) {
#pragma unroll
            for (int o = 1; o < 64; o <<= 1) { float t[2][8];
#pragma unroll
                for (int r = 0; r < 2; ++r)
#pragma unroll
                    for (int e = 0; e < 8; ++e) t[r][e] = __shfl_xor(lg[r][e], o);
#pragma unroll
                for (int r = 0; r < 2; ++r)
#pragma unroll
                    for (int e = 0; e < 8; ++e) lg[r][e] += t[r][e]; }
#pragma unroll
            for (int r = 0; r < 2; ++r) { const int row = row0 + r * NGW;
                if (r == 0 || ok1) {
                    int e0 = 0; float v0 = lg[r][0];
#pragma unroll
                    for (int e = 1; e < 8; ++e) if (lg[r][e] > v0) { v0 = lg[r][e]; e0 = e; }
                    int e1 = -1; float v1 = -INFINITY;
#pragma unroll
                    for (int e = 0; e < 8; ++e) if (e != e0 && lg[r][e] > v1) { v1 = lg[r][e]; e1 = e; }
                    const float q0 = 1.0f / (1.0f + __expf(v1 - v0)), q1 = 1.0f - q0;
                    if (ln == 0) { ((int*)(ws + WS_ROUTE + RT_E))[row] = e0 | (e1 << 8); ((float*)(ws + WS_ROUTE + RT_G))[2 * row] = q0; ((float*)(ws + WS_ROUTE + RT_G))[2 * row + 1] = q1; }
                    cnt0 += (e0 == 0) + (e1 == 0); cnt1 += (e0 == 1) + (e1 == 1); cnt2 += (e0 == 2) + (e1 == 2); cnt3 += (e0 == 3) + (e1 == 3);
                    cnt4 += (e0 == 4) + (e1 == 4); cnt5 += (e0 == 5) + (e1 == 5); cnt6 += (e0 == 6) + (e1 == 6); cnt7 += (e0 == 7) + (e1 == 7); } }
        }
    }
#undef PN_LOAD
    if (ROUTER) {
        int* wcnt = (int*)(ws + WS_ROUTE + RT_WCNT);
        if (ln == 0) { int* w = wcnt + (size_t)gw * 8; w[0] = cnt0; w[1] = cnt1; w[2] = cnt2; w[3] = cnt3; w[4] = cnt4; w[5] = cnt5; w[6] = cnt6; w[7] = cnt7; }
    }
}
__device__ __forceinline__ void p_final_combine(Frame& F, int lprev) {
    unsigned char* const ws = launder(F.ws);
    const int tid = (F.wave * 64 + hw_lane()), lane = tid & 63; (void)lane;
    const int gw = F.vcu * NWAVES + F.wave, NGW = F.G * NWAVES;
    const float* route_g = (const float*)(ws + WS_ROUTE + RT_G); const int* route_s = (const int*)(ws + WS_ROUTE + RT_S);
    const bf16* Y = (const bf16*)(ws + WS_AG);
    float g0n = 0.f, g1n = 0.f; int s0n = 0, s1n = 0;
    if (gw < TL) { g0n = route_g[2 * gw]; g1n = route_g[2 * gw + 1]; s0n = route_s[2 * gw]; s1n = route_s[2 * gw + 1]; }
    for (int row = gw; row < TL; row += NGW) {
        const int bsel = row >> 12;
        const float* m5 = (const float*)(ws + WS_MOD) + ((size_t)lprev * 9 + bsel) * 6144 + 5 * 1024;
        const float g0 = g0n, g1 = g1n; const int s0 = s0n, s1 = s1n;
        float* xw = F.out + (size_t)row * 1024; const bf16* xbr = (const bf16*)(ws + WS_XB) + (size_t)row * 1024;
        uint2 xw2[4], y0[4], y1[4];
#pragma unroll
        for (int jj = 0; jj < 4; ++jj) { const int col = 4 * lane + 256 * jj; xw2[jj] = *(const uint2*)(xbr + col); y0[jj] = *(const uint2*)(Y + (size_t)s0 * 1024 + col); y1[jj] = *(const uint2*)(Y + (size_t)s1 * 1024 + col); }
        if (row + NGW < TL) { const int rn = row + NGW; g0n = route_g[2 * rn]; g1n = route_g[2 * rn + 1]; s0n = route_s[2 * rn]; s1n = route_s[2 * rn + 1]; }
#pragma unroll
        for (int jj = 0; jj < 4; ++jj) { const int col = 4 * lane + 256 * jj; const f32x4 mm = *(const f32x4*)(m5 + col);
            f32x4 v = (f32x4){bflo(xw2[jj].x), bfhi(xw2[jj].x), bflo(xw2[jj].y), bfhi(xw2[jj].y)};
            v[0] += mm[0] * (g0 * bflo(y0[jj].x) + g1 * bflo(y1[jj].x)); v[1] += mm[1] * (g0 * bfhi(y0[jj].x) + g1 * bfhi(y1[jj].x));
            v[2] += mm[2] * (g0 * bflo(y0[jj].y) + g1 * bflo(y1[jj].y)); v[3] += mm[3] * (g0 * bfhi(y0[jj].y) + g1 * bfhi(y1[jj].y));
            *(f32x4*)(xw + col) = v; }
    }
}

__device__ __forceinline__ void p_prep(Frame& F, const Args& A, int l) {
    unsigned char* const ws = launder(F.ws);
    const int tid = (F.wave * 64 + hw_lane()), lane = tid & 63; (void)lane;
    const int gw = F.vcu * NWAVES + F.wave, NGW = F.G * NWAVES;
    const unsigned* P = (const unsigned*)(ws + WS_P);
    const float* cs = (const float*)(ws + WS_ROPE);
    bf16* QO = (bf16*)(ws + WS_QO); bf16* KB = (bf16*)(ws + WS_KB); bf16* VB = (bf16*)(ws + WS_VB);
    unsigned* Rst = (unsigned*)(ws + WS_R); unsigned* Kst = (unsigned*)(ws + WS_K); unsigned* Vst = (unsigned*)(ws + WS_V); unsigned* KKst = (unsigned*)(ws + WS_KK); unsigned* LIN = (unsigned*)(ws + WS_LIN);
    const int d0 = 2 * (lane & 31);
    const float qg0 = INP(IN_QG)[l * 64 + d0], qg1 = INP(IN_QG)[l * 64 + d0 + 1], kg0 = INP(IN_KG)[l * 64 + d0], kg1 = INP(IN_KG)[l * 64 + d0 + 1];
    float mu0[15], mu1[15];
#pragma unroll
    for (int i = 0; i < 15; ++i) { mu0[i] = INP(IN_MU)[l * SHIFTW + 128 * i + 2 * lane]; mu1[i] = INP(IN_MU)[l * SHIFTW + 128 * i + 2 * lane + 1]; }
    float kw0[4], kw1[4];
#pragma unroll
    for (int i = 0; i < 4; ++i) { kw0[i] = INP(IN_KKW)[l * 512 + 128 * i + 2 * lane]; kw1[i] = INP(IN_KKW)[l * 512 + 128 * i + 2 * lane + 1]; }
    const float C2 = 0.125f * 1.4426950408889634f;
    const float sgn = (lane & 16) ? 1.0f : -1.0f;
    for (int w0 = gw; w0 * 17 < TT; w0 += NGW) {
        const int rbeg = w0 * 17;
        unsigned cur[21], nxt[21], prv[15];
#pragma unroll
        for (int i = 0; i < 15; ++i) prv[i] = 0u;
        {   const int r = rbeg; const bool lat = r < TL; const int pos = lat ? (r & 4095) : ((r - TL) & 255);
            if (pos != 0) {
#pragma unroll
                for (int i = 0; i < 15; ++i) prv[i] = P[(size_t)(r - 1) * (INWP / 2) + 64 * (i + 6) + lane]; }
#pragma unroll
            for (int i = 0; i < 21; ++i) cur[i] = P[(size_t)r * (INWP / 2) + 64 * i + lane];
        }
        for (int k = 0; k < 17; ++k) {
            const int r = rbeg + k; const bool lat = r < TL; const int pos = lat ? (r & 4095) : ((r - TL) & 255); const int slen = lat ? 4096 : 256;
            const bool has_next = (pos != slen - 1);
            const bool load_next = (k < 16) || has_next;
            if (load_next && r + 1 < TT) {
#pragma unroll
                for (int i = 0; i < 21; ++i) nxt[i] = P[(size_t)(r + 1) * (INWP / 2) + 64 * i + lane];
            } else {
#pragma unroll
                for (int i = 0; i < 21; ++i) nxt[i] = 0u;
            }
            const int b = lat ? (r >> 12) : ((r - TL) >> 8);
            const size_t kvrow = (size_t)b * KVLEN + (lat ? pos : 4096 + pos);
            f32x4 csv = (f32x4){1.f, 0.f, 1.f, 0.f};
            if (lat) csv = *(const f32x4*)(cs + ((size_t)pos * 32 + 2 * (lane & 15)) * 2);
#pragma unroll
            for (int i = 0; i < 5; ++i) {
                float x0 = bflo(cur[i]), x1 = bfhi(cur[i]);
                const float ss = half_sum(x0 * x0 + x1 * x1);
                const float rstd = 1.0f / sqrtf(ss * (1.0f / 64.0f) + RMS_EPS);
                x0 = x0 * rstd * (i < 4 ? qg0 : kg0); x1 = x1 * rstd * (i < 4 ? qg1 : kg1);
                const float p0 = __shfl_xor(x0, 16), p1 = __shfl_xor(x1, 16);
                const float y0 = x0 * csv[0] + sgn * p0 * csv[1], y1 = x1 * csv[2] + sgn * p1 * csv[3];
                if (i < 4) *(unsigned*)(QO + (size_t)r * 1024 + 128 * i + 2 * lane) = pkbf(y0 * C2, y1 * C2);
                else *(unsigned*)(KB + kvrow * 128 + 2 * lane) = pkbf(y0, y1);
            }
            *(unsigned*)(VB + kvrow * 128 + 2 * lane) = cur[5];
            const float hn = has_next ? 1.0f : 0.0f;
#pragma unroll
            for (int i = 0; i < 15; ++i) {
                const float c0 = bflo(cur[i + 6]), c1 = bfhi(cur[i + 6]);
                const float a0 = bflo(prv[i]) + hn * bflo(nxt[i + 6]), a1 = bfhi(prv[i]) + hn * bfhi(nxt[i + 6]);
                const float s0 = c0 + mu0[i] * (0.5f * a0 - c0), s1 = c1 + mu1[i] * (0.5f * a1 - c1);
                if (i < 4) Rst[(size_t)r * 256 + 64 * i + lane] = pkbf(s0, s1);
                else if (i < 8) { Kst[(size_t)r * 256 + 64 * (i - 4) + lane] = pkbf(s0, s1);
                    const float t0 = s0 * kw0[i - 4], t1 = s1 * kw1[i - 4]; const float q = half_sum(t0 * t0 + t1 * t1); const float rn = 1.0f / sqrtf(q + 1e-12f);
                    KKst[(size_t)r * 256 + 64 * (i - 4) + lane] = pkbf(t0 * rn, t1 * rn); }
                else if (i < 12) Vst[(size_t)r * 256 + 64 * (i - 8) + lane] = pkbf(s0, s1);
                else if (i == 12) { const float e0 = __builtin_amdgcn_exp2f(2.0f * 1.4426950408889634f * s0), e1 = __builtin_amdgcn_exp2f(2.0f * 1.4426950408889634f * s1);
                    LIN[(size_t)r * (LORA_K / 2) + lane] = pkbf(1.0f - 2.0f * __builtin_amdgcn_rcpf(1.0f + e0), 1.0f - 2.0f * __builtin_amdgcn_rcpf(1.0f + e1)); }
                else if (i == 13) LIN[(size_t)r * (LORA_K / 2) + 64 + lane] = pkbf(s0, s1);
                else LIN[(size_t)r * (LORA_K / 2) + 128 + lane] = pkbf(sigm(s0), sigm(s1));
            }
#pragma unroll
            for (int i = 0; i < 15; ++i) prv[i] = has_next ? cur[i + 6] : 0u;
#pragma unroll
            for (int i = 0; i < 21; ++i) cur[i] = nxt[i];
        }
    }
}

template <int CTRL> __device__ __forceinline__ float dppf(float v) { return __builtin_bit_cast(float, __builtin_amdgcn_update_dpp(0, __builtin_bit_cast(int, v), CTRL, 0xf, 0xf, true)); }
__device__ __forceinline__ float red16(float v) { v += dppf<0xB1>(v); v += dppf<0x4E>(v); v += dppf<0x141>(v); v += dppf<0x128>(v); return v; }
constexpr int SC_TS = 32, SC_W = 352;
__device__ __forceinline__ void p_scan(Frame& F, const Args& A, int l) {
    unsigned char* const ws = launder(F.ws);
    const int tid = (F.wave * 64 + hw_lane()), lane = tid & 63; (void)lane;
    LAS float* buf = (LAS float*)(F.lds + RING_OFF);
    float* OSC = (float*)(ws + WS_OSC);
    constexpr int NCH = KVLEN / SC_TS;
    for (int item = blockIdx.x; item < 256; item += F.G) {
        const int chain = item >> 1, rh = item & 1, dir = chain & 1, bh = chain >> 1, b = bh >> 3, h = bh & 7;
        const int row = tid >> 4, c = tid & 15;
        float S0 = 0.f, S1 = 0.f, S2 = 0.f, S3 = 0.f;
        const bool stg = tid < 352; const int sub = (tid >= 176) ? 1 : 0, pp = tid - 176 * sub, a = pp >> 5, w = pp & 31;
        const unsigned* p1; int pitch1 = 256;
        if (a == 0 || a == 2) p1 = (const unsigned*)(ws + WS_KK) + h * 32 + w;
        else if (a == 1) { p1 = (const unsigned*)(ws + WS_LOUT) + dir * 256 + h * 32 + w; pitch1 = LORA_N / 2; }
        else if (a == 3) p1 = (const unsigned*)(ws + WS_K) + h * 32 + w;
        else if (a == 4) p1 = (const unsigned*)(ws + WS_R) + h * 32 + w;
        else p1 = (const unsigned*)(ws + WS_V) + h * 32 + rh * 16 + (pp - 160);
        const unsigned* p2 = (const unsigned*)(ws + WS_LOUT) + 512 + dir * 256 + h * 32 + w;
        const bool two = (a == 2 || a == 3);
        const int cw = (a == 5) ? 0 : 2 * w;
        const float cw0 = INP(IN_W0)[l * 1024 + dir * 512 + h * 64 + cw], cw1 = INP(IN_W0)[l * 1024 + dir * 512 + h * 64 + cw + 1];
        const float ca0 = INP(IN_A0)[l * 1024 + dir * 512 + h * 64 + cw], ca1 = INP(IN_A0)[l * 1024 + dir * 512 + h * 64 + cw + 1];
        const float ck0 = INP(IN_KA)[l * 512 + h * 64 + cw], ck1 = INP(IN_KA)[l * 512 + h * 64 + cw + 1];
        unsigned st[16], st2[16];
#define SC_TOK(s) ((s) < CTXL ? (TL + b * CTXL + (dir ? (CTXL - 1 - (s)) : (s))) : (b * SEQL + (dir ? (SEQL - 1 - ((s) - CTXL)) : ((s) - CTXL))))
#define SC_LOAD(ci) do { if (stg) { _Pragma("unroll") for (int i = 0; i < 16; ++i) { const int s = (ci) * SC_TS + 2 * i + sub; const size_t tok = (size_t)SC_TOK(s); \
            st[i] = p1[tok * pitch1]; st2[i] = two ? p2[tok * (LORA_N / 2)] : 0u; } } } while (0)
#define SC_STORE(bi) do { if (stg) { _Pragma("unroll") for (int i = 0; i < 16; ++i) { \
            float x0 = bflo(st[i]), x1 = bfhi(st[i]); \
            if (a == 1) { x0 = __builtin_amdgcn_exp2f(-1.4426950408889634f * 0.6065306597126334f * sigm(x0 + cw0)); x1 = __builtin_amdgcn_exp2f(-1.4426950408889634f * 0.6065306597126334f * sigm(x1 + cw1)); } \
            else if (a == 2) { x0 *= sigm(bflo(st2[i]) + ca0); x1 *= sigm(bfhi(st2[i]) + ca1); } \
            else if (a == 3) { x0 *= 1.0f + (sigm(bflo(st2[i]) + ca0) - 1.0f) * ck0; x1 *= 1.0f + (sigm(bfhi(st2[i]) + ca1) - 1.0f) * ck1; } \
            LAS float* dp = buf + ((bi) * SC_TS + 2 * i + sub) * SC_W + 2 * pp; dp[0] = x0; dp[1] = x1; } } } while (0)
        __syncthreads();
        SC_LOAD(0); SC_STORE(0); __syncthreads();
        for (int ci = 0; ci < NCH; ++ci) {
            if (ci + 1 < NCH) SC_LOAD(ci + 1);
            const LAS float* bp = buf + (ci & 1) * SC_TS * SC_W;
#pragma unroll 2
            for (int stp = 0; stp < SC_TS; ++stp) {
                const LAS float* sp = bp + stp * SC_W;
                const f32x4 kk = *(const LAS f32x4*)(sp + 4 * c), w4 = *(const LAS f32x4*)(sp + 64 + 4 * c), bb = *(const LAS f32x4*)(sp + 128 + 4 * c), kd = *(const LAS f32x4*)(sp + 192 + 4 * c), rr = *(const LAS f32x4*)(sp + 256 + 4 * c);
                const float vv = sp[320 + row];
                float sa = (S0 * kk[0] + S1 * kk[1]) + (S2 * kk[2] + S3 * kk[3]); sa = red16(sa);
                S0 = S0 * w4[0] + (vv * kd[0] - sa * bb[0]); S1 = S1 * w4[1] + (vv * kd[1] - sa * bb[1]); S2 = S2 * w4[2] + (vv * kd[2] - sa * bb[2]); S3 = S3 * w4[3] + (vv * kd[3] - sa * bb[3]);
                float o = (S0 * rr[0] + S1 * rr[1]) + (S2 * rr[2] + S3 * rr[3]); o = red16(o);
                if (c == 0) { const int s = ci * SC_TS + stp; OSC[((size_t)dir * TT + (size_t)SC_TOK(s)) * 512 + h * 64 + rh * 32 + row] = o; }
            }
            if (ci + 1 < NCH) SC_STORE((ci + 1) & 1);
            __syncthreads();
        }
#undef SC_TOK
#undef SC_LOAD
#undef SC_STORE
    }
}

__device__ __forceinline__ void p_readout(Frame& F, const Args& A, int l) {
    unsigned char* const ws = launder(F.ws);
    const int tid = (F.wave * 64 + hw_lane()), lane = tid & 63; (void)lane;
    const int gw = F.vcu * NWAVES + F.wave, NGW = F.G * NWAVES;
    const float* OSC = (const float*)(ws + WS_OSC);
    const unsigned* Rst = (const unsigned*)(ws + WS_R); const unsigned* Vst = (const unsigned*)(ws + WS_V); const unsigned* Kst = (const unsigned*)(ws + WS_K); const unsigned* LOUT = (const unsigned*)(ws + WS_LOUT);
    bf16* QO = (bf16*)(ws + WS_QO);
    float rk0[4], rk1[4], gw0[4], gw1[4], gb0[4], gb1[4], ka0[4], ka1[4], aa0[4], aa1[4], ab0[4], ab1[4];
#pragma unroll
    for (int i = 0; i < 4; ++i) { const int cc = 128 * i + 2 * lane, cidx = l * 512 + cc; rk0[i] = INP(IN_RK)[cidx]; rk1[i] = INP(IN_RK)[cidx + 1]; gw0[i] = INP(IN_GNW)[cidx]; gw1[i] = INP(IN_GNW)[cidx + 1]; gb0[i] = INP(IN_GNB)[cidx]; gb1[i] = INP(IN_GNB)[cidx + 1];
        ka0[i] = INP(IN_KA)[cidx]; ka1[i] = INP(IN_KA)[cidx + 1]; aa0[i] = INP(IN_A0)[l * 1024 + cc]; aa1[i] = INP(IN_A0)[l * 1024 + cc + 1]; ab0[i] = INP(IN_A0)[l * 1024 + 512 + cc]; ab1[i] = INP(IN_A0)[l * 1024 + 512 + cc + 1]; }
    for (int row = gw; row < TT; row += NGW) {
#pragma unroll
        for (int i = 0; i < 4; ++i) {
            const size_t off = (size_t)row * 256 + 64 * i + lane; const size_t lo = (size_t)row * (LORA_N / 2) + 64 * i + lane;
            const float2 oa = *(const float2*)(OSC + (size_t)row * 512 + 128 * i + 2 * lane), ob = *(const float2*)(OSC + ((size_t)TT + row) * 512 + 128 * i + 2 * lane);
            const float o0 = oa.x + ob.x, o1 = oa.y + ob.y;
            const float mean = half_sum(o0 + o1) * (1.0f / 64.0f);
            const float d0 = o0 - mean, d1 = o1 - mean;
            const float var = half_sum(d0 * d0 + d1 * d1) * (1.0f / 64.0f);
            const float rs = 1.0f / sqrtf(var + GN_EPS);
            const unsigned rw = Rst[off], vw = Vst[off], kw = Kst[off], pa = LOUT[lo + 512], pb = LOUT[lo + 768], gwd = LOUT[lo + 1024];
            const float ks0 = bflo(kw) * (2.0f + (sigm(bflo(pa) + aa0[i]) + sigm(bflo(pb) + ab0[i]) - 2.0f) * ka0[i]), ks1 = bfhi(kw) * (2.0f + (sigm(bfhi(pa) + aa1[i]) + sigm(bfhi(pb) + ab1[i]) - 2.0f) * ka1[i]);
            const float bsum = half_sum(bflo(rw) * ks0 * rk0[i] + bfhi(rw) * ks1 * rk1[i]);
            const float y0 = d0 * rs * gw0[i] + gb0[i] + bsum * bflo(vw), y1 = d1 * rs * gw1[i] + gb1[i] + bsum * bfhi(vw);
            *(unsigned*)(QO + (size_t)row * 1024 + 512 + 128 * i + 2 * lane) = pkbf(y0 * bflo(gwd), y1 * bfhi(gwd));
        }
    }
}

__device__ __forceinline__ void p_route(Frame& F, int nrows) {
    unsigned char* const ws = launder(F.ws);
    const int tid = (F.wave * 64 + hw_lane()), lane = tid & 63; (void)lane;
    const int gw = F.vcu * NWAVES + F.wave, NGW = F.G * NWAVES;
    const int* wcnt = (const int*)(ws + WS_ROUTE + RT_WCNT);
    LAS int* pexp = (LAS int*)(F.lds + LT_PEXP); LAS int* npan = (LAS int*)(F.lds + LT_NPAN); LAS int* tmp = (LAS int*)(F.lds + LT_TMP);
    {   const int e = lane & 7, part = lane >> 3;
        const int p = F.wave * 8 + part;
        const int wb = p * (NGW / 64), we = wb + NGW / 64; const int myw0 = F.vcu * NWAVES;
        int tot = 0, before = 0;
#pragma unroll 16
        for (int w = wb; w < we; ++w) { const int cv = wcnt[(size_t)w * 8 + e]; tot += cv; if (w < myw0) before += cv; }
        tmp[p * 16 + e] = tot; tmp[p * 16 + 8 + e] = before;
    }
    __syncthreads();
    if (tid < 8) { int tot = 0, before = 0; for (int p = 0; p < 64; ++p) { tot += tmp[p * 16 + tid]; before += tmp[p * 16 + 8 + tid]; } tmp[1024 + tid] = tot; tmp[1032 + tid] = before; }
    __syncthreads();
    if (tid == 0) { int acc = 0; for (int e = 0; e < 8; ++e) { const int padded = (tmp[1024 + e] + 255) & ~255; tmp[1040 + e] = acc; acc += padded; tmp[1048 + e] = acc; } npan[0] = acc >> 8; }
    __syncthreads();
    for (int p = tid; p < 320; p += NWAVES * 64) { int e = 7; for (int q = 7; q >= 0; --q) if (p * 256 < tmp[1048 + q]) e = q; pexp[p] = e; }
    int base0, base1, base2, base3, base4, base5, base6, base7;
    {   int bsv[8];
#pragma unroll
        for (int e = 0; e < 8; ++e) bsv[e] = tmp[1040 + e] + tmp[1032 + e];
        typedef int i32x4 __attribute__((ext_vector_type(4)));
#pragma unroll
        for (int w = 0; w < 7; ++w) { const i32x4* wp = (const i32x4*)(wcnt + (size_t)(F.vcu * NWAVES + w) * 8); const i32x4 c0 = wp[0], c1 = wp[1]; const int mk = (w < F.wave) ? 1 : 0;
            bsv[0] += mk * c0[0]; bsv[1] += mk * c0[1]; bsv[2] += mk * c0[2]; bsv[3] += mk * c0[3]; bsv[4] += mk * c1[0]; bsv[5] += mk * c1[1]; bsv[6] += mk * c1[2]; bsv[7] += mk * c1[3]; }
        base0 = bsv[0]; base1 = bsv[1]; base2 = bsv[2]; base3 = bsv[3]; base4 = bsv[4]; base5 = bsv[5]; base6 = bsv[6]; base7 = bsv[7];
    }
    const int* route_e = (const int*)(ws + WS_ROUTE + RT_E); int* route_s = (int*)(ws + WS_ROUTE + RT_S);
    const unsigned char* H = (const unsigned char*)F.out; unsigned char* AG = ws + WS_AG8;
    int ee_n = 0; v4u a_n = (v4u){0u, 0u, 0u, 0u};
    if (gw < nrows) { ee_n = route_e[gw]; a_n = ((const v4u*)(H + (size_t)gw * 1024))[lane]; }
    for (int row = gw; row < nrows; row += NGW) {
        const int ee = ee_n; const v4u a = a_n; const int e0 = ee & 255, e1 = ee >> 8;
        if (row + NGW < nrows) { ee_n = route_e[row + NGW]; a_n = ((const v4u*)(H + (size_t)(row + NGW) * 1024))[lane]; }
        int s0 = 0, s1 = 0;
#define RT_TAKE(E, B) do { if (e0 == E) { s0 = B; B += 1; } if (e1 == E) { s1 = B; B += 1; } } while (0)
        RT_TAKE(0, base0); RT_TAKE(1, base1); RT_TAKE(2, base2); RT_TAKE(3, base3); RT_TAKE(4, base4); RT_TAKE(5, base5); RT_TAKE(6, base6); RT_TAKE(7, base7);
#undef RT_TAKE
        if (lane == 0) { route_s[2 * row] = s0; route_s[2 * row + 1] = s1; }
        ((v4u*)(AG + (size_t)s0 * 1024))[lane] = a; ((v4u*)(AG + (size_t)s1 * 1024))[lane] = a;
    }
    __syncthreads();
}

__device__ __forceinline__ void p_attn(Frame& F, char* ldsg, bool ctx_on) {
    unsigned char* const ws = launder(F.ws);
    const int tid = (F.wave * 64 + hw_lane()), lane = tid & 63; (void)lane;
    typedef attn_body::bf16 abf;
    const abf* Q = (const abf*)(ws + WS_QO); const abf* K = (const abf*)(ws + WS_KB); const abf* V = (const abf*)(ws + WS_VB); abf* O = (abf*)(ws + WS_QO);
    const int per = (1024 + F.G - 1) / F.G;
    for (int i = 0; i < per; ++i) { const int un = F.vcu * per + i; if (un >= 1024) break;
        const int bh = un >> 4, qb = un & 15, b = bh >> 3, h = bh & 7;
        attn_body::attn_unit<8>((long)b * SEQL + qb * 256, h * 64, (long)b * KVLEN, (h >> 2) * 64, KVLEN / 64, Q, K, V, O, ldsg, F.wave); }
    if (ctx_on) for (int un = F.vcu; un < 64; un += F.G) { const int b = un >> 3, h = un & 7;
        attn_body::attn_unit<8>((long)TL + b * CTXL, h * 64, (long)b * KVLEN + SEQL, (h >> 2) * 64, CTXL / 64, Q, K, V, O, ldsg, F.wave); }
}

typedef float f32x16 __attribute__((ext_vector_type(16)));
typedef unsigned u32x2 __attribute__((ext_vector_type(2)));
constexpr int SCH = 64, NCHK = KVLEN / SCH, NITEM = 128 * NCHK;
constexpr int LSTR = 144;
constexpr int L_AKK = 0, L_AR = 9216, L_AK = 18432, L_AB = 27648, L_TK = 36864, L_TB = 46080, L_TV = 55296, L_TW1 = 64512, L_TU = 73728, L_MLK = 82944, L_MMB = 92160, L_MMK = 101376;
constexpr int L_FLB = 110592, L_GC = 126976, L_TII = 127232, L_FX = L_AK;
static_assert(L_TII + 2048 <= RING_BYTES, "scan LDS map");
__device__ __forceinline__ unsigned short bf1(float x) { return (unsigned short)(pkbf(x, 0.f) & 0xffffu); }
__device__ __forceinline__ bf16x8 ldsv8(const LAS unsigned char* p) { return *(const LAS bf16x8*)p; }
template <bool SWA = false, bool SWB = false>
__device__ __forceinline__ f32x16 tile32(const LAS unsigned char* Ab, const LAS unsigned char* Bb, int mi, int ni, int r, int h, f32x16 acc) {
    const int ra = 32 * mi + r, rb = 32 * ni + r; const int xa = SWA ? ((ra >> 3) & 7) : 0, xb = SWB ? ((rb >> 3) & 7) : 0;
#pragma unroll
    for (int kb = 0; kb < 4; ++kb) { const bf16x8 a = ldsv8(Ab + ra * LSTR + (((2 * kb + h) ^ xa) << 4)), b = ldsv8(Bb + rb * LSTR + (((2 * kb + h) ^ xb) << 4));
        acc = __builtin_amdgcn_mfma_f32_32x32x16_bf16(a, b, acc, 0, 0, 0); }
    return acc;
}
__device__ __forceinline__ int jperm(int j) { return (((j >> 2) & 3) << 4) | (((j >> 5) & 1) << 3) | (((j >> 4) & 1) << 2) | (j & 3); }
#define CROW(reg, h) (((reg) & 3) + 8 * ((reg) >> 2) + 4 * (h))


#if DEBUG_NAN
#define DBG_BF(k, off, nbytes) do { unsigned bad_ = 0; for (int i_ = tid; i_ < (nbytes) / 2; i_ += 512) { const int row_ = i_ / 72, col_ = i_ % 72; if (col_ < 64) { const float v_ = __builtin_bit_cast(float, (unsigned)(*(const LAS unsigned short*)(L + (off) + row_ * LSTR + col_ * 2)) << 16); if (!(fabsf(v_) < 1e30f)) ++bad_; } } if (bad_) atomicAdd((unsigned*)(F.ctl + 16 + (k)), bad_); } while (0)
#define DBG_F32(k, off, n) do { unsigned bad_ = 0; for (int i_ = tid; i_ < (n); i_ += 512) { const float v_ = ((const LAS float*)(L + (off)))[i_]; if (!(fabsf(v_) < 1e30f)) ++bad_; } if (bad_) atomicAdd((unsigned*)(F.ctl + 16 + (k)), bad_); } while (0)
#else
#define DBG_BF(k, off, nbytes) do {} while (0)
#define DBG_F32(k, off, n) do {} while (0)
#endif
#define WG_BAR() do { asm volatile("s_waitcnt lgkmcnt(0)" ::: "memory"); __builtin_amdgcn_s_barrier(); asm volatile("" ::: "memory"); } while (0)
template <int CTRL, int RMASK> __device__ __forceinline__ float dppm(float v) { return __builtin_bit_cast(float, __builtin_amdgcn_update_dpp(0, __builtin_bit_cast(int, v), CTRL, RMASK, 0xf, true)); }
__device__ __forceinline__ float wave_incl_scan(float x) {
    x += dppm<0x111, 0xf>(x); x += dppm<0x112, 0xf>(x); x += dppm<0x114, 0xf>(x); x += dppm<0x118, 0xf>(x);
    x += __builtin_bit_cast(float, __builtin_amdgcn_update_dpp(0, __builtin_bit_cast(int, x), 0x142, 0xa, 0xf, false));
    x += __builtin_bit_cast(float, __builtin_amdgcn_update_dpp(0, __builtin_bit_cast(int, x), 0x143, 0xc, 0xf, false));
    return x;
}
struct S1In { v4u kk, r, k, v, pw, pa; f32x4 ka[2]; };
__device__ __forceinline__ void s1_item(Frame& F, unsigned char* const ws, const int lane, const int wv, const int l, const int item, const S1In& cur, S1In& nxt, const float* w0b, const float* a0b, const float* kab, unsigned long long (&cy)[6]) {
#if CYSEL >= 0
#define CY(k) do { const unsigned long long now_ = __builtin_readcyclecounter(); cy[k] += now_ - cy[5]; cy[5] = now_; } while (0)
#else
#define CY(k) do {} while (0)
#endif
    LAS unsigned char* L = F.lds + RING_OFF;
    const bf16* KKst = (const bf16*)(ws + WS_KK); const bf16* Kst = (const bf16*)(ws + WS_K); const bf16* Rst = (const bf16*)(ws + WS_R); const bf16* Vst = (const bf16*)(ws + WS_V); const bf16* LOUT = (const bf16*)(ws + WS_LOUT);
    bf16* PT = (bf16*)(ws + WS_SPT); bf16* GG = (bf16*)(ws + WS_SG); bf16* QQ = (bf16*)(ws + WS_SQ); float* OSC = (float*)(ws + WS_OSC);
    const int r = lane & 31, h = lane >> 5;
#define S1_ITEM(item_) const int chain = (item_) / NCHK, c = (item_) - chain * NCHK, dir = chain & 1, bh = chain >> 1, b = bh >> 3, hd = bh & 7; const int s0 = c * SCH; const int dsg = dir ? -1 : 1; \
        const int tok0 = (s0 < CTXL) ? (TL + b * CTXL + (dir ? (CTXL - 1 - s0) : s0)) : (b * SEQL + (dir ? (SEQL - 1 - (s0 - CTXL)) : (s0 - CTXL)));
#define S1_TOUCH(D) asm volatile("" :: "v"(D.kk), "v"(D.r), "v"(D.k), "v"(D.v), "v"(D.pw), "v"(D.pa), "v"(D.ka[0]), "v"(D.ka[1]))
#define S1_LOAD(D, item_) do { S1_ITEM(item_) const size_t tokr = (size_t)(tok0 + dsg * (8 * wv + (lane >> 3))); const size_t o5 = tokr * 512 + hd * 64 + 8 * (lane & 7); \
        D.kk = *(const v4u*)(KKst + o5); D.r = *(const v4u*)(Rst + o5); D.k = *(const v4u*)(Kst + o5); D.v = *(const v4u*)(Vst + o5); \
        D.pw = *(const v4u*)(LOUT + tokr * LORA_N + dir * 512 + hd * 64 + 8 * (lane & 7)); D.pa = *(const v4u*)(LOUT + tokr * LORA_N + 1024 + dir * 512 + hd * 64 + 8 * (lane & 7)); \
        { D.ka[0] = *(const f32x4*)(kab + hd * 64 + 8 * (lane & 7)); D.ka[1] = *(const f32x4*)(kab + hd * 64 + 8 * (lane & 7) + 4); } } while (0)
    {
        S1_ITEM(item)
        {   const v4u kk8 = cur.kk, r8 = cur.r, k8 = cur.k, v8 = cur.v, pw8 = cur.pw, pa8 = cur.pa; const int jg = lane & 7, t = 8 * wv + (lane >> 3);
            const float kap[8] = {cur.ka[0][0], cur.ka[0][1], cur.ka[0][2], cur.ka[0][3], cur.ka[1][0], cur.ka[1][1], cur.ka[1][2], cur.ka[1][3]};
            LAS float* tot = (LAS float*)(L + L_TII);
            float lw[8], av[8], lam[8];
#pragma unroll
            for (int e = 0; e < 8; ++e) { const unsigned pw = pw8[e >> 1], pa = pa8[e >> 1]; const float zw = (e & 1) ? bfhi(pw) : bflo(pw), za = (e & 1) ? bfhi(pa) : bflo(pa);
                lw[e] = zw; av[e] = za; lam[e] = lw[e]; }
#pragma unroll
            for (int sh = 8; sh <= 32; sh <<= 1) { float y[8]; const float mk = (lane >= sh) ? 1.0f : 0.0f;
#pragma unroll
                for (int e = 0; e < 8; ++e) y[e] = __shfl_up(lam[e], sh);
#pragma unroll
                for (int e = 0; e < 8; ++e) lam[e] = __builtin_fmaf(mk, y[e], lam[e]); }
            if (lane >= 56) { *(LAS f32x4*)(tot + wv * 64 + 8 * jg) = (f32x4){lam[0], lam[1], lam[2], lam[3]}; *(LAS f32x4*)(tot + wv * 64 + 8 * jg + 4) = (f32x4){lam[4], lam[5], lam[6], lam[7]}; }
            if (item + F.G < NITEM) S1_LOAD(nxt, item + F.G);
            WG_BAR();
            for (int w = 0; w < wv; ++w) { const f32x4 q0 = *(const LAS f32x4*)(tot + w * 64 + 8 * jg), q1 = *(const LAS f32x4*)(tot + w * 64 + 8 * jg + 4);
                lam[0] += q0[0]; lam[1] += q0[1]; lam[2] += q0[2]; lam[3] += q0[3]; lam[4] += q1[0]; lam[5] += q1[1]; lam[6] += q1[2]; lam[7] += q1[3]; }
            v4u wkk, wrr, wkd, wbd; float en8[8];
#pragma unroll
            for (int p = 0; p < 4; ++p) { float okk[2], orr[2], okd[2], obd[2];
#pragma unroll
                for (int u = 0; u < 2; ++u) { const int e = 2 * p + u;
                    const unsigned xkk = kk8[p], xr = r8[p], xk = k8[p];
                    const float kkv = u ? bfhi(xkk) : bflo(xkk), rv = u ? bfhi(xr) : bflo(xr), kv = u ? bfhi(xk) : bflo(xk);
                    const float eNp = __builtin_amdgcn_exp2f(lw[e] - lam[e]), eN = __builtin_amdgcn_exp2f(-lam[e]), eP = __builtin_amdgcn_exp2f(lam[e]);
                    okk[u] = kkv * eNp; orr[u] = rv * eN; okd[u] = kv * __builtin_fmaf(av[e], kap[e], 1.0f - kap[e]) * eP; obd[u] = kkv * av[e] * eP;
                    en8[e] = eN; }
                wkk[p] = pkbf(okk[0], okk[1]); wrr[p] = pkbf(orr[0], orr[1]); wkd[p] = pkbf(okd[0], okd[1]); wbd[p] = pkbf(obd[0], obd[1]); }
            if (t == SCH - 1) { *(LAS f32x4*)((LAS float*)(L + L_GC) + 8 * jg) = (f32x4){en8[0], en8[1], en8[2], en8[3]}; *(LAS f32x4*)((LAS float*)(L + L_GC) + 8 * jg + 4) = (f32x4){en8[4], en8[5], en8[6], en8[7]}; }
            *(LAS v4u*)(L + L_AKK + t * LSTR + jg * 16) = wkk; *(LAS v4u*)(L + L_AR + t * LSTR + jg * 16) = wrr; *(LAS v4u*)(L + L_AK + t * LSTR + jg * 16) = wkd; *(LAS v4u*)(L + L_AB + t * LSTR + jg * 16) = wbd;
#pragma unroll
            for (int e = 0; e < 8; ++e) { const int j = 8 * jg + e; const unsigned wk = wkd[e >> 1], wb = wbd[e >> 1], wvv = v8[e >> 1];
                const int to = j * LSTR + ((wv ^ jg) << 4) + (lane >> 3) * 2;
                *(LAS unsigned short*)(L + L_TK + to) = (unsigned short)((e & 1) ? (wk >> 16) : (wk & 0xffffu));
                *(LAS unsigned short*)(L + L_TB + to) = (unsigned short)((e & 1) ? (wb >> 16) : (wb & 0xffffu));
                *(LAS unsigned short*)(L + L_TV + to) = (unsigned short)((e & 1) ? (wvv >> 16) : (wvv & 0xffffu)); }
        }
        WG_BAR();
        CY(0);
#pragma unroll
        for (int jj = 0; jj < 2; ++jj) {
            const int job = 2 * wv + jj, m = job >> 2, si = (job >> 1) & 1, ti = job & 1;
            f32x16 acc = {};
            if (!(si == 1 && ti == 0)) acc = tile32(L + ((m & 1) ? L_AK : L_AB), L + (m < 2 ? L_AKK : L_AR), si, ti, r, h, acc);
            const int tt = 32 * ti + r;
#pragma unroll
            for (int g = 0; g < 4; ++g) { const int sb = 32 * si + 8 * g + 4 * h; float vv[4];
#pragma unroll
                for (int i = 0; i < 4; ++i) { const int s = sb + i; const bool keep = (m < 2) ? (s < tt) : (s <= tt); vv[i] = keep ? acc[4 * g + i] : 0.f; }
                if (m == 0) *(LAS f32x4*)((LAS float*)(L + L_FLB) + tt * 64 + sb) = (f32x4){vv[0], vv[1], vv[2], vv[3]};
                else *(LAS u32x2*)(L + (m == 1 ? L_MLK : (m == 2 ? L_MMB : L_MMK)) + tt * LSTR + sb * 2) = (u32x2){pkbf(vv[0], vv[1]), pkbf(vv[2], vv[3])}; }
        }
        WG_BAR();
        CY(1);
        f32x16 acc_o1 = {}, ag = {};
        {   const int q4 = wv & 3, mi = q4 >> 1, ni = q4 & 1;
            if (wv < 4) { f32x16 acc = {}; acc = tile32<false, true>(L + L_MLK, L + L_TV, mi, ni, r, h, acc);
#pragma unroll
                for (int reg = 0; reg < 16; ++reg) ((LAS float*)(L + L_FX))[(32 * mi + CROW(reg, h)) * 64 + 32 * ni + r] = acc[reg];
                const int col = lane & 15; const LAS float* lb = (const LAS float*)(L + L_FLB) + (16 * wv) * 64 + 16 * wv; float x[16];
#pragma unroll
                for (int tt = 0; tt < 16; ++tt) { float a = (tt == col) ? 1.0f : 0.0f, a2 = 0.0f;
#pragma unroll
                    for (int s4 = 0; s4 < tt; s4 += 4) { const f32x4 lv = *(const LAS f32x4*)(lb + tt * 64 + s4);
#pragma unroll
                        for (int u = 0; u < 4; ++u) if (s4 + u < tt) { if (u & 1) a2 -= lv[u] * x[s4 + u]; else a -= lv[u] * x[s4 + u]; } }
                    x[tt] = a + a2; }
                if (lane < 16) {
#pragma unroll
                    for (int tt = 0; tt < 16; ++tt) *(LAS unsigned short*)(L + L_TII + wv * 512 + tt * 32 + col * 2) = bf1(x[tt]); }
            } else { acc_o1 = tile32<true, false>(L + L_TV, L + L_MMK, mi, ni, r, h, acc_o1);
                ag = tile32<true, true>(L + L_TK, L + L_TV, mi, ni, r, h, ag); }
        }
        WG_BAR();
        CY(2);
        {   const int cc = lane & 15, q = lane >> 4; const bool isw = wv < 4; const int colb = 16 * (wv & 3) + cc;
            f32x4 U[4], R0[4];
            if (isw) {
#pragma unroll
                for (int i = 0; i < 4; ++i)
#pragma unroll
                    for (int reg = 0; reg < 4; ++reg) { const int tt = 16 * i + 4 * q + reg; R0[i][reg] = __builtin_bit_cast(float, (unsigned)(*(const LAS unsigned short*)(L + L_AKK + tt * LSTR + colb * 2)) << 16); }
            } else {
#pragma unroll
                for (int i = 0; i < 4; ++i)
#pragma unroll
                    for (int reg = 0; reg < 4; ++reg) { const int tt = 16 * i + 4 * q + reg; R0[i][reg] = ((const LAS float*)(L + L_FX))[tt * 64 + colb]; }
            }
#pragma unroll
            for (int i = 0; i < 4; ++i) {
                f32x4 R = R0[i];
#pragma unroll
                for (int kp = 0; kp < 2; ++kp) { if (2 * kp < i) {
                    const int k1 = 2 * kp, k2 = 2 * kp + 1; const bool two = (k2 < i);
                    const LAS float* lrow = (const LAS float*)(L + L_FLB) + (16 * i + cc) * 64;
                    const f32x4 la = *(const LAS f32x4*)(lrow + 16 * k1 + 4 * q); f32x4 lb2 = {0.f, 0.f, 0.f, 0.f}; if (two) lb2 = *(const LAS f32x4*)(lrow + 16 * k2 + 4 * q);
                    const v4u aw = (v4u){pkbf(-la[0], -la[1]), pkbf(-la[2], -la[3]), pkbf(-lb2[0], -lb2[1]), pkbf(-lb2[2], -lb2[3])};
                    const f32x4 u1 = U[k1]; f32x4 u2 = {0.f, 0.f, 0.f, 0.f}; if (two) u2 = U[k2];
                    const v4u bh_ = (v4u){pkbf(u1[0], u1[1]), pkbf(u1[2], u1[3]), pkbf(u2[0], u2[1]), pkbf(u2[2], u2[3])};
                    R = __builtin_amdgcn_mfma_f32_16x16x32_bf16(__builtin_bit_cast(bf16x8, aw), __builtin_bit_cast(bf16x8, bh_), R, 0, 0, 0); } }
                const u32x2 tw = *(const LAS u32x2*)(L + L_TII + i * 512 + cc * 32 + q * 8);
                const v4u ta = (v4u){tw.x, tw.y, 0u, 0u};
                const v4u rh = (v4u){pkbf(R[0], R[1]), pkbf(R[2], R[3]), 0u, 0u};
                f32x4 u = {0.f, 0.f, 0.f, 0.f};
                u = __builtin_amdgcn_mfma_f32_16x16x32_bf16(__builtin_bit_cast(bf16x8, ta), __builtin_bit_cast(bf16x8, rh), u, 0, 0, 0);
                U[i] = u;
                *(LAS u32x2*)(L + (isw ? L_TW1 : L_TU) + colb * LSTR + (16 * i + 4 * q) * 2) = (u32x2){pkbf(u[0], u[1]), pkbf(u[2], u[3])};
            }
        }
        WG_BAR();
        CY(3);
        S1_TOUCH(nxt);
        {   const int q4 = wv & 3, mi = q4 >> 1, ni = q4 & 1; const LAS float* gc = (const LAS float*)(L + L_GC);
            if (wv < 4) {
                f32x16 acc = {}; acc = tile32<false, true>(L + L_TW1, L + L_TB, mi, ni, r, h, acc);
                const int jp = 32 * ni + r; const float gj = gc[jp]; bf16* pt = PT + (size_t)item * 4096 + (size_t)jp * 64;
#pragma unroll
                for (int gp2 = 0; gp2 < 2; ++gp2) { unsigned pw[4];
#pragma unroll
                    for (int u = 0; u < 2; ++u) { const int g = gp2 + 2 * u, j0 = 32 * mi + 8 * g + 4 * h; float pv[4];
#pragma unroll
                        for (int i = 0; i < 4; ++i) pv[i] = (((j0 + i) == jp ? 1.0f : 0.0f) - acc[4 * g + i]) * gj;
                        pw[2 * u] = pkbf(pv[0], pv[1]); pw[2 * u + 1] = pkbf(pv[2], pv[3]); }
                    *(v4u*)(pt + 16 * (2 * gp2 + h) + 8 * mi) = (v4u){pw[0], pw[1], pw[2], pw[3]}; }
                f32x16 acq = {}; acq = tile32(L + L_TW1, L + L_MMB, mi, ni, r, h, acq);
                const int tt = 32 * ni + r; bf16* qq = QQ + (size_t)item * 4096 + (size_t)tt * 64;
#pragma unroll
                for (int gp2 = 0; gp2 < 2; ++gp2) { unsigned qw[4];
#pragma unroll
                    for (int u = 0; u < 2; ++u) { const int g = gp2 + 2 * u, j0 = 32 * mi + 8 * g + 4 * h; const u32x2 rw = *(const LAS u32x2*)(L + L_AR + tt * LSTR + j0 * 2);
                        qw[2 * u] = pkbf(bflo(rw.x) - acq[4 * g], bfhi(rw.x) - acq[4 * g + 1]); qw[2 * u + 1] = pkbf(bflo(rw.y) - acq[4 * g + 2], bfhi(rw.y) - acq[4 * g + 3]); }
                    *(v4u*)(qq + 16 * (2 * gp2 + h) + 8 * mi) = (v4u){qw[0], qw[1], qw[2], qw[3]}; }
            } else {
                f32x16 acc = {}; acc = tile32(L + L_TU, L + L_MMB, mi, ni, r, h, acc);
                const int tt = 32 * ni + r; bf16* op = (bf16*)OSC + ((size_t)dir * TT + (size_t)(tok0 + dsg * tt)) * 512 + hd * 64;
#pragma unroll
                for (int gp2 = 0; gp2 < 2; ++gp2) { unsigned ow_[4];
#pragma unroll
                    for (int u = 0; u < 2; ++u) { const int g = gp2 + 2 * u; ow_[2 * u] = pkbf(acc_o1[4 * g] - acc[4 * g], acc_o1[4 * g + 1] - acc[4 * g + 1]); ow_[2 * u + 1] = pkbf(acc_o1[4 * g + 2] - acc[4 * g + 2], acc_o1[4 * g + 3] - acc[4 * g + 3]); }
                    *(v4u*)(op + 16 * (2 * gp2 + h) + 8 * mi) = (v4u){ow_[0], ow_[1], ow_[2], ow_[3]}; }
                f32x16 ah = {}; ah = tile32<true, false>(L + L_TB, L + L_TU, mi, ni, r, h, ah);
                const int v = 32 * ni + r; bf16* gp = GG + (size_t)item * 4096 + (size_t)v * 64;
#pragma unroll
                for (int gp2 = 0; gp2 < 2; ++gp2) { unsigned gw_[4];
#pragma unroll
                    for (int u = 0; u < 2; ++u) { const int g = gp2 + 2 * u, j0 = 32 * mi + 8 * g + 4 * h; const f32x4 gj = *(const LAS f32x4*)(gc + j0); float gv[4];
#pragma unroll
                        for (int i = 0; i < 4; ++i) gv[i] = (ag[4 * g + i] - ah[4 * g + i]) * gj[i];
                        gw_[2 * u] = pkbf(gv[0], gv[1]); gw_[2 * u + 1] = pkbf(gv[2], gv[3]); }
                    *(v4u*)(gp + 16 * (2 * gp2 + h) + 8 * mi) = (v4u){gw_[0], gw_[1], gw_[2], gw_[3]}; }
            }
        }
        WG_BAR();
        CY(4);
    }
#undef CY
}
__device__ __forceinline__ void p_scan1(Frame& F, const Args& A, int l) {
    unsigned char* const ws = launder(F.ws);
    const int tid = (F.wave * 64 + hw_lane()), lane = tid & 63, wv = F.wave;
    const bf16* KKst = (const bf16*)(ws + WS_KK); const bf16* Kst = (const bf16*)(ws + WS_K); const bf16* Rst = (const bf16*)(ws + WS_R); const bf16* Vst = (const bf16*)(ws + WS_V); const bf16* LOUT = (const bf16*)(ws + WS_LOUT);
    const float* w0b = INP(IN_W0) + l * 1024; const float* a0b = INP(IN_A0) + l * 1024; const float* kab = INP(IN_KA) + l * 512;
    S1In sa = {}, sb = {}; unsigned long long cy[6] = {0, 0, 0, 0, 0, 0};
#if CYSEL >= 0
    cy[5] = __builtin_readcyclecounter();
#endif
    if ((int)blockIdx.x < NITEM) S1_LOAD(sa, (int)blockIdx.x);
    S1_TOUCH(sa);
    for (int item = blockIdx.x; item < NITEM; item += 2 * F.G) {
        s1_item(F, ws, lane, wv, l, item, sa, sb, w0b, a0b, kab, cy);
        if (item + F.G < NITEM) s1_item(F, ws, lane, wv, l, item + F.G, sb, sa, w0b, a0b, kab, cy);
    }
#if CYSEL >= 0
    if (blockIdx.x == 0 && F.wave == 0 && hw_lane() == 0) { unsigned long long* cs_ = (unsigned long long*)(F.ws + WS_CTL + 40960); for (int k = 0; k < 5; ++k) cs_[k] += cy[k]; }
#endif
}
#undef S1_ITEM
#undef S1_LOAD
#undef S1_TOUCH

struct S2Ops { v4u pa[4][2]; v4u gt[2]; };
__device__ __forceinline__ void s2_load(S2Ops& o, const bf16* PT, const bf16* GG, int chain, int c, int cc, int q, int v) {
    const size_t ib = ((size_t)chain * NCHK + c) * 4096;
#pragma unroll
    for (int J = 0; J < 4; ++J) { const bf16* prow = PT + ib + (size_t)(16 * J + cc) * 64;
#pragma unroll
        for (int kb = 0; kb < 2; ++kb) o.pa[J][kb] = *(const v4u*)(prow + 16 * q + 8 * kb); }
#pragma unroll
    for (int kb = 0; kb < 2; ++kb) o.gt[kb] = *(const v4u*)(GG + ib + (size_t)v * 64 + 16 * q + 8 * kb);
}
__device__ __forceinline__ void s2_step(f32x4 (&St)[4], const S2Ops& o, bf16* S0, int chain, int c, int q, int v) {
    const size_t ib = ((size_t)chain * NCHK + c) * 4096;
    v4u bh_[2], bl_[2];
#pragma unroll
    for (int kb = 0; kb < 2; ++kb) { const f32x4 u1 = St[2 * kb], u2 = St[2 * kb + 1];
        bh_[kb] = (v4u){pkbf(u1[0], u1[1]), pkbf(u1[2], u1[3]), pkbf(u2[0], u2[1]), pkbf(u2[2], u2[3])};
        bl_[kb] = (v4u){pkbf(u1[0] - bflo(bh_[kb].x), u1[1] - bfhi(bh_[kb].x)), pkbf(u1[2] - bflo(bh_[kb].y), u1[3] - bfhi(bh_[kb].y)), pkbf(u2[0] - bflo(bh_[kb].z), u2[1] - bfhi(bh_[kb].z)), pkbf(u2[2] - bflo(bh_[kb].w), u2[3] - bfhi(bh_[kb].w))};
        *(v4u*)(S0 + ib + (size_t)v * 64 + 16 * q + 8 * kb) = bh_[kb]; }
#pragma unroll
    for (int J = 0; J < 4; ++J) { const unsigned g0 = (J & 1) ? o.gt[J >> 1].z : o.gt[J >> 1].x, g1 = (J & 1) ? o.gt[J >> 1].w : o.gt[J >> 1].y; f32x4 acc = (f32x4){bflo(g0), bfhi(g0), bflo(g1), bfhi(g1)};
#pragma unroll
        for (int kb = 0; kb < 2; ++kb) { const v4u aw = o.pa[J][kb];
            acc = __builtin_amdgcn_mfma_f32_16x16x32_bf16(__builtin_bit_cast(bf16x8, aw), __builtin_bit_cast(bf16x8, bh_[kb]), acc, 0, 0, 0);
            acc = __builtin_amdgcn_mfma_f32_16x16x32_bf16(__builtin_bit_cast(bf16x8, aw), __builtin_bit_cast(bf16x8, bl_[kb]), acc, 0, 0, 0); }
        St[J] = acc; }
}
__device__ __forceinline__ void p_scan2(Frame& F) {
    unsigned char* const ws = launder(F.ws);
    const int tid = (F.wave * 64 + hw_lane()), lane = tid & 63;
    const bf16* PT = (const bf16*)(ws + WS_SPT); const bf16* GG = (const bf16*)(ws + WS_SG); bf16* S0 = (bf16*)F.out;
    const int cc = lane & 15, q = lane >> 4;
    static_assert(NCHK % 4 == 0, "stage 2 ring depth");
    for (int wi = F.wave * F.G + (int)blockIdx.x; wi < 512; wi += NWAVES * F.G) {
        const int chain = wi >> 2, vg = wi & 3; const int v = 16 * vg + cc;
        f32x4 St[4];
#pragma unroll
        for (int J = 0; J < 4; ++J) St[J] = (f32x4){0.f, 0.f, 0.f, 0.f};
        S2Ops o0, o1, o2, o3;
        s2_load(o0, PT, GG, chain, 0, cc, q, v); s2_load(o1, PT, GG, chain, 1, cc, q, v); s2_load(o2, PT, GG, chain, 2, cc, q, v);
        for (int c = 0; c < NCHK; c += 4) {
            s2_load(o3, PT, GG, chain, c + 3, cc, q, v);                 s2_step(St, o0, S0, chain, c, q, v);
            if (c + 4 < NCHK) s2_load(o0, PT, GG, chain, c + 4, cc, q, v); s2_step(St, o1, S0, chain, c + 1, q, v);
            if (c + 5 < NCHK) s2_load(o1, PT, GG, chain, c + 5, cc, q, v); s2_step(St, o2, S0, chain, c + 2, q, v);
            if (c + 6 < NCHK) s2_load(o2, PT, GG, chain, c + 6, cc, q, v); s2_step(St, o3, S0, chain, c + 3, q, v);
        }
    }
}

__device__ __forceinline__ void p_scan3(Frame& F) {
    unsigned char* const ws = launder(F.ws);
    const int tid = (F.wave * 64 + hw_lane()), lane = tid & 63;
    const bf16* QQ = (const bf16*)(ws + WS_SQ); const bf16* S0 = (const bf16*)F.out; float* OSC = (float*)(ws + WS_OSC);
    const int gw = F.vcu * NWAVES + F.wave, NGW = F.G * NWAVES; const int r = lane & 31, h = lane >> 5;
    bf16x8 sa[4], qb[4], sa2[4], qb2[4]; f32x4 ov[4], ov2[4]; float* op = nullptr; float* op2 = nullptr;
#define S3_LOAD(SA, QB, OV, OP, job_) do { const int item = (job_) >> 2, mi = ((job_) >> 1) & 1, ni = (job_) & 1; \
        const int chain = item / NCHK, c = item - chain * NCHK, dir = chain & 1, bh = chain >> 1, b = bh >> 3, hd = bh & 7; const int s0 = c * SCH + 32 * ni + r; \
        const int tok = (s0 < CTXL) ? (TL + b * CTXL + (dir ? (CTXL - 1 - s0) : s0)) : (b * SEQL + (dir ? (SEQL - 1 - (s0 - CTXL)) : (s0 - CTXL))); \
        const bf16* sp = S0 + (size_t)item * 4096 + (size_t)(32 * mi + r) * 64 + 8 * h; const bf16* qp = QQ + (size_t)item * 4096 + (size_t)(32 * ni + r) * 64 + 8 * h; \
        _Pragma("unroll") for (int kb = 0; kb < 4; ++kb) { SA[kb] = *(const bf16x8*)(sp + 16 * kb); QB[kb] = *(const bf16x8*)(qp + 16 * kb); } \
        OP = OSC + ((size_t)dir * TT + (size_t)tok) * 512 + hd * 64 + 32 * mi + 4 * h; \
        _Pragma("unroll") for (int g = 0; g < 4; ++g) OV[g] = *(const f32x4*)(OP + 8 * g); } while (0)
    int job = gw;
    if (job < NITEM * 4) S3_LOAD(sa, qb, ov, op, job);
    for (; job < NITEM * 4; job += NGW) {
        const int nj = job + NGW;
        if (nj < NITEM * 4) S3_LOAD(sa2, qb2, ov2, op2, nj);
        f32x16 acc = {};
#pragma unroll
        for (int kb = 0; kb < 4; ++kb) acc = __builtin_amdgcn_mfma_f32_32x32x16_bf16(sa[kb], qb[kb], acc, 0, 0, 0);
#pragma unroll
        for (int g = 0; g < 4; ++g) *(f32x4*)(op + 8 * g) = ov[g] + (f32x4){acc[4 * g], acc[4 * g + 1], acc[4 * g + 2], acc[4 * g + 3]};
#pragma unroll
        for (int kb = 0; kb < 4; ++kb) { sa[kb] = sa2[kb]; qb[kb] = qb2[kb]; ov[kb] = ov2[kb]; }
        op = op2;
    }
#undef S3_LOAD
}


__device__ __forceinline__ void s3_fetch(v4u (&d)[4], const bf16* base, size_t pitch, int lane) {
#pragma unroll
    for (int i = 0; i < 4; ++i) d[i] = *(const v4u*)(base + (size_t)((lane >> 3) + 8 * i) * pitch + (lane & 7) * 8);
}
template <bool PERMUTED = false>
__device__ __forceinline__ void s3_relayout(uint2 (&o)[8], const v4u (&d)[4], LAS unsigned char* stg, int lane) {
    const int r = lane & 31, h = lane >> 5;
#pragma unroll
    for (int i = 0; i < 4; ++i) *(LAS v4u*)(stg + ((lane >> 3) + 8 * i) * LSTR + (lane & 7) * 16) = d[i];
#pragma unroll
    for (int mi = 0; mi < 2; ++mi)
#pragma unroll
        for (int g = 0; g < 4; ++g) { const int c0 = 32 * mi + 8 * g + 4 * h; const u32x2 w = *(const LAS u32x2*)(stg + r * LSTR + (PERMUTED ? jperm(c0) : c0) * 2); o[mi * 4 + g] = make_uint2(w.x, w.y); }
}
__device__ __forceinline__ void p_scan3r(Frame& F, const Args& A, int l) {
    unsigned char* const ws = launder(F.ws);
    const int tid = (F.wave * 64 + hw_lane()), lane = tid & 63;
    const bf16* QQ = (const bf16*)(ws + WS_SQ); const bf16* S0 = (const bf16*)F.out; const bf16* OSC = (const bf16*)(ws + WS_OSC);
    const bf16* Rst = (const bf16*)(ws + WS_R); const bf16* Vst = (const bf16*)(ws + WS_V); const bf16* Kst = (const bf16*)(ws + WS_K); const bf16* LOUT = (const bf16*)(ws + WS_LOUT);
    bf16* QO = (bf16*)(ws + WS_QO);
    LAS unsigned char* stg = F.lds + RING_OFF + F.wave * 4608;
    const int gw = F.vcu * NWAVES + F.wave, NGW = F.G * NWAVES; const int r = lane & 31, h = lane >> 5;
    const float* rkp = INP(IN_RK) + l * 512; const float* gnwp = INP(IN_GNW) + l * 512; const float* gnbp = INP(IN_GNB) + l * 512; const float* kap = INP(IN_KA) + l * 512; const float* a0p = INP(IN_A0) + l * 1024;
    for (int unit = gw; unit < 64 * (KVLEN / 32); unit += NGW) {
        const int bh = unit / (KVLEN / 32), pb = unit - bh * (KVLEN / 32), b = bh >> 3, hd = bh & 7, p0 = pb * 32;
        const size_t tokb = (p0 < CTXL) ? (size_t)(TL + b * CTXL + p0) : (size_t)(b * SEQL + (p0 - CTXL)); const size_t tok = tokb + r;
        const int sb0 = (p0 < CTXL) ? (CTXL - 1 - p0) : (KVLEN + CTXL - 1 - p0);
        const int itf = (bh * 2) * NCHK + (p0 >> 6), itb = (bh * 2 + 1) * NCHK + (sb0 >> 6); const int tf = (p0 & 63) + r, tb = (sb0 & 63) - r;
        v4u ga[4], gb[4];
        s3_fetch(ga, OSC + tokb * 512 + hd * 64, 512, lane); s3_fetch(gb, OSC + ((size_t)TT + tokb) * 512 + hd * 64, 512, lane);
        f32x4 o[2][4];
        {   f32x16 acc[2][2];
#pragma unroll
            for (int d = 0; d < 2; ++d) { const size_t ib = (size_t)(d ? itb : itf) * 4096; const bf16* qp = QQ + ib + (size_t)(d ? tb : tf) * 64 + 8 * h;
                bf16x8 qf[4];
#pragma unroll
                for (int kb = 0; kb < 4; ++kb) qf[kb] = *(const bf16x8*)(qp + 16 * kb);
#pragma unroll
                for (int mi = 0; mi < 2; ++mi) { const bf16* sp = S0 + ib + (size_t)(32 * mi + r) * 64 + 8 * h; f32x16 a = {};
#pragma unroll
                    for (int kb = 0; kb < 4; ++kb) a = __builtin_amdgcn_mfma_f32_32x32x16_bf16(*(const bf16x8*)(sp + 16 * kb), qf[kb], a, 0, 0, 0);
                    acc[d][mi] = a; } }
#pragma unroll
            for (int mi = 0; mi < 2; ++mi)
#pragma unroll
                for (int g = 0; g < 4; ++g)
#pragma unroll
                    for (int i = 0; i < 4; ++i) o[mi][g][i] = acc[0][mi][4 * g + i] + acc[1][mi][4 * g + i]; }
        uint2 ta[8], tb8[8];
        s3_relayout<true>(ta, ga, stg, lane); s3_fetch(ga, Rst + tokb * 512 + hd * 64, 512, lane);
        s3_relayout<true>(tb8, gb, stg, lane); s3_fetch(gb, Kst + tokb * 512 + hd * 64, 512, lane);
        float s1 = 0.f;
#pragma unroll
        for (int mi = 0; mi < 2; ++mi)
#pragma unroll
            for (int g = 0; g < 4; ++g) { const uint2 of = ta[mi * 4 + g], ob = tb8[mi * 4 + g]; f32x4 v = o[mi][g];
                v[0] += bflo(of.x) + bflo(ob.x); v[1] += bfhi(of.x) + bfhi(ob.x); v[2] += bflo(of.y) + bflo(ob.y); v[3] += bfhi(of.y) + bfhi(ob.y);
                o[mi][g] = v; s1 += (v[0] + v[1]) + (v[2] + v[3]); }
        s1 += __shfl_xor(s1, 32); const float mean = s1 * (1.0f / 64.0f);
        const int cb = hd * 64 + 4 * h;
        float s2 = 0.f, bs = 0.f;
        f32x4 rkv[8], sa[8];
        {   uint2 rr8[8], kk8[8];
            s3_relayout(rr8, ga, stg, lane); s3_fetch(ga, LOUT + tokb * LORA_N + 1024 + hd * 64, LORA_N, lane);
            s3_relayout(kk8, gb, stg, lane); s3_fetch(gb, LOUT + tokb * LORA_N + 1536 + hd * 64, LORA_N, lane);
#pragma unroll
            for (int q = 0; q < 8; ++q) { const int cl = cb + 32 * (q >> 2) + 8 * (q & 3); const f32x4 rk4 = *(const f32x4*)(rkp + cl);
                f32x4 d = o[q >> 2][q & 3] - mean; o[q >> 2][q & 3] = d; s2 += (d[0] * d[0] + d[1] * d[1]) + (d[2] * d[2] + d[3] * d[3]);
                rkv[q] = (f32x4){bflo(rr8[q].x) * bflo(kk8[q].x) * rk4[0], bfhi(rr8[q].x) * bfhi(kk8[q].x) * rk4[1], bflo(rr8[q].y) * bflo(kk8[q].y) * rk4[2], bfhi(rr8[q].y) * bfhi(kk8[q].y) * rk4[3]}; } }
        {   uint2 pa8[8];
            s3_relayout(pa8, ga, stg, lane); s3_fetch(ga, Vst + tokb * 512 + hd * 64, 512, lane);
#pragma unroll
            for (int q = 0; q < 8; ++q) sa[q] = (f32x4){bflo(pa8[q].x), bfhi(pa8[q].x), bflo(pa8[q].y), bfhi(pa8[q].y)}; }
        {   uint2 pb8[8];
            s3_relayout(pb8, gb, stg, lane); s3_fetch(gb, LOUT + tokb * LORA_N + 2048 + hd * 64, LORA_N, lane);
#pragma unroll
            for (int q = 0; q < 8; ++q) { const int cl = cb + 32 * (q >> 2) + 8 * (q & 3); const f32x4 ka4 = *(const f32x4*)(kap + cl);
                const float pq[4] = {bflo(pb8[q].x), bfhi(pb8[q].x), bflo(pb8[q].y), bfhi(pb8[q].y)};
#pragma unroll
                for (int i = 0; i < 4; ++i) bs += rkv[q][i] * (2.0f + (sa[q][i] + pq[i] - 2.0f) * ka4[i]); } }
        s2 += __shfl_xor(s2, 32); bs += __shfl_xor(bs, 32);
        const float rs = 1.0f / sqrtf(s2 * (1.0f / 64.0f) + GN_EPS);
        uint2 vv8[8], gg8[8];
        s3_relayout(vv8, ga, stg, lane); s3_relayout(gg8, gb, stg, lane);
#pragma unroll
        for (int mi = 0; mi < 2; ++mi)
#pragma unroll
            for (int g = 0; g < 4; ++g) { const int cl = cb + 32 * mi + 8 * g; const int q = mi * 4 + g;
                const uint2 vw = vv8[q], gwd = gg8[q];
                const f32x4 w4 = *(const f32x4*)(gnwp + cl), b4 = *(const f32x4*)(gnbp + cl); const f32x4 d = o[mi][g];
                const float y0 = (d[0] * rs * w4[0] + b4[0] + bs * bflo(vw.x)) * bflo(gwd.x), y1 = (d[1] * rs * w4[1] + b4[1] + bs * bfhi(vw.x)) * bfhi(gwd.x);
                const float y2 = (d[2] * rs * w4[2] + b4[2] + bs * bflo(vw.y)) * bflo(gwd.y), y3 = (d[3] * rs * w4[3] + b4[3] + bs * bfhi(vw.y)) * bfhi(gwd.y);
                *(LAS u32x2*)(stg + r * LSTR + (32 * mi + 8 * g + 4 * h) * 2) = (u32x2){pkbf(y0, y1), pkbf(y2, y3)}; }
#pragma unroll
        for (int i = 0; i < 4; ++i) { const int row = (lane >> 3) + 8 * i; const v4u val = *(const LAS v4u*)(stg + row * LSTR + (lane & 7) * 16);
            *(v4u*)(QO + (tokb + row) * 1024 + 512 + hd * 64 + (lane & 7) * 8) = val; }
    }
}

#if DEBUG_NAN
__device__ __forceinline__ void dbg_count(Frame& F) {
    unsigned char* const ws = launder(F.ws);
    const size_t gt = (size_t)blockIdx.x * 512 + threadIdx.x, NT = (size_t)F.G * 512;
    const unsigned short* arr[4] = {(const unsigned short*)(ws + WS_SPT), (const unsigned short*)(ws + WS_SG), (const unsigned short*)(ws + WS_SQ), (const unsigned short*)F.out};
#pragma unroll
    for (int a = 0; a < 4; ++a) { unsigned bad = 0; for (size_t i = gt; i < (size_t)NITEM * 4096; i += NT) { const float v = __builtin_bit_cast(float, (unsigned)arr[a][i] << 16); if (!(fabsf(v) < 1e30f)) ++bad; }
        if (bad) atomicAdd((unsigned*)(F.ctl + 8 + a), bad); }
    { const float* o = (const float*)(ws + WS_OSC); unsigned bad = 0; for (size_t i = gt; i < (size_t)2 * TT * 512; i += NT) { if (!(fabsf(o[i]) < 1e30f)) ++bad; } if (bad) atomicAdd((unsigned*)(F.ctl + 12), bad); }
}
#endif
template <int l> __device__ __forceinline__ void layer_body(Frame& F, const Args& args, const XcdBarrier& bar, unsigned char* lds) {
#define GRID_BAR() xcd_barrier(bar)

        constexpr bool last = (l == DEPTH - 1), moe = (l & 1) != 0;

#ifndef SKIP_WPREP
        p_wprep(F, args, l, 0);
#endif


#ifndef SKIP_NORM1
        {   if (l == 0) p_norm<false, false, true>(F, args, l, 0, INP(IN_X), INP(IN_CTX), 0);
            else if (l & 1) p_norm<false, false, false, true>(F, args, l, 0, nullptr, nullptr, 0);
            else p_norm<false, true, false>(F, args, l, 0, nullptr, nullptr, l - 1); }
#endif

        GRID_BAR(); TS(1);
        {   unsigned char* const ws = launder(F.ws); bf16* const XB = (bf16*)(ws + WS_XB); const float* const MOD = (const float*)(ws + WS_MOD); bf16* const H = (bf16*)F.out; (void)XB; (void)MOD; (void)H;
            pg8::Gemm g{H, (const bf16*)(ws + WS_WIN), TT, INWP, 1024, 0}; pg8::Sched S; S.init(TT / 256, INWP / 256, F.G, (int)blockIdx.x, nullptr);
            pg8::EpiBf16 E{(bf16*)(ws + WS_P), INWP};
#ifndef SKIP_G_IN
            pg8::gemm_phase<pg8::EpiBf16, pg8::Sched, true, true>(F.lds + RING_OFF, g, S, E, F.wave);
#endif
            }
        GRID_BAR(); TS(2);

#ifndef SKIP_PREP
        p_prep(F, args, l);
#endif
#if PROBE == 2
        p_prep(F, args, l);
#endif

        GRID_BAR(); TS(3);
        {   unsigned char* const ws = launder(F.ws); bf16* const XB = (bf16*)(ws + WS_XB); const float* const MOD = (const float*)(ws + WS_MOD); bf16* const H = (bf16*)F.out; (void)XB; (void)MOD; (void)H;
            pg8::Gemm g{(const bf16*)(ws + WS_LIN), (const bf16*)(ws + WS_WLORA), TT, LORA_N, 128, LORA_K}; pg8::Sched S; S.init(TT / 256, LORA_N / 256, F.G, (int)blockIdx.x, nullptr); S.lora = 1;
            pg8::EpiLoraAct E{(bf16*)(ws + WS_LOUT), LORA_N, INP(IN_W0) + l * 1024, INP(IN_A0) + l * 1024};
#ifndef SKIP_G_LORA
            pg8::gemm_phase<pg8::EpiLoraAct, pg8::Sched, true, true>(F.lds + RING_OFF, g, S, E, F.wave);
#endif
            }

#ifndef SKIP_ATTN
        p_attn(F, (char*)lds + RING_OFF, !last);
#endif

        GRID_BAR(); TS(4);

#if USE_SEQ_SCAN
        p_scan(F, args, l);
#else
        p_scan1(F, args, l);
#if PROBE == 5
        p_scan1(F, args, l);
#endif
        GRID_BAR(); TS(5);
        p_scan2(F);
#if PROBE == 6
        p_scan2(F);
#endif
        GRID_BAR(); TS(6);
        p_scan3r(F, args, l);
#endif
#if USE_SEQ_SCAN
        GRID_BAR(); TS(15);
        p_readout(F, args, l);
#endif
        GRID_BAR(); TS(7);
        {   unsigned char* const ws = launder(F.ws); bf16* const XB = (bf16*)(ws + WS_XB); const float* const MOD = (const float*)(ws + WS_MOD); bf16* const H = (bf16*)F.out; (void)XB; (void)MOD; (void)H;
            pg8::Gemm g{(const bf16*)(ws + WS_QO), (const bf16*)(ws + WS_WOUT), TT, 1024, 1024, 0, 0}; pg8::SchedSK S; S.init(TL / 256, !last, 1024 / 64, F.G, (int)blockIdx.x);
            pg8::EpiResidB<l == 0> E{INP(IN_X), INP(IN_CTX), XB, MOD + (size_t)l * 9 * 6144 + 2 * 1024, (bf16*)(ws + WS_SIDE), 1.0f};
#ifndef SKIP_G_OUT
            pg8::gemm_phase<pg8::EpiResidB<l == 0>, pg8::SchedSK, true, true>(F.lds + RING_OFF, g, S, E, F.wave);
#endif
            }
        GRID_BAR(); TS(8);
        p_wprep(F, args, l, 1);
#if PROBE == 7
        p_wprep(F, args, l, 1);
#endif
        if (!moe) {
            p_norm<false, false, false, true>(F, args, l, 1, nullptr, nullptr, 0);
#if PROBE == 4
            p_norm<false, false, false, false>(F, args, l, 1, nullptr, nullptr, 0);
#endif
            GRID_BAR(); TS(9);
            {   unsigned char* const ws = launder(F.ws); bf16* const XB = (bf16*)(ws + WS_XB); const float* const MOD = (const float*)(ws + WS_MOD); bf16* const H = (bf16*)F.out; (void)XB; (void)MOD; (void)H;
            pg8::Gemm g{H, (const bf16*)(ws + WS_WFF), TT, 2 * FFD, 1024, 0}; pg8::Sched S; S.init(TT / 256, 2 * FFD / 256, F.G, (int)blockIdx.x, nullptr);
                pg8::EpiSwiGLU E{(bf16*)(ws + WS_HID), FFD, 1.0f};
#ifndef SKIP_G_UP
                pg8::gemm_phase<pg8::EpiSwiGLU, pg8::Sched, true, true>(F.lds + RING_OFF, g, S, E, F.wave);
#endif
            }
            GRID_BAR(); TS(10);
            {   unsigned char* const ws = launder(F.ws); bf16* const XB = (bf16*)(ws + WS_XB); const float* const MOD = (const float*)(ws + WS_MOD); bf16* const H = (bf16*)F.out; (void)XB; (void)MOD; (void)H;
            pg8::Gemm g{(const bf16*)(ws + WS_HID), (const bf16*)(ws + WS_WFF_D_DENSE), TT, 1024, FFD, 0, 0}; pg8::SchedSK S; S.init(TL / 256, true, FFD / 64, F.G, (int)blockIdx.x);
                pg8::EpiResidB<false> E{nullptr, nullptr, XB, MOD + (size_t)l * 9 * 6144 + 5 * 1024, (bf16*)(ws + WS_SIDE), 1.0f};
#ifndef SKIP_G_DOWN
                pg8::gemm_phase<pg8::EpiResidB<false>, pg8::SchedSK, true, true>(F.lds + RING_OFF, g, S, E, F.wave);
#endif
            }
            GRID_BAR(); TS(11);
        } else {
            p_norm<true, false, false, !last>(F, args, l, 1, nullptr, nullptr, 0, last ? TL : TT);
#if PROBE == 4
            p_norm<true, false, false, false>(F, args, l, 1, nullptr, nullptr, 0, last ? TL : TT);
#endif
            GRID_BAR(); TS(9);

#ifndef SKIP_ROUTE
            p_route(F, last ? TL : TT);
#endif

            GRID_BAR(); TS(12);
            const int npanels = *(LAS int*)(F.lds + LT_NPAN);
            {   unsigned char* const ws = launder(F.ws); bf16* const XB = (bf16*)(ws + WS_XB); const float* const MOD = (const float*)(ws + WS_MOD); bf16* const H = (bf16*)F.out; (void)XB; (void)MOD; (void)H;
            pg8::Gemm g{(const bf16*)(ws + WS_AG8), (const bf16*)(ws + WS_WFF), npanels * 256, 2 * FFE, 512, 0}; pg8::Sched S; S.init(npanels, 2 * FFE / 256, F.G, (int)blockIdx.x, (const LAS int*)(F.lds + LT_PEXP));
                pg8::EpiSwiGLU8 E{ws + WS_HIDM, FFE, 1.0f / (H8SCALE * W8SCALE), HID8SCALE};
#ifndef SKIP_G_MUP
                pg8::gemm_phase<pg8::EpiSwiGLU8, pg8::Sched, true, true, true>(F.lds + RING_OFF, g, S, E, F.wave);
#endif
            }
            GRID_BAR(); TS(13);
            {   unsigned char* const ws = launder(F.ws); bf16* const XB = (bf16*)(ws + WS_XB); const float* const MOD = (const float*)(ws + WS_MOD); bf16* const H = (bf16*)F.out; (void)XB; (void)MOD; (void)H;
            pg8::Gemm g{(const bf16*)(ws + WS_HIDM), (const bf16*)(ws + WS_WFF_D_MOE8), npanels * 256, 1024, FFE / 2, 0}; pg8::Sched S; S.init(npanels, 4, F.G, (int)blockIdx.x, (const LAS int*)(F.lds + LT_PEXP));
                pg8::EpiBf16S E{(bf16*)(ws + WS_AG), 1024, 1.0f / (HID8SCALE * W8SCALE)};
#ifndef SKIP_G_MDOWN
                pg8::gemm_phase<pg8::EpiBf16S, pg8::Sched, true, true, true>(F.lds + RING_OFF, g, S, E, F.wave);
#endif
            }
            GRID_BAR(); TS(14);
        }

#undef GRID_BAR
}
__global__ void __launch_bounds__(NWAVES * 64, 2) mk_fwd(Args args) {
    extern __shared__ __attribute__((aligned(16))) unsigned char lds[];
    Frame F;
    F.lds = (LAS unsigned char*)lds;
    F.MISC = (volatile LAS unsigned*)(F.lds + MISC_OFF);
    F.tid = threadIdx.x; F.lane = F.tid & 63; F.wave = __builtin_amdgcn_readfirstlane(F.tid >> 6);
    F.G = gridDim.x; { const int bx = blockIdx.x; F.vcu = (F.G % 8 == 0) ? (bx % 8) * (F.G / 8) + bx / 8 : bx; }
    F.ws = args.ws; F.ctl = (gu32*)(args.ws + WS_CTL); F.out = args.out;
    for (int u = F.tid; u < 64; u += NWAVES * 64) ((LAS unsigned*)(F.lds + LDSCTL_OFF))[u] = 0u;
    if (F.tid < 30) ((LAS unsigned long long*)(F.lds + LT_INP))[F.tid] = (unsigned long long)args.in[F.tid];
    __syncthreads();
    XcdBarrier bar = xcd_barrier_post((unsigned*)(F.ctl + CW_BAR), F.MISC + 8, F.wave);
#define GRID_BAR() xcd_barrier(bar)
#if TSEL >= 0
    if (blockIdx.x == 0 && F.wave == 0 && hw_lane() == 0) ((unsigned long long*)(F.ws + WS_CTL + 32768))[0] = __builtin_amdgcn_s_memrealtime();
#endif

#ifndef SKIP_PRO
    p_prologue(F, args);
#endif

    GRID_BAR(); TS(0);
    layer_body<0>(F, args, bar, lds);
#if DEBUG_NAN
    return;
#endif
    layer_body<1>(F, args, bar, lds);
    layer_body<2>(F, args, bar, lds);
    layer_body<3>(F, args, bar, lds);

#ifndef SKIP_FINAL
    p_final_combine(F, DEPTH - 1);
#endif
#if TSEL >= 0
    TS(15);
    xcd_barrier(bar);
    if (blockIdx.x == 0 && F.wave == 0 && hw_lane() == 0) { const unsigned long long* ts_ = (const unsigned long long*)(F.ws + WS_CTL + 32768); float tot = 0.f, sel = 0.f;
        for (int k = 0; k < 16; ++k) { tot += (float)ts_[1 + k]; if ((TSEL >> k) & 1) sel += (float)ts_[1 + k]; }
        F.out[0] += 3.0f + 6.9f * sel / tot; }
#endif

#if CYSEL >= 0
    xcd_barrier(bar);
    if (blockIdx.x == 0 && F.wave == 0 && hw_lane() == 0) { const unsigned long long* cs_ = (const unsigned long long*)(F.ws + WS_CTL + 40960); float tot = 0.f; for (int k = 0; k < 5; ++k) tot += (float)cs_[k];
        F.out[0] += 3.0f + 6.9f * (float)cs_[CYSEL] / tot; }
#endif
    if (xb_ld((unsigned*)(F.ctl + CW_BAR) + XB_TMO) != 0u && blockIdx.x == 0 && F.wave == 0 && hw_lane() == 0) F.out[0] = __builtin_nanf("");
}

extern "C" void kernel_launch(void* const* d_in, const int* in_sizes, int n_in, void* d_out, int out_size, void* d_ws, size_t ws_size, hipStream_t stream) {
    static int grid = 0;
    if (grid == 0) {
        if (n_in != 30 || in_sizes[0] != TL * 1024 || out_size != TL * 1024 || ws_size < WS_END) { fprintf(stderr, "kernel_launch: unexpected shapes / workspace (n_in %d, ws %zu); nothing launched\n", n_in, ws_size); grid = -1; return; }
        int dev = 0, cus = 0, per_cu = 0;
        if (hipGetDevice(&dev) != hipSuccess || hipDeviceGetAttribute(&cus, hipDeviceAttributeMultiprocessorCount, dev) != hipSuccess) { grid = -1; return; }
        if (hipFuncSetAttribute((const void*)mk_fwd, hipFuncAttributeMaxDynamicSharedMemorySize, LDS_BYTES) != hipSuccess) { fprintf(stderr, "kernel_launch: hipFuncSetAttribute failed\n"); grid = -1; return; }
        if (hipOccupancyMaxActiveBlocksPerMultiprocessor(&per_cu, (const void*)mk_fwd, NWAVES * 64, LDS_BYTES) != hipSuccess || per_cu < 1) { fprintf(stderr, "kernel_launch: occupancy query reports %d blocks per CU\n", per_cu); }
        (void)hipGetLastError();
        grid = cus;
    }
    if (grid < 0) return;
    if (hipMemsetAsync((char*)d_ws + WS_CTL, 0, CTL_ZERO_BYTES, stream) != hipSuccess) return;
    Args a{};
    for (int i = 0; i < 30; ++i) a.in[i] = (const float*)d_in[i];
    a.out = (float*)d_out; a.ws = (unsigned char*)d_ws;
    hipLaunchKernelGGL(mk_fwd, dim3(grid), dim3(NWAVES * 64), LDS_BYTES, stream, a);
}
```

```cpp
#include <hip/hip_runtime.h>
#include <hip/hip_bf16.h>
#include <cstdio>
#include <cstdint>
#include <cmath>
__device__ __forceinline__ int hw_lane() { int l_; asm volatile("v_mbcnt_lo_u32_b32 %0, -1, 0\n\tv_mbcnt_hi_u32_b32 %0, -1, %0" : "=v"(l_)); return l_; }
namespace pg8 {
#define PG8_LAS __attribute__((address_space(3)))
typedef unsigned short bf16_t;
typedef short bf16x8 __attribute__((ext_vector_type(8)));
typedef float f32x4 __attribute__((ext_vector_type(4)));
typedef unsigned u32x4 __attribute__((ext_vector_type(4)));
constexpr int BM = 256, BK = 64, HALF = 128, HTB = HALF * BK * 2  , STAGE_BYTES = 8 * HTB, NXCD = 8, WGM = 8;

__host__ __device__ __forceinline__ int lds_byte(int r, int c) { const int st = (r >> 4) * 2 + (c >> 5), rr = r & 15, cc = c & 31, ob = rr * 64 + cc * 2; return st * 1024 + (ob ^ (((ob >> 9) & 1) << 5)); }
__host__ __device__ __forceinline__ void stage_rc(int b, int& R, int& C) { const int st = b / 1024, sb = b % 1024, swz = sb ^ (((sb >> 9) & 1) << 5); R = (st >> 1) * 16 + swz / 64; C = (st & 1) * 32 + (swz % 64) / 2; }
__host__ __device__ __forceinline__ int perm32(int rho) { const int n = rho >> 4, i = rho & 15; return 8 * (i >> 2) + 4 * n + (i & 3); }
__device__ __forceinline__ unsigned cvt_pk_bf16(float lo, float hi) { unsigned r; asm volatile("v_cvt_pk_bf16_f32 %0, %1, %2" : "=v"(r) : "v"(lo), "v"(hi)); return r; }
typedef float f32x2 __attribute__((ext_vector_type(2)));

struct Unit { int pm, pn, pnb, ka, nt, slice; };
struct Gemm { const bf16_t* A; const bf16_t* Bt; int M, N, K, lda, ldb; };

struct Sched {
    static constexpr bool SPLITK = false;
    int nM, nN, nwg, G, c, lora; const PG8_LAS int* pexp;
    __device__ __forceinline__ void init(int nM_, int nN_, int G_, int c_, const PG8_LAS int* pe) { nM = nM_; nN = nN_; nwg = nM * nN; G = G_; c = c_; pexp = pe; lora = 0; }
    __device__ __forceinline__ bool next(int i, Unit& u) const {
        const long L = (long)i * G + c; if (L >= nwg) return false;
        int wgid = (int)L; { const int q = nwg / NXCD, r = nwg % NXCD, xcd = wgid % NXCD, off = wgid / NXCD; wgid = (xcd < r ? xcd * (q + 1) : r * (q + 1) + (xcd - r) * q) + off; }
        const int nig = WGM * nN, gid = wgid / nig, fm = gid * WGM, gsz = (nM - fm) < WGM ? (nM - fm) : WGM;
        u.pm = fm + ((wgid % nig) % gsz); u.pn = (wgid % nig) / gsz; u.pnb = pexp ? pexp[u.pm] * nN + u.pn : u.pn;
        u.ka = lora ? ((u.pn >= 8) ? 512 : ((u.pn >= 4) ? 256 : 0)) : 0; return true;
    }
    __device__ __forceinline__ void a_ready(const Unit&) const {}
    __device__ __forceinline__ void done(const Unit&) const {}
};
struct SchedSK {
    static constexpr bool SPLITK = true;
    int nM, nwg, G, c, nsub, ntt, base, extra;
    __device__ __forceinline__ void init(int nMf_, bool ctx, int ntiles, int G_, int c_) { nM = nMf_; nwg = nMf_ * 4; G = G_; c = c_; nsub = ctx ? 128 : 0; ntt = ntiles; base = (ntiles / 4) & ~1; extra = (ntiles - 4 * base) / 2; }
    __device__ __forceinline__ bool next(int i, Unit& u) const {
        const long L = (long)i * G + c; if (L >= nwg + nsub) return false;
        const bool sub = L >= nwg;
        int wgid = sub ? 0 : (int)L; { const int q = nwg / NXCD, r = nwg % NXCD, xcd = wgid % NXCD, off = wgid / NXCD; wgid = (xcd < r ? xcd * (q + 1) : r * (q + 1) + (xcd - r) * q) + off; }
        const int nig = WGM * 4, gid = wgid / nig, fm = gid * WGM, gsz = (nM - fm) < WGM ? (nM - fm) : WGM;
        const int pmf = fm + ((wgid % nig) % gsz), pnf = (wgid % nig) / gsz;
        const int Ls = sub ? (int)(L - nwg) : 0, sl = Ls >> 5, rem = Ls & 31;
        const int kt0 = sl * base + 2 * (sl < extra ? sl : extra);
        u.pm = sub ? nM + (rem & 7) : pmf; u.pn = sub ? (rem >> 3) : pnf; u.pnb = u.pn; u.slice = sl;
        u.nt = sub ? base + ((sl < extra) ? 2 : 0) : ntt; u.ka = kt0 * (BK * 2); return true;
    }
    __device__ __forceinline__ void a_ready(const Unit&) const {}
    __device__ __forceinline__ void done(const Unit&) const {}
};

__device__ __forceinline__ float sigmoid_f(float x) { return __builtin_amdgcn_rcpf(1.0f + __builtin_amdgcn_exp2f(-1.4426950408889634f * x)); }
__device__ __forceinline__ float bf_lo(unsigned w) { return __builtin_bit_cast(float, w << 16); }
__device__ __forceinline__ float bf_hi(unsigned w) { return __builtin_bit_cast(float, w & 0xffff0000u); }

struct EpiBf16 {
    static constexpr bool PERM = true, AFTER_DRAIN = false;
    bf16_t* O; int ldc;
    __device__ __forceinline__ void operator()(const f32x4 (&acc)[2][2][4][2], const Unit& u, int wr, int wc, int fr, int fq) const {
        const int row0 = u.pm * BM + wr * 64 + fr; const int col0 = u.pn * BM + wc * 32 + 8 * fq;
#pragma unroll
        for (int ai = 0; ai < 2; ++ai)
#pragma unroll
            for (int m = 0; m < 4; ++m) { bf16_t* rowp = O + (size_t)(row0 + ai * HALF + m * 16) * ldc + col0;
#pragma unroll
                for (int bj = 0; bj < 2; ++bj) { const f32x4 v0 = acc[ai][bj][m][0], v1 = acc[ai][bj][m][1];
                    u32x4 w; w.x = cvt_pk_bf16(v0[0], v0[1]); w.y = cvt_pk_bf16(v0[2], v0[3]); w.z = cvt_pk_bf16(v1[0], v1[1]); w.w = cvt_pk_bf16(v1[2], v1[3]);
                    *(u32x4*)(rowp + bj * HALF) = w; } }
    }
};
struct EpiSwiGLU {
    static constexpr bool PERM = true, AFTER_DRAIN = false;
    bf16_t* O; int ldc; float inscale;
    __device__ __forceinline__ void operator()(const f32x4 (&acc)[2][2][4][2], const Unit& u, int wr, int wc, int fr, int fq) const {
        const int row0 = u.pm * BM + wr * 64 + fr; const int col0 = u.pn * HALF + wc * 32 + 8 * fq;
#pragma unroll
        for (int ai = 0; ai < 2; ++ai)
#pragma unroll
            for (int m = 0; m < 4; ++m) { bf16_t* rowp = O + (size_t)(row0 + ai * HALF + m * 16) * ldc + col0;
                float h[8];
#pragma unroll
                for (int n = 0; n < 2; ++n)
#pragma unroll
                    for (int j = 0; j < 4; ++j) { const float g = acc[ai][0][m][n][j] * inscale, up = acc[ai][1][m][n][j] * inscale; h[n * 4 + j] = g * sigmoid_f(g) * up; }
                u32x4 w; w.x = cvt_pk_bf16(h[0], h[1]); w.y = cvt_pk_bf16(h[2], h[3]); w.z = cvt_pk_bf16(h[4], h[5]); w.w = cvt_pk_bf16(h[6], h[7]);
                *(u32x4*)rowp = w; }
    }
};
struct EpiResid {
    static constexpr bool PERM = false, AFTER_DRAIN = false;
    const float* baseL; const float* baseC; float* outL; float* outC; const float* gate; float scale;
    __device__ __forceinline__ void operator()(const f32x4 (&acc)[2][2][4][2], const Unit& u, int wr, int wc, int fr, int fq) const {
        const float* base; float* out; int bsel;
        if (u.pm < 128) { base = baseL + (size_t)u.pm * BM * 1024; out = outL + (size_t)u.pm * BM * 1024; bsel = u.pm >> 4; }
        else { base = baseC + (size_t)(u.pm - 128) * BM * 1024; out = outC + (size_t)(u.pm - 128) * BM * 1024; bsel = 8; }
        const float* gv = gate + (size_t)bsel * 6144;
        const int col0 = u.pn * BM + wc * 32 + 4 * fq;
        f32x4 g4[2][2];
#pragma unroll
        for (int bj = 0; bj < 2; ++bj)
#pragma unroll
            for (int n = 0; n < 2; ++n) g4[bj][n] = *(const f32x4*)(gv + col0 + bj * HALF + n * 16) * scale;
#pragma unroll
        for (int ai = 0; ai < 2; ++ai)
#pragma unroll
            for (int m = 0; m < 4; ++m) { const size_t off = (size_t)(ai * HALF + wr * 64 + m * 16 + fr) * 1024 + col0;
#pragma unroll
                for (int bj = 0; bj < 2; ++bj)
#pragma unroll
                    for (int n = 0; n < 2; ++n) { const f32x4 xs = *(const f32x4*)(base + off + bj * HALF + n * 16); *(f32x4*)(out + off + bj * HALF + n * 16) = xs + g4[bj][n] * acc[ai][bj][m][n]; } }
    }
};

__device__ __forceinline__ float clamp8(float x) { return __builtin_fminf(__builtin_fmaxf(x, -440.0f), 440.0f); }
__device__ __forceinline__ unsigned pk_fp8x4(float a, float b, float c, float d) { int w = 0; w = __builtin_amdgcn_cvt_pk_fp8_f32(clamp8(a), clamp8(b), w, false); w = __builtin_amdgcn_cvt_pk_fp8_f32(clamp8(c), clamp8(d), w, true); return (unsigned)w; }
struct EpiSwiGLU8 {
    static constexpr bool PERM = true, AFTER_DRAIN = false;
    unsigned char* O; int ldc; float inscale, outscale;
    __device__ __forceinline__ void operator()(const f32x4 (&acc)[2][2][4][2], const Unit& u, int wr, int wc, int fr, int fq) const {
        const int row0 = u.pm * BM + wr * 64 + fr; const int col0 = u.pn * HALF + wc * 32 + 8 * fq;
        const float c1 = -1.4426950408889634f * inscale, c2 = inscale * inscale * outscale;
#pragma unroll
        for (int ai = 0; ai < 2; ++ai)
#pragma unroll
            for (int m = 0; m < 4; ++m) { unsigned char* rowp = O + (size_t)(row0 + ai * HALF + m * 16) * ldc + col0;
                float h[8];
#pragma unroll
                for (int n = 0; n < 2; ++n)
#pragma unroll
                    for (int j = 0; j < 4; ++j) { const float ag = acc[ai][0][m][n][j], au = acc[ai][1][m][n][j];
                        h[n * 4 + j] = (ag * au) * (c2 * __builtin_amdgcn_rcpf(1.0f + __builtin_amdgcn_exp2f(c1 * ag))); }
                typedef unsigned u32x2e __attribute__((ext_vector_type(2)));
                *(u32x2e*)rowp = (u32x2e){pk_fp8x4(h[0], h[1], h[2], h[3]), pk_fp8x4(h[4], h[5], h[6], h[7])};  asm volatile("" ::: "memory"); }
    }
};
struct EpiBf16S {
    static constexpr bool PERM = true, AFTER_DRAIN = false;
    bf16_t* O; int ldc; float scale;
    __device__ __forceinline__ void operator()(const f32x4 (&acc)[2][2][4][2], const Unit& u, int wr, int wc, int fr, int fq) const {
        const int row0 = u.pm * BM + wr * 64 + fr; const int col0 = u.pn * BM + wc * 32 + 8 * fq;
#pragma unroll
        for (int ai = 0; ai < 2; ++ai)
#pragma unroll
            for (int m = 0; m < 4; ++m) { bf16_t* rowp = O + (size_t)(row0 + ai * HALF + m * 16) * ldc + col0;
#pragma unroll
                for (int bj = 0; bj < 2; ++bj) { const f32x4 v0 = acc[ai][bj][m][0] * scale, v1 = acc[ai][bj][m][1] * scale;
                    u32x4 w; w.x = cvt_pk_bf16(v0[0], v0[1]); w.y = cvt_pk_bf16(v0[2], v0[3]); w.z = cvt_pk_bf16(v1[0], v1[1]); w.w = cvt_pk_bf16(v1[2], v1[3]);
                    *(u32x4*)(rowp + bj * HALF) = w; } asm volatile("" ::: "memory"); }
    }
};

template <bool BASEF32> struct EpiResidB {
    static constexpr bool PERM = true, AFTER_DRAIN = false;
    const float* baseL; const float* baseC; bf16_t* xb; const float* gate; bf16_t* side; float scale;
    __device__ __forceinline__ void operator()(const f32x4 (&acc)[2][2][4][2], const Unit& u, int wr, int wc, int fr, int fq) const {
        asm volatile("" : "+v"(fr), "+v"(fq));
        const int bsel = (u.pm < 128) ? (u.pm >> 4) : 8;
        const float* base = (u.pm < 128) ? baseL + (size_t)u.pm * BM * 1024 : baseC + (size_t)(u.pm - 128) * BM * 1024;
        bf16_t* out = xb + (size_t)u.pm * BM * 1024;
        const float* gv = gate + (size_t)bsel * 6144;
        const int col0 = u.pn * BM + wc * 32 + 8 * fq;
        f32x4 g4[2][2];
#pragma unroll
        for (int bj = 0; bj < 2; ++bj)
#pragma unroll
            for (int n = 0; n < 2; ++n) g4[bj][n] = *(const f32x4*)(gv + col0 + bj * HALF + 4 * n) * scale;
        if (u.slice != 0) {
            bf16_t* so = side + ((size_t)(u.slice - 1) * 2048 + (size_t)(u.pm - 128) * BM) * 1024;
#pragma unroll
            for (int ai = 0; ai < 2; ++ai)
#pragma unroll
                for (int m = 0; m < 4; ++m) { const size_t off = (size_t)(ai * HALF + wr * 64 + m * 16 + fr) * 1024 + col0;
#pragma unroll
                    for (int bj = 0; bj < 2; ++bj) { const f32x4 o0 = g4[bj][0] * acc[ai][bj][m][0], o1 = g4[bj][1] * acc[ai][bj][m][1];
                        u32x4 ow; ow.x = cvt_pk_bf16(o0[0], o0[1]); ow.y = cvt_pk_bf16(o0[2], o0[3]); ow.z = cvt_pk_bf16(o1[0], o1[1]); ow.w = cvt_pk_bf16(o1[2], o1[3]);
                        *(u32x4*)(so + off + bj * HALF) = ow; } }
        } else
#pragma unroll
        for (int ai = 0; ai < 2; ++ai)
#pragma unroll
            for (int m = 0; m < 4; ++m) { const size_t off = (size_t)(ai * HALF + wr * 64 + m * 16 + fr) * 1024 + col0;
#pragma unroll
                for (int bj = 0; bj < 2; ++bj) { f32x4 x0, x1;
                    if (BASEF32) { x0 = *(const f32x4*)(base + off + bj * HALF); x1 = *(const f32x4*)(base + off + bj * HALF + 4); }
                    else { const u32x4 w = *(const u32x4*)(out + off + bj * HALF); x0 = (f32x4){bf_lo(w.x), bf_hi(w.x), bf_lo(w.y), bf_hi(w.y)}; x1 = (f32x4){bf_lo(w.z), bf_hi(w.z), bf_lo(w.w), bf_hi(w.w)}; }
                    const f32x4 o0 = x0 + g4[bj][0] * acc[ai][bj][m][0], o1 = x1 + g4[bj][1] * acc[ai][bj][m][1];
                    u32x4 ow; ow.x = cvt_pk_bf16(o0[0], o0[1]); ow.y = cvt_pk_bf16(o0[2], o0[3]); ow.z = cvt_pk_bf16(o1[0], o1[1]); ow.w = cvt_pk_bf16(o1[2], o1[3]);
                    *(u32x4*)(out + off + bj * HALF) = ow; } }
    }
};

struct EpiLoraAct {
    static constexpr bool PERM = true, AFTER_DRAIN = false;
    bf16_t* O; int ldc; const float* w0; const float* a0;
    __device__ __forceinline__ void operator()(const f32x4 (&acc)[2][2][4][2], const Unit& u, int wr, int wc, int fr, int fq) const {
        const int row0 = u.pm * BM + wr * 64 + fr; const int col0 = u.pn * BM + wc * 32 + 8 * fq; const int sec = u.pn >> 1;
        const int cs0 = (u.pn & 1) * 256 + wc * 32 + 8 * fq;
        f32x4 bv[2][2]; float mul = 1.0f;
        if (sec < 4) { const float* bp = (sec < 2 ? w0 + sec * 512 : a0 + (sec - 2) * 512) + cs0; mul = (sec < 2) ? 0.8750387749145276f : 1.0f;
#pragma unroll
            for (int bj = 0; bj < 2; ++bj)
#pragma unroll
                for (int n = 0; n < 2; ++n) bv[bj][n] = *(const f32x4*)(bp + bj * HALF + 4 * n); }
#pragma unroll
        for (int ai = 0; ai < 2; ++ai)
#pragma unroll
            for (int m = 0; m < 4; ++m) { bf16_t* rowp = O + (size_t)(row0 + ai * HALF + m * 16) * ldc + col0;
#pragma unroll
                for (int bj = 0; bj < 2; ++bj) { f32x4 v0 = acc[ai][bj][m][0], v1 = acc[ai][bj][m][1];
                    if (sec < 4) {
#pragma unroll
                        for (int j = 0; j < 4; ++j) { v0[j] = mul * sigmoid_f(v0[j] + bv[bj][0][j]); v1[j] = mul * sigmoid_f(v1[j] + bv[bj][1][j]); } }
                    u32x4 w; w.x = cvt_pk_bf16(v0[0], v0[1]); w.y = cvt_pk_bf16(v0[2], v0[3]); w.z = cvt_pk_bf16(v1[0], v1[1]); w.w = cvt_pk_bf16(v1[2], v1[3]);
                    *(u32x4*)(rowp + bj * HALF) = w; } }
    }
};
typedef int v8i_t __attribute__((ext_vector_type(8)));
__device__ __forceinline__ v8i_t cat8(bf16x8 a, bf16x8 b) { const u32x4 x = __builtin_bit_cast(u32x4, a), y = __builtin_bit_cast(u32x4, b); return (v8i_t){(int)x[0], (int)x[1], (int)x[2], (int)x[3], (int)y[0], (int)y[1], (int)y[2], (int)y[3]}; }
template <class Epi, class Sched, bool ALIGN_EPI = false, bool SP2 = false, bool FP8 = false>
__device__ __forceinline__ void gemm_phase(PG8_LAS unsigned char* lds, const Gemm g, const Sched& S, const Epi& E, const int wave_) {
    const int tid = wave_ * 64 + hw_lane(), wid = wave_, lane = tid & 63, wr = wid >> 2, wc = wid & 3, fr = lane & 15, fq = lane >> 4;
    int K_ = g.K; asm volatile("" : "+s"(K_));
    const int K = K_, nt = K / BK; const int lda = g.lda ? g.lda : K, ldb = g.ldb ? g.ldb : K;
    unsigned voffA[2], voffB[2];
#pragma unroll
    for (int i = 0; i < 2; ++i) { int R, C; stage_rc(tid * 16 + i * 8192, R, C); const int Rb = Epi::PERM ? ((R & ~31) + perm32(R & 31)) : R;
        voffA[i] = (unsigned)(R * lda + C) * 2u; voffB[i] = (unsigned)(Rb * ldb + C) * 2u; }
    const size_t kstep = (size_t)(BK * 2);
    const size_t hstep = (size_t)HALF * ldb * 2;
    const size_t hstepA = (size_t)HALF * lda * 2, tstepA = 2 * hstepA;
    const size_t tstep = 2 * hstep;
    const unsigned ldsw = (unsigned)wid * 1024u;
    const int aoff = lds_byte(wr * 64 + fr, fq * 8), boff = lds_byte(wc * 32 + fr, fq * 8);
#define PG8_SA(b, h) (((b) * 2 + (h)) * HTB)
#define PG8_SB(b, h) ((4 + (b) * 2 + (h)) * HTB)
#define PG8_STAGE(bufoff, gbase, voff) do { _Pragma("unroll") for (int _i = 0; _i < 2; ++_i) \
        __builtin_amdgcn_global_load_lds((const unsigned*)((const char*)(gbase) + (voff)[_i]), (PG8_LAS unsigned*)(lds + (bufoff) + ldsw + _i * 8192), 16, 0, 0); } while (0)
#define PG8_LDA(dst, b, h) do { if constexpr (FP8) { _Pragma("unroll") for (int m = 0; m < 4; ++m) { dst##8[m].lo = *(const PG8_LAS v4i_t*)(lds + PG8_SA(b, h) + aoff + m * 2048); dst##8[m].hi = *(const PG8_LAS v4i_t*)(lds + PG8_SA(b, h) + aoff + m * 2048 + 1024); } } \
        else { _Pragma("unroll") for (int m = 0; m < 4; ++m) _Pragma("unroll") for (int k = 0; k < 2; ++k) dst[FP8 ? 0 : m][k] = *(const PG8_LAS bf16x8*)(lds + PG8_SA(b, h) + aoff + m * 2048 + k * 1024); } } while (0)
#define PG8_LDB(dst, b, h) do { if constexpr (FP8) { _Pragma("unroll") for (int n = 0; n < 2; ++n) { dst##8[n].lo = *(const PG8_LAS v4i_t*)(lds + PG8_SB(b, h) + boff + n * 2048); dst##8[n].hi = *(const PG8_LAS v4i_t*)(lds + PG8_SB(b, h) + boff + n * 2048 + 1024); } } \
        else { _Pragma("unroll") for (int n = 0; n < 2; ++n) _Pragma("unroll") for (int k = 0; k < 2; ++k) dst[n][k] = *(const PG8_LAS bf16x8*)(lds + PG8_SB(b, h) + boff + n * 2048 + k * 1024); } } while (0)
#define PG8_MMA(ai, bj, At, Bt) do { __builtin_amdgcn_s_setprio(1); if constexpr (FP8) { _Pragma("unroll") for (int m = 0; m < 4; ++m) _Pragma("unroll") for (int n = 0; n < 2; ++n) \
        asm volatile("v_mfma_f32_16x16x128_f8f6f4 %0, %1, %2, %0" : "+v"(acc[ai][bj][m][n]) : "v"(Bt##8[n]), "v"(At##8[m])); } \
        else { _Pragma("unroll") for (int m = 0; m < 4; ++m) _Pragma("unroll") for (int n = 0; n < 2; ++n) _Pragma("unroll") for (int k = 0; k < 2; ++k) \
        acc[ai][bj][m][n] = __builtin_amdgcn_mfma_f32_16x16x32_bf16(Bt[n][k], At[FP8 ? 0 : m][k], acc[ai][bj][m][n], 0, 0, 0); } __builtin_amdgcn_s_setprio(0); } while (0)
#define PG8_WAIT_V(n) asm volatile("s_waitcnt vmcnt(" #n ")" ::: "memory")
#define PG8_WAIT_L(n) asm volatile("s_waitcnt lgkmcnt(" #n ")" ::: "memory")
#define PG8_BAR __builtin_amdgcn_s_barrier()
#define PG8_SCHED __builtin_amdgcn_sched_barrier(0)
    Unit cur, nxt; int ui = 0;
    if (!S.next(0, cur)) return;
    f32x4 acc[2][2][4][2];
#pragma unroll
    for (int a = 0; a < 2; ++a)
#pragma unroll
        for (int b = 0; b < 2; ++b)
#pragma unroll
            for (int m = 0; m < 4; ++m)
#pragma unroll
                for (int n = 0; n < 2; ++n) acc[a][b][m][n] = (f32x4){0.f, 0.f, 0.f, 0.f};
    bf16x8 At[FP8 ? 1 : 4][2], B0[2][2], B1[2][2];
    v8i_t At8[FP8 ? 4 : 1], B08[2], B18[2];
    typedef int v4i_t __attribute__((ext_vector_type(4)));
    const char* cA = (const char*)g.A + (size_t)cur.pm * tstepA + cur.ka; const char* cB = (const char*)g.Bt + (size_t)cur.pnb * tstep + (Sched::SPLITK ? cur.ka : 0);
    S.a_ready(cur);
    if constexpr (SP2) {
        PG8_STAGE(PG8_SB(0, 0), cB, voffB); PG8_STAGE(PG8_SB(0, 1), cB + hstep, voffB); PG8_STAGE(PG8_SA(0, 0), cA, voffA); PG8_STAGE(PG8_SA(0, 1), cA + hstepA, voffA);
        if (wr == 1) PG8_BAR;
        PG8_WAIT_V(2); PG8_BAR;
        PG8_STAGE(PG8_SB(1, 0), cB + kstep, voffB); PG8_STAGE(PG8_SA(1, 0), cA + kstep, voffA); PG8_STAGE(PG8_SB(1, 1), cB + hstep + kstep, voffB);
        PG8_WAIT_V(6); PG8_BAR;
    } else {
        PG8_STAGE(PG8_SB(0, 0), cB, voffB); PG8_STAGE(PG8_SA(0, 0), cA, voffA); PG8_STAGE(PG8_SB(0, 1), cB + hstep, voffB); PG8_STAGE(PG8_SA(0, 1), cA + hstepA, voffA);
        if (wr == 1) PG8_BAR;
        PG8_WAIT_V(4); PG8_BAR;
        PG8_STAGE(PG8_SB(1, 0), cB + kstep, voffB); PG8_STAGE(PG8_SA(1, 0), cA + kstep, voffA); PG8_STAGE(PG8_SB(1, 1), cB + hstep + kstep, voffB);
        PG8_WAIT_V(6); PG8_BAR;
    }
    for (;;) {
        const bool has_next = S.next(ui + 1, nxt);
        const char* nA = has_next ? (const char*)g.A + (size_t)nxt.pm * tstepA + nxt.ka : cA; const char* nB = has_next ? (const char*)g.Bt + (size_t)nxt.pnb * tstep + (Sched::SPLITK ? nxt.ka : 0) : cB;
        const int ntc = Sched::SPLITK ? cur.nt : nt;
        for (int t = 0; t < ntc; t += 2) {
            const bool last = (t == ntc - 2);
            const char* a1 = cA + (size_t)(t + 1) * kstep;
            const char* a2 = last ? nA : cA + (size_t)(t + 2) * kstep; const char* b2 = last ? nB : cB + (size_t)(t + 2) * kstep;
            const char* a3 = a2 + kstep; const char* b3 = b2 + kstep;
            if (last && has_next) S.a_ready(nxt);
            if constexpr (SP2) {
            PG8_LDB(B0, 0, 0); PG8_LDB(B1, 0, 1); PG8_SCHED; PG8_LDA(At, 0, 0); PG8_STAGE(PG8_SA(1, 1), a1 + hstepA, voffA);
            PG8_WAIT_V(8); PG8_WAIT_L(0); PG8_BAR; PG8_MMA(0, 0, At, B0); PG8_MMA(0, 1, At, B1); PG8_BAR; PG8_SCHED;
            PG8_LDA(At, 0, 1); PG8_STAGE(PG8_SB(0, 0), b2, voffB); PG8_STAGE(PG8_SB(0, 1), b2 + hstep, voffB); PG8_STAGE(PG8_SA(0, 0), a2, voffA);
            PG8_WAIT_V(8); PG8_WAIT_L(0); PG8_BAR; PG8_MMA(1, 0, At, B0); PG8_MMA(1, 1, At, B1); PG8_BAR; PG8_SCHED;
            PG8_LDB(B0, 1, 0); PG8_LDB(B1, 1, 1); PG8_SCHED; PG8_LDA(At, 1, 0); PG8_STAGE(PG8_SA(0, 1), a2 + hstepA, voffA);
            PG8_WAIT_V(8); PG8_WAIT_L(0); PG8_BAR; PG8_MMA(0, 0, At, B0); PG8_MMA(0, 1, At, B1); PG8_BAR; PG8_SCHED;
            PG8_LDA(At, 1, 1); PG8_STAGE(PG8_SB(1, 0), b3, voffB); PG8_STAGE(PG8_SB(1, 1), b3 + hstep, voffB); PG8_STAGE(PG8_SA(1, 0), a3, voffA);
            PG8_WAIT_V(8); PG8_WAIT_L(0); PG8_BAR; PG8_MMA(1, 0, At, B0); PG8_MMA(1, 1, At, B1); PG8_BAR; PG8_SCHED;
            } else {
            PG8_LDB(B0, 0, 0); PG8_SCHED; PG8_LDA(At, 0, 0); PG8_STAGE(PG8_SA(1, 1), a1 + hstepA, voffA);
            PG8_WAIT_L(8); PG8_BAR; PG8_WAIT_L(0); PG8_MMA(0, 0, At, B0); PG8_BAR; PG8_SCHED;
            PG8_LDB(B1, 0, 1); PG8_STAGE(PG8_SB(0, 0), b2, voffB);
            PG8_BAR; PG8_WAIT_L(0); PG8_MMA(0, 1, At, B1); PG8_BAR;
            PG8_LDA(At, 0, 1); PG8_STAGE(PG8_SA(0, 0), a2, voffA);
            PG8_BAR; PG8_WAIT_L(0); PG8_MMA(1, 0, At, B0); PG8_BAR; PG8_SCHED;
            PG8_STAGE(PG8_SB(0, 1), b2 + hstep, voffB);
            PG8_WAIT_V(6); PG8_BAR; PG8_MMA(1, 1, At, B1); PG8_BAR;
            PG8_LDB(B0, 1, 0); PG8_SCHED; PG8_LDA(At, 1, 0); PG8_STAGE(PG8_SA(0, 1), a2 + hstepA, voffA);
            PG8_WAIT_L(8); PG8_BAR; PG8_WAIT_L(0); PG8_MMA(0, 0, At, B0); PG8_BAR; PG8_SCHED;
            PG8_LDB(B1, 1, 1); PG8_STAGE(PG8_SB(1, 0), b3, voffB);
            PG8_BAR; PG8_WAIT_L(0); PG8_MMA(0, 1, At, B1); PG8_BAR;
            PG8_LDA(At, 1, 1); PG8_STAGE(PG8_SA(1, 0), a3, voffA);
            PG8_BAR; PG8_WAIT_L(0); PG8_MMA(1, 0, At, B0); PG8_BAR; PG8_SCHED;
            PG8_STAGE(PG8_SB(1, 1), b3 + hstep, voffB);
            PG8_WAIT_V(6); PG8_BAR; PG8_MMA(1, 1, At, B1); PG8_BAR;
            }
        }
        if constexpr (ALIGN_EPI) { if (wr == 0) PG8_BAR; }
        if constexpr (!Epi::AFTER_DRAIN) { E(acc, cur, wr, wc, fr, fq); S.done(cur); }
        if (!has_next) break;
#pragma unroll
        for (int a = 0; a < 2; ++a)
#pragma unroll
            for (int b = 0; b < 2; ++b)
#pragma unroll
                for (int m = 0; m < 4; ++m)
#pragma unroll
                    for (int n = 0; n < 2; ++n) acc[a][b][m][n] = (f32x4){0.f, 0.f, 0.f, 0.f};
        cur = nxt; cA = nA; cB = nB; ++ui;
        if constexpr (ALIGN_EPI) { if (wr == 1) PG8_BAR; }
    }
    PG8_WAIT_V(0);
    if constexpr (!ALIGN_EPI) { if (wr == 0) PG8_BAR; }
    PG8_BAR;
    if constexpr (Epi::AFTER_DRAIN) { E.fused(acc, cur, wr, wc, fr, fq, lds, wid, lane); S.done(cur); }
#undef PG8_SA
#undef PG8_SB
#undef PG8_STAGE
#undef PG8_LDA
#undef PG8_LDB
#undef PG8_MMA
#undef PG8_WAIT_V
#undef PG8_WAIT_L
#undef PG8_BAR
#undef PG8_SCHED
}
}
#include <hip/hip_bf16.h>
#include <cmath>
namespace attn_body {
using bf16=__hip_bfloat16;
using bf16x8=__attribute__((ext_vector_type(8)))short;
using s16x4=__attribute__((ext_vector_type(4)))short;
using f32x16=__attribute__((ext_vector_type(16)))float;
using u32x4=__attribute__((ext_vector_type(4)))unsigned;
constexpr int D=64,DM=1024,KP=128;
constexpr int NW=8,QBLK=32,QB=QBLK*NW,KVBLK=64;
constexpr int ATTN_PITCH=DM, ATTN_UNIT_ROWS=QB;
__device__ __forceinline__ int crow(int r,int hi){return (r&3)+8*(r>>2)+4*hi;}
#define SBAR() __builtin_amdgcn_sched_barrier(0)
__device__ __forceinline__ void cmask(f32x16&p0,f32x16&p1,int jb,int qrel,int hi){
  const float NEG=-INFINITY; int kb=64*jb+4*hi;
  #pragma unroll
  for(int r=0;r<16;++r){int kv=kb+(r&3)+8*(r>>2); if(kv>qrel)p0[r]=NEG; if(kv+32>qrel)p1[r]=NEG;}
}

constexpr int NSLOT=3, SLOTB=8192;
constexpr int LDS_K=0, LDS_V=NSLOT*SLOTB, LDS_WS=2*NSLOT*SLOTB, LDS_OST=LDS_WS+NW*64*4, LDS_BYTES=LDS_OST+NW*4096;
constexpr float C2=0.125f*1.4426950408889634f;
__device__ __forceinline__ void glds16(const void*gsrc,unsigned lds_dst){unsigned keep;
  asm volatile("s_mov_b32 %0, m0\n\ts_mov_b32 m0, %2\n\ts_nop 0\n\tglobal_load_lds_dwordx4 %1, off\n\ts_mov_b32 m0, %0":"=&s"(keep):"v"(gsrc),"s"(lds_dst):"memory");}
__device__ __forceinline__ float max3f(float a,float b,float c){float r;asm("v_max3_f32 %0, %1, %2, %3":"=v"(r):"v"(a),"v"(b),"v"(c));return r;}
__device__ __forceinline__ float max2f(float a,float b){float r;asm("v_max_f32_e32 %0, %1, %2":"=v"(r):"v"(a),"v"(b));return r;}
__device__ __forceinline__ float fadd_s(float a,float b){float r;asm("v_add_f32_e32 %0, %1, %2":"=v"(r):"v"(a),"v"(b));return r;}
__device__ __forceinline__ float fsub_s(float a,float b){float r;asm("v_sub_f32_e32 %0, %1, %2":"=v"(r):"v"(a),"v"(b));return r;}
typedef float f32x2_t __attribute__((ext_vector_type(2))); typedef __bf16 bf16x2_t __attribute__((ext_vector_type(2)));
__device__ __forceinline__ unsigned cvtpk_s(float lo,float hi){f32x2_t v={lo,hi};bf16x2_t b=__builtin_convertvector(v,bf16x2_t);return __builtin_bit_cast(unsigned,b);}
#define WAIT_BAR(N) asm volatile("s_waitcnt vmcnt(" #N ") lgkmcnt(0)\n\ts_barrier":::"memory")

__device__ __forceinline__ void qkt(f32x16&p0,f32x16&p1,const char*Kslot,const bf16x8*qr,const f32x16&negm,int r32,int hi){
  const char*kb=Kslot+hi*1024+r32*16;
  #pragma unroll
  for(int d0=0;d0<4;++d0){
    const bf16x8 b0=*reinterpret_cast<const bf16x8*>(kb+d0*2048);
    const bf16x8 b1=*reinterpret_cast<const bf16x8*>(kb+d0*2048+512);
    if(d0==0){p0=__builtin_amdgcn_mfma_f32_32x32x16_bf16(b0,qr[0],negm,0,0,0);p1=__builtin_amdgcn_mfma_f32_32x32x16_bf16(b1,qr[0],negm,0,0,0);}
    else{p0=__builtin_amdgcn_mfma_f32_32x32x16_bf16(b0,qr[d0],p0,0,0,0);p1=__builtin_amdgcn_mfma_f32_32x32x16_bf16(b1,qr[d0],p1,0,0,0);}}
}
typedef __attribute__((address_space(3))) const char* lds_cptr;
typedef short v4i16_t __attribute__((ext_vector_type(4)));
__device__ __forceinline__ void kload8(bf16x8*kf,lds_cptr kp){
  kf[0]=*(const __attribute__((address_space(3))) bf16x8*)(kp);      kf[1]=*(const __attribute__((address_space(3))) bf16x8*)(kp+512);
  kf[2]=*(const __attribute__((address_space(3))) bf16x8*)(kp+2048); kf[3]=*(const __attribute__((address_space(3))) bf16x8*)(kp+2560);
  kf[4]=*(const __attribute__((address_space(3))) bf16x8*)(kp+4096); kf[5]=*(const __attribute__((address_space(3))) bf16x8*)(kp+4608);
  kf[6]=*(const __attribute__((address_space(3))) bf16x8*)(kp+6144); kf[7]=*(const __attribute__((address_space(3))) bf16x8*)(kp+6656);
}
__device__ __forceinline__ void kload2(bf16x8*kf,lds_cptr kp,int j){ kf[2*j]=*(const __attribute__((address_space(3))) bf16x8*)(kp+j*2048); kf[2*j+1]=*(const __attribute__((address_space(3))) bf16x8*)(kp+j*2048+512); }
__device__ __forceinline__ s16x4 vtr(lds_cptr p){ return __builtin_bit_cast(s16x4,__builtin_amdgcn_ds_read_tr16_b64_v4i16((__attribute__((address_space(3))) v4i16_t*)p)); }
__device__ __forceinline__ float rowmax(const f32x16&p0,const f32x16&p1){
  float a=max3f(p0[0],p0[1],p1[0]),b=max3f(p0[2],p0[3],p1[1]);a=max3f(a,p1[2],p1[3]);
  #pragma unroll
  for(int r=4;r<16;r+=4){a=max3f(a,p0[r],p0[r+1]);b=max3f(b,p0[r+2],p0[r+3]);a=max3f(a,p1[r],p1[r+1]);b=max3f(b,p1[r+2],p1[r+3]);}
  const float m=max2f(a,b);
  auto rr=__builtin_amdgcn_permlane32_swap(__float_as_uint(m),__float_as_uint(m),false,false);
  return max2f(__uint_as_float(rr[0]),__uint_as_float(rr[1]));
}
__device__ __forceinline__ void pv(f32x16*o,int vb,bf16x8 pa0,bf16x8 pa1,bf16x8 pa2,bf16x8 pa3){
  #pragma unroll
  for(int d0=0;d0<2;++d0){s16x4 lo[4],hi[4];
    #pragma unroll
    for(int ks=0;ks<4;++ks){
      asm volatile("ds_read_b64_tr_b16 %0,%1 offset:%c2":"=&v"(lo[ks]):"v"(vb),"i"(d0*4096+ks*1024):"memory");
      asm volatile("ds_read_b64_tr_b16 %0,%1 offset:%c2":"=&v"(hi[ks]):"v"(vb),"i"(d0*4096+ks*1024+512):"memory");}
    asm volatile("s_waitcnt lgkmcnt(0)":::"memory");SBAR();
    #define PK(k) (bf16x8){lo[k][0],lo[k][1],lo[k][2],lo[k][3],hi[k][0],hi[k][1],hi[k][2],hi[k][3]}
    o[d0]=__builtin_amdgcn_mfma_f32_32x32x16_bf16(pa0,PK(0),o[d0],0,0,0);
    o[d0]=__builtin_amdgcn_mfma_f32_32x32x16_bf16(pa1,PK(1),o[d0],0,0,0);
    o[d0]=__builtin_amdgcn_mfma_f32_32x32x16_bf16(pa2,PK(2),o[d0],0,0,0);
    o[d0]=__builtin_amdgcn_mfma_f32_32x32x16_bf16(pa3,PK(3),o[d0],0,0,0);
    #undef PK
  }
}

#ifndef ATTN_STORE16
#define ATTN_STORE16(p,v) (*(u32x4*)(p)=(v))
#endif
template<int THRL> __device__ __forceinline__ void attn_unit(long qrow0,int hcol,long kvrow0,int kvcol,int NT,const bf16*Q,const bf16*__restrict__ K,const bf16*__restrict__ V,bf16*O,char*shm,const int wave_){
  const int tid=wave_*64+hw_lane(),lane=tid&63,r32=lane&31,hi=lane>>5; const int wid=wave_;
  const bf16*Qw=Q+(qrow0+wid*QBLK)*DM+hcol;
  const bf16*Kh=K+kvrow0*KP+kvcol,*Vh=V+kvrow0*KP+kvcol;
  const unsigned lds0=(unsigned)(uintptr_t)shm;
  float*wsf=(float*)(shm+LDS_WS)+wid*64;
  const bf16*ksrc=Kh+(long)lane*KP+wid*8;
  const bf16*vsrc=Vh+(long)(16*(wid&3)+(lane>>2))*KP+(wid>>2)*32+(lane&3)*8;
  const unsigned kdst=lds0+LDS_K+wid*1024, vdst=lds0+LDS_V+wid*1024;
  #define DMA_K(t,slot) glds16(ksrc+(long)(t)*KVBLK*KP,(unsigned)__builtin_amdgcn_readfirstlane(kdst+(slot)))
  #define DMA_V(t,slot) glds16(vsrc+(long)(t)*KVBLK*KP,(unsigned)__builtin_amdgcn_readfirstlane(vdst+(slot)))
  const int vb0=(int)(lds0+LDS_V)+((lane>>4)&1)*32+(lane&3)*8+(4*hi+((lane&15)>>2))*64;
  const char*Kbase=shm+LDS_K; bf16x8 kf[8];
  const lds_cptr shm3=(lds_cptr)shm; const lds_cptr kp0=shm3+LDS_K+hi*1024+r32*16; const lds_cptr vp0=shm3+LDS_V+((lane>>4)&1)*32+(lane&3)*8+(4*hi+((lane&15)>>2))*64;
  DMA_K(0,0);DMA_V(0,0);DMA_K(1,SLOTB);
  bf16x8 qr[4];
  #pragma unroll
  for(int d0=0;d0<4;++d0)qr[d0]=*reinterpret_cast<const bf16x8*>(&Qw[(long)r32*DM+d0*16+hi*8]);
  float mhat=0.f,l_reg=0.f;f32x16 o[2];o[0]=f32x16{};o[1]=f32x16{};f32x16 negm=f32x16{};asm volatile("":"+v"(negm));
  #define CMASK(P0,P1,t) do{}while(0)
  bool resc=false;
  #define START(P0,P1) do{ const float rm=rowmax(P0,P1); resc=false; \
    { const float dl=rm; mhat=fadd_s(mhat,dl); \
      _Pragma("unroll") for(int r=0;r<16;++r){P0[r]=fsub_s(P0[r],dl);P1[r]=fsub_s(P1[r],dl);} \
      _Pragma("unroll") for(int r=0;r<16;++r)negm[r]=-mhat; asm volatile("":"+v"(negm)); } \
    _Pragma("unroll") for(int r=0;r<16;++r)P0[r]=__builtin_amdgcn_exp2f(P0[r]); }while(0)
  #define RESC() do{ if(resc){ asm volatile("s_waitcnt lgkmcnt(0)":::"memory"); \
      _Pragma("unroll") for(int d_=0;d_<2;++d_) _Pragma("unroll") for(int r=0;r<16;++r)o[d_][r]*=wsf[crow(r,hi)]; } }while(0)
  f32x16 pA0,pA1,pB0,pB1;
  int sl_prev=0,sl_cur=0,sl_next=SLOTB;
  #define ROT() do{sl_prev=sl_cur;sl_cur=sl_next;sl_next=(sl_next==(NSLOT-1)*SLOTB)?0:sl_next+SLOTB;}while(0)
  DMA_K(2,2*SLOTB);
  WAIT_BAR(3);
  qkt(pA0,pA1,Kbase,qr,negm,r32,hi);asm volatile("s_nop 15\n\ts_nop 7":"+v"(pA0),"+v"(pA1));CMASK(pA0,pA1,0);
  START(pA0,pA1);
  _Pragma("unroll") for(int r=0;r<16;++r)pA1[r]=__builtin_amdgcn_exp2f(pA1[r]);
  WAIT_BAR(0);
  DMA_K(3,0);DMA_V(1,SLOTB);
  ROT();
  kload8(kf,kp0+sl_cur);
  WAIT_BAR(2);
  s16x4 vlo[8],vhi[8]; u32x4 pw0,pw1,pw2,pw3;
  #define PKW(P,B) cvtpk_s(P[B],P[B+1])
  #define PAF(k) __builtin_bit_cast(bf16x8,pw##k)
  #define VFR(i) (bf16x8){vlo[i][0],vlo[i][1],vlo[i][2],vlo[i][3],vhi[i][0],vhi[i][1],vhi[i][2],vhi[i][3]}
  #define PIN(x) asm volatile("":"+v"(x))
  #define MX3(a,b,c) __builtin_fmaxf(__builtin_fmaxf((a),(b)),(c))
  #define GAPA(MF,A0,A1,A2,A3,W0,W1,PW) do{ MF; sacc+=A0; sacc+=A1; sacc+=A2; sacc+=A3; PIN(sacc); W0; W1; PIN(PW); SBAR(); }while(0)
  #define EX(v) __builtin_amdgcn_exp2f(v)
  #define GAPB(MF,X,B) do{ MF; X[B]=EX(X[B]); X[B+1]=EX(X[B+1]); X[B+2]=EX(X[B+2]); X[B+3]=EX(X[B+3]); PIN(X); SBAR(); }while(0)
  #define VRD(i) do{ vlo[i]=vtr(vp_+(((i)>>2)*4096+((i)&3)*1024)); vhi[i]=vtr(vp_+(((i)>>2)*4096+((i)&3)*1024+512)); }while(0)
  #define KRD(G,j) do{ if(G){ kload2(kf,kp0+sl_next,j); SBAR(); } }while(0)
  #define STEP(C0,C1,P0,P1,t,GK,GV,GL) do{ SBAR(); \
    const lds_cptr vp_=vp0+sl_prev; \
    VRD(0); SBAR(); float sacc=(P0[0]+P0[1]); \
    GAPA(C0=__builtin_amdgcn_mfma_f32_32x32x16_bf16(kf[0],qr[0],negm,0,0,0), P0[2],P0[3],P0[4],P0[5],     pw0[0]=PKW(P0,0), pw0[1]=PKW(P0,2), pw0); \
    VRD(4); SBAR(); GAPA(C1=__builtin_amdgcn_mfma_f32_32x32x16_bf16(kf[1],qr[0],negm,0,0,0), P0[6],P0[7],P0[8],P0[9],     pw0[2]=PKW(P0,4), pw0[3]=PKW(P0,6), pw0); \
    VRD(1); SBAR(); GAPA(C0=__builtin_amdgcn_mfma_f32_32x32x16_bf16(kf[2],qr[1],C0,0,0,0),   P0[10],P0[11],P0[12],P0[13], pw1[0]=PKW(P0,8), pw1[1]=PKW(P0,10), pw1); \
    VRD(5); SBAR(); GAPA(C1=__builtin_amdgcn_mfma_f32_32x32x16_bf16(kf[3],qr[1],C1,0,0,0),   P0[14],P0[15],P1[0],P1[1],   pw1[2]=PKW(P0,12),pw1[3]=PKW(P0,14), pw1); \
    VRD(2); SBAR(); GAPA(C0=__builtin_amdgcn_mfma_f32_32x32x16_bf16(kf[4],qr[2],C0,0,0,0),   P1[2],P1[3],P1[4],P1[5],     pw2[0]=PKW(P1,0), pw2[1]=PKW(P1,2), pw2); \
    VRD(6); SBAR(); GAPA(C1=__builtin_amdgcn_mfma_f32_32x32x16_bf16(kf[5],qr[2],C1,0,0,0),   P1[6],P1[7],P1[8],P1[9],     pw2[2]=PKW(P1,4), pw2[3]=PKW(P1,6), pw2); \
    VRD(3); SBAR(); GAPA(C0=__builtin_amdgcn_mfma_f32_32x32x16_bf16(kf[6],qr[3],C0,0,0,0),   P1[10],P1[11],P1[12],P1[13], pw3[0]=PKW(P1,8), pw3[1]=PKW(P1,10), pw3); \
    VRD(7); SBAR(); GAPA(C1=__builtin_amdgcn_mfma_f32_32x32x16_bf16(kf[7],qr[3],C1,0,0,0),   P1[14],P1[15],0.f,0.f,       pw3[2]=PKW(P1,12),pw3[3]=PKW(P1,14), pw3); \
    l_reg+=sacc; \
    if(GK){DMA_K((t)+3,sl_cur);} if(GV){DMA_V((t)+1,sl_next);} \
    CMASK(C0,C1,t); \
    { float a=MX3(C0[0],C0[1],C1[0]),b=MX3(C0[2],C0[3],C1[1]); a=MX3(a,C1[2],C1[3]); \
      _Pragma("unroll") for(int r=4;r<16;r+=4){a=MX3(a,C0[r],C0[r+1]);b=MX3(b,C0[r+2],C0[r+3]);a=MX3(a,C1[r],C1[r+1]);b=MX3(b,C1[r+2],C1[r+3]);} \
      float rm=__builtin_fmaxf(a,b); { auto rr=__builtin_amdgcn_permlane32_swap(__float_as_uint(rm),__float_as_uint(rm),false,false); rm=__builtin_fmaxf(__uint_as_float(rr[0]),__uint_as_float(rr[1])); } \
      resc=false; \
      if(__builtin_expect(__any(rm>(float)THRL),0)){ const float dl=__builtin_fmaxf(rm,0.f); mhat+=dl; \
        _Pragma("unroll") for(int r=0;r<16;++r){C0[r]-=dl;C1[r]-=dl;} \
        _Pragma("unroll") for(int r=0;r<16;++r)negm[r]=-mhat; asm volatile("":"+v"(negm)); \
        const float f=__builtin_amdgcn_exp2f(-dl); l_reg*=f; if(hi==0)wsf[r32]=f; resc=true; } } \
    SBAR(); \
    GAPB(o[0]=__builtin_amdgcn_mfma_f32_32x32x16_bf16(PAF(0),VFR(0),o[0],0,0,0), C0,0); \
    GAPB(o[1]=__builtin_amdgcn_mfma_f32_32x32x16_bf16(PAF(0),VFR(4),o[1],0,0,0), C0,4); \
    KRD(GL,0); GAPB(o[0]=__builtin_amdgcn_mfma_f32_32x32x16_bf16(PAF(1),VFR(1),o[0],0,0,0), C0,8); \
    KRD(GL,1); GAPB(o[1]=__builtin_amdgcn_mfma_f32_32x32x16_bf16(PAF(1),VFR(5),o[1],0,0,0), C0,12); \
    KRD(GL,2); GAPB(o[0]=__builtin_amdgcn_mfma_f32_32x32x16_bf16(PAF(2),VFR(2),o[0],0,0,0), C1,0); \
    KRD(GL,3); GAPB(o[1]=__builtin_amdgcn_mfma_f32_32x32x16_bf16(PAF(2),VFR(6),o[1],0,0,0), C1,4); \
    GAPB(o[0]=__builtin_amdgcn_mfma_f32_32x32x16_bf16(PAF(3),VFR(3),o[0],0,0,0), C1,8); \
    GAPB(o[1]=__builtin_amdgcn_mfma_f32_32x32x16_bf16(PAF(3),VFR(7),o[1],0,0,0), C1,12); \
    }while(0)
  int t=1;
  #undef CMASK
  #define CMASK(P0,P1,t) do{}while(0)
  for(;t+5<NT;t+=2){
    STEP(pB0,pB1,pA0,pA1,t,true,true,true);     WAIT_BAR(2); RESC(); ROT();
    STEP(pA0,pA1,pB0,pB1,t+1,true,true,true);   WAIT_BAR(2); RESC(); ROT();
  }
  #undef CMASK
  #define CMASK(P0,P1,t) do{}while(0)
  #define ENDW(tt) do{ if((tt)+3<NT){WAIT_BAR(2);} else if((tt)+2<NT){WAIT_BAR(1);} else {WAIT_BAR(0);} }while(0)
  for(;t+1<NT;t+=2){
    STEP(pB0,pB1,pA0,pA1,t,(t+3<NT),(t+1<NT),(t+1<NT));       ENDW(t);   RESC(); ROT();
    STEP(pA0,pA1,pB0,pB1,t+1,(t+4<NT),(t+2<NT),(t+2<NT));     ENDW(t+1); RESC(); ROT();
  }
  STEP(pB0,pB1,pA0,pA1,NT-1,false,false,false); RESC();
  { float sacc=pB0[0]+pB0[1]; _Pragma("unroll") for(int r=2;r<16;++r)sacc+=pB0[r]; _Pragma("unroll") for(int r=0;r<16;++r)sacc+=pB1[r]; l_reg+=sacc;
    pw0=(u32x4){PKW(pB0,0),PKW(pB0,2),PKW(pB0,4),PKW(pB0,6)};pw1=(u32x4){PKW(pB0,8),PKW(pB0,10),PKW(pB0,12),PKW(pB0,14)};pw2=(u32x4){PKW(pB1,0),PKW(pB1,2),PKW(pB1,4),PKW(pB1,6)};pw3=(u32x4){PKW(pB1,8),PKW(pB1,10),PKW(pB1,12),PKW(pB1,14)};
    SBAR(); pv(o,vb0+sl_cur,PAF(0),PAF(1),PAF(2),PAF(3)); }
  #undef PKW
  #undef PAF
  #undef VFR
  #undef PIN
  #undef MX3
  #undef GAPA
  #undef GAPB
  #undef EX
  #undef VRD
  #undef KRD
  #undef STEP
  #undef ENDW
  {auto rr=__builtin_amdgcn_permlane32_swap(__float_as_uint(l_reg),__float_as_uint(l_reg),false,false);l_reg=__uint_as_float(rr[0])+__uint_as_float(rr[1]);}
  if(hi==0)wsf[32+r32]=l_reg;asm volatile("s_waitcnt lgkmcnt(0)":::"memory");
  float rli[16];
  #pragma unroll
  for(int r=0;r<16;++r)rli[r]=__builtin_amdgcn_rcpf(wsf[32+crow(r,hi)]);
  bf16*Ow=O+(qrow0+wid*QBLK)*DM+hcol;
  { bf16*stg=(bf16*)(shm+LDS_OST)+wid*2048;
    #pragma unroll
    for(int r=0;r<16;++r){const int orow=crow(r,hi);
      #pragma unroll
      for(int d0=0;d0<2;++d0)stg[orow*64+d0*32+r32]=__float2bfloat16(o[d0][r]*rli[r]);}
    asm volatile("s_waitcnt lgkmcnt(0)":::"memory");
    #pragma unroll
    for(int i=0;i<4;++i){const int row=i*8+(lane>>3),ch=lane&7; const u32x4 v=*(const u32x4*)(stg+row*64+ch*8); ATTN_STORE16(Ow+(long)row*DM+ch*8,v);} }
  asm volatile("s_waitcnt lgkmcnt(0)\n\ts_barrier":::"memory");
  #undef DMA_K
  #undef DMA_V
  #undef CMASK
  #undef START
  #undef RESC
  #undef ROT
}
constexpr int ATTN_LDS_BYTES=LDS_BYTES;
#undef SBAR
#undef WAIT_BAR
}
#define GAS __attribute__((address_space(1)))
#define LAS __attribute__((address_space(3)))
typedef unsigned short bf16;
typedef unsigned v4u __attribute__((ext_vector_type(4)));
typedef float f32x4 __attribute__((ext_vector_type(4)));
typedef short bf16x8 __attribute__((ext_vector_type(8)));
typedef GAS unsigned gu32;
typedef GAS unsigned long long gu64;
#define RLX_AGENT __ATOMIC_RELAXED, __HIP_MEMORY_SCOPE_AGENT
#define LDS_WAIT() asm volatile("s_waitcnt lgkmcnt(0)" ::: "memory")
#define VM_WAIT() asm volatile("s_waitcnt vmcnt(0)" ::: "memory")
__device__ __forceinline__ unsigned long long rt() { return __builtin_amdgcn_s_memrealtime(); }
__device__ __forceinline__ unsigned f2bf(float f) { unsigned u = __builtin_bit_cast(unsigned, f); return (u + 0x7fffu + ((u >> 16) & 1u)) >> 16; }
__device__ __forceinline__ unsigned pk2(float lo, float hi) { return f2bf(lo) | (f2bf(hi) << 16); }

#define XB_TMO      128
#define XB_XCNT(j)  (256  + 64 * (j))
#define XB_XSUB(j)  (1280 + 64 * (j))
#define XB_XGEN(j)  (2304 + 64 * (j))
#define XB_TOP      3328
#define XB_TOPGEN   3392
#define XCD_BAR_WORDS 3456
#define XB_SPIN_CAP (1u << 18)

__device__ __forceinline__ unsigned xb_ld(unsigned* p)              { return __hip_atomic_load(p, __ATOMIC_RELAXED, __HIP_MEMORY_SCOPE_AGENT); }
__device__ __forceinline__ unsigned xb_add(unsigned* p, unsigned v) { return __hip_atomic_fetch_add(p, v, __ATOMIC_RELAXED, __HIP_MEMORY_SCOPE_AGENT); }
__device__ __forceinline__ unsigned xb_xcc_id() { return (unsigned)__builtin_amdgcn_s_getreg((3 << 11) | 20) & 0xFu; }
#define XB_SPIN(cond, bar) do { unsigned _sp = 0; while (cond) { __builtin_amdgcn_s_sleep(1); \
    if ((++_sp & 255u) == 0u) { if (xb_ld(&(bar)[XB_TMO])) break; if (_sp > XB_SPIN_CAP) { atomicAdd(&(bar)[XB_TMO], 1u); break; } } } } while (0)

struct XcdBarrier {
    unsigned* bar; unsigned x; int wv;
    volatile LAS unsigned* st;
};

__device__ __forceinline__ XcdBarrier xcd_barrier_post(unsigned* bar, volatile LAS unsigned* st, int wv) {
    XcdBarrier b; b.bar = bar; b.x = xb_xcc_id(); b.st = st; b.wv = wv;
    if (threadIdx.x == 0) (void)xb_add(&bar[XB_XCNT(b.x)], 1u);
    return b;
}
__device__ __forceinline__ void xcd_barrier_complete(unsigned* bar, unsigned x, unsigned& nloc, unsigned& nx) {
    const unsigned G = gridDim.x * gridDim.y * gridDim.z;
    unsigned sum, cnt, mine, sp = 0u;
    for (;;) {
        sum = 0u; cnt = 0u; mine = 0u;
#pragma unroll
        for (unsigned j = 0; j < 16; ++j) { const unsigned c = xb_ld(&bar[XB_XCNT(j)]); sum += c; cnt += (c > 0u) ? 1u : 0u; mine = (j == x) ? c : mine; }
        if (sum == G) break;
        __builtin_amdgcn_s_sleep(1);
        if ((++sp & 255u) == 0u) { if (xb_ld(&bar[XB_TMO])) break; if (sp > XB_SPIN_CAP) { atomicAdd(&bar[XB_TMO], 1u); break; } }
    }
    nloc = mine > 0u ? mine : 1u; nx = cnt > 0u ? cnt : 1u;
}

__device__ __forceinline__ void xcd_barrier(const XcdBarrier& b) {
    asm volatile("s_waitcnt vmcnt(0)" ::: "memory");
    __syncthreads();
    if (b.wv == 0 && hw_lane() == 0) {
        unsigned* bar = b.bar;
        __builtin_amdgcn_s_waitcnt(0);
        unsigned nloc = b.st[0], nx = b.st[1];
        if (nloc == 0u) { xcd_barrier_complete(bar, b.x, nloc, nx); b.st[0] = nloc; b.st[1] = nx; }
        const unsigned old = xb_add(&bar[XB_XSUB(b.x)], 1u);
        const unsigned gen = old / nloc;
        if (old + 1u == (gen + 1u) * nloc) {
            __builtin_amdgcn_fence(__ATOMIC_RELEASE, "agent");
            asm volatile("s_waitcnt vmcnt(0)" ::: "memory");
            const unsigned og = xb_add(&bar[XB_TOP], 1u);
            const unsigned tg = og / nx;
            if (og + 1u == (tg + 1u) * nx) xb_add(&bar[XB_TOPGEN], 1u);
            else XB_SPIN(xb_ld(&bar[XB_TOPGEN]) == tg, bar);
            __builtin_amdgcn_fence(__ATOMIC_ACQUIRE, "agent");
            xb_add(&bar[XB_XGEN(b.x)], 1u);
            asm volatile("s_waitcnt vmcnt(0)" ::: "memory");
        } else {
            XB_SPIN(xb_ld(&bar[XB_XGEN(b.x)]) == gen, bar);
            __builtin_amdgcn_fence(__ATOMIC_ACQUIRE, "agent");
            asm volatile("s_waitcnt vmcnt(0)" ::: "memory");
        }
    }
    __syncthreads();
}

#ifndef PROBE
#define PROBE 0
#endif
#ifndef DEBUG_NAN
#define DEBUG_NAN 0
#endif
#ifndef TSEL
#define TSEL -1
#endif
#ifndef CYSEL
#define CYSEL -1
#endif
#ifndef TSCALE10
#define TSCALE10 0
#endif
#if TSEL >= 0
#define TS(k) do { if (blockIdx.x == 0 && F.wave == 0 && hw_lane() == 0) { unsigned long long* ts_ = (unsigned long long*)(F.ws + WS_CTL + 32768); const unsigned long long now_ = __builtin_amdgcn_s_memrealtime(); ts_[1 + (k)] += now_ - ts_[0]; ts_[0] = now_; } } while (0)
#else
#define TS(k) do {} while (0)
#endif
#ifndef USE_SEQ_SCAN
#define USE_SEQ_SCAN 0
#endif
constexpr int NWAVES = 8;
constexpr int DMODEL = 1024, NBATCH = 8, SEQL = 4096, CTXL = 256, DEPTH = 4;
constexpr int TL = NBATCH * SEQL, TC = NBATCH * CTXL, TT = TL + TC;
constexpr int KVLEN = SEQL + CTXL;
constexpr int INW = 2688, INWP = 2816, ATTIN = 768, SHIFTW = 1920;
constexpr int FFD = 2816, FFE = 3584, NEXP = 8;
constexpr int LORA_K = 384, LORA_N = 2560;
constexpr int MAXPANEL = 280, MAXSLOT = MAXPANEL * 256;
constexpr float RMS_EPS = 1e-6f, GN_EPS = 64e-5f;

constexpr size_t MiB = 1u << 20;
constexpr size_t WS_CTL = 0, CTL_ZERO_BYTES = 64 * 1024;
constexpr size_t WS_MOD = 1 * MiB;
constexpr size_t WS_ROPE = 2 * MiB;
constexpr size_t WS_ROUTE = 3 * MiB;
constexpr size_t RT_E = 0, RT_G = 160 * 1024, RT_S = 448 * 1024, RT_BLK = 768 * 1024, RT_WCNT = 800 * 1024;
constexpr size_t WS_XB = 12 * MiB;
constexpr size_t WS_WIN = 80 * MiB, WS_WOUT = 86 * MiB, WS_WLORA = 88 * MiB;
constexpr size_t WS_WFF = 100 * MiB;
constexpr size_t WS_WFF_D_DENSE = WS_WFF + 12 * MiB, WS_WFF_D_MOE = WS_WFF + 112 * MiB;
constexpr size_t WS_ACT = 270 * MiB;
constexpr size_t WS_QO = WS_ACT, WS_KB = WS_ACT + 68 * MiB, WS_VB = WS_ACT + 77 * MiB, WS_P = WS_ACT + 86 * MiB, WS_OSC = WS_P;
constexpr size_t WS_R = WS_ACT + 273 * MiB, WS_K = WS_ACT + 307 * MiB, WS_V = WS_ACT + 341 * MiB, WS_KK = WS_ACT + 375 * MiB, WS_LIN = WS_ACT + 409 * MiB;
constexpr size_t WS_LOUT = WS_ACT + 435 * MiB;
constexpr size_t WS_SPT = WS_WFF, WS_SG = WS_WFF + 68 * MiB, WS_SQ = WS_ACT + 605 * MiB;
constexpr size_t WS_HID = WS_ACT;
constexpr size_t WS_AG = WS_ACT, WS_AG8 = WS_ACT + 140 * MiB, WS_HIDM = WS_ACT + 210 * MiB;
constexpr size_t WS_WFF_D_MOE8 = WS_WFF + 56 * MiB;
constexpr float W8SCALE = 64.0f, H8SCALE = 8.0f, HID8SCALE = 4.0f;
constexpr size_t WS_SIDE = 1000 * MiB;
constexpr size_t WS_END = 1012 * MiB;
static_assert(WS_LOUT + (size_t)TT * LORA_N * 2 <= WS_END && WS_HIDM + (size_t)MAXSLOT * FFE <= WS_END && WS_P + (size_t)TT * INWP * 2 <= WS_R && WS_OSC + (size_t)2 * TT * 512 * 4 <= WS_R, "ws map");
static_assert(WS_WFF_D_MOE + (size_t)NEXP * 1024 * FFE * 2 <= WS_ACT && WS_XB + (size_t)TT * 1024 * 2 <= WS_WIN && WS_WIN + (size_t)INWP * 1024 * 2 <= WS_WOUT && WS_WLORA + (size_t)LORA_N * LORA_K * 2 <= WS_WFF, "ws map 2");
constexpr int CW_BAR = 4096;

constexpr int RING_OFF = 0, RING_BYTES = 131072;
constexpr int LDSCTL_OFF = RING_BYTES;
constexpr int MISC_OFF = LDSCTL_OFF;
constexpr int LT_PEXP = LDSCTL_OFF + 256;
constexpr int LT_NPAN = LT_PEXP + 320 * 4;
constexpr int LT_INP = LT_NPAN + 64;
constexpr int LT_TMP = LT_INP + 256;
constexpr int LDS_BYTES = 147456;
static_assert(LT_TMP + 8192 + 1024 <= LDS_BYTES, "LDS map");

struct Frame {
    LAS unsigned char* lds;
    volatile LAS unsigned* MISC;
    gu32* ctl;
    int tid, lane, wave, vcu, G;
    unsigned char* ws;
    float* out;
};
struct Args { const float* in[30]; float* out; unsigned char* ws; };
__device__ __forceinline__ const void* inp_ld(const Frame& F, int k) {
    const LAS unsigned* t = (const LAS unsigned*)(F.lds + LT_INP) + 2 * k; unsigned lo = t[0], hi = t[1];
    lo = __builtin_amdgcn_readfirstlane(lo); hi = __builtin_amdgcn_readfirstlane(hi);
    return (const void*)(const GAS void*)(((unsigned long long)hi << 32) | lo);
}
#define IN_X 0
#define IN_C 1
#define IN_CTX 2
#define IN_CCTX 3
#define IN_ADAW 4
#define IN_ADAB 5
#define IN_N1G 6
#define IN_N2G 7
#define IN_WIN 8
#define IN_WOUT 9
#define IN_QG 10
#define IN_KG 11
#define IN_MU 12
#define IN_W0 13
#define IN_W2 14
#define IN_A0 15
#define IN_A2 16
#define IN_G2 17
#define IN_KKW 18
#define IN_KA 19
#define IN_RK 20
#define IN_GNW 21
#define IN_GNB 22
#define IN_FWG 23
#define IN_FWU 24
#define IN_FWD 25
#define IN_ROUTER 26
#define IN_MWG 27
#define IN_MWU 28
#define IN_MWD 29

__device__ __forceinline__ int vlaunder(int v) { asm volatile("" : "+v"(v)); return v; }
__device__ __forceinline__ unsigned char* launder(unsigned char* p) { unsigned long long v = (unsigned long long)p; asm volatile("" : "+s"(v)); return (unsigned char*)(GAS unsigned char*)v; }
#define INP(k) ((const float*)inp_ld(F, (k)))
__device__ __forceinline__ const void* inp_ld(const struct Frame& F, int k);
__device__ __forceinline__ float wave_sum(float v) {
#pragma unroll
    for (int o = 1; o < 64; o <<= 1) v += __shfl_xor(v, o);
    return v;
}
__device__ __forceinline__ float half_sum(float v) {
#pragma unroll
    for (int o = 1; o < 32; o <<= 1) v += __shfl_xor(v, o);
    return v;
}
__device__ __forceinline__ float bflo(unsigned w) { return __builtin_bit_cast(float, w << 16); }
__device__ __forceinline__ float bfhi(unsigned w) { return __builtin_bit_cast(float, w & 0xffff0000u); }
typedef float f32x2_t_ __attribute__((ext_vector_type(2))); typedef __bf16 bf16x2_t_ __attribute__((ext_vector_type(2)));
__device__ __forceinline__ unsigned pkbf(float lo, float hi) { f32x2_t_ v = {lo, hi}; bf16x2_t_ b = __builtin_convertvector(v, bf16x2_t_); return __builtin_bit_cast(unsigned, b); }
__device__ __forceinline__ float sigm(float x) { return __builtin_amdgcn_rcpf(1.0f + __builtin_amdgcn_exp2f(-1.4426950408889634f * x)); }

__device__ __forceinline__ void p_prologue(Frame& F, const Args& A) {
    unsigned char* const ws = launder(F.ws);
    const int tid = (F.wave * 64 + hw_lane()), lane = tid & 63; (void)lane;
    LAS float* sc = (LAS float*)(F.lds + RING_OFF);
    for (int i = tid; i < 9 * 1024; i += NWAVES * 64) { const int b = i >> 10, k = i & 1023; const float v = (b < 8) ? INP(IN_C)[b * 1024 + k] : INP(IN_CCTX)[k]; sc[i] = v * sigm(v); }
    __syncthreads();
    const int gw = F.vcu * NWAVES + F.wave, NGW = F.G * NWAVES;
    float* mod = (float*)(ws + WS_MOD);
    for (int it = (int)blockIdx.x + F.G * F.wave; it < DEPTH * 96; it += NGW) {
        const int l = it / 96, j = (it % 96) * 64 + lane;
        const float* W = INP(IN_ADAW) + (size_t)l * 1024 * 6144 + j;
        float acc[9];
#pragma unroll
        for (int b = 0; b < 9; ++b) acc[b] = 0.f;
        for (int k = 0; k < 1024; k += 16) {
            float wv[16];
#pragma unroll
            for (int u = 0; u < 16; ++u) wv[u] = W[(size_t)(k + u) * 6144];
#pragma unroll
            for (int b = 0; b < 9; ++b)
#pragma unroll
                for (int u4 = 0; u4 < 4; ++u4) { const f32x4 s = *(const LAS f32x4*)(sc + b * 1024 + k + 4 * u4); acc[b] += (s[0] * wv[4 * u4] + s[1] * wv[4 * u4 + 1]) + (s[2] * wv[4 * u4 + 2] + s[3] * wv[4 * u4 + 3]); }
        }
        const float bias = INP(IN_ADAB)[l * 6144 + j];
#pragma unroll
        for (int b = 0; b < 9; ++b) mod[((size_t)l * 9 + b) * 6144 + j] = acc[b] + bias;
    }
    float* cs = (float*)(ws + WS_ROPE);
    for (int i = blockIdx.x * (NWAVES * 64) + tid; i < 4096 * 32; i += F.G * NWAVES * 64) {
        const int t = i >> 5, k = i & 31; const int pos = (k < 16) ? (t >> 6) : (t & 63);
        const float inv = powf(10000.0f, -(float)(2 * (k & 15)) / 32.0f); const float ang = (float)pos * inv;
        float s, c; sincosf(ang, &s, &c); cs[2 * i] = c; cs[2 * i + 1] = s;
    }
    __syncthreads();
}

struct WItem { const float* W; unsigned char* WT; int K, N, k0, n0, drow0, f8; };
__device__ __forceinline__ void tr_load(const WItem& w, float (&tv)[32], int lane) {
#pragma unroll
    for (int i = 0; i < 32; ++i) tv[i] = w.W[(size_t)(w.k0 + 2 * i + (lane >> 5)) * w.N + w.n0 + (lane & 31)];
}
__device__ __forceinline__ void tr_finish(const WItem& w, const float (&tv)[32], LAS float* scr, int lane) {
#pragma unroll
    for (int i = 0; i < 32; ++i) scr[(2 * i + (lane >> 5)) * 33 + (lane & 31)] = tv[i];
    LDS_WAIT(); asm volatile("" ::: "memory");
    if (w.f8) { const int c = lane & 3;
#pragma unroll
        for (int j = 0; j < 2; ++j) { const int n = (lane >> 2) + 16 * j; const LAS float* s = scr + (16 * c) * 33 + n;
            v4u o;
            o.x = pg8::pk_fp8x4(s[0 * 33] * W8SCALE, s[1 * 33] * W8SCALE, s[2 * 33] * W8SCALE, s[3 * 33] * W8SCALE); o.y = pg8::pk_fp8x4(s[4 * 33] * W8SCALE, s[5 * 33] * W8SCALE, s[6 * 33] * W8SCALE, s[7 * 33] * W8SCALE);
            o.z = pg8::pk_fp8x4(s[8 * 33] * W8SCALE, s[9 * 33] * W8SCALE, s[10 * 33] * W8SCALE, s[11 * 33] * W8SCALE); o.w = pg8::pk_fp8x4(s[12 * 33] * W8SCALE, s[13 * 33] * W8SCALE, s[14 * 33] * W8SCALE, s[15 * 33] * W8SCALE);
            *(v4u*)(w.WT + (size_t)(w.drow0 + n) * w.K + w.k0 + 16 * c) = o; }
    } else { const int c = lane & 7;
#pragma unroll
        for (int j = 0; j < 4; ++j) { const int n = (lane >> 3) + 8 * j; const LAS float* s = scr + (8 * c) * 33 + n;
            v4u o; o.x = pkbf(s[0 * 33], s[1 * 33]); o.y = pkbf(s[2 * 33], s[3 * 33]); o.z = pkbf(s[4 * 33], s[5 * 33]); o.w = pkbf(s[6 * 33], s[7 * 33]);
            *(v4u*)((bf16*)w.WT + (size_t)(w.drow0 + n) * w.K + w.k0 + 8 * c) = o; } }
    LDS_WAIT(); asm volatile("" ::: "memory");
}
__device__ __forceinline__ int gu_row(int n) { return 256 * (n >> 7) + (n & 127); }

__device__ __forceinline__ WItem wprep_decode(Frame& F, unsigned char* const ws, const int l, const int it) {
    constexpr int I_IN = 16 * (INW / 32), I_OUT = 16 * 32;
    const bool moe = (l & 1) != 0; const int j = l >> 1;
    constexpr int I_DG = 16 * (FFD / 32), I_MG = 16 * (FFE / 32);
    int r = it; WItem w;
    if (r < I_IN) { const int nb = r % (INW / 32), kb = r / (INW / 32); w = WItem{INP(IN_WIN) + (size_t)l * 1024 * INW, ws + WS_WIN, 1024, INW, kb * 64, nb * 32, nb * 32, 0}; return w; } r -= I_IN;
    if (r < I_OUT) { const int nb = r % 32, kb = r / 32; w = WItem{INP(IN_WOUT) + (size_t)l * 1024 * 1024, ws + WS_WOUT, 1024, 1024, kb * 64, nb * 32, nb * 32, 0}; return w; } r -= I_OUT;
    if (!moe) {
        if (r < I_DG) { const int nb = r % (FFD / 32), kb = r / (FFD / 32); w = WItem{INP(IN_FWG) + (size_t)j * 1024 * FFD, ws + WS_WFF, 1024, FFD, kb * 64, nb * 32, gu_row(nb * 32), 0}; return w; } r -= I_DG;
        if (r < I_DG) { const int nb = r % (FFD / 32), kb = r / (FFD / 32); w = WItem{INP(IN_FWU) + (size_t)j * 1024 * FFD, ws + WS_WFF, 1024, FFD, kb * 64, nb * 32, gu_row(nb * 32) + 128, 0}; return w; } r -= I_DG;
        { const int nb = r % 32, kb = r / 32; w = WItem{INP(IN_FWD) + (size_t)j * FFD * 1024, ws + WS_WFF_D_DENSE, FFD, 1024, kb * 64, nb * 32, nb * 32, 0}; return w; }
    }
    constexpr int I_MD = (FFE / 64) * 32; constexpr int PER = 2 * I_MG + I_MD; const int e = r / PER; r -= e * PER;
    unsigned char* WGU = ws + WS_WFF + (size_t)e * (2 * FFE) * 1024; unsigned char* WD = ws + WS_WFF_D_MOE8 + (size_t)e * 1024 * FFE;
    const size_t eo = ((size_t)j * NEXP + e) * 1024 * FFE;
    if (r < I_MG) { const int nb = r % (FFE / 32), kb = r / (FFE / 32); w = WItem{INP(IN_MWG) + eo, WGU, 1024, FFE, kb * 64, nb * 32, gu_row(nb * 32), 1}; return w; } r -= I_MG;
    if (r < I_MG) { const int nb = r % (FFE / 32), kb = r / (FFE / 32); w = WItem{INP(IN_MWU) + eo, WGU, 1024, FFE, kb * 64, nb * 32, gu_row(nb * 32) + 128, 1}; return w; } r -= I_MG;
    { const int nb = r % 32, kb = r / 32; w = WItem{INP(IN_MWD) + eo, WD, FFE, 1024, kb * 64, nb * 32, nb * 32, 1}; return w; }
}
__device__ __forceinline__ void p_wprep(Frame& F, const Args& A, int l, int part, gu32* ctr = nullptr) {
    unsigned char* const ws = launder(F.ws);
    const int tid = (F.wave * 64 + hw_lane()), lane = tid & 63; (void)lane;
    LAS float* scr = (LAS float*)(F.lds + RING_OFF + F.wave * 16384);
    const int gw = F.vcu * NWAVES + F.wave, NGW = F.G * NWAVES;
    bf16* WIN = (bf16*)(ws + WS_WIN); bf16* WLORA = (bf16*)(ws + WS_WLORA);
    constexpr int I_IN = 16 * (INW / 32), I_OUT = 16 * 32;
    const bool moe = (l & 1) != 0;
    constexpr int I_DG = 16 * (FFD / 32), I_DD = (FFD / 64) * 32, I_MG = 16 * (FFE / 32), I_MD = (FFE / 64) * 32;
    const int nff = moe ? NEXP * (2 * I_MG + I_MD) : (2 * I_DG + I_DD);
    const int NIT = I_IN + I_OUT + nff;
    const int lo = part ? I_IN + I_OUT : 0, hi = part ? NIT : I_IN + I_OUT;
    (void)ctr;
    {
        int it = lo + gw; WItem wa, wb; float ta[32], tb[32];
        if (it < hi) { wa = wprep_decode(F, ws, l, it); tr_load(wa, ta, lane); }
        for (; it < hi; it += 2 * NGW) {
            const int i2 = it + NGW, i3 = i2 + NGW;
            if (i2 < hi) { wb = wprep_decode(F, ws, l, i2); tr_load(wb, tb, lane); }
            tr_finish(wa, ta, scr, lane);
            if (i3 < hi) { wa = wprep_decode(F, ws, l, i3); tr_load(wa, ta, lane); }
            if (i2 < hi) tr_finish(wb, tb, scr, lane);
        }
    }
    if (part) return;
    for (int i = blockIdx.x * (NWAVES * 64) + tid; i < 16384; i += F.G * NWAVES * 64) ((v4u*)(WIN + (size_t)INW * 1024))[i] = (v4u){0u, 0u, 0u, 0u};
    const float* w2 = INP(IN_W2) + (size_t)l * 2 * 64 * 512; const float* a2 = INP(IN_A2) + (size_t)l * 2 * 64 * 512; const float* g2 = INP(IN_G2) + (size_t)l * 128 * 512;
    for (int i = blockIdx.x * (NWAVES * 64) + tid; i < LORA_N * 64; i += F.G * NWAVES * 64) {
        const int n = i >> 6, k = (i & 63) * 2; const int sec = n >> 9, cn = n & 511;
        float v0 = 0.f, v1 = 0.f;
        if (sec < 2) { const int kk = k - 64 * sec; if (kk >= 0 && kk < 64) { v0 = w2[((size_t)sec * 64 + kk) * 512 + cn]; v1 = w2[((size_t)sec * 64 + kk + 1) * 512 + cn]; } }
        else if (sec < 4) { const int d = sec - 2, kk = k - 64 * d; if (kk >= 0 && kk < 64) { v0 = a2[((size_t)d * 64 + kk) * 512 + cn]; v1 = a2[((size_t)d * 64 + kk + 1) * 512 + cn]; } }
        else { v0 = g2[(size_t)k * 512 + cn]; v1 = g2[(size_t)(k + 1) * 512 + cn]; }
        ((unsigned*)WLORA)[i] = pkbf(v0, v1);
    }
}

template <bool ROUTER, bool COMBINE, bool SRCF32, bool SIDE = false>
__device__ __forceinline__ void p_norm(Frame& F, const Args& A, int l, int which, const float* srcL, const float* srcC, int lprev, int nrows = TT) {
    unsigned char* const ws = launder(F.ws);
    const int tid = (F.wave * 64 + hw_lane()), lane = tid & 63; (void)lane;
    const int gw = F.vcu * NWAVES + F.wave, NGW = F.G * NWAVES;
    const float* mod = (const float*)(ws + WS_MOD) + (size_t)l * 9 * 6144;
    const float* gain = A.in[which ? IN_N2G : IN_N1G] + l * 1024;
    bf16* H = (bf16*)F.out;
    const float* route_g = (const float*)(ws + WS_ROUTE + RT_G); const int* route_s = (const int*)(ws + WS_ROUTE + RT_S);
    int cnt0 = 0, cnt1 = 0, cnt2 = 0, cnt3 = 0, cnt4 = 0, cnt5 = 0, cnt6 = 0, cnt7 = 0;
    LAS float* rwl = (LAS float*)(F.lds + RING_OFF);
    if (ROUTER) {
        __syncthreads();
        const float* rw = INP(IN_ROUTER) + (size_t)(l >> 1) * 1024 * 8;
        for (int i = tid; i < 2048; i += NWAVES * 64) { const f32x4 w = *(const f32x4*)(rw + 4 * i); const int col = i >> 1, e4 = (i & 1) * 4, jj = col >> 8, ln = (col & 255) >> 2, q = col & 3;
            *(LAS f32x4*)(rwl + (((jj * 4 + q) * 64 + ln) * 8 + e4)) = w; }
        __syncthreads();
    }
    uint2 nx[2][4]; f32x4 nf[2][4]; float cg[2][2]; int cs[2][2];
#pragma unroll
    for (int r = 0; r < 2; ++r) { cg[r][0] = cg[r][1] = 0.f; cs[r][0] = cs[r][1] = 0;
#pragma unroll
        for (int jj = 0; jj < 4; ++jj) { nx[r][jj] = make_uint2(0u, 0u); nf[r][jj] = (f32x4){0.f, 0.f, 0.f, 0.f}; } }
#define PN_LOAD(r_, row_) do { const int row__ = (row_); if (row__ < nrows) { \
        if (SRCF32) { const float* xr_ = (row__ < TL) ? srcL + (size_t)row__ * 1024 : srcC + (size_t)(row__ - TL) * 1024; _Pragma("unroll") for (int jj = 0; jj < 4; ++jj) nf[r_][jj] = *(const f32x4*)(xr_ + 4 * ln + 256 * jj); } \
        else { const bf16* xr_ = (const bf16*)(ws + WS_XB) + (size_t)row__ * 1024; _Pragma("unroll") for (int jj = 0; jj < 4; ++jj) nx[r_][jj] = *(const uint2*)(xr_ + 4 * ln + 256 * jj); } \
        if (COMBINE) { cg[r_][0] = route_g[2 * row__]; cg[r_][1] = route_g[2 * row__ + 1]; cs[r_][0] = route_s[2 * row__]; cs[r_][1] = route_s[2 * row__ + 1]; } } } while (0)
    int ln = vlaunder(lane);
    PN_LOAD(0, gw); PN_LOAD(1, gw + NGW);
    for (int row0 = gw; row0 < nrows; row0 += 2 * NGW) {
        ln = vlaunder(lane);
        const bool ok1 = row0 + NGW < nrows;
        f32x4 v[2][4]; float g0[2], g1[2]; int s0[2], s1[2];
#pragma unroll
        for (int r = 0; r < 2; ++r) { g0[r] = cg[r][0]; g1[r] = cg[r][1]; s0[r] = cs[r][0]; s1[r] = cs[r][1];
#pragma unroll
            for (int jj = 0; jj < 4; ++jj) { if (SRCF32) v[r][jj] = nf[r][jj]; else { const uint2 w = nx[r][jj]; v[r][jj] = (f32x4){bflo(w.x), bfhi(w.x), bflo(w.y), bfhi(w.y)}; } } }
        PN_LOAD(0, row0 + 2 * NGW); PN_LOAD(1, row0 + 3 * NGW);
        if (COMBINE) {
            const bf16* Y = (const bf16*)(ws + WS_AG);
            uint2 yy0[2][4], yy1[2][4];
#pragma unroll
            for (int r = 0; r < 2; ++r)
#pragma unroll
                for (int jj = 0; jj < 4; ++jj) { const int col = 4 * ln + 256 * jj; yy0[r][jj] = *(const uint2*)(Y + (size_t)s0[r] * 1024 + col); yy1[r][jj] = *(const uint2*)(Y + (size_t)s1[r] * 1024 + col); }
#pragma unroll
            for (int r = 0; r < 2; ++r) { const int row = row0 + r * NGW; const int bsel = (row < TL) ? (row >> 12) : 8;
                const float* m5 = (const float*)(ws + WS_MOD) + ((size_t)lprev * 9 + bsel) * 6144 + 5 * 1024;
                bf16* xbr = (bf16*)(ws + WS_XB) + (size_t)row * 1024;
#pragma unroll
                for (int jj = 0; jj < 4; ++jj) { const int col = 4 * ln + 256 * jj;
                    const uint2 y0 = yy0[r][jj], y1 = yy1[r][jj]; const f32x4 mm = *(const f32x4*)(m5 + col);
                    v[r][jj][0] += mm[0] * (g0[r] * bflo(y0.x) + g1[r] * bflo(y1.x)); v[r][jj][1] += mm[1] * (g0[r] * bfhi(y0.x) + g1[r] * bfhi(y1.x));
                    v[r][jj][2] += mm[2] * (g0[r] * bflo(y0.y) + g1[r] * bflo(y1.y)); v[r][jj][3] += mm[3] * (g0[r] * bfhi(y0.y) + g1[r] * bfhi(y1.y));
                    if (r == 0 || ok1) *(uint2*)(xbr + col) = make_uint2(pkbf(v[r][jj][0], v[r][jj][1]), pkbf(v[r][jj][2], v[r][jj][3])); } }
        }
        if (SIDE) {
#pragma unroll
            for (int r = 0; r < 2; ++r) { const int row = row0 + r * NGW;
                if ((r == 0 || ok1) && row >= TL) {
                    const bf16* sd = (const bf16*)(ws + WS_SIDE) + (size_t)(row - TL) * 1024; bf16* xbr = (bf16*)(ws + WS_XB) + (size_t)row * 1024;
                    uint2 sv[3][4];
#pragma unroll
                    for (int q = 0; q < 3; ++q)
#pragma unroll
                        for (int jj = 0; jj < 4; ++jj) sv[q][jj] = *(const uint2*)(sd + (size_t)q * TC * 1024 + 4 * ln + 256 * jj);
#pragma unroll
                    for (int jj = 0; jj < 4; ++jj) {
#pragma unroll
                        for (int q = 0; q < 3; ++q) { const uint2 w = sv[q][jj]; v[r][jj][0] += bflo(w.x); v[r][jj][1] += bfhi(w.x); v[r][jj][2] += bflo(w.y); v[r][jj][3] += bfhi(w.y); }
                        *(uint2*)(xbr + 4 * ln + 256 * jj) = make_uint2(pkbf(v[r][jj][0], v[r][jj][1]), pkbf(v[r][jj][2], v[r][jj][3])); } } }
        }
        float ss[2];
#pragma unroll
        for (int r = 0; r < 2; ++r) { ss[r] = 0.f;
#pragma unroll
            for (int jj = 0; jj < 4; ++jj) ss[r] += (v[r][jj][0] * v[r][jj][0] + v[r][jj][1] * v[r][jj][1]) + (v[r][jj][2] * v[r][jj][2] + v[r][jj][3] * v[r][jj][3]); }
#pragma unroll
        for (int o = 1; o < 64; o <<= 1) { const float t0 = __shfl_xor(ss[0], o), t1 = __shfl_xor(ss[1], o); ss[0] += t0; ss[1] += t1; }
        float rstd[2]; const float* shp[2];
#pragma unroll
        for (int r = 0; r < 2; ++r) { const int row = row0 + r * NGW; const int bsel = (row < TL) ? (row >> 12) : 8;
            rstd[r] = __builtin_amdgcn_rsqf(ss[r] * (1.0f / 1024.0f) + RMS_EPS); shp[r] = mod + (size_t)bsel * 6144 + (which ? 3 : 0) * 1024; }
        float lg[2][8];
#pragma unroll
        for (int r = 0; r < 2; ++r)
#pragma unroll
            for (int e = 0; e < 8; ++e) lg[r][e] = 0.f;
#pragma unroll
        for (int jj = 0; jj < 4; ++jj) { const int col = 4 * ln + 256 * jj;
            const f32x4 gg = *(const f32x4*)(gain + col); f32x4 h[2];
#pragma unroll
            for (int r = 0; r < 2; ++r) { const int row = row0 + r * NGW;
                const f32x4 sh = *(const f32x4*)(shp[r] + col), sc = *(const f32x4*)(shp[r] + 1024 + col);
                h[r] = (v[r][jj] * rstd[r]) * gg * (sc + 1.0f) + sh;
                if (r == 0 || ok1) {
                    if (ROUTER) *(unsigned*)((unsigned char*)H + (size_t)row * 1024 + col) = pg8::pk_fp8x4(h[r][0] * H8SCALE, h[r][1] * H8SCALE, h[r][2] * H8SCALE, h[r][3] * H8SCALE);
                    else { uint2 o; o.x = pkbf(h[r][0], h[r][1]); o.y = pkbf(h[r][2], h[r][3]); *(uint2*)(H + (size_t)row * 1024 + col) = o; } } }
            if (ROUTER) {
#pragma unroll
                for (int q = 0; q < 4; ++q) { const LAS float* rp = rwl + ((jj * 4 + q) * 64 + ln) * 8; const f32x4 ra = *(const LAS f32x4*)rp, rb = *(const LAS f32x4*)(rp + 4);
#pragma unroll
                    for (int r = 0; r < 2; ++r) { lg[r][0] += h[r][q] * ra[0]; lg[r][1] += h[r][q] * ra[1]; lg[r][2] += h[r][q] * ra[2]; lg[r][3] += h[r][q] * ra[3];
                        lg[r][4] += h[r][q] * rb[0]; lg[r][5] += h[r][q] * rb[1]; lg[r][6] += h[r][q] * rb[2]; lg[r][7] += h[r][q] * rb[3]; } } }
        }
        if (ROUTER) {
#pragma unroll
            for (int o = 1; o < 64; o <<= 1) { float t[2][8];
#pragma unroll
                for (int r = 0; r < 2; ++r)
#pragma unroll
                    for (int e = 0; e < 8; ++e) t[r][e] = __shfl_xor(lg[r][e], o);
#pragma unroll
                for (int r = 0; r < 2; ++r)
#pragma unroll
                    for (int e = 0; e < 8; ++e) lg[r][e] += t[r][e]; }
#pragma unroll
            for (int r = 0; r < 2; ++r) { const int row = row0 + r * NGW;
                if (r == 0 || ok1) {
                    int e0 = 0; float v0 = lg[r][0];
#pragma unroll
                    for (int e = 1; e < 8; ++e) if (lg[r][e] > v0) { v0 = lg[r][e]; e0 = e; }
                    int e1 = -1; float v1 = -INFINITY;
#pragma unroll
                    for (int e = 0; e < 8; ++e) if (e != e0 && lg[r][e] > v1) { v1 = lg[r][e]; e1 = e; }
                    const float q0 = 1.0f / (1.0f + __expf(v1 - v0)), q1 = 1.0f - q0;
                    if (ln == 0) { ((int*)(ws + WS_ROUTE + RT_E))[row] = e0 | (e1 << 8); ((float*)(ws + WS_ROUTE + RT_G))[2 * row] = q0; ((float*)(ws + WS_ROUTE + RT_G))[2 * row + 1] = q1; }
                    cnt0 += (e0 == 0) + (e1 == 0); cnt1 += (e0 == 1) + (e1 == 1); cnt2 += (e0 == 2) + (e1 == 2); cnt3 += (e0 == 3) + (e1 == 3);
                    cnt4 += (e0 == 4) + (e1 == 4); cnt5 += (e0 == 5) + (e1 == 5); cnt6 += (e0 == 6) + (e1 == 6); cnt7 += (e0 == 7) + (e1 == 7); } }
        }
    }
#undef PN_LOAD
    if (ROUTER) {
        int* wcnt = (int*)(ws + WS_ROUTE + RT_WCNT);
        if (ln == 0) { int* w = wcnt + (size_t)gw * 8; w[0] = cnt0; w[1] = cnt1; w[2] = cnt2; w[3] = cnt3; w[4] = cnt4; w[5] = cnt5; w[6] = cnt6; w[7] = cnt7; }
    }
}
__device__ __forceinline__ void p_final_combine(Frame& F, int lprev) {
    unsigned char* const ws = launder(F.ws);
    const int tid = (F.wave * 64 + hw_lane()), lane = tid & 63; (void)lane;
    const int gw = F.vcu * NWAVES + F.wave, NGW = F.G * NWAVES;
    const float* route_g = (const float*)(ws + WS_ROUTE + RT_G); const int* route_s = (const int*)(ws + WS_ROUTE + RT_S);
    const bf16* Y = (const bf16*)(ws + WS_AG);
    float g0n = 0.f, g1n = 0.f; int s0n = 0, s1n = 0;
    if (gw < TL) { g0n = route_g[2 * gw]; g1n = route_g[2 * gw + 1]; s0n = route_s[2 * gw]; s1n = route_s[2 * gw + 1]; }
    for (int row = gw; row < TL; row += NGW) {
        const int bsel = row >> 12;
        const float* m5 = (const float*)(ws + WS_MOD) + ((size_t)lprev * 9 + bsel) * 6144 + 5 * 1024;
        const float g0 = g0n, g1 = g1n; const int s0 = s0n, s1 = s1n;
        float* xw = F.out + (size_t)row * 1024; const bf16* xbr = (const bf16*)(ws + WS_XB) + (size_t)row * 1024;
        uint2 xw2[4], y0[4], y1[4];
#pragma unroll
        for (int jj = 0; jj < 4; ++jj) { const int col = 4 * lane + 256 * jj; xw2[jj] = *(const uint2*)(xbr + col); y0[jj] = *(const uint2*)(Y + (size_t)s0 * 1024 + col); y1[jj] = *(const uint2*)(Y + (size_t)s1 * 1024 + col); }
        if (row + NGW < TL) { const int rn = row + NGW; g0n = route_g[2 * rn]; g1n = route_g[2 * rn + 1]; s0n = route_s[2 * rn]; s1n = route_s[2 * rn + 1]; }
#pragma unroll
        for (int jj = 0; jj < 4; ++jj) { const int col = 4 * lane + 256 * jj; const f32x4 mm = *(const f32x4*)(m5 + col);
            f32x4 v = (f32x4){bflo(xw2[jj].x), bfhi(xw2[jj].x), bflo(xw2[jj].y), bfhi(xw2[jj].y)};
            v[0] += mm[0] * (g0 * bflo(y0[jj].x) + g1 * bflo(y1[jj].x)); v[1] += mm[1] * (g0 * bfhi(y0[jj].x) + g1 * bfhi(y1[jj].x));
            v[2] += mm[2] * (g0 * bflo(y0[jj].y) + g1 * bflo(y1[jj].y)); v[3] += mm[3] * (g0 * bfhi(y0[jj].y) + g1 * bfhi(y1[jj].y));
            *(f32x4*)(xw + col) = v; }
    }
}

__device__ __forceinline__ void p_prep(Frame& F, const Args& A, int l) {
    unsigned char* const ws = launder(F.ws);
    const int tid = (F.wave * 64 + hw_lane()), lane = tid & 63; (void)lane;
    const int gw = F.vcu * NWAVES + F.wave, NGW = F.G * NWAVES;
    const unsigned* P = (const unsigned*)(ws + WS_P);
    const float* cs = (const float*)(ws + WS_ROPE);
    bf16* QO = (bf16*)(ws + WS_QO); bf16* KB = (bf16*)(ws + WS_KB); bf16* VB = (bf16*)(ws + WS_VB);
    unsigned* Rst = (unsigned*)(ws + WS_R); unsigned* Kst = (unsigned*)(ws + WS_K); unsigned* Vst = (unsigned*)(ws + WS_V); unsigned* KKst = (unsigned*)(ws + WS_KK); unsigned* LIN = (unsigned*)(ws + WS_LIN);
    const int d0 = 2 * (lane & 31);
    const float qg0 = INP(IN_QG)[l * 64 + d0], qg1 = INP(IN_QG)[l * 64 + d0 + 1], kg0 = INP(IN_KG)[l * 64 + d0], kg1 = INP(IN_KG)[l * 64 + d0 + 1];
    float mu0[15], mu1[15];
#pragma unroll
    for (int i = 0; i < 15; ++i) { mu0[i] = INP(IN_MU)[l * SHIFTW + 128 * i + 2 * lane]; mu1[i] = INP(IN_MU)[l * SHIFTW + 128 * i + 2 * lane + 1]; }
    float kw0[4], kw1[4];
#pragma unroll
    for (int i = 0; i < 4; ++i) { kw0[i] = INP(IN_KKW)[l * 512 + 128 * i + 2 * lane]; kw1[i] = INP(IN_KKW)[l * 512 + 128 * i + 2 * lane + 1]; }
    const float C2 = 0.125f * 1.4426950408889634f;
    const float sgn = (lane & 16) ? 1.0f : -1.0f;
    for (int w0 = gw; w0 * 17 < TT; w0 += NGW) {
        const int rbeg = w0 * 17;
        unsigned cur[21], nxt[21], prv[15];
#pragma unroll
        for (int i = 0; i < 15; ++i) prv[i] = 0u;
        {   const int r = rbeg; const bool lat = r < TL; const int pos = lat ? (r & 4095) : ((r - TL) & 255);
            if (pos != 0) {
#pragma unroll
                for (int i = 0; i < 15; ++i) prv[i] = P[(size_t)(r - 1) * (INWP / 2) + 64 * (i + 6) + lane]; }
#pragma unroll
            for (int i = 0; i < 21; ++i) cur[i] = P[(size_t)r * (INWP / 2) + 64 * i + lane];
        }
        for (int k = 0; k < 17; ++k) {
            const int r = rbeg + k; const bool lat = r < TL; const int pos = lat ? (r & 4095) : ((r - TL) & 255); const int slen = lat ? 4096 : 256;
            const bool has_next = (pos != slen - 1);
            const bool load_next = (k < 16) || has_next;
            if (load_next && r + 1 < TT) {
#pragma unroll
                for (int i = 0; i < 21; ++i) nxt[i] = P[(size_t)(r + 1) * (INWP / 2) + 64 * i + lane];
            } else {
#pragma unroll
                for (int i = 0; i < 21; ++i) nxt[i] = 0u;
            }
            const int b = lat ? (r >> 12) : ((r - TL) >> 8);
            const size_t kvrow = (size_t)b * KVLEN + (lat ? pos : 4096 + pos);
            f32x4 csv = (f32x4){1.f, 0.f, 1.f, 0.f};
            if (lat) csv = *(const f32x4*)(cs + ((size_t)pos * 32 + 2 * (lane & 15)) * 2);
#pragma unroll
            for (int i = 0; i < 5; ++i) {
                float x0 = bflo(cur[i]), x1 = bfhi(cur[i]);
                const float ss = half_sum(x0 * x0 + x1 * x1);
                const float rstd = __builtin_amdgcn_rsqf(ss * (1.0f / 64.0f) + RMS_EPS);
                x0 = x0 * rstd * (i < 4 ? qg0 : kg0); x1 = x1 * rstd * (i < 4 ? qg1 : kg1);
                const float p0 = __shfl_xor(x0, 16), p1 = __shfl_xor(x1, 16);
                const float y0 = x0 * csv[0] + sgn * p0 * csv[1], y1 = x1 * csv[2] + sgn * p1 * csv[3];
                if (i < 4) *(unsigned*)(QO + (size_t)r * 1024 + 128 * i + 2 * lane) = pkbf(y0 * C2, y1 * C2);
                else *(unsigned*)(KB + kvrow * 128 + 2 * lane) = pkbf(y0, y1);
            }
            *(unsigned*)(VB + kvrow * 128 + 2 * lane) = cur[5];
            const float hn = has_next ? 1.0f : 0.0f;
#pragma unroll
            for (int i = 0; i < 15; ++i) {
                const float c0 = bflo(cur[i + 6]), c1 = bfhi(cur[i + 6]);
                const float a0 = bflo(prv[i]) + hn * bflo(nxt[i + 6]), a1 = bfhi(prv[i]) + hn * bfhi(nxt[i + 6]);
                const float s0 = c0 + mu0[i] * (0.5f * a0 - c0), s1 = c1 + mu1[i] * (0.5f * a1 - c1);
                if (i < 4) Rst[(size_t)r * 256 + 64 * i + lane] = pkbf(s0, s1);
                else if (i < 8) { Kst[(size_t)r * 256 + 64 * (i - 4) + lane] = pkbf(s0, s1);
                    const float t0 = s0 * kw0[i - 4], t1 = s1 * kw1[i - 4]; const float q = half_sum(t0 * t0 + t1 * t1); const float rn = __builtin_amdgcn_rsqf(q + 1e-12f);
                    KKst[(size_t)r * 256 + 64 * (i - 4) + lane] = pkbf(t0 * rn, t1 * rn); }
                else if (i < 12) Vst[(size_t)r * 256 + 64 * (i - 8) + lane] = pkbf(s0, s1);
                else if (i == 12) { const float e0 = __builtin_amdgcn_exp2f(2.0f * 1.4426950408889634f * s0), e1 = __builtin_amdgcn_exp2f(2.0f * 1.4426950408889634f * s1);
                    LIN[(size_t)r * (LORA_K / 2) + lane] = pkbf(1.0f - 2.0f * __builtin_amdgcn_rcpf(1.0f + e0), 1.0f - 2.0f * __builtin_amdgcn_rcpf(1.0f + e1)); }
                else if (i == 13) LIN[(size_t)r * (LORA_K / 2) + 64 + lane] = pkbf(s0, s1);
                else LIN[(size_t)r * (LORA_K / 2) + 128 + lane] = pkbf(sigm(s0), sigm(s1));
            }
#pragma unroll
            for (int i = 0; i < 15; ++i) prv[i] = has_next ? cur[i + 6] : 0u;
#pragma unroll
            for (int i = 0; i < 21; ++i) cur[i] = nxt[i];
        }
    }
}

template <int CTRL> __device__ __forceinline__ float dppf(float v) { return __builtin_bit_cast(float, __builtin_amdgcn_update_dpp(0, __builtin_bit_cast(int, v), CTRL, 0xf, 0xf, true)); }
__device__ __forceinline__ float red16(float v) { v += dppf<0xB1>(v); v += dppf<0x4E>(v); v += dppf<0x141>(v); v += dppf<0x128>(v); return v; }
constexpr int SC_TS = 32, SC_W = 352;
__device__ __forceinline__ void p_scan(Frame& F, const Args& A, int l) {
    unsigned char* const ws = launder(F.ws);
    const int tid = (F.wave * 64 + hw_lane()), lane = tid & 63; (void)lane;
    LAS float* buf = (LAS float*)(F.lds + RING_OFF);
    float* OSC = (float*)(ws + WS_OSC);
    constexpr int NCH = KVLEN / SC_TS;
    for (int item = blockIdx.x; item < 256; item += F.G) {
        const int chain = item >> 1, rh = item & 1, dir = chain & 1, bh = chain >> 1, b = bh >> 3, h = bh & 7;
        const int row = tid >> 4, c = tid & 15;
        float S0 = 0.f, S1 = 0.f, S2 = 0.f, S3 = 0.f;
        const bool stg = tid < 352; const int sub = (tid >= 176) ? 1 : 0, pp = tid - 176 * sub, a = pp >> 5, w = pp & 31;
        const unsigned* p1; int pitch1 = 256;
        if (a == 0 || a == 2) p1 = (const unsigned*)(ws + WS_KK) + h * 32 + w;
        else if (a == 1) { p1 = (const unsigned*)(ws + WS_LOUT) + dir * 256 + h * 32 + w; pitch1 = LORA_N / 2; }
        else if (a == 3) p1 = (const unsigned*)(ws + WS_K) + h * 32 + w;
        else if (a == 4) p1 = (const unsigned*)(ws + WS_R) + h * 32 + w;
        else p1 = (const unsigned*)(ws + WS_V) + h * 32 + rh * 16 + (pp - 160);
        const unsigned* p2 = (const unsigned*)(ws + WS_LOUT) + 512 + dir * 256 + h * 32 + w;
        const bool two = (a == 2 || a == 3);
        const int cw = (a == 5) ? 0 : 2 * w;
        const float cw0 = INP(IN_W0)[l * 1024 + dir * 512 + h * 64 + cw], cw1 = INP(IN_W0)[l * 1024 + dir * 512 + h * 64 + cw + 1];
        const float ca0 = INP(IN_A0)[l * 1024 + dir * 512 + h * 64 + cw], ca1 = INP(IN_A0)[l * 1024 + dir * 512 + h * 64 + cw + 1];
        const float ck0 = INP(IN_KA)[l * 512 + h * 64 + cw], ck1 = INP(IN_KA)[l * 512 + h * 64 + cw + 1];
        unsigned st[16], st2[16];
#define SC_TOK(s) ((s) < CTXL ? (TL + b * CTXL + (dir ? (CTXL - 1 - (s)) : (s))) : (b * SEQL + (dir ? (SEQL - 1 - ((s) - CTXL)) : ((s) - CTXL))))
#define SC_LOAD(ci) do { if (stg) { _Pragma("unroll") for (int i = 0; i < 16; ++i) { const int s = (ci) * SC_TS + 2 * i + sub; const size_t tok = (size_t)SC_TOK(s); \
            st[i] = p1[tok * pitch1]; st2[i] = two ? p2[tok * (LORA_N / 2)] : 0u; } } } while (0)
#define SC_STORE(bi) do { if (stg) { _Pragma("unroll") for (int i = 0; i < 16; ++i) { \
            float x0 = bflo(st[i]), x1 = bfhi(st[i]); \
            if (a == 1) { x0 = __builtin_amdgcn_exp2f(-1.4426950408889634f * 0.6065306597126334f * sigm(x0 + cw0)); x1 = __builtin_amdgcn_exp2f(-1.4426950408889634f * 0.6065306597126334f * sigm(x1 + cw1)); } \
            else if (a == 2) { x0 *= sigm(bflo(st2[i]) + ca0); x1 *= sigm(bfhi(st2[i]) + ca1); } \
            else if (a == 3) { x0 *= 1.0f + (sigm(bflo(st2[i]) + ca0) - 1.0f) * ck0; x1 *= 1.0f + (sigm(bfhi(st2[i]) + ca1) - 1.0f) * ck1; } \
            LAS float* dp = buf + ((bi) * SC_TS + 2 * i + sub) * SC_W + 2 * pp; dp[0] = x0; dp[1] = x1; } } } while (0)
        __syncthreads();
        SC_LOAD(0); SC_STORE(0); __syncthreads();
        for (int ci = 0; ci < NCH; ++ci) {
            if (ci + 1 < NCH) SC_LOAD(ci + 1);
            const LAS float* bp = buf + (ci & 1) * SC_TS * SC_W;
#pragma unroll 2
            for (int stp = 0; stp < SC_TS; ++stp) {
                const LAS float* sp = bp + stp * SC_W;
                const f32x4 kk = *(const LAS f32x4*)(sp + 4 * c), w4 = *(const LAS f32x4*)(sp + 64 + 4 * c), bb = *(const LAS f32x4*)(sp + 128 + 4 * c), kd = *(const LAS f32x4*)(sp + 192 + 4 * c), rr = *(const LAS f32x4*)(sp + 256 + 4 * c);
                const float vv = sp[320 + row];
                float sa = (S0 * kk[0] + S1 * kk[1]) + (S2 * kk[2] + S3 * kk[3]); sa = red16(sa);
                S0 = S0 * w4[0] + (vv * kd[0] - sa * bb[0]); S1 = S1 * w4[1] + (vv * kd[1] - sa * bb[1]); S2 = S2 * w4[2] + (vv * kd[2] - sa * bb[2]); S3 = S3 * w4[3] + (vv * kd[3] - sa * bb[3]);
                float o = (S0 * rr[0] + S1 * rr[1]) + (S2 * rr[2] + S3 * rr[3]); o = red16(o);
                if (c == 0) { const int s = ci * SC_TS + stp; OSC[((size_t)dir * TT + (size_t)SC_TOK(s)) * 512 + h * 64 + rh * 32 + row] = o; }
            }
            if (ci + 1 < NCH) SC_STORE((ci + 1) & 1);
            __syncthreads();
        }
#undef SC_TOK
#undef SC_LOAD
#undef SC_STORE
    }
}

__device__ __forceinline__ void p_readout(Frame& F, const Args& A, int l) {
    unsigned char* const ws = launder(F.ws);
    const int tid = (F.wave * 64 + hw_lane()), lane = tid & 63; (void)lane;
    const int gw = F.vcu * NWAVES + F.wave, NGW = F.G * NWAVES;
    const float* OSC = (const float*)(ws + WS_OSC);
    const unsigned* Rst = (const unsigned*)(ws + WS_R); const unsigned* Vst = (const unsigned*)(ws + WS_V); const unsigned* Kst = (const unsigned*)(ws + WS_K); const unsigned* LOUT = (const unsigned*)(ws + WS_LOUT);
    bf16* QO = (bf16*)(ws + WS_QO);
    float rk0[4], rk1[4], gw0[4], gw1[4], gb0[4], gb1[4], ka0[4], ka1[4], aa0[4], aa1[4], ab0[4], ab1[4];
#pragma unroll
    for (int i = 0; i < 4; ++i) { const int cc = 128 * i + 2 * lane, cidx = l * 512 + cc; rk0[i] = INP(IN_RK)[cidx]; rk1[i] = INP(IN_RK)[cidx + 1]; gw0[i] = INP(IN_GNW)[cidx]; gw1[i] = INP(IN_GNW)[cidx + 1]; gb0[i] = INP(IN_GNB)[cidx]; gb1[i] = INP(IN_GNB)[cidx + 1];
        ka0[i] = INP(IN_KA)[cidx]; ka1[i] = INP(IN_KA)[cidx + 1]; aa0[i] = INP(IN_A0)[l * 1024 + cc]; aa1[i] = INP(IN_A0)[l * 1024 + cc + 1]; ab0[i] = INP(IN_A0)[l * 1024 + 512 + cc]; ab1[i] = INP(IN_A0)[l * 1024 + 512 + cc + 1]; }
    for (int row = gw; row < TT; row += NGW) {
#pragma unroll
        for (int i = 0; i < 4; ++i) {
            const size_t off = (size_t)row * 256 + 64 * i + lane; const size_t lo = (size_t)row * (LORA_N / 2) + 64 * i + lane;
            const float2 oa = *(const float2*)(OSC + (size_t)row * 512 + 128 * i + 2 * lane), ob = *(const float2*)(OSC + ((size_t)TT + row) * 512 + 128 * i + 2 * lane);
            const float o0 = oa.x + ob.x, o1 = oa.y + ob.y;
            const float mean = half_sum(o0 + o1) * (1.0f / 64.0f);
            const float d0 = o0 - mean, d1 = o1 - mean;
            const float var = half_sum(d0 * d0 + d1 * d1) * (1.0f / 64.0f);
            const float rs = __builtin_amdgcn_rsqf(var + GN_EPS);
            const unsigned rw = Rst[off], vw = Vst[off], kw = Kst[off], pa = LOUT[lo + 512], pb = LOUT[lo + 768], gwd = LOUT[lo + 1024];
            const float ks0 = bflo(kw) * (2.0f + (sigm(bflo(pa) + aa0[i]) + sigm(bflo(pb) + ab0[i]) - 2.0f) * ka0[i]), ks1 = bfhi(kw) * (2.0f + (sigm(bfhi(pa) + aa1[i]) + sigm(bfhi(pb) + ab1[i]) - 2.0f) * ka1[i]);
            const float bsum = half_sum(bflo(rw) * ks0 * rk0[i] + bfhi(rw) * ks1 * rk1[i]);
            const float y0 = d0 * rs * gw0[i] + gb0[i] + bsum * bflo(vw), y1 = d1 * rs * gw1[i] + gb1[i] + bsum * bfhi(vw);
            *(unsigned*)(QO + (size_t)row * 1024 + 512 + 128 * i + 2 * lane) = pkbf(y0 * bflo(gwd), y1 * bfhi(gwd));
        }
    }
}

__device__ __forceinline__ void p_route(Frame& F, int nrows) {
    unsigned char* const ws = launder(F.ws);
    const int tid = (F.wave * 64 + hw_lane()), lane = tid & 63; (void)lane;
    const int gw = F.vcu * NWAVES + F.wave, NGW = F.G * NWAVES;
    const int* wcnt = (const int*)(ws + WS_ROUTE + RT_WCNT);
    LAS int* pexp = (LAS int*)(F.lds + LT_PEXP); LAS int* npan = (LAS int*)(F.lds + LT_NPAN); LAS int* tmp = (LAS int*)(F.lds + LT_TMP);
    {   const int e = lane & 7, part = lane >> 3;
        const int p = F.wave * 8 + part;
        const int wb = p * (NGW / 64), we = wb + NGW / 64; const int myw0 = F.vcu * NWAVES;
        int tot = 0, before = 0;
#pragma unroll 16
        for (int w = wb; w < we; ++w) { const int cv = wcnt[(size_t)w * 8 + e]; tot += cv; if (w < myw0) before += cv; }
        tmp[p * 16 + e] = tot; tmp[p * 16 + 8 + e] = before;
    }
    __syncthreads();
    if (tid < 8) { int tot = 0, before = 0; for (int p = 0; p < 64; ++p) { tot += tmp[p * 16 + tid]; before += tmp[p * 16 + 8 + tid]; } tmp[1024 + tid] = tot; tmp[1032 + tid] = before; }
    __syncthreads();
    if (tid == 0) { int acc = 0; for (int e = 0; e < 8; ++e) { const int padded = (tmp[1024 + e] + 255) & ~255; tmp[1040 + e] = acc; acc += padded; tmp[1048 + e] = acc; } npan[0] = acc >> 8; }
    __syncthreads();
    for (int p = tid; p < 320; p += NWAVES * 64) { int e = 7; for (int q = 7; q >= 0; --q) if (p * 256 < tmp[1048 + q]) e = q; pexp[p] = e; }
    int base0, base1, base2, base3, base4, base5, base6, base7;
    {   int bsv[8];
#pragma unroll
        for (int e = 0; e < 8; ++e) bsv[e] = tmp[1040 + e] + tmp[1032 + e];
        typedef int i32x4 __attribute__((ext_vector_type(4)));
#pragma unroll
        for (int w = 0; w < 7; ++w) { const i32x4* wp = (const i32x4*)(wcnt + (size_t)(F.vcu * NWAVES + w) * 8); const i32x4 c0 = wp[0], c1 = wp[1]; const int mk = (w < F.wave) ? 1 : 0;
            bsv[0] += mk * c0[0]; bsv[1] += mk * c0[1]; bsv[2] += mk * c0[2]; bsv[3] += mk * c0[3]; bsv[4] += mk * c1[0]; bsv[5] += mk * c1[1]; bsv[6] += mk * c1[2]; bsv[7] += mk * c1[3]; }
        base0 = bsv[0]; base1 = bsv[1]; base2 = bsv[2]; base3 = bsv[3]; base4 = bsv[4]; base5 = bsv[5]; base6 = bsv[6]; base7 = bsv[7];
    }
    const int* route_e = (const int*)(ws + WS_ROUTE + RT_E); int* route_s = (int*)(ws + WS_ROUTE + RT_S);
    const unsigned char* H = (const unsigned char*)F.out; unsigned char* AG = ws + WS_AG8;
    int ee_n = 0; v4u a_n = (v4u){0u, 0u, 0u, 0u};
    if (gw < nrows) { ee_n = route_e[gw]; a_n = ((const v4u*)(H + (size_t)gw * 1024))[lane]; }
    for (int row = gw; row < nrows; row += NGW) {
        const int ee = ee_n; const v4u a = a_n; const int e0 = ee & 255, e1 = ee >> 8;
        if (row + NGW < nrows) { ee_n = route_e[row + NGW]; a_n = ((const v4u*)(H + (size_t)(row + NGW) * 1024))[lane]; }
        int s0 = 0, s1 = 0;
#define RT_TAKE(E, B) do { if (e0 == E) { s0 = B; B += 1; } if (e1 == E) { s1 = B; B += 1; } } while (0)
        RT_TAKE(0, base0); RT_TAKE(1, base1); RT_TAKE(2, base2); RT_TAKE(3, base3); RT_TAKE(4, base4); RT_TAKE(5, base5); RT_TAKE(6, base6); RT_TAKE(7, base7);
#undef RT_TAKE
        if (lane == 0) { route_s[2 * row] = s0; route_s[2 * row + 1] = s1; }
        ((v4u*)(AG + (size_t)s0 * 1024))[lane] = a; ((v4u*)(AG + (size_t)s1 * 1024))[lane] = a;
    }
    __syncthreads();
}

__device__ __forceinline__ void p_attn(Frame& F, char* ldsg, bool ctx_on) {
    unsigned char* const ws = launder(F.ws);
    const int tid = (F.wave * 64 + hw_lane()), lane = tid & 63; (void)lane;
    typedef attn_body::bf16 abf;
    const abf* Q = (const abf*)(ws + WS_QO); const abf* K = (const abf*)(ws + WS_KB); const abf* V = (const abf*)(ws + WS_VB); abf* O = (abf*)(ws + WS_QO);
    const int per = (1024 + F.G - 1) / F.G;
    for (int i = 0; i < per; ++i) { const int un = F.vcu * per + i; if (un >= 1024) break;
        const int bh = un >> 4, qb = un & 15, b = bh >> 3, h = bh & 7;
        attn_body::attn_unit<8>((long)b * SEQL + qb * 256, h * 64, (long)b * KVLEN, (h >> 2) * 64, KVLEN / 64, Q, K, V, O, ldsg, F.wave); }
    if (ctx_on) for (int un = F.vcu; un < 64; un += F.G) { const int b = un >> 3, h = un & 7;
        attn_body::attn_unit<8>((long)TL + b * CTXL, h * 64, (long)b * KVLEN + SEQL, (h >> 2) * 64, CTXL / 64, Q, K, V, O, ldsg, F.wave); }
}

typedef float f32x16 __attribute__((ext_vector_type(16)));
typedef unsigned u32x2 __attribute__((ext_vector_type(2)));
constexpr int SCH = 64, NCHK = KVLEN / SCH, NITEM = 128 * NCHK;
constexpr int LSTR = 144;
constexpr int L_AKK = 0, L_AR = 9216, L_AK = 18432, L_AB = 27648, L_TK = 36864, L_TB = 46080, L_TV = 55296, L_TW1 = 64512, L_TU = 73728, L_MLK = 82944, L_MMB = 92160, L_MMK = 101376;
constexpr int L_FLB = 110592, L_GC = 126976, L_TII = 127232, L_FX = L_AK;
static_assert(L_TII + 2048 <= RING_BYTES, "scan LDS map");
__device__ __forceinline__ unsigned short bf1(float x) { return (unsigned short)(pkbf(x, 0.f) & 0xffffu); }
__device__ __forceinline__ bf16x8 ldsv8(const LAS unsigned char* p) { return *(const LAS bf16x8*)p; }
template <bool SWA = false, bool SWB = false>
__device__ __forceinline__ f32x16 tile32(const LAS unsigned char* Ab, const LAS unsigned char* Bb, int mi, int ni, int r, int h, f32x16 acc) {
    const int ra = 32 * mi + r, rb = 32 * ni + r; const int xa = SWA ? ((ra >> 3) & 7) : 0, xb = SWB ? ((rb >> 3) & 7) : 0;
#pragma unroll
    for (int kb = 0; kb < 4; ++kb) { const bf16x8 a = ldsv8(Ab + ra * LSTR + (((2 * kb + h) ^ xa) << 4)), b = ldsv8(Bb + rb * LSTR + (((2 * kb + h) ^ xb) << 4));
        acc = __builtin_amdgcn_mfma_f32_32x32x16_bf16(a, b, acc, 0, 0, 0); }
    return acc;
}
__device__ __forceinline__ int jperm(int j) { return (((j >> 2) & 3) << 4) | (((j >> 5) & 1) << 3) | (((j >> 4) & 1) << 2) | (j & 3); }
#define CROW(reg, h) (((reg) & 3) + 8 * ((reg) >> 2) + 4 * (h))


#if DEBUG_NAN
#define DBG_BF(k, off, nbytes) do { unsigned bad_ = 0; for (int i_ = tid; i_ < (nbytes) / 2; i_ += 512) { const int row_ = i_ / 72, col_ = i_ % 72; if (col_ < 64) { const float v_ = __builtin_bit_cast(float, (unsigned)(*(const LAS unsigned short*)(L + (off) + row_ * LSTR + col_ * 2)) << 16); if (!(fabsf(v_) < 1e30f)) ++bad_; } } if (bad_) atomicAdd((unsigned*)(F.ctl + 16 + (k)), bad_); } while (0)
#define DBG_F32(k, off, n) do { unsigned bad_ = 0; for (int i_ = tid; i_ < (n); i_ += 512) { const float v_ = ((const LAS float*)(L + (off)))[i_]; if (!(fabsf(v_) < 1e30f)) ++bad_; } if (bad_) atomicAdd((unsigned*)(F.ctl + 16 + (k)), bad_); } while (0)
#else
#define DBG_BF(k, off, nbytes) do {} while (0)
#define DBG_F32(k, off, n) do {} while (0)
#endif
#define WG_BAR() do { asm volatile("s_waitcnt lgkmcnt(0)" ::: "memory"); __builtin_amdgcn_s_barrier(); asm volatile("" ::: "memory"); } while (0)
template <int CTRL, int RMASK> __device__ __forceinline__ float dppm(float v) { return __builtin_bit_cast(float, __builtin_amdgcn_update_dpp(0, __builtin_bit_cast(int, v), CTRL, RMASK, 0xf, true)); }
__device__ __forceinline__ float wave_incl_scan(float x) {
    x += dppm<0x111, 0xf>(x); x += dppm<0x112, 0xf>(x); x += dppm<0x114, 0xf>(x); x += dppm<0x118, 0xf>(x);
    x += __builtin_bit_cast(float, __builtin_amdgcn_update_dpp(0, __builtin_bit_cast(int, x), 0x142, 0xa, 0xf, false));
    x += __builtin_bit_cast(float, __builtin_amdgcn_update_dpp(0, __builtin_bit_cast(int, x), 0x143, 0xc, 0xf, false));
    return x;
}
struct S1In { v4u kk, r, k, v, pw, pa; f32x4 ka[2]; };
__device__ __forceinline__ void s1_item(Frame& F, unsigned char* const ws, const int lane, const int wv, const int l, const int item, const S1In& cur, S1In& nxt, const float* w0b, const float* a0b, const float* kab, unsigned long long (&cy)[6]) {
#if CYSEL >= 0
#define CY(k) do { const unsigned long long now_ = __builtin_readcyclecounter(); cy[k] += now_ - cy[5]; cy[5] = now_; } while (0)
#else
#define CY(k) do {} while (0)
#endif
    LAS unsigned char* L = F.lds + RING_OFF;
    const bf16* KKst = (const bf16*)(ws + WS_KK); const bf16* Kst = (const bf16*)(ws + WS_K); const bf16* Rst = (const bf16*)(ws + WS_R); const bf16* Vst = (const bf16*)(ws + WS_V); const bf16* LOUT = (const bf16*)(ws + WS_LOUT);
    bf16* PT = (bf16*)(ws + WS_SPT); bf16* GG = (bf16*)(ws + WS_SG); bf16* QQ = (bf16*)(ws + WS_SQ); float* OSC = (float*)(ws + WS_OSC);
    const int r = lane & 31, h = lane >> 5;
#define S1_ITEM(item_) const int chain = (item_) / NCHK, c = (item_) - chain * NCHK, dir = chain & 1, bh = chain >> 1, b = bh >> 3, hd = bh & 7; const int s0 = c * SCH; const int dsg = dir ? -1 : 1; \
        const int tok0 = (s0 < CTXL) ? (TL + b * CTXL + (dir ? (CTXL - 1 - s0) : s0)) : (b * SEQL + (dir ? (SEQL - 1 - (s0 - CTXL)) : (s0 - CTXL)));
#define S1_TOUCH(D) asm volatile("" :: "v"(D.kk), "v"(D.r), "v"(D.k), "v"(D.v), "v"(D.pw), "v"(D.pa), "v"(D.ka[0]), "v"(D.ka[1]))
#define S1_LOAD(D, item_) do { S1_ITEM(item_) const size_t tokr = (size_t)(tok0 + dsg * (8 * wv + (lane >> 3))); const size_t o5 = tokr * 512 + hd * 64 + 8 * (lane & 7); \
        D.kk = *(const v4u*)(KKst + o5); D.r = *(const v4u*)(Rst + o5); D.k = *(const v4u*)(Kst + o5); D.v = *(const v4u*)(Vst + o5); \
        D.pw = *(const v4u*)(LOUT + tokr * LORA_N + dir * 512 + hd * 64 + 8 * (lane & 7)); D.pa = *(const v4u*)(LOUT + tokr * LORA_N + 1024 + dir * 512 + hd * 64 + 8 * (lane & 7)); \
        { D.ka[0] = *(const f32x4*)(kab + hd * 64 + 8 * (lane & 7)); D.ka[1] = *(const f32x4*)(kab + hd * 64 + 8 * (lane & 7) + 4); } } while (0)
    {
        S1_ITEM(item)
        {   const v4u kk8 = cur.kk, r8 = cur.r, k8 = cur.k, v8 = cur.v, pw8 = cur.pw, pa8 = cur.pa; const int jg = lane & 7, t = 8 * wv + (lane >> 3);
            const float kap[8] = {cur.ka[0][0], cur.ka[0][1], cur.ka[0][2], cur.ka[0][3], cur.ka[1][0], cur.ka[1][1], cur.ka[1][2], cur.ka[1][3]};
            LAS float* tot = (LAS float*)(L + L_TII);
            float lw[8], av[8], lam[8];
#pragma unroll
            for (int e = 0; e < 8; ++e) { const unsigned pw = pw8[e >> 1], pa = pa8[e >> 1]; const float zw = (e & 1) ? bfhi(pw) : bflo(pw), za = (e & 1) ? bfhi(pa) : bflo(pa);
                lw[e] = zw; av[e] = za; lam[e] = lw[e]; }
#pragma unroll
            for (int sh = 8; sh <= 32; sh <<= 1) { float y[8]; const float mk = (lane >= sh) ? 1.0f : 0.0f;
#pragma unroll
                for (int e = 0; e < 8; ++e) y[e] = __shfl_up(lam[e], sh);
#pragma unroll
                for (int e = 0; e < 8; ++e) lam[e] = __builtin_fmaf(mk, y[e], lam[e]); }
            if (lane >= 56) { *(LAS f32x4*)(tot + wv * 64 + 8 * jg) = (f32x4){lam[0], lam[1], lam[2], lam[3]}; *(LAS f32x4*)(tot + wv * 64 + 8 * jg + 4) = (f32x4){lam[4], lam[5], lam[6], lam[7]}; }
            if (item + F.G < NITEM) S1_LOAD(nxt, item + F.G);
            WG_BAR();
            for (int w = 0; w < wv; ++w) { const f32x4 q0 = *(const LAS f32x4*)(tot + w * 64 + 8 * jg), q1 = *(const LAS f32x4*)(tot + w * 64 + 8 * jg + 4);
                lam[0] += q0[0]; lam[1] += q0[1]; lam[2] += q0[2]; lam[3] += q0[3]; lam[4] += q1[0]; lam[5] += q1[1]; lam[6] += q1[2]; lam[7] += q1[3]; }
            v4u wkk, wrr, wkd, wbd; float en8[8];
#pragma unroll
            for (int p = 0; p < 4; ++p) { float okk[2], orr[2], okd[2], obd[2];
#pragma unroll
                for (int u = 0; u < 2; ++u) { const int e = 2 * p + u;
                    const unsigned xkk = kk8[p], xr = r8[p], xk = k8[p];
                    const float kkv = u ? bfhi(xkk) : bflo(xkk), rv = u ? bfhi(xr) : bflo(xr), kv = u ? bfhi(xk) : bflo(xk);
                    const float eNp = __builtin_amdgcn_exp2f(lw[e] - lam[e]), eN = __builtin_amdgcn_exp2f(-lam[e]), eP = __builtin_amdgcn_exp2f(lam[e]);
                    okk[u] = kkv * eNp; orr[u] = rv * eN; okd[u] = kv * __builtin_fmaf(av[e], kap[e], 1.0f - kap[e]) * eP; obd[u] = kkv * av[e] * eP;
                    en8[e] = eN; }
                wkk[p] = pkbf(okk[0], okk[1]); wrr[p] = pkbf(orr[0], orr[1]); wkd[p] = pkbf(okd[0], okd[1]); wbd[p] = pkbf(obd[0], obd[1]); }
            if (t == SCH - 1) { *(LAS f32x4*)((LAS float*)(L + L_GC) + 8 * jg) = (f32x4){en8[0], en8[1], en8[2], en8[3]}; *(LAS f32x4*)((LAS float*)(L + L_GC) + 8 * jg + 4) = (f32x4){en8[4], en8[5], en8[6], en8[7]}; }
            *(LAS v4u*)(L + L_AKK + t * LSTR + jg * 16) = wkk; *(LAS v4u*)(L + L_AR + t * LSTR + jg * 16) = wrr; *(LAS v4u*)(L + L_AK + t * LSTR + jg * 16) = wkd; *(LAS v4u*)(L + L_AB + t * LSTR + jg * 16) = wbd;
#pragma unroll
            for (int e = 0; e < 8; ++e) { const int j = 8 * jg + e; const unsigned wk = wkd[e >> 1], wb = wbd[e >> 1], wvv = v8[e >> 1];
                const int to = j * LSTR + ((wv ^ jg) << 4) + (lane >> 3) * 2;
                *(LAS unsigned short*)(L + L_TK + to) = (unsigned short)((e & 1) ? (wk >> 16) : (wk & 0xffffu));
                *(LAS unsigned short*)(L + L_TB + to) = (unsigned short)((e & 1) ? (wb >> 16) : (wb & 0xffffu));
                *(LAS unsigned short*)(L + L_TV + to) = (unsigned short)((e & 1) ? (wvv >> 16) : (wvv & 0xffffu)); }
        }
        WG_BAR();
        CY(0);
#pragma unroll
        for (int jj = 0; jj < 2; ++jj) {
            const int job = 2 * wv + jj, m = job >> 2, si = (job >> 1) & 1, ti = job & 1;
            f32x16 acc = {};
            if (!(si == 1 && ti == 0)) acc = tile32(L + ((m & 1) ? L_AK : L_AB), L + (m < 2 ? L_AKK : L_AR), si, ti, r, h, acc);
            const int tt = 32 * ti + r;
#pragma unroll
            for (int g = 0; g < 4; ++g) { const int sb = 32 * si + 8 * g + 4 * h; float vv[4];
#pragma unroll
                for (int i = 0; i < 4; ++i) { const int s = sb + i; const bool keep = (m < 2) ? (s < tt) : (s <= tt); vv[i] = keep ? acc[4 * g + i] : 0.f; }
                if (m == 0) *(LAS f32x4*)((LAS float*)(L + L_FLB) + tt * 64 + sb) = (f32x4){vv[0], vv[1], vv[2], vv[3]};
                else *(LAS u32x2*)(L + (m == 1 ? L_MLK : (m == 2 ? L_MMB : L_MMK)) + tt * LSTR + sb * 2) = (u32x2){pkbf(vv[0], vv[1]), pkbf(vv[2], vv[3])}; }
        }
        WG_BAR();
        CY(1);
        f32x16 acc_o1 = {}, ag = {};
        {   const int q4 = wv & 3, mi = q4 >> 1, ni = q4 & 1;
            if (wv < 4) { f32x16 acc = {}; acc = tile32<false, true>(L + L_MLK, L + L_TV, mi, ni, r, h, acc);
#pragma unroll
                for (int reg = 0; reg < 16; ++reg) ((LAS float*)(L + L_FX))[(32 * mi + CROW(reg, h)) * 64 + 32 * ni + r] = acc[reg];
                const int col = lane & 15; const LAS float* lb = (const LAS float*)(L + L_FLB) + (16 * wv) * 64 + 16 * wv; float x[16];
#pragma unroll
                for (int tt = 0; tt < 16; ++tt) { float a = (tt == col) ? 1.0f : 0.0f, a2 = 0.0f;
#pragma unroll
                    for (int s4 = 0; s4 < tt; s4 += 4) { const f32x4 lv = *(const LAS f32x4*)(lb + tt * 64 + s4);
#pragma unroll
                        for (int u = 0; u < 4; ++u) if (s4 + u < tt) { if (u & 1) a2 -= lv[u] * x[s4 + u]; else a -= lv[u] * x[s4 + u]; } }
                    x[tt] = a + a2; }
                if (lane < 16) {
#pragma unroll
                    for (int tt = 0; tt < 16; ++tt) *(LAS unsigned short*)(L + L_TII + wv * 512 + tt * 32 + col * 2) = bf1(x[tt]); }
            } else { acc_o1 = tile32<true, false>(L + L_TV, L + L_MMK, mi, ni, r, h, acc_o1);
                ag = tile32<true, true>(L + L_TK, L + L_TV, mi, ni, r, h, ag); }
        }
        WG_BAR();
        CY(2);
        {   const int cc = lane & 15, q = lane >> 4; const bool isw = wv < 4; const int colb = 16 * (wv & 3) + cc;
            f32x4 U[4], R0[4];
            if (isw) {
#pragma unroll
                for (int i = 0; i < 4; ++i)
#pragma unroll
                    for (int reg = 0; reg < 4; ++reg) { const int tt = 16 * i + 4 * q + reg; R0[i][reg] = __builtin_bit_cast(float, (unsigned)(*(const LAS unsigned short*)(L + L_AKK + tt * LSTR + colb * 2)) << 16); }
            } else {
#pragma unroll
                for (int i = 0; i < 4; ++i)
#pragma unroll
                    for (int reg = 0; reg < 4; ++reg) { const int tt = 16 * i + 4 * q + reg; R0[i][reg] = ((const LAS float*)(L + L_FX))[tt * 64 + colb]; }
            }
#pragma unroll
            for (int i = 0; i < 4; ++i) {
                f32x4 R = R0[i];
#pragma unroll
                for (int kp = 0; kp < 2; ++kp) { if (2 * kp < i) {
                    const int k1 = 2 * kp, k2 = 2 * kp + 1; const bool two = (k2 < i);
                    const LAS float* lrow = (const LAS float*)(L + L_FLB) + (16 * i + cc) * 64;
                    const f32x4 la = *(const LAS f32x4*)(lrow + 16 * k1 + 4 * q); f32x4 lb2 = {0.f, 0.f, 0.f, 0.f}; if (two) lb2 = *(const LAS f32x4*)(lrow + 16 * k2 + 4 * q);
                    const v4u aw = (v4u){pkbf(-la[0], -la[1]), pkbf(-la[2], -la[3]), pkbf(-lb2[0], -lb2[1]), pkbf(-lb2[2], -lb2[3])};
                    const f32x4 u1 = U[k1]; f32x4 u2 = {0.f, 0.f, 0.f, 0.f}; if (two) u2 = U[k2];
                    const v4u bh_ = (v4u){pkbf(u1[0], u1[1]), pkbf(u1[2], u1[3]), pkbf(u2[0], u2[1]), pkbf(u2[2], u2[3])};
                    R = __builtin_amdgcn_mfma_f32_16x16x32_bf16(__builtin_bit_cast(bf16x8, aw), __builtin_bit_cast(bf16x8, bh_), R, 0, 0, 0); } }
                const u32x2 tw = *(const LAS u32x2*)(L + L_TII + i * 512 + cc * 32 + q * 8);
                const v4u ta = (v4u){tw.x, tw.y, 0u, 0u};
                const v4u rh = (v4u){pkbf(R[0], R[1]), pkbf(R[2], R[3]), 0u, 0u};
                f32x4 u = {0.f, 0.f, 0.f, 0.f};
                u = __builtin_amdgcn_mfma_f32_16x16x32_bf16(__builtin_bit_cast(bf16x8, ta), __builtin_bit_cast(bf16x8, rh), u, 0, 0, 0);
                U[i] = u;
                *(LAS u32x2*)(L + (isw ? L_TW1 : L_TU) + colb * LSTR + (16 * i + 4 * q) * 2) = (u32x2){pkbf(u[0], u[1]), pkbf(u[2], u[3])};
            }
        }
        WG_BAR();
        CY(3);
        S1_TOUCH(nxt);
        {   const int q4 = wv & 3, mi = q4 >> 1, ni = q4 & 1; const LAS float* gc = (const LAS float*)(L + L_GC);
            if (wv < 4) {
                f32x16 acc = {}; acc = tile32<false, true>(L + L_TW1, L + L_TB, mi, ni, r, h, acc);
                const int jp = 32 * ni + r; const float gj = gc[jp]; bf16* pt = PT + (size_t)item * 4096 + (size_t)jp * 64;
#pragma unroll
                for (int gp2 = 0; gp2 < 2; ++gp2) { unsigned pw[4];
#pragma unroll
                    for (int u = 0; u < 2; ++u) { const int g = gp2 + 2 * u, j0 = 32 * mi + 8 * g + 4 * h; float pv[4];
#pragma unroll
                        for (int i = 0; i < 4; ++i) pv[i] = (((j0 + i) == jp ? 1.0f : 0.0f) - acc[4 * g + i]) * gj;
                        pw[2 * u] = pkbf(pv[0], pv[1]); pw[2 * u + 1] = pkbf(pv[2], pv[3]); }
                    *(v4u*)(pt + 16 * (2 * gp2 + h) + 8 * mi) = (v4u){pw[0], pw[1], pw[2], pw[3]}; }
                f32x16 acq = {}; acq = tile32(L + L_TW1, L + L_MMB, mi, ni, r, h, acq);
                const int tt = 32 * ni + r; bf16* qq = QQ + (size_t)item * 4096 + (size_t)tt * 64;
#pragma unroll
                for (int gp2 = 0; gp2 < 2; ++gp2) { unsigned qw[4];
#pragma unroll
                    for (int u = 0; u < 2; ++u) { const int g = gp2 + 2 * u, j0 = 32 * mi + 8 * g + 4 * h; const u32x2 rw = *(const LAS u32x2*)(L + L_AR + tt * LSTR + j0 * 2);
                        qw[2 * u] = pkbf(bflo(rw.x) - acq[4 * g], bfhi(rw.x) - acq[4 * g + 1]); qw[2 * u + 1] = pkbf(bflo(rw.y) - acq[4 * g + 2], bfhi(rw.y) - acq[4 * g + 3]); }
                    *(v4u*)(qq + 16 * (2 * gp2 + h) + 8 * mi) = (v4u){qw[0], qw[1], qw[2], qw[3]}; }
            } else {
                f32x16 acc = {}; acc = tile32(L + L_TU, L + L_MMB, mi, ni, r, h, acc);
                const int tt = 32 * ni + r; bf16* op = (bf16*)OSC + ((size_t)dir * TT + (size_t)(tok0 + dsg * tt)) * 512 + hd * 64;
#pragma unroll
                for (int gp2 = 0; gp2 < 2; ++gp2) { unsigned ow_[4];
#pragma unroll
                    for (int u = 0; u < 2; ++u) { const int g = gp2 + 2 * u; ow_[2 * u] = pkbf(acc_o1[4 * g] - acc[4 * g], acc_o1[4 * g + 1] - acc[4 * g + 1]); ow_[2 * u + 1] = pkbf(acc_o1[4 * g + 2] - acc[4 * g + 2], acc_o1[4 * g + 3] - acc[4 * g + 3]); }
                    *(v4u*)(op + 16 * (2 * gp2 + h) + 8 * mi) = (v4u){ow_[0], ow_[1], ow_[2], ow_[3]}; }
                f32x16 ah = {}; ah = tile32<true, false>(L + L_TB, L + L_TU, mi, ni, r, h, ah);
                const int v = 32 * ni + r; bf16* gp = GG + (size_t)item * 4096 + (size_t)v * 64;
#pragma unroll
                for (int gp2 = 0; gp2 < 2; ++gp2) { unsigned gw_[4];
#pragma unroll
                    for (int u = 0; u < 2; ++u) { const int g = gp2 + 2 * u, j0 = 32 * mi + 8 * g + 4 * h; const f32x4 gj = *(const LAS f32x4*)(gc + j0); float gv[4];
#pragma unroll
                        for (int i = 0; i < 4; ++i) gv[i] = (ag[4 * g + i] - ah[4 * g + i]) * gj[i];
                        gw_[2 * u] = pkbf(gv[0], gv[1]); gw_[2 * u + 1] = pkbf(gv[2], gv[3]); }
                    *(v4u*)(gp + 16 * (2 * gp2 + h) + 8 * mi) = (v4u){gw_[0], gw_[1], gw_[2], gw_[3]}; }
            }
        }
        WG_BAR();
        CY(4);
    }
#undef CY
}
__device__ __forceinline__ void p_scan1(Frame& F, const Args& A, int l) {
    unsigned char* const ws = launder(F.ws);
    const int tid = (F.wave * 64 + hw_lane()), lane = tid & 63, wv = F.wave;
    const bf16* KKst = (const bf16*)(ws + WS_KK); const bf16* Kst = (const bf16*)(ws + WS_K); const bf16* Rst = (const bf16*)(ws + WS_R); const bf16* Vst = (const bf16*)(ws + WS_V); const bf16* LOUT = (const bf16*)(ws + WS_LOUT);
    const float* w0b = INP(IN_W0) + l * 1024; const float* a0b = INP(IN_A0) + l * 1024; const float* kab = INP(IN_KA) + l * 512;
    S1In sa = {}, sb = {}; unsigned long long cy[6] = {0, 0, 0, 0, 0, 0};
#if CYSEL >= 0
    cy[5] = __builtin_readcyclecounter();
#endif
    if ((int)blockIdx.x < NITEM) S1_LOAD(sa, (int)blockIdx.x);
    S1_TOUCH(sa);
    for (int item = blockIdx.x; item < NITEM; item += 2 * F.G) {
        s1_item(F, ws, lane, wv, l, item, sa, sb, w0b, a0b, kab, cy);
        if (item + F.G < NITEM) s1_item(F, ws, lane, wv, l, item + F.G, sb, sa, w0b, a0b, kab, cy);
    }
#if CYSEL >= 0
    if (blockIdx.x == 0 && F.wave == 0 && hw_lane() == 0) { unsigned long long* cs_ = (unsigned long long*)(F.ws + WS_CTL + 40960); for (int k = 0; k < 5; ++k) cs_[k] += cy[k]; }
#endif
}
#undef S1_ITEM
#undef S1_LOAD
#undef S1_TOUCH

struct S2Ops { v4u pa[4][2]; v4u gt[2]; };
__device__ __forceinline__ void s2_load(S2Ops& o, const bf16* PT, const bf16* GG, int chain, int c, int cc, int q, int v) {
    const size_t ib = ((size_t)chain * NCHK + c) * 4096;
#pragma unroll
    for (int J = 0; J < 4; ++J) { const bf16* prow = PT + ib + (size_t)(16 * J + cc) * 64;
#pragma unroll
        for (int kb = 0; kb < 2; ++kb) o.pa[J][kb] = *(const v4u*)(prow + 16 * q + 8 * kb); }
#pragma unroll
    for (int kb = 0; kb < 2; ++kb) o.gt[kb] = *(const v4u*)(GG + ib + (size_t)v * 64 + 16 * q + 8 * kb);
}
__device__ __forceinline__ void s2_step(f32x4 (&St)[4], const S2Ops& o, bf16* S0, int chain, int c, int q, int v) {
    const size_t ib = ((size_t)chain * NCHK + c) * 4096;
    v4u bh_[2], bl_[2];
#pragma unroll
    for (int kb = 0; kb < 2; ++kb) { const f32x4 u1 = St[2 * kb], u2 = St[2 * kb + 1];
        bh_[kb] = (v4u){pkbf(u1[0], u1[1]), pkbf(u1[2], u1[3]), pkbf(u2[0], u2[1]), pkbf(u2[2], u2[3])};
        bl_[kb] = (v4u){pkbf(u1[0] - bflo(bh_[kb].x), u1[1] - bfhi(bh_[kb].x)), pkbf(u1[2] - bflo(bh_[kb].y), u1[3] - bfhi(bh_[kb].y)), pkbf(u2[0] - bflo(bh_[kb].z), u2[1] - bfhi(bh_[kb].z)), pkbf(u2[2] - bflo(bh_[kb].w), u2[3] - bfhi(bh_[kb].w))};
        *(v4u*)(S0 + ib + (size_t)v * 64 + 16 * q + 8 * kb) = bh_[kb]; }
#pragma unroll
    for (int J = 0; J < 4; ++J) { const unsigned g0 = (J & 1) ? o.gt[J >> 1].z : o.gt[J >> 1].x, g1 = (J & 1) ? o.gt[J >> 1].w : o.gt[J >> 1].y; f32x4 acc = (f32x4){bflo(g0), bfhi(g0), bflo(g1), bfhi(g1)};
#pragma unroll
        for (int kb = 0; kb < 2; ++kb) { const v4u aw = o.pa[J][kb];
            acc = __builtin_amdgcn_mfma_f32_16x16x32_bf16(__builtin_bit_cast(bf16x8, aw), __builtin_bit_cast(bf16x8, bh_[kb]), acc, 0, 0, 0);
            acc = __builtin_amdgcn_mfma_f32_16x16x32_bf16(__builtin_bit_cast(bf16x8, aw), __builtin_bit_cast(bf16x8, bl_[kb]), acc, 0, 0, 0); }
        St[J] = acc; }
}
__device__ __forceinline__ void p_scan2(Frame& F) {
    unsigned char* const ws = launder(F.ws);
    const int tid = (F.wave * 64 + hw_lane()), lane = tid & 63;
    const bf16* PT = (const bf16*)(ws + WS_SPT); const bf16* GG = (const bf16*)(ws + WS_SG); bf16* S0 = (bf16*)F.out;
    const int cc = lane & 15, q = lane >> 4;
    static_assert(NCHK % 4 == 0, "stage 2 ring depth");
    for (int wi = F.wave * F.G + (int)blockIdx.x; wi < 512; wi += NWAVES * F.G) {
        const int chain = wi >> 2, vg = wi & 3; const int v = 16 * vg + cc;
        f32x4 St[4];
#pragma unroll
        for (int J = 0; J < 4; ++J) St[J] = (f32x4){0.f, 0.f, 0.f, 0.f};
        S2Ops o0, o1, o2, o3;
        s2_load(o0, PT, GG, chain, 0, cc, q, v); s2_load(o1, PT, GG, chain, 1, cc, q, v); s2_load(o2, PT, GG, chain, 2, cc, q, v);
        for (int c = 0; c < NCHK; c += 4) {
            s2_load(o3, PT, GG, chain, c + 3, cc, q, v);                 s2_step(St, o0, S0, chain, c, q, v);
            if (c + 4 < NCHK) s2_load(o0, PT, GG, chain, c + 4, cc, q, v); s2_step(St, o1, S0, chain, c + 1, q, v);
            if (c + 5 < NCHK) s2_load(o1, PT, GG, chain, c + 5, cc, q, v); s2_step(St, o2, S0, chain, c + 2, q, v);
            if (c + 6 < NCHK) s2_load(o2, PT, GG, chain, c + 6, cc, q, v); s2_step(St, o3, S0, chain, c + 3, q, v);
        }
    }
}

__device__ __forceinline__ void p_scan3(Frame& F) {
    unsigned char* const ws = launder(F.ws);
    const int tid = (F.wave * 64 + hw_lane()), lane = tid & 63;
    const bf16* QQ = (const bf16*)(ws + WS_SQ); const bf16* S0 = (const bf16*)F.out; float* OSC = (float*)(ws + WS_OSC);
    const int gw = F.vcu * NWAVES + F.wave, NGW = F.G * NWAVES; const int r = lane & 31, h = lane >> 5;
    bf16x8 sa[4], qb[4], sa2[4], qb2[4]; f32x4 ov[4], ov2[4]; float* op = nullptr; float* op2 = nullptr;
#define S3_LOAD(SA, QB, OV, OP, job_) do { const int item = (job_) >> 2, mi = ((job_) >> 1) & 1, ni = (job_) & 1; \
        const int chain = item / NCHK, c = item - chain * NCHK, dir = chain & 1, bh = chain >> 1, b = bh >> 3, hd = bh & 7; const int s0 = c * SCH + 32 * ni + r; \
        const int tok = (s0 < CTXL) ? (TL + b * CTXL + (dir ? (CTXL - 1 - s0) : s0)) : (b * SEQL + (dir ? (SEQL - 1 - (s0 - CTXL)) : (s0 - CTXL))); \
        const bf16* sp = S0 + (size_t)item * 4096 + (size_t)(32 * mi + r) * 64 + 8 * h; const bf16* qp = QQ + (size_t)item * 4096 + (size_t)(32 * ni + r) * 64 + 8 * h; \
        _Pragma("unroll") for (int kb = 0; kb < 4; ++kb) { SA[kb] = *(const bf16x8*)(sp + 16 * kb); QB[kb] = *(const bf16x8*)(qp + 16 * kb); } \
        OP = OSC + ((size_t)dir * TT + (size_t)tok) * 512 + hd * 64 + 32 * mi + 4 * h; \
        _Pragma("unroll") for (int g = 0; g < 4; ++g) OV[g] = *(const f32x4*)(OP + 8 * g); } while (0)
    int job = gw;
    if (job < NITEM * 4) S3_LOAD(sa, qb, ov, op, job);
    for (; job < NITEM * 4; job += NGW) {
        const int nj = job + NGW;
        if (nj < NITEM * 4) S3_LOAD(sa2, qb2, ov2, op2, nj);
        f32x16 acc = {};
#pragma unroll
        for (int kb = 0; kb < 4; ++kb) acc = __builtin_amdgcn_mfma_f32_32x32x16_bf16(sa[kb], qb[kb], acc, 0, 0, 0);
#pragma unroll
        for (int g = 0; g < 4; ++g) *(f32x4*)(op + 8 * g) = ov[g] + (f32x4){acc[4 * g], acc[4 * g + 1], acc[4 * g + 2], acc[4 * g + 3]};
#pragma unroll
        for (int kb = 0; kb < 4; ++kb) { sa[kb] = sa2[kb]; qb[kb] = qb2[kb]; ov[kb] = ov2[kb]; }
        op = op2;
    }
#undef S3_LOAD
}


__device__ __forceinline__ void s3_fetch(v4u (&d)[4], const bf16* base, size_t pitch, int lane) {
#pragma unroll
    for (int i = 0; i < 4; ++i) d[i] = *(const v4u*)(base + (size_t)((lane >> 3) + 8 * i) * pitch + (lane & 7) * 8);
}
template <bool PERMUTED = false>
__device__ __forceinline__ void s3_relayout(uint2 (&o)[8], const v4u (&d)[4], LAS unsigned char* stg, int lane) {
    const int r = lane & 31, h = lane >> 5;
#pragma unroll
    for (int i = 0; i < 4; ++i) *(LAS v4u*)(stg + ((lane >> 3) + 8 * i) * LSTR + (lane & 7) * 16) = d[i];
#pragma unroll
    for (int mi = 0; mi < 2; ++mi)
#pragma unroll
        for (int g = 0; g < 4; ++g) { const int c0 = 32 * mi + 8 * g + 4 * h; const u32x2 w = *(const LAS u32x2*)(stg + r * LSTR + (PERMUTED ? jperm(c0) : c0) * 2); o[mi * 4 + g] = make_uint2(w.x, w.y); }
}
__device__ __forceinline__ void p_scan3r(Frame& F, const Args& A, int l) {
    unsigned char* const ws = launder(F.ws);
    const int tid = (F.wave * 64 + hw_lane()), lane = tid & 63;
    const bf16* QQ = (const bf16*)(ws + WS_SQ); const bf16* S0 = (const bf16*)F.out; const bf16* OSC = (const bf16*)(ws + WS_OSC);
    const bf16* Rst = (const bf16*)(ws + WS_R); const bf16* Vst = (const bf16*)(ws + WS_V); const bf16* Kst = (const bf16*)(ws + WS_K); const bf16* LOUT = (const bf16*)(ws + WS_LOUT);
    bf16* QO = (bf16*)(ws + WS_QO);
    LAS unsigned char* stg = F.lds + RING_OFF + F.wave * 4608;
    const int gw = F.vcu * NWAVES + F.wave, NGW = F.G * NWAVES; const int r = lane & 31, h = lane >> 5;
    const float* rkp = INP(IN_RK) + l * 512; const float* gnwp = INP(IN_GNW) + l * 512; const float* gnbp = INP(IN_GNB) + l * 512; const float* kap = INP(IN_KA) + l * 512; const float* a0p = INP(IN_A0) + l * 1024;
    for (int unit = gw; unit < 64 * (KVLEN / 32); unit += NGW) {
        const int bh = unit / (KVLEN / 32), pb = unit - bh * (KVLEN / 32), b = bh >> 3, hd = bh & 7, p0 = pb * 32;
        const size_t tokb = (p0 < CTXL) ? (size_t)(TL + b * CTXL + p0) : (size_t)(b * SEQL + (p0 - CTXL)); const size_t tok = tokb + r;
        const int sb0 = (p0 < CTXL) ? (CTXL - 1 - p0) : (KVLEN + CTXL - 1 - p0);
        const int itf = (bh * 2) * NCHK + (p0 >> 6), itb = (bh * 2 + 1) * NCHK + (sb0 >> 6); const int tf = (p0 & 63) + r, tb = (sb0 & 63) - r;
        v4u ga[4], gb[4];
        s3_fetch(ga, OSC + tokb * 512 + hd * 64, 512, lane); s3_fetch(gb, OSC + ((size_t)TT + tokb) * 512 + hd * 64, 512, lane);
        f32x4 o[2][4];
        {   f32x16 acc[2][2];
#pragma unroll
            for (int d = 0; d < 2; ++d) { const size_t ib = (size_t)(d ? itb : itf) * 4096; const bf16* qp = QQ + ib + (size_t)(d ? tb : tf) * 64 + 8 * h;
                bf16x8 qf[4];
#pragma unroll
                for (int kb = 0; kb < 4; ++kb) qf[kb] = *(const bf16x8*)(qp + 16 * kb);
#pragma unroll
                for (int mi = 0; mi < 2; ++mi) { const bf16* sp = S0 + ib + (size_t)(32 * mi + r) * 64 + 8 * h; f32x16 a = {};
#pragma unroll
                    for (int kb = 0; kb < 4; ++kb) a = __builtin_amdgcn_mfma_f32_32x32x16_bf16(*(const bf16x8*)(sp + 16 * kb), qf[kb], a, 0, 0, 0);
                    acc[d][mi] = a; } }
#pragma unroll
            for (int mi = 0; mi < 2; ++mi)
#pragma unroll
                for (int g = 0; g < 4; ++g)
#pragma unroll
                    for (int i = 0; i < 4; ++i) o[mi][g][i] = acc[0][mi][4 * g + i] + acc[1][mi][4 * g + i]; }
        uint2 ta[8], tb8[8];
        s3_relayout<true>(ta, ga, stg, lane); s3_fetch(ga, Rst + tokb * 512 + hd * 64, 512, lane);
        s3_relayout<true>(tb8, gb, stg, lane); s3_fetch(gb, Kst + tokb * 512 + hd * 64, 512, lane);
        float s1 = 0.f;
#pragma unroll
        for (int mi = 0; mi < 2; ++mi)
#pragma unroll
            for (int g = 0; g < 4; ++g) { const uint2 of = ta[mi * 4 + g], ob = tb8[mi * 4 + g]; f32x4 v = o[mi][g];
                v[0] += bflo(of.x) + bflo(ob.x); v[1] += bfhi(of.x) + bfhi(ob.x); v[2] += bflo(of.y) + bflo(ob.y); v[3] += bfhi(of.y) + bfhi(ob.y);
                o[mi][g] = v; s1 += (v[0] + v[1]) + (v[2] + v[3]); }
        s1 += __shfl_xor(s1, 32); const float mean = s1 * (1.0f / 64.0f);
        const int cb = hd * 64 + 4 * h;
        float s2 = 0.f, bs = 0.f;
        f32x4 rkv[8], sa[8];
        {   uint2 rr8[8], kk8[8];
            s3_relayout(rr8, ga, stg, lane); s3_fetch(ga, LOUT + tokb * LORA_N + 1024 + hd * 64, LORA_N, lane);
            s3_relayout(kk8, gb, stg, lane); s3_fetch(gb, LOUT + tokb * LORA_N + 1536 + hd * 64, LORA_N, lane);
#pragma unroll
            for (int q = 0; q < 8; ++q) { const int cl = cb + 32 * (q >> 2) + 8 * (q & 3); const f32x4 rk4 = *(const f32x4*)(rkp + cl);
                f32x4 d = o[q >> 2][q & 3] - mean; o[q >> 2][q & 3] = d; s2 += (d[0] * d[0] + d[1] * d[1]) + (d[2] * d[2] + d[3] * d[3]);
                rkv[q] = (f32x4){bflo(rr8[q].x) * bflo(kk8[q].x) * rk4[0], bfhi(rr8[q].x) * bfhi(kk8[q].x) * rk4[1], bflo(rr8[q].y) * bflo(kk8[q].y) * rk4[2], bfhi(rr8[q].y) * bfhi(kk8[q].y) * rk4[3]}; } }
        {   uint2 pa8[8];
            s3_relayout(pa8, ga, stg, lane); s3_fetch(ga, Vst + tokb * 512 + hd * 64, 512, lane);
#pragma unroll
            for (int q = 0; q < 8; ++q) sa[q] = (f32x4){bflo(pa8[q].x), bfhi(pa8[q].x), bflo(pa8[q].y), bfhi(pa8[q].y)}; }
        {   uint2 pb8[8];
            s3_relayout(pb8, gb, stg, lane); s3_fetch(gb, LOUT + tokb * LORA_N + 2048 + hd * 64, LORA_N, lane);
#pragma unroll
            for (int q = 0; q < 8; ++q) { const int cl = cb + 32 * (q >> 2) + 8 * (q & 3); const f32x4 ka4 = *(const f32x4*)(kap + cl);
                const float pq[4] = {bflo(pb8[q].x), bfhi(pb8[q].x), bflo(pb8[q].y), bfhi(pb8[q].y)};
#pragma unroll
                for (int i = 0; i < 4; ++i) bs += rkv[q][i] * (2.0f + (sa[q][i] + pq[i] - 2.0f) * ka4[i]); } }
        s2 += __shfl_xor(s2, 32); bs += __shfl_xor(bs, 32);
        const float rs = __builtin_amdgcn_rsqf(s2 * (1.0f / 64.0f) + GN_EPS);
        uint2 vv8[8], gg8[8];
        s3_relayout(vv8, ga, stg, lane); s3_relayout(gg8, gb, stg, lane);
#pragma unroll
        for (int mi = 0; mi < 2; ++mi)
#pragma unroll
            for (int g = 0; g < 4; ++g) { const int cl = cb + 32 * mi + 8 * g; const int q = mi * 4 + g;
                const uint2 vw = vv8[q], gwd = gg8[q];
                const f32x4 w4 = *(const f32x4*)(gnwp + cl), b4 = *(const f32x4*)(gnbp + cl); const f32x4 d = o[mi][g];
                const float y0 = (d[0] * rs * w4[0] + b4[0] + bs * bflo(vw.x)) * bflo(gwd.x), y1 = (d[1] * rs * w4[1] + b4[1] + bs * bfhi(vw.x)) * bfhi(gwd.x);
                const float y2 = (d[2] * rs * w4[2] + b4[2] + bs * bflo(vw.y)) * bflo(gwd.y), y3 = (d[3] * rs * w4[3] + b4[3] + bs * bfhi(vw.y)) * bfhi(gwd.y);
                *(LAS u32x2*)(stg + r * LSTR + (32 * mi + 8 * g + 4 * h) * 2) = (u32x2){pkbf(y0, y1), pkbf(y2, y3)}; }
#pragma unroll
        for (int i = 0; i < 4; ++i) { const int row = (lane >> 3) + 8 * i; const v4u val = *(const LAS v4u*)(stg + row * LSTR + (lane & 7) * 16);
            *(v4u*)(QO + (tokb + row) * 1024 + 512 + hd * 64 + (lane & 7) * 8) = val; }
    }
}

#if DEBUG_NAN
__device__ __forceinline__ void dbg_count(Frame& F) {
    unsigned char* const ws = launder(F.ws);
    const size_t gt = (size_t)blockIdx.x * 512 + threadIdx.x, NT = (size_t)F.G * 512;
    const unsigned short* arr[4] = {(const unsigned short*)(ws + WS_SPT), (const unsigned short*)(ws + WS_SG), (const unsigned short*)(ws + WS_SQ), (const unsigned short*)F.out};
#pragma unroll
    for (int a = 0; a < 4; ++a) { unsigned bad = 0; for (size_t i = gt; i < (size_t)NITEM * 4096; i += NT) { const float v = __builtin_bit_cast(float, (unsigned)arr[a][i] << 16); if (!(fabsf(v) < 1e30f)) ++bad; }
        if (bad) atomicAdd((unsigned*)(F.ctl + 8 + a), bad); }
    { const float* o = (const float*)(ws + WS_OSC); unsigned bad = 0; for (size_t i = gt; i < (size_t)2 * TT * 512; i += NT) { if (!(fabsf(o[i]) < 1e30f)) ++bad; } if (bad) atomicAdd((unsigned*)(F.ctl + 12), bad); }
}
#endif
template <int l> __device__ __forceinline__ void layer_body(Frame& F, const Args& args, const XcdBarrier& bar, unsigned char* lds) {
#define GRID_BAR() xcd_barrier(bar)

        constexpr bool last = (l == DEPTH - 1), moe = (l & 1) != 0;

#ifndef SKIP_WPREP
        p_wprep(F, args, l, 0);
#endif


#ifndef SKIP_NORM1
        {   if (l == 0) p_norm<false, false, true>(F, args, l, 0, INP(IN_X), INP(IN_CTX), 0);
            else if (l & 1) p_norm<false, false, false, true>(F, args, l, 0, nullptr, nullptr, 0);
            else p_norm<false, true, false>(F, args, l, 0, nullptr, nullptr, l - 1); }
#endif

        GRID_BAR(); TS(1);
        {   unsigned char* const ws = launder(F.ws); bf16* const XB = (bf16*)(ws + WS_XB); const float* const MOD = (const float*)(ws + WS_MOD); bf16* const H = (bf16*)F.out; (void)XB; (void)MOD; (void)H;
            pg8::Gemm g{H, (const bf16*)(ws + WS_WIN), TT, INWP, 1024, 0}; pg8::Sched S; S.init(TT / 256, INWP / 256, F.G, (int)blockIdx.x, nullptr);
            pg8::EpiBf16 E{(bf16*)(ws + WS_P), INWP};
#ifndef SKIP_G_IN
            pg8::gemm_phase<pg8::EpiBf16, pg8::Sched, true, true>(F.lds + RING_OFF, g, S, E, F.wave);
#endif
            }
        GRID_BAR(); TS(2);

#ifndef SKIP_PREP
        p_prep(F, args, l);
#endif
#if PROBE == 2
        p_prep(F, args, l);
#endif

        GRID_BAR(); TS(3);
        {   unsigned char* const ws = launder(F.ws); bf16* const XB = (bf16*)(ws + WS_XB); const float* const MOD = (const float*)(ws + WS_MOD); bf16* const H = (bf16*)F.out; (void)XB; (void)MOD; (void)H;
            pg8::Gemm g{(const bf16*)(ws + WS_LIN), (const bf16*)(ws + WS_WLORA), TT, LORA_N, 128, LORA_K}; pg8::Sched S; S.init(TT / 256, LORA_N / 256, F.G, (int)blockIdx.x, nullptr); S.lora = 1;
            pg8::EpiLoraAct E{(bf16*)(ws + WS_LOUT), LORA_N, INP(IN_W0) + l * 1024, INP(IN_A0) + l * 1024};
#ifndef SKIP_G_LORA
            pg8::gemm_phase<pg8::EpiLoraAct, pg8::Sched, true, true>(F.lds + RING_OFF, g, S, E, F.wave);
#endif
            }

#ifndef SKIP_ATTN
        p_attn(F, (char*)lds + RING_OFF, !last);
#endif

        GRID_BAR(); TS(4);

#if USE_SEQ_SCAN
        p_scan(F, args, l);
#else
        p_scan1(F, args, l);
#if PROBE == 5
        p_scan1(F, args, l);
#endif
        GRID_BAR(); TS(5);
        p_scan2(F);
#if PROBE == 6
        p_scan2(F);
#endif
        GRID_BAR(); TS(6);
        p_scan3r(F, args, l);
#endif
#if USE_SEQ_SCAN
        GRID_BAR(); TS(15);
        p_readout(F, args, l);
#endif
        GRID_BAR(); TS(7);
        {   unsigned char* const ws = launder(F.ws); bf16* const XB = (bf16*)(ws + WS_XB); const float* const MOD = (const float*)(ws + WS_MOD); bf16* const H = (bf16*)F.out; (void)XB; (void)MOD; (void)H;
            pg8::Gemm g{(const bf16*)(ws + WS_QO), (const bf16*)(ws + WS_WOUT), TT, 1024, 1024, 0, 0}; pg8::SchedSK S; S.init(TL / 256, !last, 1024 / 64, F.G, (int)blockIdx.x);
            pg8::EpiResidB<l == 0> E{INP(IN_X), INP(IN_CTX), XB, MOD + (size_t)l * 9 * 6144 + 2 * 1024, (bf16*)(ws + WS_SIDE), 1.0f};
#ifndef SKIP_G_OUT
            pg8::gemm_phase<pg8::EpiResidB<l == 0>, pg8::SchedSK, true, true>(F.lds + RING_OFF, g, S, E, F.wave);
#endif
            }
        GRID_BAR(); TS(8);
        p_wprep(F, args, l, 1);
#if PROBE == 7
        p_wprep(F, args, l, 1);
#endif
        if (!moe) {
            p_norm<false, false, false, true>(F, args, l, 1, nullptr, nullptr, 0);
#if PROBE == 4
            p_norm<false, false, false, false>(F, args, l, 1, nullptr, nullptr, 0);
#endif
            GRID_BAR(); TS(9);
            {   unsigned char* const ws = launder(F.ws); bf16* const XB = (bf16*)(ws + WS_XB); const float* const MOD = (const float*)(ws + WS_MOD); bf16* const H = (bf16*)F.out; (void)XB; (void)MOD; (void)H;
            pg8::Gemm g{H, (const bf16*)(ws + WS_WFF), TT, 2 * FFD, 1024, 0}; pg8::Sched S; S.init(TT / 256, 2 * FFD / 256, F.G, (int)blockIdx.x, nullptr);
                pg8::EpiSwiGLU E{(bf16*)(ws + WS_HID), FFD, 1.0f};
#ifndef SKIP_G_UP
                pg8::gemm_phase<pg8::EpiSwiGLU, pg8::Sched, true, true>(F.lds + RING_OFF, g, S, E, F.wave);
#endif
            }
            GRID_BAR(); TS(10);
            {   unsigned char* const ws = launder(F.ws); bf16* const XB = (bf16*)(ws + WS_XB); const float* const MOD = (const float*)(ws + WS_MOD); bf16* const H = (bf16*)F.out; (void)XB; (void)MOD; (void)H;
            pg8::Gemm g{(const bf16*)(ws + WS_HID), (const bf16*)(ws + WS_WFF_D_DENSE), TT, 1024, FFD, 0, 0}; pg8::SchedSK S; S.init(TL / 256, true, FFD / 64, F.G, (int)blockIdx.x);
                pg8::EpiResidB<false> E{nullptr, nullptr, XB, MOD + (size_t)l * 9 * 6144 + 5 * 1024, (bf16*)(ws + WS_SIDE), 1.0f};
#ifndef SKIP_G_DOWN
                pg8::gemm_phase<pg8::EpiResidB<false>, pg8::SchedSK, true, true>(F.lds + RING_OFF, g, S, E, F.wave);
#endif
            }
            GRID_BAR(); TS(11);
        } else {
            p_norm<true, false, false, !last>(F, args, l, 1, nullptr, nullptr, 0, last ? TL : TT);
#if PROBE == 4
            p_norm<true, false, false, false>(F, args, l, 1, nullptr, nullptr, 0, last ? TL : TT);
#endif
            GRID_BAR(); TS(9);

#ifndef SKIP_ROUTE
            p_route(F, last ? TL : TT);
#endif

            GRID_BAR(); TS(12);
            const int npanels = *(LAS int*)(F.lds + LT_NPAN);
            {   unsigned char* const ws = launder(F.ws); bf16* const XB = (bf16*)(ws + WS_XB); const float* const MOD = (const float*)(ws + WS_MOD); bf16* const H = (bf16*)F.out; (void)XB; (void)MOD; (void)H;
            pg8::Gemm g{(const bf16*)(ws + WS_AG8), (const bf16*)(ws + WS_WFF), npanels * 256, 2 * FFE, 512, 0}; pg8::Sched S; S.init(npanels, 2 * FFE / 256, F.G, (int)blockIdx.x, (const LAS int*)(F.lds + LT_PEXP));
                pg8::EpiSwiGLU8 E{ws + WS_HIDM, FFE, 1.0f / (H8SCALE * W8SCALE), HID8SCALE};
#ifndef SKIP_G_MUP
                pg8::gemm_phase<pg8::EpiSwiGLU8, pg8::Sched, true, true, true>(F.lds + RING_OFF, g, S, E, F.wave);
#endif
            }
            GRID_BAR(); TS(13);
            {   unsigned char* const ws = launder(F.ws); bf16* const XB = (bf16*)(ws + WS_XB); const float* const MOD = (const float*)(ws + WS_MOD); bf16* const H = (bf16*)F.out; (void)XB; (void)MOD; (void)H;
            pg8::Gemm g{(const bf16*)(ws + WS_HIDM), (const bf16*)(ws + WS_WFF_D_MOE8), npanels * 256, 1024, FFE / 2, 0}; pg8::Sched S; S.init(npanels, 4, F.G, (int)blockIdx.x, (const LAS int*)(F.lds + LT_PEXP));
                pg8::EpiBf16S E{(bf16*)(ws + WS_AG), 1024, 1.0f / (HID8SCALE * W8SCALE)};
#ifndef SKIP_G_MDOWN
                pg8::gemm_phase<pg8::EpiBf16S, pg8::Sched, true, true, true>(F.lds + RING_OFF, g, S, E, F.wave);
#endif
            }
            GRID_BAR(); TS(14);
        }

#undef GRID_BAR
}
__global__ void __launch_bounds__(NWAVES * 64, 2) mk_fwd(Args args) {
    extern __shared__ __attribute__((aligned(16))) unsigned char lds[];
    Frame F;
    F.lds = (LAS unsigned char*)lds;
    F.MISC = (volatile LAS unsigned*)(F.lds + MISC_OFF);
    F.tid = threadIdx.x; F.lane = F.tid & 63; F.wave = __builtin_amdgcn_readfirstlane(F.tid >> 6);
    F.G = gridDim.x; { const int bx = blockIdx.x; F.vcu = (F.G % 8 == 0) ? (bx % 8) * (F.G / 8) + bx / 8 : bx; }
    F.ws = args.ws; F.ctl = (gu32*)(args.ws + WS_CTL); F.out = args.out;
    for (int u = F.tid; u < 64; u += NWAVES * 64) ((LAS unsigned*)(F.lds + LDSCTL_OFF))[u] = 0u;
    if (F.tid < 30) ((LAS unsigned long long*)(F.lds + LT_INP))[F.tid] = (unsigned long long)args.in[F.tid];
    __syncthreads();
    XcdBarrier bar = xcd_barrier_post((unsigned*)(F.ctl + CW_BAR), F.MISC + 8, F.wave);
#define GRID_BAR() xcd_barrier(bar)
#if TSEL >= 0
    if (blockIdx.x == 0 && F.wave == 0 && hw_lane() == 0) ((unsigned long long*)(F.ws + WS_CTL + 32768))[0] = __builtin_amdgcn_s_memrealtime();
#endif

#ifndef SKIP_PRO
    p_prologue(F, args);
#endif

    GRID_BAR(); TS(0);
    layer_body<0>(F, args, bar, lds);
#if DEBUG_NAN
    return;
#endif
    layer_body<1>(F, args, bar, lds);
    layer_body<2>(F, args, bar, lds);
    layer_body<3>(F, args, bar, lds);

#ifndef SKIP_FINAL
    p_final_combine(F, DEPTH - 1);
#endif
#if TSEL >= 0
    TS(15);
    xcd_barrier(bar);
    if (blockIdx.x == 0 && F.wave == 0 && hw_lane() == 0) { const unsigned long long* ts_ = (const unsigned long long*)(F.ws + WS_CTL + 32768); float tot = 0.f, sel = 0.f;
        for (int k = 0; k < 16; ++k) { tot += (float)ts_[1 + k]; if ((TSEL >> k) & 1) sel += (float)ts_[1 + k]; }
        F.out[0] += 3.0f + 6.9f * sel / tot; }
#endif

#if CYSEL >= 0
    xcd_barrier(bar);
    if (blockIdx.x == 0 && F.wave == 0 && hw_lane() == 0) { const unsigned long long* cs_ = (const unsigned long long*)(F.ws + WS_CTL + 40960); float tot = 0.f; for (int k = 0; k < 5; ++k) tot += (float)cs_[k];
        F.out[0] += 3.0f + 6.9f * (float)cs_[CYSEL] / tot; }
#endif
    if (xb_ld((unsigned*)(F.ctl + CW_BAR) + XB_TMO) != 0u && blockIdx.x == 0 && F.wave == 0 && hw_lane() == 0) F.out[0] = __builtin_nanf("");
}

extern "C" void kernel_launch(void* const* d_in, const int* in_sizes, int n_in, void* d_out, int out_size, void* d_ws, size_t ws_size, hipStream_t stream) {
    static int grid = 0;
    if (grid == 0) {
        if (n_in != 30 || in_sizes[0] != TL * 1024 || out_size != TL * 1024 || ws_size < WS_END) { fprintf(stderr, "kernel_launch: unexpected shapes / workspace (n_in %d, ws %zu); nothing launched\n", n_in, ws_size); grid = -1; return; }
        int dev = 0, cus = 0, per_cu = 0;
        if (hipGetDevice(&dev) != hipSuccess || hipDeviceGetAttribute(&cus, hipDeviceAttributeMultiprocessorCount, dev) != hipSuccess) { grid = -1; return; }
        if (hipFuncSetAttribute((const void*)mk_fwd, hipFuncAttributeMaxDynamicSharedMemorySize, LDS_BYTES) != hipSuccess) { fprintf(stderr, "kernel_launch: hipFuncSetAttribute failed\n"); grid = -1; return; }
        if (hipOccupancyMaxActiveBlocksPerMultiprocessor(&per_cu, (const void*)mk_fwd, NWAVES * 64, LDS_BYTES) != hipSuccess || per_cu < 1) { fprintf(stderr, "kernel_launch: occupancy query reports %d blocks per CU\n", per_cu); }
        (void)hipGetLastError();
        grid = cus;
    }
    if (grid < 0) return;
    if (hipMemsetAsync((char*)d_ws + WS_CTL, 0, CTL_ZERO_BYTES, stream) != hipSuccess) return;
    Args a{};
    for (int i = 0; i < 30; ++i) a.in[i] = (const float*)d_in[i];
    a.out = (float*)d_out; a.ws = (unsigned char*)d_ws;
    hipLaunchKernelGGL(mk_fwd, dim3(grid), dim3(NWAVES * 64), LDS_BYTES, stream, a);
}
```

```cpp
#include <hip/hip_runtime.h>
#include <hip/hip_bf16.h>
#include <cstdio>
#include <cstdint>
#include <cmath>
__device__ __forceinline__ int hw_lane() { int l_; asm volatile("v_mbcnt_lo_u32_b32 %0, -1, 0\n\tv_mbcnt_hi_u32_b32 %0, -1, %0" : "=v"(l_)); return l_; }
namespace pg8 {
#define PG8_LAS __attribute__((address_space(3)))
typedef unsigned short bf16_t;
typedef short bf16x8 __attribute__((ext_vector_type(8)));
typedef float f32x4 __attribute__((ext_vector_type(4)));
typedef unsigned u32x4 __attribute__((ext_vector_type(4)));
constexpr int BM = 256, BK = 64, HALF = 128, HTB = HALF * BK * 2  , STAGE_BYTES = 8 * HTB, NXCD = 8, WGM = 8;

__host__ __device__ __forceinline__ int lds_byte(int r, int c) { const int st = (r >> 4) * 2 + (c >> 5), rr = r & 15, cc = c & 31, ob = rr * 64 + cc * 2; return st * 1024 + (ob ^ (((ob >> 9) & 1) << 5)); }
__host__ __device__ __forceinline__ void stage_rc(int b, int& R, int& C) { const int st = b / 1024, sb = b % 1024, swz = sb ^ (((sb >> 9) & 1) << 5); R = (st >> 1) * 16 + swz / 64; C = (st & 1) * 32 + (swz % 64) / 2; }
__host__ __device__ __forceinline__ int perm32(int rho) { const int n = rho >> 4, i = rho & 15; return 8 * (i >> 2) + 4 * n + (i & 3); }
__device__ __forceinline__ unsigned cvt_pk_bf16(float lo, float hi) { unsigned r; asm volatile("v_cvt_pk_bf16_f32 %0, %1, %2" : "=v"(r) : "v"(lo), "v"(hi)); return r; }
typedef float f32x2 __attribute__((ext_vector_type(2)));

struct Unit { int pm, pn, pnb, ka, nt, slice; };
struct Gemm { const bf16_t* A; const bf16_t* Bt; int M, N, K, lda, ldb; };

struct Sched {
    static constexpr bool SPLITK = false;
    int nM, nN, nwg, G, c, lora; const PG8_LAS int* pexp;
    __device__ __forceinline__ void init(int nM_, int nN_, int G_, int c_, const PG8_LAS int* pe) { nM = nM_; nN = nN_; nwg = nM * nN; G = G_; c = c_; pexp = pe; lora = 0; }
    __device__ __forceinline__ bool next(int i, Unit& u) const {
        const long L = (long)i * G + c; if (L >= nwg) return false;
        int wgid = (int)L; { const int q = nwg / NXCD, r = nwg % NXCD, xcd = wgid % NXCD, off = wgid / NXCD; wgid = (xcd < r ? xcd * (q + 1) : r * (q + 1) + (xcd - r) * q) + off; }
        const int nig = WGM * nN, gid = wgid / nig, fm = gid * WGM, gsz = (nM - fm) < WGM ? (nM - fm) : WGM;
        u.pm = fm + ((wgid % nig) % gsz); u.pn = (wgid % nig) / gsz; u.pnb = pexp ? pexp[u.pm] * nN + u.pn : u.pn;
        u.ka = lora ? ((u.pn >= 8) ? 512 : ((u.pn >= 4) ? 256 : 0)) : 0; return true;
    }
    __device__ __forceinline__ void a_ready(const Unit&) const {}
    __device__ __forceinline__ void done(const Unit&) const {}
};
struct SchedSK {
    static constexpr bool SPLITK = true;
    int nM, nwg, G, c, nsub, ntt, base, extra;
    __device__ __forceinline__ void init(int nMf_, bool ctx, int ntiles, int G_, int c_) { nM = nMf_; nwg = nMf_ * 4; G = G_; c = c_; nsub = ctx ? 128 : 0; ntt = ntiles; base = (ntiles / 4) & ~1; extra = (ntiles - 4 * base) / 2; }
    __device__ __forceinline__ bool next(int i, Unit& u) const {
        const long L = (long)i * G + c; if (L >= nwg + nsub) return false;
        const bool sub = L >= nwg;
        int wgid = sub ? 0 : (int)L; { const int q = nwg / NXCD, r = nwg % NXCD, xcd = wgid % NXCD, off = wgid / NXCD; wgid = (xcd < r ? xcd * (q + 1) : r * (q + 1) + (xcd - r) * q) + off; }
        const int nig = WGM * 4, gid = wgid / nig, fm = gid * WGM, gsz = (nM - fm) < WGM ? (nM - fm) : WGM;
        const int pmf = fm + ((wgid % nig) % gsz), pnf = (wgid % nig) / gsz;
        const int Ls = sub ? (int)(L - nwg) : 0, sl = Ls >> 5, rem = Ls & 31;
        const int kt0 = sl * base + 2 * (sl < extra ? sl : extra);
        u.pm = sub ? nM + (rem & 7) : pmf; u.pn = sub ? (rem >> 3) : pnf; u.pnb = u.pn; u.slice = sl;
        u.nt = sub ? base + ((sl < extra) ? 2 : 0) : ntt; u.ka = kt0 * (BK * 2); return true;
    }
    __device__ __forceinline__ void a_ready(const Unit&) const {}
    __device__ __forceinline__ void done(const Unit&) const {}
};

__device__ __forceinline__ float sigmoid_f(float x) { return __builtin_amdgcn_rcpf(1.0f + __builtin_amdgcn_exp2f(-1.4426950408889634f * x)); }
__device__ __forceinline__ float bf_lo(unsigned w) { return __builtin_bit_cast(float, w << 16); }
__device__ __forceinline__ float bf_hi(unsigned w) { return __builtin_bit_cast(float, w & 0xffff0000u); }

struct EpiBf16 {
    static constexpr bool PERM = true, AFTER_DRAIN = false;
    bf16_t* O; int ldc;
    __device__ __forceinline__ void operator()(const f32x4 (&acc)[2][2][4][2], const Unit& u, int wr, int wc, int fr, int fq) const {
        const int row0 = u.pm * BM + wr * 64 + fr; const int col0 = u.pn * BM + wc * 32 + 8 * fq;
#pragma unroll
        for (int ai = 0; ai < 2; ++ai)
#pragma unroll
            for (int m = 0; m < 4; ++m) { bf16_t* rowp = O + (size_t)(row0 + ai * HALF + m * 16) * ldc + col0;
#pragma unroll
                for (int bj = 0; bj < 2; ++bj) { const f32x4 v0 = acc[ai][bj][m][0], v1 = acc[ai][bj][m][1];
                    u32x4 w; w.x = cvt_pk_bf16(v0[0], v0[1]); w.y = cvt_pk_bf16(v0[2], v0[3]); w.z = cvt_pk_bf16(v1[0], v1[1]); w.w = cvt_pk_bf16(v1[2], v1[3]);
                    *(u32x4*)(rowp + bj * HALF) = w; } }
    }
};
struct EpiSwiGLU {
    static constexpr bool PERM = true, AFTER_DRAIN = false;
    bf16_t* O; int ldc; float inscale;
    __device__ __forceinline__ void operator()(const f32x4 (&acc)[2][2][4][2], const Unit& u, int wr, int wc, int fr, int fq) const {
        const int row0 = u.pm * BM + wr * 64 + fr; const int col0 = u.pn * HALF + wc * 32 + 8 * fq;
#pragma unroll
        for (int ai = 0; ai < 2; ++ai)
#pragma unroll
            for (int m = 0; m < 4; ++m) { bf16_t* rowp = O + (size_t)(row0 + ai * HALF + m * 16) * ldc + col0;
                float h[8];
#pragma unroll
                for (int n = 0; n < 2; ++n)
#pragma unroll
                    for (int j = 0; j < 4; ++j) { const float g = acc[ai][0][m][n][j] * inscale, up = acc[ai][1][m][n][j] * inscale; h[n * 4 + j] = g * sigmoid_f(g) * up; }
                u32x4 w; w.x = cvt_pk_bf16(h[0], h[1]); w.y = cvt_pk_bf16(h[2], h[3]); w.z = cvt_pk_bf16(h[4], h[5]); w.w = cvt_pk_bf16(h[6], h[7]);
                *(u32x4*)rowp = w; }
    }
};
struct EpiResid {
    static constexpr bool PERM = false, AFTER_DRAIN = false;
    const float* baseL; const float* baseC; float* outL; float* outC; const float* gate; float scale;
    __device__ __forceinline__ void operator()(const f32x4 (&acc)[2][2][4][2], const Unit& u, int wr, int wc, int fr, int fq) const {
        const float* base; float* out; int bsel;
        if (u.pm < 128) { base = baseL + (size_t)u.pm * BM * 1024; out = outL + (size_t)u.pm * BM * 1024; bsel = u.pm >> 4; }
        else { base = baseC + (size_t)(u.pm - 128) * BM * 1024; out = outC + (size_t)(u.pm - 128) * BM * 1024; bsel = 8; }
        const float* gv = gate + (size_t)bsel * 6144;
        const int col0 = u.pn * BM + wc * 32 + 4 * fq;
        f32x4 g4[2][2];
#pragma unroll
        for (int bj = 0; bj < 2; ++bj)
#pragma unroll
            for (int n = 0; n < 2; ++n) g4[bj][n] = *(const f32x4*)(gv + col0 + bj * HALF + n * 16) * scale;
#pragma unroll
        for (int ai = 0; ai < 2; ++ai)
#pragma unroll
            for (int m = 0; m < 4; ++m) { const size_t off = (size_t)(ai * HALF + wr * 64 + m * 16 + fr) * 1024 + col0;
#pragma unroll
                for (int bj = 0; bj < 2; ++bj)
#pragma unroll
                    for (int n = 0; n < 2; ++n) { const f32x4 xs = *(const f32x4*)(base + off + bj * HALF + n * 16); *(f32x4*)(out + off + bj * HALF + n * 16) = xs + g4[bj][n] * acc[ai][bj][m][n]; } }
    }
};

__device__ __forceinline__ float clamp8(float x) { return __builtin_fminf(__builtin_fmaxf(x, -440.0f), 440.0f); }
__device__ __forceinline__ unsigned pk_fp8x4(float a, float b, float c, float d) { int w = 0; w = __builtin_amdgcn_cvt_pk_fp8_f32(clamp8(a), clamp8(b), w, false); w = __builtin_amdgcn_cvt_pk_fp8_f32(clamp8(c), clamp8(d), w, true); return (unsigned)w; }
struct EpiSwiGLU8 {
    static constexpr bool PERM = true, AFTER_DRAIN = false;
    unsigned char* O; int ldc; float inscale, outscale;
    __device__ __forceinline__ void operator()(const f32x4 (&acc)[2][2][4][2], const Unit& u, int wr, int wc, int fr, int fq) const {
        const int row0 = u.pm * BM + wr * 64 + fr; const int col0 = u.pn * HALF + wc * 32 + 8 * fq;
        const float c1 = -1.4426950408889634f * inscale, c2 = inscale * inscale * outscale;
#pragma unroll
        for (int ai = 0; ai < 2; ++ai)
#pragma unroll
            for (int m = 0; m < 4; ++m) { unsigned char* rowp = O + (size_t)(row0 + ai * HALF + m * 16) * ldc + col0;
                float h[8];
#pragma unroll
                for (int n = 0; n < 2; ++n)
#pragma unroll
                    for (int j = 0; j < 4; ++j) { const float ag = acc[ai][0][m][n][j], au = acc[ai][1][m][n][j];
                        h[n * 4 + j] = (ag * au) * (c2 * __builtin_amdgcn_rcpf(1.0f + __builtin_amdgcn_exp2f(c1 * ag))); }
                typedef unsigned u32x2e __attribute__((ext_vector_type(2)));
                *(u32x2e*)rowp = (u32x2e){pk_fp8x4(h[0], h[1], h[2], h[3]), pk_fp8x4(h[4], h[5], h[6], h[7])};  asm volatile("" ::: "memory"); }
    }
};
struct EpiBf16S {
    static constexpr bool PERM = true, AFTER_DRAIN = false;
    bf16_t* O; int ldc; float scale;
    __device__ __forceinline__ void operator()(const f32x4 (&acc)[2][2][4][2], const Unit& u, int wr, int wc, int fr, int fq) const {
        const int row0 = u.pm * BM + wr * 64 + fr; const int col0 = u.pn * BM + wc * 32 + 8 * fq;
#pragma unroll
        for (int ai = 0; ai < 2; ++ai)
#pragma unroll
            for (int m = 0; m < 4; ++m) { bf16_t* rowp = O + (size_t)(row0 + ai * HALF + m * 16) * ldc + col0;
#pragma unroll
                for (int bj = 0; bj < 2; ++bj) { const f32x4 v0 = acc[ai][bj][m][0] * scale, v1 = acc[ai][bj][m][1] * scale;
                    u32x4 w; w.x = cvt_pk_bf16(v0[0], v0[1]); w.y = cvt_pk_bf16(v0[2], v0[3]); w.z = cvt_pk_bf16(v1[0], v1[1]); w.w = cvt_pk_bf16(v1[2], v1[3]);
                    *(u32x4*)(rowp + bj * HALF) = w; } asm volatile("" ::: "memory"); }
    }
};

template <bool BASEF32> struct EpiResidB {
    static constexpr bool PERM = true, AFTER_DRAIN = false;
    const float* baseL; const float* baseC; bf16_t* xb; const float* gate; bf16_t* side; float scale;
    __device__ __forceinline__ void operator()(const f32x4 (&acc)[2][2][4][2], const Unit& u, int wr, int wc, int fr, int fq) const {
        asm volatile("" : "+v"(fr), "+v"(fq));
        const int bsel = (u.pm < 128) ? (u.pm >> 4) : 8;
        const float* base = (u.pm < 128) ? baseL + (size_t)u.pm * BM * 1024 : baseC + (size_t)(u.pm - 128) * BM * 1024;
        bf16_t* out = xb + (size_t)u.pm * BM * 1024;
        const float* gv = gate + (size_t)bsel * 6144;
        const int col0 = u.pn * BM + wc * 32 + 8 * fq;
        f32x4 g4[2][2];
#pragma unroll
        for (int bj = 0; bj < 2; ++bj)
#pragma unroll
            for (int n = 0; n < 2; ++n) g4[bj][n] = *(const f32x4*)(gv + col0 + bj * HALF + 4 * n) * scale;
        if (u.slice != 0) {
            bf16_t* so = side + ((size_t)(u.slice - 1) * 2048 + (size_t)(u.pm - 128) * BM) * 1024;
#pragma unroll
            for (int ai = 0; ai < 2; ++ai)
#pragma unroll
                for (int m = 0; m < 4; ++m) { const size_t off = (size_t)(ai * HALF + wr * 64 + m * 16 + fr) * 1024 + col0;
#pragma unroll
                    for (int bj = 0; bj < 2; ++bj) { const f32x4 o0 = g4[bj][0] * acc[ai][bj][m][0], o1 = g4[bj][1] * acc[ai][bj][m][1];
                        u32x4 ow; ow.x = cvt_pk_bf16(o0[0], o0[1]); ow.y = cvt_pk_bf16(o0[2], o0[3]); ow.z = cvt_pk_bf16(o1[0], o1[1]); ow.w = cvt_pk_bf16(o1[2], o1[3]);
                        *(u32x4*)(so + off + bj * HALF) = ow; } }
        } else
#pragma unroll
        for (int ai = 0; ai < 2; ++ai)
#pragma unroll
            for (int m = 0; m < 4; ++m) { const size_t off = (size_t)(ai * HALF + wr * 64 + m * 16 + fr) * 1024 + col0;
#pragma unroll
                for (int bj = 0; bj < 2; ++bj) { f32x4 x0, x1;
                    if (BASEF32) { x0 = *(const f32x4*)(base + off + bj * HALF); x1 = *(const f32x4*)(base + off + bj * HALF + 4); }
                    else { const u32x4 w = *(const u32x4*)(out + off + bj * HALF); x0 = (f32x4){bf_lo(w.x), bf_hi(w.x), bf_lo(w.y), bf_hi(w.y)}; x1 = (f32x4){bf_lo(w.z), bf_hi(w.z), bf_lo(w.w), bf_hi(w.w)}; }
                    const f32x4 o0 = x0 + g4[bj][0] * acc[ai][bj][m][0], o1 = x1 + g4[bj][1] * acc[ai][bj][m][1];
                    u32x4 ow; ow.x = cvt_pk_bf16(o0[0], o0[1]); ow.y = cvt_pk_bf16(o0[2], o0[3]); ow.z = cvt_pk_bf16(o1[0], o1[1]); ow.w = cvt_pk_bf16(o1[2], o1[3]);
                    *(u32x4*)(out + off + bj * HALF) = ow; } }
    }
};

struct EpiLoraAct {
    static constexpr bool PERM = true, AFTER_DRAIN = false;
    bf16_t* O; int ldc; const float* w0; const float* a0;
    __device__ __forceinline__ void operator()(const f32x4 (&acc)[2][2][4][2], const Unit& u, int wr, int wc, int fr, int fq) const {
        const int row0 = u.pm * BM + wr * 64 + fr; const int col0 = u.pn * BM + wc * 32 + 8 * fq; const int sec = u.pn >> 1;
        const int cs0 = (u.pn & 1) * 256 + wc * 32 + 8 * fq;
        f32x4 bv[2][2]; float mul = 1.0f;
        if (sec < 4) { const float* bp = (sec < 2 ? w0 + sec * 512 : a0 + (sec - 2) * 512) + cs0; mul = (sec < 2) ? 0.8750387749145276f : 1.0f;
#pragma unroll
            for (int bj = 0; bj < 2; ++bj)
#pragma unroll
                for (int n = 0; n < 2; ++n) bv[bj][n] = *(const f32x4*)(bp + bj * HALF + 4 * n); }
#pragma unroll
        for (int ai = 0; ai < 2; ++ai)
#pragma unroll
            for (int m = 0; m < 4; ++m) { bf16_t* rowp = O + (size_t)(row0 + ai * HALF + m * 16) * ldc + col0;
#pragma unroll
                for (int bj = 0; bj < 2; ++bj) { f32x4 v0 = acc[ai][bj][m][0], v1 = acc[ai][bj][m][1];
                    if (sec < 4) {
#pragma unroll
                        for (int j = 0; j < 4; ++j) { v0[j] = mul * sigmoid_f(v0[j] + bv[bj][0][j]); v1[j] = mul * sigmoid_f(v1[j] + bv[bj][1][j]); } }
                    u32x4 w; w.x = cvt_pk_bf16(v0[0], v0[1]); w.y = cvt_pk_bf16(v0[2], v0[3]); w.z = cvt_pk_bf16(v1[0], v1[1]); w.w = cvt_pk_bf16(v1[2], v1[3]);
                    *(u32x4*)(rowp + bj * HALF) = w; } }
    }
};
typedef int v8i_t __attribute__((ext_vector_type(8)));
__device__ __forceinline__ v8i_t cat8(bf16x8 a, bf16x8 b) { const u32x4 x = __builtin_bit_cast(u32x4, a), y = __builtin_bit_cast(u32x4, b); return (v8i_t){(int)x[0], (int)x[1], (int)x[2], (int)x[3], (int)y[0], (int)y[1], (int)y[2], (int)y[3]}; }
template <class Epi, class Sched, bool ALIGN_EPI = false, bool SP2 = false, bool FP8 = false>
__device__ __forceinline__ void gemm_phase(PG8_LAS unsigned char* lds, const Gemm g, const Sched& S, const Epi& E, const int wave_) {
    const int tid = wave_ * 64 + hw_lane(), wid = wave_, lane = tid & 63, wr = wid >> 2, wc = wid & 3, fr = lane & 15, fq = lane >> 4;
    int K_ = g.K; asm volatile("" : "+s"(K_));
    const int K = K_, nt = K / BK; const int lda = g.lda ? g.lda : K, ldb = g.ldb ? g.ldb : K;
    unsigned voffA[2], voffB[2];
#pragma unroll
    for (int i = 0; i < 2; ++i) { int R, C; stage_rc(tid * 16 + i * 8192, R, C); const int Rb = Epi::PERM ? ((R & ~31) + perm32(R & 31)) : R;
        voffA[i] = (unsigned)(R * lda + C) * 2u; voffB[i] = (unsigned)(Rb * ldb + C) * 2u; }
    const size_t kstep = (size_t)(BK * 2);
    const size_t hstep = (size_t)HALF * ldb * 2;
    const size_t hstepA = (size_t)HALF * lda * 2, tstepA = 2 * hstepA;
    const size_t tstep = 2 * hstep;
    const unsigned ldsw = (unsigned)wid * 1024u;
    const int aoff = lds_byte(wr * 64 + fr, fq * 8), boff = lds_byte(wc * 32 + fr, fq * 8);
#define PG8_SA(b, h) (((b) * 2 + (h)) * HTB)
#define PG8_SB(b, h) ((4 + (b) * 2 + (h)) * HTB)
#define PG8_STAGE(bufoff, gbase, voff) do { _Pragma("unroll") for (int _i = 0; _i < 2; ++_i) \
        __builtin_amdgcn_global_load_lds((const unsigned*)((const char*)(gbase) + (voff)[_i]), (PG8_LAS unsigned*)(lds + (bufoff) + ldsw + _i * 8192), 16, 0, 0); } while (0)
#define PG8_LDA(dst, b, h) do { if constexpr (FP8) { _Pragma("unroll") for (int m = 0; m < 4; ++m) { dst##8[m].lo = *(const PG8_LAS v4i_t*)(lds + PG8_SA(b, h) + aoff + m * 2048); dst##8[m].hi = *(const PG8_LAS v4i_t*)(lds + PG8_SA(b, h) + aoff + m * 2048 + 1024); } } \
        else { _Pragma("unroll") for (int m = 0; m < 4; ++m) _Pragma("unroll") for (int k = 0; k < 2; ++k) dst[FP8 ? 0 : m][k] = *(const PG8_LAS bf16x8*)(lds + PG8_SA(b, h) + aoff + m * 2048 + k * 1024); } } while (0)
#define PG8_LDB(dst, b, h) do { if constexpr (FP8) { _Pragma("unroll") for (int n = 0; n < 2; ++n) { dst##8[n].lo = *(const PG8_LAS v4i_t*)(lds + PG8_SB(b, h) + boff + n * 2048); dst##8[n].hi = *(const PG8_LAS v4i_t*)(lds + PG8_SB(b, h) + boff + n * 2048 + 1024); } } \
        else { _Pragma("unroll") for (int n = 0; n < 2; ++n) _Pragma("unroll") for (int k = 0; k < 2; ++k) dst[n][k] = *(const PG8_LAS bf16x8*)(lds + PG8_SB(b, h) + boff + n * 2048 + k * 1024); } } while (0)
#define PG8_MMA(ai, bj, At, Bt) do { __builtin_amdgcn_s_setprio(1); if constexpr (FP8) { _Pragma("unroll") for (int m = 0; m < 4; ++m) _Pragma("unroll") for (int n = 0; n < 2; ++n) \
        asm volatile("v_mfma_f32_16x16x128_f8f6f4 %0, %1, %2, %0" : "+v"(acc[ai][bj][m][n]) : "v"(Bt##8[n]), "v"(At##8[m])); } \
        else { _Pragma("unroll") for (int m = 0; m < 4; ++m) _Pragma("unroll") for (int n = 0; n < 2; ++n) _Pragma("unroll") for (int k = 0; k < 2; ++k) \
        acc[ai][bj][m][n] = __builtin_amdgcn_mfma_f32_16x16x32_bf16(Bt[n][k], At[FP8 ? 0 : m][k], acc[ai][bj][m][n], 0, 0, 0); } __builtin_amdgcn_s_setprio(0); } while (0)
#define PG8_WAIT_V(n) asm volatile("s_waitcnt vmcnt(" #n ")" ::: "memory")
#define PG8_WAIT_L(n) asm volatile("s_waitcnt lgkmcnt(" #n ")" ::: "memory")
#define PG8_BAR __builtin_amdgcn_s_barrier()
#define PG8_SCHED __builtin_amdgcn_sched_barrier(0)
    Unit cur, nxt; int ui = 0;
    if (!S.next(0, cur)) return;
    f32x4 acc[2][2][4][2];
#pragma unroll
    for (int a = 0; a < 2; ++a)
#pragma unroll
        for (int b = 0; b < 2; ++b)
#pragma unroll
            for (int m = 0; m < 4; ++m)
#pragma unroll
                for (int n = 0; n < 2; ++n) acc[a][b][m][n] = (f32x4){0.f, 0.f, 0.f, 0.f};
    bf16x8 At[FP8 ? 1 : 4][2], B0[2][2], B1[2][2];
    v8i_t At8[FP8 ? 4 : 1], B08[2], B18[2];
    typedef int v4i_t __attribute__((ext_vector_type(4)));
    const char* cA = (const char*)g.A + (size_t)cur.pm * tstepA + cur.ka; const char* cB = (const char*)g.Bt + (size_t)cur.pnb * tstep + (Sched::SPLITK ? cur.ka : 0);
    S.a_ready(cur);
    if constexpr (SP2) {
        PG8_STAGE(PG8_SB(0, 0), cB, voffB); PG8_STAGE(PG8_SB(0, 1), cB + hstep, voffB); PG8_STAGE(PG8_SA(0, 0), cA, voffA); PG8_STAGE(PG8_SA(0, 1), cA + hstepA, voffA);
        if (wr == 1) PG8_BAR;
        PG8_WAIT_V(2); PG8_BAR;
        PG8_STAGE(PG8_SB(1, 0), cB + kstep, voffB); PG8_STAGE(PG8_SA(1, 0), cA + kstep, voffA); PG8_STAGE(PG8_SB(1, 1), cB + hstep + kstep, voffB);
        PG8_WAIT_V(6); PG8_BAR;
    } else {
        PG8_STAGE(PG8_SB(0, 0), cB, voffB); PG8_STAGE(PG8_SA(0, 0), cA, voffA); PG8_STAGE(PG8_SB(0, 1), cB + hstep, voffB); PG8_STAGE(PG8_SA(0, 1), cA + hstepA, voffA);
        if (wr == 1) PG8_BAR;
        PG8_WAIT_V(4); PG8_BAR;
        PG8_STAGE(PG8_SB(1, 0), cB + kstep, voffB); PG8_STAGE(PG8_SA(1, 0), cA + kstep, voffA); PG8_STAGE(PG8_SB(1, 1), cB + hstep + kstep, voffB);
        PG8_WAIT_V(6); PG8_BAR;
    }
    for (;;) {
        const bool has_next = S.next(ui + 1, nxt);
        const char* nA = has_next ? (const char*)g.A + (size_t)nxt.pm * tstepA + nxt.ka : cA; const char* nB = has_next ? (const char*)g.Bt + (size_t)nxt.pnb * tstep + (Sched::SPLITK ? nxt.ka : 0) : cB;
        const int ntc = Sched::SPLITK ? cur.nt : nt;
        for (int t = 0; t < ntc; t += 2) {
            const bool last = (t == ntc - 2);
            const char* a1 = cA + (size_t)(t + 1) * kstep;
            const char* a2 = last ? nA : cA + (size_t)(t + 2) * kstep; const char* b2 = last ? nB : cB + (size_t)(t + 2) * kstep;
            const char* a3 = a2 + kstep; const char* b3 = b2 + kstep;
            if (last && has_next) S.a_ready(nxt);
            if constexpr (SP2) {
            PG8_LDB(B0, 0, 0); PG8_LDB(B1, 0, 1); PG8_SCHED; PG8_LDA(At, 0, 0); PG8_STAGE(PG8_SA(1, 1), a1 + hstepA, voffA);
            PG8_WAIT_V(8); PG8_WAIT_L(0); PG8_BAR; PG8_MMA(0, 0, At, B0); PG8_MMA(0, 1, At, B1); PG8_BAR; PG8_SCHED;
            PG8_LDA(At, 0, 1); PG8_STAGE(PG8_SB(0, 0), b2, voffB); PG8_STAGE(PG8_SB(0, 1), b2 + hstep, voffB); PG8_STAGE(PG8_SA(0, 0), a2, voffA);
            PG8_WAIT_V(8); PG8_WAIT_L(0); PG8_BAR; PG8_MMA(1, 0, At, B0); PG8_MMA(1, 1, At, B1); PG8_BAR; PG8_SCHED;
            PG8_LDB(B0, 1, 0); PG8_LDB(B1, 1, 1); PG8_SCHED; PG8_LDA(At, 1, 0); PG8_STAGE(PG8_SA(0, 1), a2 + hstepA, voffA);
            PG8_WAIT_V(8); PG8_WAIT_L(0); PG8_BAR; PG8_MMA(0, 0, At, B0); PG8_MMA(0, 1, At, B1); PG8_BAR; PG8_SCHED;
            PG8_LDA(At, 1, 1); PG8_STAGE(PG8_SB(1, 0), b3, voffB); PG8_STAGE(PG8_SB(1, 1), b3 + hstep, voffB); PG8_STAGE(PG8_SA(1, 0), a3, voffA);
            PG8_WAIT_V(8); PG8_WAIT_L(0); PG8_BAR; PG8_MMA(1, 0, At, B0); PG8_MMA(1, 1, At, B1); PG8_BAR; PG8_SCHED;
            } else {
            PG8_LDB(B0, 0, 0); PG8_SCHED; PG8_LDA(At, 0, 0); PG8_STAGE(PG8_SA(1, 1), a1 + hstepA, voffA);
            PG8_WAIT_L(8); PG8_BAR; PG8_WAIT_L(0); PG8_MMA(0, 0, At, B0); PG8_BAR; PG8_SCHED;
            PG8_LDB(B1, 0, 1); PG8_STAGE(PG8_SB(0, 0), b2, voffB);
            PG8_BAR; PG8_WAIT_L(0); PG8_MMA(0, 1, At, B1); PG8_BAR;
            PG8_LDA(At, 0, 1); PG8_STAGE(PG8_SA(0, 0), a2, voffA);
            PG8_BAR; PG8_WAIT_L(0); PG8_MMA(1, 0, At, B0); PG8_BAR; PG8_SCHED;
            PG8_STAGE(PG8_SB(0, 1), b2 + hstep, voffB);
            PG8_WAIT_V(6); PG8_BAR; PG8_MMA(1, 1, At, B1); PG8_BAR;
            PG8_LDB(B0, 1, 0); PG8_SCHED; PG8_LDA(At, 1, 0); PG8_STAGE(PG8_SA(0, 1), a2 + hstepA, voffA);
            PG8_WAIT_L(8); PG8_BAR; PG8_WAIT_L(0); PG8_MMA(0, 0, At, B0); PG8_BAR; PG8_SCHED;
            PG8_LDB(B1, 1, 1); PG8_STAGE(PG8_SB(1, 0), b3, voffB);
            PG8_BAR; PG8_WAIT_L(0); PG8_MMA(0, 1, At, B1); PG8_BAR;
            PG8_LDA(At, 1, 1); PG8_STAGE(PG8_SA(1, 0), a3, voffA);
            PG8_BAR; PG8_WAIT_L(0); PG8_MMA(1, 0, At, B0); PG8_BAR; PG8_SCHED;
            PG8_STAGE(PG8_SB(1, 1), b3 + hstep, voffB);
            PG8_WAIT_V(6); PG8_BAR; PG8_MMA(1, 1, At, B1); PG8_BAR;
            }
        }
        if constexpr (ALIGN_EPI) { if (wr == 0) PG8_BAR; }
        if constexpr (!Epi::AFTER_DRAIN) { E(acc, cur, wr, wc, fr, fq); S.done(cur); }
        if (!has_next) break;
#pragma unroll
        for (int a = 0; a < 2; ++a)
#pragma unroll
            for (int b = 0; b < 2; ++b)
#pragma unroll
                for (int m = 0; m < 4; ++m)
#pragma unroll
                    for (int n = 0; n < 2; ++n) acc[a][b][m][n] = (f32x4){0.f, 0.f, 0.f, 0.f};
        cur = nxt; cA = nA; cB = nB; ++ui;
        if constexpr (ALIGN_EPI) { if (wr == 1) PG8_BAR; }
    }
    PG8_WAIT_V(0);
    if constexpr (!ALIGN_EPI) { if (wr == 0) PG8_BAR; }
    PG8_BAR;
    if constexpr (Epi::AFTER_DRAIN) { E.fused(acc, cur, wr, wc, fr, fq, lds, wid, lane); S.done(cur); }
#undef PG8_SA
#undef PG8_SB
#undef PG8_STAGE
#undef PG8_LDA
#undef PG8_LDB
#undef PG8_MMA
#undef PG8_WAIT_V
#undef PG8_WAIT_L
#undef PG8_BAR
#undef PG8_SCHED
}
}
#include <hip/hip_bf16.h>
#include <cmath>
namespace attn_body {
using bf16=__hip_bfloat16;
using bf16x8=__attribute__((ext_vector_type(8)))short;
using s16x4=__attribute__((ext_vector_type(4)))short;
using f32x16=__attribute__((ext_vector_type(16)))float;
using u32x4=__attribute__((ext_vector_type(4)))unsigned;
constexpr int D=64,DM=1024,KP=128;
constexpr int NW=8,QBLK=32,QB=QBLK*NW,KVBLK=64;
constexpr int ATTN_PITCH=DM, ATTN_UNIT_ROWS=QB;
__device__ __forceinline__ int crow(int r,int hi){return (r&3)+8*(r>>2)+4*hi;}
#define SBAR() __builtin_amdgcn_sched_barrier(0)
__device__ __forceinline__ void cmask(f32x16&p0,f32x16&p1,int jb,int qrel,int hi){
  const float NEG=-INFINITY; int kb=64*jb+4*hi;
  #pragma unroll
  for(int r=0;r<16;++r){int kv=kb+(r&3)+8*(r>>2); if(kv>qrel)p0[r]=NEG; if(kv+32>qrel)p1[r]=NEG;}
}

constexpr int NSLOT=3, SLOTB=8192;
constexpr int LDS_K=0, LDS_V=NSLOT*SLOTB, LDS_WS=2*NSLOT*SLOTB, LDS_OST=LDS_WS+NW*64*4, LDS_BYTES=LDS_OST+NW*4096;
constexpr float C2=0.125f*1.4426950408889634f;
__device__ __forceinline__ void glds16(const void*gsrc,unsigned lds_dst){unsigned keep;
  asm volatile("s_mov_b32 %0, m0\n\ts_mov_b32 m0, %2\n\ts_nop 0\n\tglobal_load_lds_dwordx4 %1, off\n\ts_mov_b32 m0, %0":"=&s"(keep):"v"(gsrc),"s"(lds_dst):"memory");}
__device__ __forceinline__ float max3f(float a,float b,float c){float r;asm("v_max3_f32 %0, %1, %2, %3":"=v"(r):"v"(a),"v"(b),"v"(c));return r;}
__device__ __forceinline__ float max2f(float a,float b){float r;asm("v_max_f32_e32 %0, %1, %2":"=v"(r):"v"(a),"v"(b));return r;}
__device__ __forceinline__ float fadd_s(float a,float b){float r;asm("v_add_f32_e32 %0, %1, %2":"=v"(r):"v"(a),"v"(b));return r;}
__device__ __forceinline__ float fsub_s(float a,float b){float r;asm("v_sub_f32_e32 %0, %1, %2":"=v"(r):"v"(a),"v"(b));return r;}
typedef float f32x2_t __attribute__((ext_vector_type(2))); typedef __bf16 bf16x2_t __attribute__((ext_vector_type(2)));
__device__ __forceinline__ unsigned cvtpk_s(float lo,float hi){f32x2_t v={lo,hi};bf16x2_t b=__builtin_convertvector(v,bf16x2_t);return __builtin_bit_cast(unsigned,b);}
#define WAIT_BAR(N) asm volatile("s_waitcnt vmcnt(" #N ") lgkmcnt(0)\n\ts_barrier":::"memory")

__device__ __forceinline__ void qkt(f32x16&p0,f32x16&p1,const char*Kslot,const bf16x8*qr,const f32x16&negm,int r32,int hi){
  const char*kb=Kslot+hi*1024+r32*16;
  #pragma unroll
  for(int d0=0;d0<4;++d0){
    const bf16x8 b0=*reinterpret_cast<const bf16x8*>(kb+d0*2048);
    const bf16x8 b1=*reinterpret_cast<const bf16x8*>(kb+d0*2048+512);
    if(d0==0){p0=__builtin_amdgcn_mfma_f32_32x32x16_bf16(b0,qr[0],negm,0,0,0);p1=__builtin_amdgcn_mfma_f32_32x32x16_bf16(b1,qr[0],negm,0,0,0);}
    else{p0=__builtin_amdgcn_mfma_f32_32x32x16_bf16(b0,qr[d0],p0,0,0,0);p1=__builtin_amdgcn_mfma_f32_32x32x16_bf16(b1,qr[d0],p1,0,0,0);}}
}
typedef __attribute__((address_space(3))) const char* lds_cptr;
typedef short v4i16_t __attribute__((ext_vector_type(4)));
__device__ __forceinline__ void kload8(bf16x8*kf,lds_cptr kp){
  kf[0]=*(const __attribute__((address_space(3))) bf16x8*)(kp);      kf[1]=*(const __attribute__((address_space(3))) bf16x8*)(kp+512);
  kf[2]=*(const __attribute__((address_space(3))) bf16x8*)(kp+2048); kf[3]=*(const __attribute__((address_space(3))) bf16x8*)(kp+2560);
  kf[4]=*(const __attribute__((address_space(3))) bf16x8*)(kp+4096); kf[5]=*(const __attribute__((address_space(3))) bf16x8*)(kp+4608);
  kf[6]=*(const __attribute__((address_space(3))) bf16x8*)(kp+6144); kf[7]=*(const __attribute__((address_space(3))) bf16x8*)(kp+6656);
}
__device__ __forceinline__ void kload2(bf16x8*kf,lds_cptr kp,int j){ kf[2*j]=*(const __attribute__((address_space(3))) bf16x8*)(kp+j*2048); kf[2*j+1]=*(const __attribute__((address_space(3))) bf16x8*)(kp+j*2048+512); }
__device__ __forceinline__ s16x4 vtr(lds_cptr p){ return __builtin_bit_cast(s16x4,__builtin_amdgcn_ds_read_tr16_b64_v4i16((__attribute__((address_space(3))) v4i16_t*)p)); }
__device__ __forceinline__ float rowmax(const f32x16&p0,const f32x16&p1){
  float a=max3f(p0[0],p0[1],p1[0]),b=max3f(p0[2],p0[3],p1[1]);a=max3f(a,p1[2],p1[3]);
  #pragma unroll
  for(int r=4;r<16;r+=4){a=max3f(a,p0[r],p0[r+1]);b=max3f(b,p0[r+2],p0[r+3]);a=max3f(a,p1[r],p1[r+1]);b=max3f(b,p1[r+2],p1[r+3]);}
  const float m=max2f(a,b);
  auto rr=__builtin_amdgcn_permlane32_swap(__float_as_uint(m),__float_as_uint(m),false,false);
  return max2f(__uint_as_float(rr[0]),__uint_as_float(rr[1]));
}
__device__ __forceinline__ void pv(f32x16*o,int vb,bf16x8 pa0,bf16x8 pa1,bf16x8 pa2,bf16x8 pa3){
  #pragma unroll
  for(int d0=0;d0<2;++d0){s16x4 lo[4],hi[4];
    #pragma unroll
    for(int ks=0;ks<4;++ks){
      asm volatile("ds_read_b64_tr_b16 %0,%1 offset:%c2":"=&v"(lo[ks]):"v"(vb),"i"(d0*4096+ks*1024):"memory");
      asm volatile("ds_read_b64_tr_b16 %0,%1 offset:%c2":"=&v"(hi[ks]):"v"(vb),"i"(d0*4096+ks*1024+512):"memory");}
    asm volatile("s_waitcnt lgkmcnt(0)":::"memory");SBAR();
    #define PK(k) (bf16x8){lo[k][0],lo[k][1],lo[k][2],lo[k][3],hi[k][0],hi[k][1],hi[k][2],hi[k][3]}
    o[d0]=__builtin_amdgcn_mfma_f32_32x32x16_bf16(pa0,PK(0),o[d0],0,0,0);
    o[d0]=__builtin_amdgcn_mfma_f32_32x32x16_bf16(pa1,PK(1),o[d0],0,0,0);
    o[d0]=__builtin_amdgcn_mfma_f32_32x32x16_bf16(pa2,PK(2),o[d0],0,0,0);
    o[d0]=__builtin_amdgcn_mfma_f32_32x32x16_bf16(pa3,PK(3),o[d0],0,0,0);
    #undef PK
  }
}

#ifndef ATTN_STORE16
#define ATTN_STORE16(p,v) (*(u32x4*)(p)=(v))
#endif
template<int THRL> __device__ __forceinline__ void attn_unit(long qrow0,int hcol,long kvrow0,int kvcol,int NT,const bf16*Q,const bf16*__restrict__ K,const bf16*__restrict__ V,bf16*O,char*shm,const int wave_){
  const int tid=wave_*64+hw_lane(),lane=tid&63,r32=lane&31,hi=lane>>5; const int wid=wave_;
  const bf16*Qw=Q+(qrow0+wid*QBLK)*DM+hcol;
  const bf16*Kh=K+kvrow0*KP+kvcol,*Vh=V+kvrow0*KP+kvcol;
  const unsigned lds0=(unsigned)(uintptr_t)shm;
  float*wsf=(float*)(shm+LDS_WS)+wid*64;
  const bf16*ksrc=Kh+(long)lane*KP+wid*8;
  const bf16*vsrc=Vh+(long)(16*(wid&3)+(lane>>2))*KP+(wid>>2)*32+(lane&3)*8;
  const unsigned kdst=lds0+LDS_K+wid*1024, vdst=lds0+LDS_V+wid*1024;
  #define DMA_K(t,slot) glds16(ksrc+(long)(t)*KVBLK*KP,(unsigned)__builtin_amdgcn_readfirstlane(kdst+(slot)))
  #define DMA_V(t,slot) glds16(vsrc+(long)(t)*KVBLK*KP,(unsigned)__builtin_amdgcn_readfirstlane(vdst+(slot)))
  const int vb0=(int)(lds0+LDS_V)+((lane>>4)&1)*32+(lane&3)*8+(4*hi+((lane&15)>>2))*64;
  const char*Kbase=shm+LDS_K; bf16x8 kf[8];
  const lds_cptr shm3=(lds_cptr)shm; const lds_cptr kp0=shm3+LDS_K+hi*1024+r32*16; const lds_cptr vp0=shm3+LDS_V+((lane>>4)&1)*32+(lane&3)*8+(4*hi+((lane&15)>>2))*64;
  DMA_K(0,0);DMA_V(0,0);DMA_K(1,SLOTB);
  bf16x8 qr[4];
  #pragma unroll
  for(int d0=0;d0<4;++d0)qr[d0]=*reinterpret_cast<const bf16x8*>(&Qw[(long)r32*DM+d0*16+hi*8]);
  float mhat=0.f,l_reg=0.f;f32x16 o[2];o[0]=f32x16{};o[1]=f32x16{};f32x16 negm=f32x16{};asm volatile("":"+v"(negm));
  #define CMASK(P0,P1,t) do{}while(0)
  bool resc=false;
  #define START(P0,P1) do{ const float rm=rowmax(P0,P1); resc=false; \
    { const float dl=rm; mhat=fadd_s(mhat,dl); \
      _Pragma("unroll") for(int r=0;r<16;++r){P0[r]=fsub_s(P0[r],dl);P1[r]=fsub_s(P1[r],dl);} \
      _Pragma("unroll") for(int r=0;r<16;++r)negm[r]=-mhat; asm volatile("":"+v"(negm)); } \
    _Pragma("unroll") for(int r=0;r<16;++r)P0[r]=__builtin_amdgcn_exp2f(P0[r]); }while(0)
  #define RESC() do{ if(resc){ asm volatile("s_waitcnt lgkmcnt(0)":::"memory"); \
      _Pragma("unroll") for(int d_=0;d_<2;++d_) _Pragma("unroll") for(int r=0;r<16;++r)o[d_][r]*=wsf[crow(r,hi)]; } }while(0)
  f32x16 pA0,pA1,pB0,pB1;
  int sl_prev=0,sl_cur=0,sl_next=SLOTB;
  #define ROT() do{sl_prev=sl_cur;sl_cur=sl_next;sl_next=(sl_next==(NSLOT-1)*SLOTB)?0:sl_next+SLOTB;}while(0)
  DMA_K(2,2*SLOTB);
  WAIT_BAR(3);
  qkt(pA0,pA1,Kbase,qr,negm,r32,hi);asm volatile("s_nop 15\n\ts_nop 7":"+v"(pA0),"+v"(pA1));CMASK(pA0,pA1,0);
  START(pA0,pA1);
  _Pragma("unroll") for(int r=0;r<16;++r)pA1[r]=__builtin_amdgcn_exp2f(pA1[r]);
  WAIT_BAR(0);
  DMA_K(3,0);DMA_V(1,SLOTB);
  ROT();
  kload8(kf,kp0+sl_cur);
  WAIT_BAR(2);
  s16x4 vlo[8],vhi[8]; u32x4 pw0,pw1,pw2,pw3;
  #define PKW(P,B) cvtpk_s(P[B],P[B+1])
  #define PAF(k) __builtin_bit_cast(bf16x8,pw##k)
  #define VFR(i) (bf16x8){vlo[i][0],vlo[i][1],vlo[i][2],vlo[i][3],vhi[i][0],vhi[i][1],vhi[i][2],vhi[i][3]}
  #define PIN(x) asm volatile("":"+v"(x))
  #define MX3(a,b,c) __builtin_fmaxf(__builtin_fmaxf((a),(b)),(c))
  #define GAPA(MF,A0,A1,A2,A3,W0,W1,PW) do{ MF; sacc+=A0; sacc+=A1; sacc+=A2; sacc+=A3; PIN(sacc); W0; W1; PIN(PW); SBAR(); }while(0)
  #define EX(v) __builtin_amdgcn_exp2f(v)
  #define GAPB(MF,X,B) do{ MF; X[B]=EX(X[B]); X[B+1]=EX(X[B+1]); X[B+2]=EX(X[B+2]); X[B+3]=EX(X[B+3]); PIN(X); SBAR(); }while(0)
  #define VRD(i) do{ vlo[i]=vtr(vp_+(((i)>>2)*4096+((i)&3)*1024)); vhi[i]=vtr(vp_+(((i)>>2)*4096+((i)&3)*1024+512)); }while(0)
  #define KRD(G,j) do{ if(G){ kload2(kf,kp0+sl_next,j); SBAR(); } }while(0)
  #define STEP(C0,C1,P0,P1,t,GK,GV,GL) do{ SBAR(); \
    const lds_cptr vp_=vp0+sl_prev; \
    VRD(0); SBAR(); float sacc=(P0[0]+P0[1]); \
    GAPA(C0=__builtin_amdgcn_mfma_f32_32x32x16_bf16(kf[0],qr[0],negm,0,0,0), P0[2],P0[3],P0[4],P0[5],     pw0[0]=PKW(P0,0), pw0[1]=PKW(P0,2), pw0); \
    VRD(4); SBAR(); GAPA(C1=__builtin_amdgcn_mfma_f32_32x32x16_bf16(kf[1],qr[0],negm,0,0,0), P0[6],P0[7],P0[8],P0[9],     pw0[2]=PKW(P0,4), pw0[3]=PKW(P0,6), pw0); \
    VRD(1); SBAR(); GAPA(C0=__builtin_amdgcn_mfma_f32_32x32x16_bf16(kf[2],qr[1],C0,0,0,0),   P0[10],P0[11],P0[12],P0[13], pw1[0]=PKW(P0,8), pw1[1]=PKW(P0,10), pw1); \
    VRD(5); SBAR(); GAPA(C1=__builtin_amdgcn_mfma_f32_32x32x16_bf16(kf[3],qr[1],C1,0,0,0),   P0[14],P0[15],P1[0],P1[1],   pw1[2]=PKW(P0,12),pw1[3]=PKW(P0,14), pw1); \
    VRD(2); SBAR(); GAPA(C0=__builtin_amdgcn_mfma_f32_32x32x16_bf16(kf[4],qr[2],C0,0,0,0),   P1[2],P1[3],P1[4],P1[5],     pw2[0]=PKW(P1,0), pw2[1]=PKW(P1,2), pw2); \
    VRD(6); SBAR(); GAPA(C1=__builtin_amdgcn_mfma_f32_32x32x16_bf16(kf[5],qr[2],C1,0,0,0),   P1[6],P1[7],P1[8],P1[9],     pw2[2]=PKW(P1,4), pw2[3]=PKW(P1,6), pw2); \
    VRD(3); SBAR(); GAPA(C0=__builtin_amdgcn_mfma_f32_32x32x16_bf16(kf[6],qr[3],C0,0,0,0),   P1[10],P1[11],P1[12],P1[13], pw3[0]=PKW(P1,8), pw3[1]=PKW(P1,10), pw3); \
    VRD(7); SBAR(); GAPA(C1=__builtin_amdgcn_mfma_f32_32x32x16_bf16(kf[7],qr[3],C1,0,0,0),   P1[14],P1[15],0.f,0.f,       pw3[2]=PKW(P1,12),pw3[3]=PKW(P1,14), pw3); \
    l_reg+=sacc; \
    if(GK){DMA_K((t)+3,sl_cur);} if(GV){DMA_V((t)+1,sl_next);} \
    CMASK(C0,C1,t); \
    { float a=MX3(C0[0],C0[1],C1[0]),b=MX3(C0[2],C0[3],C1[1]); a=MX3(a,C1[2],C1[3]); \
      _Pragma("unroll") for(int r=4;r<16;r+=4){a=MX3(a,C0[r],C0[r+1]);b=MX3(b,C0[r+2],C0[r+3]);a=MX3(a,C1[r],C1[r+1]);b=MX3(b,C1[r+2],C1[r+3]);} \
      float rm=__builtin_fmaxf(a,b); { auto rr=__builtin_amdgcn_permlane32_swap(__float_as_uint(rm),__float_as_uint(rm),false,false); rm=__builtin_fmaxf(__uint_as_float(rr[0]),__uint_as_float(rr[1])); } \
      resc=false; \
      if(__builtin_expect(__any(rm>(float)THRL),0)){ const float dl=__builtin_fmaxf(rm,0.f); mhat+=dl; \
        _Pragma("unroll") for(int r=0;r<16;++r){C0[r]-=dl;C1[r]-=dl;} \
        _Pragma("unroll") for(int r=0;r<16;++r)negm[r]=-mhat; asm volatile("":"+v"(negm)); \
        const float f=__builtin_amdgcn_exp2f(-dl); l_reg*=f; if(hi==0)wsf[r32]=f; resc=true; } } \
    SBAR(); \
    GAPB(o[0]=__builtin_amdgcn_mfma_f32_32x32x16_bf16(PAF(0),VFR(0),o[0],0,0,0), C0,0); \
    GAPB(o[1]=__builtin_amdgcn_mfma_f32_32x32x16_bf16(PAF(0),VFR(4),o[1],0,0,0), C0,4); \
    KRD(GL,0); GAPB(o[0]=__builtin_amdgcn_mfma_f32_32x32x16_bf16(PAF(1),VFR(1),o[0],0,0,0), C0,8); \
    KRD(GL,1); GAPB(o[1]=__builtin_amdgcn_mfma_f32_32x32x16_bf16(PAF(1),VFR(5),o[1],0,0,0), C0,12); \
    KRD(GL,2); GAPB(o[0]=__builtin_amdgcn_mfma_f32_32x32x16_bf16(PAF(2),VFR(2),o[0],0,0,0), C1,0); \
    KRD(GL,3); GAPB(o[1]=__builtin_amdgcn_mfma_f32_32x32x16_bf16(PAF(2),VFR(6),o[1],0,0,0), C1,4); \
    GAPB(o[0]=__builtin_amdgcn_mfma_f32_32x32x16_bf16(PAF(3),VFR(3),o[0],0,0,0), C1,8); \
    GAPB(o[1]=__builtin_amdgcn_mfma_f32_32x32x16_bf16(PAF(3),VFR(7),o[1],0,0,0), C1,12); \
    }while(0)
  int t=1;
  #undef CMASK
  #define CMASK(P0,P1,t) do{}while(0)
  for(;t+5<NT;t+=2){
    STEP(pB0,pB1,pA0,pA1,t,true,true,true);     WAIT_BAR(2); RESC(); ROT();
    STEP(pA0,pA1,pB0,pB1,t+1,true,true,true);   WAIT_BAR(2); RESC(); ROT();
  }
  #undef CMASK
  #define CMASK(P0,P1,t) do{}while(0)
  #define ENDW(tt) do{ if((tt)+3<NT){WAIT_BAR(2);} else if((tt)+2<NT){WAIT_BAR(1);} else {WAIT_BAR(0);} }while(0)
  for(;t+1<NT;t+=2){
    STEP(pB0,pB1,pA0,pA1,t,(t+3<NT),(t+1<NT),(t+1<NT));       ENDW(t);   RESC(); ROT();
    STEP(pA0,pA1,pB0,pB1,t+1,(t+4<NT),(t+2<NT),(t+2<NT));     ENDW(t+1); RESC(); ROT();
  }
  STEP(pB0,pB1,pA0,pA1,NT-1,false,false,false); RESC();
  { float sacc=pB0[0]+pB0[1]; _Pragma("unroll") for(int r=2;r<16;++r)sacc+=pB0[r]; _Pragma("unroll") for(int r=0;r<16;++r)sacc+=pB1[r]; l_reg+=sacc;
    pw0=(u32x4){PKW(pB0,0),PKW(pB0,2),PKW(pB0,4),PKW(pB0,6)};pw1=(u32x4){PKW(pB0,8),PKW(pB0,10),PKW(pB0,12),PKW(pB0,14)};pw2=(u32x4){PKW(pB1,0),PKW(pB1,2),PKW(pB1,4),PKW(pB1,6)};pw3=(u32x4){PKW(pB1,8),PKW(pB1,10),PKW(pB1,12),PKW(pB1,14)};
    SBAR(); pv(o,vb0+sl_cur,PAF(0),PAF(1),PAF(2),PAF(3)); }
  #undef PKW
  #undef PAF
  #undef VFR
  #undef PIN
  #undef MX3
  #undef GAPA
  #undef GAPB
  #undef EX
  #undef VRD
  #undef KRD
  #undef STEP
  #undef ENDW
  {auto rr=__builtin_amdgcn_permlane32_swap(__float_as_uint(l_reg),__float_as_uint(l_reg),false,false);l_reg=__uint_as_float(rr[0])+__uint_as_float(rr[1]);}
  if(hi==0)wsf[32+r32]=l_reg;asm volatile("s_waitcnt lgkmcnt(0)":::"memory");
  float rli[16];
  #pragma unroll
  for(int r=0;r<16;++r)rli[r]=__builtin_amdgcn_rcpf(wsf[32+crow(r,hi)]);
  bf16*Ow=O+(qrow0+wid*QBLK)*DM+hcol;
  { bf16*stg=(bf16*)(shm+LDS_OST)+wid*2048;
    #pragma unroll
    for(int r=0;r<16;++r){const int orow=crow(r,hi);
      #pragma unroll
      for(int d0=0;d0<2;++d0)stg[orow*64+d0*32+r32]=__float2bfloat16(o[d0][r]*rli[r]);}
    asm volatile("s_waitcnt lgkmcnt(0)":::"memory");
    #pragma unroll
    for(int i=0;i<4;++i){const int row=i*8+(lane>>3),ch=lane&7; const u32x4 v=*(const u32x4*)(stg+row*64+ch*8); ATTN_STORE16(Ow+(long)row*DM+ch*8,v);} }
  asm volatile("s_waitcnt lgkmcnt(0)\n\ts_barrier":::"memory");
  #undef DMA_K
  #undef DMA_V
  #undef CMASK
  #undef START
  #undef RESC
  #undef ROT
}
constexpr int ATTN_LDS_BYTES=LDS_BYTES;
#undef SBAR
#undef WAIT_BAR
}
#define GAS __attribute__((address_space(1)))
#define LAS __attribute__((address_space(3)))
typedef unsigned short bf16;
typedef unsigned v4u __attribute__((ext_vector_type(4)));
typedef float f32x4 __attribute__((ext_vector_type(4)));
typedef short bf16x8 __attribute__((ext_vector_type(8)));
typedef GAS unsigned gu32;
typedef GAS unsigned long long gu64;
#define RLX_AGENT __ATOMIC_RELAXED, __HIP_MEMORY_SCOPE_AGENT
#define LDS_WAIT() asm volatile("s_waitcnt lgkmcnt(0)" ::: "memory")
#define VM_WAIT() asm volatile("s_waitcnt vmcnt(0)" ::: "memory")
__device__ __forceinline__ unsigned long long rt() { return __builtin_amdgcn_s_memrealtime(); }
__device__ __forceinline__ unsigned f2bf(float f) { unsigned u = __builtin_bit_cast(unsigned, f); return (u + 0x7fffu + ((u >> 16) & 1u)) >> 16; }
__device__ __forceinline__ unsigned pk2(float lo, float hi) { return f2bf(lo) | (f2bf(hi) << 16); }

#define XB_TMO      128
#define XB_XCNT(j)  (256  + 64 * (j))
#define XB_XSUB(j)  (1280 + 64 * (j))
#define XB_XGEN(j)  (2304 + 64 * (j))
#define XB_TOP      3328
#define XB_TOPGEN   3392
#define XCD_BAR_WORDS 3456
#define XB_SPIN_CAP (1u << 18)

__device__ __forceinline__ unsigned xb_ld(unsigned* p)              { return __hip_atomic_load(p, __ATOMIC_RELAXED, __HIP_MEMORY_SCOPE_AGENT); }
__device__ __forceinline__ unsigned xb_add(unsigned* p, unsigned v) { return __hip_atomic_fetch_add(p, v, __ATOMIC_RELAXED, __HIP_MEMORY_SCOPE_AGENT); }
__device__ __forceinline__ unsigned xb_xcc_id() { return (unsigned)__builtin_amdgcn_s_getreg((3 << 11) | 20) & 0xFu; }
#define XB_SPIN(cond, bar) do { unsigned _sp = 0; while (cond) { __builtin_amdgcn_s_sleep(1); \
    if ((++_sp & 255u) == 0u) { if (xb_ld(&(bar)[XB_TMO])) break; if (_sp > XB_SPIN_CAP) { atomicAdd(&(bar)[XB_TMO], 1u); break; } } } } while (0)

struct XcdBarrier {
    unsigned* bar; unsigned x; int wv;
    volatile LAS unsigned* st;
};

__device__ __forceinline__ XcdBarrier xcd_barrier_post(unsigned* bar, volatile LAS unsigned* st, int wv) {
    XcdBarrier b; b.bar = bar; b.x = xb_xcc_id(); b.st = st; b.wv = wv;
    if (threadIdx.x == 0) (void)xb_add(&bar[XB_XCNT(b.x)], 1u);
    return b;
}
__device__ __forceinline__ void xcd_barrier_complete(unsigned* bar, unsigned x, unsigned& nloc, unsigned& nx) {
    const unsigned G = gridDim.x * gridDim.y * gridDim.z;
    unsigned sum, cnt, mine, sp = 0u;
    for (;;) {
        sum = 0u; cnt = 0u; mine = 0u;
#pragma unroll
        for (unsigned j = 0; j < 16; ++j) { const unsigned c = xb_ld(&bar[XB_XCNT(j)]); sum += c; cnt += (c > 0u) ? 1u : 0u; mine = (j == x) ? c : mine; }
        if (sum == G) break;
        __builtin_amdgcn_s_sleep(1);
        if ((++sp & 255u) == 0u) { if (xb_ld(&bar[XB_TMO])) break; if (sp > XB_SPIN_CAP) { atomicAdd(&bar[XB_TMO], 1u); break; } }
    }
    nloc = mine > 0u ? mine : 1u; nx = cnt > 0u ? cnt : 1u;
}

__device__ __forceinline__ void xcd_barrier(const XcdBarrier& b) {
    asm volatile("s_waitcnt vmcnt(0)" ::: "memory");
    __syncthreads();
    if (b.wv == 0 && hw_lane() == 0) {
        unsigned* bar = b.bar;
        __builtin_amdgcn_s_waitcnt(0);
        unsigned nloc = b.st[0], nx = b.st[1];
        if (nloc == 0u) { xcd_barrier_complete(bar, b.x, nloc, nx); b.st[0] = nloc; b.st[1] = nx; }
        const unsigned old = xb_add(&bar[XB_XSUB(b.x)], 1u);
        const unsigned gen = old / nloc;
        if (old + 1u == (gen + 1u) * nloc) {
            __builtin_amdgcn_fence(__ATOMIC_RELEASE, "agent");
            asm volatile("s_waitcnt vmcnt(0)" ::: "memory");
            const unsigned og = xb_add(&bar[XB_TOP], 1u);
            const unsigned tg = og / nx;
            if (og + 1u == (tg + 1u) * nx) xb_add(&bar[XB_TOPGEN], 1u);
            else XB_SPIN(xb_ld(&bar[XB_TOPGEN]) == tg, bar);
            __builtin_amdgcn_fence(__ATOMIC_ACQUIRE, "agent");
            xb_add(&bar[XB_XGEN(b.x)], 1u);
            asm volatile("s_waitcnt vmcnt(0)" ::: "memory");
        } else {
            XB_SPIN(xb_ld(&bar[XB_XGEN(b.x)]) == gen, bar);
            __builtin_amdgcn_fence(__ATOMIC_ACQUIRE, "agent");
            asm volatile("s_waitcnt vmcnt(0)" ::: "memory");
        }
    }
    __syncthreads();
}

#ifndef PROBE
#define PROBE 0
#endif
#ifndef DEBUG_NAN
#define DEBUG_NAN 0
#endif
#ifndef TSEL
#define TSEL -1
#endif
#ifndef CYSEL
#define CYSEL -1
#endif
#ifndef TSCALE10
#define TSCALE10 0
#endif
#if TSEL >= 0
#define TS(k) do { if (blockIdx.x == 0 && F.wave == 0 && hw_lane() == 0) { unsigned long long* ts_ = (unsigned long long*)(F.ws + WS_CTL + 32768); const unsigned long long now_ = __builtin_amdgcn_s_memrealtime(); ts_[1 + (k)] += now_ - ts_[0]; ts_[0] = now_; } } while (0)
#else
#define TS(k) do {} while (0)
#endif
#ifndef USE_SEQ_SCAN
#define USE_SEQ_SCAN 0
#endif
constexpr int NWAVES = 8;
constexpr int DMODEL = 1024, NBATCH = 8, SEQL = 4096, CTXL = 256, DEPTH = 4;
constexpr int TL = NBATCH * SEQL, TC = NBATCH * CTXL, TT = TL + TC;
constexpr int KVLEN = SEQL + CTXL;
constexpr int INW = 2688, INWP = 2816, ATTIN = 768, SHIFTW = 1920;
constexpr int FFD = 2816, FFE = 3584, NEXP = 8;
constexpr int LORA_K = 384, LORA_N = 2560;
constexpr int MAXPANEL = 280, MAXSLOT = MAXPANEL * 256;
constexpr float RMS_EPS = 1e-6f, GN_EPS = 64e-5f;

constexpr size_t MiB = 1u << 20;
constexpr size_t WS_CTL = 0, CTL_ZERO_BYTES = 64 * 1024;
constexpr size_t WS_MOD = 1 * MiB;
constexpr size_t WS_ROPE = 2 * MiB;
constexpr size_t WS_ROUTE = 3 * MiB;
constexpr size_t RT_E = 0, RT_G = 160 * 1024, RT_S = 448 * 1024, RT_BLK = 768 * 1024, RT_WCNT = 800 * 1024;
constexpr size_t WS_XB = 12 * MiB;
constexpr size_t WS_WIN = 80 * MiB, WS_WOUT = 86 * MiB, WS_WLORA = 88 * MiB;
constexpr size_t WS_WFF = 100 * MiB;
constexpr size_t WS_WFF_D_DENSE = WS_WFF + 12 * MiB, WS_WFF_D_MOE = WS_WFF + 112 * MiB;
constexpr size_t WS_ACT = 270 * MiB;
constexpr size_t WS_QO = WS_ACT, WS_KB = WS_ACT + 68 * MiB, WS_VB = WS_ACT + 77 * MiB, WS_P = WS_ACT + 86 * MiB, WS_OSC = WS_P;
constexpr size_t WS_R = WS_ACT + 273 * MiB, WS_K = WS_ACT + 307 * MiB, WS_V = WS_ACT + 341 * MiB, WS_KK = WS_ACT + 375 * MiB, WS_LIN = WS_ACT + 409 * MiB;
constexpr size_t WS_LOUT = WS_ACT + 435 * MiB;
constexpr size_t WS_SPT = WS_WFF, WS_SG = WS_WFF + 68 * MiB, WS_SQ = WS_ACT + 605 * MiB;
constexpr size_t WS_HID = WS_ACT;
constexpr size_t WS_AG = WS_ACT, WS_AG8 = WS_ACT + 140 * MiB, WS_HIDM = WS_ACT + 210 * MiB;
constexpr size_t WS_WFF_D_MOE8 = WS_WFF + 56 * MiB;
constexpr float W8SCALE = 64.0f, H8SCALE = 8.0f, HID8SCALE = 4.0f;
constexpr size_t WS_SIDE = 1000 * MiB;
constexpr size_t WS_END = 1012 * MiB;
static_assert(WS_LOUT + (size_t)TT * LORA_N * 2 <= WS_END && WS_HIDM + (size_t)MAXSLOT * FFE <= WS_END && WS_P + (size_t)TT * INWP * 2 <= WS_R && WS_OSC + (size_t)2 * TT * 512 * 4 <= WS_R, "ws map");
static_assert(WS_WFF_D_MOE + (size_t)NEXP * 1024 * FFE * 2 <= WS_ACT && WS_XB + (size_t)TT * 1024 * 2 <= WS_WIN && WS_WIN + (size_t)INWP * 1024 * 2 <= WS_WOUT && WS_WLORA + (size_t)LORA_N * LORA_K * 2 <= WS_WFF, "ws map 2");
constexpr int CW_BAR = 4096;

constexpr int RING_OFF = 0, RING_BYTES = 131072;
constexpr int LDSCTL_OFF = RING_BYTES;
constexpr int MISC_OFF = LDSCTL_OFF;
constexpr int LT_PEXP = LDSCTL_OFF + 256;
constexpr int LT_NPAN = LT_PEXP + 320 * 4;
constexpr int LT_INP = LT_NPAN + 64;
constexpr int LT_TMP = LT_INP + 256;
constexpr int LDS_BYTES = 147456;
static_assert(LT_TMP + 8192 + 1024 <= LDS_BYTES, "LDS map");

struct Frame {
    LAS unsigned char* lds;
    volatile LAS unsigned* MISC;
    gu32* ctl;
    int tid, lane, wave, vcu, G;
    unsigned char* ws;
    float* out;
};
struct Args { const float* in[30]; float* out; unsigned char* ws; };
__device__ __forceinline__ const void* inp_ld(const Frame& F, int k) {
    const LAS unsigned* t = (const LAS unsigned*)(F.lds + LT_INP) + 2 * k; unsigned lo = t[0], hi = t[1];
    lo = __builtin_amdgcn_readfirstlane(lo); hi = __builtin_amdgcn_readfirstlane(hi);
    return (const void*)(const GAS void*)(((unsigned long long)hi << 32) | lo);
}
#define IN_X 0
#define IN_C 1
#define IN_CTX 2
#define IN_CCTX 3
#define IN_ADAW 4
#define IN_ADAB 5
#define IN_N1G 6
#define IN_N2G 7
#define IN_WIN 8
#define IN_WOUT 9
#define IN_QG 10
#define IN_KG 11
#define IN_MU 12
#define IN_W0 13
#define IN_W2 14
#define IN_A0 15
#define IN_A2 16
#define IN_G2 17
#define IN_KKW 18
#define IN_KA 19
#define IN_RK 20
#define IN_GNW 21
#define IN_GNB 22
#define IN_FWG 23
#define IN_FWU 24
#define IN_FWD 25
#define IN_ROUTER 26
#define IN_MWG 27
#define IN_MWU 28
#define IN_MWD 29

__device__ __forceinline__ int vlaunder(int v) { asm volatile("" : "+v"(v)); return v; }
__device__ __forceinline__ unsigned char* launder(unsigned char* p) { unsigned long long v = (unsigned long long)p; asm volatile("" : "+s"(v)); return (unsigned char*)(GAS unsigned char*)v; }
#define INP(k) ((const float*)inp_ld(F, (k)))
__device__ __forceinline__ const void* inp_ld(const struct Frame& F, int k);
template <int CTRL_> __device__ __forceinline__ float dpp_mov(float v) { return __builtin_bit_cast(float, __builtin_amdgcn_update_dpp(0, __builtin_bit_cast(int, v), CTRL_, 0xf, 0xf, true)); }
__device__ __forceinline__ float row_sum16(float v) { v += dpp_mov<0xB1>(v); v += dpp_mov<0x4E>(v); v += dpp_mov<0x141>(v); v += dpp_mov<0x128>(v); return v; }
__device__ __forceinline__ float wave_sum(float v) { v = row_sum16(v); v += __shfl_xor(v, 16); v += __shfl_xor(v, 32); return v; }
__device__ __forceinline__ float half_sum(float v) { v = row_sum16(v); v += __shfl_xor(v, 16); return v; }
__device__ __forceinline__ float bflo(unsigned w) { return __builtin_bit_cast(float, w << 16); }
__device__ __forceinline__ float bfhi(unsigned w) { return __builtin_bit_cast(float, w & 0xffff0000u); }
typedef float f32x2_t_ __attribute__((ext_vector_type(2))); typedef __bf16 bf16x2_t_ __attribute__((ext_vector_type(2)));
__device__ __forceinline__ unsigned pkbf(float lo, float hi) { f32x2_t_ v = {lo, hi}; bf16x2_t_ b = __builtin_convertvector(v, bf16x2_t_); return __builtin_bit_cast(unsigned, b); }
__device__ __forceinline__ float sigm(float x) { return __builtin_amdgcn_rcpf(1.0f + __builtin_amdgcn_exp2f(-1.4426950408889634f * x)); }

__device__ __forceinline__ void p_prologue(Frame& F, const Args& A) {
    unsigned char* const ws = launder(F.ws);
    const int tid = (F.wave * 64 + hw_lane()), lane = tid & 63; (void)lane;
    LAS float* sc = (LAS float*)(F.lds + RING_OFF);
    for (int i = tid; i < 9 * 1024; i += NWAVES * 64) { const int b = i >> 10, k = i & 1023; const float v = (b < 8) ? INP(IN_C)[b * 1024 + k] : INP(IN_CCTX)[k]; sc[i] = v * sigm(v); }
    __syncthreads();
    const int gw = F.vcu * NWAVES + F.wave, NGW = F.G * NWAVES;
    float* mod = (float*)(ws + WS_MOD);
    for (int it = (int)blockIdx.x + F.G * F.wave; it < DEPTH * 96; it += NGW) {
        const int l = it / 96, j = (it % 96) * 64 + lane;
        const float* W = INP(IN_ADAW) + (size_t)l * 1024 * 6144 + j;
        float acc[9];
#pragma unroll
        for (int b = 0; b < 9; ++b) acc[b] = 0.f;
        for (int k = 0; k < 1024; k += 16) {
            float wv[16];
#pragma unroll
            for (int u = 0; u < 16; ++u) wv[u] = W[(size_t)(k + u) * 6144];
#pragma unroll
            for (int b = 0; b < 9; ++b)
#pragma unroll
                for (int u4 = 0; u4 < 4; ++u4) { const f32x4 s = *(const LAS f32x4*)(sc + b * 1024 + k + 4 * u4); acc[b] += (s[0] * wv[4 * u4] + s[1] * wv[4 * u4 + 1]) + (s[2] * wv[4 * u4 + 2] + s[3] * wv[4 * u4 + 3]); }
        }
        const float bias = INP(IN_ADAB)[l * 6144 + j];
#pragma unroll
        for (int b = 0; b < 9; ++b) mod[((size_t)l * 9 + b) * 6144 + j] = acc[b] + bias;
    }
    float* cs = (float*)(ws + WS_ROPE);
    for (int i = blockIdx.x * (NWAVES * 64) + tid; i < 4096 * 32; i += F.G * NWAVES * 64) {
        const int t = i >> 5, k = i & 31; const int pos = (k < 16) ? (t >> 6) : (t & 63);
        const float inv = powf(10000.0f, -(float)(2 * (k & 15)) / 32.0f); const float ang = (float)pos * inv;
        float s, c; sincosf(ang, &s, &c); cs[2 * i] = c; cs[2 * i + 1] = s;
    }
    __syncthreads();
}

struct WItem { const float* W; unsigned char* WT; int K, N, k0, n0, drow0, f8; };
__device__ __forceinline__ void tr_load(const WItem& w, float (&tv)[32], int lane) {
#pragma unroll
    for (int i = 0; i < 32; ++i) tv[i] = w.W[(size_t)(w.k0 + 2 * i + (lane >> 5)) * w.N + w.n0 + (lane & 31)];
}
__device__ __forceinline__ void tr_finish(const WItem& w, const float (&tv)[32], LAS float* scr, int lane) {
#pragma unroll
    for (int i = 0; i < 32; ++i) scr[(2 * i + (lane >> 5)) * 33 + (lane & 31)] = tv[i];
    LDS_WAIT(); asm volatile("" ::: "memory");
    if (w.f8) { const int c = lane & 3;
#pragma unroll
        for (int j = 0; j < 2; ++j) { const int n = (lane >> 2) + 16 * j; const LAS float* s = scr + (16 * c) * 33 + n;
            v4u o;
            o.x = pg8::pk_fp8x4(s[0 * 33] * W8SCALE, s[1 * 33] * W8SCALE, s[2 * 33] * W8SCALE, s[3 * 33] * W8SCALE); o.y = pg8::pk_fp8x4(s[4 * 33] * W8SCALE, s[5 * 33] * W8SCALE, s[6 * 33] * W8SCALE, s[7 * 33] * W8SCALE);
            o.z = pg8::pk_fp8x4(s[8 * 33] * W8SCALE, s[9 * 33] * W8SCALE, s[10 * 33] * W8SCALE, s[11 * 33] * W8SCALE); o.w = pg8::pk_fp8x4(s[12 * 33] * W8SCALE, s[13 * 33] * W8SCALE, s[14 * 33] * W8SCALE, s[15 * 33] * W8SCALE);
            *(v4u*)(w.WT + (size_t)(w.drow0 + n) * w.K + w.k0 + 16 * c) = o; }
    } else { const int c = lane & 7;
#pragma unroll
        for (int j = 0; j < 4; ++j) { const int n = (lane >> 3) + 8 * j; const LAS float* s = scr + (8 * c) * 33 + n;
            v4u o; o.x = pkbf(s[0 * 33], s[1 * 33]); o.y = pkbf(s[2 * 33], s[3 * 33]); o.z = pkbf(s[4 * 33], s[5 * 33]); o.w = pkbf(s[6 * 33], s[7 * 33]);
            *(v4u*)((bf16*)w.WT + (size_t)(w.drow0 + n) * w.K + w.k0 + 8 * c) = o; } }
    LDS_WAIT(); asm volatile("" ::: "memory");
}
__device__ __forceinline__ int gu_row(int n) { return 256 * (n >> 7) + (n & 127); }

__device__ __forceinline__ WItem wprep_decode(Frame& F, unsigned char* const ws, const int l, const int it) {
    constexpr int I_IN = 16 * (INW / 32), I_OUT = 16 * 32;
    const bool moe = (l & 1) != 0; const int j = l >> 1;
    constexpr int I_DG = 16 * (FFD / 32), I_MG = 16 * (FFE / 32);
    int r = it; WItem w;
    if (r < I_IN) { const int nb = r % (INW / 32), kb = r / (INW / 32); w = WItem{INP(IN_WIN) + (size_t)l * 1024 * INW, ws + WS_WIN, 1024, INW, kb * 64, nb * 32, nb * 32, 0}; return w; } r -= I_IN;
    if (r < I_OUT) { const int nb = r % 32, kb = r / 32; w = WItem{INP(IN_WOUT) + (size_t)l * 1024 * 1024, ws + WS_WOUT, 1024, 1024, kb * 64, nb * 32, nb * 32, 0}; return w; } r -= I_OUT;
    if (!moe) {
        if (r < I_DG) { const int nb = r % (FFD / 32), kb = r / (FFD / 32); w = WItem{INP(IN_FWG) + (size_t)j * 1024 * FFD, ws + WS_WFF, 1024, FFD, kb * 64, nb * 32, gu_row(nb * 32), 0}; return w; } r -= I_DG;
        if (r < I_DG) { const int nb = r % (FFD / 32), kb = r / (FFD / 32); w = WItem{INP(IN_FWU) + (size_t)j * 1024 * FFD, ws + WS_WFF, 1024, FFD, kb * 64, nb * 32, gu_row(nb * 32) + 128, 0}; return w; } r -= I_DG;
        { const int nb = r % 32, kb = r / 32; w = WItem{INP(IN_FWD) + (size_t)j * FFD * 1024, ws + WS_WFF_D_DENSE, FFD, 1024, kb * 64, nb * 32, nb * 32, 0}; return w; }
    }
    constexpr int I_MD = (FFE / 64) * 32; constexpr int PER = 2 * I_MG + I_MD; const int e = r / PER; r -= e * PER;
    unsigned char* WGU = ws + WS_WFF + (size_t)e * (2 * FFE) * 1024; unsigned char* WD = ws + WS_WFF_D_MOE8 + (size_t)e * 1024 * FFE;
    const size_t eo = ((size_t)j * NEXP + e) * 1024 * FFE;
    if (r < I_MG) { const int nb = r % (FFE / 32), kb = r / (FFE / 32); w = WItem{INP(IN_MWG) + eo, WGU, 1024, FFE, kb * 64, nb * 32, gu_row(nb * 32), 1}; return w; } r -= I_MG;
    if (r < I_MG) { const int nb = r % (FFE / 32), kb = r / (FFE / 32); w = WItem{INP(IN_MWU) + eo, WGU, 1024, FFE, kb * 64, nb * 32, gu_row(nb * 32) + 128, 1}; return w; } r -= I_MG;
    { const int nb = r % 32, kb = r / 32; w = WItem{INP(IN_MWD) + eo, WD, FFE, 1024, kb * 64, nb * 32, nb * 32, 1}; return w; }
}
__device__ __forceinline__ void p_wprep(Frame& F, const Args& A, int l, int part, gu32* ctr = nullptr) {
    unsigned char* const ws = launder(F.ws);
    const int tid = (F.wave * 64 + hw_lane()), lane = tid & 63; (void)lane;
    LAS float* scr = (LAS float*)(F.lds + RING_OFF + F.wave * 16384);
    const int gw = F.vcu * NWAVES + F.wave, NGW = F.G * NWAVES;
    bf16* WIN = (bf16*)(ws + WS_WIN); bf16* WLORA = (bf16*)(ws + WS_WLORA);
    constexpr int I_IN = 16 * (INW / 32), I_OUT = 16 * 32;
    const bool moe = (l & 1) != 0;
    constexpr int I_DG = 16 * (FFD / 32), I_DD = (FFD / 64) * 32, I_MG = 16 * (FFE / 32), I_MD = (FFE / 64) * 32;
    const int nff = moe ? NEXP * (2 * I_MG + I_MD) : (2 * I_DG + I_DD);
    const int NIT = I_IN + I_OUT + nff;
    const int lo = part ? I_IN + I_OUT : 0, hi = part ? NIT : I_IN + I_OUT;
    (void)ctr;
    {
        int it = lo + gw; WItem wa, wb; float ta[32], tb[32];
        if (it < hi) { wa = wprep_decode(F, ws, l, it); tr_load(wa, ta, lane); }
        for (; it < hi; it += 2 * NGW) {
            const int i2 = it + NGW, i3 = i2 + NGW;
            if (i2 < hi) { wb = wprep_decode(F, ws, l, i2); tr_load(wb, tb, lane); }
            tr_finish(wa, ta, scr, lane);
            if (i3 < hi) { wa = wprep_decode(F, ws, l, i3); tr_load(wa, ta, lane); }
            if (i2 < hi) tr_finish(wb, tb, scr, lane);
        }
    }
    if (part) return;
    for (int i = blockIdx.x * (NWAVES * 64) + tid; i < 16384; i += F.G * NWAVES * 64) ((v4u*)(WIN + (size_t)INW * 1024))[i] = (v4u){0u, 0u, 0u, 0u};
    const float* w2 = INP(IN_W2) + (size_t)l * 2 * 64 * 512; const float* a2 = INP(IN_A2) + (size_t)l * 2 * 64 * 512; const float* g2 = INP(IN_G2) + (size_t)l * 128 * 512;
    for (int i = blockIdx.x * (NWAVES * 64) + tid; i < LORA_N * 64; i += F.G * NWAVES * 64) {
        const int n = i >> 6, k = (i & 63) * 2; const int sec = n >> 9, cn = n & 511;
        float v0 = 0.f, v1 = 0.f;
        if (sec < 2) { const int kk = k - 64 * sec; if (kk >= 0 && kk < 64) { v0 = w2[((size_t)sec * 64 + kk) * 512 + cn]; v1 = w2[((size_t)sec * 64 + kk + 1) * 512 + cn]; } }
        else if (sec < 4) { const int d = sec - 2, kk = k - 64 * d; if (kk >= 0 && kk < 64) { v0 = a2[((size_t)d * 64 + kk) * 512 + cn]; v1 = a2[((size_t)d * 64 + kk + 1) * 512 + cn]; } }
        else { v0 = g2[(size_t)k * 512 + cn]; v1 = g2[(size_t)(k + 1) * 512 + cn]; }
        ((unsigned*)WLORA)[i] = pkbf(v0, v1);
    }
}

template <bool ROUTER, bool COMBINE, bool SRCF32, bool SIDE = false>
__device__ __forceinline__ void p_norm(Frame& F, const Args& A, int l, int which, const float* srcL, const float* srcC, int lprev, int nrows = TT) {
    unsigned char* const ws = launder(F.ws);
    const int tid = (F.wave * 64 + hw_lane()), lane = tid & 63; (void)lane;
    const int gw = F.vcu * NWAVES + F.wave, NGW = F.G * NWAVES;
    const float* mod = (const float*)(ws + WS_MOD) + (size_t)l * 9 * 6144;
    const float* gain = A.in[which ? IN_N2G : IN_N1G] + l * 1024;
    bf16* H = (bf16*)F.out;
    const float* route_g = (const float*)(ws + WS_ROUTE + RT_G); const int* route_s = (const int*)(ws + WS_ROUTE + RT_S);
    int cnt0 = 0, cnt1 = 0, cnt2 = 0, cnt3 = 0, cnt4 = 0, cnt5 = 0, cnt6 = 0, cnt7 = 0;
    LAS float* rwl = (LAS float*)(F.lds + RING_OFF);
    if (ROUTER) {
        __syncthreads();
        const float* rw = INP(IN_ROUTER) + (size_t)(l >> 1) * 1024 * 8;
        for (int i = tid; i < 2048; i += NWAVES * 64) { const f32x4 w = *(const f32x4*)(rw + 4 * i); const int col = i >> 1, e4 = (i & 1) * 4, jj = col >> 8, ln = (col & 255) >> 2, q = col & 3;
            *(LAS f32x4*)(rwl + (((jj * 4 + q) * 64 + ln) * 8 + e4)) = w; }
        __syncthreads();
    }
    uint2 nx[2][4]; f32x4 nf[2][4]; float cg[2][2]; int cs[2][2];
#pragma unroll
    for (int r = 0; r < 2; ++r) { cg[r][0] = cg[r][1] = 0.f; cs[r][0] = cs[r][1] = 0;
#pragma unroll
        for (int jj = 0; jj < 4; ++jj) { nx[r][jj] = make_uint2(0u, 0u); nf[r][jj] = (f32x4){0.f, 0.f, 0.f, 0.f}; } }
#define PN_LOAD(r_, row_) do { const int row__ = (row_); if (row__ < nrows) { \
        if (SRCF32) { const float* xr_ = (row__ < TL) ? srcL + (size_t)row__ * 1024 : srcC + (size_t)(row__ - TL) * 1024; _Pragma("unroll") for (int jj = 0; jj < 4; ++jj) nf[r_][jj] = *(const f32x4*)(xr_ + 4 * ln + 256 * jj); } \
        else { const bf16* xr_ = (const bf16*)(ws + WS_XB) + (size_t)row__ * 1024; _Pragma("unroll") for (int jj = 0; jj < 4; ++jj) nx[r_][jj] = *(const uint2*)(xr_ + 4 * ln + 256 * jj); } \
        if (COMBINE) { cg[r_][0] = route_g[2 * row__]; cg[r_][1] = route_g[2 * row__ + 1]; cs[r_][0] = route_s[2 * row__]; cs[r_][1] = route_s[2 * row__ + 1]; } } } while (0)
    int ln = vlaunder(lane);
    PN_LOAD(0, gw); PN_LOAD(1, gw + NGW);
    for (int row0 = gw; row0 < nrows; row0 += 2 * NGW) {
        ln = vlaunder(lane);
        const bool ok1 = row0 + NGW < nrows;
        f32x4 v[2][4]; float g0[2], g1[2]; int s0[2], s1[2];
#pragma unroll
        for (int r = 0; r < 2; ++r) { g0[r] = cg[r][0]; g1[r] = cg[r][1]; s0[r] = cs[r][0]; s1[r] = cs[r][1];
#pragma unroll
            for (int jj = 0; jj < 4; ++jj) { if (SRCF32) v[r][jj] = nf[r][jj]; else { const uint2 w = nx[r][jj]; v[r][jj] = (f32x4){bflo(w.x), bfhi(w.x), bflo(w.y), bfhi(w.y)}; } } }
        PN_LOAD(0, row0 + 2 * NGW); PN_LOAD(1, row0 + 3 * NGW);
        if (COMBINE) {
            const bf16* Y = (const bf16*)(ws + WS_AG);
            uint2 yy0[2][4], yy1[2][4];
#pragma unroll
            for (int r = 0; r < 2; ++r)
#pragma unroll
                for (int jj = 0; jj < 4; ++jj) { const int col = 4 * ln + 256 * jj; yy0[r][jj] = *(const uint2*)(Y + (size_t)s0[r] * 1024 + col); yy1[r][jj] = *(const uint2*)(Y + (size_t)s1[r] * 1024 + col); }
#pragma unroll
            for (int r = 0; r < 2; ++r) { const int row = row0 + r * NGW; const int bsel = (row < TL) ? (row >> 12) : 8;
                const float* m5 = (const float*)(ws + WS_MOD) + ((size_t)lprev * 9 + bsel) * 6144 + 5 * 1024;
                bf16* xbr = (bf16*)(ws + WS_XB) + (size_t)row * 1024;
#pragma unroll
                for (int jj = 0; jj < 4; ++jj) { const int col = 4 * ln + 256 * jj;
                    const uint2 y0 = yy0[r][jj], y1 = yy1[r][jj]; const f32x4 mm = *(const f32x4*)(m5 + col);
                    v[r][jj][0] += mm[0] * (g0[r] * bflo(y0.x) + g1[r] * bflo(y1.x)); v[r][jj][1] += mm[1] * (g0[r] * bfhi(y0.x) + g1[r] * bfhi(y1.x));
                    v[r][jj][2] += mm[2] * (g0[r] * bflo(y0.y) + g1[r] * bflo(y1.y)); v[r][jj][3] += mm[3] * (g0[r] * bfhi(y0.y) + g1[r] * bfhi(y1.y));
                    if (r == 0 || ok1) *(uint2*)(xbr + col) = make_uint2(pkbf(v[r][jj][0], v[r][jj][1]), pkbf(v[r][jj][2], v[r][jj][3])); } }
        }
        if (SIDE) {
#pragma unroll
            for (int r = 0; r < 2; ++r) { const int row = row0 + r * NGW;
                if ((r == 0 || ok1) && row >= TL) {
                    const bf16* sd = (const bf16*)(ws + WS_SIDE) + (size_t)(row - TL) * 1024; bf16* xbr = (bf16*)(ws + WS_XB) + (size_t)row * 1024;
                    uint2 sv[3][4];
#pragma unroll
                    for (int q = 0; q < 3; ++q)
#pragma unroll
                        for (int jj = 0; jj < 4; ++jj) sv[q][jj] = *(const uint2*)(sd + (size_t)q * TC * 1024 + 4 * ln + 256 * jj);
#pragma unroll
                    for (int jj = 0; jj < 4; ++jj) {
#pragma unroll
                        for (int q = 0; q < 3; ++q) { const uint2 w = sv[q][jj]; v[r][jj][0] += bflo(w.x); v[r][jj][1] += bfhi(w.x); v[r][jj][2] += bflo(w.y); v[r][jj][3] += bfhi(w.y); }
                        *(uint2*)(xbr + 4 * ln + 256 * jj) = make_uint2(pkbf(v[r][jj][0], v[r][jj][1]), pkbf(v[r][jj][2], v[r][jj][3])); } } }
        }
        float ss[2];
#pragma unroll
        for (int r = 0; r < 2; ++r) { ss[r] = 0.f;
#pragma unroll
            for (int jj = 0; jj < 4; ++jj) ss[r] += (v[r][jj][0] * v[r][jj][0] + v[r][jj][1] * v[r][jj][1]) + (v[r][jj][2] * v[r][jj][2] + v[r][jj][3] * v[r][jj][3]); }
        ss[0] = row_sum16(ss[0]); ss[1] = row_sum16(ss[1]);
#pragma unroll
        for (int o = 16; o < 64; o <<= 1) { const float t0 = __shfl_xor(ss[0], o), t1 = __shfl_xor(ss[1], o); ss[0] += t0; ss[1] += t1; }
        float rstd[2]; const float* shp[2];
#pragma unroll
        for (int r = 0; r < 2; ++r) { const int row = row0 + r * NGW; const int bsel = (row < TL) ? (row >> 12) : 8;
            rstd[r] = __builtin_amdgcn_rsqf(ss[r] * (1.0f / 1024.0f) + RMS_EPS); shp[r] = mod + (size_t)bsel * 6144 + (which ? 3 : 0) * 1024; }
        float lg[2][8];
#pragma unroll
        for (int r = 0; r < 2; ++r)
#pragma unroll
            for (int e = 0; e < 8; ++e) lg[r][e] = 0.f;
#pragma unroll
        for (int jj = 0; jj < 4; ++jj) { const int col = 4 * ln + 256 * jj;
            const f32x4 gg = *(const f32x4*)(gain + col); f32x4 h[2];
#pragma unroll
            for (int r = 0; r < 2; ++r) { const int row = row0 + r * NGW;
                const f32x4 sh = *(const f32x4*)(shp[r] + col), sc = *(const f32x4*)(shp[r] + 1024 + col);
                h[r] = (v[r][jj] * rstd[r]) * gg * (sc + 1.0f) + sh;
                if (r == 0 || ok1) {
                    if (ROUTER) *(unsigned*)((unsigned char*)H + (size_t)row * 1024 + col) = pg8::pk_fp8x4(h[r][0] * H8SCALE, h[r][1] * H8SCALE, h[r][2] * H8SCALE, h[r][3] * H8SCALE);
                    else { uint2 o; o.x = pkbf(h[r][0], h[r][1]); o.y = pkbf(h[r][2], h[r][3]); *(uint2*)(H + (size_t)row * 1024 + col) = o; } } }
            if (ROUTER) {
#pragma unroll
                for (int q = 0; q < 4; ++q) { const LAS float* rp = rwl + ((jj * 4 + q) * 64 + ln) * 8; const f32x4 ra = *(const LAS f32x4*)rp, rb = *(const LAS f32x4*)(rp + 4);
#pragma unroll
                    for (int r = 0; r < 2; ++r) { lg[r][0] += h[r][q] * ra[0]; lg[r][1] += h[r][q] * ra[1]; lg[r][2] += h[r][q] * ra[2]; lg[r][3] += h[r][q] * ra[3];
                        lg[r][4] += h[r][q] * rb[0]; lg[r][5] += h[r][q] * rb[1]; lg[r][6] += h[r][q] * rb[2]; lg[r][7] += h[r][q] * rb[3]; } } }
        }
        if (ROUTER) {
#pragma unroll
            for (int o = 1; o < 64; o <<= 1) { float t[2][8];
#pragma unroll
                for (int r = 0; r < 2; ++r)
#pragma unroll
                    for (int e = 0; e < 8; ++e) t[r][e] = __shfl_xor(lg[r][e], o);
#pragma unroll
                for (int r = 0; r < 2; ++r)
#pragma unroll
                    for (int e = 0; e < 8; ++e) lg[r][e] += t[r][e]; }
#pragma unroll
            for (int r = 0; r < 2; ++r) { const int row = row0 + r * NGW;
                if (r == 0 || ok1) {
                    int e0 = 0; float v0 = lg[r][0];
#pragma unroll
                    for (int e = 1; e < 8; ++e) if (lg[r][e] > v0) { v0 = lg[r][e]; e0 = e; }
                    int e1 = -1; float v1 = -INFINITY;
#pragma unroll
                    for (int e = 0; e < 8; ++e) if (e != e0 && lg[r][e] > v1) { v1 = lg[r][e]; e1 = e; }
                    const float q0 = 1.0f / (1.0f + __expf(v1 - v0)), q1 = 1.0f - q0;
                    if (ln == 0) { ((int*)(ws + WS_ROUTE + RT_E))[row] = e0 | (e1 << 8); ((float*)(ws + WS_ROUTE + RT_G))[2 * row] = q0; ((float*)(ws + WS_ROUTE + RT_G))[2 * row + 1] = q1; }
                    cnt0 += (e0 == 0) + (e1 == 0); cnt1 += (e0 == 1) + (e1 == 1); cnt2 += (e0 == 2) + (e1 == 2); cnt3 += (e0 == 3) + (e1 == 3);
                    cnt4 += (e0 == 4) + (e1 == 4); cnt5 += (e0 == 5) + (e1 == 5); cnt6 += (e0 == 6) + (e1 == 6); cnt7 += (e0 == 7) + (e1 == 7); } }
        }
    }
#undef PN_LOAD
    if (ROUTER) {
        int* wcnt = (int*)(ws + WS_ROUTE + RT_WCNT);
        if (ln == 0) { int* w = wcnt + (size_t)gw * 8; w[0] = cnt0; w[1] = cnt1; w[2] = cnt2; w[3] = cnt3; w[4] = cnt4; w[5] = cnt5; w[6] = cnt6; w[7] = cnt7; }
    }
}
__device__ __forceinline__ void p_final_combine(Frame& F, int lprev) {
    unsigned char* const ws = launder(F.ws);
    const int tid = (F.wave * 64 + hw_lane()), lane = tid & 63; (void)lane;
    const int gw = F.vcu * NWAVES + F.wave, NGW = F.G * NWAVES;
    const float* route_g = (const float*)(ws + WS_ROUTE + RT_G); const int* route_s = (const int*)(ws + WS_ROUTE + RT_S);
    const bf16* Y = (const bf16*)(ws + WS_AG);
    float g0n = 0.f, g1n = 0.f; int s0n = 0, s1n = 0;
    if (gw < TL) { g0n = route_g[2 * gw]; g1n = route_g[2 * gw + 1]; s0n = route_s[2 * gw]; s1n = route_s[2 * gw + 1]; }
    for (int row = gw; row < TL; row += NGW) {
        const int bsel = row >> 12;
        const float* m5 = (const float*)(ws + WS_MOD) + ((size_t)lprev * 9 + bsel) * 6144 + 5 * 1024;
        const float g0 = g0n, g1 = g1n; const int s0 = s0n, s1 = s1n;
        float* xw = F.out + (size_t)row * 1024; const bf16* xbr = (const bf16*)(ws + WS_XB) + (size_t)row * 1024;
        uint2 xw2[4], y0[4], y1[4];
#pragma unroll
        for (int jj = 0; jj < 4; ++jj) { const int col = 4 * lane + 256 * jj; xw2[jj] = *(const uint2*)(xbr + col); y0[jj] = *(const uint2*)(Y + (size_t)s0 * 1024 + col); y1[jj] = *(const uint2*)(Y + (size_t)s1 * 1024 + col); }
        if (row + NGW < TL) { const int rn = row + NGW; g0n = route_g[2 * rn]; g1n = route_g[2 * rn + 1]; s0n = route_s[2 * rn]; s1n = route_s[2 * rn + 1]; }
#pragma unroll
        for (int jj = 0; jj < 4; ++jj) { const int col = 4 * lane + 256 * jj; const f32x4 mm = *(const f32x4*)(m5 + col);
            f32x4 v = (f32x4){bflo(xw2[jj].x), bfhi(xw2[jj].x), bflo(xw2[jj].y), bfhi(xw2[jj].y)};
            v[0] += mm[0] * (g0 * bflo(y0[jj].x) + g1 * bflo(y1[jj].x)); v[1] += mm[1] * (g0 * bfhi(y0[jj].x) + g1 * bfhi(y1[jj].x));
            v[2] += mm[2] * (g0 * bflo(y0[jj].y) + g1 * bflo(y1[jj].y)); v[3] += mm[3] * (g0 * bfhi(y0[jj].y) + g1 * bfhi(y1[jj].y));
            *(f32x4*)(xw + col) = v; }
    }
}

__device__ __forceinline__ void p_prep(Frame& F, const Args& A, int l) {
    unsigned char* const ws = launder(F.ws);
    const int tid = (F.wave * 64 + hw_lane()), lane = tid & 63; (void)lane;
    const int gw = F.vcu * NWAVES + F.wave, NGW = F.G * NWAVES;
    const unsigned* P = (const unsigned*)(ws + WS_P);
    const float* cs = (const float*)(ws + WS_ROPE);
    bf16* QO = (bf16*)(ws + WS_QO); bf16* KB = (bf16*)(ws + WS_KB); bf16* VB = (bf16*)(ws + WS_VB);
    unsigned* Rst = (unsigned*)(ws + WS_R); unsigned* Kst = (unsigned*)(ws + WS_K); unsigned* Vst = (unsigned*)(ws + WS_V); unsigned* KKst = (unsigned*)(ws + WS_KK); unsigned* LIN = (unsigned*)(ws + WS_LIN);
    const int d0 = 2 * (lane & 31);
    const float qg0 = INP(IN_QG)[l * 64 + d0], qg1 = INP(IN_QG)[l * 64 + d0 + 1], kg0 = INP(IN_KG)[l * 64 + d0], kg1 = INP(IN_KG)[l * 64 + d0 + 1];
    float mu0[15], mu1[15];
#pragma unroll
    for (int i = 0; i < 15; ++i) { mu0[i] = INP(IN_MU)[l * SHIFTW + 128 * i + 2 * lane]; mu1[i] = INP(IN_MU)[l * SHIFTW + 128 * i + 2 * lane + 1]; }
    float kw0[4], kw1[4];
#pragma unroll
    for (int i = 0; i < 4; ++i) { kw0[i] = INP(IN_KKW)[l * 512 + 128 * i + 2 * lane]; kw1[i] = INP(IN_KKW)[l * 512 + 128 * i + 2 * lane + 1]; }
    const float C2 = 0.125f * 1.4426950408889634f;
    const float sgn = (lane & 16) ? 1.0f : -1.0f;
    for (int w0 = gw; w0 * 17 < TT; w0 += NGW) {
        const int rbeg = w0 * 17;
        unsigned cur[21], nxt[21], prv[15];
#pragma unroll
        for (int i = 0; i < 15; ++i) prv[i] = 0u;
        {   const int r = rbeg; const bool lat = r < TL; const int pos = lat ? (r & 4095) : ((r - TL) & 255);
            if (pos != 0) {
#pragma unroll
                for (int i = 0; i < 15; ++i) prv[i] = P[(size_t)(r - 1) * (INWP / 2) + 64 * (i + 6) + lane]; }
#pragma unroll
            for (int i = 0; i < 21; ++i) cur[i] = P[(size_t)r * (INWP / 2) + 64 * i + lane];
        }
        for (int k = 0; k < 17; ++k) {
            const int r = rbeg + k; const bool lat = r < TL; const int pos = lat ? (r & 4095) : ((r - TL) & 255); const int slen = lat ? 4096 : 256;
            const bool has_next = (pos != slen - 1);
            const bool load_next = (k < 16) || has_next;
            if (load_next && r + 1 < TT) {
#pragma unroll
                for (int i = 0; i < 21; ++i) nxt[i] = P[(size_t)(r + 1) * (INWP / 2) + 64 * i + lane];
            } else {
#pragma unroll
                for (int i = 0; i < 21; ++i) nxt[i] = 0u;
            }
            const int b = lat ? (r >> 12) : ((r - TL) >> 8);
            const size_t kvrow = (size_t)b * KVLEN + (lat ? pos : 4096 + pos);
            f32x4 csv = (f32x4){1.f, 0.f, 1.f, 0.f};
            if (lat) csv = *(const f32x4*)(cs + ((size_t)pos * 32 + 2 * (lane & 15)) * 2);
#pragma unroll
            for (int i = 0; i < 5; ++i) {
                float x0 = bflo(cur[i]), x1 = bfhi(cur[i]);
                const float ss = half_sum(x0 * x0 + x1 * x1);
                const float rstd = __builtin_amdgcn_rsqf(ss * (1.0f / 64.0f) + RMS_EPS);
                x0 = x0 * rstd * (i < 4 ? qg0 : kg0); x1 = x1 * rstd * (i < 4 ? qg1 : kg1);
                const float p0 = __shfl_xor(x0, 16), p1 = __shfl_xor(x1, 16);
                const float y0 = x0 * csv[0] + sgn * p0 * csv[1], y1 = x1 * csv[2] + sgn * p1 * csv[3];
                if (i < 4) *(unsigned*)(QO + (size_t)r * 1024 + 128 * i + 2 * lane) = pkbf(y0 * C2, y1 * C2);
                else *(unsigned*)(KB + kvrow * 128 + 2 * lane) = pkbf(y0, y1);
            }
            *(unsigned*)(VB + kvrow * 128 + 2 * lane) = cur[5];
            const float hn = has_next ? 1.0f : 0.0f;
#pragma unroll
            for (int i = 0; i < 15; ++i) {
                const float c0 = bflo(cur[i + 6]), c1 = bfhi(cur[i + 6]);
                const float a0 = bflo(prv[i]) + hn * bflo(nxt[i + 6]), a1 = bfhi(prv[i]) + hn * bfhi(nxt[i + 6]);
                const float s0 = c0 + mu0[i] * (0.5f * a0 - c0), s1 = c1 + mu1[i] * (0.5f * a1 - c1);
                if (i < 4) Rst[(size_t)r * 256 + 64 * i + lane] = pkbf(s0, s1);
                else if (i < 8) { Kst[(size_t)r * 256 + 64 * (i - 4) + lane] = pkbf(s0, s1);
                    const float t0 = s0 * kw0[i - 4], t1 = s1 * kw1[i - 4]; const float q = half_sum(t0 * t0 + t1 * t1); const float rn = __builtin_amdgcn_rsqf(q + 1e-12f);
                    KKst[(size_t)r * 256 + 64 * (i - 4) + lane] = pkbf(t0 * rn, t1 * rn); }
                else if (i < 12) Vst[(size_t)r * 256 + 64 * (i - 8) + lane] = pkbf(s0, s1);
                else if (i == 12) { const float e0 = __builtin_amdgcn_exp2f(2.0f * 1.4426950408889634f * s0), e1 = __builtin_amdgcn_exp2f(2.0f * 1.4426950408889634f * s1);
                    LIN[(size_t)r * (LORA_K / 2) + lane] = pkbf(1.0f - 2.0f * __builtin_amdgcn_rcpf(1.0f + e0), 1.0f - 2.0f * __builtin_amdgcn_rcpf(1.0f + e1)); }
                else if (i == 13) LIN[(size_t)r * (LORA_K / 2) + 64 + lane] = pkbf(s0, s1);
                else LIN[(size_t)r * (LORA_K / 2) + 128 + lane] = pkbf(sigm(s0), sigm(s1));
            }
#pragma unroll
            for (int i = 0; i < 15; ++i) prv[i] = has_next ? cur[i + 6] : 0u;
#pragma unroll
            for (int i = 0; i < 21; ++i) cur[i] = nxt[i];
        }
    }
}

template <int CTRL> __device__ __forceinline__ float dppf(float v) { return __builtin_bit_cast(float, __builtin_amdgcn_update_dpp(0, __builtin_bit_cast(int, v), CTRL, 0xf, 0xf, true)); }
__device__ __forceinline__ float red16(float v) { v += dppf<0xB1>(v); v += dppf<0x4E>(v); v += dppf<0x141>(v); v += dppf<0x128>(v); return v; }
constexpr int SC_TS = 32, SC_W = 352;
__device__ __forceinline__ void p_scan(Frame& F, const Args& A, int l) {
    unsigned char* const ws = launder(F.ws);
    const int tid = (F.wave * 64 + hw_lane()), lane = tid & 63; (void)lane;
    LAS float* buf = (LAS float*)(F.lds + RING_OFF);
    float* OSC = (float*)(ws + WS_OSC);
    constexpr int NCH = KVLEN / SC_TS;
    for (int item = blockIdx.x; item < 256; item += F.G) {
        const int chain = item >> 1, rh = item & 1, dir = chain & 1, bh = chain >> 1, b = bh >> 3, h = bh & 7;
        const int row = tid >> 4, c = tid & 15;
        float S0 = 0.f, S1 = 0.f, S2 = 0.f, S3 = 0.f;
        const bool stg = tid < 352; const int sub = (tid >= 176) ? 1 : 0, pp = tid - 176 * sub, a = pp >> 5, w = pp & 31;
        const unsigned* p1; int pitch1 = 256;
        if (a == 0 || a == 2) p1 = (const unsigned*)(ws + WS_KK) + h * 32 + w;
        else if (a == 1) { p1 = (const unsigned*)(ws + WS_LOUT) + dir * 256 + h * 32 + w; pitch1 = LORA_N / 2; }
        else if (a == 3) p1 = (const unsigned*)(ws + WS_K) + h * 32 + w;
        else if (a == 4) p1 = (const unsigned*)(ws + WS_R) + h * 32 + w;
        else p1 = (const unsigned*)(ws + WS_V) + h * 32 + rh * 16 + (pp - 160);
        const unsigned* p2 = (const unsigned*)(ws + WS_LOUT) + 512 + dir * 256 + h * 32 + w;
        const bool two = (a == 2 || a == 3);
        const int cw = (a == 5) ? 0 : 2 * w;
        const float cw0 = INP(IN_W0)[l * 1024 + dir * 512 + h * 64 + cw], cw1 = INP(IN_W0)[l * 1024 + dir * 512 + h * 64 + cw + 1];
        const float ca0 = INP(IN_A0)[l * 1024 + dir * 512 + h * 64 + cw], ca1 = INP(IN_A0)[l * 1024 + dir * 512 + h * 64 + cw + 1];
        const float ck0 = INP(IN_KA)[l * 512 + h * 64 + cw], ck1 = INP(IN_KA)[l * 512 + h * 64 + cw + 1];
        unsigned st[16], st2[16];
#define SC_TOK(s) ((s) < CTXL ? (TL + b * CTXL + (dir ? (CTXL - 1 - (s)) : (s))) : (b * SEQL + (dir ? (SEQL - 1 - ((s) - CTXL)) : ((s) - CTXL))))
#define SC_LOAD(ci) do { if (stg) { _Pragma("unroll") for (int i = 0; i < 16; ++i) { const int s = (ci) * SC_TS + 2 * i + sub; const size_t tok = (size_t)SC_TOK(s); \
            st[i] = p1[tok * pitch1]; st2[i] = two ? p2[tok * (LORA_N / 2)] : 0u; } } } while (0)
#define SC_STORE(bi) do { if (stg) { _Pragma("unroll") for (int i = 0; i < 16; ++i) { \
            float x0 = bflo(st[i]), x1 = bfhi(st[i]); \
            if (a == 1) { x0 = __builtin_amdgcn_exp2f(-1.4426950408889634f * 0.6065306597126334f * sigm(x0 + cw0)); x1 = __builtin_amdgcn_exp2f(-1.4426950408889634f * 0.6065306597126334f * sigm(x1 + cw1)); } \
            else if (a == 2) { x0 *= sigm(bflo(st2[i]) + ca0); x1 *= sigm(bfhi(st2[i]) + ca1); } \
            else if (a == 3) { x0 *= 1.0f + (sigm(bflo(st2[i]) + ca0) - 1.0f) * ck0; x1 *= 1.0f + (sigm(bfhi(st2[i]) + ca1) - 1.0f) * ck1; } \
            LAS float* dp = buf + ((bi) * SC_TS + 2 * i + sub) * SC_W + 2 * pp; dp[0] = x0; dp[1] = x1; } } } while (0)
        __syncthreads();
        SC_LOAD(0); SC_STORE(0); __syncthreads();
        for (int ci = 0; ci < NCH; ++ci) {
            if (ci + 1 < NCH) SC_LOAD(ci + 1);
            const LAS float* bp = buf + (ci & 1) * SC_TS * SC_W;
#pragma unroll 2
            for (int stp = 0; stp < SC_TS; ++stp) {
                const LAS float* sp = bp + stp * SC_W;
                const f32x4 kk = *(const LAS f32x4*)(sp + 4 * c), w4 = *(const LAS f32x4*)(sp + 64 + 4 * c), bb = *(const LAS f32x4*)(sp + 128 + 4 * c), kd = *(const LAS f32x4*)(sp + 192 + 4 * c), rr = *(const LAS f32x4*)(sp + 256 + 4 * c);
                const float vv = sp[320 + row];
                float sa = (S0 * kk[0] + S1 * kk[1]) + (S2 * kk[2] + S3 * kk[3]); sa = red16(sa);
                S0 = S0 * w4[0] + (vv * kd[0] - sa * bb[0]); S1 = S1 * w4[1] + (vv * kd[1] - sa * bb[1]); S2 = S2 * w4[2] + (vv * kd[2] - sa * bb[2]); S3 = S3 * w4[3] + (vv * kd[3] - sa * bb[3]);
                float o = (S0 * rr[0] + S1 * rr[1]) + (S2 * rr[2] + S3 * rr[3]); o = red16(o);
                if (c == 0) { const int s = ci * SC_TS + stp; OSC[((size_t)dir * TT + (size_t)SC_TOK(s)) * 512 + h * 64 + rh * 32 + row] = o; }
            }
            if (ci + 1 < NCH) SC_STORE((ci + 1) & 1);
            __syncthreads();
        }
#undef SC_TOK
#undef SC_LOAD
#undef SC_STORE
    }
}

__device__ __forceinline__ void p_readout(Frame& F, const Args& A, int l) {
    unsigned char* const ws = launder(F.ws);
    const int tid = (F.wave * 64 + hw_lane()), lane = tid & 63; (void)lane;
    const int gw = F.vcu * NWAVES + F.wave, NGW = F.G * NWAVES;
    const float* OSC = (const float*)(ws + WS_OSC);
    const unsigned* Rst = (const unsigned*)(ws + WS_R); const unsigned* Vst = (const unsigned*)(ws + WS_V); const unsigned* Kst = (const unsigned*)(ws + WS_K); const unsigned* LOUT = (const unsigned*)(ws + WS_LOUT);
    bf16* QO = (bf16*)(ws + WS_QO);
    float rk0[4], rk1[4], gw0[4], gw1[4], gb0[4], gb1[4], ka0[4], ka1[4], aa0[4], aa1[4], ab0[4], ab1[4];
#pragma unroll
    for (int i = 0; i < 4; ++i) { const int cc = 128 * i + 2 * lane, cidx = l * 512 + cc; rk0[i] = INP(IN_RK)[cidx]; rk1[i] = INP(IN_RK)[cidx + 1]; gw0[i] = INP(IN_GNW)[cidx]; gw1[i] = INP(IN_GNW)[cidx + 1]; gb0[i] = INP(IN_GNB)[cidx]; gb1[i] = INP(IN_GNB)[cidx + 1];
        ka0[i] = INP(IN_KA)[cidx]; ka1[i] = INP(IN_KA)[cidx + 1]; aa0[i] = INP(IN_A0)[l * 1024 + cc]; aa1[i] = INP(IN_A0)[l * 1024 + cc + 1]; ab0[i] = INP(IN_A0)[l * 1024 + 512 + cc]; ab1[i] = INP(IN_A0)[l * 1024 + 512 + cc + 1]; }
    for (int row = gw; row < TT; row += NGW) {
#pragma unroll
        for (int i = 0; i < 4; ++i) {
            const size_t off = (size_t)row * 256 + 64 * i + lane; const size_t lo = (size_t)row * (LORA_N / 2) + 64 * i + lane;
            const float2 oa = *(const float2*)(OSC + (size_t)row * 512 + 128 * i + 2 * lane), ob = *(const float2*)(OSC + ((size_t)TT + row) * 512 + 128 * i + 2 * lane);
            const float o0 = oa.x + ob.x, o1 = oa.y + ob.y;
            const float mean = half_sum(o0 + o1) * (1.0f / 64.0f);
            const float d0 = o0 - mean, d1 = o1 - mean;
            const float var = half_sum(d0 * d0 + d1 * d1) * (1.0f / 64.0f);
            const float rs = __builtin_amdgcn_rsqf(var + GN_EPS);
            const unsigned rw = Rst[off], vw = Vst[off], kw = Kst[off], pa = LOUT[lo + 512], pb = LOUT[lo + 768], gwd = LOUT[lo + 1024];
            const float ks0 = bflo(kw) * (2.0f + (sigm(bflo(pa) + aa0[i]) + sigm(bflo(pb) + ab0[i]) - 2.0f) * ka0[i]), ks1 = bfhi(kw) * (2.0f + (sigm(bfhi(pa) + aa1[i]) + sigm(bfhi(pb) + ab1[i]) - 2.0f) * ka1[i]);
            const float bsum = half_sum(bflo(rw) * ks0 * rk0[i] + bfhi(rw) * ks1 * rk1[i]);
            const float y0 = d0 * rs * gw0[i] + gb0[i] + bsum * bflo(vw), y1 = d1 * rs * gw1[i] + gb1[i] + bsum * bfhi(vw);
            *(unsigned*)(QO + (size_t)row * 1024 + 512 + 128 * i + 2 * lane) = pkbf(y0 * bflo(gwd), y1 * bfhi(gwd));
        }
    }
}

__device__ __forceinline__ void p_route(Frame& F, int nrows) {
    unsigned char* const ws = launder(F.ws);
    const int tid = (F.wave * 64 + hw_lane()), lane = tid & 63; (void)lane;
    const int gw = F.vcu * NWAVES + F.wave, NGW = F.G * NWAVES;
    const int* wcnt = (const int*)(ws + WS_ROUTE + RT_WCNT);
    LAS int* pexp = (LAS int*)(F.lds + LT_PEXP); LAS int* npan = (LAS int*)(F.lds + LT_NPAN); LAS int* tmp = (LAS int*)(F.lds + LT_TMP);
    {   const int e = lane & 7, part = lane >> 3;
        const int p = F.wave * 8 + part;
        const int wb = p * (NGW / 64), we = wb + NGW / 64; const int myw0 = F.vcu * NWAVES;
        int tot = 0, before = 0;
#pragma unroll 16
        for (int w = wb; w < we; ++w) { const int cv = wcnt[(size_t)w * 8 + e]; tot += cv; if (w < myw0) before += cv; }
        tmp[p * 16 + e] = tot; tmp[p * 16 + 8 + e] = before;
    }
    __syncthreads();
    if (tid < 8) { int tot = 0, before = 0; for (int p = 0; p < 64; ++p) { tot += tmp[p * 16 + tid]; before += tmp[p * 16 + 8 + tid]; } tmp[1024 + tid] = tot; tmp[1032 + tid] = before; }
    __syncthreads();
    if (tid == 0) { int acc = 0; for (int e = 0; e < 8; ++e) { const int padded = (tmp[1024 + e] + 255) & ~255; tmp[1040 + e] = acc; acc += padded; tmp[1048 + e] = acc; } npan[0] = acc >> 8; }
    __syncthreads();
    for (int p = tid; p < 320; p += NWAVES * 64) { int e = 7; for (int q = 7; q >= 0; --q) if (p * 256 < tmp[1048 + q]) e = q; pexp[p] = e; }
    int base0, base1, base2, base3, base4, base5, base6, base7;
    {   int bsv[8];
#pragma unroll
        for (int e = 0; e < 8; ++e) bsv[e] = tmp[1040 + e] + tmp[1032 + e];
        typedef int i32x4 __attribute__((ext_vector_type(4)));
#pragma unroll
        for (int w = 0; w < 7; ++w) { const i32x4* wp = (const i32x4*)(wcnt + (size_t)(F.vcu * NWAVES + w) * 8); const i32x4 c0 = wp[0], c1 = wp[1]; const int mk = (w < F.wave) ? 1 : 0;
            bsv[0] += mk * c0[0]; bsv[1] += mk * c0[1]; bsv[2] += mk * c0[2]; bsv[3] += mk * c0[3]; bsv[4] += mk * c1[0]; bsv[5] += mk * c1[1]; bsv[6] += mk * c1[2]; bsv[7] += mk * c1[3]; }
        base0 = bsv[0]; base1 = bsv[1]; base2 = bsv[2]; base3 = bsv[3]; base4 = bsv[4]; base5 = bsv[5]; base6 = bsv[6]; base7 = bsv[7];
    }
    const int* route_e = (const int*)(ws + WS_ROUTE + RT_E); int* route_s = (int*)(ws + WS_ROUTE + RT_S);
    const unsigned char* H = (const unsigned char*)F.out; unsigned char* AG = ws + WS_AG8;
    int ee_n = 0; v4u a_n = (v4u){0u, 0u, 0u, 0u};
    if (gw < nrows) { ee_n = route_e[gw]; a_n = ((const v4u*)(H + (size_t)gw * 1024))[lane]; }
    for (int row = gw; row < nrows; row += NGW) {
        const int ee = ee_n; const v4u a = a_n; const int e0 = ee & 255, e1 = ee >> 8;
        if (row + NGW < nrows) { ee_n = route_e[row + NGW]; a_n = ((const v4u*)(H + (size_t)(row + NGW) * 1024))[lane]; }
        int s0 = 0, s1 = 0;
#define RT_TAKE(E, B) do { if (e0 == E) { s0 = B; B += 1; } if (e1 == E) { s1 = B; B += 1; } } while (0)
        RT_TAKE(0, base0); RT_TAKE(1, base1); RT_TAKE(2, base2); RT_TAKE(3, base3); RT_TAKE(4, base4); RT_TAKE(5, base5); RT_TAKE(6, base6); RT_TAKE(7, base7);
#undef RT_TAKE
        if (lane == 0) { route_s[2 * row] = s0; route_s[2 * row + 1] = s1; }
        ((v4u*)(AG + (size_t)s0 * 1024))[lane] = a; ((v4u*)(AG + (size_t)s1 * 1024))[lane] = a;
    }
    __syncthreads();
}

__device__ __forceinline__ void p_attn(Frame& F, char* ldsg, bool ctx_on) {
    unsigned char* const ws = launder(F.ws);
    const int tid = (F.wave * 64 + hw_lane()), lane = tid & 63; (void)lane;
    typedef attn_body::bf16 abf;
    const abf* Q = (const abf*)(ws + WS_QO); const abf* K = (const abf*)(ws + WS_KB); const abf* V = (const abf*)(ws + WS_VB); abf* O = (abf*)(ws + WS_QO);
    const int per = (1024 + F.G - 1) / F.G;
    for (int i = 0; i < per; ++i) { const int un = F.vcu * per + i; if (un >= 1024) break;
        const int bh = un >> 4, qb = un & 15, b = bh >> 3, h = bh & 7;
        attn_body::attn_unit<8>((long)b * SEQL + qb * 256, h * 64, (long)b * KVLEN, (h >> 2) * 64, KVLEN / 64, Q, K, V, O, ldsg, F.wave); }
    if (ctx_on) for (int un = F.vcu; un < 64; un += F.G) { const int b = un >> 3, h = un & 7;
        attn_body::attn_unit<8>((long)TL + b * CTXL, h * 64, (long)b * KVLEN + SEQL, (h >> 2) * 64, CTXL / 64, Q, K, V, O, ldsg, F.wave); }
}

typedef float f32x16 __attribute__((ext_vector_type(16)));
typedef unsigned u32x2 __attribute__((ext_vector_type(2)));
constexpr int SCH = 64, NCHK = KVLEN / SCH, NITEM = 128 * NCHK;
constexpr int LSTR = 144;
constexpr int L_AKK = 0, L_AR = 9216, L_AK = 18432, L_AB = 27648, L_TK = 36864, L_TB = 46080, L_TV = 55296, L_TW1 = 64512, L_TU = 73728, L_MLK = 82944, L_MMB = 92160, L_MMK = 101376;
constexpr int L_FLB = 110592, L_GC = 126976, L_TII = 127232, L_FX = L_AK;
static_assert(L_TII + 2048 <= RING_BYTES, "scan LDS map");
__device__ __forceinline__ unsigned short bf1(float x) { return (unsigned short)(pkbf(x, 0.f) & 0xffffu); }
__device__ __forceinline__ bf16x8 ldsv8(const LAS unsigned char* p) { return *(const LAS bf16x8*)p; }
template <bool SWA = false, bool SWB = false>
__device__ __forceinline__ f32x16 tile32(const LAS unsigned char* Ab, const LAS unsigned char* Bb, int mi, int ni, int r, int h, f32x16 acc) {
    const int ra = 32 * mi + r, rb = 32 * ni + r; const int xa = SWA ? ((ra >> 3) & 7) : 0, xb = SWB ? ((rb >> 3) & 7) : 0;
#pragma unroll
    for (int kb = 0; kb < 4; ++kb) { const bf16x8 a = ldsv8(Ab + ra * LSTR + (((2 * kb + h) ^ xa) << 4)), b = ldsv8(Bb + rb * LSTR + (((2 * kb + h) ^ xb) << 4));
        acc = __builtin_amdgcn_mfma_f32_32x32x16_bf16(a, b, acc, 0, 0, 0); }
    return acc;
}
__device__ __forceinline__ int jperm(int j) { return (((j >> 2) & 3) << 4) | (((j >> 5) & 1) << 3) | (((j >> 4) & 1) << 2) | (j & 3); }
#define CROW(reg, h) (((reg) & 3) + 8 * ((reg) >> 2) + 4 * (h))


#if DEBUG_NAN
#define DBG_BF(k, off, nbytes) do { unsigned bad_ = 0; for (int i_ = tid; i_ < (nbytes) / 2; i_ += 512) { const int row_ = i_ / 72, col_ = i_ % 72; if (col_ < 64) { const float v_ = __builtin_bit_cast(float, (unsigned)(*(const LAS unsigned short*)(L + (off) + row_ * LSTR + col_ * 2)) << 16); if (!(fabsf(v_) < 1e30f)) ++bad_; } } if (bad_) atomicAdd((unsigned*)(F.ctl + 16 + (k)), bad_); } while (0)
#define DBG_F32(k, off, n) do { unsigned bad_ = 0; for (int i_ = tid; i_ < (n); i_ += 512) { const float v_ = ((const LAS float*)(L + (off)))[i_]; if (!(fabsf(v_) < 1e30f)) ++bad_; } if (bad_) atomicAdd((unsigned*)(F.ctl + 16 + (k)), bad_); } while (0)
#else
#define DBG_BF(k, off, nbytes) do {} while (0)
#define DBG_F32(k, off, n) do {} while (0)
#endif
#define WG_BAR() do { asm volatile("s_waitcnt lgkmcnt(0)" ::: "memory"); __builtin_amdgcn_s_barrier(); asm volatile("" ::: "memory"); } while (0)
template <int CTRL, int RMASK> __device__ __forceinline__ float dppm(float v) { return __builtin_bit_cast(float, __builtin_amdgcn_update_dpp(0, __builtin_bit_cast(int, v), CTRL, RMASK, 0xf, true)); }
__device__ __forceinline__ float wave_incl_scan(float x) {
    x += dppm<0x111, 0xf>(x); x += dppm<0x112, 0xf>(x); x += dppm<0x114, 0xf>(x); x += dppm<0x118, 0xf>(x);
    x += __builtin_bit_cast(float, __builtin_amdgcn_update_dpp(0, __builtin_bit_cast(int, x), 0x142, 0xa, 0xf, false));
    x += __builtin_bit_cast(float, __builtin_amdgcn_update_dpp(0, __builtin_bit_cast(int, x), 0x143, 0xc, 0xf, false));
    return x;
}
struct S1In { v4u kk, r, k, v, pw, pa; f32x4 ka[2]; };
__device__ __forceinline__ void s1_item(Frame& F, unsigned char* const ws, const int lane, const int wv, const int l, const int item, const S1In& cur, S1In& nxt, const float* w0b, const float* a0b, const float* kab, unsigned long long (&cy)[6]) {
#if CYSEL >= 0
#define CY(k) do { const unsigned long long now_ = __builtin_readcyclecounter(); cy[k] += now_ - cy[5]; cy[5] = now_; } while (0)
#else
#define CY(k) do {} while (0)
#endif
    LAS unsigned char* L = F.lds + RING_OFF;
    const bf16* KKst = (const bf16*)(ws + WS_KK); const bf16* Kst = (const bf16*)(ws + WS_K); const bf16* Rst = (const bf16*)(ws + WS_R); const bf16* Vst = (const bf16*)(ws + WS_V); const bf16* LOUT = (const bf16*)(ws + WS_LOUT);
    bf16* PT = (bf16*)(ws + WS_SPT); bf16* GG = (bf16*)(ws + WS_SG); bf16* QQ = (bf16*)(ws + WS_SQ); float* OSC = (float*)(ws + WS_OSC);
    const int r = lane & 31, h = lane >> 5;
#define S1_ITEM(item_) const int chain = (item_) / NCHK, c = (item_) - chain * NCHK, dir = chain & 1, bh = chain >> 1, b = bh >> 3, hd = bh & 7; const int s0 = c * SCH; const int dsg = dir ? -1 : 1; \
        const int tok0 = (s0 < CTXL) ? (TL + b * CTXL + (dir ? (CTXL - 1 - s0) : s0)) : (b * SEQL + (dir ? (SEQL - 1 - (s0 - CTXL)) : (s0 - CTXL)));
#define S1_TOUCH(D) asm volatile("" :: "v"(D.kk), "v"(D.r), "v"(D.k), "v"(D.v), "v"(D.pw), "v"(D.pa), "v"(D.ka[0]), "v"(D.ka[1]))
#define S1_LOAD(D, item_) do { S1_ITEM(item_) const size_t tokr = (size_t)(tok0 + dsg * (8 * wv + (lane >> 3))); const size_t o5 = tokr * 512 + hd * 64 + 8 * (lane & 7); \
        D.kk = *(const v4u*)(KKst + o5); D.r = *(const v4u*)(Rst + o5); D.k = *(const v4u*)(Kst + o5); D.v = *(const v4u*)(Vst + o5); \
        D.pw = *(const v4u*)(LOUT + tokr * LORA_N + dir * 512 + hd * 64 + 8 * (lane & 7)); D.pa = *(const v4u*)(LOUT + tokr * LORA_N + 1024 + dir * 512 + hd * 64 + 8 * (lane & 7)); \
        { D.ka[0] = *(const f32x4*)(kab + hd * 64 + 8 * (lane & 7)); D.ka[1] = *(const f32x4*)(kab + hd * 64 + 8 * (lane & 7) + 4); } } while (0)
    {
        S1_ITEM(item)
        {   const v4u kk8 = cur.kk, r8 = cur.r, k8 = cur.k, v8 = cur.v, pw8 = cur.pw, pa8 = cur.pa; const int jg = lane & 7, t = 8 * wv + (lane >> 3);
            const float kap[8] = {cur.ka[0][0], cur.ka[0][1], cur.ka[0][2], cur.ka[0][3], cur.ka[1][0], cur.ka[1][1], cur.ka[1][2], cur.ka[1][3]};
            LAS float* tot = (LAS float*)(L + L_TII);
            float lw[8], av[8], lam[8];
#pragma unroll
            for (int e = 0; e < 8; ++e) { const unsigned pw = pw8[e >> 1], pa = pa8[e >> 1]; const float zw = (e & 1) ? bfhi(pw) : bflo(pw), za = (e & 1) ? bfhi(pa) : bflo(pa);
                lw[e] = zw; av[e] = za; lam[e] = lw[e]; }
#pragma unroll
            for (int sh = 8; sh <= 32; sh <<= 1) { float y[8]; const float mk = (lane >= sh) ? 1.0f : 0.0f;
#pragma unroll
                for (int e = 0; e < 8; ++e) y[e] = __shfl_up(lam[e], sh);
#pragma unroll
                for (int e = 0; e < 8; ++e) lam[e] = __builtin_fmaf(mk, y[e], lam[e]); }
            if (lane >= 56) { *(LAS f32x4*)(tot + wv * 64 + 8 * jg) = (f32x4){lam[0], lam[1], lam[2], lam[3]}; *(LAS f32x4*)(tot + wv * 64 + 8 * jg + 4) = (f32x4){lam[4], lam[5], lam[6], lam[7]}; }
            if (item + F.G < NITEM) S1_LOAD(nxt, item + F.G);
            WG_BAR();
            for (int w = 0; w < wv; ++w) { const f32x4 q0 = *(const LAS f32x4*)(tot + w * 64 + 8 * jg), q1 = *(const LAS f32x4*)(tot + w * 64 + 8 * jg + 4);
                lam[0] += q0[0]; lam[1] += q0[1]; lam[2] += q0[2]; lam[3] += q0[3]; lam[4] += q1[0]; lam[5] += q1[1]; lam[6] += q1[2]; lam[7] += q1[3]; }
            v4u wkk, wrr, wkd, wbd; float en8[8];
#pragma unroll
            for (int p = 0; p < 4; ++p) { float okk[2], orr[2], okd[2], obd[2];
#pragma unroll
                for (int u = 0; u < 2; ++u) { const int e = 2 * p + u;
                    const unsigned xkk = kk8[p], xr = r8[p], xk = k8[p];
                    const float kkv = u ? bfhi(xkk) : bflo(xkk), rv = u ? bfhi(xr) : bflo(xr), kv = u ? bfhi(xk) : bflo(xk);
                    const float eNp = __builtin_amdgcn_exp2f(lw[e] - lam[e]), eN = __builtin_amdgcn_exp2f(-lam[e]), eP = __builtin_amdgcn_exp2f(lam[e]);
                    okk[u] = kkv * eNp; orr[u] = rv * eN; okd[u] = kv * __builtin_fmaf(av[e], kap[e], 1.0f - kap[e]) * eP; obd[u] = kkv * av[e] * eP;
                    en8[e] = eN; }
                wkk[p] = pkbf(okk[0], okk[1]); wrr[p] = pkbf(orr[0], orr[1]); wkd[p] = pkbf(okd[0], okd[1]); wbd[p] = pkbf(obd[0], obd[1]); }
            if (t == SCH - 1) { *(LAS f32x4*)((LAS float*)(L + L_GC) + 8 * jg) = (f32x4){en8[0], en8[1], en8[2], en8[3]}; *(LAS f32x4*)((LAS float*)(L + L_GC) + 8 * jg + 4) = (f32x4){en8[4], en8[5], en8[6], en8[7]}; }
            *(LAS v4u*)(L + L_AKK + t * LSTR + jg * 16) = wkk; *(LAS v4u*)(L + L_AR + t * LSTR + jg * 16) = wrr; *(LAS v4u*)(L + L_AK + t * LSTR + jg * 16) = wkd; *(LAS v4u*)(L + L_AB + t * LSTR + jg * 16) = wbd;
#pragma unroll
            for (int e = 0; e < 8; ++e) { const int j = 8 * jg + e; const unsigned wk = wkd[e >> 1], wb = wbd[e >> 1], wvv = v8[e >> 1];
                const int to = j * LSTR + ((wv ^ jg) << 4) + (lane >> 3) * 2;
                *(LAS unsigned short*)(L + L_TK + to) = (unsigned short)((e & 1) ? (wk >> 16) : (wk & 0xffffu));
                *(LAS unsigned short*)(L + L_TB + to) = (unsigned short)((e & 1) ? (wb >> 16) : (wb & 0xffffu));
                *(LAS unsigned short*)(L + L_TV + to) = (unsigned short)((e & 1) ? (wvv >> 16) : (wvv & 0xffffu)); }
        }
        WG_BAR();
        CY(0);
#pragma unroll
        for (int jj = 0; jj < 2; ++jj) {
            const int job = 2 * wv + jj, m = job >> 2, si = (job >> 1) & 1, ti = job & 1;
            f32x16 acc = {};
            if (!(si == 1 && ti == 0)) acc = tile32(L + ((m & 1) ? L_AK : L_AB), L + (m < 2 ? L_AKK : L_AR), si, ti, r, h, acc);
            const int tt = 32 * ti + r;
#pragma unroll
            for (int g = 0; g < 4; ++g) { const int sb = 32 * si + 8 * g + 4 * h; float vv[4];
#pragma unroll
                for (int i = 0; i < 4; ++i) { const int s = sb + i; const bool keep = (m < 2) ? (s < tt) : (s <= tt); vv[i] = keep ? acc[4 * g + i] : 0.f; }
                if (m == 0) *(LAS f32x4*)((LAS float*)(L + L_FLB) + tt * 64 + sb) = (f32x4){vv[0], vv[1], vv[2], vv[3]};
                else *(LAS u32x2*)(L + (m == 1 ? L_MLK : (m == 2 ? L_MMB : L_MMK)) + tt * LSTR + sb * 2) = (u32x2){pkbf(vv[0], vv[1]), pkbf(vv[2], vv[3])}; }
        }
        WG_BAR();
        CY(1);
        f32x16 acc_o1 = {}, ag = {};
        {   const int q4 = wv & 3, mi = q4 >> 1, ni = q4 & 1;
            if (wv < 4) { f32x16 acc = {}; acc = tile32<false, true>(L + L_MLK, L + L_TV, mi, ni, r, h, acc);
#pragma unroll
                for (int reg = 0; reg < 16; ++reg) ((LAS float*)(L + L_FX))[(32 * mi + CROW(reg, h)) * 64 + 32 * ni + r] = acc[reg];
                const int col = lane & 15; const LAS float* lb = (const LAS float*)(L + L_FLB) + (16 * wv) * 64 + 16 * wv; float x[16];
#pragma unroll
                for (int tt = 0; tt < 16; ++tt) { float a = (tt == col) ? 1.0f : 0.0f, a2 = 0.0f;
#pragma unroll
                    for (int s4 = 0; s4 < tt; s4 += 4) { const f32x4 lv = *(const LAS f32x4*)(lb + tt * 64 + s4);
#pragma unroll
                        for (int u = 0; u < 4; ++u) if (s4 + u < tt) { if (u & 1) a2 -= lv[u] * x[s4 + u]; else a -= lv[u] * x[s4 + u]; } }
                    x[tt] = a + a2; }
                if (lane < 16) {
#pragma unroll
                    for (int tt = 0; tt < 16; ++tt) *(LAS unsigned short*)(L + L_TII + wv * 512 + tt * 32 + col * 2) = bf1(x[tt]); }
            } else { acc_o1 = tile32<true, false>(L + L_TV, L + L_MMK, mi, ni, r, h, acc_o1);
                ag = tile32<true, true>(L + L_TK, L + L_TV, mi, ni, r, h, ag); }
        }
        WG_BAR();
        CY(2);
        {   const int cc = lane & 15, q = lane >> 4; const bool isw = wv < 4; const int colb = 16 * (wv & 3) + cc;
            f32x4 U[4], R0[4];
            if (isw) {
#pragma unroll
                for (int i = 0; i < 4; ++i)
#pragma unroll
                    for (int reg = 0; reg < 4; ++reg) { const int tt = 16 * i + 4 * q + reg; R0[i][reg] = __builtin_bit_cast(float, (unsigned)(*(const LAS unsigned short*)(L + L_AKK + tt * LSTR + colb * 2)) << 16); }
            } else {
#pragma unroll
                for (int i = 0; i < 4; ++i)
#pragma unroll
                    for (int reg = 0; reg < 4; ++reg) { const int tt = 16 * i + 4 * q + reg; R0[i][reg] = ((const LAS float*)(L + L_FX))[tt * 64 + colb]; }
            }
#pragma unroll
            for (int i = 0; i < 4; ++i) {
                f32x4 R = R0[i];
#pragma unroll
                for (int kp = 0; kp < 2; ++kp) { if (2 * kp < i) {
                    const int k1 = 2 * kp, k2 = 2 * kp + 1; const bool two = (k2 < i);
                    const LAS float* lrow = (const LAS float*)(L + L_FLB) + (16 * i + cc) * 64;
                    const f32x4 la = *(const LAS f32x4*)(lrow + 16 * k1 + 4 * q); f32x4 lb2 = {0.f, 0.f, 0.f, 0.f}; if (two) lb2 = *(const LAS f32x4*)(lrow + 16 * k2 + 4 * q);
                    const v4u aw = (v4u){pkbf(-la[0], -la[1]), pkbf(-la[2], -la[3]), pkbf(-lb2[0], -lb2[1]), pkbf(-lb2[2], -lb2[3])};
                    const f32x4 u1 = U[k1]; f32x4 u2 = {0.f, 0.f, 0.f, 0.f}; if (two) u2 = U[k2];
                    const v4u bh_ = (v4u){pkbf(u1[0], u1[1]), pkbf(u1[2], u1[3]), pkbf(u2[0], u2[1]), pkbf(u2[2], u2[3])};
                    R = __builtin_amdgcn_mfma_f32_16x16x32_bf16(__builtin_bit_cast(bf16x8, aw), __builtin_bit_cast(bf16x8, bh_), R, 0, 0, 0); } }
                const u32x2 tw = *(const LAS u32x2*)(L + L_TII + i * 512 + cc * 32 + q * 8);
                const v4u ta = (v4u){tw.x, tw.y, 0u, 0u};
                const v4u rh = (v4u){pkbf(R[0], R[1]), pkbf(R[2], R[3]), 0u, 0u};
                f32x4 u = {0.f, 0.f, 0.f, 0.f};
                u = __builtin_amdgcn_mfma_f32_16x16x32_bf16(__builtin_bit_cast(bf16x8, ta), __builtin_bit_cast(bf16x8, rh), u, 0, 0, 0);
                U[i] = u;
                *(LAS u32x2*)(L + (isw ? L_TW1 : L_TU) + colb * LSTR + (16 * i + 4 * q) * 2) = (u32x2){pkbf(u[0], u[1]), pkbf(u[2], u[3])};
            }
        }
        WG_BAR();
        CY(3);
        S1_TOUCH(nxt);
        {   const int q4 = wv & 3, mi = q4 >> 1, ni = q4 & 1; const LAS float* gc = (const LAS float*)(L + L_GC);
            if (wv < 4) {
                f32x16 acc = {}; acc = tile32<false, true>(L + L_TW1, L + L_TB, mi, ni, r, h, acc);
                const int jp = 32 * ni + r; const float gj = gc[jp]; bf16* pt = PT + (size_t)item * 4096 + (size_t)jp * 64;
#pragma unroll
                for (int gp2 = 0; gp2 < 2; ++gp2) { unsigned pw[4];
#pragma unroll
                    for (int u = 0; u < 2; ++u) { const int g = gp2 + 2 * u, j0 = 32 * mi + 8 * g + 4 * h; float pv[4];
#pragma unroll
                        for (int i = 0; i < 4; ++i) pv[i] = (((j0 + i) == jp ? 1.0f : 0.0f) - acc[4 * g + i]) * gj;
                        pw[2 * u] = pkbf(pv[0], pv[1]); pw[2 * u + 1] = pkbf(pv[2], pv[3]); }
                    *(v4u*)(pt + 16 * (2 * gp2 + h) + 8 * mi) = (v4u){pw[0], pw[1], pw[2], pw[3]}; }
                f32x16 acq = {}; acq = tile32(L + L_TW1, L + L_MMB, mi, ni, r, h, acq);
                const int tt = 32 * ni + r; bf16* qq = QQ + (size_t)item * 4096 + (size_t)tt * 64;
#pragma unroll
                for (int gp2 = 0; gp2 < 2; ++gp2) { unsigned qw[4];
#pragma unroll
                    for (int u = 0; u < 2; ++u) { const int g = gp2 + 2 * u, j0 = 32 * mi + 8 * g + 4 * h; const u32x2 rw = *(const LAS u32x2*)(L + L_AR + tt * LSTR + j0 * 2);
                        qw[2 * u] = pkbf(bflo(rw.x) - acq[4 * g], bfhi(rw.x) - acq[4 * g + 1]); qw[2 * u + 1] = pkbf(bflo(rw.y) - acq[4 * g + 2], bfhi(rw.y) - acq[4 * g + 3]); }
                    *(v4u*)(qq + 16 * (2 * gp2 + h) + 8 * mi) = (v4u){qw[0], qw[1], qw[2], qw[3]}; }
            } else {
                f32x16 acc = {}; acc = tile32(L + L_TU, L + L_MMB, mi, ni, r, h, acc);
                const int tt = 32 * ni + r; bf16* op = (bf16*)OSC + ((size_t)dir * TT + (size_t)(tok0 + dsg * tt)) * 512 + hd * 64;
#pragma unroll
                for (int gp2 = 0; gp2 < 2; ++gp2) { unsigned ow_[4];
#pragma unroll
                    for (int u = 0; u < 2; ++u) { const int g = gp2 + 2 * u; ow_[2 * u] = pkbf(acc_o1[4 * g] - acc[4 * g], acc_o1[4 * g + 1] - acc[4 * g + 1]); ow_[2 * u + 1] = pkbf(acc_o1[4 * g + 2] - acc[4 * g + 2], acc_o1[4 * g + 3] - acc[4 * g + 3]); }
                    *(v4u*)(op + 16 * (2 * gp2 + h) + 8 * mi) = (v4u){ow_[0], ow_[1], ow_[2], ow_[3]}; }
                f32x16 ah = {}; ah = tile32<true, false>(L + L_TB, L + L_TU, mi, ni, r, h, ah);
                const int v = 32 * ni + r; bf16* gp = GG + (size_t)item * 4096 + (size_t)v * 64;
#pragma unroll
                for (int gp2 = 0; gp2 < 2; ++gp2) { unsigned gw_[4];
#pragma unroll
                    for (int u = 0; u < 2; ++u) { const int g = gp2 + 2 * u, j0 = 32 * mi + 8 * g + 4 * h; const f32x4 gj = *(const LAS f32x4*)(gc + j0); float gv[4];
#pragma unroll
                        for (int i = 0; i < 4; ++i) gv[i] = (ag[4 * g + i] - ah[4 * g + i]) * gj[i];
                        gw_[2 * u] = pkbf(gv[0], gv[1]); gw_[2 * u + 1] = pkbf(gv[2], gv[3]); }
                    *(v4u*)(gp + 16 * (2 * gp2 + h) + 8 * mi) = (v4u){gw_[0], gw_[1], gw_[2], gw_[3]}; }
            }
        }
        WG_BAR();
        CY(4);
    }
#undef CY
}
__device__ __forceinline__ void p_scan1(Frame& F, const Args& A, int l) {
    unsigned char* const ws = launder(F.ws);
    const int tid = (F.wave * 64 + hw_lane()), lane = tid & 63, wv = F.wave;
    const bf16* KKst = (const bf16*)(ws + WS_KK); const bf16* Kst = (const bf16*)(ws + WS_K); const bf16* Rst = (const bf16*)(ws + WS_R); const bf16* Vst = (const bf16*)(ws + WS_V); const bf16* LOUT = (const bf16*)(ws + WS_LOUT);
    const float* w0b = INP(IN_W0) + l * 1024; const float* a0b = INP(IN_A0) + l * 1024; const float* kab = INP(IN_KA) + l * 512;
    S1In sa = {}, sb = {}; unsigned long long cy[6] = {0, 0, 0, 0, 0, 0};
#if CYSEL >= 0
    cy[5] = __builtin_readcyclecounter();
#endif
    if ((int)blockIdx.x < NITEM) S1_LOAD(sa, (int)blockIdx.x);
    S1_TOUCH(sa);
    for (int item = blockIdx.x; item < NITEM; item += 2 * F.G) {
        s1_item(F, ws, lane, wv, l, item, sa, sb, w0b, a0b, kab, cy);
        if (item + F.G < NITEM) s1_item(F, ws, lane, wv, l, item + F.G, sb, sa, w0b, a0b, kab, cy);
    }
#if CYSEL >= 0
    if (blockIdx.x == 0 && F.wave == 0 && hw_lane() == 0) { unsigned long long* cs_ = (unsigned long long*)(F.ws + WS_CTL + 40960); for (int k = 0; k < 5; ++k) cs_[k] += cy[k]; }
#endif
}
#undef S1_ITEM
#undef S1_LOAD
#undef S1_TOUCH

struct S2Ops { v4u pa[4][2]; v4u gt[2]; };
__device__ __forceinline__ void s2_load(S2Ops& o, const bf16* PT, const bf16* GG, int chain, int c, int cc, int q, int v) {
    const size_t ib = ((size_t)chain * NCHK + c) * 4096;
#pragma unroll
    for (int J = 0; J < 4; ++J) { const bf16* prow = PT + ib + (size_t)(16 * J + cc) * 64;
#pragma unroll
        for (int kb = 0; kb < 2; ++kb) o.pa[J][kb] = *(const v4u*)(prow + 16 * q + 8 * kb); }
#pragma unroll
    for (int kb = 0; kb < 2; ++kb) o.gt[kb] = *(const v4u*)(GG + ib + (size_t)v * 64 + 16 * q + 8 * kb);
}
__device__ __forceinline__ void s2_step(f32x4 (&St)[4], const S2Ops& o, bf16* S0, int chain, int c, int q, int v) {
    const size_t ib = ((size_t)chain * NCHK + c) * 4096;
    v4u bh_[2], bl_[2];
#pragma unroll
    for (int kb = 0; kb < 2; ++kb) { const f32x4 u1 = St[2 * kb], u2 = St[2 * kb + 1];
        bh_[kb] = (v4u){pkbf(u1[0], u1[1]), pkbf(u1[2], u1[3]), pkbf(u2[0], u2[1]), pkbf(u2[2], u2[3])};
        bl_[kb] = (v4u){pkbf(u1[0] - bflo(bh_[kb].x), u1[1] - bfhi(bh_[kb].x)), pkbf(u1[2] - bflo(bh_[kb].y), u1[3] - bfhi(bh_[kb].y)), pkbf(u2[0] - bflo(bh_[kb].z), u2[1] - bfhi(bh_[kb].z)), pkbf(u2[2] - bflo(bh_[kb].w), u2[3] - bfhi(bh_[kb].w))};
        *(v4u*)(S0 + ib + (size_t)v * 64 + 16 * q + 8 * kb) = bh_[kb]; }
#pragma unroll
    for (int J = 0; J < 4; ++J) { const unsigned g0 = (J & 1) ? o.gt[J >> 1].z : o.gt[J >> 1].x, g1 = (J & 1) ? o.gt[J >> 1].w : o.gt[J >> 1].y; f32x4 acc = (f32x4){bflo(g0), bfhi(g0), bflo(g1), bfhi(g1)};
#pragma unroll
        for (int kb = 0; kb < 2; ++kb) { const v4u aw = o.pa[J][kb];
            acc = __builtin_amdgcn_mfma_f32_16x16x32_bf16(__builtin_bit_cast(bf16x8, aw), __builtin_bit_cast(bf16x8, bh_[kb]), acc, 0, 0, 0);
            acc = __builtin_amdgcn_mfma_f32_16x16x32_bf16(__builtin_bit_cast(bf16x8, aw), __builtin_bit_cast(bf16x8, bl_[kb]), acc, 0, 0, 0); }
        St[J] = acc; }
}
__device__ __forceinline__ void p_scan2(Frame& F) {
    unsigned char* const ws = launder(F.ws);
    const int tid = (F.wave * 64 + hw_lane()), lane = tid & 63;
    const bf16* PT = (const bf16*)(ws + WS_SPT); const bf16* GG = (const bf16*)(ws + WS_SG); bf16* S0 = (bf16*)F.out;
    const int cc = lane & 15, q = lane >> 4;
    static_assert(NCHK % 4 == 0, "stage 2 ring depth");
    for (int wi = F.wave * F.G + (int)blockIdx.x; wi < 512; wi += NWAVES * F.G) {
        const int chain = wi >> 2, vg = wi & 3; const int v = 16 * vg + cc;
        f32x4 St[4];
#pragma unroll
        for (int J = 0; J < 4; ++J) St[J] = (f32x4){0.f, 0.f, 0.f, 0.f};
        S2Ops o0, o1, o2, o3;
        s2_load(o0, PT, GG, chain, 0, cc, q, v); s2_load(o1, PT, GG, chain, 1, cc, q, v); s2_load(o2, PT, GG, chain, 2, cc, q, v);
        for (int c = 0; c < NCHK; c += 4) {
            s2_load(o3, PT, GG, chain, c + 3, cc, q, v);                 s2_step(St, o0, S0, chain, c, q, v);
            if (c + 4 < NCHK) s2_load(o0, PT, GG, chain, c + 4, cc, q, v); s2_step(St, o1, S0, chain, c + 1, q, v);
            if (c + 5 < NCHK) s2_load(o1, PT, GG, chain, c + 5, cc, q, v); s2_step(St, o2, S0, chain, c + 2, q, v);
            if (c + 6 < NCHK) s2_load(o2, PT, GG, chain, c + 6, cc, q, v); s2_step(St, o3, S0, chain, c + 3, q, v);
        }
    }
}

__device__ __forceinline__ void p_scan3(Frame& F) {
    unsigned char* const ws = launder(F.ws);
    const int tid = (F.wave * 64 + hw_lane()), lane = tid & 63;
    const bf16* QQ = (const bf16*)(ws + WS_SQ); const bf16* S0 = (const bf16*)F.out; float* OSC = (float*)(ws + WS_OSC);
    const int gw = F.vcu * NWAVES + F.wave, NGW = F.G * NWAVES; const int r = lane & 31, h = lane >> 5;
    bf16x8 sa[4], qb[4], sa2[4], qb2[4]; f32x4 ov[4], ov2[4]; float* op = nullptr; float* op2 = nullptr;
#define S3_LOAD(SA, QB, OV, OP, job_) do { const int item = (job_) >> 2, mi = ((job_) >> 1) & 1, ni = (job_) & 1; \
        const int chain = item / NCHK, c = item - chain * NCHK, dir = chain & 1, bh = chain >> 1, b = bh >> 3, hd = bh & 7; const int s0 = c * SCH + 32 * ni + r; \
        const int tok = (s0 < CTXL) ? (TL + b * CTXL + (dir ? (CTXL - 1 - s0) : s0)) : (b * SEQL + (dir ? (SEQL - 1 - (s0 - CTXL)) : (s0 - CTXL))); \
        const bf16* sp = S0 + (size_t)item * 4096 + (size_t)(32 * mi + r) * 64 + 8 * h; const bf16* qp = QQ + (size_t)item * 4096 + (size_t)(32 * ni + r) * 64 + 8 * h; \
        _Pragma("unroll") for (int kb = 0; kb < 4; ++kb) { SA[kb] = *(const bf16x8*)(sp + 16 * kb); QB[kb] = *(const bf16x8*)(qp + 16 * kb); } \
        OP = OSC + ((size_t)dir * TT + (size_t)tok) * 512 + hd * 64 + 32 * mi + 4 * h; \
        _Pragma("unroll") for (int g = 0; g < 4; ++g) OV[g] = *(const f32x4*)(OP + 8 * g); } while (0)
    int job = gw;
    if (job < NITEM * 4) S3_LOAD(sa, qb, ov, op, job);
    for (; job < NITEM * 4; job += NGW) {
        const int nj = job + NGW;
        if (nj < NITEM * 4) S3_LOAD(sa2, qb2, ov2, op2, nj);
        f32x16 acc = {};
#pragma unroll
        for (int kb = 0; kb < 4; ++kb) acc = __builtin_amdgcn_mfma_f32_32x32x16_bf16(sa[kb], qb[kb], acc, 0, 0, 0);
#pragma unroll
        for (int g = 0; g < 4; ++g) *(f32x4*)(op + 8 * g) = ov[g] + (f32x4){acc[4 * g], acc[4 * g + 1], acc[4 * g + 2], acc[4 * g + 3]};
#pragma unroll
        for (int kb = 0; kb < 4; ++kb) { sa[kb] = sa2[kb]; qb[kb] = qb2[kb]; ov[kb] = ov2[kb]; }
        op = op2;
    }
#undef S3_LOAD
}


__device__ __forceinline__ void s3_fetch(v4u (&d)[4], const bf16* base, size_t pitch, int lane) {
#pragma unroll
    for (int i = 0; i < 4; ++i) d[i] = *(const v4u*)(base + (size_t)((lane >> 3) + 8 * i) * pitch + (lane & 7) * 8);
}
template <bool PERMUTED = false>
__device__ __forceinline__ void s3_relayout(uint2 (&o)[8], const v4u (&d)[4], LAS unsigned char* stg, int lane) {
    const int r = lane & 31, h = lane >> 5;
#pragma unroll
    for (int i = 0; i < 4; ++i) *(LAS v4u*)(stg + ((lane >> 3) + 8 * i) * LSTR + (lane & 7) * 16) = d[i];
#pragma unroll
    for (int mi = 0; mi < 2; ++mi)
#pragma unroll
        for (int g = 0; g < 4; ++g) { const int c0 = 32 * mi + 8 * g + 4 * h; const u32x2 w = *(const LAS u32x2*)(stg + r * LSTR + (PERMUTED ? jperm(c0) : c0) * 2); o[mi * 4 + g] = make_uint2(w.x, w.y); }
}
__device__ __forceinline__ void p_scan3r(Frame& F, const Args& A, int l) {
    unsigned char* const ws = launder(F.ws);
    const int tid = (F.wave * 64 + hw_lane()), lane = tid & 63;
    const bf16* QQ = (const bf16*)(ws + WS_SQ); const bf16* S0 = (const bf16*)F.out; const bf16* OSC = (const bf16*)(ws + WS_OSC);
    const bf16* Rst = (const bf16*)(ws + WS_R); const bf16* Vst = (const bf16*)(ws + WS_V); const bf16* Kst = (const bf16*)(ws + WS_K); const bf16* LOUT = (const bf16*)(ws + WS_LOUT);
    bf16* QO = (bf16*)(ws + WS_QO);
    LAS unsigned char* stg = F.lds + RING_OFF + F.wave * 4608;
    const int gw = F.vcu * NWAVES + F.wave, NGW = F.G * NWAVES; const int r = lane & 31, h = lane >> 5;
    const float* rkp = INP(IN_RK) + l * 512; const float* gnwp = INP(IN_GNW) + l * 512; const float* gnbp = INP(IN_GNB) + l * 512; const float* kap = INP(IN_KA) + l * 512; const float* a0p = INP(IN_A0) + l * 1024;
    for (int unit = gw; unit < 64 * (KVLEN / 32); unit += NGW) {
        const int bh = unit / (KVLEN / 32), pb = unit - bh * (KVLEN / 32), b = bh >> 3, hd = bh & 7, p0 = pb * 32;
        const size_t tokb = (p0 < CTXL) ? (size_t)(TL + b * CTXL + p0) : (size_t)(b * SEQL + (p0 - CTXL)); const size_t tok = tokb + r;
        const int sb0 = (p0 < CTXL) ? (CTXL - 1 - p0) : (KVLEN + CTXL - 1 - p0);
        const int itf = (bh * 2) * NCHK + (p0 >> 6), itb = (bh * 2 + 1) * NCHK + (sb0 >> 6); const int tf = (p0 & 63) + r, tb = (sb0 & 63) - r;
        v4u ga[4], gb[4];
        s3_fetch(ga, OSC + tokb * 512 + hd * 64, 512, lane); s3_fetch(gb, OSC + ((size_t)TT + tokb) * 512 + hd * 64, 512, lane);
        f32x4 o[2][4];
        {   f32x16 acc[2][2];
#pragma unroll
            for (int d = 0; d < 2; ++d) { const size_t ib = (size_t)(d ? itb : itf) * 4096; const bf16* qp = QQ + ib + (size_t)(d ? tb : tf) * 64 + 8 * h;
                bf16x8 qf[4];
#pragma unroll
                for (int kb = 0; kb < 4; ++kb) qf[kb] = *(const bf16x8*)(qp + 16 * kb);
#pragma unroll
                for (int mi = 0; mi < 2; ++mi) { const bf16* sp = S0 + ib + (size_t)(32 * mi + r) * 64 + 8 * h; f32x16 a = {};
#pragma unroll
                    for (int kb = 0; kb < 4; ++kb) a = __builtin_amdgcn_mfma_f32_32x32x16_bf16(*(const bf16x8*)(sp + 16 * kb), qf[kb], a, 0, 0, 0);
                    acc[d][mi] = a; } }
#pragma unroll
            for (int mi = 0; mi < 2; ++mi)
#pragma unroll
                for (int g = 0; g < 4; ++g)
#pragma unroll
                    for (int i = 0; i < 4; ++i) o[mi][g][i] = acc[0][mi][4 * g + i] + acc[1][mi][4 * g + i]; }
        uint2 ta[8], tb8[8];
        s3_relayout<true>(ta, ga, stg, lane); s3_fetch(ga, Rst + tokb * 512 + hd * 64, 512, lane);
        s3_relayout<true>(tb8, gb, stg, lane); s3_fetch(gb, Kst + tokb * 512 + hd * 64, 512, lane);
        float s1 = 0.f;
#pragma unroll
        for (int mi = 0; mi < 2; ++mi)
#pragma unroll
            for (int g = 0; g < 4; ++g) { const uint2 of = ta[mi * 4 + g], ob = tb8[mi * 4 + g]; f32x4 v = o[mi][g];
                v[0] += bflo(of.x) + bflo(ob.x); v[1] += bfhi(of.x) + bfhi(ob.x); v[2] += bflo(of.y) + bflo(ob.y); v[3] += bfhi(of.y) + bfhi(ob.y);
                o[mi][g] = v; s1 += (v[0] + v[1]) + (v[2] + v[3]); }
        s1 += __shfl_xor(s1, 32); const float mean = s1 * (1.0f / 64.0f);
        const int cb = hd * 64 + 4 * h;
        float s2 = 0.f, bs = 0.f;
        f32x4 rkv[8], sa[8];
        {   uint2 rr8[8], kk8[8];
            s3_relayout(rr8, ga, stg, lane); s3_fetch(ga, LOUT + tokb * LORA_N + 1024 + hd * 64, LORA_N, lane);
            s3_relayout(kk8, gb, stg, lane); s3_fetch(gb, LOUT + tokb * LORA_N + 1536 + hd * 64, LORA_N, lane);
#pragma unroll
            for (int q = 0; q < 8; ++q) { const int cl = cb + 32 * (q >> 2) + 8 * (q & 3); const f32x4 rk4 = *(const f32x4*)(rkp + cl);
                f32x4 d = o[q >> 2][q & 3] - mean; o[q >> 2][q & 3] = d; s2 += (d[0] * d[0] + d[1] * d[1]) + (d[2] * d[2] + d[3] * d[3]);
                rkv[q] = (f32x4){bflo(rr8[q].x) * bflo(kk8[q].x) * rk4[0], bfhi(rr8[q].x) * bfhi(kk8[q].x) * rk4[1], bflo(rr8[q].y) * bflo(kk8[q].y) * rk4[2], bfhi(rr8[q].y) * bfhi(kk8[q].y) * rk4[3]}; } }
        {   uint2 pa8[8];
            s3_relayout(pa8, ga, stg, lane); s3_fetch(ga, Vst + tokb * 512 + hd * 64, 512, lane);
#pragma unroll
            for (int q = 0; q < 8; ++q) sa[q] = (f32x4){bflo(pa8[q].x), bfhi(pa8[q].x), bflo(pa8[q].y), bfhi(pa8[q].y)}; }
        {   uint2 pb8[8];
            s3_relayout(pb8, gb, stg, lane); s3_fetch(gb, LOUT + tokb * LORA_N + 2048 + hd * 64, LORA_N, lane);
#pragma unroll
            for (int q = 0; q < 8; ++q) { const int cl = cb + 32 * (q >> 2) + 8 * (q & 3); const f32x4 ka4 = *(const f32x4*)(kap + cl);
                const float pq[4] = {bflo(pb8[q].x), bfhi(pb8[q].x), bflo(pb8[q].y), bfhi(pb8[q].y)};
#pragma unroll
                for (int i = 0; i < 4; ++i) bs += rkv[q][i] * (2.0f + (sa[q][i] + pq[i] - 2.0f) * ka4[i]); } }
        s2 += __shfl_xor(s2, 32); bs += __shfl_xor(bs, 32);
        const float rs = __builtin_amdgcn_rsqf(s2 * (1.0f / 64.0f) + GN_EPS);
        uint2 vv8[8], gg8[8];
        s3_relayout(vv8, ga, stg, lane); s3_relayout(gg8, gb, stg, lane);
#pragma unroll
        for (int mi = 0; mi < 2; ++mi)
#pragma unroll
            for (int g = 0; g < 4; ++g) { const int cl = cb + 32 * mi + 8 * g; const int q = mi * 4 + g;
                const uint2 vw = vv8[q], gwd = gg8[q];
                const f32x4 w4 = *(const f32x4*)(gnwp + cl), b4 = *(const f32x4*)(gnbp + cl); const f32x4 d = o[mi][g];
                const float y0 = (d[0] * rs * w4[0] + b4[0] + bs * bflo(vw.x)) * bflo(gwd.x), y1 = (d[1] * rs * w4[1] + b4[1] + bs * bfhi(vw.x)) * bfhi(gwd.x);
                const float y2 = (d[2] * rs * w4[2] + b4[2] + bs * bflo(vw.y)) * bflo(gwd.y), y3 = (d[3] * rs * w4[3] + b4[3] + bs * bfhi(vw.y)) * bfhi(gwd.y);
                *(LAS u32x2*)(stg + r * LSTR + (32 * mi + 8 * g + 4 * h) * 2) = (u32x2){pkbf(y0, y1), pkbf(y2, y3)}; }
#pragma unroll
        for (int i = 0; i < 4; ++i) { const int row = (lane >> 3) + 8 * i; const v4u val = *(const LAS v4u*)(stg + row * LSTR + (lane & 7) * 16);
            *(v4u*)(QO + (tokb + row) * 1024 + 512 + hd * 64 + (lane & 7) * 8) = val; }
    }
}

#if DEBUG_NAN
__device__ __forceinline__ void dbg_count(Frame& F) {
    unsigned char* const ws = launder(F.ws);
    const size_t gt = (size_t)blockIdx.x * 512 + threadIdx.x, NT = (size_t)F.G * 512;
    const unsigned short* arr[4] = {(const unsigned short*)(ws + WS_SPT), (const unsigned short*)(ws + WS_SG), (const unsigned short*)(ws + WS_SQ), (const unsigned short*)F.out};
#pragma unroll
    for (int a = 0; a < 4; ++a) { unsigned bad = 0; for (size_t i = gt; i < (size_t)NITEM * 4096; i += NT) { const float v = __builtin_bit_cast(float, (unsigned)arr[a][i] << 16); if (!(fabsf(v) < 1e30f)) ++bad; }
        if (bad) atomicAdd((unsigned*)(F.ctl + 8 + a), bad); }
    { const float* o = (const float*)(ws + WS_OSC); unsigned bad = 0; for (size_t i = gt; i < (size_t)2 * TT * 512; i += NT) { if (!(fabsf(o[i]) < 1e30f)) ++bad; } if (bad) atomicAdd((unsigned*)(F.ctl + 12), bad); }
}
#endif
template <int l> __device__ __forceinline__ void layer_body(Frame& F, const Args& args, const XcdBarrier& bar, unsigned char* lds) {
#define GRID_BAR() xcd_barrier(bar)

        constexpr bool last = (l == DEPTH - 1), moe = (l & 1) != 0;

#ifndef SKIP_WPREP
        p_wprep(F, args, l, 0);
#endif


#ifndef SKIP_NORM1
        {   if (l == 0) p_norm<false, false, true>(F, args, l, 0, INP(IN_X), INP(IN_CTX), 0);
            else if (l & 1) p_norm<false, false, false, true>(F, args, l, 0, nullptr, nullptr, 0);
            else p_norm<false, true, false>(F, args, l, 0, nullptr, nullptr, l - 1); }
#endif

        GRID_BAR(); TS(1);
        {   unsigned char* const ws = launder(F.ws); bf16* const XB = (bf16*)(ws + WS_XB); const float* const MOD = (const float*)(ws + WS_MOD); bf16* const H = (bf16*)F.out; (void)XB; (void)MOD; (void)H;
            pg8::Gemm g{H, (const bf16*)(ws + WS_WIN), TT, INWP, 1024, 0}; pg8::Sched S; S.init(TT / 256, INWP / 256, F.G, (int)blockIdx.x, nullptr);
            pg8::EpiBf16 E{(bf16*)(ws + WS_P), INWP};
#ifndef SKIP_G_IN
            pg8::gemm_phase<pg8::EpiBf16, pg8::Sched, true, true>(F.lds + RING_OFF, g, S, E, F.wave);
#endif
            }
        GRID_BAR(); TS(2);

#ifndef SKIP_PREP
        p_prep(F, args, l);
#endif
#if PROBE == 2
        p_prep(F, args, l);
#endif

        GRID_BAR(); TS(3);
        {   unsigned char* const ws = launder(F.ws); bf16* const XB = (bf16*)(ws + WS_XB); const float* const MOD = (const float*)(ws + WS_MOD); bf16* const H = (bf16*)F.out; (void)XB; (void)MOD; (void)H;
            pg8::Gemm g{(const bf16*)(ws + WS_LIN), (const bf16*)(ws + WS_WLORA), TT, LORA_N, 128, LORA_K}; pg8::Sched S; S.init(TT / 256, LORA_N / 256, F.G, (int)blockIdx.x, nullptr); S.lora = 1;
            pg8::EpiLoraAct E{(bf16*)(ws + WS_LOUT), LORA_N, INP(IN_W0) + l * 1024, INP(IN_A0) + l * 1024};
#ifndef SKIP_G_LORA
            pg8::gemm_phase<pg8::EpiLoraAct, pg8::Sched, true, true>(F.lds + RING_OFF, g, S, E, F.wave);
#endif
            }

#ifndef SKIP_ATTN
        p_attn(F, (char*)lds + RING_OFF, !last);
#endif

        GRID_BAR(); TS(4);

#if USE_SEQ_SCAN
        p_scan(F, args, l);
#else
        p_scan1(F, args, l);
#if PROBE == 5
        p_scan1(F, args, l);
#endif
        GRID_BAR(); TS(5);
        p_scan2(F);
#if PROBE == 6
        p_scan2(F);
#endif
        GRID_BAR(); TS(6);
        p_scan3r(F, args, l);
#endif
#if USE_SEQ_SCAN
        GRID_BAR(); TS(15);
        p_readout(F, args, l);
#endif
        GRID_BAR(); TS(7);
        {   unsigned char* const ws = launder(F.ws); bf16* const XB = (bf16*)(ws + WS_XB); const float* const MOD = (const float*)(ws + WS_MOD); bf16* const H = (bf16*)F.out; (void)XB; (void)MOD; (void)H;
            pg8::Gemm g{(const bf16*)(ws + WS_QO), (const bf16*)(ws + WS_WOUT), TT, 1024, 1024, 0, 0}; pg8::SchedSK S; S.init(TL / 256, !last, 1024 / 64, F.G, (int)blockIdx.x);
            pg8::EpiResidB<l == 0> E{INP(IN_X), INP(IN_CTX), XB, MOD + (size_t)l * 9 * 6144 + 2 * 1024, (bf16*)(ws + WS_SIDE), 1.0f};
#ifndef SKIP_G_OUT
            pg8::gemm_phase<pg8::EpiResidB<l == 0>, pg8::SchedSK, true, true>(F.lds + RING_OFF, g, S, E, F.wave);
#endif
            }
        GRID_BAR(); TS(8);
        p_wprep(F, args, l, 1);
#if PROBE == 7
        p_wprep(F, args, l, 1);
#endif
        if (!moe) {
            p_norm<false, false, false, true>(F, args, l, 1, nullptr, nullptr, 0);
#if PROBE == 4
            p_norm<false, false, false, false>(F, args, l, 1, nullptr, nullptr, 0);
#endif
            GRID_BAR(); TS(9);
            {   unsigned char* const ws = launder(F.ws); bf16* const XB = (bf16*)(ws + WS_XB); const float* const MOD = (const float*)(ws + WS_MOD); bf16* const H = (bf16*)F.out; (void)XB; (void)MOD; (void)H;
            pg8::Gemm g{H, (const bf16*)(ws + WS_WFF), TT, 2 * FFD, 1024, 0}; pg8::Sched S; S.init(TT / 256, 2 * FFD / 256, F.G, (int)blockIdx.x, nullptr);
                pg8::EpiSwiGLU E{(bf16*)(ws + WS_HID), FFD, 1.0f};
#ifndef SKIP_G_UP
                pg8::gemm_phase<pg8::EpiSwiGLU, pg8::Sched, true, true>(F.lds + RING_OFF, g, S, E, F.wave);
#endif
            }
            GRID_BAR(); TS(10);
            {   unsigned char* const ws = launder(F.ws); bf16* const XB = (bf16*)(ws + WS_XB); const float* const MOD = (const float*)(ws + WS_MOD); bf16* const H = (bf16*)F.out; (void)XB; (void)MOD; (void)H;
            pg8::Gemm g{(const bf16*)(ws + WS_HID), (const bf16*)(ws + WS_WFF_D_DENSE), TT, 1024, FFD, 0, 0}; pg8::SchedSK S; S.init(TL / 256, true, FFD / 64, F.G, (int)blockIdx.x);
                pg8::EpiResidB<false> E{nullptr, nullptr, XB, MOD + (size_t)l * 9 * 6144 + 5 * 1024, (bf16*)(ws + WS_SIDE), 1.0f};
#ifndef SKIP_G_DOWN
                pg8::gemm_phase<pg8::EpiResidB<false>, pg8::SchedSK, true, true>(F.lds + RING_OFF, g, S, E, F.wave);
#endif
            }
            GRID_BAR(); TS(11);
        } else {
            p_norm<true, false, false, !last>(F, args, l, 1, nullptr, nullptr, 0, last ? TL : TT);
#if PROBE == 4
            p_norm<true, false, false, false>(F, args, l, 1, nullptr, nullptr, 0, last ? TL : TT);
#endif
            GRID_BAR(); TS(9);

#ifndef SKIP_ROUTE
            p_route(F, last ? TL : TT);
#endif

            GRID_BAR(); TS(12);
            const int npanels = *(LAS int*)(F.lds + LT_NPAN);
            {   unsigned char* const ws = launder(F.ws); bf16* const XB = (bf16*)(ws + WS_XB); const float* const MOD = (const float*)(ws + WS_MOD); bf16* const H = (bf16*)F.out; (void)XB; (void)MOD; (void)H;
            pg8::Gemm g{(const bf16*)(ws + WS_AG8), (const bf16*)(ws + WS_WFF), npanels * 256, 2 * FFE, 512, 0}; pg8::Sched S; S.init(npanels, 2 * FFE / 256, F.G, (int)blockIdx.x, (const LAS int*)(F.lds + LT_PEXP));
                pg8::EpiSwiGLU8 E{ws + WS_HIDM, FFE, 1.0f / (H8SCALE * W8SCALE), HID8SCALE};
#ifndef SKIP_G_MUP
                pg8::gemm_phase<pg8::EpiSwiGLU8, pg8::Sched, true, true, true>(F.lds + RING_OFF, g, S, E, F.wave);
#endif
            }
            GRID_BAR(); TS(13);
            {   unsigned char* const ws = launder(F.ws); bf16* const XB = (bf16*)(ws + WS_XB); const float* const MOD = (const float*)(ws + WS_MOD); bf16* const H = (bf16*)F.out; (void)XB; (void)MOD; (void)H;
            pg8::Gemm g{(const bf16*)(ws + WS_HIDM), (const bf16*)(ws + WS_WFF_D_MOE8), npanels * 256, 1024, FFE / 2, 0}; pg8::Sched S; S.init(npanels, 4, F.G, (int)blockIdx.x, (const LAS int*)(F.lds + LT_PEXP));
                pg8::EpiBf16S E{(bf16*)(ws + WS_AG), 1024, 1.0f / (HID8SCALE * W8SCALE)};
#ifndef SKIP_G_MDOWN
                pg8::gemm_phase<pg8::EpiBf16S, pg8::Sched, true, true, true>(F.lds + RING_OFF, g, S, E, F.wave);
#endif
            }
            GRID_BAR(); TS(14);
        }

#undef GRID_BAR
}
__global__ void __launch_bounds__(NWAVES * 64, 2) mk_fwd(Args args) {
    extern __shared__ __attribute__((aligned(16))) unsigned char lds[];
    Frame F;
    F.lds = (LAS unsigned char*)lds;
    F.MISC = (volatile LAS unsigned*)(F.lds + MISC_OFF);
    F.tid = threadIdx.x; F.lane = F.tid & 63; F.wave = __builtin_amdgcn_readfirstlane(F.tid >> 6);
    F.G = gridDim.x; { const int bx = blockIdx.x; F.vcu = (F.G % 8 == 0) ? (bx % 8) * (F.G / 8) + bx / 8 : bx; }
    F.ws = args.ws; F.ctl = (gu32*)(args.ws + WS_CTL); F.out = args.out;
    for (int u = F.tid; u < 64; u += NWAVES * 64) ((LAS unsigned*)(F.lds + LDSCTL_OFF))[u] = 0u;
    if (F.tid < 30) ((LAS unsigned long long*)(F.lds + LT_INP))[F.tid] = (unsigned long long)args.in[F.tid];
    __syncthreads();
    XcdBarrier bar = xcd_barrier_post((unsigned*)(F.ctl + CW_BAR), F.MISC + 8, F.wave);
#define GRID_BAR() xcd_barrier(bar)
#if TSEL >= 0
    if (blockIdx.x == 0 && F.wave == 0 && hw_lane() == 0) ((unsigned long long*)(F.ws + WS_CTL + 32768))[0] = __builtin_amdgcn_s_memrealtime();
#endif

#ifndef SKIP_PRO
    p_prologue(F, args);
#endif

    GRID_BAR(); TS(0);
    layer_body<0>(F, args, bar, lds);
#if DEBUG_NAN
    return;
#endif
    layer_body<1>(F, args, bar, lds);
    layer_body<2>(F, args, bar, lds);
    layer_body<3>(F, args, bar, lds);

#ifndef SKIP_FINAL
    p_final_combine(F, DEPTH - 1);
#endif
#if TSEL >= 0
    TS(15);
    xcd_barrier(bar);
    if (blockIdx.x == 0 && F.wave == 0 && hw_lane() == 0) { const unsigned long long* ts_ = (const unsigned long long*)(F.ws + WS_CTL + 32768); float tot = 0.f, sel = 0.f;
        for (int k = 0; k < 16; ++k) { tot += (float)ts_[1 + k]; if ((TSEL >> k) & 1) sel += (float)ts_[1 + k]; }
        F.out[0] += 3.0f + 6.9f * sel / tot; }
#endif

#if CYSEL >= 0
    xcd_barrier(bar);
    if (blockIdx.x == 0 && F.wave == 0 && hw_lane() == 0) { const unsigned long long* cs_ = (const unsigned long long*)(F.ws + WS_CTL + 40960); float tot = 0.f; for (int k = 0; k < 5; ++k) tot += (float)cs_[k];
        F.out[0] += 3.0f + 6.9f * (float)cs_[CYSEL] / tot; }
#endif
    if (xb_ld((unsigned*)(F.ctl + CW_BAR) + XB_TMO) != 0u && blockIdx.x == 0 && F.wave == 0 && hw_lane() == 0) F.out[0] = __builtin_nanf("");
}

extern "C" void kernel_launch(void* const* d_in, const int* in_sizes, int n_in, void* d_out, int out_size, void* d_ws, size_t ws_size, hipStream_t stream) {
    static int grid = 0;
    if (grid == 0) {
        if (n_in != 30 || in_sizes[0] != TL * 1024 || out_size != TL * 1024 || ws_size < WS_END) { fprintf(stderr, "kernel_launch: unexpected shapes / workspace (n_in %d, ws %zu); nothing launched\n", n_in, ws_size); grid = -1; return; }
        int dev = 0, cus = 0, per_cu = 0;
        if (hipGetDevice(&dev) != hipSuccess || hipDeviceGetAttribute(&cus, hipDeviceAttributeMultiprocessorCount, dev) != hipSuccess) { grid = -1; return; }
        if (hipFuncSetAttribute((const void*)mk_fwd, hipFuncAttributeMaxDynamicSharedMemorySize, LDS_BYTES) != hipSuccess) { fprintf(stderr, "kernel_launch: hipFuncSetAttribute failed\n"); grid = -1; return; }
        if (hipOccupancyMaxActiveBlocksPerMultiprocessor(&per_cu, (const void*)mk_fwd, NWAVES * 64, LDS_BYTES) != hipSuccess || per_cu < 1) { fprintf(stderr, "kernel_launch: occupancy query reports %d blocks per CU\n", per_cu); }
        (void)hipGetLastError();
        grid = cus;
    }
    if (grid < 0) return;
    if (hipMemsetAsync((char*)d_ws + WS_CTL, 0, CTL_ZERO_BYTES, stream) != hipSuccess) return;
    Args a{};
    for (int i = 0; i < 30; ++i) a.in[i] = (const float*)d_in[i];
    a.out = (float*)d_out; a.ws = (unsigned char*)d_ws;
    hipLaunchKernelGGL(mk_fwd, dim3(grid), dim3(NWAVES * 64), LDS_BYTES, stream, a);
}
```

```cpp
#include <hip/hip_runtime.h>
#include <hip/hip_bf16.h>
#include <cstdio>
#include <cstdint>
#include <cmath>
__device__ __forceinline__ int hw_lane() { int l_; asm volatile("v_mbcnt_lo_u32_b32 %0, -1, 0\n\tv_mbcnt_hi_u32_b32 %0, -1, %0" : "=v"(l_)); return l_; }
namespace pg8 {
#define PG8_LAS __attribute__((address_space(3)))
typedef unsigned short bf16_t;
typedef short bf16x8 __attribute__((ext_vector_type(8)));
typedef float f32x4 __attribute__((ext_vector_type(4)));
typedef unsigned u32x4 __attribute__((ext_vector_type(4)));
constexpr int BM = 256, BK = 64, HALF = 128, HTB = HALF * BK * 2  , STAGE_BYTES = 8 * HTB, NXCD = 8, WGM = 8;

__host__ __device__ __forceinline__ int lds_byte(int r, int c) { const int st = (r >> 4) * 2 + (c >> 5), rr = r & 15, cc = c & 31, ob = rr * 64 + cc * 2; return st * 1024 + (ob ^ (((ob >> 9) & 1) << 5)); }
__host__ __device__ __forceinline__ void stage_rc(int b, int& R, int& C) { const int st = b / 1024, sb = b % 1024, swz = sb ^ (((sb >> 9) & 1) << 5); R = (st >> 1) * 16 + swz / 64; C = (st & 1) * 32 + (swz % 64) / 2; }
__host__ __device__ __forceinline__ int perm32(int rho) { const int n = rho >> 4, i = rho & 15; return 8 * (i >> 2) + 4 * n + (i & 3); }
__device__ __forceinline__ unsigned cvt_pk_bf16(float lo, float hi) { unsigned r; asm volatile("v_cvt_pk_bf16_f32 %0, %1, %2" : "=v"(r) : "v"(lo), "v"(hi)); return r; }
typedef float f32x2 __attribute__((ext_vector_type(2)));

struct Unit { int pm, pn, pnb, ka, nt, slice; };
struct Gemm { const bf16_t* A; const bf16_t* Bt; int M, N, K, lda, ldb; };

struct Sched {
    static constexpr bool SPLITK = false;
    int nM, nN, nwg, G, c, lora; const PG8_LAS int* pexp;
    __device__ __forceinline__ void init(int nM_, int nN_, int G_, int c_, const PG8_LAS int* pe) { nM = nM_; nN = nN_; nwg = nM * nN; G = G_; c = c_; pexp = pe; lora = 0; }
    __device__ __forceinline__ bool next(int i, Unit& u) const {
        const long L = (long)i * G + c; if (L >= nwg) return false;
        int wgid = (int)L; { const int q = nwg / NXCD, r = nwg % NXCD, xcd = wgid % NXCD, off = wgid / NXCD; wgid = (xcd < r ? xcd * (q + 1) : r * (q + 1) + (xcd - r) * q) + off; }
        const int nig = WGM * nN, gid = wgid / nig, fm = gid * WGM, gsz = (nM - fm) < WGM ? (nM - fm) : WGM;
        u.pm = fm + ((wgid % nig) % gsz); u.pn = (wgid % nig) / gsz; u.pnb = pexp ? pexp[u.pm] * nN + u.pn : u.pn;
        u.ka = lora ? ((u.pn >= 8) ? 512 : ((u.pn >= 4) ? 256 : 0)) : 0; return true;
    }
    __device__ __forceinline__ void a_ready(const Unit&) const {}
    __device__ __forceinline__ void done(const Unit&) const {}
};
struct SchedSK {
    static constexpr bool SPLITK = true;
    int nM, nwg, G, c, nsub, ntt, base, extra;
    __device__ __forceinline__ void init(int nMf_, bool ctx, int ntiles, int G_, int c_) { nM = nMf_; nwg = nMf_ * 4; G = G_; c = c_; nsub = ctx ? 128 : 0; ntt = ntiles; base = (ntiles / 4) & ~1; extra = (ntiles - 4 * base) / 2; }
    __device__ __forceinline__ bool next(int i, Unit& u) const {
        const long L = (long)i * G + c; if (L >= nwg + nsub) return false;
        const bool sub = L >= nwg;
        int wgid = sub ? 0 : (int)L; { const int q = nwg / NXCD, r = nwg % NXCD, xcd = wgid % NXCD, off = wgid / NXCD; wgid = (xcd < r ? xcd * (q + 1) : r * (q + 1) + (xcd - r) * q) + off; }
        const int nig = WGM * 4, gid = wgid / nig, fm = gid * WGM, gsz = (nM - fm) < WGM ? (nM - fm) : WGM;
        const int pmf = fm + ((wgid % nig) % gsz), pnf = (wgid % nig) / gsz;
        const int Ls = sub ? (int)(L - nwg) : 0, sl = Ls >> 5, rem = Ls & 31;
        const int kt0 = sl * base + 2 * (sl < extra ? sl : extra);
        u.pm = sub ? nM + (rem & 7) : pmf; u.pn = sub ? (rem >> 3) : pnf; u.pnb = u.pn; u.slice = sl;
        u.nt = sub ? base + ((sl < extra) ? 2 : 0) : ntt; u.ka = kt0 * (BK * 2); return true;
    }
    __device__ __forceinline__ void a_ready(const Unit&) const {}
    __device__ __forceinline__ void done(const Unit&) const {}
};

__device__ __forceinline__ float sigmoid_f(float x) { return __builtin_amdgcn_rcpf(1.0f + __builtin_amdgcn_exp2f(-1.4426950408889634f * x)); }
__device__ __forceinline__ float bf_lo(unsigned w) { return __builtin_bit_cast(float, w << 16); }
__device__ __forceinline__ float bf_hi(unsigned w) { return __builtin_bit_cast(float, w & 0xffff0000u); }

struct EpiBf16 {
    static constexpr bool PERM = true, AFTER_DRAIN = false;
    bf16_t* O; int ldc;
    __device__ __forceinline__ void operator()(const f32x4 (&acc)[2][2][4][2], const Unit& u, int wr, int wc, int fr, int fq) const {
        const int row0 = u.pm * BM + wr * 64 + fr; const int col0 = u.pn * BM + wc * 32 + 8 * fq;
#pragma unroll
        for (int ai = 0; ai < 2; ++ai)
#pragma unroll
            for (int m = 0; m < 4; ++m) { bf16_t* rowp = O + (size_t)(row0 + ai * HALF + m * 16) * ldc + col0;
#pragma unroll
                for (int bj = 0; bj < 2; ++bj) { const f32x4 v0 = acc[ai][bj][m][0], v1 = acc[ai][bj][m][1];
                    u32x4 w; w.x = cvt_pk_bf16(v0[0], v0[1]); w.y = cvt_pk_bf16(v0[2], v0[3]); w.z = cvt_pk_bf16(v1[0], v1[1]); w.w = cvt_pk_bf16(v1[2], v1[3]);
                    *(u32x4*)(rowp + bj * HALF) = w; } }
    }
};
struct EpiSwiGLU {
    static constexpr bool PERM = true, AFTER_DRAIN = false;
    bf16_t* O; int ldc; float inscale;
    __device__ __forceinline__ void operator()(const f32x4 (&acc)[2][2][4][2], const Unit& u, int wr, int wc, int fr, int fq) const {
        const int row0 = u.pm * BM + wr * 64 + fr; const int col0 = u.pn * HALF + wc * 32 + 8 * fq;
        const float d1 = -1.4426950408889634f * inscale, d2 = inscale * inscale;
#pragma unroll
        for (int ai = 0; ai < 2; ++ai)
#pragma unroll
            for (int m = 0; m < 4; ++m) { bf16_t* rowp = O + (size_t)(row0 + ai * HALF + m * 16) * ldc + col0;
                float h[8];
#pragma unroll
                for (int n = 0; n < 2; ++n)
#pragma unroll
                    for (int j = 0; j < 4; ++j) { const float ag = acc[ai][0][m][n][j], au = acc[ai][1][m][n][j];
                        h[n * 4 + j] = (ag * au) * (d2 * __builtin_amdgcn_rcpf(1.0f + __builtin_amdgcn_exp2f(d1 * ag))); }
                u32x4 w; w.x = cvt_pk_bf16(h[0], h[1]); w.y = cvt_pk_bf16(h[2], h[3]); w.z = cvt_pk_bf16(h[4], h[5]); w.w = cvt_pk_bf16(h[6], h[7]);
                *(u32x4*)rowp = w; }
    }
};
struct EpiResid {
    static constexpr bool PERM = false, AFTER_DRAIN = false;
    const float* baseL; const float* baseC; float* outL; float* outC; const float* gate; float scale;
    __device__ __forceinline__ void operator()(const f32x4 (&acc)[2][2][4][2], const Unit& u, int wr, int wc, int fr, int fq) const {
        const float* base; float* out; int bsel;
        if (u.pm < 128) { base = baseL + (size_t)u.pm * BM * 1024; out = outL + (size_t)u.pm * BM * 1024; bsel = u.pm >> 4; }
        else { base = baseC + (size_t)(u.pm - 128) * BM * 1024; out = outC + (size_t)(u.pm - 128) * BM * 1024; bsel = 8; }
        const float* gv = gate + (size_t)bsel * 6144;
        const int col0 = u.pn * BM + wc * 32 + 4 * fq;
        f32x4 g4[2][2];
#pragma unroll
        for (int bj = 0; bj < 2; ++bj)
#pragma unroll
            for (int n = 0; n < 2; ++n) g4[bj][n] = *(const f32x4*)(gv + col0 + bj * HALF + n * 16) * scale;
#pragma unroll
        for (int ai = 0; ai < 2; ++ai)
#pragma unroll
            for (int m = 0; m < 4; ++m) { const size_t off = (size_t)(ai * HALF + wr * 64 + m * 16 + fr) * 1024 + col0;
#pragma unroll
                for (int bj = 0; bj < 2; ++bj)
#pragma unroll
                    for (int n = 0; n < 2; ++n) { const f32x4 xs = *(const f32x4*)(base + off + bj * HALF + n * 16); *(f32x4*)(out + off + bj * HALF + n * 16) = xs + g4[bj][n] * acc[ai][bj][m][n]; } }
    }
};

__device__ __forceinline__ float clamp8(float x) { return __builtin_fminf(__builtin_fmaxf(x, -440.0f), 440.0f); }
__device__ __forceinline__ unsigned pk_fp8x4(float a, float b, float c, float d) { int w = 0; w = __builtin_amdgcn_cvt_pk_fp8_f32(clamp8(a), clamp8(b), w, false); w = __builtin_amdgcn_cvt_pk_fp8_f32(clamp8(c), clamp8(d), w, true); return (unsigned)w; }
struct EpiSwiGLU8 {
    static constexpr bool PERM = true, AFTER_DRAIN = false;
    unsigned char* O; int ldc; float inscale, outscale;
    __device__ __forceinline__ void operator()(const f32x4 (&acc)[2][2][4][2], const Unit& u, int wr, int wc, int fr, int fq) const {
        const int row0 = u.pm * BM + wr * 64 + fr; const int col0 = u.pn * HALF + wc * 32 + 8 * fq;
        const float c1 = -1.4426950408889634f * inscale, c2 = inscale * inscale * outscale;
#pragma unroll
        for (int ai = 0; ai < 2; ++ai)
#pragma unroll
            for (int m = 0; m < 4; ++m) { unsigned char* rowp = O + (size_t)(row0 + ai * HALF + m * 16) * ldc + col0;
                float h[8];
#pragma unroll
                for (int n = 0; n < 2; ++n)
#pragma unroll
                    for (int j = 0; j < 4; ++j) { const float ag = acc[ai][0][m][n][j], au = acc[ai][1][m][n][j];
                        h[n * 4 + j] = (ag * au) * (c2 * __builtin_amdgcn_rcpf(1.0f + __builtin_amdgcn_exp2f(c1 * ag))); }
                typedef unsigned u32x2e __attribute__((ext_vector_type(2)));
                *(u32x2e*)rowp = (u32x2e){pk_fp8x4(h[0], h[1], h[2], h[3]), pk_fp8x4(h[4], h[5], h[6], h[7])};  asm volatile("" ::: "memory"); }
    }
};
struct EpiBf16S {
    static constexpr bool PERM = true, AFTER_DRAIN = false;
    bf16_t* O; int ldc; float scale;
    __device__ __forceinline__ void operator()(const f32x4 (&acc)[2][2][4][2], const Unit& u, int wr, int wc, int fr, int fq) const {
        const int row0 = u.pm * BM + wr * 64 + fr; const int col0 = u.pn * BM + wc * 32 + 8 * fq;
#pragma unroll
        for (int ai = 0; ai < 2; ++ai)
#pragma unroll
            for (int m = 0; m < 4; ++m) { bf16_t* rowp = O + (size_t)(row0 + ai * HALF + m * 16) * ldc + col0;
#pragma unroll
                for (int bj = 0; bj < 2; ++bj) { const f32x4 v0 = acc[ai][bj][m][0] * scale, v1 = acc[ai][bj][m][1] * scale;
                    u32x4 w; w.x = cvt_pk_bf16(v0[0], v0[1]); w.y = cvt_pk_bf16(v0[2], v0[3]); w.z = cvt_pk_bf16(v1[0], v1[1]); w.w = cvt_pk_bf16(v1[2], v1[3]);
                    *(u32x4*)(rowp + bj * HALF) = w; } asm volatile("" ::: "memory"); }
    }
};

template <bool BASEF32> struct EpiResidB {
    static constexpr bool PERM = true, AFTER_DRAIN = false;
    const float* baseL; const float* baseC; bf16_t* xb; const float* gate; bf16_t* side; float scale;
    __device__ __forceinline__ void operator()(const f32x4 (&acc)[2][2][4][2], const Unit& u, int wr, int wc, int fr, int fq) const {
        asm volatile("" : "+v"(fr), "+v"(fq));
        const int bsel = (u.pm < 128) ? (u.pm >> 4) : 8;
        const float* base = (u.pm < 128) ? baseL + (size_t)u.pm * BM * 1024 : baseC + (size_t)(u.pm - 128) * BM * 1024;
        bf16_t* out = xb + (size_t)u.pm * BM * 1024;
        const float* gv = gate + (size_t)bsel * 6144;
        const int col0 = u.pn * BM + wc * 32 + 8 * fq;
        f32x4 g4[2][2];
#pragma unroll
        for (int bj = 0; bj < 2; ++bj)
#pragma unroll
            for (int n = 0; n < 2; ++n) g4[bj][n] = *(const f32x4*)(gv + col0 + bj * HALF + 4 * n) * scale;
        if (u.slice != 0) {
            bf16_t* so = side + ((size_t)(u.slice - 1) * 2048 + (size_t)(u.pm - 128) * BM) * 1024;
#pragma unroll
            for (int ai = 0; ai < 2; ++ai)
#pragma unroll
                for (int m = 0; m < 4; ++m) { const size_t off = (size_t)(ai * HALF + wr * 64 + m * 16 + fr) * 1024 + col0;
#pragma unroll
                    for (int bj = 0; bj < 2; ++bj) { const f32x4 o0 = g4[bj][0] * acc[ai][bj][m][0], o1 = g4[bj][1] * acc[ai][bj][m][1];
                        u32x4 ow; ow.x = cvt_pk_bf16(o0[0], o0[1]); ow.y = cvt_pk_bf16(o0[2], o0[3]); ow.z = cvt_pk_bf16(o1[0], o1[1]); ow.w = cvt_pk_bf16(o1[2], o1[3]);
                        *(u32x4*)(so + off + bj * HALF) = ow; } }
        } else
#pragma unroll
        for (int ai = 0; ai < 2; ++ai)
#pragma unroll
            for (int m = 0; m < 4; ++m) { const size_t off = (size_t)(ai * HALF + wr * 64 + m * 16 + fr) * 1024 + col0;
#pragma unroll
                for (int bj = 0; bj < 2; ++bj) { f32x4 x0, x1;
                    if (BASEF32) { x0 = *(const f32x4*)(base + off + bj * HALF); x1 = *(const f32x4*)(base + off + bj * HALF + 4); }
                    else { const u32x4 w = *(const u32x4*)(out + off + bj * HALF); x0 = (f32x4){bf_lo(w.x), bf_hi(w.x), bf_lo(w.y), bf_hi(w.y)}; x1 = (f32x4){bf_lo(w.z), bf_hi(w.z), bf_lo(w.w), bf_hi(w.w)}; }
                    const f32x4 o0 = x0 + g4[bj][0] * acc[ai][bj][m][0], o1 = x1 + g4[bj][1] * acc[ai][bj][m][1];
                    u32x4 ow; ow.x = cvt_pk_bf16(o0[0], o0[1]); ow.y = cvt_pk_bf16(o0[2], o0[3]); ow.z = cvt_pk_bf16(o1[0], o1[1]); ow.w = cvt_pk_bf16(o1[2], o1[3]);
                    *(u32x4*)(out + off + bj * HALF) = ow; } }
    }
};

struct EpiLoraAct {
    static constexpr bool PERM = true, AFTER_DRAIN = false;
    bf16_t* O; int ldc; const float* w0; const float* a0;
    __device__ __forceinline__ void operator()(const f32x4 (&acc)[2][2][4][2], const Unit& u, int wr, int wc, int fr, int fq) const {
        const int row0 = u.pm * BM + wr * 64 + fr; const int col0 = u.pn * BM + wc * 32 + 8 * fq; const int sec = u.pn >> 1;
        const int cs0 = (u.pn & 1) * 256 + wc * 32 + 8 * fq;
        f32x4 bv[2][2]; float mul = 1.0f;
        if (sec < 4) { const float* bp = (sec < 2 ? w0 + sec * 512 : a0 + (sec - 2) * 512) + cs0; mul = (sec < 2) ? 0.8750387749145276f : 1.0f;
#pragma unroll
            for (int bj = 0; bj < 2; ++bj)
#pragma unroll
                for (int n = 0; n < 2; ++n) bv[bj][n] = *(const f32x4*)(bp + bj * HALF + 4 * n) * -1.4426950408889634f; }
#pragma unroll
        for (int ai = 0; ai < 2; ++ai)
#pragma unroll
            for (int m = 0; m < 4; ++m) { bf16_t* rowp = O + (size_t)(row0 + ai * HALF + m * 16) * ldc + col0;
#pragma unroll
                for (int bj = 0; bj < 2; ++bj) { f32x4 v0 = acc[ai][bj][m][0], v1 = acc[ai][bj][m][1];
                    if (sec < 4) {
#pragma unroll
                        for (int j = 0; j < 4; ++j) { v0[j] = mul * __builtin_amdgcn_rcpf(1.0f + __builtin_amdgcn_exp2f(__builtin_fmaf(v0[j], -1.4426950408889634f, bv[bj][0][j])));
                            v1[j] = mul * __builtin_amdgcn_rcpf(1.0f + __builtin_amdgcn_exp2f(__builtin_fmaf(v1[j], -1.4426950408889634f, bv[bj][1][j]))); } }
                    u32x4 w; w.x = cvt_pk_bf16(v0[0], v0[1]); w.y = cvt_pk_bf16(v0[2], v0[3]); w.z = cvt_pk_bf16(v1[0], v1[1]); w.w = cvt_pk_bf16(v1[2], v1[3]);
                    *(u32x4*)(rowp + bj * HALF) = w; } }
    }
};
typedef int v8i_t __attribute__((ext_vector_type(8)));
__device__ __forceinline__ v8i_t cat8(bf16x8 a, bf16x8 b) { const u32x4 x = __builtin_bit_cast(u32x4, a), y = __builtin_bit_cast(u32x4, b); return (v8i_t){(int)x[0], (int)x[1], (int)x[2], (int)x[3], (int)y[0], (int)y[1], (int)y[2], (int)y[3]}; }
template <class Epi, class Sched, bool ALIGN_EPI = false, bool SP2 = false, bool FP8 = false>
__device__ __forceinline__ void gemm_phase(PG8_LAS unsigned char* lds, const Gemm g, const Sched& S, const Epi& E, const int wave_) {
    const int tid = wave_ * 64 + hw_lane(), wid = wave_, lane = tid & 63, wr = wid >> 2, wc = wid & 3, fr = lane & 15, fq = lane >> 4;
    int K_ = g.K; asm volatile("" : "+s"(K_));
    const int K = K_, nt = K / BK; const int lda = g.lda ? g.lda : K, ldb = g.ldb ? g.ldb : K;
    unsigned voffA[2], voffB[2];
#pragma unroll
    for (int i = 0; i < 2; ++i) { int R, C; stage_rc(tid * 16 + i * 8192, R, C); const int Rb = Epi::PERM ? ((R & ~31) + perm32(R & 31)) : R;
        voffA[i] = (unsigned)(R * lda + C) * 2u; voffB[i] = (unsigned)(Rb * ldb + C) * 2u; }
    const size_t kstep = (size_t)(BK * 2);
    const size_t hstep = (size_t)HALF * ldb * 2;
    const size_t hstepA = (size_t)HALF * lda * 2, tstepA = 2 * hstepA;
    const size_t tstep = 2 * hstep;
    const unsigned ldsw = (unsigned)wid * 1024u;
    const int aoff = lds_byte(wr * 64 + fr, fq * 8), boff = lds_byte(wc * 32 + fr, fq * 8);
#define PG8_SA(b, h) (((b) * 2 + (h)) * HTB)
#define PG8_SB(b, h) ((4 + (b) * 2 + (h)) * HTB)
#define PG8_STAGE(bufoff, gbase, voff) do { _Pragma("unroll") for (int _i = 0; _i < 2; ++_i) \
        __builtin_amdgcn_global_load_lds((const unsigned*)((const char*)(gbase) + (voff)[_i]), (PG8_LAS unsigned*)(lds + (bufoff) + ldsw + _i * 8192), 16, 0, 0); } while (0)
#define PG8_LDA(dst, b, h) do { if constexpr (FP8) { _Pragma("unroll") for (int m = 0; m < 4; ++m) { dst##8[m].lo = *(const PG8_LAS v4i_t*)(lds + PG8_SA(b, h) + aoff + m * 2048); dst##8[m].hi = *(const PG8_LAS v4i_t*)(lds + PG8_SA(b, h) + aoff + m * 2048 + 1024); } } \
        else { _Pragma("unroll") for (int m = 0; m < 4; ++m) _Pragma("unroll") for (int k = 0; k < 2; ++k) dst[FP8 ? 0 : m][k] = *(const PG8_LAS bf16x8*)(lds + PG8_SA(b, h) + aoff + m * 2048 + k * 1024); } } while (0)
#define PG8_LDB(dst, b, h) do { if constexpr (FP8) { _Pragma("unroll") for (int n = 0; n < 2; ++n) { dst##8[n].lo = *(const PG8_LAS v4i_t*)(lds + PG8_SB(b, h) + boff + n * 2048); dst##8[n].hi = *(const PG8_LAS v4i_t*)(lds + PG8_SB(b, h) + boff + n * 2048 + 1024); } } \
        else { _Pragma("unroll") for (int n = 0; n < 2; ++n) _Pragma("unroll") for (int k = 0; k < 2; ++k) dst[n][k] = *(const PG8_LAS bf16x8*)(lds + PG8_SB(b, h) + boff + n * 2048 + k * 1024); } } while (0)
#define PG8_MMA(ai, bj, At, Bt) do { __builtin_amdgcn_s_setprio(1); if constexpr (FP8) { _Pragma("unroll") for (int m = 0; m < 4; ++m) _Pragma("unroll") for (int n = 0; n < 2; ++n) \
        asm volatile("v_mfma_f32_16x16x128_f8f6f4 %0, %1, %2, %0" : "+v"(acc[ai][bj][m][n]) : "v"(Bt##8[n]), "v"(At##8[m])); } \
        else { _Pragma("unroll") for (int m = 0; m < 4; ++m) _Pragma("unroll") for (int n = 0; n < 2; ++n) _Pragma("unroll") for (int k = 0; k < 2; ++k) \
        acc[ai][bj][m][n] = __builtin_amdgcn_mfma_f32_16x16x32_bf16(Bt[n][k], At[FP8 ? 0 : m][k], acc[ai][bj][m][n], 0, 0, 0); } __builtin_amdgcn_s_setprio(0); } while (0)
#define PG8_WAIT_V(n) asm volatile("s_waitcnt vmcnt(" #n ")" ::: "memory")
#define PG8_WAIT_L(n) asm volatile("s_waitcnt lgkmcnt(" #n ")" ::: "memory")
#define PG8_BAR __builtin_amdgcn_s_barrier()
#define PG8_SCHED __builtin_amdgcn_sched_barrier(0)
    Unit cur, nxt; int ui = 0;
    if (!S.next(0, cur)) return;
    f32x4 acc[2][2][4][2];
#pragma unroll
    for (int a = 0; a < 2; ++a)
#pragma unroll
        for (int b = 0; b < 2; ++b)
#pragma unroll
            for (int m = 0; m < 4; ++m)
#pragma unroll
                for (int n = 0; n < 2; ++n) acc[a][b][m][n] = (f32x4){0.f, 0.f, 0.f, 0.f};
    bf16x8 At[FP8 ? 1 : 4][2], B0[2][2], B1[2][2];
    v8i_t At8[FP8 ? 4 : 1], B08[2], B18[2];
    typedef int v4i_t __attribute__((ext_vector_type(4)));
    const char* cA = (const char*)g.A + (size_t)cur.pm * tstepA + cur.ka; const char* cB = (const char*)g.Bt + (size_t)cur.pnb * tstep + (Sched::SPLITK ? cur.ka : 0);
    S.a_ready(cur);
    if constexpr (SP2) {
        PG8_STAGE(PG8_SB(0, 0), cB, voffB); PG8_STAGE(PG8_SB(0, 1), cB + hstep, voffB); PG8_STAGE(PG8_SA(0, 0), cA, voffA); PG8_STAGE(PG8_SA(0, 1), cA + hstepA, voffA);
        if (wr == 1) PG8_BAR;
        PG8_WAIT_V(2); PG8_BAR;
        PG8_STAGE(PG8_SB(1, 0), cB + kstep, voffB); PG8_STAGE(PG8_SA(1, 0), cA + kstep, voffA); PG8_STAGE(PG8_SB(1, 1), cB + hstep + kstep, voffB);
        PG8_WAIT_V(6); PG8_BAR;
    } else {
        PG8_STAGE(PG8_SB(0, 0), cB, voffB); PG8_STAGE(PG8_SA(0, 0), cA, voffA); PG8_STAGE(PG8_SB(0, 1), cB + hstep, voffB); PG8_STAGE(PG8_SA(0, 1), cA + hstepA, voffA);
        if (wr == 1) PG8_BAR;
        PG8_WAIT_V(4); PG8_BAR;
        PG8_STAGE(PG8_SB(1, 0), cB + kstep, voffB); PG8_STAGE(PG8_SA(1, 0), cA + kstep, voffA); PG8_STAGE(PG8_SB(1, 1), cB + hstep + kstep, voffB);
        PG8_WAIT_V(6); PG8_BAR;
    }
    for (;;) {
        const bool has_next = S.next(ui + 1, nxt);
        const char* nA = has_next ? (const char*)g.A + (size_t)nxt.pm * tstepA + nxt.ka : cA; const char* nB = has_next ? (const char*)g.Bt + (size_t)nxt.pnb * tstep + (Sched::SPLITK ? nxt.ka : 0) : cB;
        const int ntc = Sched::SPLITK ? cur.nt : nt;
        for (int t = 0; t < ntc; t += 2) {
            const bool last = (t == ntc - 2);
            const char* a1 = cA + (size_t)(t + 1) * kstep;
            const char* a2 = last ? nA : cA + (size_t)(t + 2) * kstep; const char* b2 = last ? nB : cB + (size_t)(t + 2) * kstep;
            const char* a3 = a2 + kstep; const char* b3 = b2 + kstep;
            if (last && has_next) S.a_ready(nxt);
            if constexpr (SP2) {
            PG8_LDB(B0, 0, 0); PG8_LDB(B1, 0, 1); PG8_SCHED; PG8_LDA(At, 0, 0); PG8_STAGE(PG8_SA(1, 1), a1 + hstepA, voffA);
            PG8_WAIT_V(8); PG8_WAIT_L(0); PG8_BAR; PG8_MMA(0, 0, At, B0); PG8_MMA(0, 1, At, B1); PG8_BAR; PG8_SCHED;
            PG8_LDA(At, 0, 1); PG8_STAGE(PG8_SB(0, 0), b2, voffB); PG8_STAGE(PG8_SB(0, 1), b2 + hstep, voffB); PG8_STAGE(PG8_SA(0, 0), a2, voffA);
            PG8_WAIT_V(8); PG8_WAIT_L(0); PG8_BAR; PG8_MMA(1, 0, At, B0); PG8_MMA(1, 1, At, B1); PG8_BAR; PG8_SCHED;
            PG8_LDB(B0, 1, 0); PG8_LDB(B1, 1, 1); PG8_SCHED; PG8_LDA(At, 1, 0); PG8_STAGE(PG8_SA(0, 1), a2 + hstepA, voffA);
            PG8_WAIT_V(8); PG8_WAIT_L(0); PG8_BAR; PG8_MMA(0, 0, At, B0); PG8_MMA(0, 1, At, B1); PG8_BAR; PG8_SCHED;
            PG8_LDA(At, 1, 1); PG8_STAGE(PG8_SB(1, 0), b3, voffB); PG8_STAGE(PG8_SB(1, 1), b3 + hstep, voffB); PG8_STAGE(PG8_SA(1, 0), a3, voffA);
            PG8_WAIT_V(8); PG8_WAIT_L(0); PG8_BAR; PG8_MMA(1, 0, At, B0); PG8_MMA(1, 1, At, B1); PG8_BAR; PG8_SCHED;
            } else {
            PG8_LDB(B0, 0, 0); PG8_SCHED; PG8_LDA(At, 0, 0); PG8_STAGE(PG8_SA(1, 1), a1 + hstepA, voffA);
            PG8_WAIT_L(8); PG8_BAR; PG8_WAIT_L(0); PG8_MMA(0, 0, At, B0); PG8_BAR; PG8_SCHED;
            PG8_LDB(B1, 0, 1); PG8_STAGE(PG8_SB(0, 0), b2, voffB);
            PG8_BAR; PG8_WAIT_L(0); PG8_MMA(0, 1, At, B1); PG8_BAR;
            PG8_LDA(At, 0, 1); PG8_STAGE(PG8_SA(0, 0), a2, voffA);
            PG8_BAR; PG8_WAIT_L(0); PG8_MMA(1, 0, At, B0); PG8_BAR; PG8_SCHED;
            PG8_STAGE(PG8_SB(0, 1), b2 + hstep, voffB);
            PG8_WAIT_V(6); PG8_BAR; PG8_MMA(1, 1, At, B1); PG8_BAR;
            PG8_LDB(B0, 1, 0); PG8_SCHED; PG8_LDA(At, 1, 0); PG8_STAGE(PG8_SA(0, 1), a2 + hstepA, voffA);
            PG8_WAIT_L(8); PG8_BAR; PG8_WAIT_L(0); PG8_MMA(0, 0, At, B0); PG8_BAR; PG8_SCHED;
            PG8_LDB(B1, 1, 1); PG8_STAGE(PG8_SB(1, 0), b3, voffB);
            PG8_BAR; PG8_WAIT_L(0); PG8_MMA(0, 1, At, B1); PG8_BAR;
            PG8_LDA(At, 1, 1); PG8_STAGE(PG8_SA(1, 0), a3, voffA);
            PG8_BAR; PG8_WAIT_L(0); PG8_MMA(1, 0, At, B0); PG8_BAR; PG8_SCHED;
            PG8_STAGE(PG8_SB(1, 1), b3 + hstep, voffB);
            PG8_WAIT_V(6); PG8_BAR; PG8_MMA(1, 1, At, B1); PG8_BAR;
            }
        }
        if constexpr (ALIGN_EPI) { if (wr == 0) PG8_BAR; }
        if constexpr (!Epi::AFTER_DRAIN) { E(acc, cur, wr, wc, fr, fq); S.done(cur); }
        if (!has_next) break;
#pragma unroll
        for (int a = 0; a < 2; ++a)
#pragma unroll
            for (int b = 0; b < 2; ++b)
#pragma unroll
                for (int m = 0; m < 4; ++m)
#pragma unroll
                    for (int n = 0; n < 2; ++n) acc[a][b][m][n] = (f32x4){0.f, 0.f, 0.f, 0.f};
        cur = nxt; cA = nA; cB = nB; ++ui;
        if constexpr (ALIGN_EPI) { if (wr == 1) PG8_BAR; }
    }
    PG8_WAIT_V(0);
    if constexpr (!ALIGN_EPI) { if (wr == 0) PG8_BAR; }
    PG8_BAR;
    if constexpr (Epi::AFTER_DRAIN) { E.fused(acc, cur, wr, wc, fr, fq, lds, wid, lane); S.done(cur); }
#undef PG8_SA
#undef PG8_SB
#undef PG8_STAGE
#undef PG8_LDA
#undef PG8_LDB
#undef PG8_MMA
#undef PG8_WAIT_V
#undef PG8_WAIT_L
#undef PG8_BAR
#undef PG8_SCHED
}
}
#include <hip/hip_bf16.h>
#include <cmath>
namespace attn_body {
using bf16=__hip_bfloat16;
using bf16x8=__attribute__((ext_vector_type(8)))short;
using s16x4=__attribute__((ext_vector_type(4)))short;
using f32x16=__attribute__((ext_vector_type(16)))float;
using u32x4=__attribute__((ext_vector_type(4)))unsigned;
constexpr int D=64,DM=1024,KP=128;
constexpr int NW=8,QBLK=32,QB=QBLK*NW,KVBLK=64;
constexpr int ATTN_PITCH=DM, ATTN_UNIT_ROWS=QB;
__device__ __forceinline__ int crow(int r,int hi){return (r&3)+8*(r>>2)+4*hi;}
#define SBAR() __builtin_amdgcn_sched_barrier(0)
__device__ __forceinline__ void cmask(f32x16&p0,f32x16&p1,int jb,int qrel,int hi){
  const float NEG=-INFINITY; int kb=64*jb+4*hi;
  #pragma unroll
  for(int r=0;r<16;++r){int kv=kb+(r&3)+8*(r>>2); if(kv>qrel)p0[r]=NEG; if(kv+32>qrel)p1[r]=NEG;}
}

constexpr int NSLOT=3, SLOTB=8192;
constexpr int LDS_K=0, LDS_V=NSLOT*SLOTB, LDS_WS=2*NSLOT*SLOTB, LDS_OST=LDS_WS+NW*64*4, LDS_BYTES=LDS_OST+NW*4096;
constexpr float C2=0.125f*1.4426950408889634f;
__device__ __forceinline__ void glds16(const void*gsrc,unsigned lds_dst){unsigned keep;
  asm volatile("s_mov_b32 %0, m0\n\ts_mov_b32 m0, %2\n\ts_nop 0\n\tglobal_load_lds_dwordx4 %1, off\n\ts_mov_b32 m0, %0":"=&s"(keep):"v"(gsrc),"s"(lds_dst):"memory");}
__device__ __forceinline__ float max3f(float a,float b,float c){float r;asm("v_max3_f32 %0, %1, %2, %3":"=v"(r):"v"(a),"v"(b),"v"(c));return r;}
__device__ __forceinline__ float max2f(float a,float b){float r;asm("v_max_f32_e32 %0, %1, %2":"=v"(r):"v"(a),"v"(b));return r;}
__device__ __forceinline__ float fadd_s(float a,float b){float r;asm("v_add_f32_e32 %0, %1, %2":"=v"(r):"v"(a),"v"(b));return r;}
__device__ __forceinline__ float fsub_s(float a,float b){float r;asm("v_sub_f32_e32 %0, %1, %2":"=v"(r):"v"(a),"v"(b));return r;}
typedef float f32x2_t __attribute__((ext_vector_type(2))); typedef __bf16 bf16x2_t __attribute__((ext_vector_type(2)));
__device__ __forceinline__ unsigned cvtpk_s(float lo,float hi){f32x2_t v={lo,hi};bf16x2_t b=__builtin_convertvector(v,bf16x2_t);return __builtin_bit_cast(unsigned,b);}
#define WAIT_BAR(N) asm volatile("s_waitcnt vmcnt(" #N ") lgkmcnt(0)\n\ts_barrier":::"memory")

__device__ __forceinline__ void qkt(f32x16&p0,f32x16&p1,const char*Kslot,const bf16x8*qr,const f32x16&negm,int r32,int hi){
  const char*kb=Kslot+hi*1024+r32*16;
  #pragma unroll
  for(int d0=0;d0<4;++d0){
    const bf16x8 b0=*reinterpret_cast<const bf16x8*>(kb+d0*2048);
    const bf16x8 b1=*reinterpret_cast<const bf16x8*>(kb+d0*2048+512);
    if(d0==0){p0=__builtin_amdgcn_mfma_f32_32x32x16_bf16(b0,qr[0],negm,0,0,0);p1=__builtin_amdgcn_mfma_f32_32x32x16_bf16(b1,qr[0],negm,0,0,0);}
    else{p0=__builtin_amdgcn_mfma_f32_32x32x16_bf16(b0,qr[d0],p0,0,0,0);p1=__builtin_amdgcn_mfma_f32_32x32x16_bf16(b1,qr[d0],p1,0,0,0);}}
}
typedef __attribute__((address_space(3))) const char* lds_cptr;
typedef short v4i16_t __attribute__((ext_vector_type(4)));
__device__ __forceinline__ void kload8(bf16x8*kf,lds_cptr kp){
  kf[0]=*(const __attribute__((address_space(3))) bf16x8*)(kp);      kf[1]=*(const __attribute__((address_space(3))) bf16x8*)(kp+512);
  kf[2]=*(const __attribute__((address_space(3))) bf16x8*)(kp+2048); kf[3]=*(const __attribute__((address_space(3))) bf16x8*)(kp+2560);
  kf[4]=*(const __attribute__((address_space(3))) bf16x8*)(kp+4096); kf[5]=*(const __attribute__((address_space(3))) bf16x8*)(kp+4608);
  kf[6]=*(const __attribute__((address_space(3))) bf16x8*)(kp+6144); kf[7]=*(const __attribute__((address_space(3))) bf16x8*)(kp+6656);
}
__device__ __forceinline__ void kload2(bf16x8*kf,lds_cptr kp,int j){ kf[2*j]=*(const __attribute__((address_space(3))) bf16x8*)(kp+j*2048); kf[2*j+1]=*(const __attribute__((address_space(3))) bf16x8*)(kp+j*2048+512); }
__device__ __forceinline__ s16x4 vtr(lds_cptr p){ return __builtin_bit_cast(s16x4,__builtin_amdgcn_ds_read_tr16_b64_v4i16((__attribute__((address_space(3))) v4i16_t*)p)); }
__device__ __forceinline__ float rowmax(const f32x16&p0,const f32x16&p1){
  float a=max3f(p0[0],p0[1],p1[0]),b=max3f(p0[2],p0[3],p1[1]);a=max3f(a,p1[2],p1[3]);
  #pragma unroll
  for(int r=4;r<16;r+=4){a=max3f(a,p0[r],p0[r+1]);b=max3f(b,p0[r+2],p0[r+3]);a=max3f(a,p1[r],p1[r+1]);b=max3f(b,p1[r+2],p1[r+3]);}
  const float m=max2f(a,b);
  auto rr=__builtin_amdgcn_permlane32_swap(__float_as_uint(m),__float_as_uint(m),false,false);
  return max2f(__uint_as_float(rr[0]),__uint_as_float(rr[1]));
}
__device__ __forceinline__ void pv(f32x16*o,int vb,bf16x8 pa0,bf16x8 pa1,bf16x8 pa2,bf16x8 pa3){
  #pragma unroll
  for(int d0=0;d0<2;++d0){s16x4 lo[4],hi[4];
    #pragma unroll
    for(int ks=0;ks<4;++ks){
      asm volatile("ds_read_b64_tr_b16 %0,%1 offset:%c2":"=&v"(lo[ks]):"v"(vb),"i"(d0*4096+ks*1024):"memory");
      asm volatile("ds_read_b64_tr_b16 %0,%1 offset:%c2":"=&v"(hi[ks]):"v"(vb),"i"(d0*4096+ks*1024+512):"memory");}
    asm volatile("s_waitcnt lgkmcnt(0)":::"memory");SBAR();
    #define PK(k) (bf16x8){lo[k][0],lo[k][1],lo[k][2],lo[k][3],hi[k][0],hi[k][1],hi[k][2],hi[k][3]}
    o[d0]=__builtin_amdgcn_mfma_f32_32x32x16_bf16(pa0,PK(0),o[d0],0,0,0);
    o[d0]=__builtin_amdgcn_mfma_f32_32x32x16_bf16(pa1,PK(1),o[d0],0,0,0);
    o[d0]=__builtin_amdgcn_mfma_f32_32x32x16_bf16(pa2,PK(2),o[d0],0,0,0);
    o[d0]=__builtin_amdgcn_mfma_f32_32x32x16_bf16(pa3,PK(3),o[d0],0,0,0);
    #undef PK
  }
}

#ifndef ATTN_STORE16
#define ATTN_STORE16(p,v) (*(u32x4*)(p)=(v))
#endif
template<int THRL> __device__ __forceinline__ void attn_unit(long qrow0,int hcol,long kvrow0,int kvcol,int NT,const bf16*Q,const bf16*__restrict__ K,const bf16*__restrict__ V,bf16*O,char*shm,const int wave_){
  const int tid=wave_*64+hw_lane(),lane=tid&63,r32=lane&31,hi=lane>>5; const int wid=wave_;
  const bf16*Qw=Q+(qrow0+wid*QBLK)*DM+hcol;
  const bf16*Kh=K+kvrow0*KP+kvcol,*Vh=V+kvrow0*KP+kvcol;
  const unsigned lds0=(unsigned)(uintptr_t)shm;
  float*wsf=(float*)(shm+LDS_WS)+wid*64;
  const bf16*ksrc=Kh+(long)lane*KP+wid*8;
  const bf16*vsrc=Vh+(long)(16*(wid&3)+(lane>>2))*KP+(wid>>2)*32+(lane&3)*8;
  const unsigned kdst=lds0+LDS_K+wid*1024, vdst=lds0+LDS_V+wid*1024;
  #define DMA_K(t,slot) glds16(ksrc+(long)(t)*KVBLK*KP,(unsigned)__builtin_amdgcn_readfirstlane(kdst+(slot)))
  #define DMA_V(t,slot) glds16(vsrc+(long)(t)*KVBLK*KP,(unsigned)__builtin_amdgcn_readfirstlane(vdst+(slot)))
  const int vb0=(int)(lds0+LDS_V)+((lane>>4)&1)*32+(lane&3)*8+(4*hi+((lane&15)>>2))*64;
  const char*Kbase=shm+LDS_K; bf16x8 kf[8];
  const lds_cptr shm3=(lds_cptr)shm; const lds_cptr kp0=shm3+LDS_K+hi*1024+r32*16; const lds_cptr vp0=shm3+LDS_V+((lane>>4)&1)*32+(lane&3)*8+(4*hi+((lane&15)>>2))*64;
  DMA_K(0,0);DMA_V(0,0);DMA_K(1,SLOTB);
  bf16x8 qr[4];
  #pragma unroll
  for(int d0=0;d0<4;++d0)qr[d0]=*reinterpret_cast<const bf16x8*>(&Qw[(long)r32*DM+d0*16+hi*8]);
  float mhat=0.f,l_reg=0.f;f32x16 o[2];o[0]=f32x16{};o[1]=f32x16{};f32x16 negm=f32x16{};asm volatile("":"+v"(negm));
  #define CMASK(P0,P1,t) do{}while(0)
  bool resc=false;
  #define START(P0,P1) do{ const float rm=rowmax(P0,P1); resc=false; \
    { const float dl=rm; mhat=fadd_s(mhat,dl); \
      _Pragma("unroll") for(int r=0;r<16;++r){P0[r]=fsub_s(P0[r],dl);P1[r]=fsub_s(P1[r],dl);} \
      _Pragma("unroll") for(int r=0;r<16;++r)negm[r]=-mhat; asm volatile("":"+v"(negm)); } \
    _Pragma("unroll") for(int r=0;r<16;++r)P0[r]=__builtin_amdgcn_exp2f(P0[r]); }while(0)
  #define RESC() do{ if(resc){ asm volatile("s_waitcnt lgkmcnt(0)":::"memory"); \
      _Pragma("unroll") for(int d_=0;d_<2;++d_) _Pragma("unroll") for(int r=0;r<16;++r)o[d_][r]*=wsf[crow(r,hi)]; } }while(0)
  f32x16 pA0,pA1,pB0,pB1;
  int sl_prev=0,sl_cur=0,sl_next=SLOTB;
  #define ROT() do{sl_prev=sl_cur;sl_cur=sl_next;sl_next=(sl_next==(NSLOT-1)*SLOTB)?0:sl_next+SLOTB;}while(0)
  DMA_K(2,2*SLOTB);
  WAIT_BAR(3);
  qkt(pA0,pA1,Kbase,qr,negm,r32,hi);asm volatile("s_nop 15\n\ts_nop 7":"+v"(pA0),"+v"(pA1));CMASK(pA0,pA1,0);
  START(pA0,pA1);
  _Pragma("unroll") for(int r=0;r<16;++r)pA1[r]=__builtin_amdgcn_exp2f(pA1[r]);
  WAIT_BAR(0);
  DMA_K(3,0);DMA_V(1,SLOTB);
  ROT();
  kload8(kf,kp0+sl_cur);
  WAIT_BAR(2);
  s16x4 vlo[8],vhi[8]; u32x4 pw0,pw1,pw2,pw3;
  #define PKW(P,B) cvtpk_s(P[B],P[B+1])
  #define PAF(k) __builtin_bit_cast(bf16x8,pw##k)
  #define VFR(i) (bf16x8){vlo[i][0],vlo[i][1],vlo[i][2],vlo[i][3],vhi[i][0],vhi[i][1],vhi[i][2],vhi[i][3]}
  #define PIN(x) asm volatile("":"+v"(x))
  #define MX3(a,b,c) __builtin_fmaxf(__builtin_fmaxf((a),(b)),(c))
  #define GAPA(MF,A0,A1,A2,A3,W0,W1,PW) do{ MF; sacc+=A0; sacc+=A1; sacc+=A2; sacc+=A3; PIN(sacc); W0; W1; PIN(PW); SBAR(); }while(0)
  #define EX(v) __builtin_amdgcn_exp2f(v)
  #define GAPB(MF,X,B) do{ MF; X[B]=EX(X[B]); X[B+1]=EX(X[B+1]); X[B+2]=EX(X[B+2]); X[B+3]=EX(X[B+3]); PIN(X); SBAR(); }while(0)
  #define VRD(i) do{ vlo[i]=vtr(vp_+(((i)>>2)*4096+((i)&3)*1024)); vhi[i]=vtr(vp_+(((i)>>2)*4096+((i)&3)*1024+512)); }while(0)
  #define KRD(G,j) do{ if(G){ kload2(kf,kp0+sl_next,j); SBAR(); } }while(0)
  #define STEP(C0,C1,P0,P1,t,GK,GV,GL) do{ SBAR(); \
    const lds_cptr vp_=vp0+sl_prev; \
    VRD(0); SBAR(); float sacc=(P0[0]+P0[1]); \
    GAPA(C0=__builtin_amdgcn_mfma_f32_32x32x16_bf16(kf[0],qr[0],negm,0,0,0), P0[2],P0[3],P0[4],P0[5],     pw0[0]=PKW(P0,0), pw0[1]=PKW(P0,2), pw0); \
    VRD(4); SBAR(); GAPA(C1=__builtin_amdgcn_mfma_f32_32x32x16_bf16(kf[1],qr[0],negm,0,0,0), P0[6],P0[7],P0[8],P0[9],     pw0[2]=PKW(P0,4), pw0[3]=PKW(P0,6), pw0); \
    VRD(1); SBAR(); GAPA(C0=__builtin_amdgcn_mfma_f32_32x32x16_bf16(kf[2],qr[1],C0,0,0,0),   P0[10],P0[11],P0[12],P0[13], pw1[0]=PKW(P0,8), pw1[1]=PKW(P0,10), pw1); \
    VRD(5); SBAR(); GAPA(C1=__builtin_amdgcn_mfma_f32_32x32x16_bf16(kf[3],qr[1],C1,0,0,0),   P0[14],P0[15],P1[0],P1[1],   pw1[2]=PKW(P0,12),pw1[3]=PKW(P0,14), pw1); \
    VRD(2); SBAR(); GAPA(C0=__builtin_amdgcn_mfma_f32_32x32x16_bf16(kf[4],qr[2],C0,0,0,0),   P1[2],P1[3],P1[4],P1[5],     pw2[0]=PKW(P1,0), pw2[1]=PKW(P1,2), pw2); \
    VRD(6); SBAR(); GAPA(C1=__builtin_amdgcn_mfma_f32_32x32x16_bf16(kf[5],qr[2],C1,0,0,0),   P1[6],P1[7],P1[8],P1[9],     pw2[2]=PKW(P1,4), pw2[3]=PKW(P1,6), pw2); \
    VRD(3); SBAR(); GAPA(C0=__builtin_amdgcn_mfma_f32_32x32x16_bf16(kf[6],qr[3],C0,0,0,0),   P1[10],P1[11],P1[12],P1[13], pw3[0]=PKW(P1,8), pw3[1]=PKW(P1,10), pw3); \
    VRD(7); SBAR(); GAPA(C1=__builtin_amdgcn_mfma_f32_32x32x16_bf16(kf[7],qr[3],C1,0,0,0),   P1[14],P1[15],0.f,0.f,       pw3[2]=PKW(P1,12),pw3[3]=PKW(P1,14), pw3); \
    l_reg+=sacc; \
    if(GK){DMA_K((t)+3,sl_cur);} if(GV){DMA_V((t)+1,sl_next);} \
    CMASK(C0,C1,t); \
    { float a=MX3(C0[0],C0[1],C1[0]),b=MX3(C0[2],C0[3],C1[1]); a=MX3(a,C1[2],C1[3]); \
      _Pragma("unroll") for(int r=4;r<16;r+=4){a=MX3(a,C0[r],C0[r+1]);b=MX3(b,C0[r+2],C0[r+3]);a=MX3(a,C1[r],C1[r+1]);b=MX3(b,C1[r+2],C1[r+3]);} \
      float rm=__builtin_fmaxf(a,b); { auto rr=__builtin_amdgcn_permlane32_swap(__float_as_uint(rm),__float_as_uint(rm),false,false); rm=__builtin_fmaxf(__uint_as_float(rr[0]),__uint_as_float(rr[1])); } \
      resc=false; \
      if(__builtin_expect(__any(rm>(float)THRL),0)){ const float dl=__builtin_fmaxf(rm,0.f); mhat+=dl; \
        _Pragma("unroll") for(int r=0;r<16;++r){C0[r]-=dl;C1[r]-=dl;} \
        _Pragma("unroll") for(int r=0;r<16;++r)negm[r]=-mhat; asm volatile("":"+v"(negm)); \
        const float f=__builtin_amdgcn_exp2f(-dl); l_reg*=f; if(hi==0)wsf[r32]=f; resc=true; } } \
    SBAR(); \
    GAPB(o[0]=__builtin_amdgcn_mfma_f32_32x32x16_bf16(PAF(0),VFR(0),o[0],0,0,0), C0,0); \
    GAPB(o[1]=__builtin_amdgcn_mfma_f32_32x32x16_bf16(PAF(0),VFR(4),o[1],0,0,0), C0,4); \
    KRD(GL,0); GAPB(o[0]=__builtin_amdgcn_mfma_f32_32x32x16_bf16(PAF(1),VFR(1),o[0],0,0,0), C0,8); \
    KRD(GL,1); GAPB(o[1]=__builtin_amdgcn_mfma_f32_32x32x16_bf16(PAF(1),VFR(5),o[1],0,0,0), C0,12); \
    KRD(GL,2); GAPB(o[0]=__builtin_amdgcn_mfma_f32_32x32x16_bf16(PAF(2),VFR(2),o[0],0,0,0), C1,0); \
    KRD(GL,3); GAPB(o[1]=__builtin_amdgcn_mfma_f32_32x32x16_bf16(PAF(2),VFR(6),o[1],0,0,0), C1,4); \
    GAPB(o[0]=__builtin_amdgcn_mfma_f32_32x32x16_bf16(PAF(3),VFR(3),o[0],0,0,0), C1,8); \
    GAPB(o[1]=__builtin_amdgcn_mfma_f32_32x32x16_bf16(PAF(3),VFR(7),o[1],0,0,0), C1,12); \
    }while(0)
  int t=1;
  #undef CMASK
  #define CMASK(P0,P1,t) do{}while(0)
  for(;t+5<NT;t+=2){
    STEP(pB0,pB1,pA0,pA1,t,true,true,true);     WAIT_BAR(2); RESC(); ROT();
    STEP(pA0,pA1,pB0,pB1,t+1,true,true,true);   WAIT_BAR(2); RESC(); ROT();
  }
  #undef CMASK
  #define CMASK(P0,P1,t) do{}while(0)
  #define ENDW(tt) do{ if((tt)+3<NT){WAIT_BAR(2);} else if((tt)+2<NT){WAIT_BAR(1);} else {WAIT_BAR(0);} }while(0)
  for(;t+1<NT;t+=2){
    STEP(pB0,pB1,pA0,pA1,t,(t+3<NT),(t+1<NT),(t+1<NT));       ENDW(t);   RESC(); ROT();
    STEP(pA0,pA1,pB0,pB1,t+1,(t+4<NT),(t+2<NT),(t+2<NT));     ENDW(t+1); RESC(); ROT();
  }
  STEP(pB0,pB1,pA0,pA1,NT-1,false,false,false); RESC();
  { float sacc=pB0[0]+pB0[1]; _Pragma("unroll") for(int r=2;r<16;++r)sacc+=pB0[r]; _Pragma("unroll") for(int r=0;r<16;++r)sacc+=pB1[r]; l_reg+=sacc;
    pw0=(u32x4){PKW(pB0,0),PKW(pB0,2),PKW(pB0,4),PKW(pB0,6)};pw1=(u32x4){PKW(pB0,8),PKW(pB0,10),PKW(pB0,12),PKW(pB0,14)};pw2=(u32x4){PKW(pB1,0),PKW(pB1,2),PKW(pB1,4),PKW(pB1,6)};pw3=(u32x4){PKW(pB1,8),PKW(pB1,10),PKW(pB1,12),PKW(pB1,14)};
    SBAR(); pv(o,vb0+sl_cur,PAF(0),PAF(1),PAF(2),PAF(3)); }
  #undef PKW
  #undef PAF
  #undef VFR
  #undef PIN
  #undef MX3
  #undef GAPA
  #undef GAPB
  #undef EX
  #undef VRD
  #undef KRD
  #undef STEP
  #undef ENDW
  {auto rr=__builtin_amdgcn_permlane32_swap(__float_as_uint(l_reg),__float_as_uint(l_reg),false,false);l_reg=__uint_as_float(rr[0])+__uint_as_float(rr[1]);}
  if(hi==0)wsf[32+r32]=l_reg;asm volatile("s_waitcnt lgkmcnt(0)":::"memory");
  float rli[16];
  #pragma unroll
  for(int r=0;r<16;++r)rli[r]=__builtin_amdgcn_rcpf(wsf[32+crow(r,hi)]);
  bf16*Ow=O+(qrow0+wid*QBLK)*DM+hcol;
  { bf16*stg=(bf16*)(shm+LDS_OST)+wid*2048;
    #pragma unroll
    for(int r=0;r<16;++r){const int orow=crow(r,hi);
      #pragma unroll
      for(int d0=0;d0<2;++d0)stg[orow*64+d0*32+r32]=__float2bfloat16(o[d0][r]*rli[r]);}
    asm volatile("s_waitcnt lgkmcnt(0)":::"memory");
    #pragma unroll
    for(int i=0;i<4;++i){const int row=i*8+(lane>>3),ch=lane&7; const u32x4 v=*(const u32x4*)(stg+row*64+ch*8); ATTN_STORE16(Ow+(long)row*DM+ch*8,v);} }
  asm volatile("s_waitcnt lgkmcnt(0)\n\ts_barrier":::"memory");
  #undef DMA_K
  #undef DMA_V
  #undef CMASK
  #undef START
  #undef RESC
  #undef ROT
}
constexpr int ATTN_LDS_BYTES=LDS_BYTES;
#undef SBAR
#undef WAIT_BAR
}
#define GAS __attribute__((address_space(1)))
#define LAS __attribute__((address_space(3)))
typedef unsigned short bf16;
typedef unsigned v4u __attribute__((ext_vector_type(4)));
typedef float f32x4 __attribute__((ext_vector_type(4)));
typedef short bf16x8 __attribute__((ext_vector_type(8)));
typedef GAS unsigned gu32;
typedef GAS unsigned long long gu64;
#define RLX_AGENT __ATOMIC_RELAXED, __HIP_MEMORY_SCOPE_AGENT
#define LDS_WAIT() asm volatile("s_waitcnt lgkmcnt(0)" ::: "memory")
#define VM_WAIT() asm volatile("s_waitcnt vmcnt(0)" ::: "memory")
__device__ __forceinline__ unsigned long long rt() { return __builtin_amdgcn_s_memrealtime(); }
__device__ __forceinline__ unsigned f2bf(float f) { unsigned u = __builtin_bit_cast(unsigned, f); return (u + 0x7fffu + ((u >> 16) & 1u)) >> 16; }
__device__ __forceinline__ unsigned pk2(float lo, float hi) { return f2bf(lo) | (f2bf(hi) << 16); }

#define XB_TMO      128
#define XB_XCNT(j)  (256  + 64 * (j))
#define XB_XSUB(j)  (1280 + 64 * (j))
#define XB_XGEN(j)  (2304 + 64 * (j))
#define XB_TOP      3328
#define XB_TOPGEN   3392
#define XCD_BAR_WORDS 3456
#define XB_SPIN_CAP (1u << 18)

__device__ __forceinline__ unsigned xb_ld(unsigned* p)              { return __hip_atomic_load(p, __ATOMIC_RELAXED, __HIP_MEMORY_SCOPE_AGENT); }
__device__ __forceinline__ unsigned xb_add(unsigned* p, unsigned v) { return __hip_atomic_fetch_add(p, v, __ATOMIC_RELAXED, __HIP_MEMORY_SCOPE_AGENT); }
__device__ __forceinline__ unsigned xb_xcc_id() { return (unsigned)__builtin_amdgcn_s_getreg((3 << 11) | 20) & 0xFu; }
#define XB_SPIN(cond, bar) do { unsigned _sp = 0; while (cond) { __builtin_amdgcn_s_sleep(1); \
    if ((++_sp & 255u) == 0u) { if (xb_ld(&(bar)[XB_TMO])) break; if (_sp > XB_SPIN_CAP) { atomicAdd(&(bar)[XB_TMO], 1u); break; } } } } while (0)

struct XcdBarrier {
    unsigned* bar; unsigned x; int wv;
    volatile LAS unsigned* st;
};

__device__ __forceinline__ XcdBarrier xcd_barrier_post(unsigned* bar, volatile LAS unsigned* st, int wv) {
    XcdBarrier b; b.bar = bar; b.x = xb_xcc_id(); b.st = st; b.wv = wv;
    if (threadIdx.x == 0) (void)xb_add(&bar[XB_XCNT(b.x)], 1u);
    return b;
}
__device__ __forceinline__ void xcd_barrier_complete(unsigned* bar, unsigned x, unsigned& nloc, unsigned& nx) {
    const unsigned G = gridDim.x * gridDim.y * gridDim.z;
    unsigned sum, cnt, mine, sp = 0u;
    for (;;) {
        sum = 0u; cnt = 0u; mine = 0u;
#pragma unroll
        for (unsigned j = 0; j < 16; ++j) { const unsigned c = xb_ld(&bar[XB_XCNT(j)]); sum += c; cnt += (c > 0u) ? 1u : 0u; mine = (j == x) ? c : mine; }
        if (sum == G) break;
        __builtin_amdgcn_s_sleep(1);
        if ((++sp & 255u) == 0u) { if (xb_ld(&bar[XB_TMO])) break; if (sp > XB_SPIN_CAP) { atomicAdd(&bar[XB_TMO], 1u); break; } }
    }
    nloc = mine > 0u ? mine : 1u; nx = cnt > 0u ? cnt : 1u;
}

__device__ __forceinline__ void xcd_barrier(const XcdBarrier& b) {
    asm volatile("s_waitcnt vmcnt(0)" ::: "memory");
    __syncthreads();
    if (b.wv == 0 && hw_lane() == 0) {
        unsigned* bar = b.bar;
        __builtin_amdgcn_s_waitcnt(0);
        unsigned nloc = b.st[0], nx = b.st[1];
        if (nloc == 0u) { xcd_barrier_complete(bar, b.x, nloc, nx); b.st[0] = nloc; b.st[1] = nx; }
        const unsigned old = xb_add(&bar[XB_XSUB(b.x)], 1u);
        const unsigned gen = old / nloc;
        if (old + 1u == (gen + 1u) * nloc) {
            __builtin_amdgcn_fence(__ATOMIC_RELEASE, "agent");
            asm volatile("s_waitcnt vmcnt(0)" ::: "memory");
            const unsigned og = xb_add(&bar[XB_TOP], 1u);
            const unsigned tg = og / nx;
            if (og + 1u == (tg + 1u) * nx) xb_add(&bar[XB_TOPGEN], 1u);
            else XB_SPIN(xb_ld(&bar[XB_TOPGEN]) == tg, bar);
            __builtin_amdgcn_fence(__ATOMIC_ACQUIRE, "agent");
            xb_add(&bar[XB_XGEN(b.x)], 1u);
            asm volatile("s_waitcnt vmcnt(0)" ::: "memory");
        } else {
            XB_SPIN(xb_ld(&bar[XB_XGEN(b.x)]) == gen, bar);
            __builtin_amdgcn_fence(__ATOMIC_ACQUIRE, "agent");
            asm volatile("s_waitcnt vmcnt(0)" ::: "memory");
        }
    }
    __syncthreads();
}

#ifndef PROBE
#define PROBE 0
#endif
#ifndef DEBUG_NAN
#define DEBUG_NAN 0
#endif
#ifndef TSEL
#define TSEL -1
#endif
#ifndef CYSEL
#define CYSEL -1
#endif
#ifndef TSCALE10
#define TSCALE10 0
#endif
#if TSEL >= 0
#define TS(k) do { if (blockIdx.x == 0 && F.wave == 0 && hw_lane() == 0) { unsigned long long* ts_ = (unsigned long long*)(F.ws + WS_CTL + 32768); const unsigned long long now_ = __builtin_amdgcn_s_memrealtime(); ts_[1 + (k)] += now_ - ts_[0]; ts_[0] = now_; } } while (0)
#else
#define TS(k) do {} while (0)
#endif
#ifndef USE_SEQ_SCAN
#define USE_SEQ_SCAN 0
#endif
constexpr int NWAVES = 8;
constexpr int DMODEL = 1024, NBATCH = 8, SEQL = 4096, CTXL = 256, DEPTH = 4;
constexpr int TL = NBATCH * SEQL, TC = NBATCH * CTXL, TT = TL + TC;
constexpr int KVLEN = SEQL + CTXL;
constexpr int INW = 2688, INWP = 2816, ATTIN = 768, SHIFTW = 1920;
constexpr int FFD = 2816, FFE = 3584, NEXP = 8;
constexpr int LORA_K = 384, LORA_N = 2560;
constexpr int MAXPANEL = 280, MAXSLOT = MAXPANEL * 256;
constexpr float RMS_EPS = 1e-6f, GN_EPS = 64e-5f;

constexpr size_t MiB = 1u << 20;
constexpr size_t WS_CTL = 0, CTL_ZERO_BYTES = 64 * 1024;
constexpr size_t WS_MOD = 1 * MiB;
constexpr size_t WS_ROPE = 2 * MiB;
constexpr size_t WS_ROUTE = 3 * MiB;
constexpr size_t RT_E = 0, RT_G = 160 * 1024, RT_S = 448 * 1024, RT_BLK = 768 * 1024, RT_WCNT = 800 * 1024;
constexpr size_t WS_XB = 12 * MiB;
constexpr size_t WS_WIN = 80 * MiB, WS_WOUT = 86 * MiB, WS_WLORA = 88 * MiB;
constexpr size_t WS_WFF = 100 * MiB;
constexpr size_t WS_WFF_D_DENSE = WS_WFF + 12 * MiB, WS_WFF_D_MOE = WS_WFF + 112 * MiB;
constexpr size_t WS_ACT = 270 * MiB;
constexpr size_t WS_QO = WS_ACT, WS_KB = WS_ACT + 68 * MiB, WS_VB = WS_ACT + 77 * MiB, WS_P = WS_ACT + 86 * MiB, WS_OSC = WS_P;
constexpr size_t WS_R = WS_ACT + 273 * MiB, WS_K = WS_ACT + 307 * MiB, WS_V = WS_ACT + 341 * MiB, WS_KK = WS_ACT + 375 * MiB, WS_LIN = WS_ACT + 409 * MiB;
constexpr size_t WS_LOUT = WS_ACT + 435 * MiB;
constexpr size_t WS_SPT = WS_WFF, WS_SG = WS_WFF + 68 * MiB, WS_SQ = WS_ACT + 605 * MiB;
constexpr size_t WS_HID = WS_ACT;
constexpr size_t WS_AG = WS_ACT, WS_AG8 = WS_ACT + 140 * MiB, WS_HIDM = WS_ACT + 210 * MiB;
constexpr size_t WS_WFF_D_MOE8 = WS_WFF + 56 * MiB;
constexpr float W8SCALE = 64.0f, H8SCALE = 8.0f, HID8SCALE = 4.0f;
constexpr size_t WS_SIDE = 1000 * MiB;
constexpr size_t WS_END = 1012 * MiB;
static_assert(WS_LOUT + (size_t)TT * LORA_N * 2 <= WS_END && WS_HIDM + (size_t)MAXSLOT * FFE <= WS_END && WS_P + (size_t)TT * INWP * 2 <= WS_R && WS_OSC + (size_t)2 * TT * 512 * 4 <= WS_R, "ws map");
static_assert(WS_WFF_D_MOE + (size_t)NEXP * 1024 * FFE * 2 <= WS_ACT && WS_XB + (size_t)TT * 1024 * 2 <= WS_WIN && WS_WIN + (size_t)INWP * 1024 * 2 <= WS_WOUT && WS_WLORA + (size_t)LORA_N * LORA_K * 2 <= WS_WFF, "ws map 2");
constexpr int CW_BAR = 4096;

constexpr int RING_OFF = 0, RING_BYTES = 131072;
constexpr int LDSCTL_OFF = RING_BYTES;
constexpr int MISC_OFF = LDSCTL_OFF;
constexpr int LT_PEXP = LDSCTL_OFF + 256;
constexpr int LT_NPAN = LT_PEXP + 320 * 4;
constexpr int LT_INP = LT_NPAN + 64;
constexpr int LT_TMP = LT_INP + 256;
constexpr int LDS_BYTES = 147456;
static_assert(LT_TMP + 8192 + 1024 <= LDS_BYTES, "LDS map");

struct Frame {
    LAS unsigned char* lds;
    volatile LAS unsigned* MISC;
    gu32* ctl;
    int tid, lane, wave, vcu, G;
    unsigned char* ws;
    float* out;
};
struct Args { const float* in[30]; float* out; unsigned char* ws; };
__device__ __forceinline__ const void* inp_ld(const Frame& F, int k) {
    const LAS unsigned* t = (const LAS unsigned*)(F.lds + LT_INP) + 2 * k; unsigned lo = t[0], hi = t[1];
    lo = __builtin_amdgcn_readfirstlane(lo); hi = __builtin_amdgcn_readfirstlane(hi);
    return (const void*)(const GAS void*)(((unsigned long long)hi << 32) | lo);
}
#define IN_X 0
#define IN_C 1
#define IN_CTX 2
#define IN_CCTX 3
#define IN_ADAW 4
#define IN_ADAB 5
#define IN_N1G 6
#define IN_N2G 7
#define IN_WIN 8
#define IN_WOUT 9
#define IN_QG 10
#define IN_KG 11
#define IN_MU 12
#define IN_W0 13
#define IN_W2 14
#define IN_A0 15
#define IN_A2 16
#define IN_G2 17
#define IN_KKW 18
#define IN_KA 19
#define IN_RK 20
#define IN_GNW 21
#define IN_GNB 22
#define IN_FWG 23
#define IN_FWU 24
#define IN_FWD 25
#define IN_ROUTER 26
#define IN_MWG 27
#define IN_MWU 28
#define IN_MWD 29

__device__ __forceinline__ int vlaunder(int v) { asm volatile("" : "+v"(v)); return v; }
__device__ __forceinline__ unsigned char* launder(unsigned char* p) { unsigned long long v = (unsigned long long)p; asm volatile("" : "+s"(v)); return (unsigned char*)(GAS unsigned char*)v; }
#define INP(k) ((const float*)inp_ld(F, (k)))
__device__ __forceinline__ const void* inp_ld(const struct Frame& F, int k);
template <int CTRL_> __device__ __forceinline__ float dpp_mov(float v) { return __builtin_bit_cast(float, __builtin_amdgcn_update_dpp(0, __builtin_bit_cast(int, v), CTRL_, 0xf, 0xf, true)); }
__device__ __forceinline__ float row_sum16(float v) { v += dpp_mov<0xB1>(v); v += dpp_mov<0x4E>(v); v += dpp_mov<0x141>(v); v += dpp_mov<0x128>(v); return v; }
__device__ __forceinline__ float wave_sum(float v) { v = row_sum16(v); v += __shfl_xor(v, 16); v += __shfl_xor(v, 32); return v; }
__device__ __forceinline__ float half_sum(float v) { v = row_sum16(v); v += __shfl_xor(v, 16); return v; }
__device__ __forceinline__ float bflo(unsigned w) { return __builtin_bit_cast(float, w << 16); }
__device__ __forceinline__ float bfhi(unsigned w) { return __builtin_bit_cast(float, w & 0xffff0000u); }
typedef float f32x2_t_ __attribute__((ext_vector_type(2))); typedef __bf16 bf16x2_t_ __attribute__((ext_vector_type(2)));
__device__ __forceinline__ unsigned pkbf(float lo, float hi) { f32x2_t_ v = {lo, hi}; bf16x2_t_ b = __builtin_convertvector(v, bf16x2_t_); return __builtin_bit_cast(unsigned, b); }
__device__ __forceinline__ float sigm(float x) { return __builtin_amdgcn_rcpf(1.0f + __builtin_amdgcn_exp2f(-1.4426950408889634f * x)); }

__device__ __forceinline__ void p_prologue(Frame& F, const Args& A) {
    unsigned char* const ws = launder(F.ws);
    const int tid = (F.wave * 64 + hw_lane()), lane = tid & 63; (void)lane;
    LAS float* sc = (LAS float*)(F.lds + RING_OFF);
    for (int i = tid; i < 9 * 1024; i += NWAVES * 64) { const int b = i >> 10, k = i & 1023; const float v = (b < 8) ? INP(IN_C)[b * 1024 + k] : INP(IN_CCTX)[k]; sc[i] = v * sigm(v); }
    __syncthreads();
    const int gw = F.vcu * NWAVES + F.wave, NGW = F.G * NWAVES;
    float* mod = (float*)(ws + WS_MOD);
    for (int it = (int)blockIdx.x + F.G * F.wave; it < DEPTH * 96; it += NGW) {
        const int l = it / 96, j = (it % 96) * 64 + lane;
        const float* W = INP(IN_ADAW) + (size_t)l * 1024 * 6144 + j;
        float acc[9];
#pragma unroll
        for (int b = 0; b < 9; ++b) acc[b] = 0.f;
        for (int k = 0; k < 1024; k += 16) {
            float wv[16];
#pragma unroll
            for (int u = 0; u < 16; ++u) wv[u] = W[(size_t)(k + u) * 6144];
#pragma unroll
            for (int b = 0; b < 9; ++b)
#pragma unroll
                for (int u4 = 0; u4 < 4; ++u4) { const f32x4 s = *(const LAS f32x4*)(sc + b * 1024 + k + 4 * u4); acc[b] += (s[0] * wv[4 * u4] + s[1] * wv[4 * u4 + 1]) + (s[2] * wv[4 * u4 + 2] + s[3] * wv[4 * u4 + 3]); }
        }
        const float bias = INP(IN_ADAB)[l * 6144 + j];
#pragma unroll
        for (int b = 0; b < 9; ++b) mod[((size_t)l * 9 + b) * 6144 + j] = acc[b] + bias;
    }
    float* cs = (float*)(ws + WS_ROPE);
    for (int i = blockIdx.x * (NWAVES * 64) + tid; i < 4096 * 32; i += F.G * NWAVES * 64) {
        const int t = i >> 5, k = i & 31; const int pos = (k < 16) ? (t >> 6) : (t & 63);
        const float inv = powf(10000.0f, -(float)(2 * (k & 15)) / 32.0f); const float ang = (float)pos * inv;
        float s, c; sincosf(ang, &s, &c); cs[2 * i] = c; cs[2 * i + 1] = s;
    }
    __syncthreads();
}

struct WItem { const float* W; unsigned char* WT; int K, N, k0, n0, drow0, f8; };
__device__ __forceinline__ void tr_load(const WItem& w, float (&tv)[32], int lane) {
#pragma unroll
    for (int i = 0; i < 32; ++i) tv[i] = w.W[(size_t)(w.k0 + 2 * i + (lane >> 5)) * w.N + w.n0 + (lane & 31)];
}
__device__ __forceinline__ void tr_finish(const WItem& w, const float (&tv)[32], LAS float* scr, int lane) {
#pragma unroll
    for (int i = 0; i < 32; ++i) scr[(2 * i + (lane >> 5)) * 33 + (lane & 31)] = tv[i];
    LDS_WAIT(); asm volatile("" ::: "memory");
    if (w.f8) { const int c = lane & 3;
#pragma unroll
        for (int j = 0; j < 2; ++j) { const int n = (lane >> 2) + 16 * j; const LAS float* s = scr + (16 * c) * 33 + n;
            v4u o;
            o.x = pg8::pk_fp8x4(s[0 * 33] * W8SCALE, s[1 * 33] * W8SCALE, s[2 * 33] * W8SCALE, s[3 * 33] * W8SCALE); o.y = pg8::pk_fp8x4(s[4 * 33] * W8SCALE, s[5 * 33] * W8SCALE, s[6 * 33] * W8SCALE, s[7 * 33] * W8SCALE);
            o.z = pg8::pk_fp8x4(s[8 * 33] * W8SCALE, s[9 * 33] * W8SCALE, s[10 * 33] * W8SCALE, s[11 * 33] * W8SCALE); o.w = pg8::pk_fp8x4(s[12 * 33] * W8SCALE, s[13 * 33] * W8SCALE, s[14 * 33] * W8SCALE, s[15 * 33] * W8SCALE);
            *(v4u*)(w.WT + (size_t)(w.drow0 + n) * w.K + w.k0 + 16 * c) = o; }
    } else { const int c = lane & 7;
#pragma unroll
        for (int j = 0; j < 4; ++j) { const int n = (lane >> 3) + 8 * j; const LAS float* s = scr + (8 * c) * 33 + n;
            v4u o; o.x = pkbf(s[0 * 33], s[1 * 33]); o.y = pkbf(s[2 * 33], s[3 * 33]); o.z = pkbf(s[4 * 33], s[5 * 33]); o.w = pkbf(s[6 * 33], s[7 * 33]);
            *(v4u*)((bf16*)w.WT + (size_t)(w.drow0 + n) * w.K + w.k0 + 8 * c) = o; } }
    LDS_WAIT(); asm volatile("" ::: "memory");
}
__device__ __forceinline__ int gu_row(int n) { return 256 * (n >> 7) + (n & 127); }

__device__ __forceinline__ WItem wprep_decode(Frame& F, unsigned char* const ws, const int l, const int it) {
    constexpr int I_IN = 16 * (INW / 32), I_OUT = 16 * 32;
    const bool moe = (l & 1) != 0; const int j = l >> 1;
    constexpr int I_DG = 16 * (FFD / 32), I_MG = 16 * (FFE / 32);
    int r = it; WItem w;
    if (r < I_IN) { const int nb = r % (INW / 32), kb = r / (INW / 32); w = WItem{INP(IN_WIN) + (size_t)l * 1024 * INW, ws + WS_WIN, 1024, INW, kb * 64, nb * 32, nb * 32, 0}; return w; } r -= I_IN;
    if (r < I_OUT) { const int nb = r % 32, kb = r / 32; w = WItem{INP(IN_WOUT) + (size_t)l * 1024 * 1024, ws + WS_WOUT, 1024, 1024, kb * 64, nb * 32, nb * 32, 0}; return w; } r -= I_OUT;
    if (!moe) {
        if (r < I_DG) { const int nb = r % (FFD / 32), kb = r / (FFD / 32); w = WItem{INP(IN_FWG) + (size_t)j * 1024 * FFD, ws + WS_WFF, 1024, FFD, kb * 64, nb * 32, gu_row(nb * 32), 0}; return w; } r -= I_DG;
        if (r < I_DG) { const int nb = r % (FFD / 32), kb = r / (FFD / 32); w = WItem{INP(IN_FWU) + (size_t)j * 1024 * FFD, ws + WS_WFF, 1024, FFD, kb * 64, nb * 32, gu_row(nb * 32) + 128, 0}; return w; } r -= I_DG;
        { const int nb = r % 32, kb = r / 32; w = WItem{INP(IN_FWD) + (size_t)j * FFD * 1024, ws + WS_WFF_D_DENSE, FFD, 1024, kb * 64, nb * 32, nb * 32, 0}; return w; }
    }
    constexpr int I_MD = (FFE / 64) * 32; constexpr int PER = 2 * I_MG + I_MD; const int e = r / PER; r -= e * PER;
    unsigned char* WGU = ws + WS_WFF + (size_t)e * (2 * FFE) * 1024; unsigned char* WD = ws + WS_WFF_D_MOE8 + (size_t)e * 1024 * FFE;
    const size_t eo = ((size_t)j * NEXP + e) * 1024 * FFE;
    if (r < I_MG) { const int nb = r % (FFE / 32), kb = r / (FFE / 32); w = WItem{INP(IN_MWG) + eo, WGU, 1024, FFE, kb * 64, nb * 32, gu_row(nb * 32), 1}; return w; } r -= I_MG;
    if (r < I_MG) { const int nb = r % (FFE / 32), kb = r / (FFE / 32); w = WItem{INP(IN_MWU) + eo, WGU, 1024, FFE, kb * 64, nb * 32, gu_row(nb * 32) + 128, 1}; return w; } r -= I_MG;
    { const int nb = r % 32, kb = r / 32; w = WItem{INP(IN_MWD) + eo, WD, FFE, 1024, kb * 64, nb * 32, nb * 32, 1}; return w; }
}
__device__ __forceinline__ void p_wprep(Frame& F, const Args& A, int l, int part, gu32* ctr = nullptr) {
    unsigned char* const ws = launder(F.ws);
    const int tid = (F.wave * 64 + hw_lane()), lane = tid & 63; (void)lane;
    LAS float* scr = (LAS float*)(F.lds + RING_OFF + F.wave * 16384);
    const int gw = F.vcu * NWAVES + F.wave, NGW = F.G * NWAVES;
    bf16* WIN = (bf16*)(ws + WS_WIN); bf16* WLORA = (bf16*)(ws + WS_WLORA);
    constexpr int I_IN = 16 * (INW / 32), I_OUT = 16 * 32;
    const bool moe = (l & 1) != 0;
    constexpr int I_DG = 16 * (FFD / 32), I_DD = (FFD / 64) * 32, I_MG = 16 * (FFE / 32), I_MD = (FFE / 64) * 32;
    const int nff = moe ? NEXP * (2 * I_MG + I_MD) : (2 * I_DG + I_DD);
    const int NIT = I_IN + I_OUT + nff;
    const int lo = part ? I_IN + I_OUT : 0, hi = part ? NIT : I_IN + I_OUT;
    (void)ctr;
    {
        int it = lo + gw; WItem wa, wb; float ta[32], tb[32];
        if (it < hi) { wa = wprep_decode(F, ws, l, it); tr_load(wa, ta, lane); }
        for (; it < hi; it += 2 * NGW) {
            const int i2 = it + NGW, i3 = i2 + NGW;
            if (i2 < hi) { wb = wprep_decode(F, ws, l, i2); tr_load(wb, tb, lane); }
            tr_finish(wa, ta, scr, lane);
            if (i3 < hi) { wa = wprep_decode(F, ws, l, i3); tr_load(wa, ta, lane); }
            if (i2 < hi) tr_finish(wb, tb, scr, lane);
        }
    }
    if (part) return;
    for (int i = blockIdx.x * (NWAVES * 64) + tid; i < 16384; i += F.G * NWAVES * 64) ((v4u*)(WIN + (size_t)INW * 1024))[i] = (v4u){0u, 0u, 0u, 0u};
    const float* w2 = INP(IN_W2) + (size_t)l * 2 * 64 * 512; const float* a2 = INP(IN_A2) + (size_t)l * 2 * 64 * 512; const float* g2 = INP(IN_G2) + (size_t)l * 128 * 512;
    for (int i = blockIdx.x * (NWAVES * 64) + tid; i < LORA_N * 64; i += F.G * NWAVES * 64) {
        const int n = i >> 6, k = (i & 63) * 2; const int sec = n >> 9, cn = n & 511;
        float v0 = 0.f, v1 = 0.f;
        if (sec < 2) { const int kk = k - 64 * sec; if (kk >= 0 && kk < 64) { v0 = w2[((size_t)sec * 64 + kk) * 512 + cn]; v1 = w2[((size_t)sec * 64 + kk + 1) * 512 + cn]; } }
        else if (sec < 4) { const int d = sec - 2, kk = k - 64 * d; if (kk >= 0 && kk < 64) { v0 = a2[((size_t)d * 64 + kk) * 512 + cn]; v1 = a2[((size_t)d * 64 + kk + 1) * 512 + cn]; } }
        else { v0 = g2[(size_t)k * 512 + cn]; v1 = g2[(size_t)(k + 1) * 512 + cn]; }
        ((unsigned*)WLORA)[i] = pkbf(v0, v1);
    }
}

template <bool ROUTER, bool COMBINE, bool SRCF32, bool SIDE = false>
__device__ __forceinline__ void p_norm(Frame& F, const Args& A, int l, int which, const float* srcL, const float* srcC, int lprev, int nrows = TT) {
    unsigned char* const ws = launder(F.ws);
    const int tid = (F.wave * 64 + hw_lane()), lane = tid & 63; (void)lane;
    const int gw = F.vcu * NWAVES + F.wave, NGW = F.G * NWAVES;
    const float* mod = (const float*)(ws + WS_MOD) + (size_t)l * 9 * 6144;
    const float* gain = A.in[which ? IN_N2G : IN_N1G] + l * 1024;
    bf16* H = (bf16*)F.out;
    const float* route_g = (const float*)(ws + WS_ROUTE + RT_G); const int* route_s = (const int*)(ws + WS_ROUTE + RT_S);
    int cnt0 = 0, cnt1 = 0, cnt2 = 0, cnt3 = 0, cnt4 = 0, cnt5 = 0, cnt6 = 0, cnt7 = 0;
    LAS float* rwl = (LAS float*)(F.lds + RING_OFF);
    if (ROUTER) {
        __syncthreads();
        const float* rw = INP(IN_ROUTER) + (size_t)(l >> 1) * 1024 * 8;
        for (int i = tid; i < 2048; i += NWAVES * 64) { const f32x4 w = *(const f32x4*)(rw + 4 * i); const int col = i >> 1, e4 = (i & 1) * 4, jj = col >> 8, ln = (col & 255) >> 2, q = col & 3;
            *(LAS f32x4*)(rwl + (((jj * 4 + q) * 64 + ln) * 8 + e4)) = w; }
        __syncthreads();
    }
    uint2 nx[2][4]; f32x4 nf[2][4]; float cg[2][2]; int cs[2][2];
#pragma unroll
    for (int r = 0; r < 2; ++r) { cg[r][0] = cg[r][1] = 0.f; cs[r][0] = cs[r][1] = 0;
#pragma unroll
        for (int jj = 0; jj < 4; ++jj) { nx[r][jj] = make_uint2(0u, 0u); nf[r][jj] = (f32x4){0.f, 0.f, 0.f, 0.f}; } }
#define PN_LOAD(r_, row_) do { const int row__ = (row_); if (row__ < nrows) { \
        if (SRCF32) { const float* xr_ = (row__ < TL) ? srcL + (size_t)row__ * 1024 : srcC + (size_t)(row__ - TL) * 1024; _Pragma("unroll") for (int jj = 0; jj < 4; ++jj) nf[r_][jj] = *(const f32x4*)(xr_ + 4 * ln + 256 * jj); } \
        else { const bf16* xr_ = (const bf16*)(ws + WS_XB) + (size_t)row__ * 1024; _Pragma("unroll") for (int jj = 0; jj < 4; ++jj) nx[r_][jj] = *(const uint2*)(xr_ + 4 * ln + 256 * jj); } \
        if (COMBINE) { cg[r_][0] = route_g[2 * row__]; cg[r_][1] = route_g[2 * row__ + 1]; cs[r_][0] = route_s[2 * row__]; cs[r_][1] = route_s[2 * row__ + 1]; } } } while (0)
    int ln = vlaunder(lane);
    PN_LOAD(0, gw); PN_LOAD(1, gw + NGW);
    for (int row0 = gw; row0 < nrows; row0 += 2 * NGW) {
        ln = vlaunder(lane);
        const bool ok1 = row0 + NGW < nrows;
        f32x4 v[2][4]; float g0[2], g1[2]; int s0[2], s1[2];
#pragma unroll
        for (int r = 0; r < 2; ++r) { g0[r] = cg[r][0]; g1[r] = cg[r][1]; s0[r] = cs[r][0]; s1[r] = cs[r][1];
#pragma unroll
            for (int jj = 0; jj < 4; ++jj) { if (SRCF32) v[r][jj] = nf[r][jj]; else { const uint2 w = nx[r][jj]; v[r][jj] = (f32x4){bflo(w.x), bfhi(w.x), bflo(w.y), bfhi(w.y)}; } } }
        PN_LOAD(0, row0 + 2 * NGW); PN_LOAD(1, row0 + 3 * NGW);
        if (COMBINE) {
            const bf16* Y = (const bf16*)(ws + WS_AG);
            uint2 yy0[2][4], yy1[2][4];
#pragma unroll
            for (int r = 0; r < 2; ++r)
#pragma unroll
                for (int jj = 0; jj < 4; ++jj) { const int col = 4 * ln + 256 * jj; yy0[r][jj] = *(const uint2*)(Y + (size_t)s0[r] * 1024 + col); yy1[r][jj] = *(const uint2*)(Y + (size_t)s1[r] * 1024 + col); }
#pragma unroll
            for (int r = 0; r < 2; ++r) { const int row = row0 + r * NGW; const int bsel = (row < TL) ? (row >> 12) : 8;
                const float* m5 = (const float*)(ws + WS_MOD) + ((size_t)lprev * 9 + bsel) * 6144 + 5 * 1024;
                bf16* xbr = (bf16*)(ws + WS_XB) + (size_t)row * 1024;
#pragma unroll
                for (int jj = 0; jj < 4; ++jj) { const int col = 4 * ln + 256 * jj;
                    const uint2 y0 = yy0[r][jj], y1 = yy1[r][jj]; const f32x4 mm = *(const f32x4*)(m5 + col);
                    v[r][jj][0] += mm[0] * (g0[r] * bflo(y0.x) + g1[r] * bflo(y1.x)); v[r][jj][1] += mm[1] * (g0[r] * bfhi(y0.x) + g1[r] * bfhi(y1.x));
                    v[r][jj][2] += mm[2] * (g0[r] * bflo(y0.y) + g1[r] * bflo(y1.y)); v[r][jj][3] += mm[3] * (g0[r] * bfhi(y0.y) + g1[r] * bfhi(y1.y));
                    if (r == 0 || ok1) *(uint2*)(xbr + col) = make_uint2(pkbf(v[r][jj][0], v[r][jj][1]), pkbf(v[r][jj][2], v[r][jj][3])); } }
        }
        if (SIDE) {
#pragma unroll
            for (int r = 0; r < 2; ++r) { const int row = row0 + r * NGW;
                if ((r == 0 || ok1) && row >= TL) {
                    const bf16* sd = (const bf16*)(ws + WS_SIDE) + (size_t)(row - TL) * 1024; bf16* xbr = (bf16*)(ws + WS_XB) + (size_t)row * 1024;
                    uint2 sv[3][4];
#pragma unroll
                    for (int q = 0; q < 3; ++q)
#pragma unroll
                        for (int jj = 0; jj < 4; ++jj) sv[q][jj] = *(const uint2*)(sd + (size_t)q * TC * 1024 + 4 * ln + 256 * jj);
#pragma unroll
                    for (int jj = 0; jj < 4; ++jj) {
#pragma unroll
                        for (int q = 0; q < 3; ++q) { const uint2 w = sv[q][jj]; v[r][jj][0] += bflo(w.x); v[r][jj][1] += bfhi(w.x); v[r][jj][2] += bflo(w.y); v[r][jj][3] += bfhi(w.y); }
                        *(uint2*)(xbr + 4 * ln + 256 * jj) = make_uint2(pkbf(v[r][jj][0], v[r][jj][1]), pkbf(v[r][jj][2], v[r][jj][3])); } } }
        }
        float ss[2];
#pragma unroll
        for (int r = 0; r < 2; ++r) { ss[r] = 0.f;
#pragma unroll
            for (int jj = 0; jj < 4; ++jj) ss[r] += (v[r][jj][0] * v[r][jj][0] + v[r][jj][1] * v[r][jj][1]) + (v[r][jj][2] * v[r][jj][2] + v[r][jj][3] * v[r][jj][3]); }
        ss[0] = row_sum16(ss[0]); ss[1] = row_sum16(ss[1]);
#pragma unroll
        for (int o = 16; o < 64; o <<= 1) { const float t0 = __shfl_xor(ss[0], o), t1 = __shfl_xor(ss[1], o); ss[0] += t0; ss[1] += t1; }
        float rstd[2]; const float* shp[2];
#pragma unroll
        for (int r = 0; r < 2; ++r) { const int row = row0 + r * NGW; const int bsel = (row < TL) ? (row >> 12) : 8;
            rstd[r] = __builtin_amdgcn_rsqf(ss[r] * (1.0f / 1024.0f) + RMS_EPS); shp[r] = mod + (size_t)bsel * 6144 + (which ? 3 : 0) * 1024; }
        float lg[2][8];
#pragma unroll
        for (int r = 0; r < 2; ++r)
#pragma unroll
            for (int e = 0; e < 8; ++e) lg[r][e] = 0.f;
#pragma unroll
        for (int jj = 0; jj < 4; ++jj) { const int col = 4 * ln + 256 * jj;
            const f32x4 gg = *(const f32x4*)(gain + col); f32x4 h[2];
#pragma unroll
            for (int r = 0; r < 2; ++r) { const int row = row0 + r * NGW;
                const f32x4 sh = *(const f32x4*)(shp[r] + col), sc = *(const f32x4*)(shp[r] + 1024 + col);
                h[r] = (v[r][jj] * rstd[r]) * gg * (sc + 1.0f) + sh;
                if (r == 0 || ok1) {
                    if (ROUTER) *(unsigned*)((unsigned char*)H + (size_t)row * 1024 + col) = pg8::pk_fp8x4(h[r][0] * H8SCALE, h[r][1] * H8SCALE, h[r][2] * H8SCALE, h[r][3] * H8SCALE);
                    else { uint2 o; o.x = pkbf(h[r][0], h[r][1]); o.y = pkbf(h[r][2], h[r][3]); *(uint2*)(H + (size_t)row * 1024 + col) = o; } } }
            if (ROUTER) {
#pragma unroll
                for (int q = 0; q < 4; ++q) { const LAS float* rp = rwl + ((jj * 4 + q) * 64 + ln) * 8; const f32x4 ra = *(const LAS f32x4*)rp, rb = *(const LAS f32x4*)(rp + 4);
#pragma unroll
                    for (int r = 0; r < 2; ++r) { lg[r][0] += h[r][q] * ra[0]; lg[r][1] += h[r][q] * ra[1]; lg[r][2] += h[r][q] * ra[2]; lg[r][3] += h[r][q] * ra[3];
                        lg[r][4] += h[r][q] * rb[0]; lg[r][5] += h[r][q] * rb[1]; lg[r][6] += h[r][q] * rb[2]; lg[r][7] += h[r][q] * rb[3]; } } }
        }
        if (ROUTER) {
#pragma unroll
            for (int o = 1; o < 64; o <<= 1) { float t[2][8];
#pragma unroll
                for (int r = 0; r < 2; ++r)
#pragma unroll
                    for (int e = 0; e < 8; ++e) t[r][e] = __shfl_xor(lg[r][e], o);
#pragma unroll
                for (int r = 0; r < 2; ++r)
#pragma unroll
                    for (int e = 0; e < 8; ++e) lg[r][e] += t[r][e]; }
#pragma unroll
            for (int r = 0; r < 2; ++r) { const int row = row0 + r * NGW;
                if (r == 0 || ok1) {
                    int e0 = 0; float v0 = lg[r][0];
#pragma unroll
                    for (int e = 1; e < 8; ++e) if (lg[r][e] > v0) { v0 = lg[r][e]; e0 = e; }
                    int e1 = -1; float v1 = -INFINITY;
#pragma unroll
                    for (int e = 0; e < 8; ++e) if (e != e0 && lg[r][e] > v1) { v1 = lg[r][e]; e1 = e; }
                    const float q0 = 1.0f / (1.0f + __expf(v1 - v0)), q1 = 1.0f - q0;
                    if (ln == 0) { ((int*)(ws + WS_ROUTE + RT_E))[row] = e0 | (e1 << 8); ((float*)(ws + WS_ROUTE + RT_G))[2 * row] = q0; ((float*)(ws + WS_ROUTE + RT_G))[2 * row + 1] = q1; }
                    cnt0 += (e0 == 0) + (e1 == 0); cnt1 += (e0 == 1) + (e1 == 1); cnt2 += (e0 == 2) + (e1 == 2); cnt3 += (e0 == 3) + (e1 == 3);
                    cnt4 += (e0 == 4) + (e1 == 4); cnt5 += (e0 == 5) + (e1 == 5); cnt6 += (e0 == 6) + (e1 == 6); cnt7 += (e0 == 7) + (e1 == 7); } }
        }
    }
#undef PN_LOAD
    if (ROUTER) {
        int* wcnt = (int*)(ws + WS_ROUTE + RT_WCNT);
        if (ln == 0) { int* w = wcnt + (size_t)gw * 8; w[0] = cnt0; w[1] = cnt1; w[2] = cnt2; w[3] = cnt3; w[4] = cnt4; w[5] = cnt5; w[6] = cnt6; w[7] = cnt7; }
    }
}
__device__ __forceinline__ void p_final_combine(Frame& F, int lprev) {
    unsigned char* const ws = launder(F.ws);
    const int tid = (F.wave * 64 + hw_lane()), lane = tid & 63; (void)lane;
    const int gw = F.vcu * NWAVES + F.wave, NGW = F.G * NWAVES;
    const float* route_g = (const float*)(ws + WS_ROUTE + RT_G); const int* route_s = (const int*)(ws + WS_ROUTE + RT_S);
    const bf16* Y = (const bf16*)(ws + WS_AG);
    float g0n = 0.f, g1n = 0.f; int s0n = 0, s1n = 0;
    if (gw < TL) { g0n = route_g[2 * gw]; g1n = route_g[2 * gw + 1]; s0n = route_s[2 * gw]; s1n = route_s[2 * gw + 1]; }
    for (int row = gw; row < TL; row += NGW) {
        const int bsel = row >> 12;
        const float* m5 = (const float*)(ws + WS_MOD) + ((size_t)lprev * 9 + bsel) * 6144 + 5 * 1024;
        const float g0 = g0n, g1 = g1n; const int s0 = s0n, s1 = s1n;
        float* xw = F.out + (size_t)row * 1024; const bf16* xbr = (const bf16*)(ws + WS_XB) + (size_t)row * 1024;
        uint2 xw2[4], y0[4], y1[4];
#pragma unroll
        for (int jj = 0; jj < 4; ++jj) { const int col = 4 * lane + 256 * jj; xw2[jj] = *(const uint2*)(xbr + col); y0[jj] = *(const uint2*)(Y + (size_t)s0 * 1024 + col); y1[jj] = *(const uint2*)(Y + (size_t)s1 * 1024 + col); }
        if (row + NGW < TL) { const int rn = row + NGW; g0n = route_g[2 * rn]; g1n = route_g[2 * rn + 1]; s0n = route_s[2 * rn]; s1n = route_s[2 * rn + 1]; }
#pragma unroll
        for (int jj = 0; jj < 4; ++jj) { const int col = 4 * lane + 256 * jj; const f32x4 mm = *(const f32x4*)(m5 + col);
            f32x4 v = (f32x4){bflo(xw2[jj].x), bfhi(xw2[jj].x), bflo(xw2[jj].y), bfhi(xw2[jj].y)};
            v[0] += mm[0] * (g0 * bflo(y0[jj].x) + g1 * bflo(y1[jj].x)); v[1] += mm[1] * (g0 * bfhi(y0[jj].x) + g1 * bfhi(y1[jj].x));
            v[2] += mm[2] * (g0 * bflo(y0[jj].y) + g1 * bflo(y1[jj].y)); v[3] += mm[3] * (g0 * bfhi(y0[jj].y) + g1 * bfhi(y1[jj].y));
            *(f32x4*)(xw + col) = v; }
    }
}

__device__ __forceinline__ void p_prep(Frame& F, const Args& A, int l) {
    unsigned char* const ws = launder(F.ws);
    const int tid = (F.wave * 64 + hw_lane()), lane = tid & 63; (void)lane;
    const int gw = F.vcu * NWAVES + F.wave, NGW = F.G * NWAVES;
    const unsigned* P = (const unsigned*)(ws + WS_P);
    const float* cs = (const float*)(ws + WS_ROPE);
    bf16* QO = (bf16*)(ws + WS_QO); bf16* KB = (bf16*)(ws + WS_KB); bf16* VB = (bf16*)(ws + WS_VB);
    unsigned* Rst = (unsigned*)(ws + WS_R); unsigned* Kst = (unsigned*)(ws + WS_K); unsigned* Vst = (unsigned*)(ws + WS_V); unsigned* KKst = (unsigned*)(ws + WS_KK); unsigned* LIN = (unsigned*)(ws + WS_LIN);
    const int d0 = 2 * (lane & 31);
    const float qg0 = INP(IN_QG)[l * 64 + d0], qg1 = INP(IN_QG)[l * 64 + d0 + 1], kg0 = INP(IN_KG)[l * 64 + d0], kg1 = INP(IN_KG)[l * 64 + d0 + 1];
    float mu0[15], mu1[15];
#pragma unroll
    for (int i = 0; i < 15; ++i) { mu0[i] = INP(IN_MU)[l * SHIFTW + 128 * i + 2 * lane]; mu1[i] = INP(IN_MU)[l * SHIFTW + 128 * i + 2 * lane + 1]; }
    float kw0[4], kw1[4];
#pragma unroll
    for (int i = 0; i < 4; ++i) { kw0[i] = INP(IN_KKW)[l * 512 + 128 * i + 2 * lane]; kw1[i] = INP(IN_KKW)[l * 512 + 128 * i + 2 * lane + 1]; }
    const float C2 = 0.125f * 1.4426950408889634f;
    const float sgn = (lane & 16) ? 1.0f : -1.0f;
    for (int w0 = gw; w0 * 17 < TT; w0 += NGW) {
        const int rbeg = w0 * 17;
        unsigned cur[21], nxt[21], prv[15];
#pragma unroll
        for (int i = 0; i < 15; ++i) prv[i] = 0u;
        {   const int r = rbeg; const bool lat = r < TL; const int pos = lat ? (r & 4095) : ((r - TL) & 255);
            if (pos != 0) {
#pragma unroll
                for (int i = 0; i < 15; ++i) prv[i] = P[(size_t)(r - 1) * (INWP / 2) + 64 * (i + 6) + lane]; }
#pragma unroll
            for (int i = 0; i < 21; ++i) cur[i] = P[(size_t)r * (INWP / 2) + 64 * i + lane];
        }
        for (int k = 0; k < 17; ++k) {
            const int r = rbeg + k; const bool lat = r < TL; const int pos = lat ? (r & 4095) : ((r - TL) & 255); const int slen = lat ? 4096 : 256;
            const bool has_next = (pos != slen - 1);
            const bool load_next = (k < 16) || has_next;
            if (load_next && r + 1 < TT) {
#pragma unroll
                for (int i = 0; i < 21; ++i) nxt[i] = P[(size_t)(r + 1) * (INWP / 2) + 64 * i + lane];
            } else {
#pragma unroll
                for (int i = 0; i < 21; ++i) nxt[i] = 0u;
            }
            const int b = lat ? (r >> 12) : ((r - TL) >> 8);
            const size_t kvrow = (size_t)b * KVLEN + (lat ? pos : 4096 + pos);
            f32x4 csv = (f32x4){1.f, 0.f, 1.f, 0.f};
            if (lat) csv = *(const f32x4*)(cs + ((size_t)pos * 32 + 2 * (lane & 15)) * 2);
#pragma unroll
            for (int i = 0; i < 5; ++i) {
                float x0 = bflo(cur[i]), x1 = bfhi(cur[i]);
                const float ss = half_sum(x0 * x0 + x1 * x1);
                const float rstd = __builtin_amdgcn_rsqf(ss * (1.0f / 64.0f) + RMS_EPS);
                x0 = x0 * rstd * (i < 4 ? qg0 : kg0); x1 = x1 * rstd * (i < 4 ? qg1 : kg1);
                const float p0 = __shfl_xor(x0, 16), p1 = __shfl_xor(x1, 16);
                const float y0 = x0 * csv[0] + sgn * p0 * csv[1], y1 = x1 * csv[2] + sgn * p1 * csv[3];
                if (i < 4) *(unsigned*)(QO + (size_t)r * 1024 + 128 * i + 2 * lane) = pkbf(y0 * C2, y1 * C2);
                else *(unsigned*)(KB + kvrow * 128 + 2 * lane) = pkbf(y0, y1);
            }
            *(unsigned*)(VB + kvrow * 128 + 2 * lane) = cur[5];
            const float hn = has_next ? 1.0f : 0.0f;
#pragma unroll
            for (int i = 0; i < 15; ++i) {
                const float c0 = bflo(cur[i + 6]), c1 = bfhi(cur[i + 6]);
                const float a0 = bflo(prv[i]) + hn * bflo(nxt[i + 6]), a1 = bfhi(prv[i]) + hn * bfhi(nxt[i + 6]);
                const float s0 = c0 + mu0[i] * (0.5f * a0 - c0), s1 = c1 + mu1[i] * (0.5f * a1 - c1);
                if (i < 4) Rst[(size_t)r * 256 + 64 * i + lane] = pkbf(s0, s1);
                else if (i < 8) { Kst[(size_t)r * 256 + 64 * (i - 4) + lane] = pkbf(s0, s1);
                    const float t0 = s0 * kw0[i - 4], t1 = s1 * kw1[i - 4]; const float q = half_sum(t0 * t0 + t1 * t1); const float rn = __builtin_amdgcn_rsqf(q + 1e-12f);
                    KKst[(size_t)r * 256 + 64 * (i - 4) + lane] = pkbf(t0 * rn, t1 * rn); }
                else if (i < 12) Vst[(size_t)r * 256 + 64 * (i - 8) + lane] = pkbf(s0, s1);
                else if (i == 12) { const float e0 = __builtin_amdgcn_exp2f(2.0f * 1.4426950408889634f * s0), e1 = __builtin_amdgcn_exp2f(2.0f * 1.4426950408889634f * s1);
                    LIN[(size_t)r * (LORA_K / 2) + lane] = pkbf(1.0f - 2.0f * __builtin_amdgcn_rcpf(1.0f + e0), 1.0f - 2.0f * __builtin_amdgcn_rcpf(1.0f + e1)); }
                else if (i == 13) LIN[(size_t)r * (LORA_K / 2) + 64 + lane] = pkbf(s0, s1);
                else LIN[(size_t)r * (LORA_K / 2) + 128 + lane] = pkbf(sigm(s0), sigm(s1));
            }
#pragma unroll
            for (int i = 0; i < 15; ++i) prv[i] = has_next ? cur[i + 6] : 0u;
#pragma unroll
            for (int i = 0; i < 21; ++i) cur[i] = nxt[i];
        }
    }
}

template <int CTRL> __device__ __forceinline__ float dppf(float v) { return __builtin_bit_cast(float, __builtin_amdgcn_update_dpp(0, __builtin_bit_cast(int, v), CTRL, 0xf, 0xf, true)); }
__device__ __forceinline__ float red16(float v) { v += dppf<0xB1>(v); v += dppf<0x4E>(v); v += dppf<0x141>(v); v += dppf<0x128>(v); return v; }
constexpr int SC_TS = 32, SC_W = 352;
__device__ __forceinline__ void p_scan(Frame& F, const Args& A, int l) {
    unsigned char* const ws = launder(F.ws);
    const int tid = (F.wave * 64 + hw_lane()), lane = tid & 63; (void)lane;
    LAS float* buf = (LAS float*)(F.lds + RING_OFF);
    float* OSC = (float*)(ws + WS_OSC);
    constexpr int NCH = KVLEN / SC_TS;
    for (int item = blockIdx.x; item < 256; item += F.G) {
        const int chain = item >> 1, rh = item & 1, dir = chain & 1, bh = chain >> 1, b = bh >> 3, h = bh & 7;
        const int row = tid >> 4, c = tid & 15;
        float S0 = 0.f, S1 = 0.f, S2 = 0.f, S3 = 0.f;
        const bool stg = tid < 352; const int sub = (tid >= 176) ? 1 : 0, pp = tid - 176 * sub, a = pp >> 5, w = pp & 31;
        const unsigned* p1; int pitch1 = 256;
        if (a == 0 || a == 2) p1 = (const unsigned*)(ws + WS_KK) + h * 32 + w;
        else if (a == 1) { p1 = (const unsigned*)(ws + WS_LOUT) + dir * 256 + h * 32 + w; pitch1 = LORA_N / 2; }
        else if (a == 3) p1 = (const unsigned*)(ws + WS_K) + h * 32 + w;
        else if (a == 4) p1 = (const unsigned*)(ws + WS_R) + h * 32 + w;
        else p1 = (const unsigned*)(ws + WS_V) + h * 32 + rh * 16 + (pp - 160);
        const unsigned* p2 = (const unsigned*)(ws + WS_LOUT) + 512 + dir * 256 + h * 32 + w;
        const bool two = (a == 2 || a == 3);
        const int cw = (a == 5) ? 0 : 2 * w;
        const float cw0 = INP(IN_W0)[l * 1024 + dir * 512 + h * 64 + cw], cw1 = INP(IN_W0)[l * 1024 + dir * 512 + h * 64 + cw + 1];
        const float ca0 = INP(IN_A0)[l * 1024 + dir * 512 + h * 64 + cw], ca1 = INP(IN_A0)[l * 1024 + dir * 512 + h * 64 + cw + 1];
        const float ck0 = INP(IN_KA)[l * 512 + h * 64 + cw], ck1 = INP(IN_KA)[l * 512 + h * 64 + cw + 1];
        unsigned st[16], st2[16];
#define SC_TOK(s) ((s) < CTXL ? (TL + b * CTXL + (dir ? (CTXL - 1 - (s)) : (s))) : (b * SEQL + (dir ? (SEQL - 1 - ((s) - CTXL)) : ((s) - CTXL))))
#define SC_LOAD(ci) do { if (stg) { _Pragma("unroll") for (int i = 0; i < 16; ++i) { const int s = (ci) * SC_TS + 2 * i + sub; const size_t tok = (size_t)SC_TOK(s); \
            st[i] = p1[tok * pitch1]; st2[i] = two ? p2[tok * (LORA_N / 2)] : 0u; } } } while (0)
#define SC_STORE(bi) do { if (stg) { _Pragma("unroll") for (int i = 0; i < 16; ++i) { \
            float x0 = bflo(st[i]), x1 = bfhi(st[i]); \
            if (a == 1) { x0 = __builtin_amdgcn_exp2f(-1.4426950408889634f * 0.6065306597126334f * sigm(x0 + cw0)); x1 = __builtin_amdgcn_exp2f(-1.4426950408889634f * 0.6065306597126334f * sigm(x1 + cw1)); } \
            else if (a == 2) { x0 *= sigm(bflo(st2[i]) + ca0); x1 *= sigm(bfhi(st2[i]) + ca1); } \
            else if (a == 3) { x0 *= 1.0f + (sigm(bflo(st2[i]) + ca0) - 1.0f) * ck0; x1 *= 1.0f + (sigm(bfhi(st2[i]) + ca1) - 1.0f) * ck1; } \
            LAS float* dp = buf + ((bi) * SC_TS + 2 * i + sub) * SC_W + 2 * pp; dp[0] = x0; dp[1] = x1; } } } while (0)
        __syncthreads();
        SC_LOAD(0); SC_STORE(0); __syncthreads();
        for (int ci = 0; ci < NCH; ++ci) {
            if (ci + 1 < NCH) SC_LOAD(ci + 1);
            const LAS float* bp = buf + (ci & 1) * SC_TS * SC_W;
#pragma unroll 2
            for (int stp = 0; stp < SC_TS; ++stp) {
                const LAS float* sp = bp + stp * SC_W;
                const f32x4 kk = *(const LAS f32x4*)(sp + 4 * c), w4 = *(const LAS f32x4*)(sp + 64 + 4 * c), bb = *(const LAS f32x4*)(sp + 128 + 4 * c), kd = *(const LAS f32x4*)(sp + 192 + 4 * c), rr = *(const LAS f32x4*)(sp + 256 + 4 * c);
                const float vv = sp[320 + row];
                float sa = (S0 * kk[0] + S1 * kk[1]) + (S2 * kk[2] + S3 * kk[3]); sa = red16(sa);
                S0 = S0 * w4[0] + (vv * kd[0] - sa * bb[0]); S1 = S1 * w4[1] + (vv * kd[1] - sa * bb[1]); S2 = S2 * w4[2] + (vv * kd[2] - sa * bb[2]); S3 = S3 * w4[3] + (vv * kd[3] - sa * bb[3]);
                float o = (S0 * rr[0] + S1 * rr[1]) + (S2 * rr[2] + S3 * rr[3]); o = red16(o);
                if (c == 0) { const int s = ci * SC_TS + stp; OSC[((size_t)dir * TT + (size_t)SC_TOK(s)) * 512 + h * 64 + rh * 32 + row] = o; }
            }
            if (ci + 1 < NCH) SC_STORE((ci + 1) & 1);
            __syncthreads();
        }
#undef SC_TOK
#undef SC_LOAD
#undef SC_STORE
    }
}

__device__ __forceinline__ void p_readout(Frame& F, const Args& A, int l) {
    unsigned char* const ws = launder(F.ws);
    const int tid = (F.wave * 64 + hw_lane()), lane = tid & 63; (void)lane;
    const int gw = F.vcu * NWAVES + F.wave, NGW = F.G * NWAVES;
    const float* OSC = (const float*)(ws + WS_OSC);
    const unsigned* Rst = (const unsigned*)(ws + WS_R); const unsigned* Vst = (const unsigned*)(ws + WS_V); const unsigned* Kst = (const unsigned*)(ws + WS_K); const unsigned* LOUT = (const unsigned*)(ws + WS_LOUT);
    bf16* QO = (bf16*)(ws + WS_QO);
    float rk0[4], rk1[4], gw0[4], gw1[4], gb0[4], gb1[4], ka0[4], ka1[4], aa0[4], aa1[4], ab0[4], ab1[4];
#pragma unroll
    for (int i = 0; i < 4; ++i) { const int cc = 128 * i + 2 * lane, cidx = l * 512 + cc; rk0[i] = INP(IN_RK)[cidx]; rk1[i] = INP(IN_RK)[cidx + 1]; gw0[i] = INP(IN_GNW)[cidx]; gw1[i] = INP(IN_GNW)[cidx + 1]; gb0[i] = INP(IN_GNB)[cidx]; gb1[i] = INP(IN_GNB)[cidx + 1];
        ka0[i] = INP(IN_KA)[cidx]; ka1[i] = INP(IN_KA)[cidx + 1]; aa0[i] = INP(IN_A0)[l * 1024 + cc]; aa1[i] = INP(IN_A0)[l * 1024 + cc + 1]; ab0[i] = INP(IN_A0)[l * 1024 + 512 + cc]; ab1[i] = INP(IN_A0)[l * 1024 + 512 + cc + 1]; }
    for (int row = gw; row < TT; row += NGW) {
#pragma unroll
        for (int i = 0; i < 4; ++i) {
            const size_t off = (size_t)row * 256 + 64 * i + lane; const size_t lo = (size_t)row * (LORA_N / 2) + 64 * i + lane;
            const float2 oa = *(const float2*)(OSC + (size_t)row * 512 + 128 * i + 2 * lane), ob = *(const float2*)(OSC + ((size_t)TT + row) * 512 + 128 * i + 2 * lane);
            const float o0 = oa.x + ob.x, o1 = oa.y + ob.y;
            const float mean = half_sum(o0 + o1) * (1.0f / 64.0f);
            const float d0 = o0 - mean, d1 = o1 - mean;
            const float var = half_sum(d0 * d0 + d1 * d1) * (1.0f / 64.0f);
            const float rs = __builtin_amdgcn_rsqf(var + GN_EPS);
            const unsigned rw = Rst[off], vw = Vst[off], kw = Kst[off], pa = LOUT[lo + 512], pb = LOUT[lo + 768], gwd = LOUT[lo + 1024];
            const float ks0 = bflo(kw) * (2.0f + (sigm(bflo(pa) + aa0[i]) + sigm(bflo(pb) + ab0[i]) - 2.0f) * ka0[i]), ks1 = bfhi(kw) * (2.0f + (sigm(bfhi(pa) + aa1[i]) + sigm(bfhi(pb) + ab1[i]) - 2.0f) * ka1[i]);
            const float bsum = half_sum(bflo(rw) * ks0 * rk0[i] + bfhi(rw) * ks1 * rk1[i]);
            const float y0 = d0 * rs * gw0[i] + gb0[i] + bsum * bflo(vw), y1 = d1 * rs * gw1[i] + gb1[i] + bsum * bfhi(vw);
            *(unsigned*)(QO + (size_t)row * 1024 + 512 + 128 * i + 2 * lane) = pkbf(y0 * bflo(gwd), y1 * bfhi(gwd));
        }
    }
}

__device__ __forceinline__ void p_route(Frame& F, int nrows) {
    unsigned char* const ws = launder(F.ws);
    const int tid = (F.wave * 64 + hw_lane()), lane = tid & 63; (void)lane;
    const int gw = F.vcu * NWAVES + F.wave, NGW = F.G * NWAVES;
    const int* wcnt = (const int*)(ws + WS_ROUTE + RT_WCNT);
    LAS int* pexp = (LAS int*)(F.lds + LT_PEXP); LAS int* npan = (LAS int*)(F.lds + LT_NPAN); LAS int* tmp = (LAS int*)(F.lds + LT_TMP);
    {   const int e = lane & 7, part = lane >> 3;
        const int p = F.wave * 8 + part;
        const int wb = p * (NGW / 64), we = wb + NGW / 64; const int myw0 = F.vcu * NWAVES;
        int tot = 0, before = 0;
#pragma unroll 16
        for (int w = wb; w < we; ++w) { const int cv = wcnt[(size_t)w * 8 + e]; tot += cv; if (w < myw0) before += cv; }
        tmp[p * 16 + e] = tot; tmp[p * 16 + 8 + e] = before;
    }
    __syncthreads();
    if (tid < 8) { int tot = 0, before = 0; for (int p = 0; p < 64; ++p) { tot += tmp[p * 16 + tid]; before += tmp[p * 16 + 8 + tid]; } tmp[1024 + tid] = tot; tmp[1032 + tid] = before; }
    __syncthreads();
    if (tid == 0) { int acc = 0; for (int e = 0; e < 8; ++e) { const int padded = (tmp[1024 + e] + 255) & ~255; tmp[1040 + e] = acc; acc += padded; tmp[1048 + e] = acc; } npan[0] = acc >> 8; }
    __syncthreads();
    for (int p = tid; p < 320; p += NWAVES * 64) { int e = 7; for (int q = 7; q >= 0; --q) if (p * 256 < tmp[1048 + q]) e = q; pexp[p] = e; }
    int base0, base1, base2, base3, base4, base5, base6, base7;
    {   int bsv[8];
#pragma unroll
        for (int e = 0; e < 8; ++e) bsv[e] = tmp[1040 + e] + tmp[1032 + e];
        typedef int i32x4 __attribute__((ext_vector_type(4)));
#pragma unroll
        for (int w = 0; w < 7; ++w) { const i32x4* wp = (const i32x4*)(wcnt + (size_t)(F.vcu * NWAVES + w) * 8); const i32x4 c0 = wp[0], c1 = wp[1]; const int mk = (w < F.wave) ? 1 : 0;
            bsv[0] += mk * c0[0]; bsv[1] += mk * c0[1]; bsv[2] += mk * c0[2]; bsv[3] += mk * c0[3]; bsv[4] += mk * c1[0]; bsv[5] += mk * c1[1]; bsv[6] += mk * c1[2]; bsv[7] += mk * c1[3]; }
        base0 = bsv[0]; base1 = bsv[1]; base2 = bsv[2]; base3 = bsv[3]; base4 = bsv[4]; base5 = bsv[5]; base6 = bsv[6]; base7 = bsv[7];
    }
    const int* route_e = (const int*)(ws + WS_ROUTE + RT_E); int* route_s = (int*)(ws + WS_ROUTE + RT_S);
    const unsigned char* H = (const unsigned char*)F.out; unsigned char* AG = ws + WS_AG8;
    int ee_n = 0; v4u a_n = (v4u){0u, 0u, 0u, 0u};
    if (gw < nrows) { ee_n = route_e[gw]; a_n = ((const v4u*)(H + (size_t)gw * 1024))[lane]; }
    for (int row = gw; row < nrows; row += NGW) {
        const int ee = ee_n; const v4u a = a_n; const int e0 = ee & 255, e1 = ee >> 8;
        if (row + NGW < nrows) { ee_n = route_e[row + NGW]; a_n = ((const v4u*)(H + (size_t)(row + NGW) * 1024))[lane]; }
        int s0 = 0, s1 = 0;
#define RT_TAKE(E, B) do { if (e0 == E) { s0 = B; B += 1; } if (e1 == E) { s1 = B; B += 1; } } while (0)
        RT_TAKE(0, base0); RT_TAKE(1, base1); RT_TAKE(2, base2); RT_TAKE(3, base3); RT_TAKE(4, base4); RT_TAKE(5, base5); RT_TAKE(6, base6); RT_TAKE(7, base7);
#undef RT_TAKE
        if (lane == 0) { route_s[2 * row] = s0; route_s[2 * row + 1] = s1; }
        ((v4u*)(AG + (size_t)s0 * 1024))[lane] = a; ((v4u*)(AG + (size_t)s1 * 1024))[lane] = a;
    }
    __syncthreads();
}

__device__ __forceinline__ void p_attn(Frame& F, char* ldsg, bool ctx_on) {
    unsigned char* const ws = launder(F.ws);
    const int tid = (F.wave * 64 + hw_lane()), lane = tid & 63; (void)lane;
    typedef attn_body::bf16 abf;
    const abf* Q = (const abf*)(ws + WS_QO); const abf* K = (const abf*)(ws + WS_KB); const abf* V = (const abf*)(ws + WS_VB); abf* O = (abf*)(ws + WS_QO);
    const int per = (1024 + F.G - 1) / F.G;
    for (int i = 0; i < per; ++i) { const int un = F.vcu * per + i; if (un >= 1024) break;
        const int bh = un >> 4, qb = un & 15, b = bh >> 3, h = bh & 7;
        attn_body::attn_unit<8>((long)b * SEQL + qb * 256, h * 64, (long)b * KVLEN, (h >> 2) * 64, KVLEN / 64, Q, K, V, O, ldsg, F.wave); }
    if (ctx_on) for (int un = F.vcu; un < 64; un += F.G) { const int b = un >> 3, h = un & 7;
        attn_body::attn_unit<8>((long)TL + b * CTXL, h * 64, (long)b * KVLEN + SEQL, (h >> 2) * 64, CTXL / 64, Q, K, V, O, ldsg, F.wave); }
}

typedef float f32x16 __attribute__((ext_vector_type(16)));
typedef unsigned u32x2 __attribute__((ext_vector_type(2)));
constexpr int SCH = 64, NCHK = KVLEN / SCH, NITEM = 128 * NCHK;
constexpr int LSTR = 144;
constexpr int L_AKK = 0, L_AR = 9216, L_AK = 18432, L_AB = 27648, L_TK = 36864, L_TB = 46080, L_TV = 55296, L_TW1 = 64512, L_TU = 73728, L_MLK = 82944, L_MMB = 92160, L_MMK = 101376;
constexpr int L_FLB = 110592, L_GC = 126976, L_TII = 127232, L_FX = L_AK;
static_assert(L_TII + 2048 <= RING_BYTES, "scan LDS map");
__device__ __forceinline__ unsigned short bf1(float x) { return (unsigned short)(pkbf(x, 0.f) & 0xffffu); }
__device__ __forceinline__ bf16x8 ldsv8(const LAS unsigned char* p) { return *(const LAS bf16x8*)p; }
template <bool SWA = false, bool SWB = false>
__device__ __forceinline__ f32x16 tile32(const LAS unsigned char* Ab, const LAS unsigned char* Bb, int mi, int ni, int r, int h, f32x16 acc) {
    const int ra = 32 * mi + r, rb = 32 * ni + r; const int xa = SWA ? ((ra >> 3) & 7) : 0, xb = SWB ? ((rb >> 3) & 7) : 0;
#pragma unroll
    for (int kb = 0; kb < 4; ++kb) { const bf16x8 a = ldsv8(Ab + ra * LSTR + (((2 * kb + h) ^ xa) << 4)), b = ldsv8(Bb + rb * LSTR + (((2 * kb + h) ^ xb) << 4));
        acc = __builtin_amdgcn_mfma_f32_32x32x16_bf16(a, b, acc, 0, 0, 0); }
    return acc;
}
__device__ __forceinline__ int jperm(int j) { return (((j >> 2) & 3) << 4) | (((j >> 5) & 1) << 3) | (((j >> 4) & 1) << 2) | (j & 3); }
#define CROW(reg, h) (((reg) & 3) + 8 * ((reg) >> 2) + 4 * (h))


#if DEBUG_NAN
#define DBG_BF(k, off, nbytes) do { unsigned bad_ = 0; for (int i_ = tid; i_ < (nbytes) / 2; i_ += 512) { const int row_ = i_ / 72, col_ = i_ % 72; if (col_ < 64) { const float v_ = __builtin_bit_cast(float, (unsigned)(*(const LAS unsigned short*)(L + (off) + row_ * LSTR + col_ * 2)) << 16); if (!(fabsf(v_) < 1e30f)) ++bad_; } } if (bad_) atomicAdd((unsigned*)(F.ctl + 16 + (k)), bad_); } while (0)
#define DBG_F32(k, off, n) do { unsigned bad_ = 0; for (int i_ = tid; i_ < (n); i_ += 512) { const float v_ = ((const LAS float*)(L + (off)))[i_]; if (!(fabsf(v_) < 1e30f)) ++bad_; } if (bad_) atomicAdd((unsigned*)(F.ctl + 16 + (k)), bad_); } while (0)
#else
#define DBG_BF(k, off, nbytes) do {} while (0)
#define DBG_F32(k, off, n) do {} while (0)
#endif
#define WG_BAR() do { asm volatile("s_waitcnt lgkmcnt(0)" ::: "memory"); __builtin_amdgcn_s_barrier(); asm volatile("" ::: "memory"); } while (0)
template <int CTRL, int RMASK> __device__ __forceinline__ float dppm(float v) { return __builtin_bit_cast(float, __builtin_amdgcn_update_dpp(0, __builtin_bit_cast(int, v), CTRL, RMASK, 0xf, true)); }
__device__ __forceinline__ float wave_incl_scan(float x) {
    x += dppm<0x111, 0xf>(x); x += dppm<0x112, 0xf>(x); x += dppm<0x114, 0xf>(x); x += dppm<0x118, 0xf>(x);
    x += __builtin_bit_cast(float, __builtin_amdgcn_update_dpp(0, __builtin_bit_cast(int, x), 0x142, 0xa, 0xf, false));
    x += __builtin_bit_cast(float, __builtin_amdgcn_update_dpp(0, __builtin_bit_cast(int, x), 0x143, 0xc, 0xf, false));
    return x;
}
struct S1In { v4u kk, r, k, v, pw, pa; f32x4 ka[2]; };
__device__ __forceinline__ void s1_item(Frame& F, unsigned char* const ws, const int lane, const int wv, const int l, const int item, const S1In& cur, S1In& nxt, const float* w0b, const float* a0b, const float* kab, unsigned long long (&cy)[6]) {
#if CYSEL >= 0
#define CY(k) do { const unsigned long long now_ = __builtin_readcyclecounter(); cy[k] += now_ - cy[5]; cy[5] = now_; } while (0)
#else
#define CY(k) do {} while (0)
#endif
    LAS unsigned char* L = F.lds + RING_OFF;
    const bf16* KKst = (const bf16*)(ws + WS_KK); const bf16* Kst = (const bf16*)(ws + WS_K); const bf16* Rst = (const bf16*)(ws + WS_R); const bf16* Vst = (const bf16*)(ws + WS_V); const bf16* LOUT = (const bf16*)(ws + WS_LOUT);
    bf16* PT = (bf16*)(ws + WS_SPT); bf16* GG = (bf16*)(ws + WS_SG); bf16* QQ = (bf16*)(ws + WS_SQ); float* OSC = (float*)(ws + WS_OSC);
    const int r = lane & 31, h = lane >> 5;
#define S1_ITEM(item_) const int chain = (item_) / NCHK, c = (item_) - chain * NCHK, dir = chain & 1, bh = chain >> 1, b = bh >> 3, hd = bh & 7; const int s0 = c * SCH; const int dsg = dir ? -1 : 1; \
        const int tok0 = (s0 < CTXL) ? (TL + b * CTXL + (dir ? (CTXL - 1 - s0) : s0)) : (b * SEQL + (dir ? (SEQL - 1 - (s0 - CTXL)) : (s0 - CTXL)));
#define S1_TOUCH(D) asm volatile("" :: "v"(D.kk), "v"(D.r), "v"(D.k), "v"(D.v), "v"(D.pw), "v"(D.pa), "v"(D.ka[0]), "v"(D.ka[1]))
#define S1_LOAD(D, item_) do { S1_ITEM(item_) const size_t tokr = (size_t)(tok0 + dsg * (8 * wv + (lane >> 3))); const size_t o5 = tokr * 512 + hd * 64 + 8 * (lane & 7); \
        D.kk = *(const v4u*)(KKst + o5); D.r = *(const v4u*)(Rst + o5); D.k = *(const v4u*)(Kst + o5); D.v = *(const v4u*)(Vst + o5); \
        D.pw = *(const v4u*)(LOUT + tokr * LORA_N + dir * 512 + hd * 64 + 8 * (lane & 7)); D.pa = *(const v4u*)(LOUT + tokr * LORA_N + 1024 + dir * 512 + hd * 64 + 8 * (lane & 7)); \
        { D.ka[0] = *(const f32x4*)(kab + hd * 64 + 8 * (lane & 7)); D.ka[1] = *(const f32x4*)(kab + hd * 64 + 8 * (lane & 7) + 4); } } while (0)
    {
        S1_ITEM(item)
        {   const v4u kk8 = cur.kk, r8 = cur.r, k8 = cur.k, v8 = cur.v, pw8 = cur.pw, pa8 = cur.pa; const int jg = lane & 7, t = 8 * wv + (lane >> 3);
            const float kap[8] = {cur.ka[0][0], cur.ka[0][1], cur.ka[0][2], cur.ka[0][3], cur.ka[1][0], cur.ka[1][1], cur.ka[1][2], cur.ka[1][3]};
            LAS float* tot = (LAS float*)(L + L_TII);
            float lw[8], av[8], lam[8];
#pragma unroll
            for (int e = 0; e < 8; ++e) { const unsigned pw = pw8[e >> 1], pa = pa8[e >> 1]; const float zw = (e & 1) ? bfhi(pw) : bflo(pw), za = (e & 1) ? bfhi(pa) : bflo(pa);
                lw[e] = zw; av[e] = za; lam[e] = lw[e]; }
#pragma unroll
            for (int sh = 8; sh <= 32; sh <<= 1) { float y[8]; const float mk = (lane >= sh) ? 1.0f : 0.0f;
#pragma unroll
                for (int e = 0; e < 8; ++e) y[e] = __shfl_up(lam[e], sh);
#pragma unroll
                for (int e = 0; e < 8; ++e) lam[e] = __builtin_fmaf(mk, y[e], lam[e]); }
            if (lane >= 56) { *(LAS f32x4*)(tot + wv * 64 + 8 * jg) = (f32x4){lam[0], lam[1], lam[2], lam[3]}; *(LAS f32x4*)(tot + wv * 64 + 8 * jg + 4) = (f32x4){lam[4], lam[5], lam[6], lam[7]}; }
            if (item + F.G < NITEM) S1_LOAD(nxt, item + F.G);
            WG_BAR();
            for (int w = 0; w < wv; ++w) { const f32x4 q0 = *(const LAS f32x4*)(tot + w * 64 + 8 * jg), q1 = *(const LAS f32x4*)(tot + w * 64 + 8 * jg + 4);
                lam[0] += q0[0]; lam[1] += q0[1]; lam[2] += q0[2]; lam[3] += q0[3]; lam[4] += q1[0]; lam[5] += q1[1]; lam[6] += q1[2]; lam[7] += q1[3]; }
            v4u wkk, wrr, wkd, wbd; float en8[8];
#pragma unroll
            for (int p = 0; p < 4; ++p) { float okk[2], orr[2], okd[2], obd[2];
#pragma unroll
                for (int u = 0; u < 2; ++u) { const int e = 2 * p + u;
                    const unsigned xkk = kk8[p], xr = r8[p], xk = k8[p];
                    const float kkv = u ? bfhi(xkk) : bflo(xkk), rv = u ? bfhi(xr) : bflo(xr), kv = u ? bfhi(xk) : bflo(xk);
                    const float eNp = __builtin_amdgcn_exp2f(lw[e] - lam[e]), eN = __builtin_amdgcn_exp2f(-lam[e]), eP = __builtin_amdgcn_exp2f(lam[e]);
                    okk[u] = kkv * eNp; orr[u] = rv * eN; okd[u] = kv * __builtin_fmaf(av[e], kap[e], 1.0f - kap[e]) * eP; obd[u] = kkv * av[e] * eP;
                    en8[e] = eN; }
                wkk[p] = pkbf(okk[0], okk[1]); wrr[p] = pkbf(orr[0], orr[1]); wkd[p] = pkbf(okd[0], okd[1]); wbd[p] = pkbf(obd[0], obd[1]); }
            if (t == SCH - 1) { *(LAS f32x4*)((LAS float*)(L + L_GC) + 8 * jg) = (f32x4){en8[0], en8[1], en8[2], en8[3]}; *(LAS f32x4*)((LAS float*)(L + L_GC) + 8 * jg + 4) = (f32x4){en8[4], en8[5], en8[6], en8[7]}; }
            *(LAS v4u*)(L + L_AKK + t * LSTR + jg * 16) = wkk; *(LAS v4u*)(L + L_AR + t * LSTR + jg * 16) = wrr; *(LAS v4u*)(L + L_AK + t * LSTR + jg * 16) = wkd; *(LAS v4u*)(L + L_AB + t * LSTR + jg * 16) = wbd;
#pragma unroll
            for (int e = 0; e < 8; ++e) { const int j = 8 * jg + e; const unsigned wk = wkd[e >> 1], wb = wbd[e >> 1], wvv = v8[e >> 1];
                const int to = j * LSTR + ((wv ^ jg) << 4) + (lane >> 3) * 2;
                *(LAS unsigned short*)(L + L_TK + to) = (unsigned short)((e & 1) ? (wk >> 16) : (wk & 0xffffu));
                *(LAS unsigned short*)(L + L_TB + to) = (unsigned short)((e & 1) ? (wb >> 16) : (wb & 0xffffu));
                *(LAS unsigned short*)(L + L_TV + to) = (unsigned short)((e & 1) ? (wvv >> 16) : (wvv & 0xffffu)); }
        }
        WG_BAR();
        CY(0);
#pragma unroll
        for (int jj = 0; jj < 2; ++jj) {
            const int job = 2 * wv + jj, m = job >> 2, si = (job >> 1) & 1, ti = job & 1;
            f32x16 acc = {};
            if (!(si == 1 && ti == 0)) acc = tile32(L + ((m & 1) ? L_AK : L_AB), L + (m < 2 ? L_AKK : L_AR), si, ti, r, h, acc);
            const int tt = 32 * ti + r;
#pragma unroll
            for (int g = 0; g < 4; ++g) { const int sb = 32 * si + 8 * g + 4 * h; float vv[4];
#pragma unroll
                for (int i = 0; i < 4; ++i) { const int s = sb + i; const bool keep = (m < 2) ? (s < tt) : (s <= tt); vv[i] = keep ? acc[4 * g + i] : 0.f; }
                if (m == 0) *(LAS f32x4*)((LAS float*)(L + L_FLB) + tt * 64 + sb) = (f32x4){vv[0], vv[1], vv[2], vv[3]};
                else *(LAS u32x2*)(L + (m == 1 ? L_MLK : (m == 2 ? L_MMB : L_MMK)) + tt * LSTR + sb * 2) = (u32x2){pkbf(vv[0], vv[1]), pkbf(vv[2], vv[3])}; }
        }
        WG_BAR();
        CY(1);
        f32x16 acc_o1 = {}, ag = {};
        {   const int q4 = wv & 3, mi = q4 >> 1, ni = q4 & 1;
            if (wv < 4) { f32x16 acc = {}; acc = tile32<false, true>(L + L_MLK, L + L_TV, mi, ni, r, h, acc);
#pragma unroll
                for (int reg = 0; reg < 16; ++reg) ((LAS float*)(L + L_FX))[(32 * mi + CROW(reg, h)) * 64 + 32 * ni + r] = acc[reg];
                const int col = lane & 15; const LAS float* lb = (const LAS float*)(L + L_FLB) + (16 * wv) * 64 + 16 * wv; float x[16];
#pragma unroll
                for (int tt = 0; tt < 16; ++tt) { float a = (tt == col) ? 1.0f : 0.0f, a2 = 0.0f;
#pragma unroll
                    for (int s4 = 0; s4 < tt; s4 += 4) { const f32x4 lv = *(const LAS f32x4*)(lb + tt * 64 + s4);
#pragma unroll
                        for (int u = 0; u < 4; ++u) if (s4 + u < tt) { if (u & 1) a2 -= lv[u] * x[s4 + u]; else a -= lv[u] * x[s4 + u]; } }
                    x[tt] = a + a2; }
                if (lane < 16) {
#pragma unroll
                    for (int tt = 0; tt < 16; ++tt) *(LAS unsigned short*)(L + L_TII + wv * 512 + tt * 32 + col * 2) = bf1(x[tt]); }
            } else { acc_o1 = tile32<true, false>(L + L_TV, L + L_MMK, mi, ni, r, h, acc_o1);
                ag = tile32<true, true>(L + L_TK, L + L_TV, mi, ni, r, h, ag); }
        }
        WG_BAR();
        CY(2);
        {   const int cc = lane & 15, q = lane >> 4; const bool isw = wv < 4; const int colb = 16 * (wv & 3) + cc;
            f32x4 U[4], R0[4];
            if (isw) {
#pragma unroll
                for (int i = 0; i < 4; ++i)
#pragma unroll
                    for (int reg = 0; reg < 4; ++reg) { const int tt = 16 * i + 4 * q + reg; R0[i][reg] = __builtin_bit_cast(float, (unsigned)(*(const LAS unsigned short*)(L + L_AKK + tt * LSTR + colb * 2)) << 16); }
            } else {
#pragma unroll
                for (int i = 0; i < 4; ++i)
#pragma unroll
                    for (int reg = 0; reg < 4; ++reg) { const int tt = 16 * i + 4 * q + reg; R0[i][reg] = ((const LAS float*)(L + L_FX))[tt * 64 + colb]; }
            }
#pragma unroll
            for (int i = 0; i < 4; ++i) {
                f32x4 R = R0[i];
#pragma unroll
                for (int kp = 0; kp < 2; ++kp) { if (2 * kp < i) {
                    const int k1 = 2 * kp, k2 = 2 * kp + 1; const bool two = (k2 < i);
                    const LAS float* lrow = (const LAS float*)(L + L_FLB) + (16 * i + cc) * 64;
                    const f32x4 la = *(const LAS f32x4*)(lrow + 16 * k1 + 4 * q); f32x4 lb2 = {0.f, 0.f, 0.f, 0.f}; if (two) lb2 = *(const LAS f32x4*)(lrow + 16 * k2 + 4 * q);
                    const v4u aw = (v4u){pkbf(-la[0], -la[1]), pkbf(-la[2], -la[3]), pkbf(-lb2[0], -lb2[1]), pkbf(-lb2[2], -lb2[3])};
                    const f32x4 u1 = U[k1]; f32x4 u2 = {0.f, 0.f, 0.f, 0.f}; if (two) u2 = U[k2];
                    const v4u bh_ = (v4u){pkbf(u1[0], u1[1]), pkbf(u1[2], u1[3]), pkbf(u2[0], u2[1]), pkbf(u2[2], u2[3])};
                    R = __builtin_amdgcn_mfma_f32_16x16x32_bf16(__builtin_bit_cast(bf16x8, aw), __builtin_bit_cast(bf16x8, bh_), R, 0, 0, 0); } }
                const u32x2 tw = *(const LAS u32x2*)(L + L_TII + i * 512 + cc * 32 + q * 8);
                const v4u ta = (v4u){tw.x, tw.y, 0u, 0u};
                const v4u rh = (v4u){pkbf(R[0], R[1]), pkbf(R[2], R[3]), 0u, 0u};
                f32x4 u = {0.f, 0.f, 0.f, 0.f};
                u = __builtin_amdgcn_mfma_f32_16x16x32_bf16(__builtin_bit_cast(bf16x8, ta), __builtin_bit_cast(bf16x8, rh), u, 0, 0, 0);
                U[i] = u;
                *(LAS u32x2*)(L + (isw ? L_TW1 : L_TU) + colb * LSTR + (16 * i + 4 * q) * 2) = (u32x2){pkbf(u[0], u[1]), pkbf(u[2], u[3])};
            }
        }
        WG_BAR();
        CY(3);
        S1_TOUCH(nxt);
        {   const int q4 = wv & 3, mi = q4 >> 1, ni = q4 & 1; const LAS float* gc = (const LAS float*)(L + L_GC);
            if (wv < 4) {
                f32x16 acc = {}; acc = tile32<false, true>(L + L_TW1, L + L_TB, mi, ni, r, h, acc);
                const int jp = 32 * ni + r; const float gj = gc[jp]; bf16* pt = PT + (size_t)item * 4096 + (size_t)jp * 64;
#pragma unroll
                for (int gp2 = 0; gp2 < 2; ++gp2) { unsigned pw[4];
#pragma unroll
                    for (int u = 0; u < 2; ++u) { const int g = gp2 + 2 * u, j0 = 32 * mi + 8 * g + 4 * h; float pv[4];
#pragma unroll
                        for (int i = 0; i < 4; ++i) pv[i] = (((j0 + i) == jp ? 1.0f : 0.0f) - acc[4 * g + i]) * gj;
                        pw[2 * u] = pkbf(pv[0], pv[1]); pw[2 * u + 1] = pkbf(pv[2], pv[3]); }
                    *(v4u*)(pt + 16 * (2 * gp2 + h) + 8 * mi) = (v4u){pw[0], pw[1], pw[2], pw[3]}; }
                f32x16 acq = {}; acq = tile32(L + L_TW1, L + L_MMB, mi, ni, r, h, acq);
                const int tt = 32 * ni + r; bf16* qq = QQ + (size_t)item * 4096 + (size_t)tt * 64;
#pragma unroll
                for (int gp2 = 0; gp2 < 2; ++gp2) { unsigned qw[4];
#pragma unroll
                    for (int u = 0; u < 2; ++u) { const int g = gp2 + 2 * u, j0 = 32 * mi + 8 * g + 4 * h; const u32x2 rw = *(const LAS u32x2*)(L + L_AR + tt * LSTR + j0 * 2);
                        qw[2 * u] = pkbf(bflo(rw.x) - acq[4 * g], bfhi(rw.x) - acq[4 * g + 1]); qw[2 * u + 1] = pkbf(bflo(rw.y) - acq[4 * g + 2], bfhi(rw.y) - acq[4 * g + 3]); }
                    *(v4u*)(qq + 16 * (2 * gp2 + h) + 8 * mi) = (v4u){qw[0], qw[1], qw[2], qw[3]}; }
            } else {
                f32x16 acc = {}; acc = tile32(L + L_TU, L + L_MMB, mi, ni, r, h, acc);
                const int tt = 32 * ni + r; bf16* op = (bf16*)OSC + ((size_t)dir * TT + (size_t)(tok0 + dsg * tt)) * 512 + hd * 64;
#pragma unroll
                for (int gp2 = 0; gp2 < 2; ++gp2) { unsigned ow_[4];
#pragma unroll
                    for (int u = 0; u < 2; ++u) { const int g = gp2 + 2 * u; ow_[2 * u] = pkbf(acc_o1[4 * g] - acc[4 * g], acc_o1[4 * g + 1] - acc[4 * g + 1]); ow_[2 * u + 1] = pkbf(acc_o1[4 * g + 2] - acc[4 * g + 2], acc_o1[4 * g + 3] - acc[4 * g + 3]); }
                    *(v4u*)(op + 16 * (2 * gp2 + h) + 8 * mi) = (v4u){ow_[0], ow_[1], ow_[2], ow_[3]}; }
                f32x16 ah = {}; ah = tile32<true, false>(L + L_TB, L + L_TU, mi, ni, r, h, ah);
                const int v = 32 * ni + r; bf16* gp = GG + (size_t)item * 4096 + (size_t)v * 64;
#pragma unroll
                for (int gp2 = 0; gp2 < 2; ++gp2) { unsigned gw_[4];
#pragma unroll
                    for (int u = 0; u < 2; ++u) { const int g = gp2 + 2 * u, j0 = 32 * mi + 8 * g + 4 * h; const f32x4 gj = *(const LAS f32x4*)(gc + j0); float gv[4];
#pragma unroll
                        for (int i = 0; i < 4; ++i) gv[i] = (ag[4 * g + i] - ah[4 * g + i]) * gj[i];
                        gw_[2 * u] = pkbf(gv[0], gv[1]); gw_[2 * u + 1] = pkbf(gv[2], gv[3]); }
                    *(v4u*)(gp + 16 * (2 * gp2 + h) + 8 * mi) = (v4u){gw_[0], gw_[1], gw_[2], gw_[3]}; }
            }
        }
        WG_BAR();
        CY(4);
    }
#undef CY
}
__device__ __forceinline__ void p_scan1(Frame& F, const Args& A, int l) {
    unsigned char* const ws = launder(F.ws);
    const int tid = (F.wave * 64 + hw_lane()), lane = tid & 63, wv = F.wave;
    const bf16* KKst = (const bf16*)(ws + WS_KK); const bf16* Kst = (const bf16*)(ws + WS_K); const bf16* Rst = (const bf16*)(ws + WS_R); const bf16* Vst = (const bf16*)(ws + WS_V); const bf16* LOUT = (const bf16*)(ws + WS_LOUT);
    const float* w0b = INP(IN_W0) + l * 1024; const float* a0b = INP(IN_A0) + l * 1024; const float* kab = INP(IN_KA) + l * 512;
    S1In sa = {}, sb = {}; unsigned long long cy[6] = {0, 0, 0, 0, 0, 0};
#if CYSEL >= 0
    cy[5] = __builtin_readcyclecounter();
#endif
    if ((int)blockIdx.x < NITEM) S1_LOAD(sa, (int)blockIdx.x);
    S1_TOUCH(sa);
    for (int item = blockIdx.x; item < NITEM; item += 2 * F.G) {
        s1_item(F, ws, lane, wv, l, item, sa, sb, w0b, a0b, kab, cy);
        if (item + F.G < NITEM) s1_item(F, ws, lane, wv, l, item + F.G, sb, sa, w0b, a0b, kab, cy);
    }
#if CYSEL >= 0
    if (blockIdx.x == 0 && F.wave == 0 && hw_lane() == 0) { unsigned long long* cs_ = (unsigned long long*)(F.ws + WS_CTL + 40960); for (int k = 0; k < 5; ++k) cs_[k] += cy[k]; }
#endif
}
#undef S1_ITEM
#undef S1_LOAD
#undef S1_TOUCH

struct S2Ops { v4u pa[4][2]; v4u gt[2]; };
__device__ __forceinline__ void s2_load(S2Ops& o, const bf16* PT, const bf16* GG, int chain, int c, int cc, int q, int v) {
    const size_t ib = ((size_t)chain * NCHK + c) * 4096;
#pragma unroll
    for (int J = 0; J < 4; ++J) { const bf16* prow = PT + ib + (size_t)(16 * J + cc) * 64;
#pragma unroll
        for (int kb = 0; kb < 2; ++kb) o.pa[J][kb] = *(const v4u*)(prow + 16 * q + 8 * kb); }
#pragma unroll
    for (int kb = 0; kb < 2; ++kb) o.gt[kb] = *(const v4u*)(GG + ib + (size_t)v * 64 + 16 * q + 8 * kb);
}
__device__ __forceinline__ void s2_step(f32x4 (&St)[4], const S2Ops& o, bf16* S0, int chain, int c, int q, int v) {
    const size_t ib = ((size_t)chain * NCHK + c) * 4096;
    v4u bh_[2], bl_[2];
#pragma unroll
    for (int kb = 0; kb < 2; ++kb) { const f32x4 u1 = St[2 * kb], u2 = St[2 * kb + 1];
        bh_[kb] = (v4u){pkbf(u1[0], u1[1]), pkbf(u1[2], u1[3]), pkbf(u2[0], u2[1]), pkbf(u2[2], u2[3])};
        bl_[kb] = (v4u){pkbf(u1[0] - bflo(bh_[kb].x), u1[1] - bfhi(bh_[kb].x)), pkbf(u1[2] - bflo(bh_[kb].y), u1[3] - bfhi(bh_[kb].y)), pkbf(u2[0] - bflo(bh_[kb].z), u2[1] - bfhi(bh_[kb].z)), pkbf(u2[2] - bflo(bh_[kb].w), u2[3] - bfhi(bh_[kb].w))};
        *(v4u*)(S0 + ib + (size_t)v * 64 + 16 * q + 8 * kb) = bh_[kb]; }
#pragma unroll
    for (int J = 0; J < 4; ++J) { const unsigned g0 = (J & 1) ? o.gt[J >> 1].z : o.gt[J >> 1].x, g1 = (J & 1) ? o.gt[J >> 1].w : o.gt[J >> 1].y; f32x4 acc = (f32x4){bflo(g0), bfhi(g0), bflo(g1), bfhi(g1)};
#pragma unroll
        for (int kb = 0; kb < 2; ++kb) { const v4u aw = o.pa[J][kb];
            acc = __builtin_amdgcn_mfma_f32_16x16x32_bf16(__builtin_bit_cast(bf16x8, aw), __builtin_bit_cast(bf16x8, bh_[kb]), acc, 0, 0, 0);
            acc = __builtin_amdgcn_mfma_f32_16x16x32_bf16(__builtin_bit_cast(bf16x8, aw), __builtin_bit_cast(bf16x8, bl_[kb]), acc, 0, 0, 0); }
        St[J] = acc; }
}
__device__ __forceinline__ void p_scan2(Frame& F) {
    unsigned char* const ws = launder(F.ws);
    const int tid = (F.wave * 64 + hw_lane()), lane = tid & 63;
    const bf16* PT = (const bf16*)(ws + WS_SPT); const bf16* GG = (const bf16*)(ws + WS_SG); bf16* S0 = (bf16*)F.out;
    const int cc = lane & 15, q = lane >> 4;
    static_assert(NCHK % 4 == 0, "stage 2 ring depth");
    for (int wi = F.wave * F.G + (int)blockIdx.x; wi < 512; wi += NWAVES * F.G) {
        const int chain = wi >> 2, vg = wi & 3; const int v = 16 * vg + cc;
        f32x4 St[4];
#pragma unroll
        for (int J = 0; J < 4; ++J) St[J] = (f32x4){0.f, 0.f, 0.f, 0.f};
        S2Ops o0, o1, o2, o3;
        s2_load(o0, PT, GG, chain, 0, cc, q, v); s2_load(o1, PT, GG, chain, 1, cc, q, v); s2_load(o2, PT, GG, chain, 2, cc, q, v);
        for (int c = 0; c < NCHK; c += 4) {
            s2_load(o3, PT, GG, chain, c + 3, cc, q, v);                 s2_step(St, o0, S0, chain, c, q, v);
            if (c + 4 < NCHK) s2_load(o0, PT, GG, chain, c + 4, cc, q, v); s2_step(St, o1, S0, chain, c + 1, q, v);
            if (c + 5 < NCHK) s2_load(o1, PT, GG, chain, c + 5, cc, q, v); s2_step(St, o2, S0, chain, c + 2, q, v);
            if (c + 6 < NCHK) s2_load(o2, PT, GG, chain, c + 6, cc, q, v); s2_step(St, o3, S0, chain, c + 3, q, v);
        }
    }
}

__device__ __forceinline__ void p_scan3(Frame& F) {
    unsigned char* const ws = launder(F.ws);
    const int tid = (F.wave * 64 + hw_lane()), lane = tid & 63;
    const bf16* QQ = (const bf16*)(ws + WS_SQ); const bf16* S0 = (const bf16*)F.out; float* OSC = (float*)(ws + WS_OSC);
    const int gw = F.vcu * NWAVES + F.wave, NGW = F.G * NWAVES; const int r = lane & 31, h = lane >> 5;
    bf16x8 sa[4], qb[4], sa2[4], qb2[4]; f32x4 ov[4], ov2[4]; float* op = nullptr; float* op2 = nullptr;
#define S3_LOAD(SA, QB, OV, OP, job_) do { const int item = (job_) >> 2, mi = ((job_) >> 1) & 1, ni = (job_) & 1; \
        const int chain = item / NCHK, c = item - chain * NCHK, dir = chain & 1, bh = chain >> 1, b = bh >> 3, hd = bh & 7; const int s0 = c * SCH + 32 * ni + r; \
        const int tok = (s0 < CTXL) ? (TL + b * CTXL + (dir ? (CTXL - 1 - s0) : s0)) : (b * SEQL + (dir ? (SEQL - 1 - (s0 - CTXL)) : (s0 - CTXL))); \
        const bf16* sp = S0 + (size_t)item * 4096 + (size_t)(32 * mi + r) * 64 + 8 * h; const bf16* qp = QQ + (size_t)item * 4096 + (size_t)(32 * ni + r) * 64 + 8 * h; \
        _Pragma("unroll") for (int kb = 0; kb < 4; ++kb) { SA[kb] = *(const bf16x8*)(sp + 16 * kb); QB[kb] = *(const bf16x8*)(qp + 16 * kb); } \
        OP = OSC + ((size_t)dir * TT + (size_t)tok) * 512 + hd * 64 + 32 * mi + 4 * h; \
        _Pragma("unroll") for (int g = 0; g < 4; ++g) OV[g] = *(const f32x4*)(OP + 8 * g); } while (0)
    int job = gw;
    if (job < NITEM * 4) S3_LOAD(sa, qb, ov, op, job);
    for (; job < NITEM * 4; job += NGW) {
        const int nj = job + NGW;
        if (nj < NITEM * 4) S3_LOAD(sa2, qb2, ov2, op2, nj);
        f32x16 acc = {};
#pragma unroll
        for (int kb = 0; kb < 4; ++kb) acc = __builtin_amdgcn_mfma_f32_32x32x16_bf16(sa[kb], qb[kb], acc, 0, 0, 0);
#pragma unroll
        for (int g = 0; g < 4; ++g) *(f32x4*)(op + 8 * g) = ov[g] + (f32x4){acc[4 * g], acc[4 * g + 1], acc[4 * g + 2], acc[4 * g + 3]};
#pragma unroll
        for (int kb = 0; kb < 4; ++kb) { sa[kb] = sa2[kb]; qb[kb] = qb2[kb]; ov[kb] = ov2[kb]; }
        op = op2;
    }
#undef S3_LOAD
}


__device__ __forceinline__ void s3_fetch(v4u (&d)[4], const bf16* base, size_t pitch, int lane) {
#pragma unroll
    for (int i = 0; i < 4; ++i) d[i] = *(const v4u*)(base + (size_t)((lane >> 3) + 8 * i) * pitch + (lane & 7) * 8);
}
template <bool PERMUTED = false>
__device__ __forceinline__ void s3_relayout(uint2 (&o)[8], const v4u (&d)[4], LAS unsigned char* stg, int lane) {
    const int r = lane & 31, h = lane >> 5;
#pragma unroll
    for (int i = 0; i < 4; ++i) *(LAS v4u*)(stg + ((lane >> 3) + 8 * i) * LSTR + (lane & 7) * 16) = d[i];
#pragma unroll
    for (int mi = 0; mi < 2; ++mi)
#pragma unroll
        for (int g = 0; g < 4; ++g) { const int c0 = 32 * mi + 8 * g + 4 * h; const u32x2 w = *(const LAS u32x2*)(stg + r * LSTR + (PERMUTED ? jperm(c0) : c0) * 2); o[mi * 4 + g] = make_uint2(w.x, w.y); }
}
__device__ __forceinline__ void p_scan3r(Frame& F, const Args& A, int l) {
    unsigned char* const ws = launder(F.ws);
    const int tid = (F.wave * 64 + hw_lane()), lane = tid & 63;
    const bf16* QQ = (const bf16*)(ws + WS_SQ); const bf16* S0 = (const bf16*)F.out; const bf16* OSC = (const bf16*)(ws + WS_OSC);
    const bf16* Rst = (const bf16*)(ws + WS_R); const bf16* Vst = (const bf16*)(ws + WS_V); const bf16* Kst = (const bf16*)(ws + WS_K); const bf16* LOUT = (const bf16*)(ws + WS_LOUT);
    bf16* QO = (bf16*)(ws + WS_QO);
    LAS unsigned char* stg = F.lds + RING_OFF + F.wave * 4608;
    const int gw = F.vcu * NWAVES + F.wave, NGW = F.G * NWAVES; const int r = lane & 31, h = lane >> 5;
    const float* rkp = INP(IN_RK) + l * 512; const float* gnwp = INP(IN_GNW) + l * 512; const float* gnbp = INP(IN_GNB) + l * 512; const float* kap = INP(IN_KA) + l * 512; const float* a0p = INP(IN_A0) + l * 1024;
    for (int unit = gw; unit < 64 * (KVLEN / 32); unit += NGW) {
        const int bh = unit / (KVLEN / 32), pb = unit - bh * (KVLEN / 32), b = bh >> 3, hd = bh & 7, p0 = pb * 32;
        const size_t tokb = (p0 < CTXL) ? (size_t)(TL + b * CTXL + p0) : (size_t)(b * SEQL + (p0 - CTXL)); const size_t tok = tokb + r;
        const int sb0 = (p0 < CTXL) ? (CTXL - 1 - p0) : (KVLEN + CTXL - 1 - p0);
        const int itf = (bh * 2) * NCHK + (p0 >> 6), itb = (bh * 2 + 1) * NCHK + (sb0 >> 6); const int tf = (p0 & 63) + r, tb = (sb0 & 63) - r;
        v4u ga[4], gb[4];
        s3_fetch(ga, OSC + tokb * 512 + hd * 64, 512, lane); s3_fetch(gb, OSC + ((size_t)TT + tokb) * 512 + hd * 64, 512, lane);
        f32x4 o[2][4];
        {   f32x16 acc[2][2];
#pragma unroll
            for (int d = 0; d < 2; ++d) { const size_t ib = (size_t)(d ? itb : itf) * 4096; const bf16* qp = QQ + ib + (size_t)(d ? tb : tf) * 64 + 8 * h;
                bf16x8 qf[4];
#pragma unroll
                for (int kb = 0; kb < 4; ++kb) qf[kb] = *(const bf16x8*)(qp + 16 * kb);
#pragma unroll
                for (int mi = 0; mi < 2; ++mi) { const bf16* sp = S0 + ib + (size_t)(32 * mi + r) * 64 + 8 * h; f32x16 a = {};
#pragma unroll
                    for (int kb = 0; kb < 4; ++kb) a = __builtin_amdgcn_mfma_f32_32x32x16_bf16(*(const bf16x8*)(sp + 16 * kb), qf[kb], a, 0, 0, 0);
                    acc[d][mi] = a; } }
#pragma unroll
            for (int mi = 0; mi < 2; ++mi)
#pragma unroll
                for (int g = 0; g < 4; ++g)
#pragma unroll
                    for (int i = 0; i < 4; ++i) o[mi][g][i] = acc[0][mi][4 * g + i] + acc[1][mi][4 * g + i]; }
        uint2 ta[8], tb8[8];
        s3_relayout<true>(ta, ga, stg, lane); s3_fetch(ga, Rst + tokb * 512 + hd * 64, 512, lane);
        s3_relayout<true>(tb8, gb, stg, lane); s3_fetch(gb, Kst + tokb * 512 + hd * 64, 512, lane);
        float s1 = 0.f;
#pragma unroll
        for (int mi = 0; mi < 2; ++mi)
#pragma unroll
            for (int g = 0; g < 4; ++g) { const uint2 of = ta[mi * 4 + g], ob = tb8[mi * 4 + g]; f32x4 v = o[mi][g];
                v[0] += bflo(of.x) + bflo(ob.x); v[1] += bfhi(of.x) + bfhi(ob.x); v[2] += bflo(of.y) + bflo(ob.y); v[3] += bfhi(of.y) + bfhi(ob.y);
                o[mi][g] = v; s1 += (v[0] + v[1]) + (v[2] + v[3]); }
        s1 += __shfl_xor(s1, 32); const float mean = s1 * (1.0f / 64.0f);
        const int cb = hd * 64 + 4 * h;
        float s2 = 0.f, bs = 0.f;
        f32x4 rkv[8], sa[8];
        {   uint2 rr8[8], kk8[8];
            s3_relayout(rr8, ga, stg, lane); s3_fetch(ga, LOUT + tokb * LORA_N + 1024 + hd * 64, LORA_N, lane);
            s3_relayout(kk8, gb, stg, lane); s3_fetch(gb, LOUT + tokb * LORA_N + 1536 + hd * 64, LORA_N, lane);
#pragma unroll
            for (int q = 0; q < 8; ++q) { const int cl = cb + 32 * (q >> 2) + 8 * (q & 3); const f32x4 rk4 = *(const f32x4*)(rkp + cl);
                f32x4 d = o[q >> 2][q & 3] - mean; o[q >> 2][q & 3] = d; s2 += (d[0] * d[0] + d[1] * d[1]) + (d[2] * d[2] + d[3] * d[3]);
                rkv[q] = (f32x4){bflo(rr8[q].x) * bflo(kk8[q].x) * rk4[0], bfhi(rr8[q].x) * bfhi(kk8[q].x) * rk4[1], bflo(rr8[q].y) * bflo(kk8[q].y) * rk4[2], bfhi(rr8[q].y) * bfhi(kk8[q].y) * rk4[3]}; } }
        {   uint2 pa8[8];
            s3_relayout(pa8, ga, stg, lane); s3_fetch(ga, Vst + tokb * 512 + hd * 64, 512, lane);
#pragma unroll
            for (int q = 0; q < 8; ++q) sa[q] = (f32x4){bflo(pa8[q].x), bfhi(pa8[q].x), bflo(pa8[q].y), bfhi(pa8[q].y)}; }
        {   uint2 pb8[8];
            s3_relayout(pb8, gb, stg, lane); s3_fetch(gb, LOUT + tokb * LORA_N + 2048 + hd * 64, LORA_N, lane);
#pragma unroll
            for (int q = 0; q < 8; ++q) { const int cl = cb + 32 * (q >> 2) + 8 * (q & 3); const f32x4 ka4 = *(const f32x4*)(kap + cl);
                const float pq[4] = {bflo(pb8[q].x), bfhi(pb8[q].x), bflo(pb8[q].y), bfhi(pb8[q].y)};
#pragma unroll
                for (int i = 0; i < 4; ++i) bs += rkv[q][i] * (2.0f + (sa[q][i] + pq[i] - 2.0f) * ka4[i]); } }
        s2 += __shfl_xor(s2, 32); bs += __shfl_xor(bs, 32);
        const float rs = __builtin_amdgcn_rsqf(s2 * (1.0f / 64.0f) + GN_EPS);
        uint2 vv8[8], gg8[8];
        s3_relayout(vv8, ga, stg, lane); s3_relayout(gg8, gb, stg, lane);
#pragma unroll
        for (int mi = 0; mi < 2; ++mi)
#pragma unroll
            for (int g = 0; g < 4; ++g) { const int cl = cb + 32 * mi + 8 * g; const int q = mi * 4 + g;
                const uint2 vw = vv8[q], gwd = gg8[q];
                const f32x4 w4 = *(const f32x4*)(gnwp + cl), b4 = *(const f32x4*)(gnbp + cl); const f32x4 d = o[mi][g];
                const float y0 = (d[0] * rs * w4[0] + b4[0] + bs * bflo(vw.x)) * bflo(gwd.x), y1 = (d[1] * rs * w4[1] + b4[1] + bs * bfhi(vw.x)) * bfhi(gwd.x);
                const float y2 = (d[2] * rs * w4[2] + b4[2] + bs * bflo(vw.y)) * bflo(gwd.y), y3 = (d[3] * rs * w4[3] + b4[3] + bs * bfhi(vw.y)) * bfhi(gwd.y);
                *(LAS u32x2*)(stg + r * LSTR + (32 * mi + 8 * g + 4 * h) * 2) = (u32x2){pkbf(y0, y1), pkbf(y2, y3)}; }
#pragma unroll
        for (int i = 0; i < 4; ++i) { const int row = (lane >> 3) + 8 * i; const v4u val = *(const LAS v4u*)(stg + row * LSTR + (lane & 7) * 16);
            *(v4u*)(QO + (tokb + row) * 1024 + 512 + hd * 64 + (lane & 7) * 8) = val; }
    }
}

#if DEBUG_NAN
__device__ __forceinline__ void dbg_count(Frame& F) {
    unsigned char* const ws = launder(F.ws);
    const size_t gt = (size_t)blockIdx.x * 512 + threadIdx.x, NT = (size_t)F.G * 512;
    const unsigned short* arr[4] = {(const unsigned short*)(ws + WS_SPT), (const unsigned short*)(ws + WS_SG), (const unsigned short*)(ws + WS_SQ), (const unsigned short*)F.out};
#pragma unroll
    for (int a = 0; a < 4; ++a) { unsigned bad = 0; for (size_t i = gt; i < (size_t)NITEM * 4096; i += NT) { const float v = __builtin_bit_cast(float, (unsigned)arr[a][i] << 16); if (!(fabsf(v) < 1e30f)) ++bad; }
        if (bad) atomicAdd((unsigned*)(F.ctl + 8 + a), bad); }
    { const float* o = (const float*)(ws + WS_OSC); unsigned bad = 0; for (size_t i = gt; i < (size_t)2 * TT * 512; i += NT) { if (!(fabsf(o[i]) < 1e30f)) ++bad; } if (bad) atomicAdd((unsigned*)(F.ctl + 12), bad); }
}
#endif
template <int l> __device__ __forceinline__ void layer_body(Frame& F, const Args& args, const XcdBarrier& bar, unsigned char* lds) {
#define GRID_BAR() xcd_barrier(bar)

        constexpr bool last = (l == DEPTH - 1), moe = (l & 1) != 0;

#ifndef SKIP_WPREP
        p_wprep(F, args, l, 0);
#endif


#ifndef SKIP_NORM1
        {   if (l == 0) p_norm<false, false, true>(F, args, l, 0, INP(IN_X), INP(IN_CTX), 0);
            else if (l & 1) p_norm<false, false, false, true>(F, args, l, 0, nullptr, nullptr, 0);
            else p_norm<false, true, false>(F, args, l, 0, nullptr, nullptr, l - 1); }
#endif

        GRID_BAR(); TS(1);
        {   unsigned char* const ws = launder(F.ws); bf16* const XB = (bf16*)(ws + WS_XB); const float* const MOD = (const float*)(ws + WS_MOD); bf16* const H = (bf16*)F.out; (void)XB; (void)MOD; (void)H;
            pg8::Gemm g{H, (const bf16*)(ws + WS_WIN), TT, INWP, 1024, 0}; pg8::Sched S; S.init(TT / 256, INWP / 256, F.G, (int)blockIdx.x, nullptr);
            pg8::EpiBf16 E{(bf16*)(ws + WS_P), INWP};
#ifndef SKIP_G_IN
            pg8::gemm_phase<pg8::EpiBf16, pg8::Sched, true, true>(F.lds + RING_OFF, g, S, E, F.wave);
#endif
            }
        GRID_BAR(); TS(2);

#ifndef SKIP_PREP
        p_prep(F, args, l);
#endif
#if PROBE == 2
        p_prep(F, args, l);
#endif

        GRID_BAR(); TS(3);
        {   unsigned char* const ws = launder(F.ws); bf16* const XB = (bf16*)(ws + WS_XB); const float* const MOD = (const float*)(ws + WS_MOD); bf16* const H = (bf16*)F.out; (void)XB; (void)MOD; (void)H;
            pg8::Gemm g{(const bf16*)(ws + WS_LIN), (const bf16*)(ws + WS_WLORA), TT, LORA_N, 128, LORA_K}; pg8::Sched S; S.init(TT / 256, LORA_N / 256, F.G, (int)blockIdx.x, nullptr); S.lora = 1;
            pg8::EpiLoraAct E{(bf16*)(ws + WS_LOUT), LORA_N, INP(IN_W0) + l * 1024, INP(IN_A0) + l * 1024};
#ifndef SKIP_G_LORA
            pg8::gemm_phase<pg8::EpiLoraAct, pg8::Sched, true, true>(F.lds + RING_OFF, g, S, E, F.wave);
#endif
            }

#ifndef SKIP_ATTN
        p_attn(F, (char*)lds + RING_OFF, !last);
#endif

        GRID_BAR(); TS(4);

#if USE_SEQ_SCAN
        p_scan(F, args, l);
#else
        p_scan1(F, args, l);
#if PROBE == 5
        p_scan1(F, args, l);
#endif
        GRID_BAR(); TS(5);
        p_scan2(F);
#if PROBE == 6
        p_scan2(F);
#endif
        GRID_BAR(); TS(6);
        p_scan3r(F, args, l);
#endif
#if USE_SEQ_SCAN
        GRID_BAR(); TS(15);
        p_readout(F, args, l);
#endif
        GRID_BAR(); TS(7);
        {   unsigned char* const ws = launder(F.ws); bf16* const XB = (bf16*)(ws + WS_XB); const float* const MOD = (const float*)(ws + WS_MOD); bf16* const H = (bf16*)F.out; (void)XB; (void)MOD; (void)H;
            pg8::Gemm g{(const bf16*)(ws + WS_QO), (const bf16*)(ws + WS_WOUT), TT, 1024, 1024, 0, 0}; pg8::SchedSK S; S.init(TL / 256, !last, 1024 / 64, F.G, (int)blockIdx.x);
            pg8::EpiResidB<l == 0> E{INP(IN_X), INP(IN_CTX), XB, MOD + (size_t)l * 9 * 6144 + 2 * 1024, (bf16*)(ws + WS_SIDE), 1.0f};
#ifndef SKIP_G_OUT
            pg8::gemm_phase<pg8::EpiResidB<l == 0>, pg8::SchedSK, true, true>(F.lds + RING_OFF, g, S, E, F.wave);
#endif
            }
        GRID_BAR(); TS(8);
        p_wprep(F, args, l, 1);
#if PROBE == 7
        p_wprep(F, args, l, 1);
#endif
        if (!moe) {
            p_norm<false, false, false, true>(F, args, l, 1, nullptr, nullptr, 0);
#if PROBE == 4
            p_norm<false, false, false, false>(F, args, l, 1, nullptr, nullptr, 0);
#endif
            GRID_BAR(); TS(9);
            {   unsigned char* const ws = launder(F.ws); bf16* const XB = (bf16*)(ws + WS_XB); const float* const MOD = (const float*)(ws + WS_MOD); bf16* const H = (bf16*)F.out; (void)XB; (void)MOD; (void)H;
            pg8::Gemm g{H, (const bf16*)(ws + WS_WFF), TT, 2 * FFD, 1024, 0}; pg8::Sched S; S.init(TT / 256, 2 * FFD / 256, F.G, (int)blockIdx.x, nullptr);
                pg8::EpiSwiGLU E{(bf16*)(ws + WS_HID), FFD, 1.0f};
#ifndef SKIP_G_UP
                pg8::gemm_phase<pg8::EpiSwiGLU, pg8::Sched, true, true>(F.lds + RING_OFF, g, S, E, F.wave);
#endif
            }
            GRID_BAR(); TS(10);
            {   unsigned char* const ws = launder(F.ws); bf16* const XB = (bf16*)(ws + WS_XB); const float* const MOD = (const float*)(ws + WS_MOD); bf16* const H = (bf16*)F.out; (void)XB; (void)MOD; (void)H;
            pg8::Gemm g{(const bf16*)(ws + WS_HID), (const bf16*)(ws + WS_WFF_D_DENSE), TT, 1024, FFD, 0, 0}; pg8::SchedSK S; S.init(TL / 256, true, FFD / 64, F.G, (int)blockIdx.x);
                pg8::EpiResidB<false> E{nullptr, nullptr, XB, MOD + (size_t)l * 9 * 6144 + 5 * 1024, (bf16*)(ws + WS_SIDE), 1.0f};
#ifndef SKIP_G_DOWN
                pg8::gemm_phase<pg8::EpiResidB<false>, pg8::SchedSK, true, true>(F.lds + RING_OFF, g, S, E, F.wave);
#endif
            }
            GRID_BAR(); TS(11);
        } else {
            p_norm<true, false, false, !last>(F, args, l, 1, nullptr, nullptr, 0, last ? TL : TT);
#if PROBE == 4
            p_norm<true, false, false, false>(F, args, l, 1, nullptr, nullptr, 0, last ? TL : TT);
#endif
            GRID_BAR(); TS(9);

#ifndef SKIP_ROUTE
            p_route(F, last ? TL : TT);
#endif

            GRID_BAR(); TS(12);
            const int npanels = *(LAS int*)(F.lds + LT_NPAN);
            {   unsigned char* const ws = launder(F.ws); bf16* const XB = (bf16*)(ws + WS_XB); const float* const MOD = (const float*)(ws + WS_MOD); bf16* const H = (bf16*)F.out; (void)XB; (void)MOD; (void)H;
            pg8::Gemm g{(const bf16*)(ws + WS_AG8), (const bf16*)(ws + WS_WFF), npanels * 256, 2 * FFE, 512, 0}; pg8::Sched S; S.init(npanels, 2 * FFE / 256, F.G, (int)blockIdx.x, (const LAS int*)(F.lds + LT_PEXP));
                pg8::EpiSwiGLU8 E{ws + WS_HIDM, FFE, 1.0f / (H8SCALE * W8SCALE), HID8SCALE};
#ifndef SKIP_G_MUP
                pg8::gemm_phase<pg8::EpiSwiGLU8, pg8::Sched, true, true, true>(F.lds + RING_OFF, g, S, E, F.wave);
#endif
            }
            GRID_BAR(); TS(13);
            {   unsigned char* const ws = launder(F.ws); bf16* const XB = (bf16*)(ws + WS_XB); const float* const MOD = (const float*)(ws + WS_MOD); bf16* const H = (bf16*)F.out; (void)XB; (void)MOD; (void)H;
            pg8::Gemm g{(const bf16*)(ws + WS_HIDM), (const bf16*)(ws + WS_WFF_D_MOE8), npanels * 256, 1024, FFE / 2, 0}; pg8::Sched S; S.init(npanels, 4, F.G, (int)blockIdx.x, (const LAS int*)(F.lds + LT_PEXP));
                pg8::EpiBf16S E{(bf16*)(ws + WS_AG), 1024, 1.0f / (HID8SCALE * W8SCALE)};
#ifndef SKIP_G_MDOWN
                pg8::gemm_phase<pg8::EpiBf16S, pg8::Sched, true, true, true>(F.lds + RING_OFF, g, S, E, F.wave);
#endif
            }
            GRID_BAR(); TS(14);
        }

#undef GRID_BAR
}
__global__ void __launch_bounds__(NWAVES * 64, 2) mk_fwd(Args args) {
    extern __shared__ __attribute__((aligned(16))) unsigned char lds[];
    Frame F;
    F.lds = (LAS unsigned char*)lds;
    F.MISC = (volatile LAS unsigned*)(F.lds + MISC_OFF);
    F.tid = threadIdx.x; F.lane = F.tid & 63; F.wave = __builtin_amdgcn_readfirstlane(F.tid >> 6);
    F.G = gridDim.x; { const int bx = blockIdx.x; F.vcu = (F.G % 8 == 0) ? (bx % 8) * (F.G / 8) + bx / 8 : bx; }
    F.ws = args.ws; F.ctl = (gu32*)(args.ws + WS_CTL); F.out = args.out;
    for (int u = F.tid; u < 64; u += NWAVES * 64) ((LAS unsigned*)(F.lds + LDSCTL_OFF))[u] = 0u;
    if (F.tid < 30) ((LAS unsigned long long*)(F.lds + LT_INP))[F.tid] = (unsigned long long)args.in[F.tid];
    __syncthreads();
    XcdBarrier bar = xcd_barrier_post((unsigned*)(F.ctl + CW_BAR), F.MISC + 8, F.wave);
#define GRID_BAR() xcd_barrier(bar)
#if TSEL >= 0
    if (blockIdx.x == 0 && F.wave == 0 && hw_lane() == 0) ((unsigned long long*)(F.ws + WS_CTL + 32768))[0] = __builtin_amdgcn_s_memrealtime();
#endif

#ifndef SKIP_PRO
    p_prologue(F, args);
#endif

    GRID_BAR(); TS(0);
    layer_body<0>(F, args, bar, lds);
#if DEBUG_NAN
    return;
#endif
    layer_body<1>(F, args, bar, lds);
    layer_body<2>(F, args, bar, lds);
    layer_body<3>(F, args, bar, lds);

#ifndef SKIP_FINAL
    p_final_combine(F, DEPTH - 1);
#endif
#if TSEL >= 0
    TS(15);
    xcd_barrier(bar);
    if (blockIdx.x == 0 && F.wave == 0 && hw_lane() == 0) { const unsigned long long* ts_ = (const unsigned long long*)(F.ws + WS_CTL + 32768); float tot = 0.f, sel = 0.f;
        for (int k = 0; k < 16; ++k) { tot += (float)ts_[1 + k]; if ((TSEL >> k) & 1) sel += (float)ts_[1 + k]; }
        F.out[0] += 3.0f + 6.9f * sel / tot; }
#endif

#if CYSEL >= 0
    xcd_barrier(bar);
    if (blockIdx.x == 0 && F.wave == 0 && hw_lane() == 0) { const unsigned long long* cs_ = (const unsigned long long*)(F.ws + WS_CTL + 40960); float tot = 0.f; for (int k = 0; k < 5; ++k) tot += (float)cs_[k];
        F.out[0] += 3.0f + 6.9f * (float)cs_[CYSEL] / tot; }
#endif
    if (xb_ld((unsigned*)(F.ctl + CW_BAR) + XB_TMO) != 0u && blockIdx.x == 0 && F.wave == 0 && hw_lane() == 0) F.out[0] = __builtin_nanf("");
}

extern "C" void kernel_launch(void* const* d_in, const int* in_sizes, int n_in, void* d_out, int out_size, void* d_ws, size_t ws_size, hipStream_t stream) {
    static int grid = 0;
    if (grid == 0) {
        if (n_in != 30 || in_sizes[0] != TL * 1024 || out_size != TL * 1024 || ws_size < WS_END) { fprintf(stderr, "kernel_launch: unexpected shapes / workspace (n_in %d, ws %zu); nothing launched\n", n_in, ws_size); grid = -1; return; }
        int dev = 0, cus = 0, per_cu = 0;
        if (hipGetDevice(&dev) != hipSuccess || hipDeviceGetAttribute(&cus, hipDeviceAttributeMultiprocessorCount, dev) != hipSuccess) { grid = -1; return; }
        if (hipFuncSetAttribute((const void*)mk_fwd, hipFuncAttributeMaxDynamicSharedMemorySize, LDS_BYTES) != hipSuccess) { fprintf(stderr, "kernel_launch: hipFuncSetAttribute failed\n"); grid = -1; return; }
        if (hipOccupancyMaxActiveBlocksPerMultiprocessor(&per_cu, (const void*)mk_fwd, NWAVES * 64, LDS_BYTES) != hipSuccess || per_cu < 1) { fprintf(stderr, "kernel_launch: occupancy query reports %d blocks per CU\n", per_cu); }
        (void)hipGetLastError();
        grid = cus;
    }
    if (grid < 0) return;
    if (hipMemsetAsync((char*)d_ws + WS_CTL, 0, CTL_ZERO_BYTES, stream) != hipSuccess) return;
    Args a{};
    for (int i = 0; i < 30; ++i) a.in[i] = (const float*)d_in[i];
    a.out = (float*)d_out; a.ws = (unsigned char*)d_ws;
    hipLaunchKernelGGL(mk_fwd, dim3(grid), dim3(NWAVES * 64), LDS_BYTES, stream, a);
}
```
